# Optimizing an MI355X kernel written in HIP

```python
import jax, jax.numpy as jnp
from jax import lax
import numpy as np

D_MODEL = 1024
BATCH = 2
SEQ = 8192
DEPTH = 1

HEAD_DIM = 64
D_MIX = D_MODEL
N_HEADS = D_MIX // HEAD_DIM
NSA_HEADS = N_HEADS // 2
NSA_KV = 2
NSA_GROUP = NSA_HEADS // NSA_KV
SWA_HEADS = N_HEADS - NSA_HEADS
SWA_KV = 1
SWA_GROUP = SWA_HEADS // SWA_KV
NSA_CMP_LEN = 32
NSA_CMP_STRIDE = 16
NSA_CMP_HIDDEN = 256
NSA_SEL_BLOCK = 64
NSA_TOPN = 16
NSA_WINDOW = 512
SWA_WINDOW = 128
Q_BLOCK = 128
FORCE_SCORE = 1.0e4
PEER_HEADS = 8
PEER_NKEYS = 128
PEER_EXPERTS = PEER_NKEYS * PEER_NKEYS
PEER_DKEY = 256
PEER_TOPK = 16
PEER_CHUNK = 128
EPS = 1e-6

kernel_name = 'hymba_nsa_swa_peer_layer'


def split_sizes():
    hd = HEAD_DIM
    return [NSA_HEADS * hd,
            NSA_KV * hd, NSA_KV * hd,
            NSA_KV * hd, NSA_KV * hd,
            NSA_KV * hd, NSA_KV * hd,
            NSA_HEADS * 3,
            SWA_HEADS * hd,
            SWA_KV * hd, SWA_KV * hd]


def alibi_slopes(n):
    return (2.0 ** (-8.0 * (np.arange(n) + 1) / n)).astype(np.float32)


def rms_norm(x, g):
    xf = x.astype(jnp.float32)
    y = xf * lax.rsqrt(jnp.mean(xf * xf, axis=-1, keepdims=True) + EPS)
    return (y * g.astype(jnp.float32)).astype(x.dtype)


def masked_softmax(s, valid):
    s = jnp.where(valid, s.astype(jnp.float32), -jnp.inf)
    m = jnp.max(s, axis=-1, keepdims=True)
    m = jnp.where(jnp.isfinite(m), m, 0.0)
    e = jnp.exp(s - m)
    return e / jnp.maximum(jnp.sum(e, axis=-1, keepdims=True), 1e-30)


def compress(kv, pe, w1, w2):
    B, T, G, dh = kv.shape
    n_cmp = (T - NSA_CMP_LEN) // NSA_CMP_STRIDE + 1
    idx = np.arange(n_cmp)[:, None] * NSA_CMP_STRIDE + np.arange(NSA_CMP_LEN)[None, :]
    blocks = kv[:, idx] + pe[None, None, :, None, :]
    flat = blocks.transpose(0, 1, 3, 2, 4).reshape(B, n_cmp, G, NSA_CMP_LEN * dh)
    return jax.nn.gelu(flat @ w1) @ w2


def nsa_attention(q, kc_raw, vc_raw, ks, vs, kw, vw, gates,
                  pe_k, w1_k, w2_k, pe_v, w1_v, w2_v, slopes):
    B, T, G, Hg, dh = q.shape
    scale = dh ** -0.5
    kc = compress(kc_raw, pe_k, w1_k, w2_k)
    vc = compress(vc_raw, pe_v, w1_v, w2_v)
    n_cmp = kc.shape[1]
    n_sel = T // NSA_SEL_BLOCK
    k_top = min(NSA_TOPN, n_sel)
    cmp_end = jnp.asarray(np.arange(n_cmp) * NSA_CMP_STRIDE + NSA_CMP_LEN - 1, jnp.int32)
    c0 = np.arange(n_cmp)[:, None] * NSA_CMP_STRIDE
    s0 = np.arange(n_sel)[None, :] * NSA_SEL_BLOCK
    overlap = jnp.asarray(((c0 < s0 + NSA_SEL_BLOCK) & (c0 + NSA_CMP_LEN > s0)).astype(np.float32))
    ks_blk = ks.reshape(B, n_sel, NSA_SEL_BLOCK, G, dh).transpose(0, 3, 1, 2, 4)
    vs_blk = vs.reshape(B, n_sel, NSA_SEL_BLOCK, G, dh).transpose(0, 3, 1, 2, 4)
    kw_pad = jnp.pad(kw, ((0, 0), (NSA_WINDOW, 0), (0, 0), (0, 0)))
    vw_pad = jnp.pad(vw, ((0, 0), (NSA_WINDOW, 0), (0, 0), (0, 0)))
    gsig = jax.nn.sigmoid(gates.astype(jnp.float32))
    sl = jnp.asarray(slopes).reshape(G, Hg)[None, :, :, None, None]
    bi = jnp.arange(B)[:, None, None, None]
    gi = jnp.arange(G)[None, :, None, None]

    def block(i):
        q0 = i * Q_BLOCK
        qb = lax.dynamic_slice_in_dim(q, q0, Q_BLOCK, axis=1)
        tq = q0 + jnp.arange(Q_BLOCK)
        dist_c = tq[:, None] - cmp_end[None, :]
        s_c = jnp.einsum('bqghd,bngd->bghqn', qb, kc).astype(jnp.float32) * scale
        p_c = masked_softmax(s_c - sl * dist_c.astype(jnp.float32), dist_c >= 0)
        o_c = jnp.einsum('bghqn,bngd->bqghd', p_c.astype(vc.dtype), vc)
        imp = jnp.einsum('bgqn,ns->bgqs', jnp.sum(p_c, axis=2), overlap)
        blk_t = (tq // NSA_SEL_BLOCK)[:, None]
        j = jnp.arange(n_sel)[None, :]
        imp = jnp.where((j == 0) | (j == blk_t) | (j == blk_t - 1), FORCE_SCORE, imp)
        imp = jnp.where(j <= blk_t, imp, -jnp.inf)
        top_s, top_i = lax.top_k(imp, k_top)
        blk_ok = jnp.isfinite(top_s)
        k_sel = ks_blk[bi, gi, top_i].reshape(B, G, Q_BLOCK, k_top * NSA_SEL_BLOCK, dh)
        v_sel = vs_blk[bi, gi, top_i].reshape(B, G, Q_BLOCK, k_top * NSA_SEL_BLOCK, dh)
        pos = (top_i[..., None] * NSA_SEL_BLOCK + jnp.arange(NSA_SEL_BLOCK)).reshape(
            B, G, Q_BLOCK, k_top * NSA_SEL_BLOCK)
        dist_s = tq[None, None, :, None] - pos
        ok_s = jnp.broadcast_to(blk_ok[..., None], blk_ok.shape + (NSA_SEL_BLOCK,)).reshape(
            dist_s.shape) & (dist_s >= 0)
        s_s = jnp.einsum('bqghd,bgqkd->bghqk', qb, k_sel).astype(jnp.float32) * scale
        s_s = s_s - sl * dist_s[:, :, None].astype(jnp.float32)
        p_s = masked_softmax(s_s, ok_s[:, :, None])
        o_s = jnp.einsum('bghqk,bgqkd->bqghd', p_s.astype(v_sel.dtype), v_sel)
        kwb = lax.dynamic_slice_in_dim(kw_pad, q0, Q_BLOCK + NSA_WINDOW, axis=1)
        vwb = lax.dynamic_slice_in_dim(vw_pad, q0, Q_BLOCK + NSA_WINDOW, axis=1)
        pos_w = q0 - NSA_WINDOW + jnp.arange(Q_BLOCK + NSA_WINDOW)
        dist_w = tq[:, None] - pos_w[None, :]
        ok_w = (dist_w >= 0) & (dist_w < NSA_WINDOW) & (pos_w >= 0)[None, :]
        s_w = jnp.einsum('bqghd,bkgd->bghqk', qb, kwb).astype(jnp.float32) * scale
        p_w = masked_softmax(s_w - sl * dist_w.astype(jnp.float32), ok_w)
        o_w = jnp.einsum('bghqk,bkgd->bqghd', p_w.astype(vwb.dtype), vwb)
        gb = lax.dynamic_slice_in_dim(gsig, q0, Q_BLOCK, axis=1)
        o = gb[..., 0:1] * o_c + gb[..., 1:2] * o_s + gb[..., 2:3] * o_w
        return o.astype(q.dtype)

    out = lax.map(block, jnp.arange(T // Q_BLOCK))
    return out.transpose(1, 0, 2, 3, 4, 5).reshape(B, T, G * Hg * dh)


def swa_attention(q, k, v, sinks, slopes):
    B, T, H, dh = q.shape
    KV = k.shape[2]
    Hg = H // KV
    nb = T // Q_BLOCK
    scale = dh ** -0.5
    qb = q.reshape(B, nb, Q_BLOCK, KV, Hg, dh)
    pad = ((0, 0), (Q_BLOCK, 0), (0, 0), (0, 0))
    kp = jnp.pad(k, pad).reshape(B, nb + 1, Q_BLOCK, KV, dh)
    vp = jnp.pad(v, pad).reshape(B, nb + 1, Q_BLOCK, KV, dh)
    kwin = jnp.concatenate([kp[:, :-1], kp[:, 1:]], axis=2)
    vwin = jnp.concatenate([vp[:, :-1], vp[:, 1:]], axis=2)
    dist = (Q_BLOCK + np.arange(Q_BLOCK)[:, None] - np.arange(2 * Q_BLOCK)[None, :])
    kpos = np.arange(nb)[:, None] * Q_BLOCK - Q_BLOCK + np.arange(2 * Q_BLOCK)[None, :]
    valid = ((dist >= 0) & (dist < SWA_WINDOW))[None] & (kpos >= 0)[:, None, :]
    s = jnp.einsum('bnqghd,bnkgd->bnghqk', qb, kwin).astype(jnp.float32) * scale
    s = s - jnp.asarray(slopes).reshape(KV, Hg)[:, :, None, None] * dist.astype(np.float32)
    s = jnp.where(jnp.asarray(valid)[None, :, None, None], s, -jnp.inf)
    sink = jnp.broadcast_to(sinks.astype(jnp.float32).reshape(1, 1, KV, Hg, 1, 1), s.shape[:-1] + (1,))
    p = jax.nn.softmax(jnp.concatenate([s, sink], axis=-1), axis=-1)[..., :-1]
    o = jnp.einsum('bnghqk,bnkgd->bnqghd', p.astype(vwin.dtype), vwin)
    return o.reshape(B, T, H * dh)


def peer_ffn(h, wq, keys, u, v):
    B, T, D = h.shape
    q = (h @ wq).reshape(B, T, PEER_HEADS, 2, PEER_DKEY // 2)
    s = jnp.einsum('bthcd,hcnd->bthcn', q, keys).astype(jnp.float32)
    s1, i1 = lax.top_k(s[..., 0, :], PEER_TOPK)
    s2, i2 = lax.top_k(s[..., 1, :], PEER_TOPK)
    cand = (s1[..., :, None] + s2[..., None, :]).reshape(B, T, PEER_HEADS, PEER_TOPK * PEER_TOPK)
    cidx = (i1[..., :, None] * PEER_NKEYS + i2[..., None, :]).reshape(cand.shape)
    cs, ci = lax.top_k(cand, PEER_TOPK)
    eidx = jnp.take_along_axis(cidx, ci, axis=-1)
    gate = jax.nn.softmax(cs, axis=-1)
    n_tok = B * T
    n_chunk = n_tok // PEER_CHUNK
    n_sel = PEER_HEADS * PEER_TOPK
    hf = h.reshape(n_chunk, PEER_CHUNK, D)
    ef = eidx.reshape(n_chunk, PEER_CHUNK, n_sel)
    gf = gate.reshape(n_chunk, PEER_CHUNK, n_sel)

    def chunk(args):
        hc, ec, gc = args
        uc = u[ec]
        act = jax.nn.gelu(jnp.einsum('cd,ced->ce', hc, uc).astype(jnp.float32))
        vc = v[ec]
        return jnp.einsum('ce,ced->cd', (gc * act).astype(vc.dtype), vc)

    out = lax.map(chunk, (hf, ef, gf))
    return out.reshape(B, T, D).astype(h.dtype)


def setup_inputs(seed: int = 0) -> dict:
    key = jax.random.key(seed)
    ks = jax.random.split(key, 20)
    d_in = sum(split_sizes())
    hd = HEAD_DIM
    L = NSA_CMP_LEN
    nrm = lambda k, shape, s: jax.random.normal(k, shape, jnp.float32) * s
    return {
        'x': jax.random.normal(ks[0], (BATCH, SEQ, D_MODEL), jnp.float32),
        'ln1_g': 1.0 + nrm(ks[1], (DEPTH, D_MODEL), 0.02),
        'w_in': nrm(ks[2], (DEPTH, D_MODEL, d_in), D_MODEL ** -0.5),
        'cmp_pe_k': nrm(ks[3], (DEPTH, L, hd), 0.1),
        'cmp_w1_k': nrm(ks[4], (DEPTH, L * hd, NSA_CMP_HIDDEN), (L * hd) ** -0.5),
        'cmp_w2_k': nrm(ks[5], (DEPTH, NSA_CMP_HIDDEN, hd), NSA_CMP_HIDDEN ** -0.5),
        'cmp_pe_v': nrm(ks[6], (DEPTH, L, hd), 0.1),
        'cmp_w1_v': nrm(ks[7], (DEPTH, L * hd, NSA_CMP_HIDDEN), (L * hd) ** -0.5),
        'cmp_w2_v': nrm(ks[8], (DEPTH, NSA_CMP_HIDDEN, hd), NSA_CMP_HIDDEN ** -0.5),
        'swa_sinks': nrm(ks[9], (DEPTH, SWA_HEADS), 0.5),
        'w_out': nrm(ks[10], (DEPTH, D_MIX, D_MODEL), D_MIX ** -0.5),
        'ln2_g': 1.0 + nrm(ks[11], (DEPTH, D_MODEL), 0.02),
        'peer_wq': nrm(ks[12], (DEPTH, D_MODEL, PEER_HEADS * PEER_DKEY), D_MODEL ** -0.5),
        'peer_keys': nrm(ks[13], (DEPTH, PEER_HEADS, 2, PEER_NKEYS, PEER_DKEY // 2), (PEER_DKEY // 2) ** -0.5),
        'peer_u': nrm(ks[14], (DEPTH, PEER_EXPERTS, D_MODEL), D_MODEL ** -0.5),
        'peer_v': nrm(ks[15], (DEPTH, PEER_EXPERTS, D_MODEL), PEER_HEADS ** -0.5),
        'lnf_g': 1.0 + nrm(ks[16], (D_MODEL,), 0.02),
    }


def reference(x, ln1_g, w_in, cmp_pe_k, cmp_w1_k, cmp_w2_k, cmp_pe_v, cmp_w1_v, cmp_w2_v,
              swa_sinks, w_out, ln2_g, peer_wq, peer_keys, peer_u, peer_v, lnf_g):
    B, T, _ = x.shape
    hd = HEAD_DIM
    split_idx = [int(c) for c in np.cumsum(split_sizes())[:-1]]
    slopes = alibi_slopes(N_HEADS)
    swa_slopes = slopes[:SWA_HEADS]
    nsa_slopes = slopes[SWA_HEADS:]
    h = x
    for l in range(DEPTH):
        a = rms_norm(h, ln1_g[l])
        proj = a @ w_in[l]
        q_n, kc, vc, kss, vss, kw, vw, gt, q_s, k_s, v_s = jnp.split(proj, split_idx, axis=-1)
        kv4 = lambda t: t.reshape(B, T, NSA_KV, hd)
        o_n = nsa_attention(q_n.reshape(B, T, NSA_KV, NSA_GROUP, hd),
                            kv4(kc), kv4(vc), kv4(kss), kv4(vss), kv4(kw), kv4(vw),
                            gt.reshape(B, T, NSA_KV, NSA_GROUP, 3),
                            cmp_pe_k[l], cmp_w1_k[l], cmp_w2_k[l],
                            cmp_pe_v[l], cmp_w1_v[l], cmp_w2_v[l], nsa_slopes)
        o_s = swa_attention(q_s.reshape(B, T, SWA_HEADS, hd),
                            k_s.reshape(B, T, SWA_KV, hd), v_s.reshape(B, T, SWA_KV, hd),
                            swa_sinks[l], swa_slopes)
        h = h + jnp.concatenate([o_n, o_s], axis=-1) @ w_out[l]
        h = h + peer_ffn(rms_norm(h, ln2_g[l]), peer_wq[l], peer_keys[l], peer_u[l], peer_v[l])
    return rms_norm(h, lnf_g)
```

```cpp
#include <hip/hip_runtime.h>
#include <hip/hip_cooperative_groups.h>
#include <cstdint>
#include <cstdio>
namespace cg = cooperative_groups;

typedef unsigned short bf16_t;
typedef short bf16x8 __attribute__((ext_vector_type(8)));
typedef float f32x4 __attribute__((ext_vector_type(4)));
typedef unsigned u32x4 __attribute__((ext_vector_type(4)));
typedef unsigned u32x2 __attribute__((ext_vector_type(2)));

constexpr int BATCH = 2, T = 8192, D = 1024, NTOK = BATCH * T;
constexpr int HD = 64, NSA_H = 8, NSA_G = 2, NSA_HG = 4, SWA_H = 8;
constexpr int DIN = 1944, DINP = 2048;
constexpr int NCMP = 511, NCMPP = 512, NSEL = 128, TOPN = 16;
constexpr int NSA_WIN = 512, SWA_WIN = 128;
constexpr int PH = 8, PNK = 128, PDK = 256, PTOPK = 16, PQ = PH * PDK;
constexpr int NEXP = PNK * PNK;
constexpr float EPS = 1e-6f;
constexpr int NTHREADS = 512;

constexpr size_t MiB = 1u << 20;
constexpr size_t WS_SS2 = 0;
constexpr size_t WS_WIN = 1 * MiB;
constexpr size_t WS_WOUT = 5 * MiB;
constexpr size_t WS_WQ = 7 * MiB;
constexpr size_t WS_PKEYS = 11 * MiB;
constexpr size_t WS_XN = 16 * MiB;
constexpr size_t WS_O = WS_XN;
constexpr size_t WS_QN = 48 * MiB;
constexpr size_t WS_QS = 64 * MiB;
constexpr size_t WS_KV6 = 80 * MiB;
constexpr size_t KV6_STRIDE = 4 * MiB;
constexpr size_t WS_KSW = 104 * MiB;
constexpr size_t WS_VSW = 106 * MiB;
constexpr size_t WS_GSIG = 108 * MiB;
constexpr size_t WS_KC = 110 * MiB;
constexpr size_t WS_VC = 110 * MiB + 512 * 1024;
constexpr size_t WS_H1G = 48 * MiB;
constexpr size_t WS_QP = 80 * MiB;
constexpr size_t WS_EIDX = 144 * MiB;
constexpr size_t WS_GATE = 152 * MiB;
constexpr size_t WS_U16 = 160 * MiB;
constexpr size_t WS_V16 = 192 * MiB;
constexpr size_t WS_TOPV2 = 224 * MiB;
constexpr size_t WS_TOPI2 = 240 * MiB;
constexpr size_t WS_END = 256 * MiB;

struct Params {
    const float* x; const float* ln1_g; const float* w_in;
    const float* pe_k; const float* w1_k; const float* w2_k;
    const float* pe_v; const float* w1_v; const float* w2_v;
    const float* sinks; const float* w_out; const float* ln2_g;
    const float* wq; const float* pkeys; const float* pu; const float* pv; const float* lnf_g;
    float* out; unsigned char* ws;
};

__device__ __forceinline__ unsigned f2bf(float f) { unsigned u = __float_as_uint(f); return (u + 0x7fffu + ((u >> 16) & 1u)) >> 16; }
__device__ __forceinline__ float bf2f(unsigned h) { return __uint_as_float(h << 16); }
__device__ __forceinline__ float bflo(unsigned w) { return __uint_as_float(w << 16); }
__device__ __forceinline__ float bfhi(unsigned w) { return __uint_as_float(w & 0xffff0000u); }
__device__ __forceinline__ unsigned pk2(float lo, float hi) { return f2bf(lo) | (f2bf(hi) << 16); }
__device__ __forceinline__ float wave_sum(float v) {
#pragma unroll
    for (int o = 1; o < 64; o <<= 1) v += __shfl_xor(v, o);
    return v;
}
__device__ __forceinline__ float gelu_tanh(float x) {
    const float u = 0.7978845608028654f * (x + 0.044715f * x * x * x);
    return 0.5f * x * (1.0f + tanhf(u));
}
__device__ __forceinline__ int win_orig_col(int n) {
    if (n < 1280) return n;
    if (n < 1792) return 1304 + (n - 1280);
    if (n < 1856) return 1816 + (n - 1792);
    if (n < 1920) return 1880 + (n - 1856);
    if (n < 1944) return 1280 + (n - 1920);
    return -1;
}

template <bool WIN_MAP>
__device__ __forceinline__ void prep_transpose(const float* W, int K, int N, int NP, bf16_t* WT, long gt, long ngt) {
    const long items = (long)NP * (K / 8);
    for (long it = gt; it < items; it += ngt) {
        const int n = (int)(it % NP), k0 = (int)(it / NP) * 8;
        const int col = WIN_MAP ? win_orig_col(n) : n;
        float v[8];
#pragma unroll
        for (int i = 0; i < 8; ++i) v[i] = (col >= 0) ? W[(size_t)(k0 + i) * N + col] : 0.f;
        u32x4 o; o.x = pk2(v[0], v[1]); o.y = pk2(v[2], v[3]); o.z = pk2(v[4], v[5]); o.w = pk2(v[6], v[7]);
        *(u32x4*)(WT + (size_t)n * K + k0) = o;
    }
}
__device__ __forceinline__ void prep_convert(const float* src, bf16_t* dst, long n8, long gt, long ngt) {
    for (long it = gt; it < n8; it += ngt) {
        const f32x4 a = *(const f32x4*)(src + it * 8), b = *(const f32x4*)(src + it * 8 + 4);
        u32x4 o; o.x = pk2(a.x, a.y); o.y = pk2(a.z, a.w); o.z = pk2(b.x, b.y); o.w = pk2(b.z, b.w);
        *(u32x4*)(dst + it * 8) = o;
    }
}
__device__ __forceinline__ void phase_prep(const Params& p) {
    const long gt = (long)blockIdx.x * blockDim.x + threadIdx.x, ngt = (long)gridDim.x * blockDim.x;
    const int lane = threadIdx.x & 63;
    const long gw = gt >> 6, ngw = ngt >> 6;
    unsigned char* ws = p.ws;
    for (long m = gw; m < NTOK; m += ngw) {
        const f32x4* xr = (const f32x4*)(p.x + (size_t)m * D) + lane;
        f32x4 v[4]; float s = 0.f;
#pragma unroll
        for (int j = 0; j < 4; ++j) { v[j] = xr[64 * j]; s += (v[j].x * v[j].x + v[j].y * v[j].y) + (v[j].z * v[j].z + v[j].w * v[j].w); }
        const float rstd = 1.0f / sqrtf(wave_sum(s) * (1.0f / D) + EPS);
        u32x2* o = (u32x2*)((bf16_t*)(ws + WS_XN) + (size_t)m * D) + lane;
#pragma unroll
        for (int j = 0; j < 4; ++j) {
            const f32x4 g = *((const f32x4*)p.ln1_g + lane + 64 * j);
            u32x2 w; w.x = pk2(v[j].x * rstd * g.x, v[j].y * rstd * g.y); w.y = pk2(v[j].z * rstd * g.z, v[j].w * rstd * g.w);
            o[64 * j] = w;
        }
    }
    prep_transpose<true>(p.w_in, D, DIN, DINP, (bf16_t*)(ws + WS_WIN), gt, ngt);
    prep_transpose<false>(p.w_out, D, D, D, (bf16_t*)(ws + WS_WOUT), gt, ngt);
    prep_transpose<false>(p.wq, D, PQ, PQ, (bf16_t*)(ws + WS_WQ), gt, ngt);
    prep_convert(p.pkeys, (bf16_t*)(ws + WS_PKEYS), (long)16 * 128 * 128 / 8, gt, ngt);
    prep_convert(p.pu, (bf16_t*)(ws + WS_U16), (long)NEXP * D / 8, gt, ngt);
    prep_convert(p.pv, (bf16_t*)(ws + WS_V16), (long)NEXP * D / 8, gt, ngt);
    for (long i = gt; i < NTOK; i += ngt) ((float*)(ws + WS_SS2))[i] = 0.f;
}

template <class Epi>
__device__ __forceinline__ void gemm_simple(const bf16_t* A, const bf16_t* Bt, int M, int N, int K, const Epi& E) {
    const int lane = threadIdx.x & 63;
    const long gw = ((long)blockIdx.x * blockDim.x + threadIdx.x) >> 6, ngw = ((long)gridDim.x * blockDim.x) >> 6;
    const int ntn = N / 64; const long ntiles = (long)(M / 32) * ntn;
    const int fr = lane & 15, fq = lane >> 4;
    for (long tile = gw; tile < ntiles; tile += ngw) {
        const int m0 = (int)(tile / ntn) * 32, n0 = (int)(tile % ntn) * 64;
        f32x4 acc[2][4];
#pragma unroll
        for (int i = 0; i < 2; ++i)
#pragma unroll
            for (int j = 0; j < 4; ++j) acc[i][j] = (f32x4){0.f, 0.f, 0.f, 0.f};
        const bf16_t* ap = A + (size_t)(m0 + fr) * K + fq * 8;
        const bf16_t* bp = Bt + (size_t)(n0 + fr) * K + fq * 8;
        for (int k0 = 0; k0 < K; k0 += 32) {
            bf16x8 a[2], b[4];
#pragma unroll
            for (int i = 0; i < 2; ++i) a[i] = *(const bf16x8*)(ap + (size_t)i * 16 * K + k0);
#pragma unroll
            for (int j = 0; j < 4; ++j) b[j] = *(const bf16x8*)(bp + (size_t)j * 16 * K + k0);
#pragma unroll
            for (int i = 0; i < 2; ++i)
#pragma unroll
                for (int j = 0; j < 4; ++j) acc[i][j] = __builtin_amdgcn_mfma_f32_16x16x32_bf16(a[i], b[j], acc[i][j], 0, 0, 0);
        }
        E(acc, m0, n0, fr, fq);
    }
}

struct EpiProj {
    unsigned char* ws;
    __device__ __forceinline__ void operator()(const f32x4 (&acc)[2][4], int m0, int n0, int fr, int fq) const {
#pragma unroll
        for (int i = 0; i < 2; ++i)
#pragma unroll
            for (int j = 0; j < 4; ++j)
#pragma unroll
                for (int r = 0; r < 4; ++r) {
                    const int row = m0 + 16 * i + fq * 4 + r, n = n0 + 16 * j + fr;
                    const float v = acc[i][j][r];
                    const int b = row / T, t = row % T, d = n & 63;
                    if (n < 512) {
                        const int head = n >> 6;
                        ((bf16_t*)(ws + WS_QN))[((size_t)(b * 8 + head) * T + t) * 64 + d] = (bf16_t)f2bf(v * 0.125f);
                    } else if (n < 1280) {
                        const int arr = (n - 512) >> 7, g = ((n - 512) >> 6) & 1;
                        ((bf16_t*)(ws + WS_KV6 + arr * KV6_STRIDE))[((size_t)(b * 2 + g) * T + t) * 64 + d] = (bf16_t)f2bf(v);
                    } else if (n < 1792) {
                        const int head = (n - 1280) >> 6;
                        ((bf16_t*)(ws + WS_QS))[((size_t)(b * 8 + head) * T + t) * 64 + d] = (bf16_t)f2bf(v * 0.125f);
                    } else if (n < 1856) {
                        ((bf16_t*)(ws + WS_KSW))[((size_t)b * T + t) * 64 + d] = (bf16_t)f2bf(v);
                    } else if (n < 1920) {
                        ((bf16_t*)(ws + WS_VSW))[((size_t)b * T + t) * 64 + d] = (bf16_t)f2bf(v);
                    } else if (n < 1944) {
                        ((float*)(ws + WS_GSIG))[(size_t)row * 24 + (n - 1920)] = 1.0f / (1.0f + expf(-v));
                    }
                }
    }
};
struct EpiOut {
    const float* x; const float* g2; float* h1; bf16_t* h1g; float* ss2;
    __device__ __forceinline__ void operator()(const f32x4 (&acc)[2][4], int m0, int n0, int fr, int fq) const {
#pragma unroll
        for (int i = 0; i < 2; ++i)
#pragma unroll
            for (int r = 0; r < 4; ++r) {
                const int row = m0 + 16 * i + fq * 4 + r; float ss = 0.f;
#pragma unroll
                for (int j = 0; j < 4; ++j) {
                    const int n = n0 + 16 * j + fr; const size_t off = (size_t)row * D + n;
                    const float h = x[off] + acc[i][j][r];
                    h1[off] = h; h1g[off] = (bf16_t)f2bf(h * g2[n]); ss += h * h;
                }
                ss += __shfl_xor(ss, 1); ss += __shfl_xor(ss, 2); ss += __shfl_xor(ss, 4); ss += __shfl_xor(ss, 8);
                if (fr == 0) atomicAdd(ss2 + row, ss);
            }
    }
};
struct EpiQP {
    const float* ss2; bf16_t* qp;
    __device__ __forceinline__ void operator()(const f32x4 (&acc)[2][4], int m0, int n0, int fr, int fq) const {
#pragma unroll
        for (int i = 0; i < 2; ++i)
#pragma unroll
            for (int r = 0; r < 4; ++r) {
                const int row = m0 + 16 * i + fq * 4 + r;
                const float rstd = 1.0f / sqrtf(ss2[row] * (1.0f / D) + EPS);
#pragma unroll
                for (int j = 0; j < 4; ++j) qp[(size_t)row * PQ + n0 + 16 * j + fr] = (bf16_t)f2bf(acc[i][j][r] * rstd);
            }
    }
};

__device__ __forceinline__ void phase_compress(const Params& p, float* lds) {
    float* flat = lds;
    float* part = lds + 2048;
    float* hid = lds + 2560;
    const int tid = threadIdx.x;
    const int nunits = 2 * BATCH * NCMP * NSA_G;
    for (int u = blockIdx.x; u < nunits; u += gridDim.x) {
        const int kv = u / (BATCH * NCMP * NSA_G); int r = u % (BATCH * NCMP * NSA_G);
        const int b = r / (NCMP * NSA_G); r %= (NCMP * NSA_G);
        const int c = r / NSA_G, g = r % NSA_G;
        const bf16_t* raw = (const bf16_t*)(p.ws + WS_KV6 + (size_t)kv * KV6_STRIDE) + ((size_t)(b * 2 + g) * T + 16 * c) * 64;
        const float* pe = kv ? p.pe_v : p.pe_k; const float* w1 = kv ? p.w1_v : p.w1_k; const float* w2 = kv ? p.w2_v : p.w2_k;
        for (int i = tid; i < 2048; i += blockDim.x) flat[i] = bf2f(raw[i]) + pe[i];
        __syncthreads();
        {
            const int j = tid & 255, half = tid >> 8;
            float a = 0.f;
            const float* wp = w1 + (size_t)(half * 1024) * 256 + j; const float* fp = flat + half * 1024;
            for (int i = 0; i < 1024; ++i) a += fp[i] * wp[(size_t)i * 256];
            part[tid] = a;
        }
        __syncthreads();
        if (tid < 256) hid[tid] = gelu_tanh(part[tid] + part[tid + 256]);
        __syncthreads();
        if (tid < 64) {
            float a = 0.f;
            for (int j = 0; j < 256; ++j) a += hid[j] * w2[j * 64 + tid];
            bf16_t* dst = (bf16_t*)(p.ws + (kv ? WS_VC : WS_KC)) + ((size_t)(b * 2 + g) * NCMPP + c) * 64;
            dst[tid] = (bf16_t)f2bf(a);
        }
        __syncthreads();
    }
}

__device__ __forceinline__ void load_row64(const bf16_t* src, float (&k)[64]) {
#pragma unroll
    for (int c = 0; c < 8; ++c) {
        const u32x4 w = *(const u32x4*)(src + 8 * c);
        k[8 * c + 0] = bflo(w.x); k[8 * c + 1] = bfhi(w.x); k[8 * c + 2] = bflo(w.y); k[8 * c + 3] = bfhi(w.y);
        k[8 * c + 4] = bflo(w.z); k[8 * c + 5] = bfhi(w.z); k[8 * c + 6] = bflo(w.w); k[8 * c + 7] = bfhi(w.w);
    }
}
__device__ __forceinline__ float dot_row64(const bf16_t* src, const float (&q)[64]) {
    float s0 = 0.f, s1 = 0.f;
#pragma unroll
    for (int c = 0; c < 8; ++c) {
        const u32x4 w = *(const u32x4*)(src + 8 * c);
        s0 += q[8 * c + 0] * bflo(w.x); s1 += q[8 * c + 1] * bfhi(w.x); s0 += q[8 * c + 2] * bflo(w.y); s1 += q[8 * c + 3] * bfhi(w.y);
        s0 += q[8 * c + 4] * bflo(w.z); s1 += q[8 * c + 5] * bfhi(w.z); s0 += q[8 * c + 6] * bflo(w.w); s1 += q[8 * c + 7] * bfhi(w.w);
    }
    return s0 + s1;
}
__device__ __forceinline__ void osm_update(float s, const bf16_t* vsrc, float& m, float& l, float (&acc)[32]) {
    const float mn = fmaxf(m, s), alpha = __expf(m - mn), pr = __expf(s - mn);
    l = l * alpha + pr; m = mn;
#pragma unroll
    for (int c = 0; c < 4; ++c) {
        const u32x4 w = *(const u32x4*)(vsrc + 8 * c);
        acc[8 * c + 0] = acc[8 * c + 0] * alpha + pr * bflo(w.x); acc[8 * c + 1] = acc[8 * c + 1] * alpha + pr * bfhi(w.x);
        acc[8 * c + 2] = acc[8 * c + 2] * alpha + pr * bflo(w.y); acc[8 * c + 3] = acc[8 * c + 3] * alpha + pr * bfhi(w.y);
        acc[8 * c + 4] = acc[8 * c + 4] * alpha + pr * bflo(w.z); acc[8 * c + 5] = acc[8 * c + 5] * alpha + pr * bfhi(w.z);
        acc[8 * c + 6] = acc[8 * c + 6] * alpha + pr * bflo(w.w); acc[8 * c + 7] = acc[8 * c + 7] * alpha + pr * bfhi(w.w);
    }
}

__device__ __forceinline__ void phase_nsa(const Params& p, float* lds) {
    float* imp = lds;
    int* sel = (int*)(lds + 64 * 129);
    const int tid = threadIdx.x, qi = tid & 63, h = (tid >> 6) & 3, dh = tid >> 8;
    const unsigned char* ws = p.ws;
    const int nunits = BATCH * NSA_G * (T / 64);
    for (int u = blockIdx.x; u < nunits; u += gridDim.x) {
        const int b = u / (NSA_G * (T / 64)), g = (u / (T / 64)) % NSA_G, tile = u % (T / 64);
        const int t = tile * 64 + qi, head = g * 4 + h;
        const float slope = exp2f(-0.5f * (float)(9 + head));
        float q[64];
        load_row64((const bf16_t*)(ws + WS_QN) + ((size_t)(b * 8 + head) * T + t) * 64, q);
        const bf16_t* KC = (const bf16_t*)(ws + WS_KC) + (size_t)(b * 2 + g) * NCMPP * 64;
        const bf16_t* VC = (const bf16_t*)(ws + WS_VC) + (size_t)(b * 2 + g) * NCMPP * 64 + dh * 32;
        const bf16_t* KS = (const bf16_t*)(ws + WS_KV6 + 2 * KV6_STRIDE) + (size_t)(b * 2 + g) * T * 64;
        const bf16_t* VS = (const bf16_t*)(ws + WS_KV6 + 3 * KV6_STRIDE) + (size_t)(b * 2 + g) * T * 64 + dh * 32;
        const bf16_t* KW = (const bf16_t*)(ws + WS_KV6 + 4 * KV6_STRIDE) + (size_t)(b * 2 + g) * T * 64;
        const bf16_t* VW = (const bf16_t*)(ws + WS_KV6 + 5 * KV6_STRIDE) + (size_t)(b * 2 + g) * T * 64 + dh * 32;
        const float* gs = (const float*)(ws + WS_GSIG) + (size_t)(b * T + t) * 24 + head * 3;
        float o[32];
#pragma unroll
        for (int d = 0; d < 32; ++d) o[d] = 0.f;
        for (int i = tid; i < 64 * 129; i += blockDim.x) imp[i] = 0.f;
        __syncthreads();
        const int nc = 4 * tile + 3;
        float mc = -1e30f, lc = 0.f;
        {
            float acc[32];
#pragma unroll
            for (int d = 0; d < 32; ++d) acc[d] = 0.f;
            for (int c = 0; c < nc; ++c) {
                const int dist = t - (16 * c + 31);
                if (dist >= 0) {
                    const float s = dot_row64(KC + (size_t)c * 64, q) - slope * (float)dist;
                    osm_update(s, VC + (size_t)c * 64, mc, lc, acc);
                }
            }
            const float inv = gs[0] / fmaxf(lc, 1e-30f);
#pragma unroll
            for (int d = 0; d < 32; ++d) o[d] += acc[d] * inv;
        }
        if (dh == 0) {
            const float invl = 1.0f / fmaxf(lc, 1e-30f);
            for (int c = 0; c < nc; ++c) {
                const int dist = t - (16 * c + 31);
                if (dist >= 0) {
                    const float s = dot_row64(KC + (size_t)c * 64, q) - slope * (float)dist;
                    const float pr = __expf(s - mc) * invl;
                    const int sb = c >> 2;
                    atomicAdd(&imp[qi * 129 + sb], pr);
                    if ((c & 3) == 3 && sb + 1 < NSEL) atomicAdd(&imp[qi * 129 + sb + 1], pr);
                }
            }
        }
        __syncthreads();
        if (tid < 64) {
            const int blk_t = tile;
            float* row = imp + tid * 129;
            for (int j = 0; j <= blk_t; ++j) if (j == 0 || j == blk_t || j == blk_t - 1) row[j] = 1.0e4f;
            for (int k = 0; k < TOPN; ++k) {
                float best = -INFINITY; int bi = -1;
                for (int j = 0; j <= blk_t; ++j) { const float v = row[j]; if (v > best) { best = v; bi = j; } }
                sel[tid * 16 + k] = bi;
                if (bi >= 0) row[bi] = -INFINITY;
            }
        }
        __syncthreads();
        {
            float m = -1e30f, l = 0.f, acc[32];
#pragma unroll
            for (int d = 0; d < 32; ++d) acc[d] = 0.f;
            for (int k = 0; k < TOPN; ++k) {
                const int j = sel[qi * 16 + k];
                if (j >= 0) {
                    for (int i = 0; i < 64; ++i) {
                        const int pos = 64 * j + i;
                        if (pos <= t) {
                            const float s = dot_row64(KS + (size_t)pos * 64, q) - slope * (float)(t - pos);
                            osm_update(s, VS + (size_t)pos * 64, m, l, acc);
                        }
                    }
                }
            }
            const float inv = gs[1] / fmaxf(l, 1e-30f);
#pragma unroll
            for (int d = 0; d < 32; ++d) o[d] += acc[d] * inv;
        }
        {
            float m = -1e30f, l = 0.f, acc[32];
#pragma unroll
            for (int d = 0; d < 32; ++d) acc[d] = 0.f;
            for (int i = 0; i < NSA_WIN; ++i) {
                const int pos = t - (NSA_WIN - 1) + i;
                if (pos >= 0) {
                    const float s = dot_row64(KW + (size_t)pos * 64, q) - slope * (float)(t - pos);
                    osm_update(s, VW + (size_t)pos * 64, m, l, acc);
                }
            }
            const float inv = gs[2] / fmaxf(l, 1e-30f);
#pragma unroll
            for (int d = 0; d < 32; ++d) o[d] += acc[d] * inv;
        }
        bf16_t* O = (bf16_t*)(p.ws + WS_O) + (size_t)(b * T + t) * D + g * 256 + h * 64 + dh * 32;
#pragma unroll
        for (int c = 0; c < 4; ++c) {
            u32x4 w; w.x = pk2(o[8 * c], o[8 * c + 1]); w.y = pk2(o[8 * c + 2], o[8 * c + 3]); w.z = pk2(o[8 * c + 4], o[8 * c + 5]); w.w = pk2(o[8 * c + 6], o[8 * c + 7]);
            *(u32x4*)(O + 8 * c) = w;
        }
        __syncthreads();
    }
}

__device__ __forceinline__ void phase_swa(const Params& p) {
    const unsigned char* ws = p.ws;
    const long gt = (long)blockIdx.x * blockDim.x + threadIdx.x, ngt = (long)gridDim.x * blockDim.x;
    const long items = (long)NTOK * SWA_H * 2;
    for (long it = gt; it < items; it += ngt) {
        const int tt = (int)(it % T); long r = it / T;
        const int dh = (int)(r % 2); r /= 2;
        const int head = (int)(r % SWA_H); const int b = (int)(r / SWA_H);
        const float slope = exp2f(-0.5f * (float)(head + 1));
        float q[64];
        load_row64((const bf16_t*)(ws + WS_QS) + ((size_t)(b * 8 + head) * T + tt) * 64, q);
        const bf16_t* K = (const bf16_t*)(ws + WS_KSW) + (size_t)b * T * 64;
        const bf16_t* V = (const bf16_t*)(ws + WS_VSW) + (size_t)b * T * 64 + dh * 32;
        const float sink = p.sinks[head];
        float m = sink, l = 1.0f, acc[32];
#pragma unroll
        for (int d = 0; d < 32; ++d) acc[d] = 0.f;
        for (int i = 0; i < SWA_WIN; ++i) {
            const int pos = tt - (SWA_WIN - 1) + i;
            if (pos >= 0) {
                const float s = dot_row64(K + (size_t)pos * 64, q) - slope * (float)(tt - pos);
                osm_update(s, V + (size_t)pos * 64, m, l, acc);
            }
        }
        const float inv = 1.0f / l;
        bf16_t* O = (bf16_t*)(p.ws + WS_O) + (size_t)(b * T + tt) * D + 512 + head * 64 + dh * 32;
#pragma unroll
        for (int c = 0; c < 4; ++c) {
            u32x4 w; w.x = pk2(acc[8 * c] * inv, acc[8 * c + 1] * inv); w.y = pk2(acc[8 * c + 2] * inv, acc[8 * c + 3] * inv);
            w.z = pk2(acc[8 * c + 4] * inv, acc[8 * c + 5] * inv); w.w = pk2(acc[8 * c + 6] * inv, acc[8 * c + 7] * inv);
            *(u32x4*)(O + 8 * c) = w;
        }
    }
}

__device__ __forceinline__ void topk_insert(float v, int i, float (&tv)[16], int (&ti)[16]) {
#pragma unroll
    for (int k = 0; k < 16; ++k) {
        const bool sw = v > tv[k];
        const float ov = tv[k]; const int oi = ti[k];
        tv[k] = sw ? v : ov; ti[k] = sw ? i : oi;
        v = sw ? ov : v; i = sw ? oi : i;
    }
}
__device__ __forceinline__ void phase_peer_sub(const Params& p) {
    const unsigned char* ws = p.ws;
    const long gt = (long)blockIdx.x * blockDim.x + threadIdx.x, ngt = (long)gridDim.x * blockDim.x;
    const long items = (long)NTOK * 16;
    for (long it = gt; it < items; it += ngt) {
        const int tok = (int)(it % NTOK), hc = (int)(it / NTOK);
        const bf16_t* qp = (const bf16_t*)(ws + WS_QP) + (size_t)tok * PQ + hc * 128;
        float q0[64], q1[64];
        load_row64(qp, q0); load_row64(qp + 64, q1);
        const bf16_t* keys = (const bf16_t*)(ws + WS_PKEYS) + (size_t)hc * 128 * 128;
        float tv[16]; int ti[16];
#pragma unroll
        for (int k = 0; k < 16; ++k) { tv[k] = -INFINITY; ti[k] = 0; }
        for (int n = 0; n < 128; ++n) {
            const float s = dot_row64(keys + (size_t)n * 128, q0) + dot_row64(keys + (size_t)n * 128 + 64, q1);
            topk_insert(s, n, tv, ti);
        }
        float* ov = (float*)(p.ws + WS_TOPV2) + ((size_t)tok * 16 + hc) * 16;
        int* oi = (int*)(p.ws + WS_TOPI2) + ((size_t)tok * 16 + hc) * 16;
#pragma unroll
        for (int k = 0; k < 16; ++k) { ov[k] = tv[k]; oi[k] = ti[k]; }
    }
}
__device__ __forceinline__ void phase_peer_comb(const Params& p) {
    const long gt = (long)blockIdx.x * blockDim.x + threadIdx.x, ngt = (long)gridDim.x * blockDim.x;
    const long items = (long)NTOK * PH;
    for (long it = gt; it < items; it += ngt) {
        const int tok = (int)(it / PH), h = (int)(it % PH);
        const float* v1 = (const float*)(p.ws + WS_TOPV2) + ((size_t)tok * 16 + h * 2) * 16;
        const float* v2 = v1 + 16;
        const int* i1 = (const int*)(p.ws + WS_TOPI2) + ((size_t)tok * 16 + h * 2) * 16;
        const int* i2 = i1 + 16;
        float s2[16];
#pragma unroll
        for (int k = 0; k < 16; ++k) s2[k] = v2[k];
        float tv[16]; int ti[16];
#pragma unroll
        for (int k = 0; k < 16; ++k) { tv[k] = -INFINITY; ti[k] = 0; }
        for (int a = 0; a < 16; ++a) {
            const float s1 = v1[a];
#pragma unroll
            for (int bb = 0; bb < 16; ++bb) topk_insert(s1 + s2[bb], a * 16 + bb, tv, ti);
        }
        float e[16], sum = 0.f;
#pragma unroll
        for (int k = 0; k < 16; ++k) { e[k] = __expf(tv[k] - tv[0]); sum += e[k]; }
        const float inv = 1.0f / sum;
        int* eo = (int*)(p.ws + WS_EIDX) + (size_t)tok * 128 + h * 16;
        float* go = (float*)(p.ws + WS_GATE) + (size_t)tok * 128 + h * 16;
#pragma unroll
        for (int k = 0; k < 16; ++k) { const int ci = ti[k]; eo[k] = i1[ci >> 4] * PNK + i2[ci & 15]; go[k] = e[k] * inv; }
    }
}

__device__ __forceinline__ void phase_peer_expert(const Params& p) {
    const unsigned char* ws = p.ws;
    const int lane = threadIdx.x & 63;
    const long gw = ((long)blockIdx.x * blockDim.x + threadIdx.x) >> 6, ngw = ((long)gridDim.x * blockDim.x) >> 6;
    const bf16_t* U = (const bf16_t*)(ws + WS_U16); const bf16_t* V = (const bf16_t*)(ws + WS_V16);
    for (long tok = gw; tok < NTOK; tok += ngw) {
        const bf16_t* hg = (const bf16_t*)(ws + WS_H1G) + (size_t)tok * D;
        float a[16];
        {
            const u32x4 w0 = *(const u32x4*)(hg + 8 * lane), w1 = *(const u32x4*)(hg + 512 + 8 * lane);
            a[0] = bflo(w0.x); a[1] = bfhi(w0.x); a[2] = bflo(w0.y); a[3] = bfhi(w0.y); a[4] = bflo(w0.z); a[5] = bfhi(w0.z); a[6] = bflo(w0.w); a[7] = bfhi(w0.w);
            a[8] = bflo(w1.x); a[9] = bfhi(w1.x); a[10] = bflo(w1.y); a[11] = bfhi(w1.y); a[12] = bflo(w1.z); a[13] = bfhi(w1.z); a[14] = bflo(w1.w); a[15] = bfhi(w1.w);
        }
        const float rstd2 = 1.0f / sqrtf(((const float*)(ws + WS_SS2))[tok] * (1.0f / D) + EPS);
        const int* eidx = (const int*)(ws + WS_EIDX) + (size_t)tok * 128;
        const float* gate = (const float*)(ws + WS_GATE) + (size_t)tok * 128;
        float acc[16];
#pragma unroll
        for (int i = 0; i < 16; ++i) acc[i] = 0.f;
        for (int j = 0; j < 128; ++j) {
            const int e = eidx[j]; const float gt_ = gate[j];
            const bf16_t* ur = U + (size_t)e * D; const bf16_t* vr = V + (size_t)e * D;
            const u32x4 u0 = *(const u32x4*)(ur + 8 * lane), u1 = *(const u32x4*)(ur + 512 + 8 * lane);
            const u32x4 v0 = *(const u32x4*)(vr + 8 * lane), v1 = *(const u32x4*)(vr + 512 + 8 * lane);
            float d = a[0] * bflo(u0.x) + a[1] * bfhi(u0.x) + a[2] * bflo(u0.y) + a[3] * bfhi(u0.y) + a[4] * bflo(u0.z) + a[5] * bfhi(u0.z) + a[6] * bflo(u0.w) + a[7] * bfhi(u0.w)
                    + a[8] * bflo(u1.x) + a[9] * bfhi(u1.x) + a[10] * bflo(u1.y) + a[11] * bfhi(u1.y) + a[12] * bflo(u1.z) + a[13] * bfhi(u1.z) + a[14] * bflo(u1.w) + a[15] * bfhi(u1.w);
            d = wave_sum(d);
            const float w = gt_ * gelu_tanh(d * rstd2);
            acc[0] += w * bflo(v0.x); acc[1] += w * bfhi(v0.x); acc[2] += w * bflo(v0.y); acc[3] += w * bfhi(v0.y);
            acc[4] += w * bflo(v0.z); acc[5] += w * bfhi(v0.z); acc[6] += w * bflo(v0.w); acc[7] += w * bfhi(v0.w);
            acc[8] += w * bflo(v1.x); acc[9] += w * bfhi(v1.x); acc[10] += w * bflo(v1.y); acc[11] += w * bfhi(v1.y);
            acc[12] += w * bflo(v1.z); acc[13] += w * bfhi(v1.z); acc[14] += w * bflo(v1.w); acc[15] += w * bfhi(v1.w);
        }
        float* orow = p.out + (size_t)tok * D;
        const f32x4 h0 = *(const f32x4*)(orow + 8 * lane), h1 = *(const f32x4*)(orow + 8 * lane + 4);
        const f32x4 h2 = *(const f32x4*)(orow + 512 + 8 * lane), h3 = *(const f32x4*)(orow + 512 + 8 * lane + 4);
        float y[16] = {h0.x + acc[0], h0.y + acc[1], h0.z + acc[2], h0.w + acc[3], h1.x + acc[4], h1.y + acc[5], h1.z + acc[6], h1.w + acc[7],
                       h2.x + acc[8], h2.y + acc[9], h2.z + acc[10], h2.w + acc[11], h3.x + acc[12], h3.y + acc[13], h3.z + acc[14], h3.w + acc[15]};
        float ss = 0.f;
#pragma unroll
        for (int i = 0; i < 16; ++i) ss += y[i] * y[i];
        const float rstd = 1.0f / sqrtf(wave_sum(ss) * (1.0f / D) + EPS);
        const f32x4 g0 = *(const f32x4*)(p.lnf_g + 8 * lane), g1 = *(const f32x4*)(p.lnf_g + 8 * lane + 4);
        const f32x4 g2 = *(const f32x4*)(p.lnf_g + 512 + 8 * lane), g3 = *(const f32x4*)(p.lnf_g + 512 + 8 * lane + 4);
        *(f32x4*)(orow + 8 * lane) = (f32x4){y[0] * rstd * g0.x, y[1] * rstd * g0.y, y[2] * rstd * g0.z, y[3] * rstd * g0.w};
        *(f32x4*)(orow + 8 * lane + 4) = (f32x4){y[4] * rstd * g1.x, y[5] * rstd * g1.y, y[6] * rstd * g1.z, y[7] * rstd * g1.w};
        *(f32x4*)(orow + 512 + 8 * lane) = (f32x4){y[8] * rstd * g2.x, y[9] * rstd * g2.y, y[10] * rstd * g2.z, y[11] * rstd * g2.w};
        *(f32x4*)(orow + 512 + 8 * lane + 4) = (f32x4){y[12] * rstd * g3.x, y[13] * rstd * g3.y, y[14] * rstd * g3.z, y[15] * rstd * g3.w};
    }
}

constexpr int LDS_BYTES = 64 * 129 * 4 + 64 * 16 * 4 + 1024;
extern __shared__ __attribute__((aligned(16))) unsigned char dyn_lds[];

__global__ void __launch_bounds__(NTHREADS) k_prep(Params p) { phase_prep(p); }
__global__ void __launch_bounds__(NTHREADS) k_proj(Params p) {
    EpiProj E{p.ws};
    gemm_simple((const bf16_t*)(p.ws + WS_XN), (const bf16_t*)(p.ws + WS_WIN), NTOK, DINP, D, E);
}
__global__ void __launch_bounds__(NTHREADS) k_compress(Params p) { phase_compress(p, (float*)dyn_lds); }
__global__ void __launch_bounds__(NTHREADS) k_nsa(Params p) { phase_nsa(p, (float*)dyn_lds); }
__global__ void __launch_bounds__(NTHREADS) k_swa(Params p) { phase_swa(p); }
__global__ void __launch_bounds__(NTHREADS) k_outproj(Params p) {
    EpiOut E{p.x, p.ln2_g, p.out, (bf16_t*)(p.ws + WS_H1G), (float*)(p.ws + WS_SS2)};
    gemm_simple((const bf16_t*)(p.ws + WS_O), (const bf16_t*)(p.ws + WS_WOUT), NTOK, D, D, E);
}
__global__ void __launch_bounds__(NTHREADS) k_qp(Params p) {
    EpiQP E{(const float*)(p.ws + WS_SS2), (bf16_t*)(p.ws + WS_QP)};
    gemm_simple((const bf16_t*)(p.ws + WS_H1G), (const bf16_t*)(p.ws + WS_WQ), NTOK, PQ, D, E);
}
__global__ void __launch_bounds__(NTHREADS) k_peer_sub(Params p) { phase_peer_sub(p); }
__global__ void __launch_bounds__(NTHREADS) k_peer_comb(Params p) { phase_peer_comb(p); }
__global__ void __launch_bounds__(NTHREADS) k_peer_expert(Params p) { phase_peer_expert(p); }

extern "C" void kernel_launch(void* const* d_in, const int* in_sizes, int n_in, void* d_out, int out_size, void* d_ws, size_t ws_size, hipStream_t stream) {
    if (n_in != 17 || ws_size < WS_END) { fprintf(stderr, "kernel_launch: unexpected inputs (n_in %d, ws %zu)\n", n_in, ws_size); return; }
    Params p{};
    p.x = (const float*)d_in[0]; p.ln1_g = (const float*)d_in[1]; p.w_in = (const float*)d_in[2];
    p.pe_k = (const float*)d_in[3]; p.w1_k = (const float*)d_in[4]; p.w2_k = (const float*)d_in[5];
    p.pe_v = (const float*)d_in[6]; p.w1_v = (const float*)d_in[7]; p.w2_v = (const float*)d_in[8];
    p.sinks = (const float*)d_in[9]; p.w_out = (const float*)d_in[10]; p.ln2_g = (const float*)d_in[11];
    p.wq = (const float*)d_in[12]; p.pkeys = (const float*)d_in[13]; p.pu = (const float*)d_in[14]; p.pv = (const float*)d_in[15];
    p.lnf_g = (const float*)d_in[16];
    p.out = (float*)d_out; p.ws = (unsigned char*)d_ws;
    const int G = 1024;
    hipLaunchKernelGGL(k_prep, dim3(G), dim3(NTHREADS), 0, stream, p);
    hipLaunchKernelGGL(k_proj, dim3(G), dim3(NTHREADS), 0, stream, p);
    hipLaunchKernelGGL(k_compress, dim3(G), dim3(NTHREADS), LDS_BYTES, stream, p);
    hipLaunchKernelGGL(k_nsa, dim3(512), dim3(NTHREADS), LDS_BYTES, stream, p);
    hipLaunchKernelGGL(k_swa, dim3(G), dim3(NTHREADS), 0, stream, p);
    hipLaunchKernelGGL(k_outproj, dim3(G), dim3(NTHREADS), 0, stream, p);
    hipLaunchKernelGGL(k_qp, dim3(G), dim3(NTHREADS), 0, stream, p);
    hipLaunchKernelGGL(k_peer_sub, dim3(G), dim3(NTHREADS), 0, stream, p);
    hipLaunchKernelGGL(k_peer_comb, dim3(G), dim3(NTHREADS), 0, stream, p);
    hipLaunchKernelGGL(k_peer_expert, dim3(G), dim3(NTHREADS), 0, stream, p);
}
```

```cpp
#include <hip/hip_runtime.h>
#include <hip/hip_cooperative_groups.h>
#include <cstdint>
#include <cstdio>
namespace cg = cooperative_groups;

typedef unsigned short bf16_t;
typedef short bf16x8 __attribute__((ext_vector_type(8)));
typedef float f32x4 __attribute__((ext_vector_type(4)));
typedef unsigned u32x4 __attribute__((ext_vector_type(4)));
typedef unsigned u32x2 __attribute__((ext_vector_type(2)));

constexpr int BATCH = 2, T = 8192, D = 1024, NTOK = BATCH * T;
constexpr int HD = 64, NSA_H = 8, NSA_G = 2, NSA_HG = 4, SWA_H = 8;
constexpr int DIN = 1944, DINP = 2048;
constexpr int NCMP = 511, NCMPP = 512, NSEL = 128, TOPN = 16;
constexpr int NSA_WIN = 512, SWA_WIN = 128;
constexpr int PH = 8, PNK = 128, PDK = 256, PTOPK = 16, PQ = PH * PDK;
constexpr int NEXP = PNK * PNK;
constexpr float EPS = 1e-6f;
constexpr int NTHREADS = 512;

constexpr size_t MiB = 1u << 20;
constexpr size_t WS_SS2 = 0;
constexpr size_t WS_WIN = 1 * MiB;
constexpr size_t WS_WOUT = 5 * MiB;
constexpr size_t WS_WQ = 7 * MiB;
constexpr size_t WS_PKEYS = 11 * MiB;
constexpr size_t WS_XN = 16 * MiB;
constexpr size_t WS_O = WS_XN;
constexpr size_t WS_QN = 48 * MiB;
constexpr size_t WS_QS = 64 * MiB;
constexpr size_t WS_KV6 = 80 * MiB;
constexpr size_t KV6_STRIDE = 4 * MiB;
constexpr size_t WS_KSW = 104 * MiB;
constexpr size_t WS_VSW = 106 * MiB;
constexpr size_t WS_GSIG = 108 * MiB;
constexpr size_t WS_KC = 110 * MiB;
constexpr size_t WS_VC = 110 * MiB + 512 * 1024;
constexpr size_t WS_H1G = 48 * MiB;
constexpr size_t WS_QP = 80 * MiB;
constexpr size_t WS_EIDX = 144 * MiB;
constexpr size_t WS_GATE = 152 * MiB;
constexpr size_t WS_U16 = 160 * MiB;
constexpr size_t WS_V16 = 192 * MiB;
constexpr size_t WS_TOPV2 = 224 * MiB;
constexpr size_t WS_TOPI2 = 240 * MiB;
constexpr size_t WS_END = 256 * MiB;

struct Params {
    const float* x; const float* ln1_g; const float* w_in;
    const float* pe_k; const float* w1_k; const float* w2_k;
    const float* pe_v; const float* w1_v; const float* w2_v;
    const float* sinks; const float* w_out; const float* ln2_g;
    const float* wq; const float* pkeys; const float* pu; const float* pv; const float* lnf_g;
    float* out; unsigned char* ws;
};

__device__ __forceinline__ unsigned f2bf(float f) { unsigned u = __float_as_uint(f); return (u + 0x7fffu + ((u >> 16) & 1u)) >> 16; }
__device__ __forceinline__ float bf2f(unsigned h) { return __uint_as_float(h << 16); }
__device__ __forceinline__ float bflo(unsigned w) { return __uint_as_float(w << 16); }
__device__ __forceinline__ float bfhi(unsigned w) { return __uint_as_float(w & 0xffff0000u); }
__device__ __forceinline__ unsigned pk2(float lo, float hi) { return f2bf(lo) | (f2bf(hi) << 16); }
__device__ __forceinline__ float wave_sum(float v) {
#pragma unroll
    for (int o = 1; o < 64; o <<= 1) v += __shfl_xor(v, o);
    return v;
}
__device__ __forceinline__ float gelu_tanh(float x) {
    const float u = 0.7978845608028654f * (x + 0.044715f * x * x * x);
    return 0.5f * x * (1.0f + tanhf(u));
}
__device__ __forceinline__ int win_orig_col(int n) {
    if (n < 1280) return n;
    if (n < 1792) return 1304 + (n - 1280);
    if (n < 1856) return 1816 + (n - 1792);
    if (n < 1920) return 1880 + (n - 1856);
    if (n < 1944) return 1280 + (n - 1920);
    return -1;
}

template <bool WIN_MAP>
__device__ __forceinline__ void prep_transpose(const float* W, int K, int N, int NP, bf16_t* WT, long gt, long ngt) {
    const long items = (long)NP * (K / 8);
    for (long it = gt; it < items; it += ngt) {
        const int n = (int)(it % NP), k0 = (int)(it / NP) * 8;
        const int col = WIN_MAP ? win_orig_col(n) : n;
        float v[8];
#pragma unroll
        for (int i = 0; i < 8; ++i) v[i] = (col >= 0) ? W[(size_t)(k0 + i) * N + col] : 0.f;
        u32x4 o; o.x = pk2(v[0], v[1]); o.y = pk2(v[2], v[3]); o.z = pk2(v[4], v[5]); o.w = pk2(v[6], v[7]);
        *(u32x4*)(WT + (size_t)n * K + k0) = o;
    }
}
__device__ __forceinline__ void prep_convert(const float* src, bf16_t* dst, long n8, long gt, long ngt) {
    for (long it = gt; it < n8; it += ngt) {
        const f32x4 a = *(const f32x4*)(src + it * 8), b = *(const f32x4*)(src + it * 8 + 4);
        u32x4 o; o.x = pk2(a.x, a.y); o.y = pk2(a.z, a.w); o.z = pk2(b.x, b.y); o.w = pk2(b.z, b.w);
        *(u32x4*)(dst + it * 8) = o;
    }
}
__device__ __forceinline__ void phase_prep(const Params& p) {
    const long gt = (long)blockIdx.x * blockDim.x + threadIdx.x, ngt = (long)gridDim.x * blockDim.x;
    const int lane = threadIdx.x & 63;
    const long gw = gt >> 6, ngw = ngt >> 6;
    unsigned char* ws = p.ws;
    for (long m = gw; m < NTOK; m += ngw) {
        const f32x4* xr = (const f32x4*)(p.x + (size_t)m * D) + lane;
        f32x4 v[4]; float s = 0.f;
#pragma unroll
        for (int j = 0; j < 4; ++j) { v[j] = xr[64 * j]; s += (v[j].x * v[j].x + v[j].y * v[j].y) + (v[j].z * v[j].z + v[j].w * v[j].w); }
        const float rstd = 1.0f / sqrtf(wave_sum(s) * (1.0f / D) + EPS);
        u32x2* o = (u32x2*)((bf16_t*)(ws + WS_XN) + (size_t)m * D) + lane;
#pragma unroll
        for (int j = 0; j < 4; ++j) {
            const f32x4 g = *((const f32x4*)p.ln1_g + lane + 64 * j);
            u32x2 w; w.x = pk2(v[j].x * rstd * g.x, v[j].y * rstd * g.y); w.y = pk2(v[j].z * rstd * g.z, v[j].w * rstd * g.w);
            o[64 * j] = w;
        }
    }
    prep_transpose<true>(p.w_in, D, DIN, DINP, (bf16_t*)(ws + WS_WIN), gt, ngt);
    prep_transpose<false>(p.w_out, D, D, D, (bf16_t*)(ws + WS_WOUT), gt, ngt);
    prep_transpose<false>(p.wq, D, PQ, PQ, (bf16_t*)(ws + WS_WQ), gt, ngt);
    prep_convert(p.pkeys, (bf16_t*)(ws + WS_PKEYS), (long)16 * 128 * 128 / 8, gt, ngt);
    prep_convert(p.pu, (bf16_t*)(ws + WS_U16), (long)NEXP * D / 8, gt, ngt);
    prep_convert(p.pv, (bf16_t*)(ws + WS_V16), (long)NEXP * D / 8, gt, ngt);
    for (long i = gt; i < NTOK; i += ngt) ((float*)(ws + WS_SS2))[i] = 0.f;
}

template <class Epi>
__device__ __forceinline__ void gemm_simple(const bf16_t* A, const bf16_t* Bt, int M, int N, int K, const Epi& E) {
    const int lane = threadIdx.x & 63;
    const long gw = ((long)blockIdx.x * blockDim.x + threadIdx.x) >> 6, ngw = ((long)gridDim.x * blockDim.x) >> 6;
    const int ntn = N / 64; const long ntiles = (long)(M / 32) * ntn;
    const int fr = lane & 15, fq = lane >> 4;
    for (long tile = gw; tile < ntiles; tile += ngw) {
        const int m0 = (int)(tile / ntn) * 32, n0 = (int)(tile % ntn) * 64;
        f32x4 acc[2][4];
#pragma unroll
        for (int i = 0; i < 2; ++i)
#pragma unroll
            for (int j = 0; j < 4; ++j) acc[i][j] = (f32x4){0.f, 0.f, 0.f, 0.f};
        const bf16_t* ap = A + (size_t)(m0 + fr) * K + fq * 8;
        const bf16_t* bp = Bt + (size_t)(n0 + fr) * K + fq * 8;
        for (int k0 = 0; k0 < K; k0 += 32) {
            bf16x8 a[2], b[4];
#pragma unroll
            for (int i = 0; i < 2; ++i) a[i] = *(const bf16x8*)(ap + (size_t)i * 16 * K + k0);
#pragma unroll
            for (int j = 0; j < 4; ++j) b[j] = *(const bf16x8*)(bp + (size_t)j * 16 * K + k0);
#pragma unroll
            for (int i = 0; i < 2; ++i)
#pragma unroll
                for (int j = 0; j < 4; ++j) acc[i][j] = __builtin_amdgcn_mfma_f32_16x16x32_bf16(a[i], b[j], acc[i][j], 0, 0, 0);
        }
        E(acc, m0, n0, fr, fq);
    }
}

struct EpiProj {
    unsigned char* ws;
    __device__ __forceinline__ void operator()(const f32x4 (&acc)[2][4], int m0, int n0, int fr, int fq) const {
#pragma unroll
        for (int i = 0; i < 2; ++i)
#pragma unroll
            for (int j = 0; j < 4; ++j)
#pragma unroll
                for (int r = 0; r < 4; ++r) {
                    const int row = m0 + 16 * i + fq * 4 + r, n = n0 + 16 * j + fr;
                    const float v = acc[i][j][r];
                    const int b = row / T, t = row % T, d = n & 63;
                    if (n < 512) {
                        const int head = n >> 6;
                        ((bf16_t*)(ws + WS_QN))[((size_t)(b * 8 + head) * T + t) * 64 + d] = (bf16_t)f2bf(v * 0.125f);
                    } else if (n < 1280) {
                        const int arr = (n - 512) >> 7, g = ((n - 512) >> 6) & 1;
                        ((bf16_t*)(ws + WS_KV6 + arr * KV6_STRIDE))[((size_t)(b * 2 + g) * T + t) * 64 + d] = (bf16_t)f2bf(v);
                    } else if (n < 1792) {
                        const int head = (n - 1280) >> 6;
                        ((bf16_t*)(ws + WS_QS))[((size_t)(b * 8 + head) * T + t) * 64 + d] = (bf16_t)f2bf(v * 0.125f);
                    } else if (n < 1856) {
                        ((bf16_t*)(ws + WS_KSW))[((size_t)b * T + t) * 64 + d] = (bf16_t)f2bf(v);
                    } else if (n < 1920) {
                        ((bf16_t*)(ws + WS_VSW))[((size_t)b * T + t) * 64 + d] = (bf16_t)f2bf(v);
                    } else if (n < 1944) {
                        ((float*)(ws + WS_GSIG))[(size_t)row * 24 + (n - 1920)] = 1.0f / (1.0f + expf(-v));
                    }
                }
    }
};
struct EpiOut {
    const float* x; const float* g2; float* h1; bf16_t* h1g; float* ss2;
    __device__ __forceinline__ void operator()(const f32x4 (&acc)[2][4], int m0, int n0, int fr, int fq) const {
#pragma unroll
        for (int i = 0; i < 2; ++i)
#pragma unroll
            for (int r = 0; r < 4; ++r) {
                const int row = m0 + 16 * i + fq * 4 + r; float ss = 0.f;
#pragma unroll
                for (int j = 0; j < 4; ++j) {
                    const int n = n0 + 16 * j + fr; const size_t off = (size_t)row * D + n;
                    const float h = x[off] + acc[i][j][r];
                    h1[off] = h; h1g[off] = (bf16_t)f2bf(h * g2[n]); ss += h * h;
                }
                ss += __shfl_xor(ss, 1); ss += __shfl_xor(ss, 2); ss += __shfl_xor(ss, 4); ss += __shfl_xor(ss, 8);
                if (fr == 0) atomicAdd(ss2 + row, ss);
            }
    }
};
struct EpiQP {
    const float* ss2; bf16_t* qp;
    __device__ __forceinline__ void operator()(const f32x4 (&acc)[2][4], int m0, int n0, int fr, int fq) const {
#pragma unroll
        for (int i = 0; i < 2; ++i)
#pragma unroll
            for (int r = 0; r < 4; ++r) {
                const int row = m0 + 16 * i + fq * 4 + r;
                const float rstd = 1.0f / sqrtf(ss2[row] * (1.0f / D) + EPS);
#pragma unroll
                for (int j = 0; j < 4; ++j) qp[(size_t)row * PQ + n0 + 16 * j + fr] = (bf16_t)f2bf(acc[i][j][r] * rstd);
            }
    }
};

__device__ __forceinline__ void phase_compress(const Params& p, float* lds) {
    float* flat = lds;
    float* part = lds + 2048;
    float* hid = lds + 2560;
    const int tid = threadIdx.x;
    const int nunits = 2 * BATCH * NCMP * NSA_G;
    for (int u = blockIdx.x; u < nunits; u += gridDim.x) {
        const int kv = u / (BATCH * NCMP * NSA_G); int r = u % (BATCH * NCMP * NSA_G);
        const int b = r / (NCMP * NSA_G); r %= (NCMP * NSA_G);
        const int c = r / NSA_G, g = r % NSA_G;
        const bf16_t* raw = (const bf16_t*)(p.ws + WS_KV6 + (size_t)kv * KV6_STRIDE) + ((size_t)(b * 2 + g) * T + 16 * c) * 64;
        const float* pe = kv ? p.pe_v : p.pe_k; const float* w1 = kv ? p.w1_v : p.w1_k; const float* w2 = kv ? p.w2_v : p.w2_k;
        for (int i = tid; i < 2048; i += blockDim.x) flat[i] = bf2f(raw[i]) + pe[i];
        __syncthreads();
        {
            const int j = tid & 255, half = tid >> 8;
            float a = 0.f;
            const float* wp = w1 + (size_t)(half * 1024) * 256 + j; const float* fp = flat + half * 1024;
            for (int i = 0; i < 1024; ++i) a += fp[i] * wp[(size_t)i * 256];
            part[tid] = a;
        }
        __syncthreads();
        if (tid < 256) hid[tid] = gelu_tanh(part[tid] + part[tid + 256]);
        __syncthreads();
        if (tid < 64) {
            float a = 0.f;
            for (int j = 0; j < 256; ++j) a += hid[j] * w2[j * 64 + tid];
            bf16_t* dst = (bf16_t*)(p.ws + (kv ? WS_VC : WS_KC)) + ((size_t)(b * 2 + g) * NCMPP + c) * 64;
            dst[tid] = (bf16_t)f2bf(a);
        }
        __syncthreads();
    }
}

__device__ __forceinline__ void load_row64(const bf16_t* src, float (&k)[64]) {
#pragma unroll
    for (int c = 0; c < 8; ++c) {
        const u32x4 w = *(const u32x4*)(src + 8 * c);
        k[8 * c + 0] = bflo(w.x); k[8 * c + 1] = bfhi(w.x); k[8 * c + 2] = bflo(w.y); k[8 * c + 3] = bfhi(w.y);
        k[8 * c + 4] = bflo(w.z); k[8 * c + 5] = bfhi(w.z); k[8 * c + 6] = bflo(w.w); k[8 * c + 7] = bfhi(w.w);
    }
}
__device__ __forceinline__ float dot_row64(const bf16_t* src, const float (&q)[64]) {
    float s0 = 0.f, s1 = 0.f;
#pragma unroll
    for (int c = 0; c < 8; ++c) {
        const u32x4 w = *(const u32x4*)(src + 8 * c);
        s0 += q[8 * c + 0] * bflo(w.x); s1 += q[8 * c + 1] * bfhi(w.x); s0 += q[8 * c + 2] * bflo(w.y); s1 += q[8 * c + 3] * bfhi(w.y);
        s0 += q[8 * c + 4] * bflo(w.z); s1 += q[8 * c + 5] * bfhi(w.z); s0 += q[8 * c + 6] * bflo(w.w); s1 += q[8 * c + 7] * bfhi(w.w);
    }
    return s0 + s1;
}
__device__ __forceinline__ void osm_update(float s, const bf16_t* vsrc, float& m, float& l, float (&acc)[32]) {
    const float mn = fmaxf(m, s), alpha = __expf(m - mn), pr = __expf(s - mn);
    l = l * alpha + pr; m = mn;
#pragma unroll
    for (int c = 0; c < 4; ++c) {
        const u32x4 w = *(const u32x4*)(vsrc + 8 * c);
        acc[8 * c + 0] = acc[8 * c + 0] * alpha + pr * bflo(w.x); acc[8 * c + 1] = acc[8 * c + 1] * alpha + pr * bfhi(w.x);
        acc[8 * c + 2] = acc[8 * c + 2] * alpha + pr * bflo(w.y); acc[8 * c + 3] = acc[8 * c + 3] * alpha + pr * bfhi(w.y);
        acc[8 * c + 4] = acc[8 * c + 4] * alpha + pr * bflo(w.z); acc[8 * c + 5] = acc[8 * c + 5] * alpha + pr * bfhi(w.z);
        acc[8 * c + 6] = acc[8 * c + 6] * alpha + pr * bflo(w.w); acc[8 * c + 7] = acc[8 * c + 7] * alpha + pr * bfhi(w.w);
    }
}

__device__ __forceinline__ void phase_nsa(const Params& p, float* lds) {
    float* imp = lds;
    int* sel = (int*)(lds + 64 * 129);
    const int tid = threadIdx.x, qi = tid & 63, h = (tid >> 6) & 3, dh = tid >> 8;
    const unsigned char* ws = p.ws;
    const int nunits = BATCH * NSA_G * (T / 64);
    for (int u = blockIdx.x; u < nunits; u += gridDim.x) {
        const int b = u / (NSA_G * (T / 64)), g = (u / (T / 64)) % NSA_G, tile = u % (T / 64);
        const int t = tile * 64 + qi, head = g * 4 + h;
        const float slope = exp2f(-0.5f * (float)(9 + head));
        float q[64];
        load_row64((const bf16_t*)(ws + WS_QN) + ((size_t)(b * 8 + head) * T + t) * 64, q);
        const bf16_t* KC = (const bf16_t*)(ws + WS_KC) + (size_t)(b * 2 + g) * NCMPP * 64;
        const bf16_t* VC = (const bf16_t*)(ws + WS_VC) + (size_t)(b * 2 + g) * NCMPP * 64 + dh * 32;
        const bf16_t* KS = (const bf16_t*)(ws + WS_KV6 + 2 * KV6_STRIDE) + (size_t)(b * 2 + g) * T * 64;
        const bf16_t* VS = (const bf16_t*)(ws + WS_KV6 + 3 * KV6_STRIDE) + (size_t)(b * 2 + g) * T * 64 + dh * 32;
        const bf16_t* KW = (const bf16_t*)(ws + WS_KV6 + 4 * KV6_STRIDE) + (size_t)(b * 2 + g) * T * 64;
        const bf16_t* VW = (const bf16_t*)(ws + WS_KV6 + 5 * KV6_STRIDE) + (size_t)(b * 2 + g) * T * 64 + dh * 32;
        const float* gs = (const float*)(ws + WS_GSIG) + (size_t)(b * T + t) * 24 + head * 3;
        float o[32];
#pragma unroll
        for (int d = 0; d < 32; ++d) o[d] = 0.f;
        for (int i = tid; i < 64 * 129; i += blockDim.x) imp[i] = 0.f;
        __syncthreads();
        const int nc = 4 * tile + 3;
        float mc = -1e30f, lc = 0.f;
        {
            float acc[32];
#pragma unroll
            for (int d = 0; d < 32; ++d) acc[d] = 0.f;
            for (int c = 0; c < nc; ++c) {
                const int dist = t - (16 * c + 31);
                if (dist >= 0) {
                    const float s = dot_row64(KC + (size_t)c * 64, q) - slope * (float)dist;
                    osm_update(s, VC + (size_t)c * 64, mc, lc, acc);
                }
            }
            const float inv = gs[0] / fmaxf(lc, 1e-30f);
#pragma unroll
            for (int d = 0; d < 32; ++d) o[d] += acc[d] * inv;
        }
        if (dh == 0) {
            const float invl = 1.0f / fmaxf(lc, 1e-30f);
            for (int c = 0; c < nc; ++c) {
                const int dist = t - (16 * c + 31);
                if (dist >= 0) {
                    const float s = dot_row64(KC + (size_t)c * 64, q) - slope * (float)dist;
                    const float pr = __expf(s - mc) * invl;
                    const int sb = c >> 2;
                    atomicAdd(&imp[qi * 129 + sb], pr);
                    if ((c & 3) == 3 && sb + 1 < NSEL) atomicAdd(&imp[qi * 129 + sb + 1], pr);
                }
            }
        }
        __syncthreads();
        if (tid < 64) {
            const int blk_t = tile;
            float* row = imp + tid * 129;
            for (int j = 0; j <= blk_t; ++j) if (j == 0 || j == blk_t || j == blk_t - 1) row[j] = 1.0e4f;
            for (int k = 0; k < TOPN; ++k) {
                float best = -INFINITY; int bi = -1;
                for (int j = 0; j <= blk_t; ++j) { const float v = row[j]; if (v > best) { best = v; bi = j; } }
                sel[tid * 16 + k] = bi;
                if (bi >= 0) row[bi] = -INFINITY;
            }
        }
        __syncthreads();
        {
            float m = -1e30f, l = 0.f, acc[32];
#pragma unroll
            for (int d = 0; d < 32; ++d) acc[d] = 0.f;
            for (int k = 0; k < TOPN; ++k) {
                const int j = sel[qi * 16 + k];
                if (j >= 0) {
                    for (int i = 0; i < 64; ++i) {
                        const int pos = 64 * j + i;
                        if (pos <= t) {
                            const float s = dot_row64(KS + (size_t)pos * 64, q) - slope * (float)(t - pos);
                            osm_update(s, VS + (size_t)pos * 64, m, l, acc);
                        }
                    }
                }
            }
            const float inv = gs[1] / fmaxf(l, 1e-30f);
#pragma unroll
            for (int d = 0; d < 32; ++d) o[d] += acc[d] * inv;
        }
        {
            float m = -1e30f, l = 0.f, acc[32];
#pragma unroll
            for (int d = 0; d < 32; ++d) acc[d] = 0.f;
            for (int i = 0; i < NSA_WIN; ++i) {
                const int pos = t - (NSA_WIN - 1) + i;
                if (pos >= 0) {
                    const float s = dot_row64(KW + (size_t)pos * 64, q) - slope * (float)(t - pos);
                    osm_update(s, VW + (size_t)pos * 64, m, l, acc);
                }
            }
            const float inv = gs[2] / fmaxf(l, 1e-30f);
#pragma unroll
            for (int d = 0; d < 32; ++d) o[d] += acc[d] * inv;
        }
        bf16_t* O = (bf16_t*)(p.ws + WS_O) + (size_t)(b * T + t) * D + g * 256 + h * 64 + dh * 32;
#pragma unroll
        for (int c = 0; c < 4; ++c) {
            u32x4 w; w.x = pk2(o[8 * c], o[8 * c + 1]); w.y = pk2(o[8 * c + 2], o[8 * c + 3]); w.z = pk2(o[8 * c + 4], o[8 * c + 5]); w.w = pk2(o[8 * c + 6], o[8 * c + 7]);
            *(u32x4*)(O + 8 * c) = w;
        }
        __syncthreads();
    }
}

__device__ __forceinline__ void phase_swa(const Params& p) {
    const unsigned char* ws = p.ws;
    const long gt = (long)blockIdx.x * blockDim.x + threadIdx.x, ngt = (long)gridDim.x * blockDim.x;
    const long items = (long)NTOK * SWA_H * 2;
    for (long it = gt; it < items; it += ngt) {
        const int tt = (int)(it % T); long r = it / T;
        const int dh = (int)(r % 2); r /= 2;
        const int head = (int)(r % SWA_H); const int b = (int)(r / SWA_H);
        const float slope = exp2f(-0.5f * (float)(head + 1));
        float q[64];
        load_row64((const bf16_t*)(ws + WS_QS) + ((size_t)(b * 8 + head) * T + tt) * 64, q);
        const bf16_t* K = (const bf16_t*)(ws + WS_KSW) + (size_t)b * T * 64;
        const bf16_t* V = (const bf16_t*)(ws + WS_VSW) + (size_t)b * T * 64 + dh * 32;
        const float sink = p.sinks[head];
        float m = sink, l = 1.0f, acc[32];
#pragma unroll
        for (int d = 0; d < 32; ++d) acc[d] = 0.f;
        for (int i = 0; i < SWA_WIN; ++i) {
            const int pos = tt - (SWA_WIN - 1) + i;
            if (pos >= 0) {
                const float s = dot_row64(K + (size_t)pos * 64, q) - slope * (float)(tt - pos);
                osm_update(s, V + (size_t)pos * 64, m, l, acc);
            }
        }
        const float inv = 1.0f / l;
        bf16_t* O = (bf16_t*)(p.ws + WS_O) + (size_t)(b * T + tt) * D + 512 + head * 64 + dh * 32;
#pragma unroll
        for (int c = 0; c < 4; ++c) {
            u32x4 w; w.x = pk2(acc[8 * c] * inv, acc[8 * c + 1] * inv); w.y = pk2(acc[8 * c + 2] * inv, acc[8 * c + 3] * inv);
            w.z = pk2(acc[8 * c + 4] * inv, acc[8 * c + 5] * inv); w.w = pk2(acc[8 * c + 6] * inv, acc[8 * c + 7] * inv);
            *(u32x4*)(O + 8 * c) = w;
        }
    }
}

__device__ __forceinline__ void topk_insert(float v, int i, float (&tv)[16], int (&ti)[16]) {
#pragma unroll
    for (int k = 0; k < 16; ++k) {
        const bool sw = v > tv[k];
        const float ov = tv[k]; const int oi = ti[k];
        tv[k] = sw ? v : ov; ti[k] = sw ? i : oi;
        v = sw ? ov : v; i = sw ? oi : i;
    }
}
__device__ __forceinline__ void phase_peer_sub(const Params& p) {
    const unsigned char* ws = p.ws;
    const long gt = (long)blockIdx.x * blockDim.x + threadIdx.x, ngt = (long)gridDim.x * blockDim.x;
    const long items = (long)NTOK * 16;
    for (long it = gt; it < items; it += ngt) {
        const int tok = (int)(it % NTOK), hc = (int)(it / NTOK);
        const bf16_t* qp = (const bf16_t*)(ws + WS_QP) + (size_t)tok * PQ + hc * 128;
        float q0[64], q1[64];
        load_row64(qp, q0); load_row64(qp + 64, q1);
        const bf16_t* keys = (const bf16_t*)(ws + WS_PKEYS) + (size_t)hc * 128 * 128;
        float tv[16]; int ti[16];
#pragma unroll
        for (int k = 0; k < 16; ++k) { tv[k] = -INFINITY; ti[k] = 0; }
        for (int n = 0; n < 128; ++n) {
            const float s = dot_row64(keys + (size_t)n * 128, q0) + dot_row64(keys + (size_t)n * 128 + 64, q1);
            topk_insert(s, n, tv, ti);
        }
        float* ov = (float*)(p.ws + WS_TOPV2) + ((size_t)tok * 16 + hc) * 16;
        int* oi = (int*)(p.ws + WS_TOPI2) + ((size_t)tok * 16 + hc) * 16;
#pragma unroll
        for (int k = 0; k < 16; ++k) { ov[k] = tv[k]; oi[k] = ti[k]; }
    }
}
__device__ __forceinline__ void phase_peer_comb(const Params& p) {
    const long gt = (long)blockIdx.x * blockDim.x + threadIdx.x, ngt = (long)gridDim.x * blockDim.x;
    const long items = (long)NTOK * PH;
    for (long it = gt; it < items; it += ngt) {
        const int tok = (int)(it / PH), h = (int)(it % PH);
        const float* v1 = (const float*)(p.ws + WS_TOPV2) + ((size_t)tok * 16 + h * 2) * 16;
        const float* v2 = v1 + 16;
        const int* i1 = (const int*)(p.ws + WS_TOPI2) + ((size_t)tok * 16 + h * 2) * 16;
        const int* i2 = i1 + 16;
        float s2[16];
#pragma unroll
        for (int k = 0; k < 16; ++k) s2[k] = v2[k];
        float tv[16]; int ti[16];
#pragma unroll
        for (int k = 0; k < 16; ++k) { tv[k] = -INFINITY; ti[k] = 0; }
        for (int a = 0; a < 16; ++a) {
            const float s1 = v1[a];
#pragma unroll
            for (int bb = 0; bb < 16; ++bb) topk_insert(s1 + s2[bb], a * 16 + bb, tv, ti);
        }
        float e[16], sum = 0.f;
#pragma unroll
        for (int k = 0; k < 16; ++k) { e[k] = __expf(tv[k] - tv[0]); sum += e[k]; }
        const float inv = 1.0f / sum;
        int* eo = (int*)(p.ws + WS_EIDX) + (size_t)tok * 128 + h * 16;
        float* go = (float*)(p.ws + WS_GATE) + (size_t)tok * 128 + h * 16;
#pragma unroll
        for (int k = 0; k < 16; ++k) { const int ci = ti[k]; eo[k] = i1[ci >> 4] * PNK + i2[ci & 15]; go[k] = e[k] * inv; }
    }
}

__device__ __forceinline__ void phase_peer_expert(const Params& p) {
    const unsigned char* ws = p.ws;
    const int lane = threadIdx.x & 63;
    const long gw = ((long)blockIdx.x * blockDim.x + threadIdx.x) >> 6, ngw = ((long)gridDim.x * blockDim.x) >> 6;
    const bf16_t* U = (const bf16_t*)(ws + WS_U16); const bf16_t* V = (const bf16_t*)(ws + WS_V16);
    for (long tok = gw; tok < NTOK; tok += ngw) {
        const bf16_t* hg = (const bf16_t*)(ws + WS_H1G) + (size_t)tok * D;
        float a[16];
        {
            const u32x4 w0 = *(const u32x4*)(hg + 8 * lane), w1 = *(const u32x4*)(hg + 512 + 8 * lane);
            a[0] = bflo(w0.x); a[1] = bfhi(w0.x); a[2] = bflo(w0.y); a[3] = bfhi(w0.y); a[4] = bflo(w0.z); a[5] = bfhi(w0.z); a[6] = bflo(w0.w); a[7] = bfhi(w0.w);
            a[8] = bflo(w1.x); a[9] = bfhi(w1.x); a[10] = bflo(w1.y); a[11] = bfhi(w1.y); a[12] = bflo(w1.z); a[13] = bfhi(w1.z); a[14] = bflo(w1.w); a[15] = bfhi(w1.w);
        }
        const float rstd2 = 1.0f / sqrtf(((const float*)(ws + WS_SS2))[tok] * (1.0f / D) + EPS);
        const int* eidx = (const int*)(ws + WS_EIDX) + (size_t)tok * 128;
        const float* gate = (const float*)(ws + WS_GATE) + (size_t)tok * 128;
        float acc[16];
#pragma unroll
        for (int i = 0; i < 16; ++i) acc[i] = 0.f;
        for (int j = 0; j < 128; ++j) {
            const int e = eidx[j]; const float gt_ = gate[j];
            const bf16_t* ur = U + (size_t)e * D; const bf16_t* vr = V + (size_t)e * D;
            const u32x4 u0 = *(const u32x4*)(ur + 8 * lane), u1 = *(const u32x4*)(ur + 512 + 8 * lane);
            const u32x4 v0 = *(const u32x4*)(vr + 8 * lane), v1 = *(const u32x4*)(vr + 512 + 8 * lane);
            float d = a[0] * bflo(u0.x) + a[1] * bfhi(u0.x) + a[2] * bflo(u0.y) + a[3] * bfhi(u0.y) + a[4] * bflo(u0.z) + a[5] * bfhi(u0.z) + a[6] * bflo(u0.w) + a[7] * bfhi(u0.w)
                    + a[8] * bflo(u1.x) + a[9] * bfhi(u1.x) + a[10] * bflo(u1.y) + a[11] * bfhi(u1.y) + a[12] * bflo(u1.z) + a[13] * bfhi(u1.z) + a[14] * bflo(u1.w) + a[15] * bfhi(u1.w);
            d = wave_sum(d);
            const float w = gt_ * gelu_tanh(d * rstd2);
            acc[0] += w * bflo(v0.x); acc[1] += w * bfhi(v0.x); acc[2] += w * bflo(v0.y); acc[3] += w * bfhi(v0.y);
            acc[4] += w * bflo(v0.z); acc[5] += w * bfhi(v0.z); acc[6] += w * bflo(v0.w); acc[7] += w * bfhi(v0.w);
            acc[8] += w * bflo(v1.x); acc[9] += w * bfhi(v1.x); acc[10] += w * bflo(v1.y); acc[11] += w * bfhi(v1.y);
            acc[12] += w * bflo(v1.z); acc[13] += w * bfhi(v1.z); acc[14] += w * bflo(v1.w); acc[15] += w * bfhi(v1.w);
        }
        float* orow = p.out + (size_t)tok * D;
        const f32x4 h0 = *(const f32x4*)(orow + 8 * lane), h1 = *(const f32x4*)(orow + 8 * lane + 4);
        const f32x4 h2 = *(const f32x4*)(orow + 512 + 8 * lane), h3 = *(const f32x4*)(orow + 512 + 8 * lane + 4);
        float y[16] = {h0.x + acc[0], h0.y + acc[1], h0.z + acc[2], h0.w + acc[3], h1.x + acc[4], h1.y + acc[5], h1.z + acc[6], h1.w + acc[7],
                       h2.x + acc[8], h2.y + acc[9], h2.z + acc[10], h2.w + acc[11], h3.x + acc[12], h3.y + acc[13], h3.z + acc[14], h3.w + acc[15]};
        float ss = 0.f;
#pragma unroll
        for (int i = 0; i < 16; ++i) ss += y[i] * y[i];
        const float rstd = 1.0f / sqrtf(wave_sum(ss) * (1.0f / D) + EPS);
        const f32x4 g0 = *(const f32x4*)(p.lnf_g + 8 * lane), g1 = *(const f32x4*)(p.lnf_g + 8 * lane + 4);
        const f32x4 g2 = *(const f32x4*)(p.lnf_g + 512 + 8 * lane), g3 = *(const f32x4*)(p.lnf_g + 512 + 8 * lane + 4);
        *(f32x4*)(orow + 8 * lane) = (f32x4){y[0] * rstd * g0.x, y[1] * rstd * g0.y, y[2] * rstd * g0.z, y[3] * rstd * g0.w};
        *(f32x4*)(orow + 8 * lane + 4) = (f32x4){y[4] * rstd * g1.x, y[5] * rstd * g1.y, y[6] * rstd * g1.z, y[7] * rstd * g1.w};
        *(f32x4*)(orow + 512 + 8 * lane) = (f32x4){y[8] * rstd * g2.x, y[9] * rstd * g2.y, y[10] * rstd * g2.z, y[11] * rstd * g2.w};
        *(f32x4*)(orow + 512 + 8 * lane + 4) = (f32x4){y[12] * rstd * g3.x, y[13] * rstd * g3.y, y[14] * rstd * g3.z, y[15] * rstd * g3.w};
    }
}

constexpr int LDS_BYTES = 64 * 129 * 4 + 64 * 16 * 4 + 1024;
extern __shared__ __attribute__((aligned(16))) unsigned char dyn_lds[];

__global__ void __launch_bounds__(NTHREADS) fwd_megakernel(Params p) {
    cg::grid_group grid = cg::this_grid();
    float* lds = (float*)dyn_lds;
    phase_prep(p);
    grid.sync();
    { EpiProj E{p.ws}; gemm_simple((const bf16_t*)(p.ws + WS_XN), (const bf16_t*)(p.ws + WS_WIN), NTOK, DINP, D, E); }
    grid.sync();
    phase_compress(p, lds);
    phase_swa(p);
    grid.sync();
    phase_nsa(p, lds);
    grid.sync();
    { EpiOut E{p.x, p.ln2_g, p.out, (bf16_t*)(p.ws + WS_H1G), (float*)(p.ws + WS_SS2)};
      gemm_simple((const bf16_t*)(p.ws + WS_O), (const bf16_t*)(p.ws + WS_WOUT), NTOK, D, D, E); }
    grid.sync();
    { EpiQP E{(const float*)(p.ws + WS_SS2), (bf16_t*)(p.ws + WS_QP)};
      gemm_simple((const bf16_t*)(p.ws + WS_H1G), (const bf16_t*)(p.ws + WS_WQ), NTOK, PQ, D, E); }
    grid.sync();
    phase_peer_sub(p);
    grid.sync();
    phase_peer_comb(p);
    grid.sync();
    phase_peer_expert(p);
}

extern "C" void kernel_launch(void* const* d_in, const int* in_sizes, int n_in, void* d_out, int out_size, void* d_ws, size_t ws_size, hipStream_t stream) {
    if (n_in != 17 || ws_size < WS_END) { fprintf(stderr, "kernel_launch: unexpected inputs (n_in %d, ws %zu)\n", n_in, ws_size); return; }
    static int grid_blocks = 0;
    if (!grid_blocks) {
        int dev = 0, cus = 0, per_cu = 0;
        (void)hipGetDevice(&dev);
        (void)hipDeviceGetAttribute(&cus, hipDeviceAttributeMultiprocessorCount, dev);
        (void)hipFuncSetAttribute((const void*)fwd_megakernel, hipFuncAttributeMaxDynamicSharedMemorySize, LDS_BYTES);
        (void)hipOccupancyMaxActiveBlocksPerMultiprocessor(&per_cu, (const void*)fwd_megakernel, NTHREADS, LDS_BYTES);
        if (per_cu < 1) per_cu = 1;
        grid_blocks = cus * per_cu;
        fprintf(stderr, "kernel_launch: %d CUs x %d blocks/CU\n", cus, per_cu);
    }
    Params p{};
    p.x = (const float*)d_in[0]; p.ln1_g = (const float*)d_in[1]; p.w_in = (const float*)d_in[2];
    p.pe_k = (const float*)d_in[3]; p.w1_k = (const float*)d_in[4]; p.w2_k = (const float*)d_in[5];
    p.pe_v = (const float*)d_in[6]; p.w1_v = (const float*)d_in[7]; p.w2_v = (const float*)d_in[8];
    p.sinks = (const float*)d_in[9]; p.w_out = (const float*)d_in[10]; p.ln2_g = (const float*)d_in[11];
    p.wq = (const float*)d_in[12]; p.pkeys = (const float*)d_in[13]; p.pu = (const float*)d_in[14]; p.pv = (const float*)d_in[15];
    p.lnf_g = (const float*)d_in[16];
    p.out = (float*)d_out; p.ws = (unsigned char*)d_ws;
    void* args[] = {&p};
    hipError_t e = hipLaunchCooperativeKernel((void*)fwd_megakernel, dim3(grid_blocks), dim3(NTHREADS), args, LDS_BYTES, stream);
    if (e != hipSuccess) fprintf(stderr, "cooperative launch failed: %s (grid %d)\n", hipGetErrorString(e), grid_blocks);
}
```

```cpp
#include <hip/hip_runtime.h>
#include <hip/hip_cooperative_groups.h>
#include <cstdint>
#include <cstdio>
namespace cg = cooperative_groups;
#define PROBE_PREP 0
#define PROBE_COMPRESS 0
#define PROBE_SWA 0
#define PROBE_NSA 0
#define PROBE_SUB 0
#define PROBE_COMB 0

typedef unsigned short bf16_t;
typedef short bf16x8 __attribute__((ext_vector_type(8)));
typedef float f32x4 __attribute__((ext_vector_type(4)));
typedef unsigned u32x4 __attribute__((ext_vector_type(4)));
typedef unsigned u32x2 __attribute__((ext_vector_type(2)));

constexpr int BATCH = 2, T = 8192, D = 1024, NTOK = BATCH * T;
constexpr int HD = 64, NSA_H = 8, NSA_G = 2, NSA_HG = 4, SWA_H = 8;
constexpr int DIN = 1944, DINP = 2048;
constexpr int NCMP = 511, NCMPP = 512, NSEL = 128, TOPN = 16;
constexpr int NSA_WIN = 512, SWA_WIN = 128;
constexpr int PH = 8, PNK = 128, PDK = 256, PTOPK = 16, PQ = PH * PDK;
constexpr int NEXP = PNK * PNK;
constexpr float EPS = 1e-6f;
constexpr int NTHREADS = 512;

constexpr size_t MiB = 1u << 20;
constexpr size_t WS_SS2 = 0;
constexpr size_t WS_WIN = 1 * MiB;
constexpr size_t WS_WOUT = 5 * MiB;
constexpr size_t WS_WQ = 7 * MiB;
constexpr size_t WS_PKEYS = 11 * MiB;
constexpr size_t WS_W1T = 12 * MiB;
constexpr size_t WS_W2T = 14 * MiB;
constexpr size_t WS_B1 = 14 * MiB + 512 * 1024;
constexpr size_t WS_XN = 16 * MiB;
constexpr size_t WS_O = WS_XN;
constexpr size_t WS_QN = 48 * MiB;
constexpr size_t WS_QS = 64 * MiB;
constexpr size_t WS_KV6 = 80 * MiB;
constexpr size_t KV6_STRIDE = 4 * MiB;
constexpr size_t WS_KSW = 104 * MiB;
constexpr size_t WS_VSW = 106 * MiB;
constexpr size_t WS_GSIG = 108 * MiB;
constexpr size_t WS_KC = 110 * MiB;
constexpr size_t WS_VC = 110 * MiB + 512 * 1024;
constexpr size_t WS_H1G = 48 * MiB;
constexpr size_t WS_QP = 80 * MiB;
constexpr size_t WS_EIDX = 144 * MiB;
constexpr size_t WS_GATE = 152 * MiB;
constexpr size_t WS_U8 = 160 * MiB;
constexpr size_t WS_V8 = 176 * MiB;
constexpr size_t WS_TOPV2 = 224 * MiB;
constexpr size_t WS_TOPI2 = 240 * MiB;
constexpr size_t WS_END = 256 * MiB;

struct Params {
    const float* x; const float* ln1_g; const float* w_in;
    const float* pe_k; const float* w1_k; const float* w2_k;
    const float* pe_v; const float* w1_v; const float* w2_v;
    const float* sinks; const float* w_out; const float* ln2_g;
    const float* wq; const float* pkeys; const float* pu; const float* pv; const float* lnf_g;
    float* out; unsigned char* ws;
};

__device__ __forceinline__ int tid_opaque() { int t = (int)threadIdx.x; asm volatile("" : "+v"(t)); return t; }
__device__ __forceinline__ unsigned f2bf(float f) { unsigned u = __float_as_uint(f); return (u + 0x7fffu + ((u >> 16) & 1u)) >> 16; }
__device__ __forceinline__ float bf2f(unsigned h) { return __uint_as_float(h << 16); }
__device__ __forceinline__ float bflo(unsigned w) { return __uint_as_float(w << 16); }
__device__ __forceinline__ float bfhi(unsigned w) { return __uint_as_float(w & 0xffff0000u); }
__device__ __forceinline__ unsigned pk2(float lo, float hi) { return f2bf(lo) | (f2bf(hi) << 16); }
__device__ __forceinline__ float wave_sum(float v) {
#pragma unroll
    for (int o = 1; o < 64; o <<= 1) v += __shfl_xor(v, o);
    return v;
}
__device__ __forceinline__ float gelu_tanh(float x) {
    const float u = 0.7978845608028654f * (x + 0.044715f * x * x * x);
    return 0.5f * x * (1.0f + tanhf(u));
}
__device__ __forceinline__ int win_orig_col(int n) {
    if (n < 1280) return n;
    if (n < 1792) return 1304 + (n - 1280);
    if (n < 1856) return 1816 + (n - 1792);
    if (n < 1920) return 1880 + (n - 1856);
    if (n < 1944) return 1280 + (n - 1920);
    return -1;
}

template <bool WIN_MAP>
__device__ __forceinline__ void prep_transpose(const float* W, int K, int N, int NP, bf16_t* WT, long gt, long ngt) {
    const long items = (long)NP * (K / 8);
    for (long it = gt; it < items; it += ngt) {
        const int n = (int)(it % NP), k0 = (int)(it / NP) * 8;
        const int col = WIN_MAP ? win_orig_col(n) : n;
        float v[8];
#pragma unroll
        for (int i = 0; i < 8; ++i) v[i] = (col >= 0) ? W[(size_t)(k0 + i) * N + col] : 0.f;
        u32x4 o; o.x = pk2(v[0], v[1]); o.y = pk2(v[2], v[3]); o.z = pk2(v[4], v[5]); o.w = pk2(v[6], v[7]);
        *(u32x4*)(WT + (size_t)n * K + k0) = o;
    }
}
__device__ __forceinline__ void prep_convert(const float* src, bf16_t* dst, long n8, long gt, long ngt) {
    for (long it = gt; it < n8; it += ngt) {
        const f32x4 a = *(const f32x4*)(src + it * 8), b = *(const f32x4*)(src + it * 8 + 4);
        u32x4 o; o.x = pk2(a.x, a.y); o.y = pk2(a.z, a.w); o.z = pk2(b.x, b.y); o.w = pk2(b.z, b.w);
        *(u32x4*)(dst + it * 8) = o;
    }
}
constexpr float U8_SCALE = 256.0f, V8_SCALE = 16.0f;
__device__ __forceinline__ void prep_convert_fp8(const float* src, unsigned char* dst, long n16, float sc, long gt, long ngt) {
    for (long it = gt; it < n16; it += ngt) {
        u32x4 o;
#pragma unroll
        for (int q = 0; q < 4; ++q) {
            const f32x4 a = *(const f32x4*)(src + it * 16 + q * 4);
            int w = 0;
            w = __builtin_amdgcn_cvt_pk_fp8_f32(a.x * sc, a.y * sc, w, false);
            w = __builtin_amdgcn_cvt_pk_fp8_f32(a.z * sc, a.w * sc, w, true);
            o[q] = (unsigned)w;
        }
        *(u32x4*)(dst + it * 16) = o;
    }
}
__device__ __forceinline__ void phase_prep(const Params& p) {
    const long gt = (long)blockIdx.x * NTHREADS + tid_opaque(), ngt = (long)gridDim.x * NTHREADS;
    const int lane = tid_opaque() & 63;
    const long gw = gt >> 6, ngw = ngt >> 6;
    unsigned char* ws = p.ws;
    for (long m = gw; m < NTOK; m += ngw) {
        const f32x4* xr = (const f32x4*)(p.x + (size_t)m * D) + lane;
        f32x4 v[4]; float s = 0.f;
#pragma unroll
        for (int j = 0; j < 4; ++j) { v[j] = xr[64 * j]; s += (v[j].x * v[j].x + v[j].y * v[j].y) + (v[j].z * v[j].z + v[j].w * v[j].w); }
        const float rstd = 1.0f / sqrtf(wave_sum(s) * (1.0f / D) + EPS);
        u32x2* o = (u32x2*)((bf16_t*)(ws + WS_XN) + (size_t)m * D) + lane;
#pragma unroll
        for (int j = 0; j < 4; ++j) {
            const f32x4 g = *((const f32x4*)p.ln1_g + lane + 64 * j);
            u32x2 w; w.x = pk2(v[j].x * rstd * g.x, v[j].y * rstd * g.y); w.y = pk2(v[j].z * rstd * g.z, v[j].w * rstd * g.w);
            o[64 * j] = w;
        }
    }
    prep_transpose<true>(p.w_in, D, DIN, DINP, (bf16_t*)(ws + WS_WIN), gt, ngt);
    prep_transpose<false>(p.w_out, D, D, D, (bf16_t*)(ws + WS_WOUT), gt, ngt);
    prep_transpose<false>(p.wq, D, PQ, PQ, (bf16_t*)(ws + WS_WQ), gt, ngt);
    prep_convert(p.pkeys, (bf16_t*)(ws + WS_PKEYS), (long)16 * 128 * 128 / 8, gt, ngt);
    prep_transpose<false>(p.w1_k, 2048, 256, 256, (bf16_t*)(ws + WS_W1T), gt, ngt);
    prep_transpose<false>(p.w1_v, 2048, 256, 256, (bf16_t*)(ws + WS_W1T) + 256 * 2048, gt, ngt);
    prep_transpose<false>(p.w2_k, 256, 64, 64, (bf16_t*)(ws + WS_W2T), gt, ngt);
    prep_transpose<false>(p.w2_v, 256, 64, 64, (bf16_t*)(ws + WS_W2T) + 64 * 256, gt, ngt);
    for (long o = gw; o < 512; o += ngw) {
        const int kv = (int)(o >> 8), n = (int)(o & 255);
        const float* pe = kv ? p.pe_v : p.pe_k; const float* w1 = kv ? p.w1_v : p.w1_k;
        float s = 0.f;
        for (int k = lane; k < 2048; k += 64) s += pe[k] * w1[(size_t)k * 256 + n];
        s = wave_sum(s);
        if (lane == 0) ((float*)(ws + WS_B1))[o] = s;
    }
    prep_convert_fp8(p.pu, ws + WS_U8, (long)NEXP * D / 16, U8_SCALE, gt, ngt);
    prep_convert_fp8(p.pv, ws + WS_V8, (long)NEXP * D / 16, V8_SCALE, gt, ngt);
    for (long i = gt; i < NTOK; i += ngt) ((float*)(ws + WS_SS2))[i] = 0.f;
}

template <class Epi>
__device__ __forceinline__ void gemm_simple(const bf16_t* A, const bf16_t* Bt, int M, int N, int K, const Epi& E) {
    const int lane = tid_opaque() & 63;
    const long gw = ((long)blockIdx.x * NTHREADS + tid_opaque()) >> 6, ngw = ((long)gridDim.x * NTHREADS) >> 6;
    const int ntn = N / 64; const long ntiles = (long)(M / 32) * ntn;
    const int fr = lane & 15, fq = lane >> 4;
    for (long tile = gw; tile < ntiles; tile += ngw) {
        const int m0 = (int)(tile / ntn) * 32, n0 = (int)(tile % ntn) * 64;
        f32x4 acc[2][4];
#pragma unroll
        for (int i = 0; i < 2; ++i)
#pragma unroll
            for (int j = 0; j < 4; ++j) acc[i][j] = (f32x4){0.f, 0.f, 0.f, 0.f};
        const bf16_t* ap = A + (size_t)(m0 + fr) * K + fq * 8;
        const bf16_t* bp = Bt + (size_t)(n0 + fr) * K + fq * 8;
        for (int k0 = 0; k0 < K; k0 += 32) {
            bf16x8 a[2], b[4];
#pragma unroll
            for (int i = 0; i < 2; ++i) a[i] = *(const bf16x8*)(ap + (size_t)i * 16 * K + k0);
#pragma unroll
            for (int j = 0; j < 4; ++j) b[j] = *(const bf16x8*)(bp + (size_t)j * 16 * K + k0);
#pragma unroll
            for (int i = 0; i < 2; ++i)
#pragma unroll
                for (int j = 0; j < 4; ++j) acc[i][j] = __builtin_amdgcn_mfma_f32_16x16x32_bf16(a[i], b[j], acc[i][j], 0, 0, 0);
        }
        E(acc, m0, n0, fr, fq);
    }
}

struct EpiProj {
    unsigned char* ws;
    __device__ __forceinline__ void operator()(const f32x4 (&acc)[2][4], int m0, int n0, int fr, int fq) const {
#pragma unroll
        for (int i = 0; i < 2; ++i)
#pragma unroll
            for (int j = 0; j < 4; ++j)
#pragma unroll
                for (int r = 0; r < 4; ++r) {
                    const int row = m0 + 16 * i + fq * 4 + r, n = n0 + 16 * j + fr;
                    const float v = acc[i][j][r];
                    const int b = row / T, t = row % T, d = n & 63;
                    if (n < 512) {
                        const int head = n >> 6;
                        ((bf16_t*)(ws + WS_QN))[((size_t)(b * 8 + head) * T + t) * 64 + d] = (bf16_t)f2bf(v * 0.125f);
                    } else if (n < 1280) {
                        const int arr = (n - 512) >> 7, g = ((n - 512) >> 6) & 1;
                        ((bf16_t*)(ws + WS_KV6 + arr * KV6_STRIDE))[((size_t)(b * 2 + g) * T + t) * 64 + d] = (bf16_t)f2bf(v);
                    } else if (n < 1792) {
                        const int head = (n - 1280) >> 6;
                        ((bf16_t*)(ws + WS_QS))[((size_t)(b * 8 + head) * T + t) * 64 + d] = (bf16_t)f2bf(v * 0.125f);
                    } else if (n < 1856) {
                        ((bf16_t*)(ws + WS_KSW))[((size_t)b * T + t) * 64 + d] = (bf16_t)f2bf(v);
                    } else if (n < 1920) {
                        ((bf16_t*)(ws + WS_VSW))[((size_t)b * T + t) * 64 + d] = (bf16_t)f2bf(v);
                    } else if (n < 1944) {
                        ((float*)(ws + WS_GSIG))[(size_t)row * 24 + (n - 1920)] = 1.0f / (1.0f + expf(-v));
                    }
                }
    }
};
struct EpiOut {
    const float* x; const float* g2; float* h1; bf16_t* h1g; float* ss2;
    __device__ __forceinline__ void operator()(const f32x4 (&acc)[2][4], int m0, int n0, int fr, int fq) const {
#pragma unroll
        for (int i = 0; i < 2; ++i)
#pragma unroll
            for (int r = 0; r < 4; ++r) {
                const int row = m0 + 16 * i + fq * 4 + r; float ss = 0.f;
#pragma unroll
                for (int j = 0; j < 4; ++j) {
                    const int n = n0 + 16 * j + fr; const size_t off = (size_t)row * D + n;
                    const float h = x[off] + acc[i][j][r];
                    h1[off] = h; h1g[off] = (bf16_t)f2bf(h * g2[n]); ss += h * h;
                }
                ss += __shfl_xor(ss, 1); ss += __shfl_xor(ss, 2); ss += __shfl_xor(ss, 4); ss += __shfl_xor(ss, 8);
                if (fr == 0) atomicAdd(ss2 + row, ss);
            }
    }
};
struct EpiQP {
    const float* ss2; bf16_t* qp;
    __device__ __forceinline__ void operator()(const f32x4 (&acc)[2][4], int m0, int n0, int fr, int fq) const {
#pragma unroll
        for (int i = 0; i < 2; ++i)
#pragma unroll
            for (int r = 0; r < 4; ++r) {
                const int row = m0 + 16 * i + fq * 4 + r;
                const float rstd = 1.0f / sqrtf(ss2[row] * (1.0f / D) + EPS);
#pragma unroll
                for (int j = 0; j < 4; ++j) qp[(size_t)row * PQ + n0 + 16 * j + fr] = (bf16_t)f2bf(acc[i][j][r] * rstd);
            }
    }
};

namespace pg8 {
#define PG8_LAS __attribute__((address_space(3)))
typedef unsigned short bf16_t;
typedef short bf16x8 __attribute__((ext_vector_type(8)));
typedef float f32x4 __attribute__((ext_vector_type(4)));
typedef unsigned u32x4 __attribute__((ext_vector_type(4)));
constexpr int BM = 256, BK = 64, HALF = 128, HTB = HALF * BK * 2  , STAGE_BYTES = 8 * HTB, NXCD = 8, WGM = 8;

__host__ __device__ __forceinline__ int lds_byte(int r, int c) { const int st = (r >> 4) * 2 + (c >> 5), rr = r & 15, cc = c & 31, ob = rr * 64 + cc * 2; return st * 1024 + (ob ^ (((ob >> 9) & 1) << 5)); }
__host__ __device__ __forceinline__ void stage_rc(int b, int& R, int& C) { const int st = b / 1024, sb = b % 1024, swz = sb ^ (((sb >> 9) & 1) << 5); R = (st >> 1) * 16 + swz / 64; C = (st & 1) * 32 + (swz % 64) / 2; }
__host__ __device__ __forceinline__ int perm32(int rho) { const int n = rho >> 4, i = rho & 15; return 8 * (i >> 2) + 4 * n + (i & 3); }

struct Unit { int pm, pn; };
struct Gemm { const bf16_t* A; const bf16_t* Bt; int M, N, K; };

struct StaticOrder {
    int nM, nN, nwg, G, c;
    __host__ __device__ void init(int M, int N, int G_, int c_) { nM = M / BM; nN = N / BM; nwg = nM * nN; G = G_; c = c_; }
    __host__ __device__ bool next(int i, Unit& u) const {
        const long L = (long)i * G + c; if (L >= nwg) return false;
        int wgid = (int)L; { const int q = nwg / NXCD, r = nwg % NXCD, xcd = wgid % NXCD, off = wgid / NXCD; wgid = (xcd < r ? xcd * (q + 1) : r * (q + 1) + (xcd - r) * q) + off; }
        const int nig = WGM * nN, gid = wgid / nig, fm = gid * WGM, gsz = (nM - fm) < WGM ? (nM - fm) : WGM;
        u.pm = fm + ((wgid % nig) % gsz); u.pn = (wgid % nig) / gsz; return true;
    }
    __device__ __forceinline__ void a_ready(const Unit&) const {}
    __device__ __forceinline__ void done(const Unit&) const {}
};

__device__ __forceinline__ unsigned cvt_pk_bf16(float lo, float hi) { unsigned r; asm volatile("v_cvt_pk_bf16_f32 %0, %1, %2" : "=v"(r) : "v"(lo), "v"(hi)); return r; }
template <class Epi, class Sched, bool ALIGN_EPI = false, bool SP2 = false>
__device__ __forceinline__ void gemm_phase(PG8_LAS unsigned char* lds, const Gemm g, const Sched& S, const Epi& E) {
    const int tid = tid_opaque(), wid = __builtin_amdgcn_readfirstlane(tid >> 6), lane = tid & 63, wr = wid >> 2, wc = wid & 3, fr = lane & 15, fq = lane >> 4;
    const int K = g.K, nt = K / BK;
    unsigned voffA[2], voffB[2];
#pragma unroll
    for (int i = 0; i < 2; ++i) { int R, C; stage_rc(tid * 16 + i * 8192, R, C); const int Rb = Epi::PERM ? ((R & ~31) + perm32(R & 31)) : R;
        voffA[i] = (unsigned)(R * K + C) * 2u; voffB[i] = (unsigned)(Rb * K + C) * 2u; }
    const size_t kstep = (size_t)(BK * 2);
    const size_t hstep = (size_t)HALF * K * 2;
    const size_t tstep = 2 * hstep;
    const unsigned ldsw = (unsigned)wid * 1024u;
    const int aoff = lds_byte(wr * 64 + fr, fq * 8), boff = lds_byte(wc * 32 + fr, fq * 8);
#define PG8_SA(b, h) (((b) * 2 + (h)) * HTB)
#define PG8_SB(b, h) ((4 + (b) * 2 + (h)) * HTB)
#define PG8_STAGE(bufoff, gbase, voff) do { _Pragma("unroll") for (int _i = 0; _i < 2; ++_i) \
        __builtin_amdgcn_global_load_lds((const unsigned*)((const char*)(gbase) + (voff)[_i]), (PG8_LAS unsigned*)(lds + (bufoff) + ldsw + _i * 8192), 16, 0, 0); } while (0)
#define PG8_LDA(dst, b, h) do { _Pragma("unroll") for (int m = 0; m < 4; ++m) _Pragma("unroll") for (int k = 0; k < 2; ++k) dst[m][k] = *(const PG8_LAS bf16x8*)(lds + PG8_SA(b, h) + aoff + m * 2048 + k * 1024); } while (0)
#define PG8_LDB(dst, b, h) do { _Pragma("unroll") for (int n = 0; n < 2; ++n) _Pragma("unroll") for (int k = 0; k < 2; ++k) dst[n][k] = *(const PG8_LAS bf16x8*)(lds + PG8_SB(b, h) + boff + n * 2048 + k * 1024); } while (0)
#define PG8_MMA(ai, bj, At, Bt) do { __builtin_amdgcn_s_setprio(1); _Pragma("unroll") for (int m = 0; m < 4; ++m) _Pragma("unroll") for (int n = 0; n < 2; ++n) _Pragma("unroll") for (int k = 0; k < 2; ++k) \
        acc[ai][bj][m][n] = __builtin_amdgcn_mfma_f32_16x16x32_bf16(Bt[n][k], At[m][k], acc[ai][bj][m][n], 0, 0, 0); __builtin_amdgcn_s_setprio(0); } while (0)
#define PG8_WAIT_V(n) asm volatile("s_waitcnt vmcnt(" #n ")" ::: "memory")
#define PG8_WAIT_L(n) asm volatile("s_waitcnt lgkmcnt(" #n ")" ::: "memory")
#define PG8_BAR __builtin_amdgcn_s_barrier()
#define PG8_SCHED __builtin_amdgcn_sched_barrier(0)
    Unit cur, nxt; int ui = 0;
    if (!S.next(0, cur)) return;
    f32x4 acc[2][2][4][2];
#pragma unroll
    for (int a = 0; a < 2; ++a)
#pragma unroll
        for (int b = 0; b < 2; ++b)
#pragma unroll
            for (int m = 0; m < 4; ++m)
#pragma unroll
                for (int n = 0; n < 2; ++n) acc[a][b][m][n] = (f32x4){0.f, 0.f, 0.f, 0.f};
    bf16x8 At[4][2], B0[2][2], B1[2][2];
    const char* cA = (const char*)g.A + (size_t)cur.pm * tstep; const char* cB = (const char*)g.Bt + (size_t)cur.pn * tstep;
    S.a_ready(cur);
    if constexpr (SP2) {
        PG8_STAGE(PG8_SB(0, 0), cB, voffB); PG8_STAGE(PG8_SB(0, 1), cB + hstep, voffB); PG8_STAGE(PG8_SA(0, 0), cA, voffA); PG8_STAGE(PG8_SA(0, 1), cA + hstep, voffA);
        if (wr == 1) PG8_BAR;
        PG8_WAIT_V(2); PG8_BAR;
        PG8_STAGE(PG8_SB(1, 0), cB + kstep, voffB); PG8_STAGE(PG8_SA(1, 0), cA + kstep, voffA); PG8_STAGE(PG8_SB(1, 1), cB + hstep + kstep, voffB);
        PG8_WAIT_V(6); PG8_BAR;
    } else {
        PG8_STAGE(PG8_SB(0, 0), cB, voffB); PG8_STAGE(PG8_SA(0, 0), cA, voffA); PG8_STAGE(PG8_SB(0, 1), cB + hstep, voffB); PG8_STAGE(PG8_SA(0, 1), cA + hstep, voffA);
        if (wr == 1) PG8_BAR;
        PG8_WAIT_V(4); PG8_BAR;
        PG8_STAGE(PG8_SB(1, 0), cB + kstep, voffB); PG8_STAGE(PG8_SA(1, 0), cA + kstep, voffA); PG8_STAGE(PG8_SB(1, 1), cB + hstep + kstep, voffB);
        PG8_WAIT_V(6); PG8_BAR;
    }
    for (;;) {
        const bool has_next = S.next(ui + 1, nxt);
        const char* nA = has_next ? (const char*)g.A + (size_t)nxt.pm * tstep : cA; const char* nB = has_next ? (const char*)g.Bt + (size_t)nxt.pn * tstep : cB;
        for (int t = 0; t < nt; t += 2) {
            const bool last = (t == nt - 2);
            const char* a1 = cA + (size_t)(t + 1) * kstep;
            const char* a2 = last ? nA : cA + (size_t)(t + 2) * kstep; const char* b2 = last ? nB : cB + (size_t)(t + 2) * kstep;
            const char* a3 = a2 + kstep; const char* b3 = b2 + kstep;
            if (last && has_next) S.a_ready(nxt);
            if constexpr (SP2) {
            PG8_LDB(B0, 0, 0); PG8_LDB(B1, 0, 1); PG8_SCHED; PG8_LDA(At, 0, 0); PG8_STAGE(PG8_SA(1, 1), a1 + hstep, voffA);
            PG8_WAIT_V(8); PG8_WAIT_L(0); PG8_BAR; PG8_MMA(0, 0, At, B0); PG8_MMA(0, 1, At, B1); PG8_BAR; PG8_SCHED;
            PG8_LDA(At, 0, 1); PG8_STAGE(PG8_SB(0, 0), b2, voffB); PG8_STAGE(PG8_SB(0, 1), b2 + hstep, voffB); PG8_STAGE(PG8_SA(0, 0), a2, voffA);
            PG8_WAIT_V(8); PG8_WAIT_L(0); PG8_BAR; PG8_MMA(1, 0, At, B0); PG8_MMA(1, 1, At, B1); PG8_BAR; PG8_SCHED;
            PG8_LDB(B0, 1, 0); PG8_LDB(B1, 1, 1); PG8_SCHED; PG8_LDA(At, 1, 0); PG8_STAGE(PG8_SA(0, 1), a2 + hstep, voffA);
            PG8_WAIT_V(8); PG8_WAIT_L(0); PG8_BAR; PG8_MMA(0, 0, At, B0); PG8_MMA(0, 1, At, B1); PG8_BAR; PG8_SCHED;
            PG8_LDA(At, 1, 1); PG8_STAGE(PG8_SB(1, 0), b3, voffB); PG8_STAGE(PG8_SB(1, 1), b3 + hstep, voffB); PG8_STAGE(PG8_SA(1, 0), a3, voffA);
            PG8_WAIT_V(8); PG8_WAIT_L(0); PG8_BAR; PG8_MMA(1, 0, At, B0); PG8_MMA(1, 1, At, B1); PG8_BAR; PG8_SCHED;
            } else {
            PG8_LDB(B0, 0, 0); PG8_SCHED; PG8_LDA(At, 0, 0); PG8_STAGE(PG8_SA(1, 1), a1 + hstep, voffA);
            PG8_WAIT_L(8); PG8_BAR; PG8_WAIT_L(0); PG8_MMA(0, 0, At, B0); PG8_BAR; PG8_SCHED;
            PG8_LDB(B1, 0, 1); PG8_STAGE(PG8_SB(0, 0), b2, voffB);
            PG8_BAR; PG8_WAIT_L(0); PG8_MMA(0, 1, At, B1); PG8_BAR;
            PG8_LDA(At, 0, 1); PG8_STAGE(PG8_SA(0, 0), a2, voffA);
            PG8_BAR; PG8_WAIT_L(0); PG8_MMA(1, 0, At, B0); PG8_BAR; PG8_SCHED;
            PG8_STAGE(PG8_SB(0, 1), b2 + hstep, voffB);
            PG8_WAIT_V(6); PG8_BAR; PG8_MMA(1, 1, At, B1); PG8_BAR;
            PG8_LDB(B0, 1, 0); PG8_SCHED; PG8_LDA(At, 1, 0); PG8_STAGE(PG8_SA(0, 1), a2 + hstep, voffA);
            PG8_WAIT_L(8); PG8_BAR; PG8_WAIT_L(0); PG8_MMA(0, 0, At, B0); PG8_BAR; PG8_SCHED;
            PG8_LDB(B1, 1, 1); PG8_STAGE(PG8_SB(1, 0), b3, voffB);
            PG8_BAR; PG8_WAIT_L(0); PG8_MMA(0, 1, At, B1); PG8_BAR;
            PG8_LDA(At, 1, 1); PG8_STAGE(PG8_SA(1, 0), a3, voffA);
            PG8_BAR; PG8_WAIT_L(0); PG8_MMA(1, 0, At, B0); PG8_BAR; PG8_SCHED;
            PG8_STAGE(PG8_SB(1, 1), b3 + hstep, voffB);
            PG8_WAIT_V(6); PG8_BAR; PG8_MMA(1, 1, At, B1); PG8_BAR;
            }
        }
        if constexpr (ALIGN_EPI) { if (wr == 0) PG8_BAR; }
        if constexpr (!Epi::AFTER_DRAIN) { E(acc, cur, wr, wc, fr, fq); S.done(cur); }
        if (!has_next) break;
#pragma unroll
        for (int a = 0; a < 2; ++a)
#pragma unroll
            for (int b = 0; b < 2; ++b)
#pragma unroll
                for (int m = 0; m < 4; ++m)
#pragma unroll
                    for (int n = 0; n < 2; ++n) acc[a][b][m][n] = (f32x4){0.f, 0.f, 0.f, 0.f};
        cur = nxt; cA = nA; cB = nB; ++ui;
        if constexpr (ALIGN_EPI) { if (wr == 1) PG8_BAR; }
    }
    PG8_WAIT_V(0);
    if constexpr (!ALIGN_EPI) { if (wr == 0) PG8_BAR; }
    PG8_BAR;
    if constexpr (Epi::AFTER_DRAIN) { E.fused(acc, cur, wr, wc, fr, fq, lds, wid, lane); S.done(cur); }
#undef PG8_SA
#undef PG8_SB
#undef PG8_STAGE
#undef PG8_LDA
#undef PG8_LDB
#undef PG8_MMA
#undef PG8_WAIT_V
#undef PG8_WAIT_L
#undef PG8_BAR
#undef PG8_SCHED
}
}

struct EpiProjT {
    static constexpr bool PERM = true, AFTER_DRAIN = false;
    unsigned char* ws;
    __device__ __forceinline__ void operator()(const f32x4 (&acc)[2][2][4][2], const pg8::Unit& u, int wr, int wc, int fr, int fq) const {
        const int row0 = u.pm * 256 + wr * 64 + fr;
#pragma unroll
        for (int bj = 0; bj < 2; ++bj) {
            const int n8 = u.pn * 256 + bj * 128 + wc * 32 + 8 * fq;
            if (n8 >= 1944) continue;
            if (n8 >= 1920) {
#pragma unroll
                for (int ai = 0; ai < 2; ++ai)
#pragma unroll
                    for (int m = 0; m < 4; ++m) {
                        const int row = row0 + ai * 128 + m * 16;
                        const f32x4 v0 = acc[ai][bj][m][0], v1 = acc[ai][bj][m][1];
                        float* dst = (float*)(ws + WS_GSIG) + (size_t)row * 24 + (n8 - 1920);
                        *(f32x4*)dst = (f32x4){1.0f / (1.0f + __expf(-v0[0])), 1.0f / (1.0f + __expf(-v0[1])), 1.0f / (1.0f + __expf(-v0[2])), 1.0f / (1.0f + __expf(-v0[3]))};
                        *(f32x4*)(dst + 4) = (f32x4){1.0f / (1.0f + __expf(-v1[0])), 1.0f / (1.0f + __expf(-v1[1])), 1.0f / (1.0f + __expf(-v1[2])), 1.0f / (1.0f + __expf(-v1[3]))};
                    }
                continue;
            }
            bf16_t* base; int nh, hidx; float sc = 1.0f;
            if (n8 < 512) { base = (bf16_t*)(ws + WS_QN); nh = 8; hidx = n8 >> 6; sc = 0.125f; }
            else if (n8 < 1280) { const int arr = (n8 - 512) >> 7; base = (bf16_t*)(ws + WS_KV6 + (size_t)arr * KV6_STRIDE); nh = 2; hidx = ((n8 - 512) >> 6) & 1; }
            else if (n8 < 1792) { base = (bf16_t*)(ws + WS_QS); nh = 8; hidx = (n8 - 1280) >> 6; sc = 0.125f; }
            else if (n8 < 1856) { base = (bf16_t*)(ws + WS_KSW); nh = 1; hidx = 0; }
            else { base = (bf16_t*)(ws + WS_VSW); nh = 1; hidx = 0; }
            const int d0 = n8 & 63;
#pragma unroll
            for (int ai = 0; ai < 2; ++ai)
#pragma unroll
                for (int m = 0; m < 4; ++m) {
                    const int row = row0 + ai * 128 + m * 16, b = row >> 13, t = row & (T - 1);
                    const f32x4 v0 = acc[ai][bj][m][0] * sc, v1 = acc[ai][bj][m][1] * sc;
                    u32x4 w; w.x = pg8::cvt_pk_bf16(v0[0], v0[1]); w.y = pg8::cvt_pk_bf16(v0[2], v0[3]); w.z = pg8::cvt_pk_bf16(v1[0], v1[1]); w.w = pg8::cvt_pk_bf16(v1[2], v1[3]);
                    *(u32x4*)(base + ((size_t)(b * nh + hidx) * T + t) * 64 + d0) = w;
                }
        }
    }
};
struct EpiOutT {
    static constexpr bool PERM = false, AFTER_DRAIN = false;
    const float* x; const float* g2; float* h1; bf16_t* h1g; float* ss2;
    __device__ __forceinline__ void operator()(const f32x4 (&acc)[2][2][4][2], const pg8::Unit& u, int wr, int wc, int fr, int fq) const {
        const int row0 = u.pm * 256 + wr * 64 + fr, col0 = u.pn * 256 + wc * 32 + 4 * fq;
#pragma unroll
        for (int ai = 0; ai < 2; ++ai)
#pragma unroll
            for (int m = 0; m < 4; ++m) {
                const int row = row0 + ai * 128 + m * 16; float ss = 0.f;
#pragma unroll
                for (int bj = 0; bj < 2; ++bj)
#pragma unroll
                    for (int n = 0; n < 2; ++n) {
                        const int c = col0 + bj * 128 + n * 16; const size_t off = (size_t)row * D + c;
                        const f32x4 h = *(const f32x4*)(x + off) + acc[ai][bj][m][n];
                        const f32x4 g = *(const f32x4*)(g2 + c);
                        *(f32x4*)(h1 + off) = h;
                        u32x2 w; w.x = pg8::cvt_pk_bf16(h[0] * g[0], h[1] * g[1]); w.y = pg8::cvt_pk_bf16(h[2] * g[2], h[3] * g[3]);
                        *(u32x2*)(h1g + off) = w;
                        ss += (h[0] * h[0] + h[1] * h[1]) + (h[2] * h[2] + h[3] * h[3]);
                    }
                ss += __shfl_xor(ss, 16); ss += __shfl_xor(ss, 32);
                if (fq == 0) atomicAdd(ss2 + row, ss);
            }
    }
};
struct EpiQPT {
    static constexpr bool PERM = true, AFTER_DRAIN = false;
    const float* ss2; bf16_t* qp;
    __device__ __forceinline__ void operator()(const f32x4 (&acc)[2][2][4][2], const pg8::Unit& u, int wr, int wc, int fr, int fq) const {
        const int row0 = u.pm * 256 + wr * 64 + fr;
#pragma unroll
        for (int ai = 0; ai < 2; ++ai)
#pragma unroll
            for (int m = 0; m < 4; ++m) {
                const int row = row0 + ai * 128 + m * 16;
                const float rstd = 1.0f / sqrtf(ss2[row] * (1.0f / D) + EPS);
#pragma unroll
                for (int bj = 0; bj < 2; ++bj) {
                    const int n8 = u.pn * 256 + bj * 128 + wc * 32 + 8 * fq;
                    const f32x4 v0 = acc[ai][bj][m][0] * rstd, v1 = acc[ai][bj][m][1] * rstd;
                    u32x4 w; w.x = pg8::cvt_pk_bf16(v0[0], v0[1]); w.y = pg8::cvt_pk_bf16(v0[2], v0[3]); w.z = pg8::cvt_pk_bf16(v1[0], v1[1]); w.w = pg8::cvt_pk_bf16(v1[2], v1[3]);
                    *(u32x4*)(qp + (size_t)row * PQ + n8) = w;
                }
            }
    }
};

__device__ __forceinline__ void phase_compress(const Params& p, float* lds) {
    float* flat = lds;
    float* part = lds + 2048;
    float* hid = lds + 2560;
    const int tid = tid_opaque();
    const int nunits = 2 * BATCH * NCMP * NSA_G;
    for (int u = blockIdx.x; u < nunits; u += gridDim.x) {
        const int kv = u / (BATCH * NCMP * NSA_G); int r = u % (BATCH * NCMP * NSA_G);
        const int b = r / (NCMP * NSA_G); r %= (NCMP * NSA_G);
        const int c = r / NSA_G, g = r % NSA_G;
        const bf16_t* raw = (const bf16_t*)(p.ws + WS_KV6 + (size_t)kv * KV6_STRIDE) + ((size_t)(b * 2 + g) * T + 16 * c) * 64;
        const float* pe = kv ? p.pe_v : p.pe_k; const float* w1 = kv ? p.w1_v : p.w1_k; const float* w2 = kv ? p.w2_v : p.w2_k;
        for (int i = tid; i < 2048; i += NTHREADS) flat[i] = bf2f(raw[i]) + pe[i];
        __syncthreads();
        {
            const int j = tid & 255, half = tid >> 8;
            float a = 0.f;
            const float* wp = w1 + (size_t)(half * 1024) * 256 + j; const float* fp = flat + half * 1024;
            for (int i = 0; i < 1024; ++i) a += fp[i] * wp[(size_t)i * 256];
            part[tid] = a;
        }
        __syncthreads();
        if (tid < 256) hid[tid] = gelu_tanh(part[tid] + part[tid + 256]);
        __syncthreads();
        if (tid < 64) {
            float a = 0.f;
            for (int j = 0; j < 256; ++j) a += hid[j] * w2[j * 64 + tid];
            bf16_t* dst = (bf16_t*)(p.ws + (kv ? WS_VC : WS_KC)) + ((size_t)(b * 2 + g) * NCMPP + c) * 64;
            dst[tid] = (bf16_t)f2bf(a);
        }
        __syncthreads();
    }
}

__device__ __forceinline__ void load_row64(const bf16_t* src, float (&k)[64]) {
#pragma unroll
    for (int c = 0; c < 8; ++c) {
        const u32x4 w = *(const u32x4*)(src + 8 * c);
        k[8 * c + 0] = bflo(w.x); k[8 * c + 1] = bfhi(w.x); k[8 * c + 2] = bflo(w.y); k[8 * c + 3] = bfhi(w.y);
        k[8 * c + 4] = bflo(w.z); k[8 * c + 5] = bfhi(w.z); k[8 * c + 6] = bflo(w.w); k[8 * c + 7] = bfhi(w.w);
    }
}
__device__ __forceinline__ float dot_row64(const bf16_t* src, const float (&q)[64]) {
    float s0 = 0.f, s1 = 0.f;
#pragma unroll
    for (int c = 0; c < 8; ++c) {
        const u32x4 w = *(const u32x4*)(src + 8 * c);
        s0 += q[8 * c + 0] * bflo(w.x); s1 += q[8 * c + 1] * bfhi(w.x); s0 += q[8 * c + 2] * bflo(w.y); s1 += q[8 * c + 3] * bfhi(w.y);
        s0 += q[8 * c + 4] * bflo(w.z); s1 += q[8 * c + 5] * bfhi(w.z); s0 += q[8 * c + 6] * bflo(w.w); s1 += q[8 * c + 7] * bfhi(w.w);
    }
    return s0 + s1;
}
__device__ __forceinline__ void osm_update(float s, const bf16_t* vsrc, float& m, float& l, float (&acc)[32]) {
    const float mn = fmaxf(m, s), alpha = __expf(m - mn), pr = __expf(s - mn);
    l = l * alpha + pr; m = mn;
#pragma unroll
    for (int c = 0; c < 4; ++c) {
        const u32x4 w = *(const u32x4*)(vsrc + 8 * c);
        acc[8 * c + 0] = acc[8 * c + 0] * alpha + pr * bflo(w.x); acc[8 * c + 1] = acc[8 * c + 1] * alpha + pr * bfhi(w.x);
        acc[8 * c + 2] = acc[8 * c + 2] * alpha + pr * bflo(w.y); acc[8 * c + 3] = acc[8 * c + 3] * alpha + pr * bfhi(w.y);
        acc[8 * c + 4] = acc[8 * c + 4] * alpha + pr * bflo(w.z); acc[8 * c + 5] = acc[8 * c + 5] * alpha + pr * bfhi(w.z);
        acc[8 * c + 6] = acc[8 * c + 6] * alpha + pr * bflo(w.w); acc[8 * c + 7] = acc[8 * c + 7] * alpha + pr * bfhi(w.w);
    }
}

__device__ __forceinline__ void phase_nsa(const Params& p, float* lds) {
    float* imp = lds;
    int* sel = (int*)(lds + 64 * 129);
    const int tid = tid_opaque(), qi = tid & 63, h = (tid >> 6) & 3, dh = tid >> 8;
    const unsigned char* ws = p.ws;
    const int nunits = BATCH * NSA_G * (T / 64);
    for (int u = blockIdx.x; u < nunits; u += gridDim.x) {
        const int b = u / (NSA_G * (T / 64)), g = (u / (T / 64)) % NSA_G, tile = u % (T / 64);
        const int t = tile * 64 + qi, head = g * 4 + h;
        const float slope = exp2f(-0.5f * (float)(9 + head));
        float q[64];
        load_row64((const bf16_t*)(ws + WS_QN) + ((size_t)(b * 8 + head) * T + t) * 64, q);
        const bf16_t* KC = (const bf16_t*)(ws + WS_KC) + (size_t)(b * 2 + g) * NCMPP * 64;
        const bf16_t* VC = (const bf16_t*)(ws + WS_VC) + (size_t)(b * 2 + g) * NCMPP * 64 + dh * 32;
        const bf16_t* KS = (const bf16_t*)(ws + WS_KV6 + 2 * KV6_STRIDE) + (size_t)(b * 2 + g) * T * 64;
        const bf16_t* VS = (const bf16_t*)(ws + WS_KV6 + 3 * KV6_STRIDE) + (size_t)(b * 2 + g) * T * 64 + dh * 32;
        const bf16_t* KW = (const bf16_t*)(ws + WS_KV6 + 4 * KV6_STRIDE) + (size_t)(b * 2 + g) * T * 64;
        const bf16_t* VW = (const bf16_t*)(ws + WS_KV6 + 5 * KV6_STRIDE) + (size_t)(b * 2 + g) * T * 64 + dh * 32;
        const float* gs = (const float*)(ws + WS_GSIG) + (size_t)(b * T + t) * 24 + head * 3;
        float o[32];
#pragma unroll
        for (int d = 0; d < 32; ++d) o[d] = 0.f;
        for (int i = tid; i < 64 * 129; i += NTHREADS) imp[i] = 0.f;
        __syncthreads();
        const int nc = 4 * tile + 3;
        float mc = -1e30f, lc = 0.f;
        {
            float acc[32];
#pragma unroll
            for (int d = 0; d < 32; ++d) acc[d] = 0.f;
            for (int c = 0; c < nc; ++c) {
                const int dist = t - (16 * c + 31);
                if (dist >= 0) {
                    const float s = dot_row64(KC + (size_t)c * 64, q) - slope * (float)dist;
                    osm_update(s, VC + (size_t)c * 64, mc, lc, acc);
                }
            }
            const float inv = gs[0] / fmaxf(lc, 1e-30f);
#pragma unroll
            for (int d = 0; d < 32; ++d) o[d] += acc[d] * inv;
        }
        if (dh == 0) {
            const float invl = 1.0f / fmaxf(lc, 1e-30f);
            for (int c = 0; c < nc; ++c) {
                const int dist = t - (16 * c + 31);
                if (dist >= 0) {
                    const float s = dot_row64(KC + (size_t)c * 64, q) - slope * (float)dist;
                    const float pr = __expf(s - mc) * invl;
                    const int sb = c >> 2;
                    atomicAdd(&imp[qi * 129 + sb], pr);
                    if ((c & 3) == 3 && sb + 1 < NSEL) atomicAdd(&imp[qi * 129 + sb + 1], pr);
                }
            }
        }
        __syncthreads();
        if (tid < 64) {
            const int blk_t = tile;
            float* row = imp + tid * 129;
            for (int j = 0; j <= blk_t; ++j) if (j == 0 || j == blk_t || j == blk_t - 1) row[j] = 1.0e4f;
            for (int k = 0; k < TOPN; ++k) {
                float best = -INFINITY; int bi = -1;
                for (int j = 0; j <= blk_t; ++j) { const float v = row[j]; if (v > best) { best = v; bi = j; } }
                sel[tid * 16 + k] = bi;
                if (bi >= 0) row[bi] = -INFINITY;
            }
        }
        __syncthreads();
        {
            float m = -1e30f, l = 0.f, acc[32];
#pragma unroll
            for (int d = 0; d < 32; ++d) acc[d] = 0.f;
            for (int k = 0; k < TOPN; ++k) {
                const int j = sel[qi * 16 + k];
                if (j >= 0) {
                    for (int i = 0; i < 64; ++i) {
                        const int pos = 64 * j + i;
                        if (pos <= t) {
                            const float s = dot_row64(KS + (size_t)pos * 64, q) - slope * (float)(t - pos);
                            osm_update(s, VS + (size_t)pos * 64, m, l, acc);
                        }
                    }
                }
            }
            const float inv = gs[1] / fmaxf(l, 1e-30f);
#pragma unroll
            for (int d = 0; d < 32; ++d) o[d] += acc[d] * inv;
        }
        {
            float m = -1e30f, l = 0.f, acc[32];
#pragma unroll
            for (int d = 0; d < 32; ++d) acc[d] = 0.f;
            for (int i = 0; i < NSA_WIN; ++i) {
                const int pos = t - (NSA_WIN - 1) + i;
                if (pos >= 0) {
                    const float s = dot_row64(KW + (size_t)pos * 64, q) - slope * (float)(t - pos);
                    osm_update(s, VW + (size_t)pos * 64, m, l, acc);
                }
            }
            const float inv = gs[2] / fmaxf(l, 1e-30f);
#pragma unroll
            for (int d = 0; d < 32; ++d) o[d] += acc[d] * inv;
        }
        bf16_t* O = (bf16_t*)(p.ws + WS_O) + (size_t)(b * T + t) * D + g * 256 + h * 64 + dh * 32;
#pragma unroll
        for (int c = 0; c < 4; ++c) {
            u32x4 w; w.x = pk2(o[8 * c], o[8 * c + 1]); w.y = pk2(o[8 * c + 2], o[8 * c + 3]); w.z = pk2(o[8 * c + 4], o[8 * c + 5]); w.w = pk2(o[8 * c + 6], o[8 * c + 7]);
            *(u32x4*)(O + 8 * c) = w;
        }
        __syncthreads();
    }
}

__device__ __forceinline__ void phase_swa(const Params& p) {
    const unsigned char* ws = p.ws;
    const long gt = (long)blockIdx.x * NTHREADS + tid_opaque(), ngt = (long)gridDim.x * NTHREADS;
    const long items = (long)NTOK * SWA_H * 2;
    for (long it = gt; it < items; it += ngt) {
        const int tt = (int)(it % T); long r = it / T;
        const int dh = (int)(r % 2); r /= 2;
        const int head = (int)(r % SWA_H); const int b = (int)(r / SWA_H);
        const float slope = exp2f(-0.5f * (float)(head + 1));
        float q[64];
        load_row64((const bf16_t*)(ws + WS_QS) + ((size_t)(b * 8 + head) * T + tt) * 64, q);
        const bf16_t* K = (const bf16_t*)(ws + WS_KSW) + (size_t)b * T * 64;
        const bf16_t* V = (const bf16_t*)(ws + WS_VSW) + (size_t)b * T * 64 + dh * 32;
        const float sink = p.sinks[head];
        float m = sink, l = 1.0f, acc[32];
#pragma unroll
        for (int d = 0; d < 32; ++d) acc[d] = 0.f;
        for (int i = 0; i < SWA_WIN; ++i) {
            const int pos = tt - (SWA_WIN - 1) + i;
            if (pos >= 0) {
                const float s = dot_row64(K + (size_t)pos * 64, q) - slope * (float)(tt - pos);
                osm_update(s, V + (size_t)pos * 64, m, l, acc);
            }
        }
        const float inv = 1.0f / l;
        bf16_t* O = (bf16_t*)(p.ws + WS_O) + (size_t)(b * T + tt) * D + 512 + head * 64 + dh * 32;
#pragma unroll
        for (int c = 0; c < 4; ++c) {
            u32x4 w; w.x = pk2(acc[8 * c] * inv, acc[8 * c + 1] * inv); w.y = pk2(acc[8 * c + 2] * inv, acc[8 * c + 3] * inv);
            w.z = pk2(acc[8 * c + 4] * inv, acc[8 * c + 5] * inv); w.w = pk2(acc[8 * c + 6] * inv, acc[8 * c + 7] * inv);
            *(u32x4*)(O + 8 * c) = w;
        }
    }
}

__device__ __forceinline__ void topk_insert(float v, int i, float (&tv)[16], int (&ti)[16]) {
#pragma unroll
    for (int k = 0; k < 16; ++k) {
        const bool sw = v > tv[k];
        const float ov = tv[k]; const int oi = ti[k];
        tv[k] = sw ? v : ov; ti[k] = sw ? i : oi;
        v = sw ? ov : v; i = sw ? oi : i;
    }
}
__device__ __forceinline__ void phase_peer_sub(const Params& p) {
    const unsigned char* ws = p.ws;
    const long gt = (long)blockIdx.x * NTHREADS + tid_opaque(), ngt = (long)gridDim.x * NTHREADS;
    const long items = (long)NTOK * 16;
    for (long it = gt; it < items; it += ngt) {
        const int tok = (int)(it % NTOK), hc = (int)(it / NTOK);
        const bf16_t* qp = (const bf16_t*)(ws + WS_QP) + (size_t)tok * PQ + hc * 128;
        float q0[64], q1[64];
        load_row64(qp, q0); load_row64(qp + 64, q1);
        const bf16_t* keys = (const bf16_t*)(ws + WS_PKEYS) + (size_t)hc * 128 * 128;
        float tv[16]; int ti[16];
#pragma unroll
        for (int k = 0; k < 16; ++k) { tv[k] = -INFINITY; ti[k] = 0; }
        for (int n = 0; n < 128; ++n) {
            const float s = dot_row64(keys + (size_t)n * 128, q0) + dot_row64(keys + (size_t)n * 128 + 64, q1);
            topk_insert(s, n, tv, ti);
        }
        float* ov = (float*)(p.ws + WS_TOPV2) + ((size_t)tok * 16 + hc) * 16;
        int* oi = (int*)(p.ws + WS_TOPI2) + ((size_t)tok * 16 + hc) * 16;
#pragma unroll
        for (int k = 0; k < 16; ++k) { ov[k] = tv[k]; oi[k] = ti[k]; }
    }
}
__device__ __forceinline__ void phase_peer_comb(const Params& p) {
    const long gt = (long)blockIdx.x * NTHREADS + tid_opaque(), ngt = (long)gridDim.x * NTHREADS;
    const long items = (long)NTOK * PH;
    for (long it = gt; it < items; it += ngt) {
        const int tok = (int)(it / PH), h = (int)(it % PH);
        const float* v1 = (const float*)(p.ws + WS_TOPV2) + ((size_t)tok * 16 + h * 2) * 16;
        const float* v2 = v1 + 16;
        const int* i1 = (const int*)(p.ws + WS_TOPI2) + ((size_t)tok * 16 + h * 2) * 16;
        const int* i2 = i1 + 16;
        float s2[16];
#pragma unroll
        for (int k = 0; k < 16; ++k) s2[k] = v2[k];
        float tv[16]; int ti[16];
#pragma unroll
        for (int k = 0; k < 16; ++k) { tv[k] = -INFINITY; ti[k] = 0; }
        for (int a = 0; a < 16; ++a) {
            const float s1 = v1[a];
#pragma unroll
            for (int bb = 0; bb < 16; ++bb) topk_insert(s1 + s2[bb], a * 16 + bb, tv, ti);
        }
        float e[16], sum = 0.f;
#pragma unroll
        for (int k = 0; k < 16; ++k) { e[k] = __expf(tv[k] - tv[0]); sum += e[k]; }
        const float inv = 1.0f / sum;
        int* eo = (int*)(p.ws + WS_EIDX) + (size_t)tok * 128 + h * 16;
        float* go = (float*)(p.ws + WS_GATE) + (size_t)tok * 128 + h * 16;
#pragma unroll
        for (int k = 0; k < 16; ++k) { const int ci = ti[k]; eo[k] = i1[ci >> 4] * PNK + i2[ci & 15]; go[k] = e[k] * inv; }
    }
}

typedef float f32x2 __attribute__((ext_vector_type(2)));
__device__ __forceinline__ void unpack16_fp8(const u32x4& w, float (&f)[16]) {
#pragma unroll
    for (int q = 0; q < 4; ++q) {
        const f32x2 lo = __builtin_amdgcn_cvt_pk_f32_fp8((int)w[q], false), hi = __builtin_amdgcn_cvt_pk_f32_fp8((int)w[q], true);
        f[4 * q] = lo.x; f[4 * q + 1] = lo.y; f[4 * q + 2] = hi.x; f[4 * q + 3] = hi.y;
    }
}
__device__ __forceinline__ float reduce8(const float (&d)[8], int lane) {
    const bool b5 = lane & 32, b4 = lane & 16, b3 = lane & 8;
    float e[4], f[2];
#pragma unroll
    for (int i = 0; i < 4; ++i) { const float snd = b5 ? d[i] : d[i + 4], keep = b5 ? d[i + 4] : d[i]; e[i] = keep + __shfl_xor(snd, 32); }
#pragma unroll
    for (int i = 0; i < 2; ++i) { const float snd = b4 ? e[i] : e[i + 2], keep = b4 ? e[i + 2] : e[i]; f[i] = keep + __shfl_xor(snd, 16); }
    const float snd = b3 ? f[0] : f[1], keep = b3 ? f[1] : f[0];
    float g = keep + __shfl_xor(snd, 8);
    g += __shfl_xor(g, 4); g += __shfl_xor(g, 2); g += __shfl_xor(g, 1);
    return g;
}
__device__ __forceinline__ void phase_peer_expert(const Params& p) {
    const unsigned char* ws = p.ws;
    const int tid_ = tid_opaque(), lane = tid_ & 63;
    const int gw = (int)blockIdx.x * (NTHREADS / 64) + __builtin_amdgcn_readfirstlane(tid_ >> 6), ngw = (int)gridDim.x * (NTHREADS / 64);
    const unsigned char* U = ws + WS_U8; const unsigned char* V = ws + WS_V8;
    const unsigned loff = 16u * (unsigned)lane;
    for (int tok = gw; tok < NTOK; tok += ngw) {
        const bf16_t* hg = (const bf16_t*)(ws + WS_H1G + (size_t)tok * D * 2) + loff;
        float a[16];
        {
            const u32x4 w0 = *(const u32x4*)hg, w1 = *(const u32x4*)(hg + 8);
            a[0] = bflo(w0.x); a[1] = bfhi(w0.x); a[2] = bflo(w0.y); a[3] = bfhi(w0.y); a[4] = bflo(w0.z); a[5] = bfhi(w0.z); a[6] = bflo(w0.w); a[7] = bfhi(w0.w);
            a[8] = bflo(w1.x); a[9] = bfhi(w1.x); a[10] = bflo(w1.y); a[11] = bfhi(w1.y); a[12] = bflo(w1.z); a[13] = bfhi(w1.z); a[14] = bflo(w1.w); a[15] = bfhi(w1.w);
        }
        const float rstd2 = (1.0f / U8_SCALE) / sqrtf(((const float*)(ws + WS_SS2))[tok] * (1.0f / D) + EPS);
        const int e_lo = ((const int*)(ws + WS_EIDX))[(size_t)tok * 128 + lane], e_hi = ((const int*)(ws + WS_EIDX))[(size_t)tok * 128 + 64 + lane];
        const float g_lo = ((const float*)(ws + WS_GATE))[(size_t)tok * 128 + lane], g_hi = ((const float*)(ws + WS_GATE))[(size_t)tok * 128 + 64 + lane];
        float acc[16];
#pragma unroll
        for (int i = 0; i < 16; ++i) acc[i] = 0.f;
        u32x4 uw[8], vw[8];
#pragma unroll
        for (int k = 0; k < 8; ++k) { const int e = __builtin_amdgcn_readlane(e_lo, k); uw[k] = *(const u32x4*)(U + (size_t)e * D + loff); vw[k] = *(const u32x4*)(V + (size_t)e * D + loff); }
#pragma unroll 1
        for (int b = 0; b < 16; ++b) {
            const int nsrc = (b + 1 < 8) ? e_lo : e_hi; const int nbase = ((b + 1) & 7) * 8;
            float d[8];
#pragma unroll
            for (int k = 0; k < 8; ++k) {
                float uf[16]; unpack16_fp8(uw[k], uf);
                float d0 = 0.f, d1 = 0.f;
#pragma unroll
                for (int i = 0; i < 16; i += 2) { d0 += a[i] * uf[i]; d1 += a[i + 1] * uf[i + 1]; }
                d[k] = d0 + d1;
                __builtin_amdgcn_sched_barrier(0);
            }
            if (b + 1 < 16) {
#pragma unroll
                for (int k = 0; k < 8; ++k) { const int e = __builtin_amdgcn_readlane(nsrc, nbase + k); uw[k] = *(const u32x4*)(U + (size_t)e * D + loff); }
            }
            const float dk = reduce8(d, lane);
            const float gsel = __shfl((b < 8) ? g_lo : g_hi, (b & 7) * 8 + ((lane >> 3) & 7));
            const float w = gsel * gelu_tanh(dk * rstd2);
#pragma unroll
            for (int k = 0; k < 8; ++k) {
                const float wk = __uint_as_float((unsigned)__builtin_amdgcn_readlane((int)__float_as_uint(w), 8 * k));
                float vf[16]; unpack16_fp8(vw[k], vf);
#pragma unroll
                for (int i = 0; i < 16; ++i) acc[i] += wk * vf[i];
                __builtin_amdgcn_sched_barrier(0);
            }
            if (b + 1 < 16) {
#pragma unroll
                for (int k = 0; k < 8; ++k) { const int e = __builtin_amdgcn_readlane(nsrc, nbase + k); vw[k] = *(const u32x4*)(V + (size_t)e * D + loff); }
            }
        }
        float* orow = (float*)((unsigned char*)p.out + (size_t)tok * D * 4) + loff;
        float y[16]; float ss = 0.f;
#pragma unroll
        for (int q = 0; q < 4; ++q) {
            const f32x4 h = *(const f32x4*)(orow + 4 * q);
            y[4 * q] = h.x + acc[4 * q] * (1.0f / V8_SCALE); y[4 * q + 1] = h.y + acc[4 * q + 1] * (1.0f / V8_SCALE);
            y[4 * q + 2] = h.z + acc[4 * q + 2] * (1.0f / V8_SCALE); y[4 * q + 3] = h.w + acc[4 * q + 3] * (1.0f / V8_SCALE);
        }
#pragma unroll
        for (int i = 0; i < 16; ++i) ss += y[i] * y[i];
        const float rstd = 1.0f / sqrtf(wave_sum(ss) * (1.0f / D) + EPS);
#pragma unroll
        for (int q = 0; q < 4; ++q) {
            const f32x4 g = *(const f32x4*)(p.lnf_g + loff + 4 * q);
            *(f32x4*)(orow + 4 * q) = (f32x4){y[4 * q] * rstd * g.x, y[4 * q + 1] * rstd * g.y, y[4 * q + 2] * rstd * g.z, y[4 * q + 3] * rstd * g.w};
        }
    }
}


namespace psel {
#define HD __host__ __device__ __forceinline__
HD unsigned f2ord(float f) { unsigned u = __builtin_bit_cast(unsigned, f); const unsigned m = (unsigned)((int)u >> 31); return u ^ (m | 0x80000000u); }
HD float ord2f(unsigned o) { const unsigned m = (unsigned)((int)o >> 31); return __builtin_bit_cast(float, o ^ (~m | 0x80000000u)); }
HD unsigned umax_(unsigned a, unsigned b) { return a > b ? a : b; }
HD unsigned umin_(unsigned a, unsigned b) { return a < b ? a : b; }
HD void sort16_desc(unsigned (&a)[16]) {
#pragma unroll
    for (int k = 2; k <= 16; k <<= 1)
#pragma unroll
        for (int j = k >> 1; j > 0; j >>= 1)
#pragma unroll
            for (int i = 0; i < 16; ++i) {
                const int l = i ^ j;
                if (l > i) {
                    const bool up = ((i & k) == 0);
                    const unsigned hi = umax_(a[i], a[l]), lo = umin_(a[i], a[l]);
                    a[i] = up ? hi : lo; a[l] = up ? lo : hi;
                }
            }
}
HD void merge16_desc(unsigned (&a)[16], const unsigned (&b)[16]) {
#pragma unroll
    for (int i = 0; i < 16; ++i) a[i] = umax_(a[i], b[15 - i]);
#pragma unroll
    for (int j = 8; j > 0; j >>= 1)
#pragma unroll
        for (int i = 0; i < 16; ++i) {
            const int l = i ^ j;
            if (l > i) { const unsigned hi = umax_(a[i], a[l]), lo = umin_(a[i], a[l]); a[i] = hi; a[l] = lo; }
        }
}
HD void top16_of_64(unsigned (&g0)[16], unsigned (&g1)[16], unsigned (&g2)[16], unsigned (&g3)[16]) {
    sort16_desc(g0); sort16_desc(g1); sort16_desc(g2); sort16_desc(g3);
    merge16_desc(g0, g1); merge16_desc(g2, g3); merge16_desc(g0, g2);
}
struct PairTab { int a[64]; int b[64]; int n; };
constexpr PairTab make_pairs() {
    PairTab t{}; int n = 0;
    for (int a = 0; a < 16; ++a) for (int b = 0; b < 16; ++b) if ((a + 1) * (b + 1) <= 16) { t.a[n] = a; t.b[n] = b; ++n; }
    t.n = n; for (int i = n; i < 64; ++i) { t.a[i] = 0; t.b[i] = 0; }
    return t;
}
#undef HD
typedef float f32x16 __attribute__((ext_vector_type(16)));
#define PLAS __attribute__((address_space(3)))
static constexpr PairTab PT = make_pairs();
__device__ __forceinline__ constexpr int crow_c(int r) { return (r & 3) + 8 * (r >> 2); }
__device__ __forceinline__ void phase_peer_select(const Params& p, unsigned char* lds_generic) {
    const unsigned char* ws = p.ws;
    const int tid = tid_opaque(), lane = tid & 63, wid = __builtin_amdgcn_readfirstlane(tid >> 6), r32 = lane & 31, hi = lane >> 5;
    PLAS int* tab = (PLAS int*)((PLAS unsigned char*)lds_generic) + wid * 2048;
    const int gw = (int)blockIdx.x * (NTHREADS / 64) + wid, ngw = (int)gridDim.x * (NTHREADS / 64);
    const __amdgpu_buffer_rsrc_t rq = __builtin_amdgcn_make_buffer_rsrc((void*)(p.ws + WS_QP), (short)0, (int)((size_t)NTOK * PQ * 2), 0x00020000);
    const __amdgpu_buffer_rsrc_t rk = __builtin_amdgcn_make_buffer_rsrc((void*)(p.ws + WS_PKEYS), (short)0, 16 * 128 * 128 * 2, 0x00020000);
    for (int task = gw; task < (NTOK / 32) * PH; task += ngw) {
        const int tb = task >> 3, h = task & 7, tok = 32 * tb + r32;
        int hi4 = 4 * hi; asm volatile("" : "+v"(hi4));
        unsigned k1[16], k2[16];
#pragma unroll
        for (int c = 0; c < 2; ++c) {
            const int hc = h * 2 + c;
            const unsigned qoff = (unsigned)(r32 * PQ + 8 * hi) * 2u, koff = (unsigned)(r32 * 128 + 8 * hi) * 2u;
            const int qso = (tb * 32 * PQ + hc * 128) * 2, kso = hc * 128 * 128 * 2;
            bf16x8 qf[8];
#pragma unroll
            for (int d0 = 0; d0 < 8; ++d0) qf[d0] = __builtin_bit_cast(bf16x8, __builtin_amdgcn_raw_buffer_load_b128(rq, (int)qoff, qso + 32 * d0, 0));
            unsigned g[4][16];
#pragma unroll
            for (int nt = 0; nt < 4; ++nt) {
                f32x16 acc;
#pragma unroll
                for (int r = 0; r < 16; ++r) acc[r] = 0.f;
#pragma unroll
                for (int d0 = 0; d0 < 8; ++d0) {
                    const bf16x8 kf = __builtin_bit_cast(bf16x8, __builtin_amdgcn_raw_buffer_load_b128(rk, (int)koff, kso + nt * 8192 + 32 * d0, 0));
                    acc = __builtin_amdgcn_mfma_f32_32x32x16_bf16(kf, qf[d0], acc, 0, 0, 0);
                }
#pragma unroll
                for (int r = 0; r < 16; ++r) g[nt][r] = (f2ord(acc[r]) & 0xFFFFFF80u) | (unsigned)((127 - 32 * nt - crow_c(r)) - hi4);
                __builtin_amdgcn_sched_barrier(0);
            }
            top16_of_64(g[0], g[1], g[2], g[3]);
            unsigned pb[16];
#pragma unroll
            for (int i = 0; i < 16; ++i) pb[i] = (unsigned)__shfl_xor((int)g[0][i], 32);
            merge16_desc(g[0], pb);
#pragma unroll
            for (int i = 0; i < 16; ++i) { if (c == 0) k1[i] = g[0][i]; else k2[i] = g[0][i]; }
        }
        float v1[16], v2[16];
#pragma unroll
        for (int i = 0; i < 16; ++i) { v1[i] = ord2f(k1[i] & 0xFFFFFF80u); v2[i] = ord2f(k2[i] & 0xFFFFFF80u); }
        unsigned cg[4][16];
#pragma unroll
        for (int s = 0; s < 64; ++s) {
            unsigned key = 0u;
            if (s < PT.n) key = (f2ord(v1[PT.a[s]] + v2[PT.b[s]]) & 0xFFFFFF00u) | (unsigned)(255 - (PT.a[s] * 16 + PT.b[s]));
            cg[s >> 4][s & 15] = key;
        }
        top16_of_64(cg[0], cg[1], cg[2], cg[3]);
#pragma unroll
        for (int i = 0; i < 16; ++i) { tab[i * 64 + lane] = 127 - (int)(k1[i] & 127u); tab[(16 + i) * 64 + lane] = 127 - (int)(k2[i] & 127u); }
        __builtin_amdgcn_fence(__ATOMIC_RELEASE, "wavefront"); __builtin_amdgcn_wave_barrier();
        int eo[16]; float ge[16]; float gsum = 0.f;
        const float top = ord2f(cg[0][0] & 0xFFFFFF00u);
#pragma unroll
        for (int k = 0; k < 16; ++k) {
            const int ab = 255 - (int)(cg[0][k] & 255u);
            eo[k] = tab[(ab >> 4) * 64 + lane] * PNK + tab[(16 + (ab & 15)) * 64 + lane];
            ge[k] = __expf(ord2f(cg[0][k] & 0xFFFFFF00u) - top); gsum += ge[k];
        }
        __builtin_amdgcn_wave_barrier();
        const float ginv = 1.0f / gsum;
        if (hi == 0) {
            int* eout = (int*)(p.ws + WS_EIDX) + (size_t)tok * 128 + h * 16;
            float* gout = (float*)(p.ws + WS_GATE) + (size_t)tok * 128 + h * 16;
#pragma unroll
            for (int q = 0; q < 4; ++q) {
                *(u32x4*)(eout + 4 * q) = (u32x4){(unsigned)eo[4 * q], (unsigned)eo[4 * q + 1], (unsigned)eo[4 * q + 2], (unsigned)eo[4 * q + 3]};
                *(f32x4*)(gout + 4 * q) = (f32x4){ge[4 * q] * ginv, ge[4 * q + 1] * ginv, ge[4 * q + 2] * ginv, ge[4 * q + 3] * ginv};
            }
        }
    }
}
}

namespace att {
typedef float f32x16 __attribute__((ext_vector_type(16)));
typedef short s16x4 __attribute__((ext_vector_type(4)));
typedef short v4i16_t __attribute__((ext_vector_type(4)));
#define ALAS __attribute__((address_space(3)))
typedef ALAS unsigned char* lptr;
constexpr int L_K = 0, L_V = 16384, L_IMP = 32768, L_SELM = L_IMP + 64 * 129 * 4, L_UNION = L_SELM + 1024, L_WSCR = L_UNION + 16, L_ACC = L_WSCR + 8 * 256, L_END = L_ACC + 8 * 8192;
constexpr float LOG2E = 1.4426950408889634f;
constexpr float THR = 8.0f;
__device__ __forceinline__ constexpr int crow_c(int r) { return (r & 3) + 8 * (r >> 2); }
__device__ __forceinline__ unsigned cvtpk(float lo, float hi) { typedef float f2 __attribute__((ext_vector_type(2))); typedef __bf16 b2 __attribute__((ext_vector_type(2)));
    f2 v = {lo, hi}; b2 b = __builtin_convertvector(v, b2); return __builtin_bit_cast(unsigned, b); }
__device__ __forceinline__ s16x4 vtr(lptr p) { return __builtin_bit_cast(s16x4, __builtin_amdgcn_ds_read_tr16_b64_v4i16((ALAS v4i16_t*)p)); }

struct Stage { u32x4 k, v; };
__device__ __forceinline__ void stage_load(const bf16_t* Kt, const bf16_t* Vt, int wid, int lane, Stage& s, bool withV) {
    s.k = *(const u32x4*)(Kt + (size_t)lane * 64 + wid * 8);
    if (withV) s.v = *(const u32x4*)(Vt + (size_t)(16 * (wid & 3) + (lane >> 2)) * 64 + (wid >> 2) * 32 + (lane & 3) * 8);
}
__device__ __forceinline__ void stage_store(lptr kbuf, lptr vbuf, int wid, int lane, const Stage& s, bool withV) {
    *(ALAS u32x4*)(kbuf + wid * 1024 + lane * 16) = s.k;
    if (withV) *(ALAS u32x4*)(vbuf + wid * 1024 + lane * 16) = s.v;
}
__device__ __forceinline__ void qk_tile(f32x16& p0, f32x16& p1, lptr kbuf, const bf16x8 (&qf)[4], float cb, float sk, int r32, int hi) {
    asm volatile("" : "+v"(sk));
    const float cb2 = cb + sk * (float)(4 * hi);
#pragma unroll
    for (int r = 0; r < 16; ++r) { p0[r] = cb2 + sk * (float)crow_c(r); p1[r] = cb2 + sk * (float)(crow_c(r) + 32); }
    lptr kb = kbuf + hi * 1024 + r32 * 16;
#pragma unroll
    for (int d0 = 0; d0 < 4; ++d0) {
        const bf16x8 k0 = *(const ALAS bf16x8*)(kb + d0 * 2048), k1 = *(const ALAS bf16x8*)(kb + d0 * 2048 + 512);
        p0 = __builtin_amdgcn_mfma_f32_32x32x16_bf16(k0, qf[d0], p0, 0, 0, 0);
        p1 = __builtin_amdgcn_mfma_f32_32x32x16_bf16(k1, qf[d0], p1, 0, 0, 0);
    }
}
__device__ __forceinline__ void mask_tile(f32x16& p0, f32x16& p1, int hi_lim, int lo_lim, int hi) {
    int hl = hi_lim - 4 * hi, ll1 = lo_lim + 1 - 4 * hi;
    asm volatile("" : "+v"(hl), "+v"(ll1));
#pragma unroll
    for (int r = 0; r < 16; ++r) {
        const int c0 = crow_c(r), c1 = crow_c(r) + 32;
        const unsigned t0 = (unsigned)((c0 - ll1) | (hl - c0)), t1 = (unsigned)((c1 - ll1) | (hl - c1));
        p0[r] = fminf(p0[r], __uint_as_float((t0 & 0x80000000u) | 0x7f800000u));
        p1[r] = fminf(p1[r], __uint_as_float((t1 & 0x80000000u) | 0x7f800000u));
    }
}
__device__ __forceinline__ float tile_max(const f32x16& p0, const f32x16& p1) {
    float a = fmaxf(p0[0], p1[0]);
#pragma unroll
    for (int r = 1; r < 16; ++r) a = fmaxf(a, fmaxf(p0[r], p1[r]));
    return fmaxf(a, __shfl_xor(a, 32));
}
__device__ __forceinline__ float tile_sum(const f32x16& p0, const f32x16& p1) {
    float a = p0[0] + p1[0];
#pragma unroll
    for (int r = 1; r < 16; ++r) a += p0[r] + p1[r];
    return a + __shfl_xor(a, 32);
}
__device__ __forceinline__ void pv_tile(f32x16& o0, f32x16& o1, const f32x16& p0, const f32x16& p1, lptr vbuf, int lane, int hi) {
    u32x4 pw[4];
    pw[0] = (u32x4){cvtpk(p0[0], p0[1]), cvtpk(p0[2], p0[3]), cvtpk(p0[4], p0[5]), cvtpk(p0[6], p0[7])};
    pw[1] = (u32x4){cvtpk(p0[8], p0[9]), cvtpk(p0[10], p0[11]), cvtpk(p0[12], p0[13]), cvtpk(p0[14], p0[15])};
    pw[2] = (u32x4){cvtpk(p1[0], p1[1]), cvtpk(p1[2], p1[3]), cvtpk(p1[4], p1[5]), cvtpk(p1[6], p1[7])};
    pw[3] = (u32x4){cvtpk(p1[8], p1[9]), cvtpk(p1[10], p1[11]), cvtpk(p1[12], p1[13]), cvtpk(p1[14], p1[15])};
    lptr vp = vbuf + ((lane >> 4) & 1) * 32 + (lane & 3) * 8 + (4 * hi + ((lane & 15) >> 2)) * 64;
#pragma unroll
    for (int ks = 0; ks < 4; ++ks) {
        const s16x4 a = vtr(vp + ks * 1024), b = vtr(vp + ks * 1024 + 512);
        const s16x4 c = vtr(vp + 4096 + ks * 1024), d = vtr(vp + 4096 + ks * 1024 + 512);
        const bf16x8 v0 = (bf16x8){a[0], a[1], a[2], a[3], b[0], b[1], b[2], b[3]}, v1 = (bf16x8){c[0], c[1], c[2], c[3], d[0], d[1], d[2], d[3]};
        const bf16x8 pa = __builtin_bit_cast(bf16x8, pw[ks]);
        o0 = __builtin_amdgcn_mfma_f32_32x32x16_bf16(pa, v0, o0, 0, 0, 0);
        o1 = __builtin_amdgcn_mfma_f32_32x32x16_bf16(pa, v1, o1, 0, 0, 0);
    }
}
__device__ __forceinline__ void scale_rows(f32x16& o0, f32x16& o1, float f, ALAS float* wscr, int r32, int hi) {
    if (hi == 0) wscr[r32] = f;
    __builtin_amdgcn_fence(__ATOMIC_RELEASE, "wavefront"); __builtin_amdgcn_wave_barrier();
#pragma unroll
    for (int r = 0; r < 16; ++r) { const float a = wscr[crow_c(r) + 4 * hi]; o0[r] *= a; o1[r] *= a; }
    __builtin_amdgcn_wave_barrier();
}
template <bool FIRST>
__device__ __forceinline__ void acc_rows(ALAS float* accw, const f32x16& o0, const f32x16& o1, float f, ALAS float* wscr, int r32, int hi) {
    if (hi == 0) wscr[r32] = f;
    __builtin_amdgcn_fence(__ATOMIC_RELEASE, "wavefront"); __builtin_amdgcn_wave_barrier();
#pragma unroll
    for (int r = 0; r < 16; ++r) {
        const int row = crow_c(r) + 4 * hi; const float a = wscr[row];
        ALAS float* d = accw + row * 64 + r32;
        if (FIRST) { d[0] = o0[r] * a; d[32] = o1[r] * a; } else { d[0] += o0[r] * a; d[32] += o1[r] * a; }
    }
    __builtin_amdgcn_wave_barrier();
}
__device__ __forceinline__ void store_acc(ALAS float* accw, bf16_t* O, int lane) {
    __builtin_amdgcn_fence(__ATOMIC_RELEASE, "wavefront"); __builtin_amdgcn_wave_barrier();
#pragma unroll
    for (int it = 0; it < 4; ++it) {
        const int item = it * 64 + lane, row = item >> 3, ch = item & 7;
        const f32x4 x = *(const ALAS f32x4*)(accw + row * 64 + ch * 8), y = *(const ALAS f32x4*)(accw + row * 64 + ch * 8 + 4);
        u32x4 w; w.x = cvtpk(x[0], x[1]); w.y = cvtpk(x[2], x[3]); w.z = cvtpk(y[0], y[1]); w.w = cvtpk(y[2], y[3]);
        *(u32x4*)(O + (size_t)(row & 7) * D + (row >> 3) * 64 + ch * 8) = w;
    }
    __builtin_amdgcn_wave_barrier();
}
struct Br { float m, l; f32x16 o0, o1; };
template <bool MASK>
__device__ __forceinline__ void attend_tile(Br& s, lptr kbuf, lptr vbuf, const bf16x8 (&qf)[4], float cb, float sk, int hi_lim, int lo_lim, ALAS float* wscr, int lane, int r32, int hi) {
    f32x16 p0, p1;
    qk_tile(p0, p1, kbuf, qf, cb, sk, r32, hi);
    if (MASK) mask_tile(p0, p1, hi_lim, lo_lim, hi);
    const float rm = tile_max(p0, p1);
    if (__any(rm > s.m + THR)) {
        const float mn = fmaxf(s.m, rm), alpha = __expf(s.m - mn);
        s.l *= alpha; s.m = mn;
        scale_rows(s.o0, s.o1, alpha, wscr, r32, hi);
    }
    const float mL = s.m * LOG2E;
#pragma unroll
    for (int r = 0; r < 16; ++r) { p0[r] = __builtin_amdgcn_exp2f(p0[r] * LOG2E - mL); p1[r] = __builtin_amdgcn_exp2f(p1[r] * LOG2E - mL); }
    s.l += tile_sum(p0, p1);
    pv_tile(s.o0, s.o1, p0, p1, vbuf, lane, hi);
}

__device__ __forceinline__ void nsa_unit(const Params& p, unsigned char* lds_generic, int b, int g, int tile) {
    lptr lds = (lptr)lds_generic;
    const int tid = tid_opaque(), lane = tid & 63, wid = __builtin_amdgcn_readfirstlane(tid >> 6), r32 = lane & 31, hi = lane >> 5;
    const int h = r32 >> 3, qi = r32 & 7, tq = 8 * wid + qi, t = 64 * tile + tq, head = g * 4 + h;
    const float slope = exp2f(-0.5f * (float)(9 + head));
    const unsigned char* ws = p.ws;
    ALAS float* imp = (ALAS float*)(lds + L_IMP);
    ALAS unsigned* selm = (ALAS unsigned*)(lds + L_SELM);
    ALAS unsigned* uni = (ALAS unsigned*)(lds + L_UNION);
    ALAS float* wscr = (ALAS float*)(lds + L_WSCR) + wid * 64;
    const bf16_t* KC = (const bf16_t*)(ws + WS_KC) + (size_t)(b * 2 + g) * NCMPP * 64;
    const bf16_t* VC = (const bf16_t*)(ws + WS_VC) + (size_t)(b * 2 + g) * NCMPP * 64;
    const bf16_t* KS = (const bf16_t*)(ws + WS_KV6 + 2 * KV6_STRIDE) + (size_t)(b * 2 + g) * T * 64;
    const bf16_t* VS = (const bf16_t*)(ws + WS_KV6 + 3 * KV6_STRIDE) + (size_t)(b * 2 + g) * T * 64;
    const bf16_t* KW = (const bf16_t*)(ws + WS_KV6 + 4 * KV6_STRIDE) + (size_t)(b * 2 + g) * T * 64;
    const bf16_t* VW = (const bf16_t*)(ws + WS_KV6 + 5 * KV6_STRIDE) + (size_t)(b * 2 + g) * T * 64;
    const float* gs = (const float*)(ws + WS_GSIG) + (size_t)(b * T + t) * 24 + head * 3;
    bf16x8 qf[4];
    {
        const bf16_t* qp = (const bf16_t*)(ws + WS_QN) + ((size_t)(b * 8 + head) * T + t) * 64 + 8 * hi;
#pragma unroll
        for (int d0 = 0; d0 < 4; ++d0) qf[d0] = *(const bf16x8*)(qp + 16 * d0);
    }
    for (int i = tid; i < 64 * 129; i += NTHREADS) imp[i] = 0.f;
    if (tid < 4) uni[tid] = 0u;
    ALAS float* accw = (ALAS float*)(lds + L_ACC) + wid * 2048;
    Stage st;
    const int nc = 4 * tile + 3, nct = (nc + 63) >> 6;
    const int cmax = (t >= 31) ? ((t - 31) >> 4) : -1;
    const float skc = 16.0f * slope, cbc = -slope * (float)(t - 31);
    float mc = -1e30f, lc = 0.f;
    stage_load(KC, VC, wid, lane, st, false);
    stage_store(lds + L_K, lds + L_V, wid, lane, st, false);
    __syncthreads();
    for (int i = 0; i < nct; ++i) {
        const int cur = i & 1;
        if (i + 1 < nct) stage_load(KC + (size_t)(i + 1) * 64 * 64, VC, wid, lane, st, false);
        f32x16 p0, p1;
        qk_tile(p0, p1, lds + L_K + cur * 8192, qf, cbc + skc * (float)(64 * i), skc, r32, hi);
        mask_tile(p0, p1, cmax - 64 * i, -1, hi);
        const float rm = tile_max(p0, p1), mn = fmaxf(mc, rm), mL = mn * LOG2E;
#pragma unroll
        for (int r = 0; r < 16; ++r) { p0[r] = __builtin_amdgcn_exp2f(p0[r] * LOG2E - mL); p1[r] = __builtin_amdgcn_exp2f(p1[r] * LOG2E - mL); }
        lc = lc * __expf(mc - mn) + tile_sum(p0, p1); mc = mn;
        if (i + 1 < nct) stage_store(lds + L_K + (cur ^ 1) * 8192, lds + L_V, wid, lane, st, false);
        __syncthreads();
    }
    {
        const float invl = 1.0f / fmaxf(lc, 1e-30f), mL = mc * LOG2E;
        Br sc; sc.m = 0.f; sc.l = 0.f;
#pragma unroll
        for (int r = 0; r < 16; ++r) { sc.o0[r] = 0.f; sc.o1[r] = 0.f; }
        stage_load(KC, VC, wid, lane, st, true);
        stage_store(lds + L_K, lds + L_V, wid, lane, st, true);
        __syncthreads();
        for (int i = 0; i < nct; ++i) {
            const int cur = i & 1;
            if (i + 1 < nct) stage_load(KC + (size_t)(i + 1) * 64 * 64, VC + (size_t)(i + 1) * 64 * 64, wid, lane, st, true);
            f32x16 p0, p1;
            qk_tile(p0, p1, lds + L_K + cur * 8192, qf, cbc + skc * (float)(64 * i), skc, r32, hi);
            mask_tile(p0, p1, cmax - 64 * i, -1, hi);
#pragma unroll
            for (int r = 0; r < 16; ++r) { p0[r] = __builtin_amdgcn_exp2f(p0[r] * LOG2E - mL) * invl; p1[r] = __builtin_amdgcn_exp2f(p1[r] * LOG2E - mL) * invl; }
            pv_tile(sc.o0, sc.o1, p0, p1, lds + L_V + cur * 8192, lane, hi);
#pragma unroll
            for (int kh = 0; kh < 2; ++kh)
#pragma unroll
                for (int gq = 0; gq < 4; ++gq) {
                    const float e3 = kh ? p1[4 * gq + 3] : p0[4 * gq + 3];
                    float s4 = kh ? ((p1[4 * gq] + p1[4 * gq + 1]) + (p1[4 * gq + 2] + e3)) : ((p0[4 * gq] + p0[4 * gq + 1]) + (p0[4 * gq + 2] + e3));
                    float e = e3;
                    s4 += __shfl_xor(s4, 8); e += __shfl_xor(e, 8);
                    s4 += __shfl_xor(s4, 16); e += __shfl_xor(e, 16);
                    const int sb = 16 * i + 8 * kh + 2 * gq + hi;
                    if (r32 < 8) { atomicAdd((float*)(imp + tq * 129 + sb), s4); if (sb + 1 < NSEL) atomicAdd((float*)(imp + tq * 129 + sb + 1), e); }
                }
            if (i + 1 < nct) stage_store(lds + L_K + (cur ^ 1) * 8192, lds + L_V + (cur ^ 1) * 8192, wid, lane, st, true);
            __syncthreads();
        }
        acc_rows<true>(accw, sc.o0, sc.o1, gs[0], wscr, r32, hi);
    }
    {
        const int q = tid >> 3, sub = tid & 7;
        float v[16];
#pragma unroll
        for (int i = 0; i < 16; ++i) {
            const int j = sub * 16 + i; float x = imp[q * 129 + j];
            if (j == 0 || j == tile || j == tile - 1) x = 1.0e4f;
            if (j > tile) x = -INFINITY;
            v[i] = x;
        }
        unsigned w0 = 0u, w1 = 0u, w2 = 0u, w3 = 0u;
        for (int it = 0; it < TOPN; ++it) {
            float best = v[0]; int bi = 0;
#pragma unroll
            for (int i = 1; i < 16; ++i) if (v[i] > best) { best = v[i]; bi = i; }
            int bj = sub * 16 + bi;
#pragma unroll
            for (int off = 1; off < 8; off <<= 1) {
                const float ob = __shfl_xor(best, off); const int oj = __shfl_xor(bj, off);
                const bool take = (ob > best) || (ob == best && oj < bj);
                best = take ? ob : best; bj = take ? oj : bj;
            }
            if (best > -INFINITY) {
                const int k = bj >> 5; const unsigned bit = 1u << (bj & 31);
                w0 |= (k == 0) ? bit : 0u; w1 |= (k == 1) ? bit : 0u; w2 |= (k == 2) ? bit : 0u; w3 |= (k == 3) ? bit : 0u;
                const int own = bj - sub * 16;
#pragma unroll
                for (int i = 0; i < 16; ++i) v[i] = (i == own) ? -INFINITY : v[i];
            }
        }
        if (sub == 0) {
            selm[q * 4 + 0] = w0; selm[q * 4 + 1] = w1; selm[q * 4 + 2] = w2; selm[q * 4 + 3] = w3;
            atomicOr((unsigned*)(uni + 0), w0); atomicOr((unsigned*)(uni + 1), w1); atomicOr((unsigned*)(uni + 2), w2); atomicOr((unsigned*)(uni + 3), w3);
        }
    }
    __syncthreads();
    {
        unsigned u0 = uni[0], u1 = uni[1], u2 = uni[2], u3 = uni[3];
        u0 = __builtin_amdgcn_readfirstlane(u0); u1 = __builtin_amdgcn_readfirstlane(u1); u2 = __builtin_amdgcn_readfirstlane(u2); u3 = __builtin_amdgcn_readfirstlane(u3);
        const unsigned s0 = selm[tq * 4 + 0], s1 = selm[tq * 4 + 1], s2 = selm[tq * 4 + 2], s3 = selm[tq * 4 + 3];
        Br sb_; sb_.m = -1e30f; sb_.l = 0.f;
#pragma unroll
        for (int r = 0; r < 16; ++r) { sb_.o0[r] = 0.f; sb_.o1[r] = 0.f; }
#define POP_BLOCK(j) do { if (u3) { const int bb = 31 - __builtin_clz(u3); u3 ^= 1u << bb; j = 96 + bb; } else if (u2) { const int bb = 31 - __builtin_clz(u2); u2 ^= 1u << bb; j = 64 + bb; } \
        else if (u1) { const int bb = 31 - __builtin_clz(u1); u1 ^= 1u << bb; j = 32 + bb; } else if (u0) { const int bb = 31 - __builtin_clz(u0); u0 ^= 1u << bb; j = bb; } else j = -1; } while (0)
        int j; POP_BLOCK(j);
        if (j >= 0) {
            stage_load(KS + (size_t)j * 64 * 64, VS + (size_t)j * 64 * 64, wid, lane, st, true);
            stage_store(lds + L_K, lds + L_V, wid, lane, st, true);
        }
        __syncthreads();
        int cur = 0;
        while (j >= 0) {
            int jn; POP_BLOCK(jn);
            if (jn >= 0) stage_load(KS + (size_t)jn * 64 * 64, VS + (size_t)jn * 64 * 64, wid, lane, st, true);
            const unsigned wsel = (j >> 5) == 0 ? s0 : (j >> 5) == 1 ? s1 : (j >> 5) == 2 ? s2 : s3;
            const bool mine = (wsel >> (j & 31)) & 1u;
            if (__any(mine)) {
                const int hl = mine ? ((j == tile) ? tq : 63) : -1;
                const float cb = -slope * (float)(t - 64 * j);
                attend_tile<true>(sb_, lds + L_K + cur * 8192, lds + L_V + cur * 8192, qf, cb, slope, hl, -1, wscr, lane, r32, hi);
            }
            if (jn >= 0) stage_store(lds + L_K + (cur ^ 1) * 8192, lds + L_V + (cur ^ 1) * 8192, wid, lane, st, true);
            __syncthreads();
            cur ^= 1; j = jn;
        }
#undef POP_BLOCK
        acc_rows<false>(accw, sb_.o0, sb_.o1, gs[1] / fmaxf(sb_.l, 1e-30f), wscr, r32, hi);
    }
    {
        Br sw; sw.m = -1e30f; sw.l = 0.f;
#pragma unroll
        for (int r = 0; r < 16; ++r) { sw.o0[r] = 0.f; sw.o1[r] = 0.f; }
        const int jlo = (tile - 8 > 0) ? tile - 8 : 0;
        stage_load(KW + (size_t)tile * 64 * 64, VW + (size_t)tile * 64 * 64, wid, lane, st, true);
        stage_store(lds + L_K, lds + L_V, wid, lane, st, true);
        __syncthreads();
        int cur = 0;
        for (int j = tile; j >= jlo; --j) {
            if (j > jlo) stage_load(KW + (size_t)(j - 1) * 64 * 64, VW + (size_t)(j - 1) * 64 * 64, wid, lane, st, true);
            const float cb = -slope * (float)(t - 64 * j);
            if (j == tile) attend_tile<true>(sw, lds + L_K + cur * 8192, lds + L_V + cur * 8192, qf, cb, slope, tq, -1, wscr, lane, r32, hi);
            else if (j == tile - 8) attend_tile<true>(sw, lds + L_K + cur * 8192, lds + L_V + cur * 8192, qf, cb, slope, 63, tq, wscr, lane, r32, hi);
            else attend_tile<false>(sw, lds + L_K + cur * 8192, lds + L_V + cur * 8192, qf, cb, slope, 63, -1, wscr, lane, r32, hi);
            if (j > jlo) stage_store(lds + L_K + (cur ^ 1) * 8192, lds + L_V + (cur ^ 1) * 8192, wid, lane, st, true);
            __syncthreads();
            cur ^= 1;
        }
        acc_rows<false>(accw, sw.o0, sw.o1, gs[2] / fmaxf(sw.l, 1e-30f), wscr, r32, hi);
    }
    store_acc(accw, (bf16_t*)(p.ws + WS_O) + (size_t)(b * T + 64 * tile + 8 * wid) * D + g * 256, lane);
}

__device__ __forceinline__ void swa_unit(const Params& p, unsigned char* lds_generic, int b, int hh, int tile) {
    lptr lds = (lptr)lds_generic;
    const int tid = tid_opaque(), lane = tid & 63, wid = __builtin_amdgcn_readfirstlane(tid >> 6), r32 = lane & 31, hi = lane >> 5;
    const int h = r32 >> 3, qi = r32 & 7, tq = 8 * wid + qi, t = 64 * tile + tq, head = hh * 4 + h;
    const float slope = exp2f(-0.5f * (float)(head + 1));
    const unsigned char* ws = p.ws;
    ALAS float* wscr = (ALAS float*)(lds + L_WSCR) + wid * 64;
    const bf16_t* K = (const bf16_t*)(ws + WS_KSW) + (size_t)b * T * 64;
    const bf16_t* V = (const bf16_t*)(ws + WS_VSW) + (size_t)b * T * 64;
    bf16x8 qf[4];
    {
        const bf16_t* qp = (const bf16_t*)(ws + WS_QS) + ((size_t)(b * 8 + head) * T + t) * 64 + 8 * hi;
#pragma unroll
        for (int d0 = 0; d0 < 4; ++d0) qf[d0] = *(const bf16x8*)(qp + 16 * d0);
    }
    Br sw; sw.m = p.sinks[head]; sw.l = 1.0f;
#pragma unroll
    for (int r = 0; r < 16; ++r) { sw.o0[r] = 0.f; sw.o1[r] = 0.f; }
    Stage st;
    const int jlo = (tile - 2 > 0) ? tile - 2 : 0;
    stage_load(K + (size_t)tile * 64 * 64, V + (size_t)tile * 64 * 64, wid, lane, st, true);
    stage_store(lds + L_K, lds + L_V, wid, lane, st, true);
    __syncthreads();
    int cur = 0;
    for (int j = tile; j >= jlo; --j) {
        if (j > jlo) stage_load(K + (size_t)(j - 1) * 64 * 64, V + (size_t)(j - 1) * 64 * 64, wid, lane, st, true);
        const float cb = -slope * (float)(t - 64 * j);
        if (j == tile) attend_tile<true>(sw, lds + L_K + cur * 8192, lds + L_V + cur * 8192, qf, cb, slope, tq, -1, wscr, lane, r32, hi);
        else if (j == tile - 2) attend_tile<true>(sw, lds + L_K + cur * 8192, lds + L_V + cur * 8192, qf, cb, slope, 63, tq, wscr, lane, r32, hi);
        else attend_tile<false>(sw, lds + L_K + cur * 8192, lds + L_V + cur * 8192, qf, cb, slope, 63, -1, wscr, lane, r32, hi);
        if (j > jlo) stage_store(lds + L_K + (cur ^ 1) * 8192, lds + L_V + (cur ^ 1) * 8192, wid, lane, st, true);
        __syncthreads();
        cur ^= 1;
    }
    ALAS float* accw = (ALAS float*)(lds + L_ACC) + wid * 2048;
    acc_rows<true>(accw, sw.o0, sw.o1, 1.0f / sw.l, wscr, r32, hi);
    store_acc(accw, (bf16_t*)(p.ws + WS_O) + (size_t)(b * T + 64 * tile + 8 * wid) * D + 512 + hh * 256, lane);
}
__device__ __forceinline__ void phase_swa_mfma(const Params& p, unsigned char* lds) {
    for (int u = blockIdx.x; u < BATCH * 2 * (T / 64); u += gridDim.x) swa_unit(p, lds, u >> 8, (u >> 7) & 1, u & 127);
}
__device__ __forceinline__ void phase_nsa_mfma(const Params& p, unsigned char* lds) {
    const int nu = BATCH * NSA_G * (T / 64);
    for (int i = blockIdx.x; i < nu; i += gridDim.x) {
        const int u = (i < (int)gridDim.x) ? (nu - 1 - i) : (i - (int)gridDim.x);
        nsa_unit(p, lds, u >> 8, (u >> 7) & 1, u & 127);
    }
}
}


namespace cmp {
#define CLAS __attribute__((address_space(3)))
constexpr int HS = 264;
__device__ __forceinline__ void compress_unit(const Params& p, unsigned char* lds_generic, int unit) {
    const unsigned char* ws = p.ws;
    const int tid = tid_opaque(), lane = tid & 63, wid = __builtin_amdgcn_readfirstlane(tid >> 6), fr = lane & 15, fq = lane >> 4;
    const int row0 = unit * 32, kv = row0 >> 11, bg = (row0 & 2047) >> 9, c0 = row0 & 511;
    const bf16_t* raw = (const bf16_t*)(ws + WS_KV6 + (size_t)kv * KV6_STRIDE) + (size_t)bg * T * 64;
    const bf16_t* W1T = (const bf16_t*)(ws + WS_W1T) + (size_t)kv * 256 * 2048;
    const bf16_t* W2T = (const bf16_t*)(ws + WS_W2T) + (size_t)kv * 64 * 256;
    const float* b1 = (const float*)(ws + WS_B1) + kv * 256;
    CLAS bf16_t* H = (CLAS bf16_t*)((CLAS unsigned char*)lds_generic);
    const int n0 = wid * 32;
    f32x4 acc[2][2];
#pragma unroll
    for (int i = 0; i < 2; ++i)
#pragma unroll
        for (int j = 0; j < 2; ++j) acc[i][j] = (f32x4){0.f, 0.f, 0.f, 0.f};
    const bf16_t* ap = raw + (size_t)(c0 + fr) * 1024 + fq * 8;
    const bf16_t* bp = W1T + (size_t)(n0 + fr) * 2048 + fq * 8;
    bf16x8 a[2], b[2], an[2], bn[2];
#pragma unroll
    for (int i = 0; i < 2; ++i) { a[i] = *(const bf16x8*)(ap + (size_t)i * 16 * 1024); b[i] = *(const bf16x8*)(bp + (size_t)i * 16 * 2048); }
    for (int k0 = 0; k0 < 2048; k0 += 32) {
        if (k0 + 32 < 2048) {
#pragma unroll
            for (int i = 0; i < 2; ++i) { an[i] = *(const bf16x8*)(ap + (size_t)i * 16 * 1024 + k0 + 32); bn[i] = *(const bf16x8*)(bp + (size_t)i * 16 * 2048 + k0 + 32); }
        }
#pragma unroll
        for (int i = 0; i < 2; ++i)
#pragma unroll
            for (int j = 0; j < 2; ++j) acc[i][j] = __builtin_amdgcn_mfma_f32_16x16x32_bf16(a[i], b[j], acc[i][j], 0, 0, 0);
#pragma unroll
        for (int i = 0; i < 2; ++i) { a[i] = an[i]; b[i] = bn[i]; }
    }
#pragma unroll
    for (int i = 0; i < 2; ++i)
#pragma unroll
        for (int j = 0; j < 2; ++j) {
            const int n = n0 + 16 * j + fr; const float bias = b1[n];
#pragma unroll
            for (int r = 0; r < 4; ++r) H[(16 * i + 4 * fq + r) * HS + n] = (bf16_t)f2bf(gelu_tanh(acc[i][j][r] + bias));
        }
    __syncthreads();
    {
        const int mi = wid >> 2, nj = wid & 3;
        f32x4 o = (f32x4){0.f, 0.f, 0.f, 0.f};
        const CLAS bf16_t* hp = H + (16 * mi + fr) * HS + fq * 8;
        const bf16_t* wp = W2T + (size_t)(16 * nj + fr) * 256 + fq * 8;
#pragma unroll
        for (int k0 = 0; k0 < 256; k0 += 32) {
            const bf16x8 ha = *(const CLAS bf16x8*)(hp + k0), wb = *(const bf16x8*)(wp + k0);
            o = __builtin_amdgcn_mfma_f32_16x16x32_bf16(ha, wb, o, 0, 0, 0);
        }
        bf16_t* dst = (bf16_t*)(p.ws + (kv ? WS_VC : WS_KC)) + ((size_t)bg * NCMPP + c0 + 16 * mi + 4 * fq) * 64 + 16 * nj + fr;
#pragma unroll
        for (int r = 0; r < 4; ++r) dst[(size_t)r * 64] = (bf16_t)f2bf(o[r]);
    }
    __syncthreads();
}
__device__ __forceinline__ void phase_compress_swa(const Params& p, unsigned char* lds) {
    const int G = (int)gridDim.x, bx = (int)blockIdx.x;
    if (G >= 256) {
        if (bx < 128) { compress_unit(p, lds, bx); }
        else { for (int u = bx - 128; u < BATCH * 2 * (T / 64); u += G - 128) att::swa_unit(p, lds, u >> 8, (u >> 7) & 1, u & 127); }
    } else {
        for (int u = bx; u < 128; u += G) compress_unit(p, lds, u);
        for (int u = bx; u < BATCH * 2 * (T / 64); u += G) att::swa_unit(p, lds, u >> 8, (u >> 7) & 1, u & 127);
    }
}
}

constexpr int LDS_BYTES = 147456;
extern __shared__ __attribute__((aligned(16))) unsigned char dyn_lds[];

__device__ __forceinline__ Params load_params() {
#if !defined(__HIP_DEVICE_COMPILE__)
    return Params{};
#else
    const __attribute__((address_space(4))) unsigned char* ka = (const __attribute__((address_space(4))) unsigned char*)__builtin_amdgcn_kernarg_segment_ptr();
    asm volatile("" : "+s"(ka));
    const __attribute__((address_space(4))) Params* kp = (const __attribute__((address_space(4))) Params*)ka;
    Params r;
    r.x = kp->x; r.ln1_g = kp->ln1_g; r.w_in = kp->w_in; r.pe_k = kp->pe_k; r.w1_k = kp->w1_k; r.w2_k = kp->w2_k; r.pe_v = kp->pe_v; r.w1_v = kp->w1_v; r.w2_v = kp->w2_v;
    r.sinks = kp->sinks; r.w_out = kp->w_out; r.ln2_g = kp->ln2_g; r.wq = kp->wq; r.pkeys = kp->pkeys; r.pu = kp->pu; r.pv = kp->pv; r.lnf_g = kp->lnf_g; r.out = kp->out; r.ws = kp->ws;
    return r;
#endif
}
__global__ void __launch_bounds__(NTHREADS, 2) fwd_megakernel(Params p_unused) {
    cg::grid_group grid = cg::this_grid();
    float* lds = (float*)dyn_lds;
    PG8_LAS unsigned char* ldsp = (PG8_LAS unsigned char*)dyn_lds;
    for (int rep = 0; rep < 1 + PROBE_PREP; ++rep) { const Params p = load_params(); phase_prep(p); }
    grid.sync();
    { const Params p = load_params();
      pg8::Gemm g{(const bf16_t*)(p.ws + WS_XN), (const bf16_t*)(p.ws + WS_WIN), NTOK, DINP, D}; pg8::StaticOrder S; S.init(NTOK, DINP, (int)gridDim.x, (int)blockIdx.x);
      EpiProjT E{p.ws}; pg8::gemm_phase<EpiProjT, pg8::StaticOrder, true, true>(ldsp, g, S, E); }
    grid.sync();
    { const Params p = load_params(); cmp::phase_compress_swa(p, dyn_lds); }
    grid.sync();
    for (int rep = 0; rep < 1 + PROBE_NSA; ++rep) { const Params p = load_params(); att::phase_nsa_mfma(p, dyn_lds); }
    grid.sync();
    { const Params p = load_params();
      pg8::Gemm g{(const bf16_t*)(p.ws + WS_O), (const bf16_t*)(p.ws + WS_WOUT), NTOK, D, D}; pg8::StaticOrder S; S.init(NTOK, D, (int)gridDim.x, (int)blockIdx.x);
      EpiOutT E{p.x, p.ln2_g, p.out, (bf16_t*)(p.ws + WS_H1G), (float*)(p.ws + WS_SS2)}; pg8::gemm_phase<EpiOutT, pg8::StaticOrder, true, true>(ldsp, g, S, E); }
    grid.sync();
    { const Params p = load_params();
      pg8::Gemm g{(const bf16_t*)(p.ws + WS_H1G), (const bf16_t*)(p.ws + WS_WQ), NTOK, PQ, D}; pg8::StaticOrder S; S.init(NTOK, PQ, (int)gridDim.x, (int)blockIdx.x);
      EpiQPT E{(const float*)(p.ws + WS_SS2), (bf16_t*)(p.ws + WS_QP)}; pg8::gemm_phase<EpiQPT, pg8::StaticOrder, true, true>(ldsp, g, S, E); }
    grid.sync();
    { const Params p = load_params(); psel::phase_peer_select(p, dyn_lds); }
    grid.sync();
    { const Params p = load_params(); phase_peer_expert(p); }
}

extern "C" void kernel_launch(void* const* d_in, const int* in_sizes, int n_in, void* d_out, int out_size, void* d_ws, size_t ws_size, hipStream_t stream) {
    if (n_in != 17 || ws_size < WS_END) { fprintf(stderr, "kernel_launch: unexpected inputs (n_in %d, ws %zu)\n", n_in, ws_size); return; }
    static int grid_blocks = 0;
    if (!grid_blocks) {
        int dev = 0, cus = 0, per_cu = 0;
        (void)hipGetDevice(&dev);
        (void)hipDeviceGetAttribute(&cus, hipDeviceAttributeMultiprocessorCount, dev);
        (void)hipFuncSetAttribute((const void*)fwd_megakernel, hipFuncAttributeMaxDynamicSharedMemorySize, LDS_BYTES);
        (void)hipOccupancyMaxActiveBlocksPerMultiprocessor(&per_cu, (const void*)fwd_megakernel, NTHREADS, LDS_BYTES);
        if (per_cu < 1) per_cu = 1;
        grid_blocks = cus * per_cu;
        fprintf(stderr, "kernel_launch: %d CUs x %d blocks/CU\n", cus, per_cu);
    }
    Params p{};
    p.x = (const float*)d_in[0]; p.ln1_g = (const float*)d_in[1]; p.w_in = (const float*)d_in[2];
    p.pe_k = (const float*)d_in[3]; p.w1_k = (const float*)d_in[4]; p.w2_k = (const float*)d_in[5];
    p.pe_v = (const float*)d_in[6]; p.w1_v = (const float*)d_in[7]; p.w2_v = (const float*)d_in[8];
    p.sinks = (const float*)d_in[9]; p.w_out = (const float*)d_in[10]; p.ln2_g = (const float*)d_in[11];
    p.wq = (const float*)d_in[12]; p.pkeys = (const float*)d_in[13]; p.pu = (const float*)d_in[14]; p.pv = (const float*)d_in[15];
    p.lnf_g = (const float*)d_in[16];
    p.out = (float*)d_out; p.ws = (unsigned char*)d_ws;
    void* args[] = {&p};
    hipError_t e = hipLaunchCooperativeKernel((void*)fwd_megakernel, dim3(grid_blocks), dim3(NTHREADS), args, LDS_BYTES, stream);
    if (e != hipSuccess) fprintf(stderr, "cooperative launch failed: %s (grid %d)\n", hipGetErrorString(e), grid_blocks);
}
```

```cpp
#include <hip/hip_runtime.h>
#include <hip/hip_cooperative_groups.h>
#include <cstdint>
#include <cstdio>
namespace cg = cooperative_groups;
#define PROBE_PREP 0
#define PROBE_COMPRESS 0
#define PROBE_SWA 0
#define PROBE_NSA 0
#define PROBE_SUB 0
#define PROBE_COMB 0
#define PROBE_PEXU 0
#define PROBE_PEXV 0

typedef unsigned short bf16_t;
typedef short bf16x8 __attribute__((ext_vector_type(8)));
typedef float f32x4 __attribute__((ext_vector_type(4)));
typedef unsigned u32x4 __attribute__((ext_vector_type(4)));
typedef unsigned u32x2 __attribute__((ext_vector_type(2)));

constexpr int BATCH = 2, T = 8192, D = 1024, NTOK = BATCH * T;
constexpr int HD = 64, NSA_H = 8, NSA_G = 2, NSA_HG = 4, SWA_H = 8;
constexpr int DIN = 1944, DINP = 2048;
constexpr int NCMP = 511, NCMPP = 512, NSEL = 128, TOPN = 16;
constexpr int NSA_WIN = 512, SWA_WIN = 128;
constexpr int PH = 8, PNK = 128, PDK = 256, PTOPK = 16, PQ = PH * PDK;
constexpr int NEXP = PNK * PNK;
constexpr float EPS = 1e-6f;
constexpr int NTHREADS = 512;

constexpr size_t MiB = 1u << 20;
constexpr size_t WS_SS2 = 0;
constexpr size_t WS_BAR = 128 * 1024;
constexpr size_t WS_WIN = 1 * MiB;
constexpr size_t WS_WOUT = 5 * MiB;
constexpr size_t WS_WQ = 7 * MiB;
constexpr size_t WS_PKEYS = 11 * MiB;
constexpr size_t WS_W1T = 12 * MiB;
constexpr size_t WS_W2T = 14 * MiB;
constexpr size_t WS_B1 = 14 * MiB + 512 * 1024;
constexpr size_t WS_XN = 16 * MiB;
constexpr size_t WS_O = WS_XN;
constexpr size_t WS_QN = 48 * MiB;
constexpr size_t WS_QS = 64 * MiB;
constexpr size_t WS_KV6 = 80 * MiB;
constexpr size_t KV6_STRIDE = 4 * MiB;
constexpr size_t WS_KSW = 104 * MiB;
constexpr size_t WS_VSW = 106 * MiB;
constexpr size_t WS_GSIG = 108 * MiB;
constexpr size_t WS_KC = 110 * MiB;
constexpr size_t WS_VC = 110 * MiB + 512 * 1024;
constexpr size_t WS_H1G = 48 * MiB;
constexpr size_t WS_QP = 80 * MiB;
constexpr size_t WS_EIDX = 144 * MiB;
constexpr size_t WS_GATE = 152 * MiB;
constexpr size_t WS_U8 = 160 * MiB;
constexpr size_t WS_PART = 80 * MiB;
constexpr size_t WS_V8 = 176 * MiB;
constexpr size_t WS_PW = 224 * MiB;
constexpr size_t WS_CTR = 128 * 1024 + 16 * 1024;
constexpr size_t WS_TOPV2 = 224 * MiB;
constexpr size_t WS_TOPI2 = 240 * MiB;
constexpr size_t WS_END = 256 * MiB;

struct Params {
    const float* x; const float* ln1_g; const float* w_in;
    const float* pe_k; const float* w1_k; const float* w2_k;
    const float* pe_v; const float* w1_v; const float* w2_v;
    const float* sinks; const float* w_out; const float* ln2_g;
    const float* wq; const float* pkeys; const float* pu; const float* pv; const float* lnf_g;
    float* out; unsigned char* ws;
};

__device__ __forceinline__ int tid_opaque() { int t = (int)threadIdx.x; asm volatile("" : "+v"(t)); return t; }
__device__ __forceinline__ unsigned f2bf(float f) { unsigned u = __float_as_uint(f); return (u + 0x7fffu + ((u >> 16) & 1u)) >> 16; }
__device__ __forceinline__ float bf2f(unsigned h) { return __uint_as_float(h << 16); }
__device__ __forceinline__ float bflo(unsigned w) { return __uint_as_float(w << 16); }
__device__ __forceinline__ float bfhi(unsigned w) { return __uint_as_float(w & 0xffff0000u); }
__device__ __forceinline__ unsigned pk2(float lo, float hi) { return f2bf(lo) | (f2bf(hi) << 16); }
__device__ __forceinline__ float wave_sum(float v) {
#pragma unroll
    for (int o = 1; o < 64; o <<= 1) v += __shfl_xor(v, o);
    return v;
}
__device__ __forceinline__ float gelu_tanh(float x) {
    const float u = 0.7978845608028654f * (x + 0.044715f * x * x * x);
    return 0.5f * x * (1.0f + tanhf(u));
}
__device__ __forceinline__ int win_orig_col(int n) {
    if (n < 1280) return n;
    if (n < 1792) return 1304 + (n - 1280);
    if (n < 1856) return 1816 + (n - 1792);
    if (n < 1920) return 1880 + (n - 1856);
    if (n < 1944) return 1280 + (n - 1920);
    return -1;
}

template <bool WIN_MAP>
__device__ __forceinline__ void prep_transpose(const float* W, int K, int N, int NP, bf16_t* WT, long gt, long ngt) {
    const long items = (long)NP * (K / 8);
    for (long it = gt; it < items; it += ngt) {
        const int n = (int)(it % NP), k0 = (int)(it / NP) * 8;
        const int col = WIN_MAP ? win_orig_col(n) : n;
        float v[8];
#pragma unroll
        for (int i = 0; i < 8; ++i) v[i] = (col >= 0) ? W[(size_t)(k0 + i) * N + col] : 0.f;
        u32x4 o; o.x = pk2(v[0], v[1]); o.y = pk2(v[2], v[3]); o.z = pk2(v[4], v[5]); o.w = pk2(v[6], v[7]);
        *(u32x4*)(WT + (size_t)n * K + k0) = o;
    }
}
__device__ __forceinline__ void prep_convert(const float* src, bf16_t* dst, long n8, long gt, long ngt) {
    for (long it = gt; it < n8; it += ngt) {
        const f32x4 a = *(const f32x4*)(src + it * 8), b = *(const f32x4*)(src + it * 8 + 4);
        u32x4 o; o.x = pk2(a.x, a.y); o.y = pk2(a.z, a.w); o.z = pk2(b.x, b.y); o.w = pk2(b.z, b.w);
        *(u32x4*)(dst + it * 8) = o;
    }
}
constexpr float U8_SCALE = 256.0f, V8_SCALE = 16.0f;
__device__ __forceinline__ void prep_convert_fp8(const float* src, unsigned char* dst, long n16, float sc, long gt, long ngt) {
    for (long it = gt; it < n16; it += ngt) {
        u32x4 o;
#pragma unroll
        for (int q = 0; q < 4; ++q) {
            const f32x4 a = *(const f32x4*)(src + it * 16 + q * 4);
            int w = 0;
            w = __builtin_amdgcn_cvt_pk_fp8_f32(a.x * sc, a.y * sc, w, false);
            w = __builtin_amdgcn_cvt_pk_fp8_f32(a.z * sc, a.w * sc, w, true);
            o[q] = (unsigned)w;
        }
        *(u32x4*)(dst + it * 16) = o;
    }
}
__device__ __forceinline__ void prep_convert_fp8_sliced(const float* src, unsigned char* dst, long n16, float sc, long gt, long ngt) {
    for (long it = gt; it < n16; it += ngt) {
        u32x4 o;
#pragma unroll
        for (int q = 0; q < 4; ++q) {
            const f32x4 a = *(const f32x4*)(src + it * 16 + q * 4);
            int w = 0;
            w = __builtin_amdgcn_cvt_pk_fp8_f32(a.x * sc, a.y * sc, w, false);
            w = __builtin_amdgcn_cvt_pk_fp8_f32(a.z * sc, a.w * sc, w, true);
            o[q] = (unsigned)w;
        }
        const long e = (it * 16) >> 10; const int col = (int)((it * 16) & 1023);
        *(u32x4*)(dst + (size_t)(col >> 7) * ((size_t)NEXP * 128) + e * 128 + (col & 127)) = o;
    }
}
__device__ __forceinline__ void phase_prep(const Params& p) {
    const long gt = (long)blockIdx.x * NTHREADS + tid_opaque(), ngt = (long)gridDim.x * NTHREADS;
    const int lane = tid_opaque() & 63;
    const long gw = gt >> 6, ngw = ngt >> 6;
    unsigned char* ws = p.ws;
    for (long m = gw; m < NTOK; m += ngw) {
        const f32x4* xr = (const f32x4*)(p.x + (size_t)m * D) + lane;
        f32x4 v[4]; float s = 0.f;
#pragma unroll
        for (int j = 0; j < 4; ++j) { v[j] = xr[64 * j]; s += (v[j].x * v[j].x + v[j].y * v[j].y) + (v[j].z * v[j].z + v[j].w * v[j].w); }
        const float rstd = 1.0f / sqrtf(wave_sum(s) * (1.0f / D) + EPS);
        u32x2* o = (u32x2*)((bf16_t*)(ws + WS_XN) + (size_t)m * D) + lane;
#pragma unroll
        for (int j = 0; j < 4; ++j) {
            const f32x4 g = *((const f32x4*)p.ln1_g + lane + 64 * j);
            u32x2 w; w.x = pk2(v[j].x * rstd * g.x, v[j].y * rstd * g.y); w.y = pk2(v[j].z * rstd * g.z, v[j].w * rstd * g.w);
            o[64 * j] = w;
        }
    }
    prep_transpose<true>(p.w_in, D, DIN, DINP, (bf16_t*)(ws + WS_WIN), gt, ngt);
    prep_transpose<false>(p.w_out, D, D, D, (bf16_t*)(ws + WS_WOUT), gt, ngt);
    prep_transpose<false>(p.wq, D, PQ, PQ, (bf16_t*)(ws + WS_WQ), gt, ngt);
    prep_convert(p.pkeys, (bf16_t*)(ws + WS_PKEYS), (long)16 * 128 * 128 / 8, gt, ngt);
    prep_transpose<false>(p.w1_k, 2048, 256, 256, (bf16_t*)(ws + WS_W1T), gt, ngt);
    prep_transpose<false>(p.w1_v, 2048, 256, 256, (bf16_t*)(ws + WS_W1T) + 256 * 2048, gt, ngt);
    prep_transpose<false>(p.w2_k, 256, 64, 64, (bf16_t*)(ws + WS_W2T), gt, ngt);
    prep_transpose<false>(p.w2_v, 256, 64, 64, (bf16_t*)(ws + WS_W2T) + 64 * 256, gt, ngt);
    for (long o = gw; o < 512; o += ngw) {
        const int kv = (int)(o >> 8), n = (int)(o & 255);
        const float* pe = kv ? p.pe_v : p.pe_k; const float* w1 = kv ? p.w1_v : p.w1_k;
        float s = 0.f;
        for (int k = lane; k < 2048; k += 64) s += pe[k] * w1[(size_t)k * 256 + n];
        s = wave_sum(s);
        if (lane == 0) ((float*)(ws + WS_B1))[o] = s;
    }
    prep_convert_fp8_sliced(p.pu, ws + WS_U8, (long)NEXP * D / 16, U8_SCALE, gt, ngt);
    prep_convert_fp8_sliced(p.pv, ws + WS_V8, (long)NEXP * D / 16, V8_SCALE, gt, ngt);
    for (long i = gt; i < NTOK; i += ngt) ((float*)(ws + WS_SS2))[i] = 0.f;
}

template <class Epi>
__device__ __forceinline__ void gemm_simple(const bf16_t* A, const bf16_t* Bt, int M, int N, int K, const Epi& E) {
    const int lane = tid_opaque() & 63;
    const long gw = ((long)blockIdx.x * NTHREADS + tid_opaque()) >> 6, ngw = ((long)gridDim.x * NTHREADS) >> 6;
    const int ntn = N / 64; const long ntiles = (long)(M / 32) * ntn;
    const int fr = lane & 15, fq = lane >> 4;
    for (long tile = gw; tile < ntiles; tile += ngw) {
        const int m0 = (int)(tile / ntn) * 32, n0 = (int)(tile % ntn) * 64;
        f32x4 acc[2][4];
#pragma unroll
        for (int i = 0; i < 2; ++i)
#pragma unroll
            for (int j = 0; j < 4; ++j) acc[i][j] = (f32x4){0.f, 0.f, 0.f, 0.f};
        const bf16_t* ap = A + (size_t)(m0 + fr) * K + fq * 8;
        const bf16_t* bp = Bt + (size_t)(n0 + fr) * K + fq * 8;
        for (int k0 = 0; k0 < K; k0 += 32) {
            bf16x8 a[2], b[4];
#pragma unroll
            for (int i = 0; i < 2; ++i) a[i] = *(const bf16x8*)(ap + (size_t)i * 16 * K + k0);
#pragma unroll
            for (int j = 0; j < 4; ++j) b[j] = *(const bf16x8*)(bp + (size_t)j * 16 * K + k0);
#pragma unroll
            for (int i = 0; i < 2; ++i)
#pragma unroll
                for (int j = 0; j < 4; ++j) acc[i][j] = __builtin_amdgcn_mfma_f32_16x16x32_bf16(a[i], b[j], acc[i][j], 0, 0, 0);
        }
        E(acc, m0, n0, fr, fq);
    }
}

struct EpiProj {
    unsigned char* ws;
    __device__ __forceinline__ void operator()(const f32x4 (&acc)[2][4], int m0, int n0, int fr, int fq) const {
#pragma unroll
        for (int i = 0; i < 2; ++i)
#pragma unroll
            for (int j = 0; j < 4; ++j)
#pragma unroll
                for (int r = 0; r < 4; ++r) {
                    const int row = m0 + 16 * i + fq * 4 + r, n = n0 + 16 * j + fr;
                    const float v = acc[i][j][r];
                    const int b = row / T, t = row % T, d = n & 63;
                    if (n < 512) {
                        const int head = n >> 6;
                        ((bf16_t*)(ws + WS_QN))[((size_t)(b * 8 + head) * T + t) * 64 + d] = (bf16_t)f2bf(v * 0.125f);
                    } else if (n < 1280) {
                        const int arr = (n - 512) >> 7, g = ((n - 512) >> 6) & 1;
                        ((bf16_t*)(ws + WS_KV6 + arr * KV6_STRIDE))[((size_t)(b * 2 + g) * T + t) * 64 + d] = (bf16_t)f2bf(v);
                    } else if (n < 1792) {
                        const int head = (n - 1280) >> 6;
                        ((bf16_t*)(ws + WS_QS))[((size_t)(b * 8 + head) * T + t) * 64 + d] = (bf16_t)f2bf(v * 0.125f);
                    } else if (n < 1856) {
                        ((bf16_t*)(ws + WS_KSW))[((size_t)b * T + t) * 64 + d] = (bf16_t)f2bf(v);
                    } else if (n < 1920) {
                        ((bf16_t*)(ws + WS_VSW))[((size_t)b * T + t) * 64 + d] = (bf16_t)f2bf(v);
                    } else if (n < 1944) {
                        ((float*)(ws + WS_GSIG))[(size_t)row * 24 + (n - 1920)] = 1.0f / (1.0f + expf(-v));
                    }
                }
    }
};
struct EpiOut {
    const float* x; const float* g2; float* h1; bf16_t* h1g; float* ss2;
    __device__ __forceinline__ void operator()(const f32x4 (&acc)[2][4], int m0, int n0, int fr, int fq) const {
#pragma unroll
        for (int i = 0; i < 2; ++i)
#pragma unroll
            for (int r = 0; r < 4; ++r) {
                const int row = m0 + 16 * i + fq * 4 + r; float ss = 0.f;
#pragma unroll
                for (int j = 0; j < 4; ++j) {
                    const int n = n0 + 16 * j + fr; const size_t off = (size_t)row * D + n;
                    const float h = x[off] + acc[i][j][r];
                    h1[off] = h; h1g[off] = (bf16_t)f2bf(h * g2[n]); ss += h * h;
                }
                ss += __shfl_xor(ss, 1); ss += __shfl_xor(ss, 2); ss += __shfl_xor(ss, 4); ss += __shfl_xor(ss, 8);
                if (fr == 0) atomicAdd(ss2 + row, ss);
            }
    }
};
struct EpiQP {
    const float* ss2; bf16_t* qp;
    __device__ __forceinline__ void operator()(const f32x4 (&acc)[2][4], int m0, int n0, int fr, int fq) const {
#pragma unroll
        for (int i = 0; i < 2; ++i)
#pragma unroll
            for (int r = 0; r < 4; ++r) {
                const int row = m0 + 16 * i + fq * 4 + r;
                const float rstd = 1.0f / sqrtf(ss2[row] * (1.0f / D) + EPS);
#pragma unroll
                for (int j = 0; j < 4; ++j) qp[(size_t)row * PQ + n0 + 16 * j + fr] = (bf16_t)f2bf(acc[i][j][r] * rstd);
            }
    }
};

namespace pg8 {
#define PG8_LAS __attribute__((address_space(3)))
typedef unsigned short bf16_t;
typedef short bf16x8 __attribute__((ext_vector_type(8)));
typedef float f32x4 __attribute__((ext_vector_type(4)));
typedef unsigned u32x4 __attribute__((ext_vector_type(4)));
constexpr int BM = 256, BK = 64, HALF = 128, HTB = HALF * BK * 2  , STAGE_BYTES = 8 * HTB, NXCD = 8, WGM = 8;

__host__ __device__ __forceinline__ int lds_byte(int r, int c) { const int st = (r >> 4) * 2 + (c >> 5), rr = r & 15, cc = c & 31, ob = rr * 64 + cc * 2; return st * 1024 + (ob ^ (((ob >> 9) & 1) << 5)); }
__host__ __device__ __forceinline__ void stage_rc(int b, int& R, int& C) { const int st = b / 1024, sb = b % 1024, swz = sb ^ (((sb >> 9) & 1) << 5); R = (st >> 1) * 16 + swz / 64; C = (st & 1) * 32 + (swz % 64) / 2; }
__host__ __device__ __forceinline__ int perm32(int rho) { const int n = rho >> 4, i = rho & 15; return 8 * (i >> 2) + 4 * n + (i & 3); }

struct Unit { int pm, pn; };
struct Gemm { const bf16_t* A; const bf16_t* Bt; int M, N, K; };

struct StaticOrder {
    int nM, nN, nwg, G, c;
    __host__ __device__ void init(int M, int N, int G_, int c_) { nM = M / BM; nN = N / BM; nwg = nM * nN; G = G_; c = c_; }
    __host__ __device__ bool next(int i, Unit& u) const {
        const long L = (long)i * G + c; if (L >= nwg) return false;
        int wgid = (int)L; { const int q = nwg / NXCD, r = nwg % NXCD, xcd = wgid % NXCD, off = wgid / NXCD; wgid = (xcd < r ? xcd * (q + 1) : r * (q + 1) + (xcd - r) * q) + off; }
        const int nig = WGM * nN, gid = wgid / nig, fm = gid * WGM, gsz = (nM - fm) < WGM ? (nM - fm) : WGM;
        u.pm = fm + ((wgid % nig) % gsz); u.pn = (wgid % nig) / gsz; return true;
    }
    __device__ __forceinline__ void a_ready(const Unit&) const {}
    __device__ __forceinline__ void done(const Unit&) const {}
};

__device__ __forceinline__ unsigned cvt_pk_bf16(float lo, float hi) { unsigned r; asm volatile("v_cvt_pk_bf16_f32 %0, %1, %2" : "=v"(r) : "v"(lo), "v"(hi)); return r; }
template <class Epi, class Sched, bool ALIGN_EPI = false, bool SP2 = false>
__device__ __forceinline__ void gemm_phase(PG8_LAS unsigned char* lds, const Gemm g, const Sched& S, const Epi& E) {
    const int tid = tid_opaque(), wid = __builtin_amdgcn_readfirstlane(tid >> 6), lane = tid & 63, wr = wid >> 2, wc = wid & 3, fr = lane & 15, fq = lane >> 4;
    const int K = g.K, nt = K / BK;
    unsigned voffA[2], voffB[2];
#pragma unroll
    for (int i = 0; i < 2; ++i) { int R, C; stage_rc(tid * 16 + i * 8192, R, C); const int Rb = Epi::PERM ? ((R & ~31) + perm32(R & 31)) : R;
        voffA[i] = (unsigned)(R * K + C) * 2u; voffB[i] = (unsigned)(Rb * K + C) * 2u; }
    const size_t kstep = (size_t)(BK * 2);
    const size_t hstep = (size_t)HALF * K * 2;
    const size_t tstep = 2 * hstep;
    const unsigned ldsw = (unsigned)wid * 1024u;
    const int aoff = lds_byte(wr * 64 + fr, fq * 8), boff = lds_byte(wc * 32 + fr, fq * 8);
#define PG8_SA(b, h) (((b) * 2 + (h)) * HTB)
#define PG8_SB(b, h) ((4 + (b) * 2 + (h)) * HTB)
#define PG8_STAGE(bufoff, gbase, voff) do { _Pragma("unroll") for (int _i = 0; _i < 2; ++_i) \
        __builtin_amdgcn_global_load_lds((const unsigned*)((const char*)(gbase) + (voff)[_i]), (PG8_LAS unsigned*)(lds + (bufoff) + ldsw + _i * 8192), 16, 0, 0); } while (0)
#define PG8_LDA(dst, b, h) do { _Pragma("unroll") for (int m = 0; m < 4; ++m) _Pragma("unroll") for (int k = 0; k < 2; ++k) dst[m][k] = *(const PG8_LAS bf16x8*)(lds + PG8_SA(b, h) + aoff + m * 2048 + k * 1024); } while (0)
#define PG8_LDB(dst, b, h) do { _Pragma("unroll") for (int n = 0; n < 2; ++n) _Pragma("unroll") for (int k = 0; k < 2; ++k) dst[n][k] = *(const PG8_LAS bf16x8*)(lds + PG8_SB(b, h) + boff + n * 2048 + k * 1024); } while (0)
#define PG8_MMA(ai, bj, At, Bt) do { __builtin_amdgcn_s_setprio(1); _Pragma("unroll") for (int m = 0; m < 4; ++m) _Pragma("unroll") for (int n = 0; n < 2; ++n) _Pragma("unroll") for (int k = 0; k < 2; ++k) \
        acc[ai][bj][m][n] = __builtin_amdgcn_mfma_f32_16x16x32_bf16(Bt[n][k], At[m][k], acc[ai][bj][m][n], 0, 0, 0); __builtin_amdgcn_s_setprio(0); } while (0)
#define PG8_WAIT_V(n) asm volatile("s_waitcnt vmcnt(" #n ")" ::: "memory")
#define PG8_WAIT_L(n) asm volatile("s_waitcnt lgkmcnt(" #n ")" ::: "memory")
#define PG8_BAR __builtin_amdgcn_s_barrier()
#define PG8_SCHED __builtin_amdgcn_sched_barrier(0)
    Unit cur, nxt; int ui = 0;
    if (!S.next(0, cur)) return;
    f32x4 acc[2][2][4][2];
#pragma unroll
    for (int a = 0; a < 2; ++a)
#pragma unroll
        for (int b = 0; b < 2; ++b)
#pragma unroll
            for (int m = 0; m < 4; ++m)
#pragma unroll
                for (int n = 0; n < 2; ++n) acc[a][b][m][n] = (f32x4){0.f, 0.f, 0.f, 0.f};
    bf16x8 At[4][2], B0[2][2], B1[2][2];
    const char* cA = (const char*)g.A + (size_t)cur.pm * tstep; const char* cB = (const char*)g.Bt + (size_t)cur.pn * tstep;
    S.a_ready(cur);
    if constexpr (SP2) {
        PG8_STAGE(PG8_SB(0, 0), cB, voffB); PG8_STAGE(PG8_SB(0, 1), cB + hstep, voffB); PG8_STAGE(PG8_SA(0, 0), cA, voffA); PG8_STAGE(PG8_SA(0, 1), cA + hstep, voffA);
        if (wr == 1) PG8_BAR;
        PG8_WAIT_V(2); PG8_BAR;
        PG8_STAGE(PG8_SB(1, 0), cB + kstep, voffB); PG8_STAGE(PG8_SA(1, 0), cA + kstep, voffA); PG8_STAGE(PG8_SB(1, 1), cB + hstep + kstep, voffB);
        PG8_WAIT_V(6); PG8_BAR;
    } else {
        PG8_STAGE(PG8_SB(0, 0), cB, voffB); PG8_STAGE(PG8_SA(0, 0), cA, voffA); PG8_STAGE(PG8_SB(0, 1), cB + hstep, voffB); PG8_STAGE(PG8_SA(0, 1), cA + hstep, voffA);
        if (wr == 1) PG8_BAR;
        PG8_WAIT_V(4); PG8_BAR;
        PG8_STAGE(PG8_SB(1, 0), cB + kstep, voffB); PG8_STAGE(PG8_SA(1, 0), cA + kstep, voffA); PG8_STAGE(PG8_SB(1, 1), cB + hstep + kstep, voffB);
        PG8_WAIT_V(6); PG8_BAR;
    }
    for (;;) {
        const bool has_next = S.next(ui + 1, nxt);
        const char* nA = has_next ? (const char*)g.A + (size_t)nxt.pm * tstep : cA; const char* nB = has_next ? (const char*)g.Bt + (size_t)nxt.pn * tstep : cB;
        for (int t = 0; t < nt; t += 2) {
            const bool last = (t == nt - 2);
            const char* a1 = cA + (size_t)(t + 1) * kstep;
            const char* a2 = last ? nA : cA + (size_t)(t + 2) * kstep; const char* b2 = last ? nB : cB + (size_t)(t + 2) * kstep;
            const char* a3 = a2 + kstep; const char* b3 = b2 + kstep;
            if (last && has_next) S.a_ready(nxt);
            if constexpr (SP2) {
            PG8_LDB(B0, 0, 0); PG8_LDB(B1, 0, 1); PG8_SCHED; PG8_LDA(At, 0, 0); PG8_STAGE(PG8_SA(1, 1), a1 + hstep, voffA);
            PG8_WAIT_V(8); PG8_WAIT_L(0); PG8_BAR; PG8_MMA(0, 0, At, B0); PG8_MMA(0, 1, At, B1); PG8_BAR; PG8_SCHED;
            PG8_LDA(At, 0, 1); PG8_STAGE(PG8_SB(0, 0), b2, voffB); PG8_STAGE(PG8_SB(0, 1), b2 + hstep, voffB); PG8_STAGE(PG8_SA(0, 0), a2, voffA);
            PG8_WAIT_V(8); PG8_WAIT_L(0); PG8_BAR; PG8_MMA(1, 0, At, B0); PG8_MMA(1, 1, At, B1); PG8_BAR; PG8_SCHED;
            PG8_LDB(B0, 1, 0); PG8_LDB(B1, 1, 1); PG8_SCHED; PG8_LDA(At, 1, 0); PG8_STAGE(PG8_SA(0, 1), a2 + hstep, voffA);
            PG8_WAIT_V(8); PG8_WAIT_L(0); PG8_BAR; PG8_MMA(0, 0, At, B0); PG8_MMA(0, 1, At, B1); PG8_BAR; PG8_SCHED;
            PG8_LDA(At, 1, 1); PG8_STAGE(PG8_SB(1, 0), b3, voffB); PG8_STAGE(PG8_SB(1, 1), b3 + hstep, voffB); PG8_STAGE(PG8_SA(1, 0), a3, voffA);
            PG8_WAIT_V(8); PG8_WAIT_L(0); PG8_BAR; PG8_MMA(1, 0, At, B0); PG8_MMA(1, 1, At, B1); PG8_BAR; PG8_SCHED;
            } else {
            PG8_LDB(B0, 0, 0); PG8_SCHED; PG8_LDA(At, 0, 0); PG8_STAGE(PG8_SA(1, 1), a1 + hstep, voffA);
            PG8_WAIT_L(8); PG8_BAR; PG8_WAIT_L(0); PG8_MMA(0, 0, At, B0); PG8_BAR; PG8_SCHED;
            PG8_LDB(B1, 0, 1); PG8_STAGE(PG8_SB(0, 0), b2, voffB);
            PG8_BAR; PG8_WAIT_L(0); PG8_MMA(0, 1, At, B1); PG8_BAR;
            PG8_LDA(At, 0, 1); PG8_STAGE(PG8_SA(0, 0), a2, voffA);
            PG8_BAR; PG8_WAIT_L(0); PG8_MMA(1, 0, At, B0); PG8_BAR; PG8_SCHED;
            PG8_STAGE(PG8_SB(0, 1), b2 + hstep, voffB);
            PG8_WAIT_V(6); PG8_BAR; PG8_MMA(1, 1, At, B1); PG8_BAR;
            PG8_LDB(B0, 1, 0); PG8_SCHED; PG8_LDA(At, 1, 0); PG8_STAGE(PG8_SA(0, 1), a2 + hstep, voffA);
            PG8_WAIT_L(8); PG8_BAR; PG8_WAIT_L(0); PG8_MMA(0, 0, At, B0); PG8_BAR; PG8_SCHED;
            PG8_LDB(B1, 1, 1); PG8_STAGE(PG8_SB(1, 0), b3, voffB);
            PG8_BAR; PG8_WAIT_L(0); PG8_MMA(0, 1, At, B1); PG8_BAR;
            PG8_LDA(At, 1, 1); PG8_STAGE(PG8_SA(1, 0), a3, voffA);
            PG8_BAR; PG8_WAIT_L(0); PG8_MMA(1, 0, At, B0); PG8_BAR; PG8_SCHED;
            PG8_STAGE(PG8_SB(1, 1), b3 + hstep, voffB);
            PG8_WAIT_V(6); PG8_BAR; PG8_MMA(1, 1, At, B1); PG8_BAR;
            }
        }
        if constexpr (ALIGN_EPI) { if (wr == 0) PG8_BAR; }
        if constexpr (!Epi::AFTER_DRAIN) { E(acc, cur, wr, wc, fr, fq); S.done(cur); }
        if (!has_next) break;
#pragma unroll
        for (int a = 0; a < 2; ++a)
#pragma unroll
            for (int b = 0; b < 2; ++b)
#pragma unroll
                for (int m = 0; m < 4; ++m)
#pragma unroll
                    for (int n = 0; n < 2; ++n) acc[a][b][m][n] = (f32x4){0.f, 0.f, 0.f, 0.f};
        cur = nxt; cA = nA; cB = nB; ++ui;
        if constexpr (ALIGN_EPI) { if (wr == 1) PG8_BAR; }
    }
    PG8_WAIT_V(0);
    if constexpr (!ALIGN_EPI) { if (wr == 0) PG8_BAR; }
    PG8_BAR;
    if constexpr (Epi::AFTER_DRAIN) { E.fused(acc, cur, wr, wc, fr, fq, lds, wid, lane); S.done(cur); }
#undef PG8_SA
#undef PG8_SB
#undef PG8_STAGE
#undef PG8_LDA
#undef PG8_LDB
#undef PG8_MMA
#undef PG8_WAIT_V
#undef PG8_WAIT_L
#undef PG8_BAR
#undef PG8_SCHED
}
}

struct EpiProjT {
    static constexpr bool PERM = true, AFTER_DRAIN = false;
    unsigned char* ws;
    __device__ __forceinline__ void operator()(const f32x4 (&acc)[2][2][4][2], const pg8::Unit& u, int wr, int wc, int fr, int fq) const {
        const int row0 = u.pm * 256 + wr * 64 + fr;
#pragma unroll
        for (int bj = 0; bj < 2; ++bj) {
            const int n8 = u.pn * 256 + bj * 128 + wc * 32 + 8 * fq;
            if (n8 >= 1944) continue;
            if (n8 >= 1920) {
#pragma unroll
                for (int ai = 0; ai < 2; ++ai)
#pragma unroll
                    for (int m = 0; m < 4; ++m) {
                        const int row = row0 + ai * 128 + m * 16;
                        const f32x4 v0 = acc[ai][bj][m][0], v1 = acc[ai][bj][m][1];
                        float* dst = (float*)(ws + WS_GSIG) + (size_t)row * 24 + (n8 - 1920);
                        *(f32x4*)dst = (f32x4){1.0f / (1.0f + __expf(-v0[0])), 1.0f / (1.0f + __expf(-v0[1])), 1.0f / (1.0f + __expf(-v0[2])), 1.0f / (1.0f + __expf(-v0[3]))};
                        *(f32x4*)(dst + 4) = (f32x4){1.0f / (1.0f + __expf(-v1[0])), 1.0f / (1.0f + __expf(-v1[1])), 1.0f / (1.0f + __expf(-v1[2])), 1.0f / (1.0f + __expf(-v1[3]))};
                    }
                continue;
            }
            bf16_t* base; int nh, hidx; float sc = 1.0f;
            if (n8 < 512) { base = (bf16_t*)(ws + WS_QN); nh = 8; hidx = n8 >> 6; sc = 0.125f; }
            else if (n8 < 1280) { const int arr = (n8 - 512) >> 7; base = (bf16_t*)(ws + WS_KV6 + (size_t)arr * KV6_STRIDE); nh = 2; hidx = ((n8 - 512) >> 6) & 1; }
            else if (n8 < 1792) { base = (bf16_t*)(ws + WS_QS); nh = 8; hidx = (n8 - 1280) >> 6; sc = 0.125f; }
            else if (n8 < 1856) { base = (bf16_t*)(ws + WS_KSW); nh = 1; hidx = 0; }
            else { base = (bf16_t*)(ws + WS_VSW); nh = 1; hidx = 0; }
            const int d0 = n8 & 63;
#pragma unroll
            for (int ai = 0; ai < 2; ++ai)
#pragma unroll
                for (int m = 0; m < 4; ++m) {
                    const int row = row0 + ai * 128 + m * 16, b = row >> 13, t = row & (T - 1);
                    const f32x4 v0 = acc[ai][bj][m][0] * sc, v1 = acc[ai][bj][m][1] * sc;
                    u32x4 w; w.x = pg8::cvt_pk_bf16(v0[0], v0[1]); w.y = pg8::cvt_pk_bf16(v0[2], v0[3]); w.z = pg8::cvt_pk_bf16(v1[0], v1[1]); w.w = pg8::cvt_pk_bf16(v1[2], v1[3]);
                    *(u32x4*)(base + ((size_t)(b * nh + hidx) * T + t) * 64 + d0) = w;
                }
        }
    }
};
struct EpiOutT {
    static constexpr bool PERM = false, AFTER_DRAIN = false;
    const float* x; const float* g2; float* h1; bf16_t* h1g; float* ss2;
    __device__ __forceinline__ void operator()(const f32x4 (&acc)[2][2][4][2], const pg8::Unit& u, int wr, int wc, int fr, int fq) const {
        const int row0 = u.pm * 256 + wr * 64 + fr, col0 = u.pn * 256 + wc * 32 + 4 * fq;
#pragma unroll
        for (int ai = 0; ai < 2; ++ai)
#pragma unroll
            for (int m = 0; m < 4; ++m) {
                const int row = row0 + ai * 128 + m * 16; float ss = 0.f;
#pragma unroll
                for (int bj = 0; bj < 2; ++bj)
#pragma unroll
                    for (int n = 0; n < 2; ++n) {
                        const int c = col0 + bj * 128 + n * 16; const size_t off = (size_t)row * D + c;
                        const f32x4 h = *(const f32x4*)(x + off) + acc[ai][bj][m][n];
                        const f32x4 g = *(const f32x4*)(g2 + c);
                        *(f32x4*)(h1 + off) = h;
                        u32x2 w; w.x = pg8::cvt_pk_bf16(h[0] * g[0], h[1] * g[1]); w.y = pg8::cvt_pk_bf16(h[2] * g[2], h[3] * g[3]);
                        *(u32x2*)(h1g + off) = w;
                        ss += (h[0] * h[0] + h[1] * h[1]) + (h[2] * h[2] + h[3] * h[3]);
                    }
                ss += __shfl_xor(ss, 16); ss += __shfl_xor(ss, 32);
                if (fq == 0) atomicAdd(ss2 + row, ss);
            }
    }
};
struct EpiQPT {
    static constexpr bool PERM = true, AFTER_DRAIN = false;
    const float* ss2; bf16_t* qp;
    __device__ __forceinline__ void operator()(const f32x4 (&acc)[2][2][4][2], const pg8::Unit& u, int wr, int wc, int fr, int fq) const {
        const int row0 = u.pm * 256 + wr * 64 + fr;
#pragma unroll
        for (int ai = 0; ai < 2; ++ai)
#pragma unroll
            for (int m = 0; m < 4; ++m) {
                const int row = row0 + ai * 128 + m * 16;
                const float rstd = 1.0f / sqrtf(ss2[row] * (1.0f / D) + EPS);
#pragma unroll
                for (int bj = 0; bj < 2; ++bj) {
                    const int n8 = u.pn * 256 + bj * 128 + wc * 32 + 8 * fq;
                    const f32x4 v0 = acc[ai][bj][m][0] * rstd, v1 = acc[ai][bj][m][1] * rstd;
                    u32x4 w; w.x = pg8::cvt_pk_bf16(v0[0], v0[1]); w.y = pg8::cvt_pk_bf16(v0[2], v0[3]); w.z = pg8::cvt_pk_bf16(v1[0], v1[1]); w.w = pg8::cvt_pk_bf16(v1[2], v1[3]);
                    *(u32x4*)(qp + (size_t)row * PQ + n8) = w;
                }
            }
    }
};

__device__ __forceinline__ void phase_compress(const Params& p, float* lds) {
    float* flat = lds;
    float* part = lds + 2048;
    float* hid = lds + 2560;
    const int tid = tid_opaque();
    const int nunits = 2 * BATCH * NCMP * NSA_G;
    for (int u = blockIdx.x; u < nunits; u += gridDim.x) {
        const int kv = u / (BATCH * NCMP * NSA_G); int r = u % (BATCH * NCMP * NSA_G);
        const int b = r / (NCMP * NSA_G); r %= (NCMP * NSA_G);
        const int c = r / NSA_G, g = r % NSA_G;
        const bf16_t* raw = (const bf16_t*)(p.ws + WS_KV6 + (size_t)kv * KV6_STRIDE) + ((size_t)(b * 2 + g) * T + 16 * c) * 64;
        const float* pe = kv ? p.pe_v : p.pe_k; const float* w1 = kv ? p.w1_v : p.w1_k; const float* w2 = kv ? p.w2_v : p.w2_k;
        for (int i = tid; i < 2048; i += NTHREADS) flat[i] = bf2f(raw[i]) + pe[i];
        __syncthreads();
        {
            const int j = tid & 255, half = tid >> 8;
            float a = 0.f;
            const float* wp = w1 + (size_t)(half * 1024) * 256 + j; const float* fp = flat + half * 1024;
            for (int i = 0; i < 1024; ++i) a += fp[i] * wp[(size_t)i * 256];
            part[tid] = a;
        }
        __syncthreads();
        if (tid < 256) hid[tid] = gelu_tanh(part[tid] + part[tid + 256]);
        __syncthreads();
        if (tid < 64) {
            float a = 0.f;
            for (int j = 0; j < 256; ++j) a += hid[j] * w2[j * 64 + tid];
            bf16_t* dst = (bf16_t*)(p.ws + (kv ? WS_VC : WS_KC)) + ((size_t)(b * 2 + g) * NCMPP + c) * 64;
            dst[tid] = (bf16_t)f2bf(a);
        }
        __syncthreads();
    }
}

__device__ __forceinline__ void load_row64(const bf16_t* src, float (&k)[64]) {
#pragma unroll
    for (int c = 0; c < 8; ++c) {
        const u32x4 w = *(const u32x4*)(src + 8 * c);
        k[8 * c + 0] = bflo(w.x); k[8 * c + 1] = bfhi(w.x); k[8 * c + 2] = bflo(w.y); k[8 * c + 3] = bfhi(w.y);
        k[8 * c + 4] = bflo(w.z); k[8 * c + 5] = bfhi(w.z); k[8 * c + 6] = bflo(w.w); k[8 * c + 7] = bfhi(w.w);
    }
}
__device__ __forceinline__ float dot_row64(const bf16_t* src, const float (&q)[64]) {
    float s0 = 0.f, s1 = 0.f;
#pragma unroll
    for (int c = 0; c < 8; ++c) {
        const u32x4 w = *(const u32x4*)(src + 8 * c);
        s0 += q[8 * c + 0] * bflo(w.x); s1 += q[8 * c + 1] * bfhi(w.x); s0 += q[8 * c + 2] * bflo(w.y); s1 += q[8 * c + 3] * bfhi(w.y);
        s0 += q[8 * c + 4] * bflo(w.z); s1 += q[8 * c + 5] * bfhi(w.z); s0 += q[8 * c + 6] * bflo(w.w); s1 += q[8 * c + 7] * bfhi(w.w);
    }
    return s0 + s1;
}
__device__ __forceinline__ void osm_update(float s, const bf16_t* vsrc, float& m, float& l, float (&acc)[32]) {
    const float mn = fmaxf(m, s), alpha = __expf(m - mn), pr = __expf(s - mn);
    l = l * alpha + pr; m = mn;
#pragma unroll
    for (int c = 0; c < 4; ++c) {
        const u32x4 w = *(const u32x4*)(vsrc + 8 * c);
        acc[8 * c + 0] = acc[8 * c + 0] * alpha + pr * bflo(w.x); acc[8 * c + 1] = acc[8 * c + 1] * alpha + pr * bfhi(w.x);
        acc[8 * c + 2] = acc[8 * c + 2] * alpha + pr * bflo(w.y); acc[8 * c + 3] = acc[8 * c + 3] * alpha + pr * bfhi(w.y);
        acc[8 * c + 4] = acc[8 * c + 4] * alpha + pr * bflo(w.z); acc[8 * c + 5] = acc[8 * c + 5] * alpha + pr * bfhi(w.z);
        acc[8 * c + 6] = acc[8 * c + 6] * alpha + pr * bflo(w.w); acc[8 * c + 7] = acc[8 * c + 7] * alpha + pr * bfhi(w.w);
    }
}

__device__ __forceinline__ void phase_nsa(const Params& p, float* lds) {
    float* imp = lds;
    int* sel = (int*)(lds + 64 * 129);
    const int tid = tid_opaque(), qi = tid & 63, h = (tid >> 6) & 3, dh = tid >> 8;
    const unsigned char* ws = p.ws;
    const int nunits = BATCH * NSA_G * (T / 64);
    for (int u = blockIdx.x; u < nunits; u += gridDim.x) {
        const int b = u / (NSA_G * (T / 64)), g = (u / (T / 64)) % NSA_G, tile = u % (T / 64);
        const int t = tile * 64 + qi, head = g * 4 + h;
        const float slope = exp2f(-0.5f * (float)(9 + head));
        float q[64];
        load_row64((const bf16_t*)(ws + WS_QN) + ((size_t)(b * 8 + head) * T + t) * 64, q);
        const bf16_t* KC = (const bf16_t*)(ws + WS_KC) + (size_t)(b * 2 + g) * NCMPP * 64;
        const bf16_t* VC = (const bf16_t*)(ws + WS_VC) + (size_t)(b * 2 + g) * NCMPP * 64 + dh * 32;
        const bf16_t* KS = (const bf16_t*)(ws + WS_KV6 + 2 * KV6_STRIDE) + (size_t)(b * 2 + g) * T * 64;
        const bf16_t* VS = (const bf16_t*)(ws + WS_KV6 + 3 * KV6_STRIDE) + (size_t)(b * 2 + g) * T * 64 + dh * 32;
        const bf16_t* KW = (const bf16_t*)(ws + WS_KV6 + 4 * KV6_STRIDE) + (size_t)(b * 2 + g) * T * 64;
        const bf16_t* VW = (const bf16_t*)(ws + WS_KV6 + 5 * KV6_STRIDE) + (size_t)(b * 2 + g) * T * 64 + dh * 32;
        const float* gs = (const float*)(ws + WS_GSIG) + (size_t)(b * T + t) * 24 + head * 3;
        float o[32];
#pragma unroll
        for (int d = 0; d < 32; ++d) o[d] = 0.f;
        for (int i = tid; i < 64 * 129; i += NTHREADS) imp[i] = 0.f;
        __syncthreads();
        const int nc = 4 * tile + 3;
        float mc = -1e30f, lc = 0.f;
        {
            float acc[32];
#pragma unroll
            for (int d = 0; d < 32; ++d) acc[d] = 0.f;
            for (int c = 0; c < nc; ++c) {
                const int dist = t - (16 * c + 31);
                if (dist >= 0) {
                    const float s = dot_row64(KC + (size_t)c * 64, q) - slope * (float)dist;
                    osm_update(s, VC + (size_t)c * 64, mc, lc, acc);
                }
            }
            const float inv = gs[0] / fmaxf(lc, 1e-30f);
#pragma unroll
            for (int d = 0; d < 32; ++d) o[d] += acc[d] * inv;
        }
        if (dh == 0) {
            const float invl = 1.0f / fmaxf(lc, 1e-30f);
            for (int c = 0; c < nc; ++c) {
                const int dist = t - (16 * c + 31);
                if (dist >= 0) {
                    const float s = dot_row64(KC + (size_t)c * 64, q) - slope * (float)dist;
                    const float pr = __expf(s - mc) * invl;
                    const int sb = c >> 2;
                    atomicAdd(&imp[qi * 129 + sb], pr);
                    if ((c & 3) == 3 && sb + 1 < NSEL) atomicAdd(&imp[qi * 129 + sb + 1], pr);
                }
            }
        }
        __syncthreads();
        if (tid < 64) {
            const int blk_t = tile;
            float* row = imp + tid * 129;
            for (int j = 0; j <= blk_t; ++j) if (j == 0 || j == blk_t || j == blk_t - 1) row[j] = 1.0e4f;
            for (int k = 0; k < TOPN; ++k) {
                float best = -INFINITY; int bi = -1;
                for (int j = 0; j <= blk_t; ++j) { const float v = row[j]; if (v > best) { best = v; bi = j; } }
                sel[tid * 16 + k] = bi;
                if (bi >= 0) row[bi] = -INFINITY;
            }
        }
        __syncthreads();
        {
            float m = -1e30f, l = 0.f, acc[32];
#pragma unroll
            for (int d = 0; d < 32; ++d) acc[d] = 0.f;
            for (int k = 0; k < TOPN; ++k) {
                const int j = sel[qi * 16 + k];
                if (j >= 0) {
                    for (int i = 0; i < 64; ++i) {
                        const int pos = 64 * j + i;
                        if (pos <= t) {
                            const float s = dot_row64(KS + (size_t)pos * 64, q) - slope * (float)(t - pos);
                            osm_update(s, VS + (size_t)pos * 64, m, l, acc);
                        }
                    }
                }
            }
            const float inv = gs[1] / fmaxf(l, 1e-30f);
#pragma unroll
            for (int d = 0; d < 32; ++d) o[d] += acc[d] * inv;
        }
        {
            float m = -1e30f, l = 0.f, acc[32];
#pragma unroll
            for (int d = 0; d < 32; ++d) acc[d] = 0.f;
            for (int i = 0; i < NSA_WIN; ++i) {
                const int pos = t - (NSA_WIN - 1) + i;
                if (pos >= 0) {
                    const float s = dot_row64(KW + (size_t)pos * 64, q) - slope * (float)(t - pos);
                    osm_update(s, VW + (size_t)pos * 64, m, l, acc);
                }
            }
            const float inv = gs[2] / fmaxf(l, 1e-30f);
#pragma unroll
            for (int d = 0; d < 32; ++d) o[d] += acc[d] * inv;
        }
        bf16_t* O = (bf16_t*)(p.ws + WS_O) + (size_t)(b * T + t) * D + g * 256 + h * 64 + dh * 32;
#pragma unroll
        for (int c = 0; c < 4; ++c) {
            u32x4 w; w.x = pk2(o[8 * c], o[8 * c + 1]); w.y = pk2(o[8 * c + 2], o[8 * c + 3]); w.z = pk2(o[8 * c + 4], o[8 * c + 5]); w.w = pk2(o[8 * c + 6], o[8 * c + 7]);
            *(u32x4*)(O + 8 * c) = w;
        }
        __syncthreads();
    }
}

__device__ __forceinline__ void phase_swa(const Params& p) {
    const unsigned char* ws = p.ws;
    const long gt = (long)blockIdx.x * NTHREADS + tid_opaque(), ngt = (long)gridDim.x * NTHREADS;
    const long items = (long)NTOK * SWA_H * 2;
    for (long it = gt; it < items; it += ngt) {
        const int tt = (int)(it % T); long r = it / T;
        const int dh = (int)(r % 2); r /= 2;
        const int head = (int)(r % SWA_H); const int b = (int)(r / SWA_H);
        const float slope = exp2f(-0.5f * (float)(head + 1));
        float q[64];
        load_row64((const bf16_t*)(ws + WS_QS) + ((size_t)(b * 8 + head) * T + tt) * 64, q);
        const bf16_t* K = (const bf16_t*)(ws + WS_KSW) + (size_t)b * T * 64;
        const bf16_t* V = (const bf16_t*)(ws + WS_VSW) + (size_t)b * T * 64 + dh * 32;
        const float sink = p.sinks[head];
        float m = sink, l = 1.0f, acc[32];
#pragma unroll
        for (int d = 0; d < 32; ++d) acc[d] = 0.f;
        for (int i = 0; i < SWA_WIN; ++i) {
            const int pos = tt - (SWA_WIN - 1) + i;
            if (pos >= 0) {
                const float s = dot_row64(K + (size_t)pos * 64, q) - slope * (float)(tt - pos);
                osm_update(s, V + (size_t)pos * 64, m, l, acc);
            }
        }
        const float inv = 1.0f / l;
        bf16_t* O = (bf16_t*)(p.ws + WS_O) + (size_t)(b * T + tt) * D + 512 + head * 64 + dh * 32;
#pragma unroll
        for (int c = 0; c < 4; ++c) {
            u32x4 w; w.x = pk2(acc[8 * c] * inv, acc[8 * c + 1] * inv); w.y = pk2(acc[8 * c + 2] * inv, acc[8 * c + 3] * inv);
            w.z = pk2(acc[8 * c + 4] * inv, acc[8 * c + 5] * inv); w.w = pk2(acc[8 * c + 6] * inv, acc[8 * c + 7] * inv);
            *(u32x4*)(O + 8 * c) = w;
        }
    }
}

__device__ __forceinline__ void topk_insert(float v, int i, float (&tv)[16], int (&ti)[16]) {
#pragma unroll
    for (int k = 0; k < 16; ++k) {
        const bool sw = v > tv[k];
        const float ov = tv[k]; const int oi = ti[k];
        tv[k] = sw ? v : ov; ti[k] = sw ? i : oi;
        v = sw ? ov : v; i = sw ? oi : i;
    }
}
__device__ __forceinline__ void phase_peer_sub(const Params& p) {
    const unsigned char* ws = p.ws;
    const long gt = (long)blockIdx.x * NTHREADS + tid_opaque(), ngt = (long)gridDim.x * NTHREADS;
    const long items = (long)NTOK * 16;
    for (long it = gt; it < items; it += ngt) {
        const int tok = (int)(it % NTOK), hc = (int)(it / NTOK);
        const bf16_t* qp = (const bf16_t*)(ws + WS_QP) + (size_t)tok * PQ + hc * 128;
        float q0[64], q1[64];
        load_row64(qp, q0); load_row64(qp + 64, q1);
        const bf16_t* keys = (const bf16_t*)(ws + WS_PKEYS) + (size_t)hc * 128 * 128;
        float tv[16]; int ti[16];
#pragma unroll
        for (int k = 0; k < 16; ++k) { tv[k] = -INFINITY; ti[k] = 0; }
        for (int n = 0; n < 128; ++n) {
            const float s = dot_row64(keys + (size_t)n * 128, q0) + dot_row64(keys + (size_t)n * 128 + 64, q1);
            topk_insert(s, n, tv, ti);
        }
        float* ov = (float*)(p.ws + WS_TOPV2) + ((size_t)tok * 16 + hc) * 16;
        int* oi = (int*)(p.ws + WS_TOPI2) + ((size_t)tok * 16 + hc) * 16;
#pragma unroll
        for (int k = 0; k < 16; ++k) { ov[k] = tv[k]; oi[k] = ti[k]; }
    }
}
__device__ __forceinline__ void phase_peer_comb(const Params& p) {
    const long gt = (long)blockIdx.x * NTHREADS + tid_opaque(), ngt = (long)gridDim.x * NTHREADS;
    const long items = (long)NTOK * PH;
    for (long it = gt; it < items; it += ngt) {
        const int tok = (int)(it / PH), h = (int)(it % PH);
        const float* v1 = (const float*)(p.ws + WS_TOPV2) + ((size_t)tok * 16 + h * 2) * 16;
        const float* v2 = v1 + 16;
        const int* i1 = (const int*)(p.ws + WS_TOPI2) + ((size_t)tok * 16 + h * 2) * 16;
        const int* i2 = i1 + 16;
        float s2[16];
#pragma unroll
        for (int k = 0; k < 16; ++k) s2[k] = v2[k];
        float tv[16]; int ti[16];
#pragma unroll
        for (int k = 0; k < 16; ++k) { tv[k] = -INFINITY; ti[k] = 0; }
        for (int a = 0; a < 16; ++a) {
            const float s1 = v1[a];
#pragma unroll
            for (int bb = 0; bb < 16; ++bb) topk_insert(s1 + s2[bb], a * 16 + bb, tv, ti);
        }
        float e[16], sum = 0.f;
#pragma unroll
        for (int k = 0; k < 16; ++k) { e[k] = __expf(tv[k] - tv[0]); sum += e[k]; }
        const float inv = 1.0f / sum;
        int* eo = (int*)(p.ws + WS_EIDX) + (size_t)tok * 128 + h * 16;
        float* go = (float*)(p.ws + WS_GATE) + (size_t)tok * 128 + h * 16;
#pragma unroll
        for (int k = 0; k < 16; ++k) { const int ci = ti[k]; eo[k] = i1[ci >> 4] * PNK + i2[ci & 15]; go[k] = e[k] * inv; }
    }
}

typedef float f32x2 __attribute__((ext_vector_type(2)));
__device__ __forceinline__ void unpack16_fp8(const u32x4& w, float (&f)[16]) {
#pragma unroll
    for (int q = 0; q < 4; ++q) {
        const f32x2 lo = __builtin_amdgcn_cvt_pk_f32_fp8((int)w[q], false), hi = __builtin_amdgcn_cvt_pk_f32_fp8((int)w[q], true);
        f[4 * q] = lo.x; f[4 * q + 1] = lo.y; f[4 * q + 2] = hi.x; f[4 * q + 3] = hi.y;
    }
}
__device__ __forceinline__ float reduce8(const float (&d)[8], int lane) {
    const bool b5 = lane & 32, b4 = lane & 16, b3 = lane & 8;
    float e[4], f[2];
#pragma unroll
    for (int i = 0; i < 4; ++i) { const float snd = b5 ? d[i] : d[i + 4], keep = b5 ? d[i + 4] : d[i]; e[i] = keep + __shfl_xor(snd, 32); }
#pragma unroll
    for (int i = 0; i < 2; ++i) { const float snd = b4 ? e[i] : e[i + 2], keep = b4 ? e[i + 2] : e[i]; f[i] = keep + __shfl_xor(snd, 16); }
    const float snd = b3 ? f[0] : f[1], keep = b3 ? f[1] : f[0];
    float g = keep + __shfl_xor(snd, 8);
    g += __shfl_xor(g, 4); g += __shfl_xor(g, 2); g += __shfl_xor(g, 1);
    return g;
}
__device__ __forceinline__ void phase_peer_expert(const Params& p) {
    const unsigned char* ws = p.ws;
    const int tid_ = tid_opaque(), lane = tid_ & 63;
    const int gw = (int)blockIdx.x * (NTHREADS / 64) + __builtin_amdgcn_readfirstlane(tid_ >> 6), ngw = (int)gridDim.x * (NTHREADS / 64);
    const unsigned char* U = ws + WS_U8; const unsigned char* V = ws + WS_V8;
    const unsigned loff = 16u * (unsigned)lane;
    for (int tok = gw; tok < NTOK; tok += ngw) {
        const bf16_t* hg = (const bf16_t*)(ws + WS_H1G + (size_t)tok * D * 2) + loff;
        float a[16];
        {
            const u32x4 w0 = *(const u32x4*)hg, w1 = *(const u32x4*)(hg + 8);
            a[0] = bflo(w0.x); a[1] = bfhi(w0.x); a[2] = bflo(w0.y); a[3] = bfhi(w0.y); a[4] = bflo(w0.z); a[5] = bfhi(w0.z); a[6] = bflo(w0.w); a[7] = bfhi(w0.w);
            a[8] = bflo(w1.x); a[9] = bfhi(w1.x); a[10] = bflo(w1.y); a[11] = bfhi(w1.y); a[12] = bflo(w1.z); a[13] = bfhi(w1.z); a[14] = bflo(w1.w); a[15] = bfhi(w1.w);
        }
        const float rstd2 = (1.0f / U8_SCALE) / sqrtf(((const float*)(ws + WS_SS2))[tok] * (1.0f / D) + EPS);
        const int e_lo = ((const int*)(ws + WS_EIDX))[(size_t)tok * 128 + lane], e_hi = ((const int*)(ws + WS_EIDX))[(size_t)tok * 128 + 64 + lane];
        const float g_lo = ((const float*)(ws + WS_GATE))[(size_t)tok * 128 + lane], g_hi = ((const float*)(ws + WS_GATE))[(size_t)tok * 128 + 64 + lane];
        float acc[16];
#pragma unroll
        for (int i = 0; i < 16; ++i) acc[i] = 0.f;
        u32x4 uw[8], vw[8];
#pragma unroll
        for (int k = 0; k < 8; ++k) { const int e = __builtin_amdgcn_readlane(e_lo, k); uw[k] = *(const u32x4*)(U + (size_t)e * D + loff); vw[k] = *(const u32x4*)(V + (size_t)e * D + loff); }
#pragma unroll 1
        for (int b = 0; b < 16; ++b) {
            const int nsrc = (b + 1 < 8) ? e_lo : e_hi; const int nbase = ((b + 1) & 7) * 8;
            float d[8];
#pragma unroll
            for (int k = 0; k < 8; ++k) {
                float uf[16]; unpack16_fp8(uw[k], uf);
                float d0 = 0.f, d1 = 0.f;
#pragma unroll
                for (int i = 0; i < 16; i += 2) { d0 += a[i] * uf[i]; d1 += a[i + 1] * uf[i + 1]; }
                d[k] = d0 + d1;
                __builtin_amdgcn_sched_barrier(0);
            }
            if (b + 1 < 16) {
#pragma unroll
                for (int k = 0; k < 8; ++k) { const int e = __builtin_amdgcn_readlane(nsrc, nbase + k); uw[k] = *(const u32x4*)(U + (size_t)e * D + loff); }
            }
            const float dk = reduce8(d, lane);
            const float gsel = __shfl((b < 8) ? g_lo : g_hi, (b & 7) * 8 + ((lane >> 3) & 7));
            const float w = gsel * gelu_tanh(dk * rstd2);
#pragma unroll
            for (int k = 0; k < 8; ++k) {
                const float wk = __uint_as_float((unsigned)__builtin_amdgcn_readlane((int)__float_as_uint(w), 8 * k));
                float vf[16]; unpack16_fp8(vw[k], vf);
#pragma unroll
                for (int i = 0; i < 16; ++i) acc[i] += wk * vf[i];
                __builtin_amdgcn_sched_barrier(0);
            }
            if (b + 1 < 16) {
#pragma unroll
                for (int k = 0; k < 8; ++k) { const int e = __builtin_amdgcn_readlane(nsrc, nbase + k); vw[k] = *(const u32x4*)(V + (size_t)e * D + loff); }
            }
        }
        float* orow = (float*)((unsigned char*)p.out + (size_t)tok * D * 4) + loff;
        float y[16]; float ss = 0.f;
#pragma unroll
        for (int q = 0; q < 4; ++q) {
            const f32x4 h = *(const f32x4*)(orow + 4 * q);
            y[4 * q] = h.x + acc[4 * q] * (1.0f / V8_SCALE); y[4 * q + 1] = h.y + acc[4 * q + 1] * (1.0f / V8_SCALE);
            y[4 * q + 2] = h.z + acc[4 * q + 2] * (1.0f / V8_SCALE); y[4 * q + 3] = h.w + acc[4 * q + 3] * (1.0f / V8_SCALE);
        }
#pragma unroll
        for (int i = 0; i < 16; ++i) ss += y[i] * y[i];
        const float rstd = 1.0f / sqrtf(wave_sum(ss) * (1.0f / D) + EPS);
#pragma unroll
        for (int q = 0; q < 4; ++q) {
            const f32x4 g = *(const f32x4*)(p.lnf_g + loff + 4 * q);
            *(f32x4*)(orow + 4 * q) = (f32x4){y[4 * q] * rstd * g.x, y[4 * q + 1] * rstd * g.y, y[4 * q + 2] * rstd * g.z, y[4 * q + 3] * rstd * g.w};
        }
    }
}


namespace psel {
#define HD __host__ __device__ __forceinline__
HD unsigned f2ord(float f) { unsigned u = __builtin_bit_cast(unsigned, f); const unsigned m = (unsigned)((int)u >> 31); return u ^ (m | 0x80000000u); }
HD float ord2f(unsigned o) { const unsigned m = (unsigned)((int)o >> 31); return __builtin_bit_cast(float, o ^ (~m | 0x80000000u)); }
HD unsigned umax_(unsigned a, unsigned b) { return a > b ? a : b; }
HD unsigned umin_(unsigned a, unsigned b) { return a < b ? a : b; }
HD void sort16_desc(unsigned (&a)[16]) {
#pragma unroll
    for (int k = 2; k <= 16; k <<= 1)
#pragma unroll
        for (int j = k >> 1; j > 0; j >>= 1)
#pragma unroll
            for (int i = 0; i < 16; ++i) {
                const int l = i ^ j;
                if (l > i) {
                    const bool up = ((i & k) == 0);
                    const unsigned hi = umax_(a[i], a[l]), lo = umin_(a[i], a[l]);
                    a[i] = up ? hi : lo; a[l] = up ? lo : hi;
                }
            }
}
HD void merge16_desc(unsigned (&a)[16], const unsigned (&b)[16]) {
#pragma unroll
    for (int i = 0; i < 16; ++i) a[i] = umax_(a[i], b[15 - i]);
#pragma unroll
    for (int j = 8; j > 0; j >>= 1)
#pragma unroll
        for (int i = 0; i < 16; ++i) {
            const int l = i ^ j;
            if (l > i) { const unsigned hi = umax_(a[i], a[l]), lo = umin_(a[i], a[l]); a[i] = hi; a[l] = lo; }
        }
}
HD void top16_of_64(unsigned (&g0)[16], unsigned (&g1)[16], unsigned (&g2)[16], unsigned (&g3)[16]) {
    sort16_desc(g0); sort16_desc(g1); sort16_desc(g2); sort16_desc(g3);
    merge16_desc(g0, g1); merge16_desc(g2, g3); merge16_desc(g0, g2);
}
struct PairTab { int a[64]; int b[64]; int n; };
constexpr PairTab make_pairs() {
    PairTab t{}; int n = 0;
    for (int a = 0; a < 16; ++a) for (int b = 0; b < 16; ++b) if ((a + 1) * (b + 1) <= 16) { t.a[n] = a; t.b[n] = b; ++n; }
    t.n = n; for (int i = n; i < 64; ++i) { t.a[i] = 0; t.b[i] = 0; }
    return t;
}
#undef HD
typedef float f32x16 __attribute__((ext_vector_type(16)));
#define PLAS __attribute__((address_space(3)))
static constexpr PairTab PT = make_pairs();
__device__ __forceinline__ constexpr int crow_c(int r) { return (r & 3) + 8 * (r >> 2); }
__device__ __forceinline__ void phase_peer_select(const Params& p, unsigned char* lds_generic) {
    const unsigned char* ws = p.ws;
    const int tid = tid_opaque(), lane = tid & 63, wid = __builtin_amdgcn_readfirstlane(tid >> 6), r32 = lane & 31, hi = lane >> 5;
    PLAS int* tab = (PLAS int*)((PLAS unsigned char*)lds_generic) + wid * 2048;
    const int gw = (int)blockIdx.x * (NTHREADS / 64) + wid, ngw = (int)gridDim.x * (NTHREADS / 64);
    const __amdgpu_buffer_rsrc_t rq = __builtin_amdgcn_make_buffer_rsrc((void*)(p.ws + WS_QP), (short)0, (int)((size_t)NTOK * PQ * 2), 0x00020000);
    const __amdgpu_buffer_rsrc_t rk = __builtin_amdgcn_make_buffer_rsrc((void*)(p.ws + WS_PKEYS), (short)0, 16 * 128 * 128 * 2, 0x00020000);
    for (int task = gw; task < (NTOK / 32) * PH; task += ngw) {
        const int tb = task >> 3, h = task & 7, tok = 32 * tb + r32;
        int hi4 = 4 * hi; asm volatile("" : "+v"(hi4));
        unsigned k1[16], k2[16];
#pragma unroll
        for (int c = 0; c < 2; ++c) {
            const int hc = h * 2 + c;
            const unsigned qoff = (unsigned)(r32 * PQ + 8 * hi) * 2u, koff = (unsigned)(r32 * 128 + 8 * hi) * 2u;
            const int qso = (tb * 32 * PQ + hc * 128) * 2, kso = hc * 128 * 128 * 2;
            bf16x8 qf[8];
#pragma unroll
            for (int d0 = 0; d0 < 8; ++d0) qf[d0] = __builtin_bit_cast(bf16x8, __builtin_amdgcn_raw_buffer_load_b128(rq, (int)qoff, qso + 32 * d0, 0));
            unsigned g[4][16];
#pragma unroll
            for (int nt = 0; nt < 4; ++nt) {
                f32x16 acc;
#pragma unroll
                for (int r = 0; r < 16; ++r) acc[r] = 0.f;
#pragma unroll
                for (int d0 = 0; d0 < 8; ++d0) {
                    const bf16x8 kf = __builtin_bit_cast(bf16x8, __builtin_amdgcn_raw_buffer_load_b128(rk, (int)koff, kso + nt * 8192 + 32 * d0, 0));
                    acc = __builtin_amdgcn_mfma_f32_32x32x16_bf16(kf, qf[d0], acc, 0, 0, 0);
                }
#pragma unroll
                for (int r = 0; r < 16; ++r) g[nt][r] = (f2ord(acc[r]) & 0xFFFFFF80u) | (unsigned)((127 - 32 * nt - crow_c(r)) - hi4);
                __builtin_amdgcn_sched_barrier(0);
            }
            top16_of_64(g[0], g[1], g[2], g[3]);
            unsigned pb[16];
#pragma unroll
            for (int i = 0; i < 16; ++i) pb[i] = (unsigned)__shfl_xor((int)g[0][i], 32);
            merge16_desc(g[0], pb);
#pragma unroll
            for (int i = 0; i < 16; ++i) { if (c == 0) k1[i] = g[0][i]; else k2[i] = g[0][i]; }
        }
        float v1[16], v2[16];
#pragma unroll
        for (int i = 0; i < 16; ++i) { v1[i] = ord2f(k1[i] & 0xFFFFFF80u); v2[i] = ord2f(k2[i] & 0xFFFFFF80u); }
        unsigned cg[4][16];
#pragma unroll
        for (int s = 0; s < 64; ++s) {
            unsigned key = 0u;
            if (s < PT.n) key = (f2ord(v1[PT.a[s]] + v2[PT.b[s]]) & 0xFFFFFF00u) | (unsigned)(255 - (PT.a[s] * 16 + PT.b[s]));
            cg[s >> 4][s & 15] = key;
        }
        top16_of_64(cg[0], cg[1], cg[2], cg[3]);
#pragma unroll
        for (int i = 0; i < 16; ++i) { tab[i * 64 + lane] = 127 - (int)(k1[i] & 127u); tab[(16 + i) * 64 + lane] = 127 - (int)(k2[i] & 127u); }
        __builtin_amdgcn_fence(__ATOMIC_RELEASE, "wavefront"); __builtin_amdgcn_wave_barrier();
        int eo[16]; float ge[16]; float gsum = 0.f;
        const float top = ord2f(cg[0][0] & 0xFFFFFF00u);
#pragma unroll
        for (int k = 0; k < 16; ++k) {
            const int ab = 255 - (int)(cg[0][k] & 255u);
            eo[k] = tab[(ab >> 4) * 64 + lane] * PNK + tab[(16 + (ab & 15)) * 64 + lane];
            ge[k] = __expf(ord2f(cg[0][k] & 0xFFFFFF00u) - top); gsum += ge[k];
        }
        __builtin_amdgcn_wave_barrier();
        const float ginv = 1.0f / gsum;
        if (hi == 0) {
            int* eout = (int*)(p.ws + WS_EIDX) + (size_t)tok * 128 + h * 16;
            float* gout = (float*)(p.ws + WS_GATE) + (size_t)tok * 128 + h * 16;
#pragma unroll
            for (int q = 0; q < 4; ++q) {
                *(u32x4*)(eout + 4 * q) = (u32x4){(unsigned)eo[4 * q], (unsigned)eo[4 * q + 1], (unsigned)eo[4 * q + 2], (unsigned)eo[4 * q + 3]};
                *(f32x4*)(gout + 4 * q) = (f32x4){ge[4 * q] * ginv, ge[4 * q + 1] * ginv, ge[4 * q + 2] * ginv, ge[4 * q + 3] * ginv};
            }
        }
    }
}
}

namespace att {
typedef float f32x16 __attribute__((ext_vector_type(16)));
typedef short s16x4 __attribute__((ext_vector_type(4)));
typedef short v4i16_t __attribute__((ext_vector_type(4)));
#define ALAS __attribute__((address_space(3)))
typedef ALAS unsigned char* lptr;
constexpr int L_K = 0, L_V = 16384, L_IMP = 32768, L_SELM = L_IMP + 64 * 129 * 4, L_UNION = L_SELM + 1024, L_WSCR = L_UNION + 16, L_ACC = L_WSCR + 8 * 256, L_END = L_ACC + 8 * 8192;
constexpr float LOG2E = 1.4426950408889634f;
constexpr float THR = 8.0f;
__device__ __forceinline__ constexpr int crow_c(int r) { return (r & 3) + 8 * (r >> 2); }
__device__ __forceinline__ unsigned cvtpk(float lo, float hi) { typedef float f2 __attribute__((ext_vector_type(2))); typedef __bf16 b2 __attribute__((ext_vector_type(2)));
    f2 v = {lo, hi}; b2 b = __builtin_convertvector(v, b2); return __builtin_bit_cast(unsigned, b); }
__device__ __forceinline__ s16x4 vtr(lptr p) { return __builtin_bit_cast(s16x4, __builtin_amdgcn_ds_read_tr16_b64_v4i16((ALAS v4i16_t*)p)); }

struct Stage { u32x4 k, v; };
__device__ __forceinline__ void stage_load(const bf16_t* Kt, const bf16_t* Vt, int wid, int lane, Stage& s, bool withV) {
    s.k = *(const u32x4*)(Kt + (size_t)lane * 64 + wid * 8);
    if (withV) s.v = *(const u32x4*)(Vt + (size_t)(16 * (wid & 3) + (lane >> 2)) * 64 + (wid >> 2) * 32 + (lane & 3) * 8);
}
__device__ __forceinline__ void stage_store(lptr kbuf, lptr vbuf, int wid, int lane, const Stage& s, bool withV) {
    *(ALAS u32x4*)(kbuf + wid * 1024 + lane * 16) = s.k;
    if (withV) *(ALAS u32x4*)(vbuf + wid * 1024 + lane * 16) = s.v;
}
__device__ __forceinline__ void qk_tile(f32x16& p0, f32x16& p1, lptr kbuf, const bf16x8 (&qf)[4], float cb, float sk, int r32, int hi) {
    asm volatile("" : "+v"(sk));
    const float cb2 = cb + sk * (float)(4 * hi);
#pragma unroll
    for (int r = 0; r < 16; ++r) { p0[r] = cb2 + sk * (float)crow_c(r); p1[r] = cb2 + sk * (float)(crow_c(r) + 32); }
    lptr kb = kbuf + hi * 1024 + r32 * 16;
#pragma unroll
    for (int d0 = 0; d0 < 4; ++d0) {
        const bf16x8 k0 = *(const ALAS bf16x8*)(kb + d0 * 2048), k1 = *(const ALAS bf16x8*)(kb + d0 * 2048 + 512);
        p0 = __builtin_amdgcn_mfma_f32_32x32x16_bf16(k0, qf[d0], p0, 0, 0, 0);
        p1 = __builtin_amdgcn_mfma_f32_32x32x16_bf16(k1, qf[d0], p1, 0, 0, 0);
    }
}
__device__ __forceinline__ void mask_tile(f32x16& p0, f32x16& p1, int hi_lim, int lo_lim, int hi) {
    int hl = hi_lim - 4 * hi, ll1 = lo_lim + 1 - 4 * hi;
    asm volatile("" : "+v"(hl), "+v"(ll1));
#pragma unroll
    for (int r = 0; r < 16; ++r) {
        const int c0 = crow_c(r), c1 = crow_c(r) + 32;
        const unsigned t0 = (unsigned)((c0 - ll1) | (hl - c0)), t1 = (unsigned)((c1 - ll1) | (hl - c1));
        p0[r] = fminf(p0[r], __uint_as_float((t0 & 0x80000000u) | 0x7f800000u));
        p1[r] = fminf(p1[r], __uint_as_float((t1 & 0x80000000u) | 0x7f800000u));
    }
}
__device__ __forceinline__ float tile_max(const f32x16& p0, const f32x16& p1) {
    float a = fmaxf(p0[0], p1[0]);
#pragma unroll
    for (int r = 1; r < 16; ++r) a = fmaxf(a, fmaxf(p0[r], p1[r]));
    return fmaxf(a, __shfl_xor(a, 32));
}
__device__ __forceinline__ float tile_sum(const f32x16& p0, const f32x16& p1) {
    float a = p0[0] + p1[0];
#pragma unroll
    for (int r = 1; r < 16; ++r) a += p0[r] + p1[r];
    return a + __shfl_xor(a, 32);
}
__device__ __forceinline__ void pv_tile(f32x16& o0, f32x16& o1, const f32x16& p0, const f32x16& p1, lptr vbuf, int lane, int hi) {
    u32x4 pw[4];
    pw[0] = (u32x4){cvtpk(p0[0], p0[1]), cvtpk(p0[2], p0[3]), cvtpk(p0[4], p0[5]), cvtpk(p0[6], p0[7])};
    pw[1] = (u32x4){cvtpk(p0[8], p0[9]), cvtpk(p0[10], p0[11]), cvtpk(p0[12], p0[13]), cvtpk(p0[14], p0[15])};
    pw[2] = (u32x4){cvtpk(p1[0], p1[1]), cvtpk(p1[2], p1[3]), cvtpk(p1[4], p1[5]), cvtpk(p1[6], p1[7])};
    pw[3] = (u32x4){cvtpk(p1[8], p1[9]), cvtpk(p1[10], p1[11]), cvtpk(p1[12], p1[13]), cvtpk(p1[14], p1[15])};
    lptr vp = vbuf + ((lane >> 4) & 1) * 32 + (lane & 3) * 8 + (4 * hi + ((lane & 15) >> 2)) * 64;
#pragma unroll
    for (int ks = 0; ks < 4; ++ks) {
        const s16x4 a = vtr(vp + ks * 1024), b = vtr(vp + ks * 1024 + 512);
        const s16x4 c = vtr(vp + 4096 + ks * 1024), d = vtr(vp + 4096 + ks * 1024 + 512);
        const bf16x8 v0 = (bf16x8){a[0], a[1], a[2], a[3], b[0], b[1], b[2], b[3]}, v1 = (bf16x8){c[0], c[1], c[2], c[3], d[0], d[1], d[2], d[3]};
        const bf16x8 pa = __builtin_bit_cast(bf16x8, pw[ks]);
        o0 = __builtin_amdgcn_mfma_f32_32x32x16_bf16(pa, v0, o0, 0, 0, 0);
        o1 = __builtin_amdgcn_mfma_f32_32x32x16_bf16(pa, v1, o1, 0, 0, 0);
    }
}
__device__ __forceinline__ void scale_rows(f32x16& o0, f32x16& o1, float f, ALAS float* wscr, int r32, int hi) {
    if (hi == 0) wscr[r32] = f;
    __builtin_amdgcn_fence(__ATOMIC_RELEASE, "wavefront"); __builtin_amdgcn_wave_barrier();
#pragma unroll
    for (int r = 0; r < 16; ++r) { const float a = wscr[crow_c(r) + 4 * hi]; o0[r] *= a; o1[r] *= a; }
    __builtin_amdgcn_wave_barrier();
}
template <bool FIRST>
__device__ __forceinline__ void acc_rows(ALAS float* accw, const f32x16& o0, const f32x16& o1, float f, ALAS float* wscr, int r32, int hi) {
    if (hi == 0) wscr[r32] = f;
    __builtin_amdgcn_fence(__ATOMIC_RELEASE, "wavefront"); __builtin_amdgcn_wave_barrier();
#pragma unroll
    for (int r = 0; r < 16; ++r) {
        const int row = crow_c(r) + 4 * hi; const float a = wscr[row];
        ALAS float* d = accw + row * 64 + r32;
        if (FIRST) { d[0] = o0[r] * a; d[32] = o1[r] * a; } else { d[0] += o0[r] * a; d[32] += o1[r] * a; }
    }
    __builtin_amdgcn_wave_barrier();
}
__device__ __forceinline__ void store_acc(ALAS float* accw, bf16_t* O, int lane) {
    __builtin_amdgcn_fence(__ATOMIC_RELEASE, "wavefront"); __builtin_amdgcn_wave_barrier();
#pragma unroll
    for (int it = 0; it < 4; ++it) {
        const int item = it * 64 + lane, row = item >> 3, ch = item & 7;
        const f32x4 x = *(const ALAS f32x4*)(accw + row * 64 + ch * 8), y = *(const ALAS f32x4*)(accw + row * 64 + ch * 8 + 4);
        u32x4 w; w.x = cvtpk(x[0], x[1]); w.y = cvtpk(x[2], x[3]); w.z = cvtpk(y[0], y[1]); w.w = cvtpk(y[2], y[3]);
        *(u32x4*)(O + (size_t)(row & 7) * D + (row >> 3) * 64 + ch * 8) = w;
    }
    __builtin_amdgcn_wave_barrier();
}
struct Br { float m, l; f32x16 o0, o1; };
template <bool MASK>
__device__ __forceinline__ void attend_tile(Br& s, lptr kbuf, lptr vbuf, const bf16x8 (&qf)[4], float cb, float sk, int hi_lim, int lo_lim, ALAS float* wscr, int lane, int r32, int hi) {
    f32x16 p0, p1;
    qk_tile(p0, p1, kbuf, qf, cb, sk, r32, hi);
    if (MASK) mask_tile(p0, p1, hi_lim, lo_lim, hi);
    const float rm = tile_max(p0, p1);
    if (__any(rm > s.m + THR)) {
        const float mn = fmaxf(s.m, rm), alpha = __expf(s.m - mn);
        s.l *= alpha; s.m = mn;
        scale_rows(s.o0, s.o1, alpha, wscr, r32, hi);
    }
    const float mL = s.m * LOG2E;
#pragma unroll
    for (int r = 0; r < 16; ++r) { p0[r] = __builtin_amdgcn_exp2f(p0[r] * LOG2E - mL); p1[r] = __builtin_amdgcn_exp2f(p1[r] * LOG2E - mL); }
    s.l += tile_sum(p0, p1);
    pv_tile(s.o0, s.o1, p0, p1, vbuf, lane, hi);
}

__device__ __forceinline__ void nsa_unit(const Params& p, unsigned char* lds_generic, int b, int g, int tile) {
    lptr lds = (lptr)lds_generic;
    const int tid = tid_opaque(), lane = tid & 63, wid = __builtin_amdgcn_readfirstlane(tid >> 6), r32 = lane & 31, hi = lane >> 5;
    const int h = r32 >> 3, qi = r32 & 7, tq = 8 * wid + qi, t = 64 * tile + tq, head = g * 4 + h;
    const float slope = exp2f(-0.5f * (float)(9 + head));
    const unsigned char* ws = p.ws;
    ALAS float* imp = (ALAS float*)(lds + L_IMP);
    ALAS unsigned* selm = (ALAS unsigned*)(lds + L_SELM);
    ALAS unsigned* uni = (ALAS unsigned*)(lds + L_UNION);
    ALAS float* wscr = (ALAS float*)(lds + L_WSCR) + wid * 64;
    const bf16_t* KC = (const bf16_t*)(ws + WS_KC) + (size_t)(b * 2 + g) * NCMPP * 64;
    const bf16_t* VC = (const bf16_t*)(ws + WS_VC) + (size_t)(b * 2 + g) * NCMPP * 64;
    const bf16_t* KS = (const bf16_t*)(ws + WS_KV6 + 2 * KV6_STRIDE) + (size_t)(b * 2 + g) * T * 64;
    const bf16_t* VS = (const bf16_t*)(ws + WS_KV6 + 3 * KV6_STRIDE) + (size_t)(b * 2 + g) * T * 64;
    const bf16_t* KW = (const bf16_t*)(ws + WS_KV6 + 4 * KV6_STRIDE) + (size_t)(b * 2 + g) * T * 64;
    const bf16_t* VW = (const bf16_t*)(ws + WS_KV6 + 5 * KV6_STRIDE) + (size_t)(b * 2 + g) * T * 64;
    const float* gs = (const float*)(ws + WS_GSIG) + (size_t)(b * T + t) * 24 + head * 3;
    bf16x8 qf[4];
    {
        const bf16_t* qp = (const bf16_t*)(ws + WS_QN) + ((size_t)(b * 8 + head) * T + t) * 64 + 8 * hi;
#pragma unroll
        for (int d0 = 0; d0 < 4; ++d0) qf[d0] = *(const bf16x8*)(qp + 16 * d0);
    }
    for (int i = tid; i < 64 * 129; i += NTHREADS) imp[i] = 0.f;
    if (tid < 4) uni[tid] = 0u;
    ALAS float* accw = (ALAS float*)(lds + L_ACC) + wid * 2048;
    Stage st;
    const int nc = 4 * tile + 3, nct = (nc + 63) >> 6;
    const int cmax = (t >= 31) ? ((t - 31) >> 4) : -1;
    const float skc = 16.0f * slope, cbc = -slope * (float)(t - 31);
    float mc = -1e30f, lc = 0.f;
    stage_load(KC, VC, wid, lane, st, false);
    stage_store(lds + L_K, lds + L_V, wid, lane, st, false);
    __syncthreads();
    for (int i = 0; i < nct; ++i) {
        const int cur = i & 1;
        if (i + 1 < nct) stage_load(KC + (size_t)(i + 1) * 64 * 64, VC, wid, lane, st, false);
        f32x16 p0, p1;
        qk_tile(p0, p1, lds + L_K + cur * 8192, qf, cbc + skc * (float)(64 * i), skc, r32, hi);
        mask_tile(p0, p1, cmax - 64 * i, -1, hi);
        const float rm = tile_max(p0, p1), mn = fmaxf(mc, rm), mL = mn * LOG2E;
#pragma unroll
        for (int r = 0; r < 16; ++r) { p0[r] = __builtin_amdgcn_exp2f(p0[r] * LOG2E - mL); p1[r] = __builtin_amdgcn_exp2f(p1[r] * LOG2E - mL); }
        lc = lc * __expf(mc - mn) + tile_sum(p0, p1); mc = mn;
        if (i + 1 < nct) stage_store(lds + L_K + (cur ^ 1) * 8192, lds + L_V, wid, lane, st, false);
        __syncthreads();
    }
    {
        const float invl = 1.0f / fmaxf(lc, 1e-30f), mL = mc * LOG2E;
        Br sc; sc.m = 0.f; sc.l = 0.f;
#pragma unroll
        for (int r = 0; r < 16; ++r) { sc.o0[r] = 0.f; sc.o1[r] = 0.f; }
        stage_load(KC, VC, wid, lane, st, true);
        stage_store(lds + L_K, lds + L_V, wid, lane, st, true);
        __syncthreads();
        for (int i = 0; i < nct; ++i) {
            const int cur = i & 1;
            if (i + 1 < nct) stage_load(KC + (size_t)(i + 1) * 64 * 64, VC + (size_t)(i + 1) * 64 * 64, wid, lane, st, true);
            f32x16 p0, p1;
            qk_tile(p0, p1, lds + L_K + cur * 8192, qf, cbc + skc * (float)(64 * i), skc, r32, hi);
            mask_tile(p0, p1, cmax - 64 * i, -1, hi);
#pragma unroll
            for (int r = 0; r < 16; ++r) { p0[r] = __builtin_amdgcn_exp2f(p0[r] * LOG2E - mL) * invl; p1[r] = __builtin_amdgcn_exp2f(p1[r] * LOG2E - mL) * invl; }
            pv_tile(sc.o0, sc.o1, p0, p1, lds + L_V + cur * 8192, lane, hi);
#pragma unroll
            for (int kh = 0; kh < 2; ++kh)
#pragma unroll
                for (int gq = 0; gq < 4; ++gq) {
                    const float e3 = kh ? p1[4 * gq + 3] : p0[4 * gq + 3];
                    float s4 = kh ? ((p1[4 * gq] + p1[4 * gq + 1]) + (p1[4 * gq + 2] + e3)) : ((p0[4 * gq] + p0[4 * gq + 1]) + (p0[4 * gq + 2] + e3));
                    float e = e3;
                    s4 += __shfl_xor(s4, 8); e += __shfl_xor(e, 8);
                    s4 += __shfl_xor(s4, 16); e += __shfl_xor(e, 16);
                    const int sb = 16 * i + 8 * kh + 2 * gq + hi;
                    if (r32 < 8) { atomicAdd((float*)(imp + tq * 129 + sb), s4); if (sb + 1 < NSEL) atomicAdd((float*)(imp + tq * 129 + sb + 1), e); }
                }
            if (i + 1 < nct) stage_store(lds + L_K + (cur ^ 1) * 8192, lds + L_V + (cur ^ 1) * 8192, wid, lane, st, true);
            __syncthreads();
        }
        acc_rows<true>(accw, sc.o0, sc.o1, gs[0], wscr, r32, hi);
    }
    {
        const int q = tid >> 3, sub = tid & 7;
        float v[16];
#pragma unroll
        for (int i = 0; i < 16; ++i) {
            const int j = sub * 16 + i; float x = imp[q * 129 + j];
            if (j == 0 || j == tile || j == tile - 1) x = 1.0e4f;
            if (j > tile) x = -INFINITY;
            v[i] = x;
        }
        unsigned w0 = 0u, w1 = 0u, w2 = 0u, w3 = 0u;
        for (int it = 0; it < TOPN; ++it) {
            float best = v[0]; int bi = 0;
#pragma unroll
            for (int i = 1; i < 16; ++i) if (v[i] > best) { best = v[i]; bi = i; }
            int bj = sub * 16 + bi;
#pragma unroll
            for (int off = 1; off < 8; off <<= 1) {
                const float ob = __shfl_xor(best, off); const int oj = __shfl_xor(bj, off);
                const bool take = (ob > best) || (ob == best && oj < bj);
                best = take ? ob : best; bj = take ? oj : bj;
            }
            if (best > -INFINITY) {
                const int k = bj >> 5; const unsigned bit = 1u << (bj & 31);
                w0 |= (k == 0) ? bit : 0u; w1 |= (k == 1) ? bit : 0u; w2 |= (k == 2) ? bit : 0u; w3 |= (k == 3) ? bit : 0u;
                const int own = bj - sub * 16;
#pragma unroll
                for (int i = 0; i < 16; ++i) v[i] = (i == own) ? -INFINITY : v[i];
            }
        }
        if (sub == 0) {
            selm[q * 4 + 0] = w0; selm[q * 4 + 1] = w1; selm[q * 4 + 2] = w2; selm[q * 4 + 3] = w3;
            atomicOr((unsigned*)(uni + 0), w0); atomicOr((unsigned*)(uni + 1), w1); atomicOr((unsigned*)(uni + 2), w2); atomicOr((unsigned*)(uni + 3), w3);
        }
    }
    __syncthreads();
    {
        unsigned u0 = uni[0], u1 = uni[1], u2 = uni[2], u3 = uni[3];
        u0 = __builtin_amdgcn_readfirstlane(u0); u1 = __builtin_amdgcn_readfirstlane(u1); u2 = __builtin_amdgcn_readfirstlane(u2); u3 = __builtin_amdgcn_readfirstlane(u3);
        const unsigned s0 = selm[tq * 4 + 0], s1 = selm[tq * 4 + 1], s2 = selm[tq * 4 + 2], s3 = selm[tq * 4 + 3];
        Br sb_; sb_.m = -1e30f; sb_.l = 0.f;
#pragma unroll
        for (int r = 0; r < 16; ++r) { sb_.o0[r] = 0.f; sb_.o1[r] = 0.f; }
#define POP_BLOCK(j) do { if (u3) { const int bb = 31 - __builtin_clz(u3); u3 ^= 1u << bb; j = 96 + bb; } else if (u2) { const int bb = 31 - __builtin_clz(u2); u2 ^= 1u << bb; j = 64 + bb; } \
        else if (u1) { const int bb = 31 - __builtin_clz(u1); u1 ^= 1u << bb; j = 32 + bb; } else if (u0) { const int bb = 31 - __builtin_clz(u0); u0 ^= 1u << bb; j = bb; } else j = -1; } while (0)
        int j; POP_BLOCK(j);
        if (j >= 0) {
            stage_load(KS + (size_t)j * 64 * 64, VS + (size_t)j * 64 * 64, wid, lane, st, true);
            stage_store(lds + L_K, lds + L_V, wid, lane, st, true);
        }
        __syncthreads();
        int cur = 0;
        while (j >= 0) {
            int jn; POP_BLOCK(jn);
            if (jn >= 0) stage_load(KS + (size_t)jn * 64 * 64, VS + (size_t)jn * 64 * 64, wid, lane, st, true);
            const unsigned wsel = (j >> 5) == 0 ? s0 : (j >> 5) == 1 ? s1 : (j >> 5) == 2 ? s2 : s3;
            const bool mine = (wsel >> (j & 31)) & 1u;
            if (__any(mine)) {
                const int hl = mine ? ((j == tile) ? tq : 63) : -1;
                const float cb = -slope * (float)(t - 64 * j);
                attend_tile<true>(sb_, lds + L_K + cur * 8192, lds + L_V + cur * 8192, qf, cb, slope, hl, -1, wscr, lane, r32, hi);
            }
            if (jn >= 0) stage_store(lds + L_K + (cur ^ 1) * 8192, lds + L_V + (cur ^ 1) * 8192, wid, lane, st, true);
            __syncthreads();
            cur ^= 1; j = jn;
        }
#undef POP_BLOCK
        acc_rows<false>(accw, sb_.o0, sb_.o1, gs[1] / fmaxf(sb_.l, 1e-30f), wscr, r32, hi);
    }
    {
        Br sw; sw.m = -1e30f; sw.l = 0.f;
#pragma unroll
        for (int r = 0; r < 16; ++r) { sw.o0[r] = 0.f; sw.o1[r] = 0.f; }
        const int jlo = (tile - 8 > 0) ? tile - 8 : 0;
        stage_load(KW + (size_t)tile * 64 * 64, VW + (size_t)tile * 64 * 64, wid, lane, st, true);
        stage_store(lds + L_K, lds + L_V, wid, lane, st, true);
        __syncthreads();
        int cur = 0;
        for (int j = tile; j >= jlo; --j) {
            if (j > jlo) stage_load(KW + (size_t)(j - 1) * 64 * 64, VW + (size_t)(j - 1) * 64 * 64, wid, lane, st, true);
            const float cb = -slope * (float)(t - 64 * j);
            if (j == tile) attend_tile<true>(sw, lds + L_K + cur * 8192, lds + L_V + cur * 8192, qf, cb, slope, tq, -1, wscr, lane, r32, hi);
            else if (j == tile - 8) attend_tile<true>(sw, lds + L_K + cur * 8192, lds + L_V + cur * 8192, qf, cb, slope, 63, tq, wscr, lane, r32, hi);
            else attend_tile<false>(sw, lds + L_K + cur * 8192, lds + L_V + cur * 8192, qf, cb, slope, 63, -1, wscr, lane, r32, hi);
            if (j > jlo) stage_store(lds + L_K + (cur ^ 1) * 8192, lds + L_V + (cur ^ 1) * 8192, wid, lane, st, true);
            __syncthreads();
            cur ^= 1;
        }
        acc_rows<false>(accw, sw.o0, sw.o1, gs[2] / fmaxf(sw.l, 1e-30f), wscr, r32, hi);
    }
    store_acc(accw, (bf16_t*)(p.ws + WS_O) + (size_t)(b * T + 64 * tile + 8 * wid) * D + g * 256, lane);
}

__device__ __forceinline__ void swa_unit(const Params& p, unsigned char* lds_generic, int b, int hh, int tile) {
    lptr lds = (lptr)lds_generic;
    const int tid = tid_opaque(), lane = tid & 63, wid = __builtin_amdgcn_readfirstlane(tid >> 6), r32 = lane & 31, hi = lane >> 5;
    const int h = r32 >> 3, qi = r32 & 7, tq = 8 * wid + qi, t = 64 * tile + tq, head = hh * 4 + h;
    const float slope = exp2f(-0.5f * (float)(head + 1));
    const unsigned char* ws = p.ws;
    ALAS float* wscr = (ALAS float*)(lds + L_WSCR) + wid * 64;
    const bf16_t* K = (const bf16_t*)(ws + WS_KSW) + (size_t)b * T * 64;
    const bf16_t* V = (const bf16_t*)(ws + WS_VSW) + (size_t)b * T * 64;
    bf16x8 qf[4];
    {
        const bf16_t* qp = (const bf16_t*)(ws + WS_QS) + ((size_t)(b * 8 + head) * T + t) * 64 + 8 * hi;
#pragma unroll
        for (int d0 = 0; d0 < 4; ++d0) qf[d0] = *(const bf16x8*)(qp + 16 * d0);
    }
    Br sw; sw.m = p.sinks[head]; sw.l = 1.0f;
#pragma unroll
    for (int r = 0; r < 16; ++r) { sw.o0[r] = 0.f; sw.o1[r] = 0.f; }
    Stage st;
    const int jlo = (tile - 2 > 0) ? tile - 2 : 0;
    stage_load(K + (size_t)tile * 64 * 64, V + (size_t)tile * 64 * 64, wid, lane, st, true);
    stage_store(lds + L_K, lds + L_V, wid, lane, st, true);
    __syncthreads();
    int cur = 0;
    for (int j = tile; j >= jlo; --j) {
        if (j > jlo) stage_load(K + (size_t)(j - 1) * 64 * 64, V + (size_t)(j - 1) * 64 * 64, wid, lane, st, true);
        const float cb = -slope * (float)(t - 64 * j);
        if (j == tile) attend_tile<true>(sw, lds + L_K + cur * 8192, lds + L_V + cur * 8192, qf, cb, slope, tq, -1, wscr, lane, r32, hi);
        else if (j == tile - 2) attend_tile<true>(sw, lds + L_K + cur * 8192, lds + L_V + cur * 8192, qf, cb, slope, 63, tq, wscr, lane, r32, hi);
        else attend_tile<false>(sw, lds + L_K + cur * 8192, lds + L_V + cur * 8192, qf, cb, slope, 63, -1, wscr, lane, r32, hi);
        if (j > jlo) stage_store(lds + L_K + (cur ^ 1) * 8192, lds + L_V + (cur ^ 1) * 8192, wid, lane, st, true);
        __syncthreads();
        cur ^= 1;
    }
    ALAS float* accw = (ALAS float*)(lds + L_ACC) + wid * 2048;
    acc_rows<true>(accw, sw.o0, sw.o1, 1.0f / sw.l, wscr, r32, hi);
    store_acc(accw, (bf16_t*)(p.ws + WS_O) + (size_t)(b * T + 64 * tile + 8 * wid) * D + 512 + hh * 256, lane);
}
__device__ __forceinline__ void phase_swa_mfma(const Params& p, unsigned char* lds) {
    for (int u = blockIdx.x; u < BATCH * 2 * (T / 64); u += gridDim.x) swa_unit(p, lds, u >> 8, (u >> 7) & 1, u & 127);
}
__device__ __forceinline__ void phase_nsa_mfma(const Params& p, unsigned char* lds) {
    const int nu = BATCH * NSA_G * (T / 64);
    for (int i = blockIdx.x; i < nu; i += gridDim.x) {
        const int u = (i < (int)gridDim.x) ? (nu - 1 - i) : (i - (int)gridDim.x);
        nsa_unit(p, lds, u >> 8, (u >> 7) & 1, u & 127);
    }
}
}


namespace cmp {
#define CLAS __attribute__((address_space(3)))
constexpr int HS = 264;
__device__ __forceinline__ void compress_unit(const Params& p, unsigned char* lds_generic, int unit) {
    const unsigned char* ws = p.ws;
    const int tid = tid_opaque(), lane = tid & 63, wid = __builtin_amdgcn_readfirstlane(tid >> 6), fr = lane & 15, fq = lane >> 4;
    const int row0 = unit * 32, kv = row0 >> 11, bg = (row0 & 2047) >> 9, c0 = row0 & 511;
    const bf16_t* raw = (const bf16_t*)(ws + WS_KV6 + (size_t)kv * KV6_STRIDE) + (size_t)bg * T * 64;
    const bf16_t* W1T = (const bf16_t*)(ws + WS_W1T) + (size_t)kv * 256 * 2048;
    const bf16_t* W2T = (const bf16_t*)(ws + WS_W2T) + (size_t)kv * 64 * 256;
    const float* b1 = (const float*)(ws + WS_B1) + kv * 256;
    CLAS bf16_t* H = (CLAS bf16_t*)((CLAS unsigned char*)lds_generic);
    const int n0 = wid * 32;
    f32x4 acc[2][2];
#pragma unroll
    for (int i = 0; i < 2; ++i)
#pragma unroll
        for (int j = 0; j < 2; ++j) acc[i][j] = (f32x4){0.f, 0.f, 0.f, 0.f};
    const bf16_t* ap = raw + (size_t)(c0 + fr) * 1024 + fq * 8;
    const bf16_t* bp = W1T + (size_t)(n0 + fr) * 2048 + fq * 8;
    bf16x8 a[2], b[2], an[2], bn[2];
#pragma unroll
    for (int i = 0; i < 2; ++i) { a[i] = *(const bf16x8*)(ap + (size_t)i * 16 * 1024); b[i] = *(const bf16x8*)(bp + (size_t)i * 16 * 2048); }
    for (int k0 = 0; k0 < 2048; k0 += 32) {
        if (k0 + 32 < 2048) {
#pragma unroll
            for (int i = 0; i < 2; ++i) { an[i] = *(const bf16x8*)(ap + (size_t)i * 16 * 1024 + k0 + 32); bn[i] = *(const bf16x8*)(bp + (size_t)i * 16 * 2048 + k0 + 32); }
        }
#pragma unroll
        for (int i = 0; i < 2; ++i)
#pragma unroll
            for (int j = 0; j < 2; ++j) acc[i][j] = __builtin_amdgcn_mfma_f32_16x16x32_bf16(a[i], b[j], acc[i][j], 0, 0, 0);
#pragma unroll
        for (int i = 0; i < 2; ++i) { a[i] = an[i]; b[i] = bn[i]; }
    }
#pragma unroll
    for (int i = 0; i < 2; ++i)
#pragma unroll
        for (int j = 0; j < 2; ++j) {
            const int n = n0 + 16 * j + fr; const float bias = b1[n];
#pragma unroll
            for (int r = 0; r < 4; ++r) H[(16 * i + 4 * fq + r) * HS + n] = (bf16_t)f2bf(gelu_tanh(acc[i][j][r] + bias));
        }
    __syncthreads();
    {
        const int mi = wid >> 2, nj = wid & 3;
        f32x4 o = (f32x4){0.f, 0.f, 0.f, 0.f};
        const CLAS bf16_t* hp = H + (16 * mi + fr) * HS + fq * 8;
        const bf16_t* wp = W2T + (size_t)(16 * nj + fr) * 256 + fq * 8;
#pragma unroll
        for (int k0 = 0; k0 < 256; k0 += 32) {
            const bf16x8 ha = *(const CLAS bf16x8*)(hp + k0), wb = *(const bf16x8*)(wp + k0);
            o = __builtin_amdgcn_mfma_f32_16x16x32_bf16(ha, wb, o, 0, 0, 0);
        }
        bf16_t* dst = (bf16_t*)(p.ws + (kv ? WS_VC : WS_KC)) + ((size_t)bg * NCMPP + c0 + 16 * mi + 4 * fq) * 64 + 16 * nj + fr;
#pragma unroll
        for (int r = 0; r < 4; ++r) dst[(size_t)r * 64] = (bf16_t)f2bf(o[r]);
    }
    __syncthreads();
}
__device__ __forceinline__ void phase_compress_swa(const Params& p, unsigned char* lds) {
    const int G = (int)gridDim.x, bx = (int)blockIdx.x;
    if (G >= 256) {
        if (bx < 128) { compress_unit(p, lds, bx); }
        else { for (int u = bx - 128; u < BATCH * 2 * (T / 64); u += G - 128) att::swa_unit(p, lds, u >> 8, (u >> 7) & 1, u & 127); }
    } else {
        for (int u = bx; u < 128; u += G) compress_unit(p, lds, u);
        for (int u = bx; u < BATCH * 2 * (T / 64); u += G) att::swa_unit(p, lds, u >> 8, (u >> 7) & 1, u & 127);
    }
}
}

#define XB_TMO      128
#define XB_XCNT(j)  (256  + 64 * (j))
#define XB_XSUB(j)  (1280 + 64 * (j))
#define XB_XGEN(j)  (2304 + 64 * (j))
#define XB_TOP      3328
#define XB_TOPGEN   3392
#define XCD_BAR_WORDS 3456
#define XB_SPIN_CAP (1u << 18)
#define XLAS __attribute__((address_space(3)))

__device__ __forceinline__ unsigned xb_ld(unsigned* p)              { return __hip_atomic_load(p, __ATOMIC_RELAXED, __HIP_MEMORY_SCOPE_AGENT); }
__device__ __forceinline__ unsigned xb_add(unsigned* p, unsigned v) { return __hip_atomic_fetch_add(p, v, __ATOMIC_RELAXED, __HIP_MEMORY_SCOPE_AGENT); }
__device__ __forceinline__ unsigned xb_xcc_id() { return (unsigned)__builtin_amdgcn_s_getreg((3 << 11) | 20) & 0xFu; }
#define XB_SPIN(cond, bar) do { unsigned _sp = 0; while (cond) { __builtin_amdgcn_s_sleep(1); \
    if ((++_sp & 255u) == 0u) { if (xb_ld(&(bar)[XB_TMO])) break; if (_sp > XB_SPIN_CAP) { atomicAdd(&(bar)[XB_TMO], 1u); break; } } } } while (0)

struct XcdBarrier {
    unsigned* bar; unsigned x;
    volatile XLAS unsigned* st;
};

__device__ __forceinline__ XcdBarrier xcd_barrier_post(unsigned* bar, volatile XLAS unsigned* st) {
    XcdBarrier b; b.bar = bar; b.x = xb_xcc_id(); b.st = st;
    if (threadIdx.x == 0) (void)xb_add(&bar[XB_XCNT(b.x)], 1u);
    return b;
}
__device__ __forceinline__ void xcd_barrier_complete(unsigned* bar, unsigned x, unsigned& nloc, unsigned& nx) {
    const unsigned G = gridDim.x * gridDim.y * gridDim.z;
    unsigned sum, cnt, mine, sp = 0u;
    for (;;) {
        sum = 0u; cnt = 0u; mine = 0u;
#pragma unroll
        for (unsigned j = 0; j < 16; ++j) { const unsigned c = xb_ld(&bar[XB_XCNT(j)]); sum += c; cnt += (c > 0u) ? 1u : 0u; mine = (j == x) ? c : mine; }
        if (sum == G) break;
        __builtin_amdgcn_s_sleep(1);
        if ((++sp & 255u) == 0u) { if (xb_ld(&bar[XB_TMO])) break; if (sp > XB_SPIN_CAP) { atomicAdd(&bar[XB_TMO], 1u); break; } }
    }
    nloc = mine > 0u ? mine : 1u; nx = cnt > 0u ? cnt : 1u;
}

__device__ __forceinline__ void xcd_barrier(const XcdBarrier& b) {
    asm volatile("s_waitcnt vmcnt(0)" ::: "memory");
    __syncthreads();
    if (threadIdx.x == 0) {
        unsigned* bar = b.bar;
        __builtin_amdgcn_s_waitcnt(0);
        unsigned nloc = b.st[0], nx = b.st[1];
        if (nloc == 0u) { xcd_barrier_complete(bar, b.x, nloc, nx); b.st[0] = nloc; b.st[1] = nx; }
        const unsigned old = xb_add(&bar[XB_XSUB(b.x)], 1u);
        const unsigned gen = old / nloc;
        if (old + 1u == (gen + 1u) * nloc) {
            __builtin_amdgcn_fence(__ATOMIC_RELEASE, "agent");
            asm volatile("s_waitcnt vmcnt(0)" ::: "memory");
            const unsigned og = xb_add(&bar[XB_TOP], 1u);
            const unsigned tg = og / nx;
            if (og + 1u == (tg + 1u) * nx) xb_add(&bar[XB_TOPGEN], 1u);
            else XB_SPIN(xb_ld(&bar[XB_TOPGEN]) == tg, bar);
            __builtin_amdgcn_fence(__ATOMIC_ACQUIRE, "agent");
            xb_add(&bar[XB_XGEN(b.x)], 1u);
            asm volatile("s_waitcnt vmcnt(0)" ::: "memory");
        } else {
            XB_SPIN(xb_ld(&bar[XB_XGEN(b.x)]) == gen, bar);
            __builtin_amdgcn_fence(__ATOMIC_ACQUIRE, "agent");
            asm volatile("s_waitcnt vmcnt(0)" ::: "memory");
        }
    }
    __syncthreads();
}


namespace pex {
constexpr int TOK_PER_TICKET = 8, NTICKET = NTOK / TOK_PER_TICKET;
__device__ __forceinline__ int claim(unsigned* ctr, int lane) {
    unsigned t = 0u;
    if (lane == 0) t = __hip_atomic_fetch_add(ctr, 1u, __ATOMIC_RELAXED, __HIP_MEMORY_SCOPE_AGENT);
    return __builtin_amdgcn_readfirstlane((int)t);
}
struct UMeta { int e_lo, e_hi; float g_lo, g_hi; u32x4 h0, h1; float ss; };
__device__ __forceinline__ void u_meta(const unsigned char* ws, int tok, int lane, unsigned loff, UMeta& m) {
    const int* ep = (const int*)(ws + WS_EIDX) + (size_t)tok * 128;
    m.e_lo = ep[lane]; m.e_hi = ep[64 + lane];
    const float* gp = (const float*)(ws + WS_GATE) + (size_t)tok * 128;
    m.g_lo = gp[lane]; m.g_hi = gp[64 + lane];
    const bf16_t* hg = (const bf16_t*)(ws + WS_H1G + (size_t)tok * D * 2) + loff;
    m.h0 = *(const u32x4*)hg; m.h1 = *(const u32x4*)(hg + 8);
    m.ss = ((const float*)(ws + WS_SS2))[tok];
}
constexpr int UB = 16;
__device__ __forceinline__ void u_task(const unsigned char* ws, int tok, int y, int lane, unsigned loff, const UMeta& m, int tok_next, UMeta& mn) {
    unsigned long long m0 = __ballot((m.e_lo >> 11) == y), m1 = __ballot((m.e_hi >> 11) == y);
    const unsigned char* U = ws + WS_U8;
    const int grp = (lane >> 3) & 7;
    bool first = true;
    f32x2 a2[8]; float rstd2 = 0.f;
    do {
        int slot[UB]; u32x4 uw[UB];
#pragma unroll
        for (int k = 0; k < UB; ++k) {
            int e = 0; slot[k] = -1;
            if (m0 != 0ull) { const int j = __builtin_ctzll(m0); m0 &= m0 - 1ull; slot[k] = j; e = __builtin_amdgcn_readlane(m.e_lo, j); }
            else if (m1 != 0ull) { const int j = __builtin_ctzll(m1); m1 &= m1 - 1ull; slot[k] = 64 + j; e = __builtin_amdgcn_readlane(m.e_hi, j); }
            if (slot[k] >= 0) uw[k] = *(const u32x4*)(U + (size_t)e * D + loff); else uw[k] = (u32x4){0u, 0u, 0u, 0u};
        }
        if (first) {
            if (tok_next >= 0) u_meta(ws, tok_next, lane, loff, mn);
            const u32x4 w0 = m.h0, w1 = m.h1;
            a2[0] = (f32x2){bflo(w0.x), bfhi(w0.x)}; a2[1] = (f32x2){bflo(w0.y), bfhi(w0.y)}; a2[2] = (f32x2){bflo(w0.z), bfhi(w0.z)}; a2[3] = (f32x2){bflo(w0.w), bfhi(w0.w)};
            a2[4] = (f32x2){bflo(w1.x), bfhi(w1.x)}; a2[5] = (f32x2){bflo(w1.y), bfhi(w1.y)}; a2[6] = (f32x2){bflo(w1.z), bfhi(w1.z)}; a2[7] = (f32x2){bflo(w1.w), bfhi(w1.w)};
            rstd2 = (1.0f / U8_SCALE) / sqrtf(m.ss * (1.0f / D) + EPS);
            first = false;
        }
#pragma unroll
        for (int hb = 0; hb < UB / 8; ++hb) {
            if (slot[8 * hb] < 0) break;
            float d[8];
#pragma unroll
            for (int k = 0; k < 8; ++k) {
                f32x2 dd = (f32x2){0.f, 0.f};
#pragma unroll
                for (int q = 0; q < 4; ++q) {
                    const f32x2 lo = __builtin_amdgcn_cvt_pk_f32_fp8((int)uw[8 * hb + k][q], false), hi = __builtin_amdgcn_cvt_pk_f32_fp8((int)uw[8 * hb + k][q], true);
                    dd += a2[2 * q] * lo; dd += a2[2 * q + 1] * hi;
                }
                d[k] = dd.x + dd.y;
                __builtin_amdgcn_sched_barrier(0);
            }
            const float dk = reduce8(d, lane);
            int myslot = -1;
#pragma unroll
            for (int k = 0; k < 8; ++k) myslot = (grp == k) ? slot[8 * hb + k] : myslot;
            const float gA = __shfl(m.g_lo, myslot & 63), gB = __shfl(m.g_hi, myslot & 63);
            const float g = (myslot & 64) ? gB : gA;
            if (myslot >= 0 && (lane & 7) == 0) ((float*)(ws + WS_PW))[(size_t)tok * 128 + myslot] = g * gelu_tanh(dk * rstd2);
        }
    } while ((m0 | m1) != 0ull);
}
struct VMeta { u32x4 e[4]; };
__device__ __forceinline__ void v_meta(const Params& p, int tok, int y, int lane, VMeta& m) {
    const unsigned char* ep = p.ws + WS_EIDX + (size_t)tok * 512;
    const unsigned eoff = (unsigned)(lane >> 3) * 64u;
#pragma unroll
    for (int q = 0; q < 4; ++q) m.e[q] = *(const u32x4*)(ep + eoff + 16 * q);
}
__device__ __forceinline__ void ucol_task(const Params& p, int tok, int y, int lane, const VMeta& m, int tok_next, VMeta& mn) {
    const int cc = lane & 7;
    const bool b2 = lane & 4, b1 = lane & 2, b0 = lane & 1;
    const __amdgpu_buffer_rsrc_t ru = __builtin_amdgcn_make_buffer_rsrc((void*)(p.ws + WS_U8 + (size_t)y * ((size_t)NEXP * 128)), (short)0, NEXP * 128, 0x00020000);
    const unsigned coff = (unsigned)cc * 16u;
    u32x4 uw[16];
#pragma unroll
    for (int q = 0; q < 4; ++q) {
        uw[4 * q] = __builtin_bit_cast(u32x4, __builtin_amdgcn_raw_buffer_load_b128(ru, (int)(m.e[q].x * 128u + coff), 0, 0));
        uw[4 * q + 1] = __builtin_bit_cast(u32x4, __builtin_amdgcn_raw_buffer_load_b128(ru, (int)(m.e[q].y * 128u + coff), 0, 0));
        uw[4 * q + 2] = __builtin_bit_cast(u32x4, __builtin_amdgcn_raw_buffer_load_b128(ru, (int)(m.e[q].z * 128u + coff), 0, 0));
        uw[4 * q + 3] = __builtin_bit_cast(u32x4, __builtin_amdgcn_raw_buffer_load_b128(ru, (int)(m.e[q].w * 128u + coff), 0, 0));
    }
    f32x2 a2[8];
    {
        const unsigned char* hp = p.ws + WS_H1G + (size_t)tok * D * 2 + (size_t)y * 256;
        const u32x4 w0 = *(const u32x4*)(hp + cc * 32u), w1 = *(const u32x4*)(hp + cc * 32u + 16u);
        a2[0] = (f32x2){bflo(w0.x), bfhi(w0.x)}; a2[1] = (f32x2){bflo(w0.y), bfhi(w0.y)}; a2[2] = (f32x2){bflo(w0.z), bfhi(w0.z)}; a2[3] = (f32x2){bflo(w0.w), bfhi(w0.w)};
        a2[4] = (f32x2){bflo(w1.x), bfhi(w1.x)}; a2[5] = (f32x2){bflo(w1.y), bfhi(w1.y)}; a2[6] = (f32x2){bflo(w1.z), bfhi(w1.z)}; a2[7] = (f32x2){bflo(w1.w), bfhi(w1.w)};
    }
    if (tok_next >= 0) v_meta(p, tok_next, y, lane, mn);
    float d[16];
#pragma unroll
    for (int i = 0; i < 16; ++i) {
        f32x2 dd = (f32x2){0.f, 0.f};
#pragma unroll
        for (int q = 0; q < 4; ++q) {
            const f32x2 lo = __builtin_amdgcn_cvt_pk_f32_fp8((int)uw[i][q], false), hi = __builtin_amdgcn_cvt_pk_f32_fp8((int)uw[i][q], true);
            dd += a2[2 * q] * lo; dd += a2[2 * q + 1] * hi;
        }
        d[i] = dd.x + dd.y;
        __builtin_amdgcn_sched_barrier(0);
    }
    float s8[8], s4[4], s2[2];
#pragma unroll
    for (int i = 0; i < 8; ++i) { const float snd = b2 ? d[i] : d[i + 8], keep = b2 ? d[i + 8] : d[i]; s8[i] = keep + __shfl_xor(snd, 4); }
#pragma unroll
    for (int i = 0; i < 4; ++i) { const float snd = b1 ? s8[i] : s8[i + 4], keep = b1 ? s8[i + 4] : s8[i]; s4[i] = keep + __shfl_xor(snd, 2); }
#pragma unroll
    for (int i = 0; i < 2; ++i) { const float snd = b0 ? s4[i] : s4[i + 2], keep = b0 ? s4[i + 2] : s4[i]; s2[i] = keep + __shfl_xor(snd, 1); }
    const unsigned so = (unsigned)(16 * (lane >> 3) + (b2 ? 8 : 0) + (b1 ? 4 : 0) + (b0 ? 2 : 0)) * 4u;
    *(f32x2*)(p.ws + WS_PART + ((size_t)tok * 8 + y) * 512 + so) = (f32x2){s2[0], s2[1]};
}
__device__ __forceinline__ void phase_expert_act(const Params& p) {
    const int tid_ = tid_opaque(), lane = tid_ & 63;
    const int gw = (int)blockIdx.x * (NTHREADS / 64) + __builtin_amdgcn_readfirstlane(tid_ >> 6), ngw = (int)gridDim.x * (NTHREADS / 64);
    for (int tok = gw; tok < NTOK; tok += ngw) {
        const float* pp = (const float*)(p.ws + WS_PART) + (size_t)tok * 1024;
        float sa = 0.f, sb = 0.f;
#pragma unroll
        for (int y = 0; y < 8; ++y) { sa += pp[y * 128 + lane]; sb += pp[y * 128 + 64 + lane]; }
        const float rstd2 = (1.0f / U8_SCALE) / sqrtf(((const float*)(p.ws + WS_SS2))[tok] * (1.0f / D) + EPS);
        const float* gp = (const float*)(p.ws + WS_GATE) + (size_t)tok * 128;
        float* wp = (float*)(p.ws + WS_PW) + (size_t)tok * 128;
        wp[lane] = gp[lane] * gelu_tanh(sa * rstd2);
        wp[64 + lane] = gp[64 + lane] * gelu_tanh(sb * rstd2);
    }
}
__device__ __forceinline__ void v_task(const Params& p, int tok, int y, int lane, const VMeta& m, int tok_next, VMeta& mn) {
    const int cc = lane & 7;
    const bool b5 = lane & 32, b4 = lane & 16, b3 = lane & 8;
    const __amdgpu_buffer_rsrc_t rv = __builtin_amdgcn_make_buffer_rsrc((void*)(p.ws + WS_V8 + (size_t)y * ((size_t)NEXP * 128)), (short)0, NEXP * 128, 0x00020000);
    const unsigned coff = (unsigned)cc * 16u;
    u32x4 vw[16];
#pragma unroll
    for (int q = 0; q < 4; ++q) {
        vw[4 * q] = __builtin_bit_cast(u32x4, __builtin_amdgcn_raw_buffer_load_b128(rv, (int)(m.e[q].x * 128u + coff), 0, 0));
        vw[4 * q + 1] = __builtin_bit_cast(u32x4, __builtin_amdgcn_raw_buffer_load_b128(rv, (int)(m.e[q].y * 128u + coff), 0, 0));
        vw[4 * q + 2] = __builtin_bit_cast(u32x4, __builtin_amdgcn_raw_buffer_load_b128(rv, (int)(m.e[q].z * 128u + coff), 0, 0));
        vw[4 * q + 3] = __builtin_bit_cast(u32x4, __builtin_amdgcn_raw_buffer_load_b128(rv, (int)(m.e[q].w * 128u + coff), 0, 0));
    }
    f32x4 w[4];
    {
        const unsigned char* wp = p.ws + WS_PW + (size_t)tok * 512;
        const unsigned woff = (unsigned)(lane >> 3) * 64u;
#pragma unroll
        for (int q = 0; q < 4; ++q) w[q] = *(const f32x4*)(wp + woff + 16 * q);
    }
    const unsigned colb = (unsigned)(128 * y + 16 * cc + (b5 ? 8 : 0) + (b4 ? 4 : 0) + (b3 ? 2 : 0)) * 4u;
    float* orow = (float*)((unsigned char*)p.out + (size_t)tok * D * 4);
    const f32x2 h = *(const f32x2*)((const unsigned char*)orow + colb);
    if (tok_next >= 0) v_meta(p, tok_next, y, lane, mn);
    f32x2 acc2[8];
#pragma unroll
    for (int q = 0; q < 8; ++q) acc2[q] = (f32x2){0.f, 0.f};
#pragma unroll
    for (int i = 0; i < 16; ++i) {
        const float wi = w[i >> 2][i & 3];
#pragma unroll
        for (int q = 0; q < 4; ++q) {
            const f32x2 lo = __builtin_amdgcn_cvt_pk_f32_fp8((int)vw[i][q], false), hi = __builtin_amdgcn_cvt_pk_f32_fp8((int)vw[i][q], true);
            acc2[2 * q] += lo * wi; acc2[2 * q + 1] += hi * wi;
        }
        __builtin_amdgcn_sched_barrier(0);
    }
    float acc[16];
#pragma unroll
    for (int q = 0; q < 8; ++q) { acc[2 * q] = acc2[q].x; acc[2 * q + 1] = acc2[q].y; }
    float s8[8], s4[4], s2[2];
#pragma unroll
    for (int i = 0; i < 8; ++i) { const float snd = b5 ? acc[i] : acc[i + 8], keep = b5 ? acc[i + 8] : acc[i]; s8[i] = keep + __shfl_xor(snd, 32); }
#pragma unroll
    for (int i = 0; i < 4; ++i) { const float snd = b4 ? s8[i] : s8[i + 4], keep = b4 ? s8[i + 4] : s8[i]; s4[i] = keep + __shfl_xor(snd, 16); }
#pragma unroll
    for (int i = 0; i < 2; ++i) { const float snd = b3 ? s4[i] : s4[i + 2], keep = b3 ? s4[i + 2] : s4[i]; s2[i] = keep + __shfl_xor(snd, 8); }
    *(f32x2*)((unsigned char*)orow + colb) = (f32x2){h.x + s2[0] * (1.0f / V8_SCALE), h.y + s2[1] * (1.0f / V8_SCALE)};
}
template <bool VPHASE, int PROBE = 0>
__device__ __forceinline__ void phase_sliced(const Params& p_in) {
    Params p = p_in; if (PROBE) p.out = (float*)(p_in.ws + WS_QP);
    const int tid_ = tid_opaque(), lane = tid_ & 63;
    const unsigned loff = 16u * (unsigned)lane;
    unsigned* ctr = (unsigned*)(p.ws + WS_CTR + (VPHASE ? 2048 : 0) + PROBE * 4096);
    const int x0 = (int)(xb_xcc_id() & 7u);
    for (int k = 0; k < 8; ++k) {
        const int y = (x0 + k) & 7;
        int tk = claim(ctr + y * 64, lane);
        if (tk >= NTICKET) continue;
        VMeta vm, vmn;
        v_meta(p, tk * TOK_PER_TICKET, y, lane, vm);
        while (tk < NTICKET) {
            const int tkn = claim(ctr + y * 64, lane);
#pragma unroll 1
            for (int i = 0; i < TOK_PER_TICKET; ++i) {
                const int tok = tk * TOK_PER_TICKET + i;
                const int tok_next = (i + 1 < TOK_PER_TICKET) ? tok + 1 : ((tkn < NTICKET) ? tkn * TOK_PER_TICKET : -1);
                if (VPHASE) { v_task(p, tok, y, lane, vm, tok_next, vmn); vm = vmn; }
                else { ucol_task(p, tok, y, lane, vm, tok_next, vmn); vm = vmn; }
            }
            tk = tkn;
        }
    }
}
__device__ __forceinline__ void phase_final_norm(const Params& p) {
    const int tid_ = tid_opaque(), lane = tid_ & 63;
    const int gw = (int)blockIdx.x * (NTHREADS / 64) + __builtin_amdgcn_readfirstlane(tid_ >> 6), ngw = (int)gridDim.x * (NTHREADS / 64);
    const unsigned loff = 16u * (unsigned)lane;
    f32x4 g[4];
#pragma unroll
    for (int q = 0; q < 4; ++q) g[q] = *(const f32x4*)(p.lnf_g + loff + 4 * q);
    for (int tok = gw; tok < NTOK; tok += ngw) {
        float* orow = (float*)((unsigned char*)p.out + (size_t)tok * D * 4) + loff;
        f32x4 y[4]; float ss = 0.f;
#pragma unroll
        for (int q = 0; q < 4; ++q) { y[q] = *(const f32x4*)(orow + 4 * q); ss += (y[q].x * y[q].x + y[q].y * y[q].y) + (y[q].z * y[q].z + y[q].w * y[q].w); }
        const float rstd = 1.0f / sqrtf(wave_sum(ss) * (1.0f / D) + EPS);
#pragma unroll
        for (int q = 0; q < 4; ++q) *(f32x4*)(orow + 4 * q) = (f32x4){y[q].x * rstd * g[q].x, y[q].y * rstd * g[q].y, y[q].z * rstd * g[q].z, y[q].w * rstd * g[q].w};
    }
}
}

constexpr int LDS_BYTES = 147456;
extern __shared__ __attribute__((aligned(16))) unsigned char dyn_lds[];

__device__ __forceinline__ Params load_params() {
#if !defined(__HIP_DEVICE_COMPILE__)
    return Params{};
#else
    const __attribute__((address_space(4))) unsigned char* ka = (const __attribute__((address_space(4))) unsigned char*)__builtin_amdgcn_kernarg_segment_ptr();
    asm volatile("" : "+s"(ka));
    const __attribute__((address_space(4))) Params* kp = (const __attribute__((address_space(4))) Params*)ka;
    Params r;
    r.x = kp->x; r.ln1_g = kp->ln1_g; r.w_in = kp->w_in; r.pe_k = kp->pe_k; r.w1_k = kp->w1_k; r.w2_k = kp->w2_k; r.pe_v = kp->pe_v; r.w1_v = kp->w1_v; r.w2_v = kp->w2_v;
    r.sinks = kp->sinks; r.w_out = kp->w_out; r.ln2_g = kp->ln2_g; r.wq = kp->wq; r.pkeys = kp->pkeys; r.pu = kp->pu; r.pv = kp->pv; r.lnf_g = kp->lnf_g; r.out = kp->out; r.ws = kp->ws;
    return r;
#endif
}
__global__ void __launch_bounds__(NTHREADS, 2) fwd_megakernel(Params p_unused) {
    cg::grid_group grid = cg::this_grid();
    float* lds = (float*)dyn_lds;
    PG8_LAS unsigned char* ldsp = (PG8_LAS unsigned char*)dyn_lds;
    volatile XLAS unsigned* bst = (volatile XLAS unsigned*)((XLAS unsigned char*)dyn_lds + (LDS_BYTES - 16));
    if (threadIdx.x < 4) bst[threadIdx.x] = 0u;
    __syncthreads();
    { const Params p = load_params(); (void)xcd_barrier_post((unsigned*)(p.ws + WS_BAR), bst); }
#define GRID_BARRIER() do { const Params p_ = load_params(); XcdBarrier xb_; xb_.bar = (unsigned*)(p_.ws + WS_BAR); xb_.x = xb_xcc_id(); \
        xb_.st = (volatile XLAS unsigned*)((XLAS unsigned char*)dyn_lds + (LDS_BYTES - 16)); xcd_barrier(xb_); } while (0)
    for (int rep = 0; rep < 1 + PROBE_PREP; ++rep) { const Params p = load_params(); phase_prep(p); }
    grid.sync();
    { const Params p = load_params();
      pg8::Gemm g{(const bf16_t*)(p.ws + WS_XN), (const bf16_t*)(p.ws + WS_WIN), NTOK, DINP, D}; pg8::StaticOrder S; S.init(NTOK, DINP, (int)gridDim.x, (int)blockIdx.x);
      EpiProjT E{p.ws}; pg8::gemm_phase<EpiProjT, pg8::StaticOrder, true, true>(ldsp, g, S, E); }
    GRID_BARRIER();
    { const Params p = load_params(); cmp::phase_compress_swa(p, dyn_lds); }
    GRID_BARRIER();
    for (int rep = 0; rep < 1 + PROBE_NSA; ++rep) { const Params p = load_params(); att::phase_nsa_mfma(p, dyn_lds); }
    GRID_BARRIER();
    { const Params p = load_params();
      pg8::Gemm g{(const bf16_t*)(p.ws + WS_O), (const bf16_t*)(p.ws + WS_WOUT), NTOK, D, D}; pg8::StaticOrder S; S.init(NTOK, D, (int)gridDim.x, (int)blockIdx.x);
      EpiOutT E{p.x, p.ln2_g, p.out, (bf16_t*)(p.ws + WS_H1G), (float*)(p.ws + WS_SS2)}; pg8::gemm_phase<EpiOutT, pg8::StaticOrder, true, true>(ldsp, g, S, E); }
    GRID_BARRIER();
    { const Params p = load_params();
      pg8::Gemm g{(const bf16_t*)(p.ws + WS_H1G), (const bf16_t*)(p.ws + WS_WQ), NTOK, PQ, D}; pg8::StaticOrder S; S.init(NTOK, PQ, (int)gridDim.x, (int)blockIdx.x);
      EpiQPT E{(const float*)(p.ws + WS_SS2), (bf16_t*)(p.ws + WS_QP)}; pg8::gemm_phase<EpiQPT, pg8::StaticOrder, true, true>(ldsp, g, S, E); }
    GRID_BARRIER();
    { const Params p = load_params(); psel::phase_peer_select(p, dyn_lds); }
    GRID_BARRIER();
    { const Params p = load_params(); pex::phase_sliced<false>(p); }
    GRID_BARRIER();
    { const Params p = load_params(); pex::phase_expert_act(p); }
    GRID_BARRIER();
    { const Params p = load_params(); pex::phase_sliced<true>(p); }
    GRID_BARRIER();
    { const Params p = load_params(); pex::phase_final_norm(p); }
}

extern "C" void kernel_launch(void* const* d_in, const int* in_sizes, int n_in, void* d_out, int out_size, void* d_ws, size_t ws_size, hipStream_t stream) {
    if (n_in != 17 || ws_size < WS_END) { fprintf(stderr, "kernel_launch: unexpected inputs (n_in %d, ws %zu)\n", n_in, ws_size); return; }
    static int grid_blocks = 0;
    if (!grid_blocks) {
        int dev = 0, cus = 0, per_cu = 0;
        (void)hipGetDevice(&dev);
        (void)hipDeviceGetAttribute(&cus, hipDeviceAttributeMultiprocessorCount, dev);
        (void)hipFuncSetAttribute((const void*)fwd_megakernel, hipFuncAttributeMaxDynamicSharedMemorySize, LDS_BYTES);
        (void)hipOccupancyMaxActiveBlocksPerMultiprocessor(&per_cu, (const void*)fwd_megakernel, NTHREADS, LDS_BYTES);
        if (per_cu < 1) per_cu = 1;
        grid_blocks = cus * per_cu;
        fprintf(stderr, "kernel_launch: %d CUs x %d blocks/CU\n", cus, per_cu);
    }
    Params p{};
    p.x = (const float*)d_in[0]; p.ln1_g = (const float*)d_in[1]; p.w_in = (const float*)d_in[2];
    p.pe_k = (const float*)d_in[3]; p.w1_k = (const float*)d_in[4]; p.w2_k = (const float*)d_in[5];
    p.pe_v = (const float*)d_in[6]; p.w1_v = (const float*)d_in[7]; p.w2_v = (const float*)d_in[8];
    p.sinks = (const float*)d_in[9]; p.w_out = (const float*)d_in[10]; p.ln2_g = (const float*)d_in[11];
    p.wq = (const float*)d_in[12]; p.pkeys = (const float*)d_in[13]; p.pu = (const float*)d_in[14]; p.pv = (const float*)d_in[15];
    p.lnf_g = (const float*)d_in[16];
    p.out = (float*)d_out; p.ws = (unsigned char*)d_ws;
    (void)hipMemsetAsync((unsigned char*)d_ws + WS_BAR, 0, 16 * 1024 + 8192, stream);
    void* args[] = {&p};
    hipError_t e = hipLaunchCooperativeKernel((void*)fwd_megakernel, dim3(grid_blocks), dim3(NTHREADS), args, LDS_BYTES, stream);
    if (e != hipSuccess) fprintf(stderr, "cooperative launch failed: %s (grid %d)\n", hipGetErrorString(e), grid_blocks);
}
```

```cpp
#include <hip/hip_runtime.h>
#include <hip/hip_cooperative_groups.h>
#include <cstdint>
#include <cstdio>
namespace cg = cooperative_groups;
#define PROBE_PREP 0
#define PROBE_COMPRESS 0
#define PROBE_SWA 0
#define PROBE_NSA 0
#define PROBE_SUB 0
#define PROBE_COMB 0
#define PROBE_PEXU 0
#define PROBE_PEXV 0
#define PROBE_PROJ 0
#define PROBE_QP 0
#define PROBE_SEL 0
#define PROBE_CS 0
#define PROBE_ACT 0

typedef unsigned short bf16_t;
typedef short bf16x8 __attribute__((ext_vector_type(8)));
typedef float f32x4 __attribute__((ext_vector_type(4)));
typedef unsigned u32x4 __attribute__((ext_vector_type(4)));
typedef unsigned u32x2 __attribute__((ext_vector_type(2)));

constexpr int BATCH = 2, T = 8192, D = 1024, NTOK = BATCH * T;
constexpr int HD = 64, NSA_H = 8, NSA_G = 2, NSA_HG = 4, SWA_H = 8;
constexpr int DIN = 1944, DINP = 2048;
constexpr int NCMP = 511, NCMPP = 512, NSEL = 128, TOPN = 16;
constexpr int NSA_WIN = 512, SWA_WIN = 128;
constexpr int PH = 8, PNK = 128, PDK = 256, PTOPK = 16, PQ = PH * PDK;
constexpr int NEXP = PNK * PNK;
constexpr float EPS = 1e-6f;
constexpr int NTHREADS = 512;

constexpr size_t MiB = 1u << 20;
constexpr size_t WS_SS2 = 0;
constexpr size_t WS_BAR = 128 * 1024;
constexpr size_t WS_WIN = 1 * MiB;
constexpr size_t WS_WOUT = 5 * MiB;
constexpr size_t WS_WQ = 7 * MiB;
constexpr size_t WS_PKEYS = 11 * MiB;
constexpr size_t WS_W1T = 12 * MiB;
constexpr size_t WS_W2T = 14 * MiB;
constexpr size_t WS_B1 = 14 * MiB + 512 * 1024;
constexpr size_t WS_XN = 16 * MiB;
constexpr size_t WS_O = WS_XN;
constexpr size_t WS_QN = 48 * MiB;
constexpr size_t WS_QS = 64 * MiB;
constexpr size_t WS_KV6 = 80 * MiB;
constexpr size_t KV6_STRIDE = 4 * MiB;
constexpr size_t WS_KSW = 104 * MiB;
constexpr size_t WS_VSW = 106 * MiB;
constexpr size_t WS_GSIG = 108 * MiB;
constexpr size_t WS_KC = 110 * MiB;
constexpr size_t WS_VC = 110 * MiB + 512 * 1024;
constexpr size_t WS_H1G = 48 * MiB;
constexpr size_t WS_QP = 80 * MiB;
constexpr size_t WS_EIDX = 144 * MiB;
constexpr size_t WS_GATE = 152 * MiB;
constexpr size_t WS_U8 = 160 * MiB;
constexpr size_t WS_PART = 80 * MiB;
constexpr size_t WS_V8 = 176 * MiB;
constexpr size_t WS_PW = 224 * MiB;
constexpr size_t WS_CTR = 128 * 1024 + 16 * 1024;
constexpr size_t WS_TOPV2 = 224 * MiB;
constexpr size_t WS_TOPI2 = 240 * MiB;
constexpr size_t WS_END = 256 * MiB;

struct Params {
    const float* x; const float* ln1_g; const float* w_in;
    const float* pe_k; const float* w1_k; const float* w2_k;
    const float* pe_v; const float* w1_v; const float* w2_v;
    const float* sinks; const float* w_out; const float* ln2_g;
    const float* wq; const float* pkeys; const float* pu; const float* pv; const float* lnf_g;
    float* out; unsigned char* ws;
};

__device__ __forceinline__ int tid_opaque() { int t = (int)threadIdx.x; asm volatile("" : "+v"(t)); return t; }
__device__ __forceinline__ unsigned f2bf(float f) { unsigned u = __float_as_uint(f); return (u + 0x7fffu + ((u >> 16) & 1u)) >> 16; }
__device__ __forceinline__ float bf2f(unsigned h) { return __uint_as_float(h << 16); }
__device__ __forceinline__ float bflo(unsigned w) { return __uint_as_float(w << 16); }
__device__ __forceinline__ float bfhi(unsigned w) { return __uint_as_float(w & 0xffff0000u); }
__device__ __forceinline__ unsigned pk2(float lo, float hi) { return f2bf(lo) | (f2bf(hi) << 16); }
__device__ __forceinline__ float wave_sum(float v) {
#pragma unroll
    for (int o = 1; o < 64; o <<= 1) v += __shfl_xor(v, o);
    return v;
}
__device__ __forceinline__ float gelu_tanh(float x) {
    const float u = 0.7978845608028654f * (x + 0.044715f * x * x * x);
    return 0.5f * x * (1.0f + tanhf(u));
}
__device__ __forceinline__ int win_orig_col(int n) {
    if (n < 1280) return n;
    if (n < 1792) return 1304 + (n - 1280);
    if (n < 1856) return 1816 + (n - 1792);
    if (n < 1920) return 1880 + (n - 1856);
    if (n < 1944) return 1280 + (n - 1920);
    return -1;
}

template <bool WIN_MAP>
__device__ __forceinline__ void prep_transpose(const float* W, int K, int N, int NP, bf16_t* WT, long gt, long ngt) {
    const long items = (long)NP * (K / 8);
    for (long it = gt; it < items; it += ngt) {
        const int n = (int)(it % NP), k0 = (int)(it / NP) * 8;
        const int col = WIN_MAP ? win_orig_col(n) : n;
        float v[8];
#pragma unroll
        for (int i = 0; i < 8; ++i) v[i] = (col >= 0) ? W[(size_t)(k0 + i) * N + col] : 0.f;
        u32x4 o; o.x = pk2(v[0], v[1]); o.y = pk2(v[2], v[3]); o.z = pk2(v[4], v[5]); o.w = pk2(v[6], v[7]);
        *(u32x4*)(WT + (size_t)n * K + k0) = o;
    }
}
__device__ __forceinline__ void prep_convert(const float* src, bf16_t* dst, long n8, long gt, long ngt) {
    for (long it = gt; it < n8; it += ngt) {
        const f32x4 a = *(const f32x4*)(src + it * 8), b = *(const f32x4*)(src + it * 8 + 4);
        u32x4 o; o.x = pk2(a.x, a.y); o.y = pk2(a.z, a.w); o.z = pk2(b.x, b.y); o.w = pk2(b.z, b.w);
        *(u32x4*)(dst + it * 8) = o;
    }
}
constexpr float U8_SCALE = 256.0f, V8_SCALE = 16.0f;
__device__ __forceinline__ void prep_convert_fp8(const float* src, unsigned char* dst, long n16, float sc, long gt, long ngt) {
    for (long it = gt; it < n16; it += ngt) {
        u32x4 o;
#pragma unroll
        for (int q = 0; q < 4; ++q) {
            const f32x4 a = *(const f32x4*)(src + it * 16 + q * 4);
            int w = 0;
            w = __builtin_amdgcn_cvt_pk_fp8_f32(a.x * sc, a.y * sc, w, false);
            w = __builtin_amdgcn_cvt_pk_fp8_f32(a.z * sc, a.w * sc, w, true);
            o[q] = (unsigned)w;
        }
        *(u32x4*)(dst + it * 16) = o;
    }
}
__device__ __forceinline__ void prep_convert_fp8_sliced(const float* src, unsigned char* dst, long n16, float sc, long gt, long ngt) {
    for (long it = gt; it < n16; it += ngt) {
        u32x4 o;
#pragma unroll
        for (int q = 0; q < 4; ++q) {
            const f32x4 a = *(const f32x4*)(src + it * 16 + q * 4);
            int w = 0;
            w = __builtin_amdgcn_cvt_pk_fp8_f32(a.x * sc, a.y * sc, w, false);
            w = __builtin_amdgcn_cvt_pk_fp8_f32(a.z * sc, a.w * sc, w, true);
            o[q] = (unsigned)w;
        }
        const long e = (it * 16) >> 10; const int col = (int)((it * 16) & 1023);
        *(u32x4*)(dst + (size_t)(col >> 7) * ((size_t)NEXP * 128) + e * 128 + (col & 127)) = o;
    }
}
__device__ __forceinline__ void convert_expert_tables(const Params& p, int bi, int nblk) {
    const long gt = (long)bi * NTHREADS + tid_opaque(), ngt = (long)nblk * NTHREADS;
    prep_convert_fp8_sliced(p.pu, p.ws + WS_U8, (long)NEXP * D / 16, U8_SCALE, gt, ngt);
    prep_convert_fp8_sliced(p.pv, p.ws + WS_V8, (long)NEXP * D / 16, V8_SCALE, gt, ngt);
}
__device__ __forceinline__ void phase_prep(const Params& p) {
    const long gt = (long)blockIdx.x * NTHREADS + tid_opaque(), ngt = (long)gridDim.x * NTHREADS;
    const int lane = tid_opaque() & 63;
    const long gw = gt >> 6, ngw = ngt >> 6;
    unsigned char* ws = p.ws;
    for (long m = gw; m < NTOK; m += ngw) {
        const f32x4* xr = (const f32x4*)(p.x + (size_t)m * D) + lane;
        f32x4 v[4]; float s = 0.f;
#pragma unroll
        for (int j = 0; j < 4; ++j) { v[j] = xr[64 * j]; s += (v[j].x * v[j].x + v[j].y * v[j].y) + (v[j].z * v[j].z + v[j].w * v[j].w); }
        const float rstd = 1.0f / sqrtf(wave_sum(s) * (1.0f / D) + EPS);
        u32x2* o = (u32x2*)((bf16_t*)(ws + WS_XN) + (size_t)m * D) + lane;
#pragma unroll
        for (int j = 0; j < 4; ++j) {
            const f32x4 g = *((const f32x4*)p.ln1_g + lane + 64 * j);
            u32x2 w; w.x = pk2(v[j].x * rstd * g.x, v[j].y * rstd * g.y); w.y = pk2(v[j].z * rstd * g.z, v[j].w * rstd * g.w);
            o[64 * j] = w;
        }
    }
    prep_transpose<true>(p.w_in, D, DIN, DINP, (bf16_t*)(ws + WS_WIN), gt, ngt);
    prep_transpose<false>(p.w_out, D, D, D, (bf16_t*)(ws + WS_WOUT), gt, ngt);
    prep_transpose<false>(p.wq, D, PQ, PQ, (bf16_t*)(ws + WS_WQ), gt, ngt);
    prep_convert(p.pkeys, (bf16_t*)(ws + WS_PKEYS), (long)16 * 128 * 128 / 8, gt, ngt);
    prep_transpose<false>(p.w1_k, 2048, 256, 256, (bf16_t*)(ws + WS_W1T), gt, ngt);
    prep_transpose<false>(p.w1_v, 2048, 256, 256, (bf16_t*)(ws + WS_W1T) + 256 * 2048, gt, ngt);
    prep_transpose<false>(p.w2_k, 256, 64, 64, (bf16_t*)(ws + WS_W2T), gt, ngt);
    prep_transpose<false>(p.w2_v, 256, 64, 64, (bf16_t*)(ws + WS_W2T) + 64 * 256, gt, ngt);
    for (long o = gw; o < 512; o += ngw) {
        const int kv = (int)(o >> 8), n = (int)(o & 255);
        const float* pe = kv ? p.pe_v : p.pe_k; const float* w1 = kv ? p.w1_v : p.w1_k;
        float s = 0.f;
        for (int k = lane; k < 2048; k += 64) s += pe[k] * w1[(size_t)k * 256 + n];
        s = wave_sum(s);
        if (lane == 0) ((float*)(ws + WS_B1))[o] = s;
    }
    for (long i = gt; i < NTOK; i += ngt) ((float*)(ws + WS_SS2))[i] = 0.f;
}

template <class Epi>
__device__ __forceinline__ void gemm_simple(const bf16_t* A, const bf16_t* Bt, int M, int N, int K, const Epi& E) {
    const int lane = tid_opaque() & 63;
    const long gw = ((long)blockIdx.x * NTHREADS + tid_opaque()) >> 6, ngw = ((long)gridDim.x * NTHREADS) >> 6;
    const int ntn = N / 64; const long ntiles = (long)(M / 32) * ntn;
    const int fr = lane & 15, fq = lane >> 4;
    for (long tile = gw; tile < ntiles; tile += ngw) {
        const int m0 = (int)(tile / ntn) * 32, n0 = (int)(tile % ntn) * 64;
        f32x4 acc[2][4];
#pragma unroll
        for (int i = 0; i < 2; ++i)
#pragma unroll
            for (int j = 0; j < 4; ++j) acc[i][j] = (f32x4){0.f, 0.f, 0.f, 0.f};
        const bf16_t* ap = A + (size_t)(m0 + fr) * K + fq * 8;
        const bf16_t* bp = Bt + (size_t)(n0 + fr) * K + fq * 8;
        for (int k0 = 0; k0 < K; k0 += 32) {
            bf16x8 a[2], b[4];
#pragma unroll
            for (int i = 0; i < 2; ++i) a[i] = *(const bf16x8*)(ap + (size_t)i * 16 * K + k0);
#pragma unroll
            for (int j = 0; j < 4; ++j) b[j] = *(const bf16x8*)(bp + (size_t)j * 16 * K + k0);
#pragma unroll
            for (int i = 0; i < 2; ++i)
#pragma unroll
                for (int j = 0; j < 4; ++j) acc[i][j] = __builtin_amdgcn_mfma_f32_16x16x32_bf16(a[i], b[j], acc[i][j], 0, 0, 0);
        }
        E(acc, m0, n0, fr, fq);
    }
}

struct EpiProj {
    unsigned char* ws;
    __device__ __forceinline__ void operator()(const f32x4 (&acc)[2][4], int m0, int n0, int fr, int fq) const {
#pragma unroll
        for (int i = 0; i < 2; ++i)
#pragma unroll
            for (int j = 0; j < 4; ++j)
#pragma unroll
                for (int r = 0; r < 4; ++r) {
                    const int row = m0 + 16 * i + fq * 4 + r, n = n0 + 16 * j + fr;
                    const float v = acc[i][j][r];
                    const int b = row / T, t = row % T, d = n & 63;
                    if (n < 512) {
                        const int head = n >> 6;
                        ((bf16_t*)(ws + WS_QN))[((size_t)(b * 8 + head) * T + t) * 64 + d] = (bf16_t)f2bf(v * 0.125f);
                    } else if (n < 1280) {
                        const int arr = (n - 512) >> 7, g = ((n - 512) >> 6) & 1;
                        ((bf16_t*)(ws + WS_KV6 + arr * KV6_STRIDE))[((size_t)(b * 2 + g) * T + t) * 64 + d] = (bf16_t)f2bf(v);
                    } else if (n < 1792) {
                        const int head = (n - 1280) >> 6;
                        ((bf16_t*)(ws + WS_QS))[((size_t)(b * 8 + head) * T + t) * 64 + d] = (bf16_t)f2bf(v * 0.125f);
                    } else if (n < 1856) {
                        ((bf16_t*)(ws + WS_KSW))[((size_t)b * T + t) * 64 + d] = (bf16_t)f2bf(v);
                    } else if (n < 1920) {
                        ((bf16_t*)(ws + WS_VSW))[((size_t)b * T + t) * 64 + d] = (bf16_t)f2bf(v);
                    } else if (n < 1944) {
                        ((float*)(ws + WS_GSIG))[(size_t)row * 24 + (n - 1920)] = 1.0f / (1.0f + expf(-v));
                    }
                }
    }
};
struct EpiOut {
    const float* x; const float* g2; float* h1; bf16_t* h1g; float* ss2;
    __device__ __forceinline__ void operator()(const f32x4 (&acc)[2][4], int m0, int n0, int fr, int fq) const {
#pragma unroll
        for (int i = 0; i < 2; ++i)
#pragma unroll
            for (int r = 0; r < 4; ++r) {
                const int row = m0 + 16 * i + fq * 4 + r; float ss = 0.f;
#pragma unroll
                for (int j = 0; j < 4; ++j) {
                    const int n = n0 + 16 * j + fr; const size_t off = (size_t)row * D + n;
                    const float h = x[off] + acc[i][j][r];
                    h1[off] = h; h1g[off] = (bf16_t)f2bf(h * g2[n]); ss += h * h;
                }
                ss += __shfl_xor(ss, 1); ss += __shfl_xor(ss, 2); ss += __shfl_xor(ss, 4); ss += __shfl_xor(ss, 8);
                if (fr == 0) atomicAdd(ss2 + row, ss);
            }
    }
};
struct EpiQP {
    const float* ss2; bf16_t* qp;
    __device__ __forceinline__ void operator()(const f32x4 (&acc)[2][4], int m0, int n0, int fr, int fq) const {
#pragma unroll
        for (int i = 0; i < 2; ++i)
#pragma unroll
            for (int r = 0; r < 4; ++r) {
                const int row = m0 + 16 * i + fq * 4 + r;
                const float rstd = 1.0f / sqrtf(ss2[row] * (1.0f / D) + EPS);
#pragma unroll
                for (int j = 0; j < 4; ++j) qp[(size_t)row * PQ + n0 + 16 * j + fr] = (bf16_t)f2bf(acc[i][j][r] * rstd);
            }
    }
};

namespace pg8 {
#define PG8_LAS __attribute__((address_space(3)))
typedef unsigned short bf16_t;
typedef short bf16x8 __attribute__((ext_vector_type(8)));
typedef float f32x4 __attribute__((ext_vector_type(4)));
typedef unsigned u32x4 __attribute__((ext_vector_type(4)));
constexpr int BM = 256, BK = 64, HALF = 128, HTB = HALF * BK * 2  , STAGE_BYTES = 8 * HTB, NXCD = 8, WGM = 8;

__host__ __device__ __forceinline__ int lds_byte(int r, int c) { const int st = (r >> 4) * 2 + (c >> 5), rr = r & 15, cc = c & 31, ob = rr * 64 + cc * 2; return st * 1024 + (ob ^ (((ob >> 9) & 1) << 5)); }
__host__ __device__ __forceinline__ void stage_rc(int b, int& R, int& C) { const int st = b / 1024, sb = b % 1024, swz = sb ^ (((sb >> 9) & 1) << 5); R = (st >> 1) * 16 + swz / 64; C = (st & 1) * 32 + (swz % 64) / 2; }
__host__ __device__ __forceinline__ int perm32(int rho) { const int n = rho >> 4, i = rho & 15; return 8 * (i >> 2) + 4 * n + (i & 3); }

struct Unit { int pm, pn; };
struct Gemm { const bf16_t* A; const bf16_t* Bt; int M, N, K; };

struct StaticOrder {
    int nM, nN, nwg, G, c;
    __host__ __device__ void init(int M, int N, int G_, int c_) { nM = M / BM; nN = N / BM; nwg = nM * nN; G = G_; c = c_; }
    __host__ __device__ bool next(int i, Unit& u) const {
        const long L = (long)i * G + c; if (L >= nwg) return false;
        int wgid = (int)L; { const int q = nwg / NXCD, r = nwg % NXCD, xcd = wgid % NXCD, off = wgid / NXCD; wgid = (xcd < r ? xcd * (q + 1) : r * (q + 1) + (xcd - r) * q) + off; }
        const int nig = WGM * nN, gid = wgid / nig, fm = gid * WGM, gsz = (nM - fm) < WGM ? (nM - fm) : WGM;
        u.pm = fm + ((wgid % nig) % gsz); u.pn = (wgid % nig) / gsz; return true;
    }
    __device__ __forceinline__ void a_ready(const Unit&) const {}
    __device__ __forceinline__ void done(const Unit&) const {}
};

__device__ __forceinline__ unsigned cvt_pk_bf16(float lo, float hi) { unsigned r; asm volatile("v_cvt_pk_bf16_f32 %0, %1, %2" : "=v"(r) : "v"(lo), "v"(hi)); return r; }
template <class Epi, class Sched, bool ALIGN_EPI = false, bool SP2 = false>
__device__ __forceinline__ void gemm_phase(PG8_LAS unsigned char* lds, const Gemm g, const Sched& S, const Epi& E) {
    const int tid = tid_opaque(), wid = __builtin_amdgcn_readfirstlane(tid >> 6), lane = tid & 63, wr = wid >> 2, wc = wid & 3, fr = lane & 15, fq = lane >> 4;
    const int K = g.K, nt = K / BK;
    unsigned voffA[2], voffB[2];
#pragma unroll
    for (int i = 0; i < 2; ++i) { int R, C; stage_rc(tid * 16 + i * 8192, R, C); const int Rb = Epi::PERM ? ((R & ~31) + perm32(R & 31)) : R;
        voffA[i] = (unsigned)(R * K + C) * 2u; voffB[i] = (unsigned)(Rb * K + C) * 2u; }
    const size_t kstep = (size_t)(BK * 2);
    const size_t hstep = (size_t)HALF * K * 2;
    const size_t tstep = 2 * hstep;
    const unsigned ldsw = (unsigned)wid * 1024u;
    const int aoff = lds_byte(wr * 64 + fr, fq * 8), boff = lds_byte(wc * 32 + fr, fq * 8);
#define PG8_SA(b, h) (((b) * 2 + (h)) * HTB)
#define PG8_SB(b, h) ((4 + (b) * 2 + (h)) * HTB)
#define PG8_STAGE(bufoff, gbase, voff) do { _Pragma("unroll") for (int _i = 0; _i < 2; ++_i) \
        __builtin_amdgcn_global_load_lds((const unsigned*)((const char*)(gbase) + (voff)[_i]), (PG8_LAS unsigned*)(lds + (bufoff) + ldsw + _i * 8192), 16, 0, 0); } while (0)
#define PG8_LDA(dst, b, h) do { _Pragma("unroll") for (int m = 0; m < 4; ++m) _Pragma("unroll") for (int k = 0; k < 2; ++k) dst[m][k] = *(const PG8_LAS bf16x8*)(lds + PG8_SA(b, h) + aoff + m * 2048 + k * 1024); } while (0)
#define PG8_LDB(dst, b, h) do { _Pragma("unroll") for (int n = 0; n < 2; ++n) _Pragma("unroll") for (int k = 0; k < 2; ++k) dst[n][k] = *(const PG8_LAS bf16x8*)(lds + PG8_SB(b, h) + boff + n * 2048 + k * 1024); } while (0)
#define PG8_MMA(ai, bj, At, Bt) do { __builtin_amdgcn_s_setprio(1); _Pragma("unroll") for (int m = 0; m < 4; ++m) _Pragma("unroll") for (int n = 0; n < 2; ++n) _Pragma("unroll") for (int k = 0; k < 2; ++k) \
        acc[ai][bj][m][n] = __builtin_amdgcn_mfma_f32_16x16x32_bf16(Bt[n][k], At[m][k], acc[ai][bj][m][n], 0, 0, 0); __builtin_amdgcn_s_setprio(0); } while (0)
#define PG8_WAIT_V(n) asm volatile("s_waitcnt vmcnt(" #n ")" ::: "memory")
#define PG8_WAIT_L(n) asm volatile("s_waitcnt lgkmcnt(" #n ")" ::: "memory")
#define PG8_BAR __builtin_amdgcn_s_barrier()
#define PG8_SCHED __builtin_amdgcn_sched_barrier(0)
    Unit cur, nxt; int ui = 0;
    if (!S.next(0, cur)) return;
    f32x4 acc[2][2][4][2];
#pragma unroll
    for (int a = 0; a < 2; ++a)
#pragma unroll
        for (int b = 0; b < 2; ++b)
#pragma unroll
            for (int m = 0; m < 4; ++m)
#pragma unroll
                for (int n = 0; n < 2; ++n) acc[a][b][m][n] = (f32x4){0.f, 0.f, 0.f, 0.f};
    bf16x8 At[4][2], B0[2][2], B1[2][2];
    const char* cA = (const char*)g.A + (size_t)cur.pm * tstep; const char* cB = (const char*)g.Bt + (size_t)cur.pn * tstep;
    S.a_ready(cur);
    if constexpr (SP2) {
        PG8_STAGE(PG8_SB(0, 0), cB, voffB); PG8_STAGE(PG8_SB(0, 1), cB + hstep, voffB); PG8_STAGE(PG8_SA(0, 0), cA, voffA); PG8_STAGE(PG8_SA(0, 1), cA + hstep, voffA);
        if (wr == 1) PG8_BAR;
        PG8_WAIT_V(2); PG8_BAR;
        PG8_STAGE(PG8_SB(1, 0), cB + kstep, voffB); PG8_STAGE(PG8_SA(1, 0), cA + kstep, voffA); PG8_STAGE(PG8_SB(1, 1), cB + hstep + kstep, voffB);
        PG8_WAIT_V(6); PG8_BAR;
    } else {
        PG8_STAGE(PG8_SB(0, 0), cB, voffB); PG8_STAGE(PG8_SA(0, 0), cA, voffA); PG8_STAGE(PG8_SB(0, 1), cB + hstep, voffB); PG8_STAGE(PG8_SA(0, 1), cA + hstep, voffA);
        if (wr == 1) PG8_BAR;
        PG8_WAIT_V(4); PG8_BAR;
        PG8_STAGE(PG8_SB(1, 0), cB + kstep, voffB); PG8_STAGE(PG8_SA(1, 0), cA + kstep, voffA); PG8_STAGE(PG8_SB(1, 1), cB + hstep + kstep, voffB);
        PG8_WAIT_V(6); PG8_BAR;
    }
    for (;;) {
        const bool has_next = S.next(ui + 1, nxt);
        const char* nA = has_next ? (const char*)g.A + (size_t)nxt.pm * tstep : cA; const char* nB = has_next ? (const char*)g.Bt + (size_t)nxt.pn * tstep : cB;
        for (int t = 0; t < nt; t += 2) {
            const bool last = (t == nt - 2);
            const char* a1 = cA + (size_t)(t + 1) * kstep;
            const char* a2 = last ? nA : cA + (size_t)(t + 2) * kstep; const char* b2 = last ? nB : cB + (size_t)(t + 2) * kstep;
            const char* a3 = a2 + kstep; const char* b3 = b2 + kstep;
            if (last && has_next) S.a_ready(nxt);
            if constexpr (SP2) {
            PG8_LDB(B0, 0, 0); PG8_LDB(B1, 0, 1); PG8_SCHED; PG8_LDA(At, 0, 0); PG8_STAGE(PG8_SA(1, 1), a1 + hstep, voffA);
            PG8_WAIT_V(8); PG8_WAIT_L(0); PG8_BAR; PG8_MMA(0, 0, At, B0); PG8_MMA(0, 1, At, B1); PG8_BAR; PG8_SCHED;
            PG8_LDA(At, 0, 1); PG8_STAGE(PG8_SB(0, 0), b2, voffB); PG8_STAGE(PG8_SB(0, 1), b2 + hstep, voffB); PG8_STAGE(PG8_SA(0, 0), a2, voffA);
            PG8_WAIT_V(8); PG8_WAIT_L(0); PG8_BAR; PG8_MMA(1, 0, At, B0); PG8_MMA(1, 1, At, B1); PG8_BAR; PG8_SCHED;
            PG8_LDB(B0, 1, 0); PG8_LDB(B1, 1, 1); PG8_SCHED; PG8_LDA(At, 1, 0); PG8_STAGE(PG8_SA(0, 1), a2 + hstep, voffA);
            PG8_WAIT_V(8); PG8_WAIT_L(0); PG8_BAR; PG8_MMA(0, 0, At, B0); PG8_MMA(0, 1, At, B1); PG8_BAR; PG8_SCHED;
            PG8_LDA(At, 1, 1); PG8_STAGE(PG8_SB(1, 0), b3, voffB); PG8_STAGE(PG8_SB(1, 1), b3 + hstep, voffB); PG8_STAGE(PG8_SA(1, 0), a3, voffA);
            PG8_WAIT_V(8); PG8_WAIT_L(0); PG8_BAR; PG8_MMA(1, 0, At, B0); PG8_MMA(1, 1, At, B1); PG8_BAR; PG8_SCHED;
            } else {
            PG8_LDB(B0, 0, 0); PG8_SCHED; PG8_LDA(At, 0, 0); PG8_STAGE(PG8_SA(1, 1), a1 + hstep, voffA);
            PG8_WAIT_L(8); PG8_BAR; PG8_WAIT_L(0); PG8_MMA(0, 0, At, B0); PG8_BAR; PG8_SCHED;
            PG8_LDB(B1, 0, 1); PG8_STAGE(PG8_SB(0, 0), b2, voffB);
            PG8_BAR; PG8_WAIT_L(0); PG8_MMA(0, 1, At, B1); PG8_BAR;
            PG8_LDA(At, 0, 1); PG8_STAGE(PG8_SA(0, 0), a2, voffA);
            PG8_BAR; PG8_WAIT_L(0); PG8_MMA(1, 0, At, B0); PG8_BAR; PG8_SCHED;
            PG8_STAGE(PG8_SB(0, 1), b2 + hstep, voffB);
            PG8_WAIT_V(6); PG8_BAR; PG8_MMA(1, 1, At, B1); PG8_BAR;
            PG8_LDB(B0, 1, 0); PG8_SCHED; PG8_LDA(At, 1, 0); PG8_STAGE(PG8_SA(0, 1), a2 + hstep, voffA);
            PG8_WAIT_L(8); PG8_BAR; PG8_WAIT_L(0); PG8_MMA(0, 0, At, B0); PG8_BAR; PG8_SCHED;
            PG8_LDB(B1, 1, 1); PG8_STAGE(PG8_SB(1, 0), b3, voffB);
            PG8_BAR; PG8_WAIT_L(0); PG8_MMA(0, 1, At, B1); PG8_BAR;
            PG8_LDA(At, 1, 1); PG8_STAGE(PG8_SA(1, 0), a3, voffA);
            PG8_BAR; PG8_WAIT_L(0); PG8_MMA(1, 0, At, B0); PG8_BAR; PG8_SCHED;
            PG8_STAGE(PG8_SB(1, 1), b3 + hstep, voffB);
            PG8_WAIT_V(6); PG8_BAR; PG8_MMA(1, 1, At, B1); PG8_BAR;
            }
        }
        if constexpr (ALIGN_EPI) { if (wr == 0) PG8_BAR; }
        if constexpr (!Epi::AFTER_DRAIN) { E(acc, cur, wr, wc, fr, fq); S.done(cur); }
        if (!has_next) break;
#pragma unroll
        for (int a = 0; a < 2; ++a)
#pragma unroll
            for (int b = 0; b < 2; ++b)
#pragma unroll
                for (int m = 0; m < 4; ++m)
#pragma unroll
                    for (int n = 0; n < 2; ++n) acc[a][b][m][n] = (f32x4){0.f, 0.f, 0.f, 0.f};
        cur = nxt; cA = nA; cB = nB; ++ui;
        if constexpr (ALIGN_EPI) { if (wr == 1) PG8_BAR; }
    }
    PG8_WAIT_V(0);
    if constexpr (!ALIGN_EPI) { if (wr == 0) PG8_BAR; }
    PG8_BAR;
    if constexpr (Epi::AFTER_DRAIN) { E.fused(acc, cur, wr, wc, fr, fq, lds, wid, lane); S.done(cur); }
#undef PG8_SA
#undef PG8_SB
#undef PG8_STAGE
#undef PG8_LDA
#undef PG8_LDB
#undef PG8_MMA
#undef PG8_WAIT_V
#undef PG8_WAIT_L
#undef PG8_BAR
#undef PG8_SCHED
}
}

struct EpiProjT {
    static constexpr bool PERM = true, AFTER_DRAIN = false;
    unsigned char* ws;
    __device__ __forceinline__ void operator()(const f32x4 (&acc)[2][2][4][2], const pg8::Unit& u, int wr, int wc, int fr, int fq) const {
        const int row0 = u.pm * 256 + wr * 64 + fr;
#pragma unroll
        for (int bj = 0; bj < 2; ++bj) {
            const int n8 = u.pn * 256 + bj * 128 + wc * 32 + 8 * fq;
            if (n8 >= 1944) continue;
            if (n8 >= 1920) {
#pragma unroll
                for (int ai = 0; ai < 2; ++ai)
#pragma unroll
                    for (int m = 0; m < 4; ++m) {
                        const int row = row0 + ai * 128 + m * 16;
                        const f32x4 v0 = acc[ai][bj][m][0], v1 = acc[ai][bj][m][1];
                        float* dst = (float*)(ws + WS_GSIG) + (size_t)row * 24 + (n8 - 1920);
                        *(f32x4*)dst = (f32x4){1.0f / (1.0f + __expf(-v0[0])), 1.0f / (1.0f + __expf(-v0[1])), 1.0f / (1.0f + __expf(-v0[2])), 1.0f / (1.0f + __expf(-v0[3]))};
                        *(f32x4*)(dst + 4) = (f32x4){1.0f / (1.0f + __expf(-v1[0])), 1.0f / (1.0f + __expf(-v1[1])), 1.0f / (1.0f + __expf(-v1[2])), 1.0f / (1.0f + __expf(-v1[3]))};
                    }
                continue;
            }
            bf16_t* base; int nh, hidx; float sc = 1.0f;
            if (n8 < 512) { base = (bf16_t*)(ws + WS_QN); nh = 8; hidx = n8 >> 6; sc = 0.125f * 1.4426950408889634f; }
            else if (n8 < 1280) { const int arr = (n8 - 512) >> 7; base = (bf16_t*)(ws + WS_KV6 + (size_t)arr * KV6_STRIDE); nh = 2; hidx = ((n8 - 512) >> 6) & 1; }
            else if (n8 < 1792) { base = (bf16_t*)(ws + WS_QS); nh = 8; hidx = (n8 - 1280) >> 6; sc = 0.125f * 1.4426950408889634f; }
            else if (n8 < 1856) { base = (bf16_t*)(ws + WS_KSW); nh = 1; hidx = 0; }
            else { base = (bf16_t*)(ws + WS_VSW); nh = 1; hidx = 0; }
            const int d0 = n8 & 63;
#pragma unroll
            for (int ai = 0; ai < 2; ++ai)
#pragma unroll
                for (int m = 0; m < 4; ++m) {
                    const int row = row0 + ai * 128 + m * 16, b = row >> 13, t = row & (T - 1);
                    const f32x4 v0 = acc[ai][bj][m][0] * sc, v1 = acc[ai][bj][m][1] * sc;
                    u32x4 w; w.x = pg8::cvt_pk_bf16(v0[0], v0[1]); w.y = pg8::cvt_pk_bf16(v0[2], v0[3]); w.z = pg8::cvt_pk_bf16(v1[0], v1[1]); w.w = pg8::cvt_pk_bf16(v1[2], v1[3]);
                    *(u32x4*)(base + ((size_t)(b * nh + hidx) * T + t) * 64 + d0) = w;
                }
        }
    }
};
struct EpiOutT {
    static constexpr bool PERM = false, AFTER_DRAIN = false;
    const float* x; const float* g2; float* h1; bf16_t* h1g; float* ss2;
    __device__ __forceinline__ void operator()(const f32x4 (&acc)[2][2][4][2], const pg8::Unit& u, int wr, int wc, int fr, int fq) const {
        const int row0 = u.pm * 256 + wr * 64 + fr, col0 = u.pn * 256 + wc * 32 + 4 * fq;
#pragma unroll
        for (int ai = 0; ai < 2; ++ai)
#pragma unroll
            for (int m = 0; m < 4; ++m) {
                const int row = row0 + ai * 128 + m * 16; float ss = 0.f;
#pragma unroll
                for (int bj = 0; bj < 2; ++bj)
#pragma unroll
                    for (int n = 0; n < 2; ++n) {
                        const int c = col0 + bj * 128 + n * 16; const size_t off = (size_t)row * D + c;
                        const f32x4 h = *(const f32x4*)(x + off) + acc[ai][bj][m][n];
                        const f32x4 g = *(const f32x4*)(g2 + c);
                        *(f32x4*)(h1 + off) = h;
                        u32x2 w; w.x = pg8::cvt_pk_bf16(h[0] * g[0], h[1] * g[1]); w.y = pg8::cvt_pk_bf16(h[2] * g[2], h[3] * g[3]);
                        *(u32x2*)(h1g + off) = w;
                        ss += (h[0] * h[0] + h[1] * h[1]) + (h[2] * h[2] + h[3] * h[3]);
                    }
                ss += __shfl_xor(ss, 16); ss += __shfl_xor(ss, 32);
                if (fq == 0) atomicAdd(ss2 + row, ss);
            }
    }
};
struct EpiQPT {
    static constexpr bool PERM = true, AFTER_DRAIN = false;
    const float* ss2; bf16_t* qp;
    __device__ __forceinline__ void operator()(const f32x4 (&acc)[2][2][4][2], const pg8::Unit& u, int wr, int wc, int fr, int fq) const {
        const int row0 = u.pm * 256 + wr * 64 + fr;
#pragma unroll
        for (int ai = 0; ai < 2; ++ai)
#pragma unroll
            for (int m = 0; m < 4; ++m) {
                const int row = row0 + ai * 128 + m * 16;
                const float rstd = 1.0f / sqrtf(ss2[row] * (1.0f / D) + EPS);
#pragma unroll
                for (int bj = 0; bj < 2; ++bj) {
                    const int n8 = u.pn * 256 + bj * 128 + wc * 32 + 8 * fq;
                    const f32x4 v0 = acc[ai][bj][m][0] * rstd, v1 = acc[ai][bj][m][1] * rstd;
                    u32x4 w; w.x = pg8::cvt_pk_bf16(v0[0], v0[1]); w.y = pg8::cvt_pk_bf16(v0[2], v0[3]); w.z = pg8::cvt_pk_bf16(v1[0], v1[1]); w.w = pg8::cvt_pk_bf16(v1[2], v1[3]);
                    *(u32x4*)(qp + (size_t)row * PQ + n8) = w;
                }
            }
    }
};

__device__ __forceinline__ void phase_compress(const Params& p, float* lds) {
    float* flat = lds;
    float* part = lds + 2048;
    float* hid = lds + 2560;
    const int tid = tid_opaque();
    const int nunits = 2 * BATCH * NCMP * NSA_G;
    for (int u = blockIdx.x; u < nunits; u += gridDim.x) {
        const int kv = u / (BATCH * NCMP * NSA_G); int r = u % (BATCH * NCMP * NSA_G);
        const int b = r / (NCMP * NSA_G); r %= (NCMP * NSA_G);
        const int c = r / NSA_G, g = r % NSA_G;
        const bf16_t* raw = (const bf16_t*)(p.ws + WS_KV6 + (size_t)kv * KV6_STRIDE) + ((size_t)(b * 2 + g) * T + 16 * c) * 64;
        const float* pe = kv ? p.pe_v : p.pe_k; const float* w1 = kv ? p.w1_v : p.w1_k; const float* w2 = kv ? p.w2_v : p.w2_k;
        for (int i = tid; i < 2048; i += NTHREADS) flat[i] = bf2f(raw[i]) + pe[i];
        __syncthreads();
        {
            const int j = tid & 255, half = tid >> 8;
            float a = 0.f;
            const float* wp = w1 + (size_t)(half * 1024) * 256 + j; const float* fp = flat + half * 1024;
            for (int i = 0; i < 1024; ++i) a += fp[i] * wp[(size_t)i * 256];
            part[tid] = a;
        }
        __syncthreads();
        if (tid < 256) hid[tid] = gelu_tanh(part[tid] + part[tid + 256]);
        __syncthreads();
        if (tid < 64) {
            float a = 0.f;
            for (int j = 0; j < 256; ++j) a += hid[j] * w2[j * 64 + tid];
            bf16_t* dst = (bf16_t*)(p.ws + (kv ? WS_VC : WS_KC)) + ((size_t)(b * 2 + g) * NCMPP + c) * 64;
            dst[tid] = (bf16_t)f2bf(a);
        }
        __syncthreads();
    }
}

__device__ __forceinline__ void load_row64(const bf16_t* src, float (&k)[64]) {
#pragma unroll
    for (int c = 0; c < 8; ++c) {
        const u32x4 w = *(const u32x4*)(src + 8 * c);
        k[8 * c + 0] = bflo(w.x); k[8 * c + 1] = bfhi(w.x); k[8 * c + 2] = bflo(w.y); k[8 * c + 3] = bfhi(w.y);
        k[8 * c + 4] = bflo(w.z); k[8 * c + 5] = bfhi(w.z); k[8 * c + 6] = bflo(w.w); k[8 * c + 7] = bfhi(w.w);
    }
}
__device__ __forceinline__ float dot_row64(const bf16_t* src, const float (&q)[64]) {
    float s0 = 0.f, s1 = 0.f;
#pragma unroll
    for (int c = 0; c < 8; ++c) {
        const u32x4 w = *(const u32x4*)(src + 8 * c);
        s0 += q[8 * c + 0] * bflo(w.x); s1 += q[8 * c + 1] * bfhi(w.x); s0 += q[8 * c + 2] * bflo(w.y); s1 += q[8 * c + 3] * bfhi(w.y);
        s0 += q[8 * c + 4] * bflo(w.z); s1 += q[8 * c + 5] * bfhi(w.z); s0 += q[8 * c + 6] * bflo(w.w); s1 += q[8 * c + 7] * bfhi(w.w);
    }
    return s0 + s1;
}
__device__ __forceinline__ void osm_update(float s, const bf16_t* vsrc, float& m, float& l, float (&acc)[32]) {
    const float mn = fmaxf(m, s), alpha = __expf(m - mn), pr = __expf(s - mn);
    l = l * alpha + pr; m = mn;
#pragma unroll
    for (int c = 0; c < 4; ++c) {
        const u32x4 w = *(const u32x4*)(vsrc + 8 * c);
        acc[8 * c + 0] = acc[8 * c + 0] * alpha + pr * bflo(w.x); acc[8 * c + 1] = acc[8 * c + 1] * alpha + pr * bfhi(w.x);
        acc[8 * c + 2] = acc[8 * c + 2] * alpha + pr * bflo(w.y); acc[8 * c + 3] = acc[8 * c + 3] * alpha + pr * bfhi(w.y);
        acc[8 * c + 4] = acc[8 * c + 4] * alpha + pr * bflo(w.z); acc[8 * c + 5] = acc[8 * c + 5] * alpha + pr * bfhi(w.z);
        acc[8 * c + 6] = acc[8 * c + 6] * alpha + pr * bflo(w.w); acc[8 * c + 7] = acc[8 * c + 7] * alpha + pr * bfhi(w.w);
    }
}

__device__ __forceinline__ void phase_nsa(const Params& p, float* lds) {
    float* imp = lds;
    int* sel = (int*)(lds + 64 * 129);
    const int tid = tid_opaque(), qi = tid & 63, h = (tid >> 6) & 3, dh = tid >> 8;
    const unsigned char* ws = p.ws;
    const int nunits = BATCH * NSA_G * (T / 64);
    for (int u = blockIdx.x; u < nunits; u += gridDim.x) {
        const int b = u / (NSA_G * (T / 64)), g = (u / (T / 64)) % NSA_G, tile = u % (T / 64);
        const int t = tile * 64 + qi, head = g * 4 + h;
        const float slope = exp2f(-0.5f * (float)(9 + head));
        float q[64];
        load_row64((const bf16_t*)(ws + WS_QN) + ((size_t)(b * 8 + head) * T + t) * 64, q);
        const bf16_t* KC = (const bf16_t*)(ws + WS_KC) + (size_t)(b * 2 + g) * NCMPP * 64;
        const bf16_t* VC = (const bf16_t*)(ws + WS_VC) + (size_t)(b * 2 + g) * NCMPP * 64 + dh * 32;
        const bf16_t* KS = (const bf16_t*)(ws + WS_KV6 + 2 * KV6_STRIDE) + (size_t)(b * 2 + g) * T * 64;
        const bf16_t* VS = (const bf16_t*)(ws + WS_KV6 + 3 * KV6_STRIDE) + (size_t)(b * 2 + g) * T * 64 + dh * 32;
        const bf16_t* KW = (const bf16_t*)(ws + WS_KV6 + 4 * KV6_STRIDE) + (size_t)(b * 2 + g) * T * 64;
        const bf16_t* VW = (const bf16_t*)(ws + WS_KV6 + 5 * KV6_STRIDE) + (size_t)(b * 2 + g) * T * 64 + dh * 32;
        const float* gs = (const float*)(ws + WS_GSIG) + (size_t)(b * T + t) * 24 + head * 3;
        float o[32];
#pragma unroll
        for (int d = 0; d < 32; ++d) o[d] = 0.f;
        for (int i = tid; i < 64 * 129; i += NTHREADS) imp[i] = 0.f;
        __syncthreads();
        const int nc = 4 * tile + 3;
        float mc = -1e30f, lc = 0.f;
        {
            float acc[32];
#pragma unroll
            for (int d = 0; d < 32; ++d) acc[d] = 0.f;
            for (int c = 0; c < nc; ++c) {
                const int dist = t - (16 * c + 31);
                if (dist >= 0) {
                    const float s = dot_row64(KC + (size_t)c * 64, q) - slope * (float)dist;
                    osm_update(s, VC + (size_t)c * 64, mc, lc, acc);
                }
            }
            const float inv = gs[0] / fmaxf(lc, 1e-30f);
#pragma unroll
            for (int d = 0; d < 32; ++d) o[d] += acc[d] * inv;
        }
        if (dh == 0) {
            const float invl = 1.0f / fmaxf(lc, 1e-30f);
            for (int c = 0; c < nc; ++c) {
                const int dist = t - (16 * c + 31);
                if (dist >= 0) {
                    const float s = dot_row64(KC + (size_t)c * 64, q) - slope * (float)dist;
                    const float pr = __expf(s - mc) * invl;
                    const int sb = c >> 2;
                    atomicAdd(&imp[qi * 129 + sb], pr);
                    if ((c & 3) == 3 && sb + 1 < NSEL) atomicAdd(&imp[qi * 129 + sb + 1], pr);
                }
            }
        }
        __syncthreads();
        if (tid < 64) {
            const int blk_t = tile;
            float* row = imp + tid * 129;
            for (int j = 0; j <= blk_t; ++j) if (j == 0 || j == blk_t || j == blk_t - 1) row[j] = 1.0e4f;
            for (int k = 0; k < TOPN; ++k) {
                float best = -INFINITY; int bi = -1;
                for (int j = 0; j <= blk_t; ++j) { const float v = row[j]; if (v > best) { best = v; bi = j; } }
                sel[tid * 16 + k] = bi;
                if (bi >= 0) row[bi] = -INFINITY;
            }
        }
        __syncthreads();
        {
            float m = -1e30f, l = 0.f, acc[32];
#pragma unroll
            for (int d = 0; d < 32; ++d) acc[d] = 0.f;
            for (int k = 0; k < TOPN; ++k) {
                const int j = sel[qi * 16 + k];
                if (j >= 0) {
                    for (int i = 0; i < 64; ++i) {
                        const int pos = 64 * j + i;
                        if (pos <= t) {
                            const float s = dot_row64(KS + (size_t)pos * 64, q) - slope * (float)(t - pos);
                            osm_update(s, VS + (size_t)pos * 64, m, l, acc);
                        }
                    }
                }
            }
            const float inv = gs[1] / fmaxf(l, 1e-30f);
#pragma unroll
            for (int d = 0; d < 32; ++d) o[d] += acc[d] * inv;
        }
        {
            float m = -1e30f, l = 0.f, acc[32];
#pragma unroll
            for (int d = 0; d < 32; ++d) acc[d] = 0.f;
            for (int i = 0; i < NSA_WIN; ++i) {
                const int pos = t - (NSA_WIN - 1) + i;
                if (pos >= 0) {
                    const float s = dot_row64(KW + (size_t)pos * 64, q) - slope * (float)(t - pos);
                    osm_update(s, VW + (size_t)pos * 64, m, l, acc);
                }
            }
            const float inv = gs[2] / fmaxf(l, 1e-30f);
#pragma unroll
            for (int d = 0; d < 32; ++d) o[d] += acc[d] * inv;
        }
        bf16_t* O = (bf16_t*)(p.ws + WS_O) + (size_t)(b * T + t) * D + g * 256 + h * 64 + dh * 32;
#pragma unroll
        for (int c = 0; c < 4; ++c) {
            u32x4 w; w.x = pk2(o[8 * c], o[8 * c + 1]); w.y = pk2(o[8 * c + 2], o[8 * c + 3]); w.z = pk2(o[8 * c + 4], o[8 * c + 5]); w.w = pk2(o[8 * c + 6], o[8 * c + 7]);
            *(u32x4*)(O + 8 * c) = w;
        }
        __syncthreads();
    }
}

__device__ __forceinline__ void phase_swa(const Params& p) {
    const unsigned char* ws = p.ws;
    const long gt = (long)blockIdx.x * NTHREADS + tid_opaque(), ngt = (long)gridDim.x * NTHREADS;
    const long items = (long)NTOK * SWA_H * 2;
    for (long it = gt; it < items; it += ngt) {
        const int tt = (int)(it % T); long r = it / T;
        const int dh = (int)(r % 2); r /= 2;
        const int head = (int)(r % SWA_H); const int b = (int)(r / SWA_H);
        const float slope = exp2f(-0.5f * (float)(head + 1));
        float q[64];
        load_row64((const bf16_t*)(ws + WS_QS) + ((size_t)(b * 8 + head) * T + tt) * 64, q);
        const bf16_t* K = (const bf16_t*)(ws + WS_KSW) + (size_t)b * T * 64;
        const bf16_t* V = (const bf16_t*)(ws + WS_VSW) + (size_t)b * T * 64 + dh * 32;
        const float sink = p.sinks[head];
        float m = sink, l = 1.0f, acc[32];
#pragma unroll
        for (int d = 0; d < 32; ++d) acc[d] = 0.f;
        for (int i = 0; i < SWA_WIN; ++i) {
            const int pos = tt - (SWA_WIN - 1) + i;
            if (pos >= 0) {
                const float s = dot_row64(K + (size_t)pos * 64, q) - slope * (float)(tt - pos);
                osm_update(s, V + (size_t)pos * 64, m, l, acc);
            }
        }
        const float inv = 1.0f / l;
        bf16_t* O = (bf16_t*)(p.ws + WS_O) + (size_t)(b * T + tt) * D + 512 + head * 64 + dh * 32;
#pragma unroll
        for (int c = 0; c < 4; ++c) {
            u32x4 w; w.x = pk2(acc[8 * c] * inv, acc[8 * c + 1] * inv); w.y = pk2(acc[8 * c + 2] * inv, acc[8 * c + 3] * inv);
            w.z = pk2(acc[8 * c + 4] * inv, acc[8 * c + 5] * inv); w.w = pk2(acc[8 * c + 6] * inv, acc[8 * c + 7] * inv);
            *(u32x4*)(O + 8 * c) = w;
        }
    }
}

__device__ __forceinline__ void topk_insert(float v, int i, float (&tv)[16], int (&ti)[16]) {
#pragma unroll
    for (int k = 0; k < 16; ++k) {
        const bool sw = v > tv[k];
        const float ov = tv[k]; const int oi = ti[k];
        tv[k] = sw ? v : ov; ti[k] = sw ? i : oi;
        v = sw ? ov : v; i = sw ? oi : i;
    }
}
__device__ __forceinline__ void phase_peer_sub(const Params& p) {
    const unsigned char* ws = p.ws;
    const long gt = (long)blockIdx.x * NTHREADS + tid_opaque(), ngt = (long)gridDim.x * NTHREADS;
    const long items = (long)NTOK * 16;
    for (long it = gt; it < items; it += ngt) {
        const int tok = (int)(it % NTOK), hc = (int)(it / NTOK);
        const bf16_t* qp = (const bf16_t*)(ws + WS_QP) + (size_t)tok * PQ + hc * 128;
        float q0[64], q1[64];
        load_row64(qp, q0); load_row64(qp + 64, q1);
        const bf16_t* keys = (const bf16_t*)(ws + WS_PKEYS) + (size_t)hc * 128 * 128;
        float tv[16]; int ti[16];
#pragma unroll
        for (int k = 0; k < 16; ++k) { tv[k] = -INFINITY; ti[k] = 0; }
        for (int n = 0; n < 128; ++n) {
            const float s = dot_row64(keys + (size_t)n * 128, q0) + dot_row64(keys + (size_t)n * 128 + 64, q1);
            topk_insert(s, n, tv, ti);
        }
        float* ov = (float*)(p.ws + WS_TOPV2) + ((size_t)tok * 16 + hc) * 16;
        int* oi = (int*)(p.ws + WS_TOPI2) + ((size_t)tok * 16 + hc) * 16;
#pragma unroll
        for (int k = 0; k < 16; ++k) { ov[k] = tv[k]; oi[k] = ti[k]; }
    }
}
__device__ __forceinline__ void phase_peer_comb(const Params& p) {
    const long gt = (long)blockIdx.x * NTHREADS + tid_opaque(), ngt = (long)gridDim.x * NTHREADS;
    const long items = (long)NTOK * PH;
    for (long it = gt; it < items; it += ngt) {
        const int tok = (int)(it / PH), h = (int)(it % PH);
        const float* v1 = (const float*)(p.ws + WS_TOPV2) + ((size_t)tok * 16 + h * 2) * 16;
        const float* v2 = v1 + 16;
        const int* i1 = (const int*)(p.ws + WS_TOPI2) + ((size_t)tok * 16 + h * 2) * 16;
        const int* i2 = i1 + 16;
        float s2[16];
#pragma unroll
        for (int k = 0; k < 16; ++k) s2[k] = v2[k];
        float tv[16]; int ti[16];
#pragma unroll
        for (int k = 0; k < 16; ++k) { tv[k] = -INFINITY; ti[k] = 0; }
        for (int a = 0; a < 16; ++a) {
            const float s1 = v1[a];
#pragma unroll
            for (int bb = 0; bb < 16; ++bb) topk_insert(s1 + s2[bb], a * 16 + bb, tv, ti);
        }
        float e[16], sum = 0.f;
#pragma unroll
        for (int k = 0; k < 16; ++k) { e[k] = __expf(tv[k] - tv[0]); sum += e[k]; }
        const float inv = 1.0f / sum;
        int* eo = (int*)(p.ws + WS_EIDX) + (size_t)tok * 128 + h * 16;
        float* go = (float*)(p.ws + WS_GATE) + (size_t)tok * 128 + h * 16;
#pragma unroll
        for (int k = 0; k < 16; ++k) { const int ci = ti[k]; eo[k] = i1[ci >> 4] * PNK + i2[ci & 15]; go[k] = e[k] * inv; }
    }
}

typedef float f32x2 __attribute__((ext_vector_type(2)));
__device__ __forceinline__ void unpack16_fp8(const u32x4& w, float (&f)[16]) {
#pragma unroll
    for (int q = 0; q < 4; ++q) {
        const f32x2 lo = __builtin_amdgcn_cvt_pk_f32_fp8((int)w[q], false), hi = __builtin_amdgcn_cvt_pk_f32_fp8((int)w[q], true);
        f[4 * q] = lo.x; f[4 * q + 1] = lo.y; f[4 * q + 2] = hi.x; f[4 * q + 3] = hi.y;
    }
}
__device__ __forceinline__ float reduce8(const float (&d)[8], int lane) {
    const bool b5 = lane & 32, b4 = lane & 16, b3 = lane & 8;
    float e[4], f[2];
#pragma unroll
    for (int i = 0; i < 4; ++i) { const float snd = b5 ? d[i] : d[i + 4], keep = b5 ? d[i + 4] : d[i]; e[i] = keep + __shfl_xor(snd, 32); }
#pragma unroll
    for (int i = 0; i < 2; ++i) { const float snd = b4 ? e[i] : e[i + 2], keep = b4 ? e[i + 2] : e[i]; f[i] = keep + __shfl_xor(snd, 16); }
    const float snd = b3 ? f[0] : f[1], keep = b3 ? f[1] : f[0];
    float g = keep + __shfl_xor(snd, 8);
    g += __shfl_xor(g, 4); g += __shfl_xor(g, 2); g += __shfl_xor(g, 1);
    return g;
}
__device__ __forceinline__ void phase_peer_expert(const Params& p) {
    const unsigned char* ws = p.ws;
    const int tid_ = tid_opaque(), lane = tid_ & 63;
    const int gw = (int)blockIdx.x * (NTHREADS / 64) + __builtin_amdgcn_readfirstlane(tid_ >> 6), ngw = (int)gridDim.x * (NTHREADS / 64);
    const unsigned char* U = ws + WS_U8; const unsigned char* V = ws + WS_V8;
    const unsigned loff = 16u * (unsigned)lane;
    for (int tok = gw; tok < NTOK; tok += ngw) {
        const bf16_t* hg = (const bf16_t*)(ws + WS_H1G + (size_t)tok * D * 2) + loff;
        float a[16];
        {
            const u32x4 w0 = *(const u32x4*)hg, w1 = *(const u32x4*)(hg + 8);
            a[0] = bflo(w0.x); a[1] = bfhi(w0.x); a[2] = bflo(w0.y); a[3] = bfhi(w0.y); a[4] = bflo(w0.z); a[5] = bfhi(w0.z); a[6] = bflo(w0.w); a[7] = bfhi(w0.w);
            a[8] = bflo(w1.x); a[9] = bfhi(w1.x); a[10] = bflo(w1.y); a[11] = bfhi(w1.y); a[12] = bflo(w1.z); a[13] = bfhi(w1.z); a[14] = bflo(w1.w); a[15] = bfhi(w1.w);
        }
        const float rstd2 = (1.0f / U8_SCALE) / sqrtf(((const float*)(ws + WS_SS2))[tok] * (1.0f / D) + EPS);
        const int e_lo = ((const int*)(ws + WS_EIDX))[(size_t)tok * 128 + lane], e_hi = ((const int*)(ws + WS_EIDX))[(size_t)tok * 128 + 64 + lane];
        const float g_lo = ((const float*)(ws + WS_GATE))[(size_t)tok * 128 + lane], g_hi = ((const float*)(ws + WS_GATE))[(size_t)tok * 128 + 64 + lane];
        float acc[16];
#pragma unroll
        for (int i = 0; i < 16; ++i) acc[i] = 0.f;
        u32x4 uw[8], vw[8];
#pragma unroll
        for (int k = 0; k < 8; ++k) { const int e = __builtin_amdgcn_readlane(e_lo, k); uw[k] = *(const u32x4*)(U + (size_t)e * D + loff); vw[k] = *(const u32x4*)(V + (size_t)e * D + loff); }
#pragma unroll 1
        for (int b = 0; b < 16; ++b) {
            const int nsrc = (b + 1 < 8) ? e_lo : e_hi; const int nbase = ((b + 1) & 7) * 8;
            float d[8];
#pragma unroll
            for (int k = 0; k < 8; ++k) {
                float uf[16]; unpack16_fp8(uw[k], uf);
                float d0 = 0.f, d1 = 0.f;
#pragma unroll
                for (int i = 0; i < 16; i += 2) { d0 += a[i] * uf[i]; d1 += a[i + 1] * uf[i + 1]; }
                d[k] = d0 + d1;
                __builtin_amdgcn_sched_barrier(0);
            }
            if (b + 1 < 16) {
#pragma unroll
                for (int k = 0; k < 8; ++k) { const int e = __builtin_amdgcn_readlane(nsrc, nbase + k); uw[k] = *(const u32x4*)(U + (size_t)e * D + loff); }
            }
            const float dk = reduce8(d, lane);
            const float gsel = __shfl((b < 8) ? g_lo : g_hi, (b & 7) * 8 + ((lane >> 3) & 7));
            const float w = gsel * gelu_tanh(dk * rstd2);
#pragma unroll
            for (int k = 0; k < 8; ++k) {
                const float wk = __uint_as_float((unsigned)__builtin_amdgcn_readlane((int)__float_as_uint(w), 8 * k));
                float vf[16]; unpack16_fp8(vw[k], vf);
#pragma unroll
                for (int i = 0; i < 16; ++i) acc[i] += wk * vf[i];
                __builtin_amdgcn_sched_barrier(0);
            }
            if (b + 1 < 16) {
#pragma unroll
                for (int k = 0; k < 8; ++k) { const int e = __builtin_amdgcn_readlane(nsrc, nbase + k); vw[k] = *(const u32x4*)(V + (size_t)e * D + loff); }
            }
        }
        float* orow = (float*)((unsigned char*)p.out + (size_t)tok * D * 4) + loff;
        float y[16]; float ss = 0.f;
#pragma unroll
        for (int q = 0; q < 4; ++q) {
            const f32x4 h = *(const f32x4*)(orow + 4 * q);
            y[4 * q] = h.x + acc[4 * q] * (1.0f / V8_SCALE); y[4 * q + 1] = h.y + acc[4 * q + 1] * (1.0f / V8_SCALE);
            y[4 * q + 2] = h.z + acc[4 * q + 2] * (1.0f / V8_SCALE); y[4 * q + 3] = h.w + acc[4 * q + 3] * (1.0f / V8_SCALE);
        }
#pragma unroll
        for (int i = 0; i < 16; ++i) ss += y[i] * y[i];
        const float rstd = 1.0f / sqrtf(wave_sum(ss) * (1.0f / D) + EPS);
#pragma unroll
        for (int q = 0; q < 4; ++q) {
            const f32x4 g = *(const f32x4*)(p.lnf_g + loff + 4 * q);
            *(f32x4*)(orow + 4 * q) = (f32x4){y[4 * q] * rstd * g.x, y[4 * q + 1] * rstd * g.y, y[4 * q + 2] * rstd * g.z, y[4 * q + 3] * rstd * g.w};
        }
    }
}


namespace psel {
#define HD __host__ __device__ __forceinline__
HD unsigned f2ord(float f) { unsigned u = __builtin_bit_cast(unsigned, f); const unsigned m = (unsigned)((int)u >> 31); return u ^ (m | 0x80000000u); }
HD float ord2f(unsigned o) { const unsigned m = (unsigned)((int)o >> 31); return __builtin_bit_cast(float, o ^ (~m | 0x80000000u)); }
HD unsigned umax_(unsigned a, unsigned b) { return a > b ? a : b; }
HD unsigned umin_(unsigned a, unsigned b) { return a < b ? a : b; }
HD void sort16_desc(unsigned (&a)[16]) {
#pragma unroll
    for (int k = 2; k <= 16; k <<= 1)
#pragma unroll
        for (int j = k >> 1; j > 0; j >>= 1)
#pragma unroll
            for (int i = 0; i < 16; ++i) {
                const int l = i ^ j;
                if (l > i) {
                    const bool up = ((i & k) == 0);
                    const unsigned hi = umax_(a[i], a[l]), lo = umin_(a[i], a[l]);
                    a[i] = up ? hi : lo; a[l] = up ? lo : hi;
                }
            }
}
HD void merge16_desc(unsigned (&a)[16], const unsigned (&b)[16]) {
#pragma unroll
    for (int i = 0; i < 16; ++i) a[i] = umax_(a[i], b[15 - i]);
#pragma unroll
    for (int j = 8; j > 0; j >>= 1)
#pragma unroll
        for (int i = 0; i < 16; ++i) {
            const int l = i ^ j;
            if (l > i) { const unsigned hi = umax_(a[i], a[l]), lo = umin_(a[i], a[l]); a[i] = hi; a[l] = lo; }
        }
}
HD void top16_of_64(unsigned (&g0)[16], unsigned (&g1)[16], unsigned (&g2)[16], unsigned (&g3)[16]) {
    sort16_desc(g0); sort16_desc(g1); sort16_desc(g2); sort16_desc(g3);
    merge16_desc(g0, g1); merge16_desc(g2, g3); merge16_desc(g0, g2);
}
struct PairTab { int a[64]; int b[64]; int n; };
constexpr PairTab make_pairs() {
    PairTab t{}; int n = 0;
    for (int a = 0; a < 16; ++a) for (int b = 0; b < 16; ++b) if ((a + 1) * (b + 1) <= 16) { t.a[n] = a; t.b[n] = b; ++n; }
    t.n = n; for (int i = n; i < 64; ++i) { t.a[i] = 0; t.b[i] = 0; }
    return t;
}
#undef HD
typedef float f32x16 __attribute__((ext_vector_type(16)));
#define PLAS __attribute__((address_space(3)))
static constexpr PairTab PT = make_pairs();
__device__ __forceinline__ constexpr int crow_c(int r) { return (r & 3) + 8 * (r >> 2); }
__device__ __forceinline__ void phase_peer_select(const Params& p, unsigned char* lds_generic) {
    const unsigned char* ws = p.ws;
    const int tid = tid_opaque(), lane = tid & 63, wid = __builtin_amdgcn_readfirstlane(tid >> 6), r32 = lane & 31, hi = lane >> 5;
    PLAS int* tab = (PLAS int*)((PLAS unsigned char*)lds_generic) + wid * 2048;
    const int gw = (int)blockIdx.x * (NTHREADS / 64) + wid, ngw = (int)gridDim.x * (NTHREADS / 64);
    const __amdgpu_buffer_rsrc_t rq = __builtin_amdgcn_make_buffer_rsrc((void*)(p.ws + WS_QP), (short)0, (int)((size_t)NTOK * PQ * 2), 0x00020000);
    const __amdgpu_buffer_rsrc_t rk = __builtin_amdgcn_make_buffer_rsrc((void*)(p.ws + WS_PKEYS), (short)0, 16 * 128 * 128 * 2, 0x00020000);
    for (int task = gw; task < (NTOK / 32) * PH; task += ngw) {
        const int tb = task >> 3, h = task & 7, tok = 32 * tb + r32;
        int hi4 = 4 * hi; asm volatile("" : "+v"(hi4));
        unsigned k1[16], k2[16];
#pragma unroll
        for (int c = 0; c < 2; ++c) {
            const int hc = h * 2 + c;
            const unsigned qoff = (unsigned)(r32 * PQ + 8 * hi) * 2u, koff = (unsigned)(r32 * 128 + 8 * hi) * 2u;
            const int qso = (tb * 32 * PQ + hc * 128) * 2, kso = hc * 128 * 128 * 2;
            bf16x8 qf[8];
#pragma unroll
            for (int d0 = 0; d0 < 8; ++d0) qf[d0] = __builtin_bit_cast(bf16x8, __builtin_amdgcn_raw_buffer_load_b128(rq, (int)qoff, qso + 32 * d0, 0));
            unsigned g[4][16];
#pragma unroll
            for (int nt = 0; nt < 4; ++nt) {
                f32x16 acc;
#pragma unroll
                for (int r = 0; r < 16; ++r) acc[r] = 0.f;
#pragma unroll
                for (int d0 = 0; d0 < 8; ++d0) {
                    const bf16x8 kf = __builtin_bit_cast(bf16x8, __builtin_amdgcn_raw_buffer_load_b128(rk, (int)koff, kso + nt * 8192 + 32 * d0, 0));
                    acc = __builtin_amdgcn_mfma_f32_32x32x16_bf16(kf, qf[d0], acc, 0, 0, 0);
                }
#pragma unroll
                for (int r = 0; r < 16; ++r) g[nt][r] = (f2ord(acc[r]) & 0xFFFFFF80u) | (unsigned)((127 - 32 * nt - crow_c(r)) - hi4);
                __builtin_amdgcn_sched_barrier(0);
            }
            top16_of_64(g[0], g[1], g[2], g[3]);
            unsigned pb[16];
#pragma unroll
            for (int i = 0; i < 16; ++i) pb[i] = (unsigned)__shfl_xor((int)g[0][i], 32);
            merge16_desc(g[0], pb);
#pragma unroll
            for (int i = 0; i < 16; ++i) { if (c == 0) k1[i] = g[0][i]; else k2[i] = g[0][i]; }
        }
        float v1[16], v2[16];
#pragma unroll
        for (int i = 0; i < 16; ++i) { v1[i] = ord2f(k1[i] & 0xFFFFFF80u); v2[i] = ord2f(k2[i] & 0xFFFFFF80u); }
        unsigned cg[4][16];
#pragma unroll
        for (int s = 0; s < 64; ++s) {
            unsigned key = 0u;
            if (s < PT.n) key = (f2ord(v1[PT.a[s]] + v2[PT.b[s]]) & 0xFFFFFF00u) | (unsigned)(255 - (PT.a[s] * 16 + PT.b[s]));
            cg[s >> 4][s & 15] = key;
        }
        top16_of_64(cg[0], cg[1], cg[2], cg[3]);
#pragma unroll
        for (int i = 0; i < 16; ++i) { tab[i * 64 + lane] = 127 - (int)(k1[i] & 127u); tab[(16 + i) * 64 + lane] = 127 - (int)(k2[i] & 127u); }
        __builtin_amdgcn_fence(__ATOMIC_RELEASE, "wavefront"); __builtin_amdgcn_wave_barrier();
        int eo[16]; float ge[16]; float gsum = 0.f;
        const float top = ord2f(cg[0][0] & 0xFFFFFF00u);
#pragma unroll
        for (int k = 0; k < 16; ++k) {
            const int ab = 255 - (int)(cg[0][k] & 255u);
            eo[k] = tab[(ab >> 4) * 64 + lane] * PNK + tab[(16 + (ab & 15)) * 64 + lane];
            ge[k] = __expf(ord2f(cg[0][k] & 0xFFFFFF00u) - top); gsum += ge[k];
        }
        __builtin_amdgcn_wave_barrier();
        const float ginv = 1.0f / gsum;
        if (hi == 0) {
            int* eout = (int*)(p.ws + WS_EIDX) + (size_t)tok * 128 + h * 16;
            float* gout = (float*)(p.ws + WS_GATE) + (size_t)tok * 128 + h * 16;
#pragma unroll
            for (int q = 0; q < 4; ++q) {
                *(u32x4*)(eout + 4 * q) = (u32x4){(unsigned)eo[4 * q], (unsigned)eo[4 * q + 1], (unsigned)eo[4 * q + 2], (unsigned)eo[4 * q + 3]};
                *(f32x4*)(gout + 4 * q) = (f32x4){ge[4 * q] * ginv, ge[4 * q + 1] * ginv, ge[4 * q + 2] * ginv, ge[4 * q + 3] * ginv};
            }
        }
    }
}
}

namespace att {
typedef float f32x16 __attribute__((ext_vector_type(16)));
typedef short s16x4 __attribute__((ext_vector_type(4)));
typedef short v4i16_t __attribute__((ext_vector_type(4)));
#define ALAS __attribute__((address_space(3)))
typedef ALAS unsigned char* lptr;
constexpr int L_K = 0, L_V = 16384, L_IMP = 32768, L_SELM = L_IMP + 64 * 129 * 4, L_UNION = L_SELM + 1024, L_WSCR = L_UNION + 16, L_ACC = L_WSCR + 8 * 256, L_END = L_ACC + 8 * 8192;
constexpr float LOG2E = 1.4426950408889634f;
constexpr float THR = 10.0f;
__device__ __forceinline__ constexpr int crow_c(int r) { return (r & 3) + 8 * (r >> 2); }
__device__ __forceinline__ unsigned cvtpk(float lo, float hi) { typedef float f2 __attribute__((ext_vector_type(2))); typedef __bf16 b2 __attribute__((ext_vector_type(2)));
    f2 v = {lo, hi}; b2 b = __builtin_convertvector(v, b2); return __builtin_bit_cast(unsigned, b); }
__device__ __forceinline__ s16x4 vtr(lptr p) { return __builtin_bit_cast(s16x4, __builtin_amdgcn_ds_read_tr16_b64_v4i16((ALAS v4i16_t*)p)); }

struct Stage { u32x4 k, v; };
__device__ __forceinline__ void stage_load(const bf16_t* Kt, const bf16_t* Vt, int wid, int lane, Stage& s, bool withV) {
    s.k = *(const u32x4*)(Kt + (size_t)lane * 64 + wid * 8);
    if (withV) s.v = *(const u32x4*)(Vt + (size_t)(16 * (wid & 3) + (lane >> 2)) * 64 + (wid >> 2) * 32 + (lane & 3) * 8);
}
__device__ __forceinline__ void stage_store(lptr kbuf, lptr vbuf, int wid, int lane, const Stage& s, bool withV) {
    *(ALAS u32x4*)(kbuf + wid * 1024 + lane * 16) = s.k;
    if (withV) *(ALAS u32x4*)(vbuf + wid * 1024 + lane * 16) = s.v;
}
__device__ __forceinline__ void qk_tile(f32x16& p0, f32x16& p1, lptr kbuf, const bf16x8 (&qf)[4], float cb, float sk, int r32, int hi) {
    asm volatile("" : "+v"(sk));
    const float cb2 = cb + sk * (float)(4 * hi);
#pragma unroll
    for (int r = 0; r < 16; ++r) { p0[r] = cb2 + sk * (float)crow_c(r); p1[r] = cb2 + sk * (float)(crow_c(r) + 32); }
    lptr kb = kbuf + hi * 1024 + r32 * 16;
#pragma unroll
    for (int d0 = 0; d0 < 4; ++d0) {
        const bf16x8 k0 = *(const ALAS bf16x8*)(kb + d0 * 2048), k1 = *(const ALAS bf16x8*)(kb + d0 * 2048 + 512);
        p0 = __builtin_amdgcn_mfma_f32_32x32x16_bf16(k0, qf[d0], p0, 0, 0, 0);
        p1 = __builtin_amdgcn_mfma_f32_32x32x16_bf16(k1, qf[d0], p1, 0, 0, 0);
    }
}
__device__ __forceinline__ void mask_tile(f32x16& p0, f32x16& p1, int hi_lim, int lo_lim, int hi) {
    int hl = hi_lim - 4 * hi, ll1 = lo_lim + 1 - 4 * hi;
    asm volatile("" : "+v"(hl), "+v"(ll1));
#pragma unroll
    for (int r = 0; r < 16; ++r) {
        const int c0 = crow_c(r), c1 = crow_c(r) + 32;
        const unsigned t0 = (unsigned)((c0 - ll1) | (hl - c0)), t1 = (unsigned)((c1 - ll1) | (hl - c1));
        p0[r] = fminf(p0[r], __uint_as_float((t0 & 0x80000000u) | 0x7f800000u));
        p1[r] = fminf(p1[r], __uint_as_float((t1 & 0x80000000u) | 0x7f800000u));
    }
}
__device__ __forceinline__ float max3f(float a, float b, float c) { float r; asm("v_max3_f32 %0, %1, %2, %3" : "=v"(r) : "v"(a), "v"(b), "v"(c)); return r; }
__device__ __forceinline__ float max2f(float a, float b) { float r; asm("v_max_f32_e32 %0, %1, %2" : "=v"(r) : "v"(a), "v"(b)); return r; }
__device__ __forceinline__ float tile_max(const f32x16& p0, const f32x16& p1) {
    float a = max3f(p0[0], p0[1], p1[0]), b = max3f(p0[2], p0[3], p1[1]); a = max3f(a, p1[2], p1[3]);
#pragma unroll
    for (int r = 4; r < 16; r += 4) { a = max3f(a, p0[r], p0[r + 1]); b = max3f(b, p0[r + 2], p0[r + 3]); a = max3f(a, p1[r], p1[r + 1]); b = max3f(b, p1[r + 2], p1[r + 3]); }
    const float m = max2f(a, b);
    return max2f(m, __shfl_xor(m, 32));
}
__device__ __forceinline__ float tile_sum(const f32x16& p0, const f32x16& p1) {
    float a = p0[0] + p1[0];
#pragma unroll
    for (int r = 1; r < 16; ++r) a += p0[r] + p1[r];
    return a + __shfl_xor(a, 32);
}
__device__ __forceinline__ void pv_tile(f32x16& o0, f32x16& o1, const f32x16& p0, const f32x16& p1, lptr vbuf, int lane, int hi) {
    u32x4 pw[4];
    pw[0] = (u32x4){cvtpk(p0[0], p0[1]), cvtpk(p0[2], p0[3]), cvtpk(p0[4], p0[5]), cvtpk(p0[6], p0[7])};
    pw[1] = (u32x4){cvtpk(p0[8], p0[9]), cvtpk(p0[10], p0[11]), cvtpk(p0[12], p0[13]), cvtpk(p0[14], p0[15])};
    pw[2] = (u32x4){cvtpk(p1[0], p1[1]), cvtpk(p1[2], p1[3]), cvtpk(p1[4], p1[5]), cvtpk(p1[6], p1[7])};
    pw[3] = (u32x4){cvtpk(p1[8], p1[9]), cvtpk(p1[10], p1[11]), cvtpk(p1[12], p1[13]), cvtpk(p1[14], p1[15])};
    lptr vp = vbuf + ((lane >> 4) & 1) * 32 + (lane & 3) * 8 + (4 * hi + ((lane & 15) >> 2)) * 64;
#pragma unroll
    for (int ks = 0; ks < 4; ++ks) {
        const s16x4 a = vtr(vp + ks * 1024), b = vtr(vp + ks * 1024 + 512);
        const s16x4 c = vtr(vp + 4096 + ks * 1024), d = vtr(vp + 4096 + ks * 1024 + 512);
        const bf16x8 v0 = (bf16x8){a[0], a[1], a[2], a[3], b[0], b[1], b[2], b[3]}, v1 = (bf16x8){c[0], c[1], c[2], c[3], d[0], d[1], d[2], d[3]};
        const bf16x8 pa = __builtin_bit_cast(bf16x8, pw[ks]);
        o0 = __builtin_amdgcn_mfma_f32_32x32x16_bf16(pa, v0, o0, 0, 0, 0);
        o1 = __builtin_amdgcn_mfma_f32_32x32x16_bf16(pa, v1, o1, 0, 0, 0);
    }
}
__device__ __forceinline__ void scale_rows(f32x16& o0, f32x16& o1, float f, ALAS float* wscr, int r32, int hi) {
    if (hi == 0) wscr[r32] = f;
    __builtin_amdgcn_fence(__ATOMIC_RELEASE, "wavefront"); __builtin_amdgcn_wave_barrier();
#pragma unroll
    for (int r = 0; r < 16; ++r) { const float a = wscr[crow_c(r) + 4 * hi]; o0[r] *= a; o1[r] *= a; }
    __builtin_amdgcn_wave_barrier();
}
template <bool FIRST>
__device__ __forceinline__ void acc_rows(ALAS float* accw, const f32x16& o0, const f32x16& o1, float f, ALAS float* wscr, int r32, int hi) {
    if (hi == 0) wscr[r32] = f;
    __builtin_amdgcn_fence(__ATOMIC_RELEASE, "wavefront"); __builtin_amdgcn_wave_barrier();
#pragma unroll
    for (int r = 0; r < 16; ++r) {
        const int row = crow_c(r) + 4 * hi; const float a = wscr[row];
        ALAS float* d = accw + row * 64 + r32;
        if (FIRST) { d[0] = o0[r] * a; d[32] = o1[r] * a; } else { d[0] += o0[r] * a; d[32] += o1[r] * a; }
    }
    __builtin_amdgcn_wave_barrier();
}
__device__ __forceinline__ void store_acc(ALAS float* accw, bf16_t* O, int lane) {
    __builtin_amdgcn_fence(__ATOMIC_RELEASE, "wavefront"); __builtin_amdgcn_wave_barrier();
#pragma unroll
    for (int it = 0; it < 4; ++it) {
        const int item = it * 64 + lane, row = item >> 3, ch = item & 7;
        const f32x4 x = *(const ALAS f32x4*)(accw + row * 64 + ch * 8), y = *(const ALAS f32x4*)(accw + row * 64 + ch * 8 + 4);
        u32x4 w; w.x = cvtpk(x[0], x[1]); w.y = cvtpk(x[2], x[3]); w.z = cvtpk(y[0], y[1]); w.w = cvtpk(y[2], y[3]);
        *(u32x4*)(O + (size_t)(row & 7) * D + (row >> 3) * 64 + ch * 8) = w;
    }
    __builtin_amdgcn_wave_barrier();
}
struct Br { float m, l; f32x16 o0, o1; };
template <bool MASK>
__device__ __forceinline__ void attend_tile(Br& s, lptr kbuf, lptr vbuf, const bf16x8 (&qf)[4], float cb, float sk, int hi_lim, int lo_lim, ALAS float* wscr, int lane, int r32, int hi) {
    f32x16 p0, p1;
    const float mu = (s.m < -1e29f) ? 0.f : s.m;
    qk_tile(p0, p1, kbuf, qf, cb - mu, sk, r32, hi);
    if (MASK) mask_tile(p0, p1, hi_lim, lo_lim, hi);
    const float rm = tile_max(p0, p1);
    if (__any(rm + mu > s.m + THR)) {
        const float mn = fmaxf(s.m, rm + mu), alpha = __builtin_amdgcn_exp2f(s.m - mn), delta = mn - mu;
        s.l *= alpha; s.m = mn;
        scale_rows(s.o0, s.o1, alpha, wscr, r32, hi);
#pragma unroll
        for (int r = 0; r < 16; ++r) { p0[r] -= delta; p1[r] -= delta; }
    }
#pragma unroll
    for (int r = 0; r < 16; ++r) { p0[r] = __builtin_amdgcn_exp2f(p0[r]); p1[r] = __builtin_amdgcn_exp2f(p1[r]); }
    s.l += tile_sum(p0, p1);
    pv_tile(s.o0, s.o1, p0, p1, vbuf, lane, hi);
}

__device__ __forceinline__ void nsa_unit(const Params& p, unsigned char* lds_generic, int b, int g, int tile) {
    lptr lds = (lptr)lds_generic;
    const int tid = tid_opaque(), lane = tid & 63, wid = __builtin_amdgcn_readfirstlane(tid >> 6), r32 = lane & 31, hi = lane >> 5;
    const int h = r32 >> 3, qi = r32 & 7, tq = 8 * wid + qi, t = 64 * tile + tq, head = g * 4 + h;
    const float slope = exp2f(-0.5f * (float)(9 + head)) * LOG2E;
    const unsigned char* ws = p.ws;
    ALAS float* imp = (ALAS float*)(lds + L_IMP);
    ALAS unsigned* selm = (ALAS unsigned*)(lds + L_SELM);
    ALAS unsigned* uni = (ALAS unsigned*)(lds + L_UNION);
    ALAS float* wscr = (ALAS float*)(lds + L_WSCR) + wid * 64;
    const bf16_t* KC = (const bf16_t*)(ws + WS_KC) + (size_t)(b * 2 + g) * NCMPP * 64;
    const bf16_t* VC = (const bf16_t*)(ws + WS_VC) + (size_t)(b * 2 + g) * NCMPP * 64;
    const bf16_t* KS = (const bf16_t*)(ws + WS_KV6 + 2 * KV6_STRIDE) + (size_t)(b * 2 + g) * T * 64;
    const bf16_t* VS = (const bf16_t*)(ws + WS_KV6 + 3 * KV6_STRIDE) + (size_t)(b * 2 + g) * T * 64;
    const bf16_t* KW = (const bf16_t*)(ws + WS_KV6 + 4 * KV6_STRIDE) + (size_t)(b * 2 + g) * T * 64;
    const bf16_t* VW = (const bf16_t*)(ws + WS_KV6 + 5 * KV6_STRIDE) + (size_t)(b * 2 + g) * T * 64;
    const float* gs = (const float*)(ws + WS_GSIG) + (size_t)(b * T + t) * 24 + head * 3;
    bf16x8 qf[4];
    {
        const bf16_t* qp = (const bf16_t*)(ws + WS_QN) + ((size_t)(b * 8 + head) * T + t) * 64 + 8 * hi;
#pragma unroll
        for (int d0 = 0; d0 < 4; ++d0) qf[d0] = *(const bf16x8*)(qp + 16 * d0);
    }
    for (int i = tid; i < 64 * 129; i += NTHREADS) imp[i] = 0.f;
    if (tid < 4) uni[tid] = 0u;
    ALAS float* accw = (ALAS float*)(lds + L_ACC) + wid * 2048;
    Stage st;
    const int nc = 4 * tile + 3, nct = (nc + 63) >> 6;
    const int cmax = (t >= 31) ? ((t - 31) >> 4) : -1;
    const float skc = 16.0f * slope, cbc = -slope * (float)(t - 31);
    float mc = -1e30f, lc = 0.f;
    stage_load(KC, VC, wid, lane, st, false);
    stage_store(lds + L_K, lds + L_V, wid, lane, st, false);
    __syncthreads();
    for (int i = 0; i < nct; ++i) {
        const int cur = i & 1;
        if (i + 1 < nct) stage_load(KC + (size_t)(i + 1) * 64 * 64, VC, wid, lane, st, false);
        f32x16 p0, p1;
        qk_tile(p0, p1, lds + L_K + cur * 8192, qf, cbc + skc * (float)(64 * i), skc, r32, hi);
        if (__any(cmax - 64 * i < 63)) mask_tile(p0, p1, cmax - 64 * i, -1, hi);
        const float rm = tile_max(p0, p1), mn = fmaxf(mc, rm);
#pragma unroll
        for (int r = 0; r < 16; ++r) { p0[r] = __builtin_amdgcn_exp2f(p0[r] - mn); p1[r] = __builtin_amdgcn_exp2f(p1[r] - mn); }
        lc = lc * __builtin_amdgcn_exp2f(mc - mn) + tile_sum(p0, p1); mc = mn;
        if (i + 1 < nct) stage_store(lds + L_K + (cur ^ 1) * 8192, lds + L_V, wid, lane, st, false);
        __syncthreads();
    }
    {
        const float nrm = (lc > 0.f) ? (mc + __builtin_amdgcn_logf(lc)) : 0.f;
        Br sc; sc.m = 0.f; sc.l = 0.f;
#pragma unroll
        for (int r = 0; r < 16; ++r) { sc.o0[r] = 0.f; sc.o1[r] = 0.f; }
        stage_load(KC, VC, wid, lane, st, true);
        stage_store(lds + L_K, lds + L_V, wid, lane, st, true);
        __syncthreads();
        for (int i = 0; i < nct; ++i) {
            const int cur = i & 1;
            if (i + 1 < nct) stage_load(KC + (size_t)(i + 1) * 64 * 64, VC + (size_t)(i + 1) * 64 * 64, wid, lane, st, true);
            f32x16 p0, p1;
            qk_tile(p0, p1, lds + L_K + cur * 8192, qf, cbc + skc * (float)(64 * i) - nrm, skc, r32, hi);
            if (__any(cmax - 64 * i < 63)) mask_tile(p0, p1, cmax - 64 * i, -1, hi);
#pragma unroll
            for (int r = 0; r < 16; ++r) { p0[r] = __builtin_amdgcn_exp2f(p0[r]); p1[r] = __builtin_amdgcn_exp2f(p1[r]); }
            pv_tile(sc.o0, sc.o1, p0, p1, lds + L_V + cur * 8192, lane, hi);
#pragma unroll
            for (int kh = 0; kh < 2; ++kh)
#pragma unroll
                for (int gq = 0; gq < 4; ++gq) {
                    const float e3 = kh ? p1[4 * gq + 3] : p0[4 * gq + 3];
                    float s4 = kh ? ((p1[4 * gq] + p1[4 * gq + 1]) + (p1[4 * gq + 2] + e3)) : ((p0[4 * gq] + p0[4 * gq + 1]) + (p0[4 * gq + 2] + e3));
                    float e = e3;
                    s4 += __shfl_xor(s4, 8); e += __shfl_xor(e, 8);
                    s4 += __shfl_xor(s4, 16); e += __shfl_xor(e, 16);
                    const int sb = 16 * i + 8 * kh + 2 * gq + hi;
                    if (r32 < 8) { atomicAdd((float*)(imp + tq * 129 + sb), s4); if (sb + 1 < NSEL) atomicAdd((float*)(imp + tq * 129 + sb + 1), e); }
                }
            if (i + 1 < nct) stage_store(lds + L_K + (cur ^ 1) * 8192, lds + L_V + (cur ^ 1) * 8192, wid, lane, st, true);
            __syncthreads();
        }
        acc_rows<true>(accw, sc.o0, sc.o1, gs[0], wscr, r32, hi);
    }
    {
        const int q = tid >> 3, sub = tid & 7;
        float v[16];
#pragma unroll
        for (int i = 0; i < 16; ++i) {
            const int j = sub * 16 + i; float x = imp[q * 129 + j];
            if (j == 0 || j == tile || j == tile - 1) x = 1.0e4f;
            if (j > tile) x = -INFINITY;
            v[i] = x;
        }
        unsigned w0 = 0u, w1 = 0u, w2 = 0u, w3 = 0u;
        for (int it = 0; it < TOPN; ++it) {
            float best = v[0]; int bi = 0;
#pragma unroll
            for (int i = 1; i < 16; ++i) if (v[i] > best) { best = v[i]; bi = i; }
            int bj = sub * 16 + bi;
#pragma unroll
            for (int off = 1; off < 8; off <<= 1) {
                const float ob = __shfl_xor(best, off); const int oj = __shfl_xor(bj, off);
                const bool take = (ob > best) || (ob == best && oj < bj);
                best = take ? ob : best; bj = take ? oj : bj;
            }
            if (best > -INFINITY) {
                const int k = bj >> 5; const unsigned bit = 1u << (bj & 31);
                w0 |= (k == 0) ? bit : 0u; w1 |= (k == 1) ? bit : 0u; w2 |= (k == 2) ? bit : 0u; w3 |= (k == 3) ? bit : 0u;
                const int own = bj - sub * 16;
#pragma unroll
                for (int i = 0; i < 16; ++i) v[i] = (i == own) ? -INFINITY : v[i];
            }
        }
        if (sub == 0) {
            selm[q * 4 + 0] = w0; selm[q * 4 + 1] = w1; selm[q * 4 + 2] = w2; selm[q * 4 + 3] = w3;
            atomicOr((unsigned*)(uni + 0), w0); atomicOr((unsigned*)(uni + 1), w1); atomicOr((unsigned*)(uni + 2), w2); atomicOr((unsigned*)(uni + 3), w3);
        }
    }
    __syncthreads();
    {
        unsigned u0 = uni[0], u1 = uni[1], u2 = uni[2], u3 = uni[3];
        u0 = __builtin_amdgcn_readfirstlane(u0); u1 = __builtin_amdgcn_readfirstlane(u1); u2 = __builtin_amdgcn_readfirstlane(u2); u3 = __builtin_amdgcn_readfirstlane(u3);
        const unsigned s0 = selm[tq * 4 + 0], s1 = selm[tq * 4 + 1], s2 = selm[tq * 4 + 2], s3 = selm[tq * 4 + 3];
        Br sb_; sb_.m = -1e30f; sb_.l = 0.f;
#pragma unroll
        for (int r = 0; r < 16; ++r) { sb_.o0[r] = 0.f; sb_.o1[r] = 0.f; }
#define POP_BLOCK(j) do { if (u3) { const int bb = 31 - __builtin_clz(u3); u3 ^= 1u << bb; j = 96 + bb; } else if (u2) { const int bb = 31 - __builtin_clz(u2); u2 ^= 1u << bb; j = 64 + bb; } \
        else if (u1) { const int bb = 31 - __builtin_clz(u1); u1 ^= 1u << bb; j = 32 + bb; } else if (u0) { const int bb = 31 - __builtin_clz(u0); u0 ^= 1u << bb; j = bb; } else j = -1; } while (0)
        int j; POP_BLOCK(j);
        if (j >= 0) {
            stage_load(KS + (size_t)j * 64 * 64, VS + (size_t)j * 64 * 64, wid, lane, st, true);
            stage_store(lds + L_K, lds + L_V, wid, lane, st, true);
        }
        __syncthreads();
        int cur = 0;
        while (j >= 0) {
            int jn; POP_BLOCK(jn);
            if (jn >= 0) stage_load(KS + (size_t)jn * 64 * 64, VS + (size_t)jn * 64 * 64, wid, lane, st, true);
            const unsigned wsel = (j >> 5) == 0 ? s0 : (j >> 5) == 1 ? s1 : (j >> 5) == 2 ? s2 : s3;
            const bool mine = (wsel >> (j & 31)) & 1u;
            if (__any(mine)) {
                const float cb = mine ? -slope * (float)(t - 64 * j) : -INFINITY;
                if (j == tile) attend_tile<true>(sb_, lds + L_K + cur * 8192, lds + L_V + cur * 8192, qf, cb, slope, tq, -1, wscr, lane, r32, hi);
                else attend_tile<false>(sb_, lds + L_K + cur * 8192, lds + L_V + cur * 8192, qf, cb, slope, 63, -1, wscr, lane, r32, hi);
            }
            if (jn >= 0) stage_store(lds + L_K + (cur ^ 1) * 8192, lds + L_V + (cur ^ 1) * 8192, wid, lane, st, true);
            __syncthreads();
            cur ^= 1; j = jn;
        }
#undef POP_BLOCK
        acc_rows<false>(accw, sb_.o0, sb_.o1, gs[1] / fmaxf(sb_.l, 1e-30f), wscr, r32, hi);
    }
    {
        Br sw; sw.m = -1e30f; sw.l = 0.f;
#pragma unroll
        for (int r = 0; r < 16; ++r) { sw.o0[r] = 0.f; sw.o1[r] = 0.f; }
        const int jlo = (tile - 8 > 0) ? tile - 8 : 0;
        stage_load(KW + (size_t)tile * 64 * 64, VW + (size_t)tile * 64 * 64, wid, lane, st, true);
        stage_store(lds + L_K, lds + L_V, wid, lane, st, true);
        __syncthreads();
        int cur = 0;
        for (int j = tile; j >= jlo; --j) {
            if (j > jlo) stage_load(KW + (size_t)(j - 1) * 64 * 64, VW + (size_t)(j - 1) * 64 * 64, wid, lane, st, true);
            const float cb = -slope * (float)(t - 64 * j);
            if (j == tile) attend_tile<true>(sw, lds + L_K + cur * 8192, lds + L_V + cur * 8192, qf, cb, slope, tq, -1, wscr, lane, r32, hi);
            else if (j == tile - 8) attend_tile<true>(sw, lds + L_K + cur * 8192, lds + L_V + cur * 8192, qf, cb, slope, 63, tq, wscr, lane, r32, hi);
            else attend_tile<false>(sw, lds + L_K + cur * 8192, lds + L_V + cur * 8192, qf, cb, slope, 63, -1, wscr, lane, r32, hi);
            if (j > jlo) stage_store(lds + L_K + (cur ^ 1) * 8192, lds + L_V + (cur ^ 1) * 8192, wid, lane, st, true);
            __syncthreads();
            cur ^= 1;
        }
        acc_rows<false>(accw, sw.o0, sw.o1, gs[2] / fmaxf(sw.l, 1e-30f), wscr, r32, hi);
    }
    store_acc(accw, (bf16_t*)(p.ws + WS_O) + (size_t)(b * T + 64 * tile + 8 * wid) * D + g * 256, lane);
}

__device__ __forceinline__ void swa_unit(const Params& p, unsigned char* lds_generic, int b, int hh, int tile) {
    lptr lds = (lptr)lds_generic;
    const int tid = tid_opaque(), lane = tid & 63, wid = __builtin_amdgcn_readfirstlane(tid >> 6), r32 = lane & 31, hi = lane >> 5;
    const int h = r32 >> 3, qi = r32 & 7, tq = 8 * wid + qi, t = 64 * tile + tq, head = hh * 4 + h;
    const float slope = exp2f(-0.5f * (float)(head + 1)) * LOG2E;
    const unsigned char* ws = p.ws;
    ALAS float* wscr = (ALAS float*)(lds + L_WSCR) + wid * 64;
    const bf16_t* K = (const bf16_t*)(ws + WS_KSW) + (size_t)b * T * 64;
    const bf16_t* V = (const bf16_t*)(ws + WS_VSW) + (size_t)b * T * 64;
    bf16x8 qf[4];
    {
        const bf16_t* qp = (const bf16_t*)(ws + WS_QS) + ((size_t)(b * 8 + head) * T + t) * 64 + 8 * hi;
#pragma unroll
        for (int d0 = 0; d0 < 4; ++d0) qf[d0] = *(const bf16x8*)(qp + 16 * d0);
    }
    Br sw; sw.m = p.sinks[head] * LOG2E; sw.l = 1.0f;
#pragma unroll
    for (int r = 0; r < 16; ++r) { sw.o0[r] = 0.f; sw.o1[r] = 0.f; }
    Stage st;
    const int jlo = (tile - 2 > 0) ? tile - 2 : 0;
    stage_load(K + (size_t)tile * 64 * 64, V + (size_t)tile * 64 * 64, wid, lane, st, true);
    stage_store(lds + L_K, lds + L_V, wid, lane, st, true);
    __syncthreads();
    int cur = 0;
    for (int j = tile; j >= jlo; --j) {
        if (j > jlo) stage_load(K + (size_t)(j - 1) * 64 * 64, V + (size_t)(j - 1) * 64 * 64, wid, lane, st, true);
        const float cb = -slope * (float)(t - 64 * j);
        if (j == tile) attend_tile<true>(sw, lds + L_K + cur * 8192, lds + L_V + cur * 8192, qf, cb, slope, tq, -1, wscr, lane, r32, hi);
        else if (j == tile - 2) attend_tile<true>(sw, lds + L_K + cur * 8192, lds + L_V + cur * 8192, qf, cb, slope, 63, tq, wscr, lane, r32, hi);
        else attend_tile<false>(sw, lds + L_K + cur * 8192, lds + L_V + cur * 8192, qf, cb, slope, 63, -1, wscr, lane, r32, hi);
        if (j > jlo) stage_store(lds + L_K + (cur ^ 1) * 8192, lds + L_V + (cur ^ 1) * 8192, wid, lane, st, true);
        __syncthreads();
        cur ^= 1;
    }
    ALAS float* accw = (ALAS float*)(lds + L_ACC) + wid * 2048;
    acc_rows<true>(accw, sw.o0, sw.o1, 1.0f / sw.l, wscr, r32, hi);
    store_acc(accw, (bf16_t*)(p.ws + WS_O) + (size_t)(b * T + 64 * tile + 8 * wid) * D + 512 + hh * 256, lane);
}
__device__ __forceinline__ void phase_swa_mfma(const Params& p, unsigned char* lds) {
    for (int u = blockIdx.x; u < BATCH * 2 * (T / 64); u += gridDim.x) swa_unit(p, lds, u >> 8, (u >> 7) & 1, u & 127);
}
__device__ __forceinline__ void phase_nsa_mfma(const Params& p, unsigned char* lds) {
    const int nu = BATCH * NSA_G * (T / 64);
    for (int i = blockIdx.x; i < nu; i += gridDim.x) {
        const int u = (i < (int)gridDim.x) ? (nu - 1 - i) : (i - (int)gridDim.x);
        nsa_unit(p, lds, u >> 8, (u >> 7) & 1, u & 127);
    }
}
}


namespace cmp {
#define CLAS __attribute__((address_space(3)))
constexpr int HS = 264;
__device__ __forceinline__ void compress_unit(const Params& p, unsigned char* lds_generic, int unit) {
    const unsigned char* ws = p.ws;
    const int tid = tid_opaque(), lane = tid & 63, wid = __builtin_amdgcn_readfirstlane(tid >> 6), fr = lane & 15, fq = lane >> 4;
    const int row0 = unit * 32, kv = row0 >> 11, bg = (row0 & 2047) >> 9, c0 = row0 & 511;
    const bf16_t* raw = (const bf16_t*)(ws + WS_KV6 + (size_t)kv * KV6_STRIDE) + (size_t)bg * T * 64;
    const bf16_t* W1T = (const bf16_t*)(ws + WS_W1T) + (size_t)kv * 256 * 2048;
    const bf16_t* W2T = (const bf16_t*)(ws + WS_W2T) + (size_t)kv * 64 * 256;
    const float* b1 = (const float*)(ws + WS_B1) + kv * 256;
    CLAS bf16_t* H = (CLAS bf16_t*)((CLAS unsigned char*)lds_generic);
    const int n0 = wid * 32;
    f32x4 acc[2][2];
#pragma unroll
    for (int i = 0; i < 2; ++i)
#pragma unroll
        for (int j = 0; j < 2; ++j) acc[i][j] = (f32x4){0.f, 0.f, 0.f, 0.f};
    const bf16_t* ap = raw + (size_t)(c0 + fr) * 1024 + fq * 8;
    const bf16_t* bp = W1T + (size_t)(n0 + fr) * 2048 + fq * 8;
    constexpr int PF = 4;
    bf16x8 a[PF][2], b[PF][2];
#pragma unroll
    for (int s = 0; s < PF; ++s)
#pragma unroll
        for (int i = 0; i < 2; ++i) { a[s][i] = *(const bf16x8*)(ap + (size_t)i * 16 * 1024 + 32 * s); b[s][i] = *(const bf16x8*)(bp + (size_t)i * 16 * 2048 + 32 * s); }
    for (int k0 = 0; k0 < 2048; k0 += 32 * PF) {
#pragma unroll
        for (int s = 0; s < PF; ++s) {
#pragma unroll
            for (int i = 0; i < 2; ++i)
#pragma unroll
                for (int j = 0; j < 2; ++j) acc[i][j] = __builtin_amdgcn_mfma_f32_16x16x32_bf16(a[s][i], b[s][j], acc[i][j], 0, 0, 0);
            const int kn = k0 + 32 * (PF + s);
            if (kn < 2048) {
#pragma unroll
                for (int i = 0; i < 2; ++i) { a[s][i] = *(const bf16x8*)(ap + (size_t)i * 16 * 1024 + kn); b[s][i] = *(const bf16x8*)(bp + (size_t)i * 16 * 2048 + kn); }
            }
        }
    }
#pragma unroll
    for (int i = 0; i < 2; ++i)
#pragma unroll
        for (int j = 0; j < 2; ++j) {
            const int n = n0 + 16 * j + fr; const float bias = b1[n];
#pragma unroll
            for (int r = 0; r < 4; ++r) H[(16 * i + 4 * fq + r) * HS + n] = (bf16_t)f2bf(gelu_tanh(acc[i][j][r] + bias));
        }
    __syncthreads();
    {
        const int mi = wid >> 2, nj = wid & 3;
        f32x4 o = (f32x4){0.f, 0.f, 0.f, 0.f};
        const CLAS bf16_t* hp = H + (16 * mi + fr) * HS + fq * 8;
        const bf16_t* wp = W2T + (size_t)(16 * nj + fr) * 256 + fq * 8;
#pragma unroll
        for (int k0 = 0; k0 < 256; k0 += 32) {
            const bf16x8 ha = *(const CLAS bf16x8*)(hp + k0), wb = *(const bf16x8*)(wp + k0);
            o = __builtin_amdgcn_mfma_f32_16x16x32_bf16(ha, wb, o, 0, 0, 0);
        }
        bf16_t* dst = (bf16_t*)(p.ws + (kv ? WS_VC : WS_KC)) + ((size_t)bg * NCMPP + c0 + 16 * mi + 4 * fq) * 64 + 16 * nj + fr;
#pragma unroll
        for (int r = 0; r < 4; ++r) dst[(size_t)r * 64] = (bf16_t)f2bf(o[r]);
    }
    __syncthreads();
}
__device__ __forceinline__ void phase_compress_swa(const Params& p, unsigned char* lds) {
    const int G = (int)gridDim.x, bx = (int)blockIdx.x;
    if (G >= 256) {
        if (bx < 128) { compress_unit(p, lds, bx); }
        else { for (int u = bx - 128; u < BATCH * 2 * (T / 64); u += G - 128) att::swa_unit(p, lds, u >> 8, (u >> 7) & 1, u & 127);
               convert_expert_tables(p, bx - 128, G - 128); }
    } else {
        for (int u = bx; u < 128; u += G) compress_unit(p, lds, u);
        for (int u = bx; u < BATCH * 2 * (T / 64); u += G) att::swa_unit(p, lds, u >> 8, (u >> 7) & 1, u & 127);
        convert_expert_tables(p, bx, G);
    }
}
}

#define XB_TMO      128
#define XB_XCNT(j)  (256  + 64 * (j))
#define XB_XSUB(j)  (1280 + 64 * (j))
#define XB_XGEN(j)  (2304 + 64 * (j))
#define XB_TOP      3328
#define XB_TOPGEN   3392
#define XCD_BAR_WORDS 3456
#define XB_SPIN_CAP (1u << 18)
#define XLAS __attribute__((address_space(3)))

__device__ __forceinline__ unsigned xb_ld(unsigned* p)              { return __hip_atomic_load(p, __ATOMIC_RELAXED, __HIP_MEMORY_SCOPE_AGENT); }
__device__ __forceinline__ unsigned xb_add(unsigned* p, unsigned v) { return __hip_atomic_fetch_add(p, v, __ATOMIC_RELAXED, __HIP_MEMORY_SCOPE_AGENT); }
__device__ __forceinline__ unsigned xb_xcc_id() { return (unsigned)__builtin_amdgcn_s_getreg((3 << 11) | 20) & 0xFu; }
#define XB_SPIN(cond, bar) do { unsigned _sp = 0; while (cond) { __builtin_amdgcn_s_sleep(1); \
    if ((++_sp & 255u) == 0u) { if (xb_ld(&(bar)[XB_TMO])) break; if (_sp > XB_SPIN_CAP) { atomicAdd(&(bar)[XB_TMO], 1u); break; } } } } while (0)

struct XcdBarrier {
    unsigned* bar; unsigned x;
    volatile XLAS unsigned* st;
};

__device__ __forceinline__ XcdBarrier xcd_barrier_post(unsigned* bar, volatile XLAS unsigned* st) {
    XcdBarrier b; b.bar = bar; b.x = xb_xcc_id(); b.st = st;
    if (threadIdx.x == 0) (void)xb_add(&bar[XB_XCNT(b.x)], 1u);
    return b;
}
__device__ __forceinline__ void xcd_barrier_complete(unsigned* bar, unsigned x, unsigned& nloc, unsigned& nx) {
    const unsigned G = gridDim.x * gridDim.y * gridDim.z;
    unsigned sum, cnt, mine, sp = 0u;
    for (;;) {
        sum = 0u; cnt = 0u; mine = 0u;
#pragma unroll
        for (unsigned j = 0; j < 16; ++j) { const unsigned c = xb_ld(&bar[XB_XCNT(j)]); sum += c; cnt += (c > 0u) ? 1u : 0u; mine = (j == x) ? c : mine; }
        if (sum == G) break;
        __builtin_amdgcn_s_sleep(1);
        if ((++sp & 255u) == 0u) { if (xb_ld(&bar[XB_TMO])) break; if (sp > XB_SPIN_CAP) { atomicAdd(&bar[XB_TMO], 1u); break; } }
    }
    nloc = mine > 0u ? mine : 1u; nx = cnt > 0u ? cnt : 1u;
}

__device__ __forceinline__ void xcd_barrier(const XcdBarrier& b) {
    asm volatile("s_waitcnt vmcnt(0)" ::: "memory");
    __syncthreads();
    if (threadIdx.x == 0) {
        unsigned* bar = b.bar;
        __builtin_amdgcn_s_waitcnt(0);
        unsigned nloc = b.st[0], nx = b.st[1];
        if (nloc == 0u) { xcd_barrier_complete(bar, b.x, nloc, nx); b.st[0] = nloc; b.st[1] = nx; }
        const unsigned old = xb_add(&bar[XB_XSUB(b.x)], 1u);
        const unsigned gen = old / nloc;
        if (old + 1u == (gen + 1u) * nloc) {
            __builtin_amdgcn_fence(__ATOMIC_RELEASE, "agent");
            asm volatile("s_waitcnt vmcnt(0)" ::: "memory");
            const unsigned og = xb_add(&bar[XB_TOP], 1u);
            const unsigned tg = og / nx;
            if (og + 1u == (tg + 1u) * nx) xb_add(&bar[XB_TOPGEN], 1u);
            else XB_SPIN(xb_ld(&bar[XB_TOPGEN]) == tg, bar);
            __builtin_amdgcn_fence(__ATOMIC_ACQUIRE, "agent");
            xb_add(&bar[XB_XGEN(b.x)], 1u);
            asm volatile("s_waitcnt vmcnt(0)" ::: "memory");
        } else {
            XB_SPIN(xb_ld(&bar[XB_XGEN(b.x)]) == gen, bar);
            __builtin_amdgcn_fence(__ATOMIC_ACQUIRE, "agent");
            asm volatile("s_waitcnt vmcnt(0)" ::: "memory");
        }
    }
    __syncthreads();
}


namespace pex {
constexpr int TOK_PER_TICKET = 8, NTICKET = NTOK / TOK_PER_TICKET;
__device__ __forceinline__ int claim(unsigned* ctr, int lane) {
    unsigned t = 0u;
    if (lane == 0) t = __hip_atomic_fetch_add(ctr, 1u, __ATOMIC_RELAXED, __HIP_MEMORY_SCOPE_AGENT);
    return __builtin_amdgcn_readfirstlane((int)t);
}
struct UMeta { int e_lo, e_hi; float g_lo, g_hi; u32x4 h0, h1; float ss; };
__device__ __forceinline__ void u_meta(const unsigned char* ws, int tok, int lane, unsigned loff, UMeta& m) {
    const int* ep = (const int*)(ws + WS_EIDX) + (size_t)tok * 128;
    m.e_lo = ep[lane]; m.e_hi = ep[64 + lane];
    const float* gp = (const float*)(ws + WS_GATE) + (size_t)tok * 128;
    m.g_lo = gp[lane]; m.g_hi = gp[64 + lane];
    const bf16_t* hg = (const bf16_t*)(ws + WS_H1G + (size_t)tok * D * 2) + loff;
    m.h0 = *(const u32x4*)hg; m.h1 = *(const u32x4*)(hg + 8);
    m.ss = ((const float*)(ws + WS_SS2))[tok];
}
constexpr int UB = 16;
__device__ __forceinline__ void u_task(const unsigned char* ws, int tok, int y, int lane, unsigned loff, const UMeta& m, int tok_next, UMeta& mn) {
    unsigned long long m0 = __ballot((m.e_lo >> 11) == y), m1 = __ballot((m.e_hi >> 11) == y);
    const unsigned char* U = ws + WS_U8;
    const int grp = (lane >> 3) & 7;
    bool first = true;
    f32x2 a2[8]; float rstd2 = 0.f;
    do {
        int slot[UB]; u32x4 uw[UB];
#pragma unroll
        for (int k = 0; k < UB; ++k) {
            int e = 0; slot[k] = -1;
            if (m0 != 0ull) { const int j = __builtin_ctzll(m0); m0 &= m0 - 1ull; slot[k] = j; e = __builtin_amdgcn_readlane(m.e_lo, j); }
            else if (m1 != 0ull) { const int j = __builtin_ctzll(m1); m1 &= m1 - 1ull; slot[k] = 64 + j; e = __builtin_amdgcn_readlane(m.e_hi, j); }
            if (slot[k] >= 0) uw[k] = *(const u32x4*)(U + (size_t)e * D + loff); else uw[k] = (u32x4){0u, 0u, 0u, 0u};
        }
        if (first) {
            if (tok_next >= 0) u_meta(ws, tok_next, lane, loff, mn);
            const u32x4 w0 = m.h0, w1 = m.h1;
            a2[0] = (f32x2){bflo(w0.x), bfhi(w0.x)}; a2[1] = (f32x2){bflo(w0.y), bfhi(w0.y)}; a2[2] = (f32x2){bflo(w0.z), bfhi(w0.z)}; a2[3] = (f32x2){bflo(w0.w), bfhi(w0.w)};
            a2[4] = (f32x2){bflo(w1.x), bfhi(w1.x)}; a2[5] = (f32x2){bflo(w1.y), bfhi(w1.y)}; a2[6] = (f32x2){bflo(w1.z), bfhi(w1.z)}; a2[7] = (f32x2){bflo(w1.w), bfhi(w1.w)};
            rstd2 = (1.0f / U8_SCALE) / sqrtf(m.ss * (1.0f / D) + EPS);
            first = false;
        }
#pragma unroll
        for (int hb = 0; hb < UB / 8; ++hb) {
            if (slot[8 * hb] < 0) break;
            float d[8];
#pragma unroll
            for (int k = 0; k < 8; ++k) {
                f32x2 dd = (f32x2){0.f, 0.f};
#pragma unroll
                for (int q = 0; q < 4; ++q) {
                    const f32x2 lo = __builtin_amdgcn_cvt_pk_f32_fp8((int)uw[8 * hb + k][q], false), hi = __builtin_amdgcn_cvt_pk_f32_fp8((int)uw[8 * hb + k][q], true);
                    dd += a2[2 * q] * lo; dd += a2[2 * q + 1] * hi;
                }
                d[k] = dd.x + dd.y;
                __builtin_amdgcn_sched_barrier(0);
            }
            const float dk = reduce8(d, lane);
            int myslot = -1;
#pragma unroll
            for (int k = 0; k < 8; ++k) myslot = (grp == k) ? slot[8 * hb + k] : myslot;
            const float gA = __shfl(m.g_lo, myslot & 63), gB = __shfl(m.g_hi, myslot & 63);
            const float g = (myslot & 64) ? gB : gA;
            if (myslot >= 0 && (lane & 7) == 0) ((float*)(ws + WS_PW))[(size_t)tok * 128 + myslot] = g * gelu_tanh(dk * rstd2);
        }
    } while ((m0 | m1) != 0ull);
}
struct VMeta { u32x4 e[4]; };
__device__ __forceinline__ void v_meta(const Params& p, int tok, int y, int lane, VMeta& m) {
    const unsigned char* ep = p.ws + WS_EIDX + (size_t)tok * 512;
    const unsigned eoff = (unsigned)(lane >> 3) * 64u;
#pragma unroll
    for (int q = 0; q < 4; ++q) m.e[q] = *(const u32x4*)(ep + eoff + 16 * q);
}
__device__ __forceinline__ void ucol_task(const Params& p, int tok, int y, int lane, const VMeta& m, int tok_next, VMeta& mn) {
    const int cc = lane & 7;
    const bool b2 = lane & 4, b1 = lane & 2, b0 = lane & 1;
    const __amdgpu_buffer_rsrc_t ru = __builtin_amdgcn_make_buffer_rsrc((void*)(p.ws + WS_U8 + (size_t)y * ((size_t)NEXP * 128)), (short)0, NEXP * 128, 0x00020000);
    const unsigned coff = (unsigned)cc * 16u;
    u32x4 uw[16];
#pragma unroll
    for (int q = 0; q < 4; ++q) {
        uw[4 * q] = __builtin_bit_cast(u32x4, __builtin_amdgcn_raw_buffer_load_b128(ru, (int)(m.e[q].x * 128u + coff), 0, 0));
        uw[4 * q + 1] = __builtin_bit_cast(u32x4, __builtin_amdgcn_raw_buffer_load_b128(ru, (int)(m.e[q].y * 128u + coff), 0, 0));
        uw[4 * q + 2] = __builtin_bit_cast(u32x4, __builtin_amdgcn_raw_buffer_load_b128(ru, (int)(m.e[q].z * 128u + coff), 0, 0));
        uw[4 * q + 3] = __builtin_bit_cast(u32x4, __builtin_amdgcn_raw_buffer_load_b128(ru, (int)(m.e[q].w * 128u + coff), 0, 0));
    }
    f32x2 a2[8];
    {
        const unsigned char* hp = p.ws + WS_H1G + (size_t)tok * D * 2 + (size_t)y * 256;
        const u32x4 w0 = *(const u32x4*)(hp + cc * 32u), w1 = *(const u32x4*)(hp + cc * 32u + 16u);
        a2[0] = (f32x2){bflo(w0.x), bfhi(w0.x)}; a2[1] = (f32x2){bflo(w0.y), bfhi(w0.y)}; a2[2] = (f32x2){bflo(w0.z), bfhi(w0.z)}; a2[3] = (f32x2){bflo(w0.w), bfhi(w0.w)};
        a2[4] = (f32x2){bflo(w1.x), bfhi(w1.x)}; a2[5] = (f32x2){bflo(w1.y), bfhi(w1.y)}; a2[6] = (f32x2){bflo(w1.z), bfhi(w1.z)}; a2[7] = (f32x2){bflo(w1.w), bfhi(w1.w)};
    }
    if (tok_next >= 0) v_meta(p, tok_next, y, lane, mn);
    float d[16];
#pragma unroll
    for (int i = 0; i < 16; ++i) {
        f32x2 dd = (f32x2){0.f, 0.f};
#pragma unroll
        for (int q = 0; q < 4; ++q) {
            const f32x2 lo = __builtin_amdgcn_cvt_pk_f32_fp8((int)uw[i][q], false), hi = __builtin_amdgcn_cvt_pk_f32_fp8((int)uw[i][q], true);
            dd += a2[2 * q] * lo; dd += a2[2 * q + 1] * hi;
        }
        d[i] = dd.x + dd.y;
        __builtin_amdgcn_sched_barrier(0);
    }
    float s8[8], s4[4], s2[2];
#pragma unroll
    for (int i = 0; i < 8; ++i) { const float snd = b2 ? d[i] : d[i + 8], keep = b2 ? d[i + 8] : d[i]; s8[i] = keep + __shfl_xor(snd, 4); }
#pragma unroll
    for (int i = 0; i < 4; ++i) { const float snd = b1 ? s8[i] : s8[i + 4], keep = b1 ? s8[i + 4] : s8[i]; s4[i] = keep + __shfl_xor(snd, 2); }
#pragma unroll
    for (int i = 0; i < 2; ++i) { const float snd = b0 ? s4[i] : s4[i + 2], keep = b0 ? s4[i + 2] : s4[i]; s2[i] = keep + __shfl_xor(snd, 1); }
    const unsigned so = (unsigned)(16 * (lane >> 3) + (b2 ? 8 : 0) + (b1 ? 4 : 0) + (b0 ? 2 : 0)) * 4u;
    *(f32x2*)(p.ws + WS_PART + ((size_t)tok * 8 + y) * 512 + so) = (f32x2){s2[0], s2[1]};
}
__device__ __forceinline__ void phase_expert_act(const Params& p) {
    const int tid_ = tid_opaque(), lane = tid_ & 63;
    const int gw = (int)blockIdx.x * (NTHREADS / 64) + __builtin_amdgcn_readfirstlane(tid_ >> 6), ngw = (int)gridDim.x * (NTHREADS / 64);
    for (int tok = gw; tok < NTOK; tok += ngw) {
        const float* pp = (const float*)(p.ws + WS_PART) + (size_t)tok * 1024;
        float sa = 0.f, sb = 0.f;
#pragma unroll
        for (int y = 0; y < 8; ++y) { sa += pp[y * 128 + lane]; sb += pp[y * 128 + 64 + lane]; }
        const float rstd2 = (1.0f / U8_SCALE) / sqrtf(((const float*)(p.ws + WS_SS2))[tok] * (1.0f / D) + EPS);
        const float* gp = (const float*)(p.ws + WS_GATE) + (size_t)tok * 128;
        float* wp = (float*)(p.ws + WS_PW) + (size_t)tok * 128;
        wp[lane] = gp[lane] * gelu_tanh(sa * rstd2);
        wp[64 + lane] = gp[64 + lane] * gelu_tanh(sb * rstd2);
    }
}
__device__ __forceinline__ void v_task(const Params& p, int tok, int y, int lane, const VMeta& m, int tok_next, VMeta& mn) {
    const int cc = lane & 7;
    const bool b5 = lane & 32, b4 = lane & 16, b3 = lane & 8;
    const __amdgpu_buffer_rsrc_t rv = __builtin_amdgcn_make_buffer_rsrc((void*)(p.ws + WS_V8 + (size_t)y * ((size_t)NEXP * 128)), (short)0, NEXP * 128, 0x00020000);
    const unsigned coff = (unsigned)cc * 16u;
    u32x4 vw[16];
#pragma unroll
    for (int q = 0; q < 4; ++q) {
        vw[4 * q] = __builtin_bit_cast(u32x4, __builtin_amdgcn_raw_buffer_load_b128(rv, (int)(m.e[q].x * 128u + coff), 0, 0));
        vw[4 * q + 1] = __builtin_bit_cast(u32x4, __builtin_amdgcn_raw_buffer_load_b128(rv, (int)(m.e[q].y * 128u + coff), 0, 0));
        vw[4 * q + 2] = __builtin_bit_cast(u32x4, __builtin_amdgcn_raw_buffer_load_b128(rv, (int)(m.e[q].z * 128u + coff), 0, 0));
        vw[4 * q + 3] = __builtin_bit_cast(u32x4, __builtin_amdgcn_raw_buffer_load_b128(rv, (int)(m.e[q].w * 128u + coff), 0, 0));
    }
    f32x4 w[4];
    {
        const unsigned char* wp = p.ws + WS_PW + (size_t)tok * 512;
        const unsigned woff = (unsigned)(lane >> 3) * 64u;
#pragma unroll
        for (int q = 0; q < 4; ++q) w[q] = *(const f32x4*)(wp + woff + 16 * q);
    }
    const unsigned colb = (unsigned)(128 * y + 16 * cc + (b5 ? 8 : 0) + (b4 ? 4 : 0) + (b3 ? 2 : 0)) * 4u;
    float* orow = (float*)((unsigned char*)p.out + (size_t)tok * D * 4);
    const f32x2 h = *(const f32x2*)((const unsigned char*)orow + colb);
    if (tok_next >= 0) v_meta(p, tok_next, y, lane, mn);
    f32x2 acc2[8];
#pragma unroll
    for (int q = 0; q < 8; ++q) acc2[q] = (f32x2){0.f, 0.f};
#pragma unroll
    for (int i = 0; i < 16; ++i) {
        const float wi = w[i >> 2][i & 3];
#pragma unroll
        for (int q = 0; q < 4; ++q) {
            const f32x2 lo = __builtin_amdgcn_cvt_pk_f32_fp8((int)vw[i][q], false), hi = __builtin_amdgcn_cvt_pk_f32_fp8((int)vw[i][q], true);
            acc2[2 * q] += lo * wi; acc2[2 * q + 1] += hi * wi;
        }
        __builtin_amdgcn_sched_barrier(0);
    }
    float acc[16];
#pragma unroll
    for (int q = 0; q < 8; ++q) { acc[2 * q] = acc2[q].x; acc[2 * q + 1] = acc2[q].y; }
    float s8[8], s4[4], s2[2];
#pragma unroll
    for (int i = 0; i < 8; ++i) { const float snd = b5 ? acc[i] : acc[i + 8], keep = b5 ? acc[i + 8] : acc[i]; s8[i] = keep + __shfl_xor(snd, 32); }
#pragma unroll
    for (int i = 0; i < 4; ++i) { const float snd = b4 ? s8[i] : s8[i + 4], keep = b4 ? s8[i + 4] : s8[i]; s4[i] = keep + __shfl_xor(snd, 16); }
#pragma unroll
    for (int i = 0; i < 2; ++i) { const float snd = b3 ? s4[i] : s4[i + 2], keep = b3 ? s4[i + 2] : s4[i]; s2[i] = keep + __shfl_xor(snd, 8); }
    *(f32x2*)((unsigned char*)orow + colb) = (f32x2){h.x + s2[0] * (1.0f / V8_SCALE), h.y + s2[1] * (1.0f / V8_SCALE)};
}
template <bool VPHASE, int PROBE = 0>
__device__ __forceinline__ void phase_sliced(const Params& p_in) {
    Params p = p_in; if (PROBE) p.out = (float*)(p_in.ws + WS_QP);
    const int tid_ = tid_opaque(), lane = tid_ & 63;
    const unsigned loff = 16u * (unsigned)lane;
    unsigned* ctr = (unsigned*)(p.ws + WS_CTR + (VPHASE ? 2048 : 0) + PROBE * 4096);
    const int x0 = (int)(xb_xcc_id() & 7u);
    for (int k = 0; k < 8; ++k) {
        const int y = (x0 + k) & 7;
        int tk = claim(ctr + y * 64, lane);
        if (tk >= NTICKET) continue;
        VMeta vm, vmn;
        v_meta(p, tk * TOK_PER_TICKET, y, lane, vm);
        while (tk < NTICKET) {
            const int tkn = claim(ctr + y * 64, lane);
#pragma unroll 1
            for (int i = 0; i < TOK_PER_TICKET; ++i) {
                const int tok = tk * TOK_PER_TICKET + i;
                const int tok_next = (i + 1 < TOK_PER_TICKET) ? tok + 1 : ((tkn < NTICKET) ? tkn * TOK_PER_TICKET : -1);
                if (VPHASE) { v_task(p, tok, y, lane, vm, tok_next, vmn); vm = vmn; }
                else { ucol_task(p, tok, y, lane, vm, tok_next, vmn); vm = vmn; }
            }
            tk = tkn;
        }
    }
}
__device__ __forceinline__ void phase_final_norm(const Params& p) {
    const int tid_ = tid_opaque(), lane = tid_ & 63;
    const int gw = (int)blockIdx.x * (NTHREADS / 64) + __builtin_amdgcn_readfirstlane(tid_ >> 6), ngw = (int)gridDim.x * (NTHREADS / 64);
    const unsigned loff = 16u * (unsigned)lane;
    f32x4 g[4];
#pragma unroll
    for (int q = 0; q < 4; ++q) g[q] = *(const f32x4*)(p.lnf_g + loff + 4 * q);
    for (int tok = gw; tok < NTOK; tok += ngw) {
        float* orow = (float*)((unsigned char*)p.out + (size_t)tok * D * 4) + loff;
        f32x4 y[4]; float ss = 0.f;
#pragma unroll
        for (int q = 0; q < 4; ++q) { y[q] = *(const f32x4*)(orow + 4 * q); ss += (y[q].x * y[q].x + y[q].y * y[q].y) + (y[q].z * y[q].z + y[q].w * y[q].w); }
        const float rstd = 1.0f / sqrtf(wave_sum(ss) * (1.0f / D) + EPS);
#pragma unroll
        for (int q = 0; q < 4; ++q) *(f32x4*)(orow + 4 * q) = (f32x4){y[q].x * rstd * g[q].x, y[q].y * rstd * g[q].y, y[q].z * rstd * g[q].z, y[q].w * rstd * g[q].w};
    }
}
}

constexpr int LDS_BYTES = 147456;
extern __shared__ __attribute__((aligned(16))) unsigned char dyn_lds[];

__device__ __forceinline__ Params load_params() {
#if !defined(__HIP_DEVICE_COMPILE__)
    return Params{};
#else
    const __attribute__((address_space(4))) unsigned char* ka = (const __attribute__((address_space(4))) unsigned char*)__builtin_amdgcn_kernarg_segment_ptr();
    asm volatile("" : "+s"(ka));
    const __attribute__((address_space(4))) Params* kp = (const __attribute__((address_space(4))) Params*)ka;
    Params r;
    r.x = kp->x; r.ln1_g = kp->ln1_g; r.w_in = kp->w_in; r.pe_k = kp->pe_k; r.w1_k = kp->w1_k; r.w2_k = kp->w2_k; r.pe_v = kp->pe_v; r.w1_v = kp->w1_v; r.w2_v = kp->w2_v;
    r.sinks = kp->sinks; r.w_out = kp->w_out; r.ln2_g = kp->ln2_g; r.wq = kp->wq; r.pkeys = kp->pkeys; r.pu = kp->pu; r.pv = kp->pv; r.lnf_g = kp->lnf_g; r.out = kp->out; r.ws = kp->ws;
    return r;
#endif
}
__global__ void __launch_bounds__(NTHREADS, 2) fwd_megakernel(Params p_unused) {
    cg::grid_group grid = cg::this_grid();
    float* lds = (float*)dyn_lds;
    PG8_LAS unsigned char* ldsp = (PG8_LAS unsigned char*)dyn_lds;
    volatile XLAS unsigned* bst = (volatile XLAS unsigned*)((XLAS unsigned char*)dyn_lds + (LDS_BYTES - 16));
    if (threadIdx.x < 4) bst[threadIdx.x] = 0u;
    __syncthreads();
    { const Params p = load_params(); (void)xcd_barrier_post((unsigned*)(p.ws + WS_BAR), bst); }
#define GRID_BARRIER() do { const Params p_ = load_params(); XcdBarrier xb_; xb_.bar = (unsigned*)(p_.ws + WS_BAR); xb_.x = xb_xcc_id(); \
        xb_.st = (volatile XLAS unsigned*)((XLAS unsigned char*)dyn_lds + (LDS_BYTES - 16)); xcd_barrier(xb_); } while (0)
    for (int rep = 0; rep < 1 + PROBE_PREP; ++rep) { const Params p = load_params(); phase_prep(p); }
    if (gridDim.y == 0x7fffu) grid.sync();
    GRID_BARRIER();
    for (int rep = 0; rep < 1 + PROBE_PROJ; ++rep) { const Params p = load_params();
      pg8::Gemm g{(const bf16_t*)(p.ws + WS_XN), (const bf16_t*)(p.ws + WS_WIN), NTOK, DINP, D}; pg8::StaticOrder S; S.init(NTOK, DINP, (int)gridDim.x, (int)blockIdx.x);
      EpiProjT E{p.ws}; pg8::gemm_phase<EpiProjT, pg8::StaticOrder, true, true>(ldsp, g, S, E); }
    GRID_BARRIER();
    for (int rep = 0; rep < 1 + PROBE_CS; ++rep) { const Params p = load_params(); cmp::phase_compress_swa(p, dyn_lds); }
    GRID_BARRIER();
    for (int rep = 0; rep < 1 + PROBE_NSA; ++rep) { const Params p = load_params(); att::phase_nsa_mfma(p, dyn_lds); }
    GRID_BARRIER();
    { const Params p = load_params();
      pg8::Gemm g{(const bf16_t*)(p.ws + WS_O), (const bf16_t*)(p.ws + WS_WOUT), NTOK, D, D}; pg8::StaticOrder S; S.init(NTOK, D, (int)gridDim.x, (int)blockIdx.x);
      EpiOutT E{p.x, p.ln2_g, p.out, (bf16_t*)(p.ws + WS_H1G), (float*)(p.ws + WS_SS2)}; pg8::gemm_phase<EpiOutT, pg8::StaticOrder, true, true>(ldsp, g, S, E); }
    GRID_BARRIER();
    for (int rep = 0; rep < 1 + PROBE_QP; ++rep) { const Params p = load_params();
      pg8::Gemm g{(const bf16_t*)(p.ws + WS_H1G), (const bf16_t*)(p.ws + WS_WQ), NTOK, PQ, D}; pg8::StaticOrder S; S.init(NTOK, PQ, (int)gridDim.x, (int)blockIdx.x);
      EpiQPT E{(const float*)(p.ws + WS_SS2), (bf16_t*)(p.ws + WS_QP)}; pg8::gemm_phase<EpiQPT, pg8::StaticOrder, true, true>(ldsp, g, S, E); }
    GRID_BARRIER();
    for (int rep = 0; rep < 1 + PROBE_SEL; ++rep) { const Params p = load_params(); psel::phase_peer_select(p, dyn_lds); }
    GRID_BARRIER();
    { const Params p = load_params(); pex::phase_sliced<false>(p); }
    GRID_BARRIER();
    for (int rep = 0; rep < 1 + PROBE_ACT; ++rep) { const Params p = load_params(); pex::phase_expert_act(p); }
    GRID_BARRIER();
    { const Params p = load_params(); pex::phase_sliced<true>(p); }
    GRID_BARRIER();
    { const Params p = load_params(); pex::phase_final_norm(p); }
}

extern "C" void kernel_launch(void* const* d_in, const int* in_sizes, int n_in, void* d_out, int out_size, void* d_ws, size_t ws_size, hipStream_t stream) {
    if (n_in != 17 || ws_size < WS_END) { fprintf(stderr, "kernel_launch: unexpected inputs (n_in %d, ws %zu)\n", n_in, ws_size); return; }
    static int grid_blocks = 0;
    if (!grid_blocks) {
        int dev = 0, cus = 0, per_cu = 0;
        (void)hipGetDevice(&dev);
        (void)hipDeviceGetAttribute(&cus, hipDeviceAttributeMultiprocessorCount, dev);
        (void)hipFuncSetAttribute((const void*)fwd_megakernel, hipFuncAttributeMaxDynamicSharedMemorySize, LDS_BYTES);
        (void)hipOccupancyMaxActiveBlocksPerMultiprocessor(&per_cu, (const void*)fwd_megakernel, NTHREADS, LDS_BYTES);
        if (per_cu < 1) per_cu = 1;
        grid_blocks = cus * per_cu;
        fprintf(stderr, "kernel_launch: %d CUs x %d blocks/CU\n", cus, per_cu);
    }
    Params p{};
    p.x = (const float*)d_in[0]; p.ln1_g = (const float*)d_in[1]; p.w_in = (const float*)d_in[2];
    p.pe_k = (const float*)d_in[3]; p.w1_k = (const float*)d_in[4]; p.w2_k = (const float*)d_in[5];
    p.pe_v = (const float*)d_in[6]; p.w1_v = (const float*)d_in[7]; p.w2_v = (const float*)d_in[8];
    p.sinks = (const float*)d_in[9]; p.w_out = (const float*)d_in[10]; p.ln2_g = (const float*)d_in[11];
    p.wq = (const float*)d_in[12]; p.pkeys = (const float*)d_in[13]; p.pu = (const float*)d_in[14]; p.pv = (const float*)d_in[15];
    p.lnf_g = (const float*)d_in[16];
    p.out = (float*)d_out; p.ws = (unsigned char*)d_ws;
    (void)hipMemsetAsync((unsigned char*)d_ws + WS_BAR, 0, 16 * 1024 + 8192, stream);
    void* args[] = {&p};
    hipError_t e = hipLaunchCooperativeKernel((void*)fwd_megakernel, dim3(grid_blocks), dim3(NTHREADS), args, LDS_BYTES, stream);
    if (e != hipSuccess) fprintf(stderr, "cooperative launch failed: %s (grid %d)\n", hipGetErrorString(e), grid_blocks);
}
```

```cpp
#include <hip/hip_runtime.h>
#include <hip/hip_cooperative_groups.h>
#include <cstdint>
#include <cstdio>
namespace cg = cooperative_groups;
#define PROBE_PREP 0
#define PROBE_COMPRESS 0
#define PROBE_SWA 0
#define PROBE_NSA 0
#define PROBE_SUB 0
#define PROBE_COMB 0
#define PROBE_PEXU 0
#define PROBE_PEXV 0
#define PROBE_PROJ 0
#define PROBE_QP 0
#define PROBE_SEL 0
#define PROBE_CS 0
#define PROBE_ACT 0

typedef unsigned short bf16_t;
typedef short bf16x8 __attribute__((ext_vector_type(8)));
typedef float f32x4 __attribute__((ext_vector_type(4)));
typedef unsigned u32x4 __attribute__((ext_vector_type(4)));
typedef unsigned u32x2 __attribute__((ext_vector_type(2)));

constexpr int BATCH = 2, T = 8192, D = 1024, NTOK = BATCH * T;
constexpr int HD = 64, NSA_H = 8, NSA_G = 2, NSA_HG = 4, SWA_H = 8;
constexpr int DIN = 1944, DINP = 2048;
constexpr int NCMP = 511, NCMPP = 512, NSEL = 128, TOPN = 16;
constexpr int NSA_WIN = 512, SWA_WIN = 128;
constexpr int PH = 8, PNK = 128, PDK = 256, PTOPK = 16, PQ = PH * PDK;
constexpr int NEXP = PNK * PNK;
constexpr float EPS = 1e-6f;
constexpr int NTHREADS = 512;

constexpr size_t MiB = 1u << 20;
constexpr size_t WS_SS2 = 0;
constexpr size_t WS_BAR = 128 * 1024;
constexpr size_t WS_WIN = 1 * MiB;
constexpr size_t WS_WOUT = 5 * MiB;
constexpr size_t WS_WQ = 7 * MiB;
constexpr size_t WS_PKEYS = 11 * MiB;
constexpr size_t WS_W1T = 12 * MiB;
constexpr size_t WS_W2T = 14 * MiB;
constexpr size_t WS_B1 = 14 * MiB + 512 * 1024;
constexpr size_t WS_XN = 16 * MiB;
constexpr size_t WS_O = WS_XN;
constexpr size_t WS_QN = 48 * MiB;
constexpr size_t WS_QS = 64 * MiB;
constexpr size_t WS_KV6 = 80 * MiB;
constexpr size_t KV6_STRIDE = 4 * MiB;
constexpr size_t WS_KSW = 104 * MiB;
constexpr size_t WS_VSW = 106 * MiB;
constexpr size_t WS_GSIG = 108 * MiB;
constexpr size_t WS_KC = 110 * MiB;
constexpr size_t WS_VC = 110 * MiB + 512 * 1024;
constexpr size_t WS_H1G = 48 * MiB;
constexpr size_t WS_QP = 80 * MiB;
constexpr size_t WS_EIDX = 144 * MiB;
constexpr size_t WS_GATE = 152 * MiB;
constexpr size_t WS_U8 = 160 * MiB;
constexpr size_t WS_PART = 80 * MiB;
constexpr size_t WS_V8 = 176 * MiB;
constexpr size_t WS_PW = 224 * MiB;
constexpr size_t WS_CTR = 128 * 1024 + 16 * 1024;
constexpr size_t WS_TOPV2 = 224 * MiB;
constexpr size_t WS_TOPI2 = 240 * MiB;
constexpr size_t WS_END = 256 * MiB;

struct Params {
    const float* x; const float* ln1_g; const float* w_in;
    const float* pe_k; const float* w1_k; const float* w2_k;
    const float* pe_v; const float* w1_v; const float* w2_v;
    const float* sinks; const float* w_out; const float* ln2_g;
    const float* wq; const float* pkeys; const float* pu; const float* pv; const float* lnf_g;
    float* out; unsigned char* ws;
};

__device__ __forceinline__ int tid_opaque() { int t = (int)threadIdx.x; asm volatile("" : "+v"(t)); return t; }
__device__ __forceinline__ unsigned f2bf(float f) { unsigned u = __float_as_uint(f); return (u + 0x7fffu + ((u >> 16) & 1u)) >> 16; }
__device__ __forceinline__ float bf2f(unsigned h) { return __uint_as_float(h << 16); }
__device__ __forceinline__ float bflo(unsigned w) { return __uint_as_float(w << 16); }
__device__ __forceinline__ float bfhi(unsigned w) { return __uint_as_float(w & 0xffff0000u); }
__device__ __forceinline__ unsigned pk2(float lo, float hi) { return f2bf(lo) | (f2bf(hi) << 16); }
__device__ __forceinline__ float wave_sum(float v) {
#pragma unroll
    for (int o = 1; o < 64; o <<= 1) v += __shfl_xor(v, o);
    return v;
}
__device__ __forceinline__ float gelu_tanh(float x) {
    const float u = 0.7978845608028654f * (x + 0.044715f * x * x * x);
    return 0.5f * x * (1.0f + tanhf(u));
}
__device__ __forceinline__ int win_orig_col(int n) {
    if (n < 1280) return n;
    if (n < 1792) return 1304 + (n - 1280);
    if (n < 1856) return 1816 + (n - 1792);
    if (n < 1920) return 1880 + (n - 1856);
    if (n < 1944) return 1280 + (n - 1920);
    return -1;
}

template <bool WIN_MAP>
__device__ __forceinline__ void prep_transpose(const float* W, int K, int N, int NP, bf16_t* WT, long gt, long ngt) {
    const long items = (long)NP * (K / 8);
    for (long it = gt; it < items; it += ngt) {
        const int n = (int)(it % NP), k0 = (int)(it / NP) * 8;
        const int col = WIN_MAP ? win_orig_col(n) : n;
        float v[8];
#pragma unroll
        for (int i = 0; i < 8; ++i) v[i] = (col >= 0) ? W[(size_t)(k0 + i) * N + col] : 0.f;
        u32x4 o; o.x = pk2(v[0], v[1]); o.y = pk2(v[2], v[3]); o.z = pk2(v[4], v[5]); o.w = pk2(v[6], v[7]);
        *(u32x4*)(WT + (size_t)n * K + k0) = o;
    }
}
__device__ __forceinline__ void prep_convert(const float* src, bf16_t* dst, long n8, long gt, long ngt) {
    for (long it = gt; it < n8; it += ngt) {
        const f32x4 a = *(const f32x4*)(src + it * 8), b = *(const f32x4*)(src + it * 8 + 4);
        u32x4 o; o.x = pk2(a.x, a.y); o.y = pk2(a.z, a.w); o.z = pk2(b.x, b.y); o.w = pk2(b.z, b.w);
        *(u32x4*)(dst + it * 8) = o;
    }
}
constexpr float U8_SCALE = 256.0f, V8_SCALE = 16.0f;
__device__ __forceinline__ void prep_convert_fp8(const float* src, unsigned char* dst, long n16, float sc, long gt, long ngt) {
    for (long it = gt; it < n16; it += ngt) {
        u32x4 o;
#pragma unroll
        for (int q = 0; q < 4; ++q) {
            const f32x4 a = *(const f32x4*)(src + it * 16 + q * 4);
            int w = 0;
            w = __builtin_amdgcn_cvt_pk_fp8_f32(a.x * sc, a.y * sc, w, false);
            w = __builtin_amdgcn_cvt_pk_fp8_f32(a.z * sc, a.w * sc, w, true);
            o[q] = (unsigned)w;
        }
        *(u32x4*)(dst + it * 16) = o;
    }
}
__device__ __forceinline__ void prep_convert_fp8_sliced(const float* src, unsigned char* dst, long n16, float sc, long gt, long ngt) {
    for (long it = gt; it < n16; it += ngt) {
        u32x4 o;
#pragma unroll
        for (int q = 0; q < 4; ++q) {
            const f32x4 a = *(const f32x4*)(src + it * 16 + q * 4);
            int w = 0;
            w = __builtin_amdgcn_cvt_pk_fp8_f32(a.x * sc, a.y * sc, w, false);
            w = __builtin_amdgcn_cvt_pk_fp8_f32(a.z * sc, a.w * sc, w, true);
            o[q] = (unsigned)w;
        }
        const long e = (it * 16) >> 10; const int col = (int)((it * 16) & 1023);
        *(u32x4*)(dst + (size_t)(col >> 7) * ((size_t)NEXP * 128) + e * 128 + (col & 127)) = o;
    }
}
__device__ __forceinline__ void convert_expert_tables(const Params& p, int bi, int nblk) {
    const long gt = (long)bi * NTHREADS + tid_opaque(), ngt = (long)nblk * NTHREADS;
    prep_convert_fp8_sliced(p.pu, p.ws + WS_U8, (long)NEXP * D / 16, U8_SCALE, gt, ngt);
    prep_convert_fp8_sliced(p.pv, p.ws + WS_V8, (long)NEXP * D / 16, V8_SCALE, gt, ngt);
}
__device__ __forceinline__ void phase_prep(const Params& p) {
    const long gt = (long)blockIdx.x * NTHREADS + tid_opaque(), ngt = (long)gridDim.x * NTHREADS;
    const int lane = tid_opaque() & 63;
    const long gw = gt >> 6, ngw = ngt >> 6;
    unsigned char* ws = p.ws;
    for (long m = gw; m < NTOK; m += ngw) {
        const f32x4* xr = (const f32x4*)(p.x + (size_t)m * D) + lane;
        f32x4 v[4]; float s = 0.f;
#pragma unroll
        for (int j = 0; j < 4; ++j) { v[j] = xr[64 * j]; s += (v[j].x * v[j].x + v[j].y * v[j].y) + (v[j].z * v[j].z + v[j].w * v[j].w); }
        const float rstd = 1.0f / sqrtf(wave_sum(s) * (1.0f / D) + EPS);
        u32x2* o = (u32x2*)((bf16_t*)(ws + WS_XN) + (size_t)m * D) + lane;
#pragma unroll
        for (int j = 0; j < 4; ++j) {
            const f32x4 g = *((const f32x4*)p.ln1_g + lane + 64 * j);
            u32x2 w; w.x = pk2(v[j].x * rstd * g.x, v[j].y * rstd * g.y); w.y = pk2(v[j].z * rstd * g.z, v[j].w * rstd * g.w);
            o[64 * j] = w;
        }
    }
    prep_transpose<true>(p.w_in, D, DIN, DINP, (bf16_t*)(ws + WS_WIN), gt, ngt);
    prep_transpose<false>(p.w_out, D, D, D, (bf16_t*)(ws + WS_WOUT), gt, ngt);
    prep_transpose<false>(p.wq, D, PQ, PQ, (bf16_t*)(ws + WS_WQ), gt, ngt);
    prep_convert(p.pkeys, (bf16_t*)(ws + WS_PKEYS), (long)16 * 128 * 128 / 8, gt, ngt);
    prep_transpose<false>(p.w1_k, 2048, 256, 256, (bf16_t*)(ws + WS_W1T), gt, ngt);
    prep_transpose<false>(p.w1_v, 2048, 256, 256, (bf16_t*)(ws + WS_W1T) + 256 * 2048, gt, ngt);
    prep_transpose<false>(p.w2_k, 256, 64, 64, (bf16_t*)(ws + WS_W2T), gt, ngt);
    prep_transpose<false>(p.w2_v, 256, 64, 64, (bf16_t*)(ws + WS_W2T) + 64 * 256, gt, ngt);
    for (long o = gw; o < 512; o += ngw) {
        const int kv = (int)(o >> 8), n = (int)(o & 255);
        const float* pe = kv ? p.pe_v : p.pe_k; const float* w1 = kv ? p.w1_v : p.w1_k;
        float s = 0.f;
        for (int k = lane; k < 2048; k += 64) s += pe[k] * w1[(size_t)k * 256 + n];
        s = wave_sum(s);
        if (lane == 0) ((float*)(ws + WS_B1))[o] = s;
    }
    for (long i = gt; i < NTOK; i += ngt) ((float*)(ws + WS_SS2))[i] = 0.f;
}

template <class Epi>
__device__ __forceinline__ void gemm_simple(const bf16_t* A, const bf16_t* Bt, int M, int N, int K, const Epi& E) {
    const int lane = tid_opaque() & 63;
    const long gw = ((long)blockIdx.x * NTHREADS + tid_opaque()) >> 6, ngw = ((long)gridDim.x * NTHREADS) >> 6;
    const int ntn = N / 64; const long ntiles = (long)(M / 32) * ntn;
    const int fr = lane & 15, fq = lane >> 4;
    for (long tile = gw; tile < ntiles; tile += ngw) {
        const int m0 = (int)(tile / ntn) * 32, n0 = (int)(tile % ntn) * 64;
        f32x4 acc[2][4];
#pragma unroll
        for (int i = 0; i < 2; ++i)
#pragma unroll
            for (int j = 0; j < 4; ++j) acc[i][j] = (f32x4){0.f, 0.f, 0.f, 0.f};
        const bf16_t* ap = A + (size_t)(m0 + fr) * K + fq * 8;
        const bf16_t* bp = Bt + (size_t)(n0 + fr) * K + fq * 8;
        for (int k0 = 0; k0 < K; k0 += 32) {
            bf16x8 a[2], b[4];
#pragma unroll
            for (int i = 0; i < 2; ++i) a[i] = *(const bf16x8*)(ap + (size_t)i * 16 * K + k0);
#pragma unroll
            for (int j = 0; j < 4; ++j) b[j] = *(const bf16x8*)(bp + (size_t)j * 16 * K + k0);
#pragma unroll
            for (int i = 0; i < 2; ++i)
#pragma unroll
                for (int j = 0; j < 4; ++j) acc[i][j] = __builtin_amdgcn_mfma_f32_16x16x32_bf16(a[i], b[j], acc[i][j], 0, 0, 0);
        }
        E(acc, m0, n0, fr, fq);
    }
}

struct EpiProj {
    unsigned char* ws;
    __device__ __forceinline__ void operator()(const f32x4 (&acc)[2][4], int m0, int n0, int fr, int fq) const {
#pragma unroll
        for (int i = 0; i < 2; ++i)
#pragma unroll
            for (int j = 0; j < 4; ++j)
#pragma unroll
                for (int r = 0; r < 4; ++r) {
                    const int row = m0 + 16 * i + fq * 4 + r, n = n0 + 16 * j + fr;
                    const float v = acc[i][j][r];
                    const int b = row / T, t = row % T, d = n & 63;
                    if (n < 512) {
                        const int head = n >> 6;
                        ((bf16_t*)(ws + WS_QN))[((size_t)(b * 8 + head) * T + t) * 64 + d] = (bf16_t)f2bf(v * 0.125f);
                    } else if (n < 1280) {
                        const int arr = (n - 512) >> 7, g = ((n - 512) >> 6) & 1;
                        ((bf16_t*)(ws + WS_KV6 + arr * KV6_STRIDE))[((size_t)(b * 2 + g) * T + t) * 64 + d] = (bf16_t)f2bf(v);
                    } else if (n < 1792) {
                        const int head = (n - 1280) >> 6;
                        ((bf16_t*)(ws + WS_QS))[((size_t)(b * 8 + head) * T + t) * 64 + d] = (bf16_t)f2bf(v * 0.125f);
                    } else if (n < 1856) {
                        ((bf16_t*)(ws + WS_KSW))[((size_t)b * T + t) * 64 + d] = (bf16_t)f2bf(v);
                    } else if (n < 1920) {
                        ((bf16_t*)(ws + WS_VSW))[((size_t)b * T + t) * 64 + d] = (bf16_t)f2bf(v);
                    } else if (n < 1944) {
                        ((float*)(ws + WS_GSIG))[(size_t)row * 24 + (n - 1920)] = 1.0f / (1.0f + expf(-v));
                    }
                }
    }
};
struct EpiOut {
    const float* x; const float* g2; float* h1; bf16_t* h1g; float* ss2;
    __device__ __forceinline__ void operator()(const f32x4 (&acc)[2][4], int m0, int n0, int fr, int fq) const {
#pragma unroll
        for (int i = 0; i < 2; ++i)
#pragma unroll
            for (int r = 0; r < 4; ++r) {
                const int row = m0 + 16 * i + fq * 4 + r; float ss = 0.f;
#pragma unroll
                for (int j = 0; j < 4; ++j) {
                    const int n = n0 + 16 * j + fr; const size_t off = (size_t)row * D + n;
                    const float h = x[off] + acc[i][j][r];
                    h1[off] = h; h1g[off] = (bf16_t)f2bf(h * g2[n]); ss += h * h;
                }
                ss += __shfl_xor(ss, 1); ss += __shfl_xor(ss, 2); ss += __shfl_xor(ss, 4); ss += __shfl_xor(ss, 8);
                if (fr == 0) atomicAdd(ss2 + row, ss);
            }
    }
};
struct EpiQP {
    const float* ss2; bf16_t* qp;
    __device__ __forceinline__ void operator()(const f32x4 (&acc)[2][4], int m0, int n0, int fr, int fq) const {
#pragma unroll
        for (int i = 0; i < 2; ++i)
#pragma unroll
            for (int r = 0; r < 4; ++r) {
                const int row = m0 + 16 * i + fq * 4 + r;
                const float rstd = 1.0f / sqrtf(ss2[row] * (1.0f / D) + EPS);
#pragma unroll
                for (int j = 0; j < 4; ++j) qp[(size_t)row * PQ + n0 + 16 * j + fr] = (bf16_t)f2bf(acc[i][j][r] * rstd);
            }
    }
};

namespace pg8 {
#define PG8_LAS __attribute__((address_space(3)))
typedef unsigned short bf16_t;
typedef short bf16x8 __attribute__((ext_vector_type(8)));
typedef float f32x4 __attribute__((ext_vector_type(4)));
typedef unsigned u32x4 __attribute__((ext_vector_type(4)));
constexpr int BM = 256, BK = 64, HALF = 128, HTB = HALF * BK * 2  , STAGE_BYTES = 8 * HTB, NXCD = 8, WGM = 8;

__host__ __device__ __forceinline__ int lds_byte(int r, int c) { const int st = (r >> 4) * 2 + (c >> 5), rr = r & 15, cc = c & 31, ob = rr * 64 + cc * 2; return st * 1024 + (ob ^ (((ob >> 9) & 1) << 5)); }
__host__ __device__ __forceinline__ void stage_rc(int b, int& R, int& C) { const int st = b / 1024, sb = b % 1024, swz = sb ^ (((sb >> 9) & 1) << 5); R = (st >> 1) * 16 + swz / 64; C = (st & 1) * 32 + (swz % 64) / 2; }
__host__ __device__ __forceinline__ int perm32(int rho) { const int n = rho >> 4, i = rho & 15; return 8 * (i >> 2) + 4 * n + (i & 3); }

struct Unit { int pm, pn; };
struct Gemm { const bf16_t* A; const bf16_t* Bt; int M, N, K; };

struct StaticOrder {
    int nM, nN, nwg, G, c;
    __host__ __device__ void init(int M, int N, int G_, int c_) { nM = M / BM; nN = N / BM; nwg = nM * nN; G = G_; c = c_; }
    __host__ __device__ bool next(int i, Unit& u) const {
        const long L = (long)i * G + c; if (L >= nwg) return false;
        int wgid = (int)L; { const int q = nwg / NXCD, r = nwg % NXCD, xcd = wgid % NXCD, off = wgid / NXCD; wgid = (xcd < r ? xcd * (q + 1) : r * (q + 1) + (xcd - r) * q) + off; }
        const int nig = WGM * nN, gid = wgid / nig, fm = gid * WGM, gsz = (nM - fm) < WGM ? (nM - fm) : WGM;
        u.pm = fm + ((wgid % nig) % gsz); u.pn = (wgid % nig) / gsz; return true;
    }
    __device__ __forceinline__ void a_ready(const Unit&) const {}
    __device__ __forceinline__ void done(const Unit&) const {}
};

__device__ __forceinline__ unsigned cvt_pk_bf16(float lo, float hi) { unsigned r; asm volatile("v_cvt_pk_bf16_f32 %0, %1, %2" : "=v"(r) : "v"(lo), "v"(hi)); return r; }
template <class Epi, class Sched, bool ALIGN_EPI = false, bool SP2 = false>
__device__ __forceinline__ void gemm_phase(PG8_LAS unsigned char* lds, const Gemm g, const Sched& S, const Epi& E) {
    const int tid = tid_opaque(), wid = __builtin_amdgcn_readfirstlane(tid >> 6), lane = tid & 63, wr = wid >> 2, wc = wid & 3, fr = lane & 15, fq = lane >> 4;
    const int K = g.K, nt = K / BK;
    unsigned voffA[2], voffB[2];
#pragma unroll
    for (int i = 0; i < 2; ++i) { int R, C; stage_rc(tid * 16 + i * 8192, R, C); const int Rb = Epi::PERM ? ((R & ~31) + perm32(R & 31)) : R;
        voffA[i] = (unsigned)(R * K + C) * 2u; voffB[i] = (unsigned)(Rb * K + C) * 2u; }
    const size_t kstep = (size_t)(BK * 2);
    const size_t hstep = (size_t)HALF * K * 2;
    const size_t tstep = 2 * hstep;
    const unsigned ldsw = (unsigned)wid * 1024u;
    const int aoff = lds_byte(wr * 64 + fr, fq * 8), boff = lds_byte(wc * 32 + fr, fq * 8);
#define PG8_SA(b, h) (((b) * 2 + (h)) * HTB)
#define PG8_SB(b, h) ((4 + (b) * 2 + (h)) * HTB)
#define PG8_STAGE(bufoff, gbase, voff) do { _Pragma("unroll") for (int _i = 0; _i < 2; ++_i) \
        __builtin_amdgcn_global_load_lds((const unsigned*)((const char*)(gbase) + (voff)[_i]), (PG8_LAS unsigned*)(lds + (bufoff) + ldsw + _i * 8192), 16, 0, 0); } while (0)
#define PG8_LDA(dst, b, h) do { _Pragma("unroll") for (int m = 0; m < 4; ++m) _Pragma("unroll") for (int k = 0; k < 2; ++k) dst[m][k] = *(const PG8_LAS bf16x8*)(lds + PG8_SA(b, h) + aoff + m * 2048 + k * 1024); } while (0)
#define PG8_LDB(dst, b, h) do { _Pragma("unroll") for (int n = 0; n < 2; ++n) _Pragma("unroll") for (int k = 0; k < 2; ++k) dst[n][k] = *(const PG8_LAS bf16x8*)(lds + PG8_SB(b, h) + boff + n * 2048 + k * 1024); } while (0)
#define PG8_MMA(ai, bj, At, Bt) do { __builtin_amdgcn_s_setprio(1); _Pragma("unroll") for (int m = 0; m < 4; ++m) _Pragma("unroll") for (int n = 0; n < 2; ++n) _Pragma("unroll") for (int k = 0; k < 2; ++k) \
        acc[ai][bj][m][n] = __builtin_amdgcn_mfma_f32_16x16x32_bf16(Bt[n][k], At[m][k], acc[ai][bj][m][n], 0, 0, 0); __builtin_amdgcn_s_setprio(0); } while (0)
#define PG8_WAIT_V(n) asm volatile("s_waitcnt vmcnt(" #n ")" ::: "memory")
#define PG8_WAIT_L(n) asm volatile("s_waitcnt lgkmcnt(" #n ")" ::: "memory")
#define PG8_BAR __builtin_amdgcn_s_barrier()
#define PG8_SCHED __builtin_amdgcn_sched_barrier(0)
    Unit cur, nxt; int ui = 0;
    if (!S.next(0, cur)) return;
    f32x4 acc[2][2][4][2];
#pragma unroll
    for (int a = 0; a < 2; ++a)
#pragma unroll
        for (int b = 0; b < 2; ++b)
#pragma unroll
            for (int m = 0; m < 4; ++m)
#pragma unroll
                for (int n = 0; n < 2; ++n) acc[a][b][m][n] = (f32x4){0.f, 0.f, 0.f, 0.f};
    bf16x8 At[4][2], B0[2][2], B1[2][2];
    const char* cA = (const char*)g.A + (size_t)cur.pm * tstep; const char* cB = (const char*)g.Bt + (size_t)cur.pn * tstep;
    S.a_ready(cur);
    if constexpr (SP2) {
        PG8_STAGE(PG8_SB(0, 0), cB, voffB); PG8_STAGE(PG8_SB(0, 1), cB + hstep, voffB); PG8_STAGE(PG8_SA(0, 0), cA, voffA); PG8_STAGE(PG8_SA(0, 1), cA + hstep, voffA);
        if (wr == 1) PG8_BAR;
        PG8_WAIT_V(2); PG8_BAR;
        PG8_STAGE(PG8_SB(1, 0), cB + kstep, voffB); PG8_STAGE(PG8_SA(1, 0), cA + kstep, voffA); PG8_STAGE(PG8_SB(1, 1), cB + hstep + kstep, voffB);
        PG8_WAIT_V(6); PG8_BAR;
    } else {
        PG8_STAGE(PG8_SB(0, 0), cB, voffB); PG8_STAGE(PG8_SA(0, 0), cA, voffA); PG8_STAGE(PG8_SB(0, 1), cB + hstep, voffB); PG8_STAGE(PG8_SA(0, 1), cA + hstep, voffA);
        if (wr == 1) PG8_BAR;
        PG8_WAIT_V(4); PG8_BAR;
        PG8_STAGE(PG8_SB(1, 0), cB + kstep, voffB); PG8_STAGE(PG8_SA(1, 0), cA + kstep, voffA); PG8_STAGE(PG8_SB(1, 1), cB + hstep + kstep, voffB);
        PG8_WAIT_V(6); PG8_BAR;
    }
    for (;;) {
        const bool has_next = S.next(ui + 1, nxt);
        const char* nA = has_next ? (const char*)g.A + (size_t)nxt.pm * tstep : cA; const char* nB = has_next ? (const char*)g.Bt + (size_t)nxt.pn * tstep : cB;
        for (int t = 0; t < nt; t += 2) {
            const bool last = (t == nt - 2);
            const char* a1 = cA + (size_t)(t + 1) * kstep;
            const char* a2 = last ? nA : cA + (size_t)(t + 2) * kstep; const char* b2 = last ? nB : cB + (size_t)(t + 2) * kstep;
            const char* a3 = a2 + kstep; const char* b3 = b2 + kstep;
            if (last && has_next) S.a_ready(nxt);
            if constexpr (SP2) {
            PG8_LDB(B0, 0, 0); PG8_LDB(B1, 0, 1); PG8_SCHED; PG8_LDA(At, 0, 0); PG8_STAGE(PG8_SA(1, 1), a1 + hstep, voffA);
            PG8_WAIT_V(8); PG8_WAIT_L(0); PG8_BAR; PG8_MMA(0, 0, At, B0); PG8_MMA(0, 1, At, B1); PG8_BAR; PG8_SCHED;
            PG8_LDA(At, 0, 1); PG8_STAGE(PG8_SB(0, 0), b2, voffB); PG8_STAGE(PG8_SB(0, 1), b2 + hstep, voffB); PG8_STAGE(PG8_SA(0, 0), a2, voffA);
            PG8_WAIT_V(8); PG8_WAIT_L(0); PG8_BAR; PG8_MMA(1, 0, At, B0); PG8_MMA(1, 1, At, B1); PG8_BAR; PG8_SCHED;
            PG8_LDB(B0, 1, 0); PG8_LDB(B1, 1, 1); PG8_SCHED; PG8_LDA(At, 1, 0); PG8_STAGE(PG8_SA(0, 1), a2 + hstep, voffA);
            PG8_WAIT_V(8); PG8_WAIT_L(0); PG8_BAR; PG8_MMA(0, 0, At, B0); PG8_MMA(0, 1, At, B1); PG8_BAR; PG8_SCHED;
            PG8_LDA(At, 1, 1); PG8_STAGE(PG8_SB(1, 0), b3, voffB); PG8_STAGE(PG8_SB(1, 1), b3 + hstep, voffB); PG8_STAGE(PG8_SA(1, 0), a3, voffA);
            PG8_WAIT_V(8); PG8_WAIT_L(0); PG8_BAR; PG8_MMA(1, 0, At, B0); PG8_MMA(1, 1, At, B1); PG8_BAR; PG8_SCHED;
            } else {
            PG8_LDB(B0, 0, 0); PG8_SCHED; PG8_LDA(At, 0, 0); PG8_STAGE(PG8_SA(1, 1), a1 + hstep, voffA);
            PG8_WAIT_L(8); PG8_BAR; PG8_WAIT_L(0); PG8_MMA(0, 0, At, B0); PG8_BAR; PG8_SCHED;
            PG8_LDB(B1, 0, 1); PG8_STAGE(PG8_SB(0, 0), b2, voffB);
            PG8_BAR; PG8_WAIT_L(0); PG8_MMA(0, 1, At, B1); PG8_BAR;
            PG8_LDA(At, 0, 1); PG8_STAGE(PG8_SA(0, 0), a2, voffA);
            PG8_BAR; PG8_WAIT_L(0); PG8_MMA(1, 0, At, B0); PG8_BAR; PG8_SCHED;
            PG8_STAGE(PG8_SB(0, 1), b2 + hstep, voffB);
            PG8_WAIT_V(6); PG8_BAR; PG8_MMA(1, 1, At, B1); PG8_BAR;
            PG8_LDB(B0, 1, 0); PG8_SCHED; PG8_LDA(At, 1, 0); PG8_STAGE(PG8_SA(0, 1), a2 + hstep, voffA);
            PG8_WAIT_L(8); PG8_BAR; PG8_WAIT_L(0); PG8_MMA(0, 0, At, B0); PG8_BAR; PG8_SCHED;
            PG8_LDB(B1, 1, 1); PG8_STAGE(PG8_SB(1, 0), b3, voffB);
            PG8_BAR; PG8_WAIT_L(0); PG8_MMA(0, 1, At, B1); PG8_BAR;
            PG8_LDA(At, 1, 1); PG8_STAGE(PG8_SA(1, 0), a3, voffA);
            PG8_BAR; PG8_WAIT_L(0); PG8_MMA(1, 0, At, B0); PG8_BAR; PG8_SCHED;
            PG8_STAGE(PG8_SB(1, 1), b3 + hstep, voffB);
            PG8_WAIT_V(6); PG8_BAR; PG8_MMA(1, 1, At, B1); PG8_BAR;
            }
        }
        if constexpr (ALIGN_EPI) { if (wr == 0) PG8_BAR; }
        if constexpr (!Epi::AFTER_DRAIN) { E(acc, cur, wr, wc, fr, fq); S.done(cur); }
        if (!has_next) break;
#pragma unroll
        for (int a = 0; a < 2; ++a)
#pragma unroll
            for (int b = 0; b < 2; ++b)
#pragma unroll
                for (int m = 0; m < 4; ++m)
#pragma unroll
                    for (int n = 0; n < 2; ++n) acc[a][b][m][n] = (f32x4){0.f, 0.f, 0.f, 0.f};
        cur = nxt; cA = nA; cB = nB; ++ui;
        if constexpr (ALIGN_EPI) { if (wr == 1) PG8_BAR; }
    }
    PG8_WAIT_V(0);
    if constexpr (!ALIGN_EPI) { if (wr == 0) PG8_BAR; }
    PG8_BAR;
    if constexpr (Epi::AFTER_DRAIN) { E.fused(acc, cur, wr, wc, fr, fq, lds, wid, lane); S.done(cur); }
#undef PG8_SA
#undef PG8_SB
#undef PG8_STAGE
#undef PG8_LDA
#undef PG8_LDB
#undef PG8_MMA
#undef PG8_WAIT_V
#undef PG8_WAIT_L
#undef PG8_BAR
#undef PG8_SCHED
}
}

struct EpiProjT {
    static constexpr bool PERM = true, AFTER_DRAIN = false;
    unsigned char* ws;
    __device__ __forceinline__ void operator()(const f32x4 (&acc)[2][2][4][2], const pg8::Unit& u, int wr, int wc, int fr, int fq) const {
        const int row0 = u.pm * 256 + wr * 64 + fr;
#pragma unroll
        for (int bj = 0; bj < 2; ++bj) {
            const int n8 = u.pn * 256 + bj * 128 + wc * 32 + 8 * fq;
            if (n8 >= 1944) continue;
            if (n8 >= 1920) {
#pragma unroll
                for (int ai = 0; ai < 2; ++ai)
#pragma unroll
                    for (int m = 0; m < 4; ++m) {
                        const int row = row0 + ai * 128 + m * 16;
                        const f32x4 v0 = acc[ai][bj][m][0], v1 = acc[ai][bj][m][1];
                        float* dst = (float*)(ws + WS_GSIG) + (size_t)row * 24 + (n8 - 1920);
                        *(f32x4*)dst = (f32x4){1.0f / (1.0f + __expf(-v0[0])), 1.0f / (1.0f + __expf(-v0[1])), 1.0f / (1.0f + __expf(-v0[2])), 1.0f / (1.0f + __expf(-v0[3]))};
                        *(f32x4*)(dst + 4) = (f32x4){1.0f / (1.0f + __expf(-v1[0])), 1.0f / (1.0f + __expf(-v1[1])), 1.0f / (1.0f + __expf(-v1[2])), 1.0f / (1.0f + __expf(-v1[3]))};
                    }
                continue;
            }
            bf16_t* base; int nh, hidx; float sc = 1.0f;
            if (n8 < 512) { base = (bf16_t*)(ws + WS_QN); nh = 8; hidx = n8 >> 6; sc = 0.125f * 1.4426950408889634f; }
            else if (n8 < 1280) { const int arr = (n8 - 512) >> 7; base = (bf16_t*)(ws + WS_KV6 + (size_t)arr * KV6_STRIDE); nh = 2; hidx = ((n8 - 512) >> 6) & 1; }
            else if (n8 < 1792) { base = (bf16_t*)(ws + WS_QS); nh = 8; hidx = (n8 - 1280) >> 6; sc = 0.125f * 1.4426950408889634f; }
            else if (n8 < 1856) { base = (bf16_t*)(ws + WS_KSW); nh = 1; hidx = 0; }
            else { base = (bf16_t*)(ws + WS_VSW); nh = 1; hidx = 0; }
            const int d0 = n8 & 63;
#pragma unroll
            for (int ai = 0; ai < 2; ++ai)
#pragma unroll
                for (int m = 0; m < 4; ++m) {
                    const int row = row0 + ai * 128 + m * 16, b = row >> 13, t = row & (T - 1);
                    const f32x4 v0 = acc[ai][bj][m][0] * sc, v1 = acc[ai][bj][m][1] * sc;
                    u32x4 w; w.x = pg8::cvt_pk_bf16(v0[0], v0[1]); w.y = pg8::cvt_pk_bf16(v0[2], v0[3]); w.z = pg8::cvt_pk_bf16(v1[0], v1[1]); w.w = pg8::cvt_pk_bf16(v1[2], v1[3]);
                    *(u32x4*)(base + ((size_t)(b * nh + hidx) * T + t) * 64 + d0) = w;
                }
        }
    }
};
struct EpiOutT {
    static constexpr bool PERM = false, AFTER_DRAIN = false;
    const float* x; const float* g2; float* h1; bf16_t* h1g; float* ss2;
    __device__ __forceinline__ void operator()(const f32x4 (&acc)[2][2][4][2], const pg8::Unit& u, int wr, int wc, int fr, int fq) const {
        const int row0 = u.pm * 256 + wr * 64 + fr, col0 = u.pn * 256 + wc * 32 + 4 * fq;
#pragma unroll
        for (int ai = 0; ai < 2; ++ai)
#pragma unroll
            for (int m = 0; m < 4; ++m) {
                const int row = row0 + ai * 128 + m * 16; float ss = 0.f;
#pragma unroll
                for (int bj = 0; bj < 2; ++bj)
#pragma unroll
                    for (int n = 0; n < 2; ++n) {
                        const int c = col0 + bj * 128 + n * 16; const size_t off = (size_t)row * D + c;
                        const f32x4 h = *(const f32x4*)(x + off) + acc[ai][bj][m][n];
                        const f32x4 g = *(const f32x4*)(g2 + c);
                        *(f32x4*)(h1 + off) = h;
                        u32x2 w; w.x = pg8::cvt_pk_bf16(h[0] * g[0], h[1] * g[1]); w.y = pg8::cvt_pk_bf16(h[2] * g[2], h[3] * g[3]);
                        *(u32x2*)(h1g + off) = w;
                        ss += (h[0] * h[0] + h[1] * h[1]) + (h[2] * h[2] + h[3] * h[3]);
                    }
                ss += __shfl_xor(ss, 16); ss += __shfl_xor(ss, 32);
                if (fq == 0) atomicAdd(ss2 + row, ss);
            }
    }
};
struct EpiQPT {
    static constexpr bool PERM = true, AFTER_DRAIN = false;
    const float* ss2; bf16_t* qp;
    __device__ __forceinline__ void operator()(const f32x4 (&acc)[2][2][4][2], const pg8::Unit& u, int wr, int wc, int fr, int fq) const {
        const int row0 = u.pm * 256 + wr * 64 + fr;
#pragma unroll
        for (int ai = 0; ai < 2; ++ai)
#pragma unroll
            for (int m = 0; m < 4; ++m) {
                const int row = row0 + ai * 128 + m * 16;
                const float rstd = 1.0f / sqrtf(ss2[row] * (1.0f / D) + EPS);
#pragma unroll
                for (int bj = 0; bj < 2; ++bj) {
                    const int n8 = u.pn * 256 + bj * 128 + wc * 32 + 8 * fq;
                    const f32x4 v0 = acc[ai][bj][m][0] * rstd, v1 = acc[ai][bj][m][1] * rstd;
                    u32x4 w; w.x = pg8::cvt_pk_bf16(v0[0], v0[1]); w.y = pg8::cvt_pk_bf16(v0[2], v0[3]); w.z = pg8::cvt_pk_bf16(v1[0], v1[1]); w.w = pg8::cvt_pk_bf16(v1[2], v1[3]);
                    *(u32x4*)(qp + (size_t)row * PQ + n8) = w;
                }
            }
    }
};

__device__ __forceinline__ void phase_compress(const Params& p, float* lds) {
    float* flat = lds;
    float* part = lds + 2048;
    float* hid = lds + 2560;
    const int tid = tid_opaque();
    const int nunits = 2 * BATCH * NCMP * NSA_G;
    for (int u = blockIdx.x; u < nunits; u += gridDim.x) {
        const int kv = u / (BATCH * NCMP * NSA_G); int r = u % (BATCH * NCMP * NSA_G);
        const int b = r / (NCMP * NSA_G); r %= (NCMP * NSA_G);
        const int c = r / NSA_G, g = r % NSA_G;
        const bf16_t* raw = (const bf16_t*)(p.ws + WS_KV6 + (size_t)kv * KV6_STRIDE) + ((size_t)(b * 2 + g) * T + 16 * c) * 64;
        const float* pe = kv ? p.pe_v : p.pe_k; const float* w1 = kv ? p.w1_v : p.w1_k; const float* w2 = kv ? p.w2_v : p.w2_k;
        for (int i = tid; i < 2048; i += NTHREADS) flat[i] = bf2f(raw[i]) + pe[i];
        __syncthreads();
        {
            const int j = tid & 255, half = tid >> 8;
            float a = 0.f;
            const float* wp = w1 + (size_t)(half * 1024) * 256 + j; const float* fp = flat + half * 1024;
            for (int i = 0; i < 1024; ++i) a += fp[i] * wp[(size_t)i * 256];
            part[tid] = a;
        }
        __syncthreads();
        if (tid < 256) hid[tid] = gelu_tanh(part[tid] + part[tid + 256]);
        __syncthreads();
        if (tid < 64) {
            float a = 0.f;
            for (int j = 0; j < 256; ++j) a += hid[j] * w2[j * 64 + tid];
            bf16_t* dst = (bf16_t*)(p.ws + (kv ? WS_VC : WS_KC)) + ((size_t)(b * 2 + g) * NCMPP + c) * 64;
            dst[tid] = (bf16_t)f2bf(a);
        }
        __syncthreads();
    }
}

__device__ __forceinline__ void load_row64(const bf16_t* src, float (&k)[64]) {
#pragma unroll
    for (int c = 0; c < 8; ++c) {
        const u32x4 w = *(const u32x4*)(src + 8 * c);
        k[8 * c + 0] = bflo(w.x); k[8 * c + 1] = bfhi(w.x); k[8 * c + 2] = bflo(w.y); k[8 * c + 3] = bfhi(w.y);
        k[8 * c + 4] = bflo(w.z); k[8 * c + 5] = bfhi(w.z); k[8 * c + 6] = bflo(w.w); k[8 * c + 7] = bfhi(w.w);
    }
}
__device__ __forceinline__ float dot_row64(const bf16_t* src, const float (&q)[64]) {
    float s0 = 0.f, s1 = 0.f;
#pragma unroll
    for (int c = 0; c < 8; ++c) {
        const u32x4 w = *(const u32x4*)(src + 8 * c);
        s0 += q[8 * c + 0] * bflo(w.x); s1 += q[8 * c + 1] * bfhi(w.x); s0 += q[8 * c + 2] * bflo(w.y); s1 += q[8 * c + 3] * bfhi(w.y);
        s0 += q[8 * c + 4] * bflo(w.z); s1 += q[8 * c + 5] * bfhi(w.z); s0 += q[8 * c + 6] * bflo(w.w); s1 += q[8 * c + 7] * bfhi(w.w);
    }
    return s0 + s1;
}
__device__ __forceinline__ void osm_update(float s, const bf16_t* vsrc, float& m, float& l, float (&acc)[32]) {
    const float mn = fmaxf(m, s), alpha = __expf(m - mn), pr = __expf(s - mn);
    l = l * alpha + pr; m = mn;
#pragma unroll
    for (int c = 0; c < 4; ++c) {
        const u32x4 w = *(const u32x4*)(vsrc + 8 * c);
        acc[8 * c + 0] = acc[8 * c + 0] * alpha + pr * bflo(w.x); acc[8 * c + 1] = acc[8 * c + 1] * alpha + pr * bfhi(w.x);
        acc[8 * c + 2] = acc[8 * c + 2] * alpha + pr * bflo(w.y); acc[8 * c + 3] = acc[8 * c + 3] * alpha + pr * bfhi(w.y);
        acc[8 * c + 4] = acc[8 * c + 4] * alpha + pr * bflo(w.z); acc[8 * c + 5] = acc[8 * c + 5] * alpha + pr * bfhi(w.z);
        acc[8 * c + 6] = acc[8 * c + 6] * alpha + pr * bflo(w.w); acc[8 * c + 7] = acc[8 * c + 7] * alpha + pr * bfhi(w.w);
    }
}

__device__ __forceinline__ void phase_nsa(const Params& p, float* lds) {
    float* imp = lds;
    int* sel = (int*)(lds + 64 * 129);
    const int tid = tid_opaque(), qi = tid & 63, h = (tid >> 6) & 3, dh = tid >> 8;
    const unsigned char* ws = p.ws;
    const int nunits = BATCH * NSA_G * (T / 64);
    for (int u = blockIdx.x; u < nunits; u += gridDim.x) {
        const int b = u / (NSA_G * (T / 64)), g = (u / (T / 64)) % NSA_G, tile = u % (T / 64);
        const int t = tile * 64 + qi, head = g * 4 + h;
        const float slope = exp2f(-0.5f * (float)(9 + head));
        float q[64];
        load_row64((const bf16_t*)(ws + WS_QN) + ((size_t)(b * 8 + head) * T + t) * 64, q);
        const bf16_t* KC = (const bf16_t*)(ws + WS_KC) + (size_t)(b * 2 + g) * NCMPP * 64;
        const bf16_t* VC = (const bf16_t*)(ws + WS_VC) + (size_t)(b * 2 + g) * NCMPP * 64 + dh * 32;
        const bf16_t* KS = (const bf16_t*)(ws + WS_KV6 + 2 * KV6_STRIDE) + (size_t)(b * 2 + g) * T * 64;
        const bf16_t* VS = (const bf16_t*)(ws + WS_KV6 + 3 * KV6_STRIDE) + (size_t)(b * 2 + g) * T * 64 + dh * 32;
        const bf16_t* KW = (const bf16_t*)(ws + WS_KV6 + 4 * KV6_STRIDE) + (size_t)(b * 2 + g) * T * 64;
        const bf16_t* VW = (const bf16_t*)(ws + WS_KV6 + 5 * KV6_STRIDE) + (size_t)(b * 2 + g) * T * 64 + dh * 32;
        const float* gs = (const float*)(ws + WS_GSIG) + (size_t)(b * T + t) * 24 + head * 3;
        float o[32];
#pragma unroll
        for (int d = 0; d < 32; ++d) o[d] = 0.f;
        for (int i = tid; i < 64 * 129; i += NTHREADS) imp[i] = 0.f;
        __syncthreads();
        const int nc = 4 * tile + 3;
        float mc = -1e30f, lc = 0.f;
        {
            float acc[32];
#pragma unroll
            for (int d = 0; d < 32; ++d) acc[d] = 0.f;
            for (int c = 0; c < nc; ++c) {
                const int dist = t - (16 * c + 31);
                if (dist >= 0) {
                    const float s = dot_row64(KC + (size_t)c * 64, q) - slope * (float)dist;
                    osm_update(s, VC + (size_t)c * 64, mc, lc, acc);
                }
            }
            const float inv = gs[0] / fmaxf(lc, 1e-30f);
#pragma unroll
            for (int d = 0; d < 32; ++d) o[d] += acc[d] * inv;
        }
        if (dh == 0) {
            const float invl = 1.0f / fmaxf(lc, 1e-30f);
            for (int c = 0; c < nc; ++c) {
                const int dist = t - (16 * c + 31);
                if (dist >= 0) {
                    const float s = dot_row64(KC + (size_t)c * 64, q) - slope * (float)dist;
                    const float pr = __expf(s - mc) * invl;
                    const int sb = c >> 2;
                    atomicAdd(&imp[qi * 129 + sb], pr);
                    if ((c & 3) == 3 && sb + 1 < NSEL) atomicAdd(&imp[qi * 129 + sb + 1], pr);
                }
            }
        }
        __syncthreads();
        if (tid < 64) {
            const int blk_t = tile;
            float* row = imp + tid * 129;
            for (int j = 0; j <= blk_t; ++j) if (j == 0 || j == blk_t || j == blk_t - 1) row[j] = 1.0e4f;
            for (int k = 0; k < TOPN; ++k) {
                float best = -INFINITY; int bi = -1;
                for (int j = 0; j <= blk_t; ++j) { const float v = row[j]; if (v > best) { best = v; bi = j; } }
                sel[tid * 16 + k] = bi;
                if (bi >= 0) row[bi] = -INFINITY;
            }
        }
        __syncthreads();
        {
            float m = -1e30f, l = 0.f, acc[32];
#pragma unroll
            for (int d = 0; d < 32; ++d) acc[d] = 0.f;
            for (int k = 0; k < TOPN; ++k) {
                const int j = sel[qi * 16 + k];
                if (j >= 0) {
                    for (int i = 0; i < 64; ++i) {
                        const int pos = 64 * j + i;
                        if (pos <= t) {
                            const float s = dot_row64(KS + (size_t)pos * 64, q) - slope * (float)(t - pos);
                            osm_update(s, VS + (size_t)pos * 64, m, l, acc);
                        }
                    }
                }
            }
            const float inv = gs[1] / fmaxf(l, 1e-30f);
#pragma unroll
            for (int d = 0; d < 32; ++d) o[d] += acc[d] * inv;
        }
        {
            float m = -1e30f, l = 0.f, acc[32];
#pragma unroll
            for (int d = 0; d < 32; ++d) acc[d] = 0.f;
            for (int i = 0; i < NSA_WIN; ++i) {
                const int pos = t - (NSA_WIN - 1) + i;
                if (pos >= 0) {
                    const float s = dot_row64(KW + (size_t)pos * 64, q) - slope * (float)(t - pos);
                    osm_update(s, VW + (size_t)pos * 64, m, l, acc);
                }
            }
            const float inv = gs[2] / fmaxf(l, 1e-30f);
#pragma unroll
            for (int d = 0; d < 32; ++d) o[d] += acc[d] * inv;
        }
        bf16_t* O = (bf16_t*)(p.ws + WS_O) + (size_t)(b * T + t) * D + g * 256 + h * 64 + dh * 32;
#pragma unroll
        for (int c = 0; c < 4; ++c) {
            u32x4 w; w.x = pk2(o[8 * c], o[8 * c + 1]); w.y = pk2(o[8 * c + 2], o[8 * c + 3]); w.z = pk2(o[8 * c + 4], o[8 * c + 5]); w.w = pk2(o[8 * c + 6], o[8 * c + 7]);
            *(u32x4*)(O + 8 * c) = w;
        }
        __syncthreads();
    }
}

__device__ __forceinline__ void phase_swa(const Params& p) {
    const unsigned char* ws = p.ws;
    const long gt = (long)blockIdx.x * NTHREADS + tid_opaque(), ngt = (long)gridDim.x * NTHREADS;
    const long items = (long)NTOK * SWA_H * 2;
    for (long it = gt; it < items; it += ngt) {
        const int tt = (int)(it % T); long r = it / T;
        const int dh = (int)(r % 2); r /= 2;
        const int head = (int)(r % SWA_H); const int b = (int)(r / SWA_H);
        const float slope = exp2f(-0.5f * (float)(head + 1));
        float q[64];
        load_row64((const bf16_t*)(ws + WS_QS) + ((size_t)(b * 8 + head) * T + tt) * 64, q);
        const bf16_t* K = (const bf16_t*)(ws + WS_KSW) + (size_t)b * T * 64;
        const bf16_t* V = (const bf16_t*)(ws + WS_VSW) + (size_t)b * T * 64 + dh * 32;
        const float sink = p.sinks[head];
        float m = sink, l = 1.0f, acc[32];
#pragma unroll
        for (int d = 0; d < 32; ++d) acc[d] = 0.f;
        for (int i = 0; i < SWA_WIN; ++i) {
            const int pos = tt - (SWA_WIN - 1) + i;
            if (pos >= 0) {
                const float s = dot_row64(K + (size_t)pos * 64, q) - slope * (float)(tt - pos);
                osm_update(s, V + (size_t)pos * 64, m, l, acc);
            }
        }
        const float inv = 1.0f / l;
        bf16_t* O = (bf16_t*)(p.ws + WS_O) + (size_t)(b * T + tt) * D + 512 + head * 64 + dh * 32;
#pragma unroll
        for (int c = 0; c < 4; ++c) {
            u32x4 w; w.x = pk2(acc[8 * c] * inv, acc[8 * c + 1] * inv); w.y = pk2(acc[8 * c + 2] * inv, acc[8 * c + 3] * inv);
            w.z = pk2(acc[8 * c + 4] * inv, acc[8 * c + 5] * inv); w.w = pk2(acc[8 * c + 6] * inv, acc[8 * c + 7] * inv);
            *(u32x4*)(O + 8 * c) = w;
        }
    }
}

__device__ __forceinline__ void topk_insert(float v, int i, float (&tv)[16], int (&ti)[16]) {
#pragma unroll
    for (int k = 0; k < 16; ++k) {
        const bool sw = v > tv[k];
        const float ov = tv[k]; const int oi = ti[k];
        tv[k] = sw ? v : ov; ti[k] = sw ? i : oi;
        v = sw ? ov : v; i = sw ? oi : i;
    }
}
__device__ __forceinline__ void phase_peer_sub(const Params& p) {
    const unsigned char* ws = p.ws;
    const long gt = (long)blockIdx.x * NTHREADS + tid_opaque(), ngt = (long)gridDim.x * NTHREADS;
    const long items = (long)NTOK * 16;
    for (long it = gt; it < items; it += ngt) {
        const int tok = (int)(it % NTOK), hc = (int)(it / NTOK);
        const bf16_t* qp = (const bf16_t*)(ws + WS_QP) + (size_t)tok * PQ + hc * 128;
        float q0[64], q1[64];
        load_row64(qp, q0); load_row64(qp + 64, q1);
        const bf16_t* keys = (const bf16_t*)(ws + WS_PKEYS) + (size_t)hc * 128 * 128;
        float tv[16]; int ti[16];
#pragma unroll
        for (int k = 0; k < 16; ++k) { tv[k] = -INFINITY; ti[k] = 0; }
        for (int n = 0; n < 128; ++n) {
            const float s = dot_row64(keys + (size_t)n * 128, q0) + dot_row64(keys + (size_t)n * 128 + 64, q1);
            topk_insert(s, n, tv, ti);
        }
        float* ov = (float*)(p.ws + WS_TOPV2) + ((size_t)tok * 16 + hc) * 16;
        int* oi = (int*)(p.ws + WS_TOPI2) + ((size_t)tok * 16 + hc) * 16;
#pragma unroll
        for (int k = 0; k < 16; ++k) { ov[k] = tv[k]; oi[k] = ti[k]; }
    }
}
__device__ __forceinline__ void phase_peer_comb(const Params& p) {
    const long gt = (long)blockIdx.x * NTHREADS + tid_opaque(), ngt = (long)gridDim.x * NTHREADS;
    const long items = (long)NTOK * PH;
    for (long it = gt; it < items; it += ngt) {
        const int tok = (int)(it / PH), h = (int)(it % PH);
        const float* v1 = (const float*)(p.ws + WS_TOPV2) + ((size_t)tok * 16 + h * 2) * 16;
        const float* v2 = v1 + 16;
        const int* i1 = (const int*)(p.ws + WS_TOPI2) + ((size_t)tok * 16 + h * 2) * 16;
        const int* i2 = i1 + 16;
        float s2[16];
#pragma unroll
        for (int k = 0; k < 16; ++k) s2[k] = v2[k];
        float tv[16]; int ti[16];
#pragma unroll
        for (int k = 0; k < 16; ++k) { tv[k] = -INFINITY; ti[k] = 0; }
        for (int a = 0; a < 16; ++a) {
            const float s1 = v1[a];
#pragma unroll
            for (int bb = 0; bb < 16; ++bb) topk_insert(s1 + s2[bb], a * 16 + bb, tv, ti);
        }
        float e[16], sum = 0.f;
#pragma unroll
        for (int k = 0; k < 16; ++k) { e[k] = __expf(tv[k] - tv[0]); sum += e[k]; }
        const float inv = 1.0f / sum;
        int* eo = (int*)(p.ws + WS_EIDX) + (size_t)tok * 128 + h * 16;
        float* go = (float*)(p.ws + WS_GATE) + (size_t)tok * 128 + h * 16;
#pragma unroll
        for (int k = 0; k < 16; ++k) { const int ci = ti[k]; eo[k] = i1[ci >> 4] * PNK + i2[ci & 15]; go[k] = e[k] * inv; }
    }
}

typedef float f32x2 __attribute__((ext_vector_type(2)));
__device__ __forceinline__ void unpack16_fp8(const u32x4& w, float (&f)[16]) {
#pragma unroll
    for (int q = 0; q < 4; ++q) {
        const f32x2 lo = __builtin_amdgcn_cvt_pk_f32_fp8((int)w[q], false), hi = __builtin_amdgcn_cvt_pk_f32_fp8((int)w[q], true);
        f[4 * q] = lo.x; f[4 * q + 1] = lo.y; f[4 * q + 2] = hi.x; f[4 * q + 3] = hi.y;
    }
}
__device__ __forceinline__ float reduce8(const float (&d)[8], int lane) {
    const bool b5 = lane & 32, b4 = lane & 16, b3 = lane & 8;
    float e[4], f[2];
#pragma unroll
    for (int i = 0; i < 4; ++i) { const float snd = b5 ? d[i] : d[i + 4], keep = b5 ? d[i + 4] : d[i]; e[i] = keep + __shfl_xor(snd, 32); }
#pragma unroll
    for (int i = 0; i < 2; ++i) { const float snd = b4 ? e[i] : e[i + 2], keep = b4 ? e[i + 2] : e[i]; f[i] = keep + __shfl_xor(snd, 16); }
    const float snd = b3 ? f[0] : f[1], keep = b3 ? f[1] : f[0];
    float g = keep + __shfl_xor(snd, 8);
    g += __shfl_xor(g, 4); g += __shfl_xor(g, 2); g += __shfl_xor(g, 1);
    return g;
}
__device__ __forceinline__ void phase_peer_expert(const Params& p) {
    const unsigned char* ws = p.ws;
    const int tid_ = tid_opaque(), lane = tid_ & 63;
    const int gw = (int)blockIdx.x * (NTHREADS / 64) + __builtin_amdgcn_readfirstlane(tid_ >> 6), ngw = (int)gridDim.x * (NTHREADS / 64);
    const unsigned char* U = ws + WS_U8; const unsigned char* V = ws + WS_V8;
    const unsigned loff = 16u * (unsigned)lane;
    for (int tok = gw; tok < NTOK; tok += ngw) {
        const bf16_t* hg = (const bf16_t*)(ws + WS_H1G + (size_t)tok * D * 2) + loff;
        float a[16];
        {
            const u32x4 w0 = *(const u32x4*)hg, w1 = *(const u32x4*)(hg + 8);
            a[0] = bflo(w0.x); a[1] = bfhi(w0.x); a[2] = bflo(w0.y); a[3] = bfhi(w0.y); a[4] = bflo(w0.z); a[5] = bfhi(w0.z); a[6] = bflo(w0.w); a[7] = bfhi(w0.w);
            a[8] = bflo(w1.x); a[9] = bfhi(w1.x); a[10] = bflo(w1.y); a[11] = bfhi(w1.y); a[12] = bflo(w1.z); a[13] = bfhi(w1.z); a[14] = bflo(w1.w); a[15] = bfhi(w1.w);
        }
        const float rstd2 = (1.0f / U8_SCALE) / sqrtf(((const float*)(ws + WS_SS2))[tok] * (1.0f / D) + EPS);
        const int e_lo = ((const int*)(ws + WS_EIDX))[(size_t)tok * 128 + lane], e_hi = ((const int*)(ws + WS_EIDX))[(size_t)tok * 128 + 64 + lane];
        const float g_lo = ((const float*)(ws + WS_GATE))[(size_t)tok * 128 + lane], g_hi = ((const float*)(ws + WS_GATE))[(size_t)tok * 128 + 64 + lane];
        float acc[16];
#pragma unroll
        for (int i = 0; i < 16; ++i) acc[i] = 0.f;
        u32x4 uw[8], vw[8];
#pragma unroll
        for (int k = 0; k < 8; ++k) { const int e = __builtin_amdgcn_readlane(e_lo, k); uw[k] = *(const u32x4*)(U + (size_t)e * D + loff); vw[k] = *(const u32x4*)(V + (size_t)e * D + loff); }
#pragma unroll 1
        for (int b = 0; b < 16; ++b) {
            const int nsrc = (b + 1 < 8) ? e_lo : e_hi; const int nbase = ((b + 1) & 7) * 8;
            float d[8];
#pragma unroll
            for (int k = 0; k < 8; ++k) {
                float uf[16]; unpack16_fp8(uw[k], uf);
                float d0 = 0.f, d1 = 0.f;
#pragma unroll
                for (int i = 0; i < 16; i += 2) { d0 += a[i] * uf[i]; d1 += a[i + 1] * uf[i + 1]; }
                d[k] = d0 + d1;
                __builtin_amdgcn_sched_barrier(0);
            }
            if (b + 1 < 16) {
#pragma unroll
                for (int k = 0; k < 8; ++k) { const int e = __builtin_amdgcn_readlane(nsrc, nbase + k); uw[k] = *(const u32x4*)(U + (size_t)e * D + loff); }
            }
            const float dk = reduce8(d, lane);
            const float gsel = __shfl((b < 8) ? g_lo : g_hi, (b & 7) * 8 + ((lane >> 3) & 7));
            const float w = gsel * gelu_tanh(dk * rstd2);
#pragma unroll
            for (int k = 0; k < 8; ++k) {
                const float wk = __uint_as_float((unsigned)__builtin_amdgcn_readlane((int)__float_as_uint(w), 8 * k));
                float vf[16]; unpack16_fp8(vw[k], vf);
#pragma unroll
                for (int i = 0; i < 16; ++i) acc[i] += wk * vf[i];
                __builtin_amdgcn_sched_barrier(0);
            }
            if (b + 1 < 16) {
#pragma unroll
                for (int k = 0; k < 8; ++k) { const int e = __builtin_amdgcn_readlane(nsrc, nbase + k); vw[k] = *(const u32x4*)(V + (size_t)e * D + loff); }
            }
        }
        float* orow = (float*)((unsigned char*)p.out + (size_t)tok * D * 4) + loff;
        float y[16]; float ss = 0.f;
#pragma unroll
        for (int q = 0; q < 4; ++q) {
            const f32x4 h = *(const f32x4*)(orow + 4 * q);
            y[4 * q] = h.x + acc[4 * q] * (1.0f / V8_SCALE); y[4 * q + 1] = h.y + acc[4 * q + 1] * (1.0f / V8_SCALE);
            y[4 * q + 2] = h.z + acc[4 * q + 2] * (1.0f / V8_SCALE); y[4 * q + 3] = h.w + acc[4 * q + 3] * (1.0f / V8_SCALE);
        }
#pragma unroll
        for (int i = 0; i < 16; ++i) ss += y[i] * y[i];
        const float rstd = 1.0f / sqrtf(wave_sum(ss) * (1.0f / D) + EPS);
#pragma unroll
        for (int q = 0; q < 4; ++q) {
            const f32x4 g = *(const f32x4*)(p.lnf_g + loff + 4 * q);
            *(f32x4*)(orow + 4 * q) = (f32x4){y[4 * q] * rstd * g.x, y[4 * q + 1] * rstd * g.y, y[4 * q + 2] * rstd * g.z, y[4 * q + 3] * rstd * g.w};
        }
    }
}


namespace psel {
#define HD __host__ __device__ __forceinline__
HD unsigned f2ord(float f) { unsigned u = __builtin_bit_cast(unsigned, f); const unsigned m = (unsigned)((int)u >> 31); return u ^ (m | 0x80000000u); }
HD float ord2f(unsigned o) { const unsigned m = (unsigned)((int)o >> 31); return __builtin_bit_cast(float, o ^ (~m | 0x80000000u)); }
HD unsigned umax_(unsigned a, unsigned b) { return a > b ? a : b; }
HD unsigned umin_(unsigned a, unsigned b) { return a < b ? a : b; }
HD void sort16_desc(unsigned (&a)[16]) {
#pragma unroll
    for (int k = 2; k <= 16; k <<= 1)
#pragma unroll
        for (int j = k >> 1; j > 0; j >>= 1)
#pragma unroll
            for (int i = 0; i < 16; ++i) {
                const int l = i ^ j;
                if (l > i) {
                    const bool up = ((i & k) == 0);
                    const unsigned hi = umax_(a[i], a[l]), lo = umin_(a[i], a[l]);
                    a[i] = up ? hi : lo; a[l] = up ? lo : hi;
                }
            }
}
HD void merge16_desc(unsigned (&a)[16], const unsigned (&b)[16]) {
#pragma unroll
    for (int i = 0; i < 16; ++i) a[i] = umax_(a[i], b[15 - i]);
#pragma unroll
    for (int j = 8; j > 0; j >>= 1)
#pragma unroll
        for (int i = 0; i < 16; ++i) {
            const int l = i ^ j;
            if (l > i) { const unsigned hi = umax_(a[i], a[l]), lo = umin_(a[i], a[l]); a[i] = hi; a[l] = lo; }
        }
}
HD void top16_of_64(unsigned (&g0)[16], unsigned (&g1)[16], unsigned (&g2)[16], unsigned (&g3)[16]) {
    sort16_desc(g0); sort16_desc(g1); sort16_desc(g2); sort16_desc(g3);
    merge16_desc(g0, g1); merge16_desc(g2, g3); merge16_desc(g0, g2);
}
struct PairTab { int a[64]; int b[64]; int n; };
constexpr PairTab make_pairs() {
    PairTab t{}; int n = 0;
    for (int a = 0; a < 16; ++a) for (int b = 0; b < 16; ++b) if ((a + 1) * (b + 1) <= 16) { t.a[n] = a; t.b[n] = b; ++n; }
    t.n = n; for (int i = n; i < 64; ++i) { t.a[i] = 0; t.b[i] = 0; }
    return t;
}
#undef HD
typedef float f32x16 __attribute__((ext_vector_type(16)));
#define PLAS __attribute__((address_space(3)))
static constexpr PairTab PT = make_pairs();
__device__ __forceinline__ constexpr int crow_c(int r) { return (r & 3) + 8 * (r >> 2); }
__device__ __forceinline__ void phase_peer_select(const Params& p, unsigned char* lds_generic) {
    const unsigned char* ws = p.ws;
    const int tid = tid_opaque(), lane = tid & 63, wid = __builtin_amdgcn_readfirstlane(tid >> 6), r32 = lane & 31, hi = lane >> 5;
    PLAS int* tab = (PLAS int*)((PLAS unsigned char*)lds_generic) + wid * 2048;
    const int gw = (int)blockIdx.x * (NTHREADS / 64) + wid, ngw = (int)gridDim.x * (NTHREADS / 64);
    const __amdgpu_buffer_rsrc_t rq = __builtin_amdgcn_make_buffer_rsrc((void*)(p.ws + WS_QP), (short)0, (int)((size_t)NTOK * PQ * 2), 0x00020000);
    const __amdgpu_buffer_rsrc_t rk = __builtin_amdgcn_make_buffer_rsrc((void*)(p.ws + WS_PKEYS), (short)0, 16 * 128 * 128 * 2, 0x00020000);
    for (int task = gw; task < (NTOK / 32) * PH; task += ngw) {
        const int tb = task >> 3, h = task & 7, tok = 32 * tb + r32;
        int hi4 = 4 * hi; asm volatile("" : "+v"(hi4));
        unsigned k1[16], k2[16];
#pragma unroll
        for (int c = 0; c < 2; ++c) {
            const int hc = h * 2 + c;
            const unsigned qoff = (unsigned)(r32 * PQ + 8 * hi) * 2u, koff = (unsigned)(r32 * 128 + 8 * hi) * 2u;
            const int qso = (tb * 32 * PQ + hc * 128) * 2, kso = hc * 128 * 128 * 2;
            bf16x8 qf[8];
#pragma unroll
            for (int d0 = 0; d0 < 8; ++d0) qf[d0] = __builtin_bit_cast(bf16x8, __builtin_amdgcn_raw_buffer_load_b128(rq, (int)qoff, qso + 32 * d0, 0));
            unsigned g[4][16];
#pragma unroll
            for (int nt = 0; nt < 4; ++nt) {
                f32x16 acc;
#pragma unroll
                for (int r = 0; r < 16; ++r) acc[r] = 0.f;
#pragma unroll
                for (int d0 = 0; d0 < 8; ++d0) {
                    const bf16x8 kf = __builtin_bit_cast(bf16x8, __builtin_amdgcn_raw_buffer_load_b128(rk, (int)koff, kso + nt * 8192 + 32 * d0, 0));
                    acc = __builtin_amdgcn_mfma_f32_32x32x16_bf16(kf, qf[d0], acc, 0, 0, 0);
                }
#pragma unroll
                for (int r = 0; r < 16; ++r) g[nt][r] = (f2ord(acc[r]) & 0xFFFFFF80u) | (unsigned)((127 - 32 * nt - crow_c(r)) - hi4);
                __builtin_amdgcn_sched_barrier(0);
            }
            top16_of_64(g[0], g[1], g[2], g[3]);
            unsigned pb[16];
#pragma unroll
            for (int i = 0; i < 16; ++i) pb[i] = (unsigned)__shfl_xor((int)g[0][i], 32);
            merge16_desc(g[0], pb);
#pragma unroll
            for (int i = 0; i < 16; ++i) { if (c == 0) k1[i] = g[0][i]; else k2[i] = g[0][i]; }
        }
        float v1[16], v2[16];
#pragma unroll
        for (int i = 0; i < 16; ++i) { v1[i] = ord2f(k1[i] & 0xFFFFFF80u); v2[i] = ord2f(k2[i] & 0xFFFFFF80u); }
        unsigned cg[4][16];
#pragma unroll
        for (int s = 0; s < 64; ++s) {
            unsigned key = 0u;
            if (s < PT.n) key = (f2ord(v1[PT.a[s]] + v2[PT.b[s]]) & 0xFFFFFF00u) | (unsigned)(255 - (PT.a[s] * 16 + PT.b[s]));
            cg[s >> 4][s & 15] = key;
        }
        top16_of_64(cg[0], cg[1], cg[2], cg[3]);
#pragma unroll
        for (int i = 0; i < 16; ++i) { tab[i * 64 + lane] = 127 - (int)(k1[i] & 127u); tab[(16 + i) * 64 + lane] = 127 - (int)(k2[i] & 127u); }
        __builtin_amdgcn_fence(__ATOMIC_RELEASE, "wavefront"); __builtin_amdgcn_wave_barrier();
        int eo[16]; float ge[16]; float gsum = 0.f;
        const float top = ord2f(cg[0][0] & 0xFFFFFF00u);
#pragma unroll
        for (int k = 0; k < 16; ++k) {
            const int ab = 255 - (int)(cg[0][k] & 255u);
            eo[k] = tab[(ab >> 4) * 64 + lane] * PNK + tab[(16 + (ab & 15)) * 64 + lane];
            ge[k] = __expf(ord2f(cg[0][k] & 0xFFFFFF00u) - top); gsum += ge[k];
        }
        __builtin_amdgcn_wave_barrier();
        const float ginv = 1.0f / gsum;
        if (hi == 0) {
            int* eout = (int*)(p.ws + WS_EIDX) + (size_t)tok * 128 + h * 16;
            float* gout = (float*)(p.ws + WS_GATE) + (size_t)tok * 128 + h * 16;
#pragma unroll
            for (int q = 0; q < 4; ++q) {
                *(u32x4*)(eout + 4 * q) = (u32x4){(unsigned)eo[4 * q], (unsigned)eo[4 * q + 1], (unsigned)eo[4 * q + 2], (unsigned)eo[4 * q + 3]};
                *(f32x4*)(gout + 4 * q) = (f32x4){ge[4 * q] * ginv, ge[4 * q + 1] * ginv, ge[4 * q + 2] * ginv, ge[4 * q + 3] * ginv};
            }
        }
    }
}
}

namespace att {
typedef float f32x16 __attribute__((ext_vector_type(16)));
typedef short s16x4 __attribute__((ext_vector_type(4)));
typedef short v4i16_t __attribute__((ext_vector_type(4)));
#define ALAS __attribute__((address_space(3)))
typedef ALAS unsigned char* lptr;
constexpr int L_K = 0, L_V = 16384, L_IMP = 32768, L_SELM = L_IMP + 64 * 129 * 4, L_UNION = L_SELM + 1024, L_WSCR = L_UNION + 16, L_ACC = L_WSCR + 8 * 256, L_END = L_ACC + 8 * 8192;
constexpr float LOG2E = 1.4426950408889634f;
constexpr float THR = 10.0f;
__device__ __forceinline__ constexpr int crow_c(int r) { return (r & 3) + 8 * (r >> 2); }
__device__ __forceinline__ unsigned cvtpk(float lo, float hi) { typedef float f2 __attribute__((ext_vector_type(2))); typedef __bf16 b2 __attribute__((ext_vector_type(2)));
    f2 v = {lo, hi}; b2 b = __builtin_convertvector(v, b2); return __builtin_bit_cast(unsigned, b); }
__device__ __forceinline__ s16x4 vtr(lptr p) { return __builtin_bit_cast(s16x4, __builtin_amdgcn_ds_read_tr16_b64_v4i16((ALAS v4i16_t*)p)); }

struct Stage { u32x4 k, v; };
__device__ __forceinline__ void stage_load(const bf16_t* Kt, const bf16_t* Vt, int wid, int lane, Stage& s, bool withV) {
    s.k = *(const u32x4*)(Kt + (size_t)lane * 64 + wid * 8);
    if (withV) s.v = *(const u32x4*)(Vt + (size_t)(16 * (wid & 3) + (lane >> 2)) * 64 + (wid >> 2) * 32 + (lane & 3) * 8);
}
__device__ __forceinline__ void stage_store(lptr kbuf, lptr vbuf, int wid, int lane, const Stage& s, bool withV) {
    *(ALAS u32x4*)(kbuf + wid * 1024 + lane * 16) = s.k;
    if (withV) *(ALAS u32x4*)(vbuf + wid * 1024 + lane * 16) = s.v;
}
__device__ __forceinline__ void qk_tile(f32x16& p0, f32x16& p1, lptr kbuf, const bf16x8 (&qf)[4], float cb, float sk, int r32, int hi) {
    asm volatile("" : "+v"(sk));
    const float cb2 = cb + sk * (float)(4 * hi);
#pragma unroll
    for (int r = 0; r < 16; ++r) { p0[r] = cb2 + sk * (float)crow_c(r); p1[r] = cb2 + sk * (float)(crow_c(r) + 32); }
    lptr kb = kbuf + hi * 1024 + r32 * 16;
#pragma unroll
    for (int d0 = 0; d0 < 4; ++d0) {
        const bf16x8 k0 = *(const ALAS bf16x8*)(kb + d0 * 2048), k1 = *(const ALAS bf16x8*)(kb + d0 * 2048 + 512);
        p0 = __builtin_amdgcn_mfma_f32_32x32x16_bf16(k0, qf[d0], p0, 0, 0, 0);
        p1 = __builtin_amdgcn_mfma_f32_32x32x16_bf16(k1, qf[d0], p1, 0, 0, 0);
    }
}
__device__ __forceinline__ void mask_tile(f32x16& p0, f32x16& p1, int hi_lim, int lo_lim, int hi) {
    int hl = hi_lim - 4 * hi, ll1 = lo_lim + 1 - 4 * hi;
    asm volatile("" : "+v"(hl), "+v"(ll1));
#pragma unroll
    for (int r = 0; r < 16; ++r) {
        const int c0 = crow_c(r), c1 = crow_c(r) + 32;
        const unsigned t0 = (unsigned)((c0 - ll1) | (hl - c0)), t1 = (unsigned)((c1 - ll1) | (hl - c1));
        p0[r] = fminf(p0[r], __uint_as_float((t0 & 0x80000000u) | 0x7f800000u));
        p1[r] = fminf(p1[r], __uint_as_float((t1 & 0x80000000u) | 0x7f800000u));
    }
}
__device__ __forceinline__ float max3f(float a, float b, float c) { float r; asm("v_max3_f32 %0, %1, %2, %3" : "=v"(r) : "v"(a), "v"(b), "v"(c)); return r; }
__device__ __forceinline__ float max2f(float a, float b) { float r; asm("v_max_f32_e32 %0, %1, %2" : "=v"(r) : "v"(a), "v"(b)); return r; }
__device__ __forceinline__ float tile_max(const f32x16& p0, const f32x16& p1) {
    float a = max3f(p0[0], p0[1], p1[0]), b = max3f(p0[2], p0[3], p1[1]); a = max3f(a, p1[2], p1[3]);
#pragma unroll
    for (int r = 4; r < 16; r += 4) { a = max3f(a, p0[r], p0[r + 1]); b = max3f(b, p0[r + 2], p0[r + 3]); a = max3f(a, p1[r], p1[r + 1]); b = max3f(b, p1[r + 2], p1[r + 3]); }
    const float m = max2f(a, b);
    return max2f(m, __shfl_xor(m, 32));
}
__device__ __forceinline__ float tile_sum(const f32x16& p0, const f32x16& p1) {
    float a = p0[0] + p1[0];
#pragma unroll
    for (int r = 1; r < 16; ++r) a += p0[r] + p1[r];
    return a + __shfl_xor(a, 32);
}
__device__ __forceinline__ void pack_p(u32x4 (&pw)[4], const f32x16& p0, const f32x16& p1) {
    pw[0] = (u32x4){cvtpk(p0[0], p0[1]), cvtpk(p0[2], p0[3]), cvtpk(p0[4], p0[5]), cvtpk(p0[6], p0[7])};
    pw[1] = (u32x4){cvtpk(p0[8], p0[9]), cvtpk(p0[10], p0[11]), cvtpk(p0[12], p0[13]), cvtpk(p0[14], p0[15])};
    pw[2] = (u32x4){cvtpk(p1[0], p1[1]), cvtpk(p1[2], p1[3]), cvtpk(p1[4], p1[5]), cvtpk(p1[6], p1[7])};
    pw[3] = (u32x4){cvtpk(p1[8], p1[9]), cvtpk(p1[10], p1[11]), cvtpk(p1[12], p1[13]), cvtpk(p1[14], p1[15])};
}
__device__ __forceinline__ void pv_packed(f32x16& o0, f32x16& o1, const u32x4 (&pw)[4], lptr vbuf, int lane, int hi) {
    lptr vp = vbuf + ((lane >> 4) & 1) * 32 + (lane & 3) * 8 + (4 * hi + ((lane & 15) >> 2)) * 64;
#pragma unroll
    for (int ks = 0; ks < 4; ++ks) {
        const s16x4 a = vtr(vp + ks * 1024), b = vtr(vp + ks * 1024 + 512);
        const s16x4 c = vtr(vp + 4096 + ks * 1024), d = vtr(vp + 4096 + ks * 1024 + 512);
        const bf16x8 v0 = (bf16x8){a[0], a[1], a[2], a[3], b[0], b[1], b[2], b[3]}, v1 = (bf16x8){c[0], c[1], c[2], c[3], d[0], d[1], d[2], d[3]};
        const bf16x8 pa = __builtin_bit_cast(bf16x8, pw[ks]);
        o0 = __builtin_amdgcn_mfma_f32_32x32x16_bf16(pa, v0, o0, 0, 0, 0);
        o1 = __builtin_amdgcn_mfma_f32_32x32x16_bf16(pa, v1, o1, 0, 0, 0);
    }
}
__device__ __forceinline__ void pv_tile(f32x16& o0, f32x16& o1, const f32x16& p0, const f32x16& p1, lptr vbuf, int lane, int hi) {
    u32x4 pw[4]; pack_p(pw, p0, p1);
    pv_packed(o0, o1, pw, vbuf, lane, hi);
}
__device__ __forceinline__ void ov_frags(bf16x8 (&ovf)[4], int r32, int hi) {
#pragma unroll
    for (int ks = 0; ks < 4; ++ks)
#pragma unroll
        for (int j = 0; j < 8; ++j) {
            const int q4 = 4 * ks + 2 * (j >> 2) + hi;
            const bool on = (r32 == q4) || ((j & 3) == 3 && r32 == q4 + 1);
            ovf[ks][j] = on ? (short)0x3F80 : (short)0;
        }
}
__device__ __forceinline__ void scale_rows(f32x16& o0, f32x16& o1, float f, ALAS float* wscr, int r32, int hi) {
    if (hi == 0) wscr[r32] = f;
    __builtin_amdgcn_fence(__ATOMIC_RELEASE, "wavefront"); __builtin_amdgcn_wave_barrier();
#pragma unroll
    for (int r = 0; r < 16; ++r) { const float a = wscr[crow_c(r) + 4 * hi]; o0[r] *= a; o1[r] *= a; }
    __builtin_amdgcn_wave_barrier();
}
template <bool FIRST>
__device__ __forceinline__ void acc_rows(ALAS float* accw, const f32x16& o0, const f32x16& o1, float f, ALAS float* wscr, int r32, int hi) {
    if (hi == 0) wscr[r32] = f;
    __builtin_amdgcn_fence(__ATOMIC_RELEASE, "wavefront"); __builtin_amdgcn_wave_barrier();
#pragma unroll
    for (int r = 0; r < 16; ++r) {
        const int row = crow_c(r) + 4 * hi; const float a = wscr[row];
        ALAS float* d = accw + row * 64 + r32;
        if (FIRST) { d[0] = o0[r] * a; d[32] = o1[r] * a; } else { d[0] += o0[r] * a; d[32] += o1[r] * a; }
    }
    __builtin_amdgcn_wave_barrier();
}
__device__ __forceinline__ void store_acc(ALAS float* accw, bf16_t* O, int lane) {
    __builtin_amdgcn_fence(__ATOMIC_RELEASE, "wavefront"); __builtin_amdgcn_wave_barrier();
#pragma unroll
    for (int it = 0; it < 4; ++it) {
        const int item = it * 64 + lane, row = item >> 3, ch = item & 7;
        const f32x4 x = *(const ALAS f32x4*)(accw + row * 64 + ch * 8), y = *(const ALAS f32x4*)(accw + row * 64 + ch * 8 + 4);
        u32x4 w; w.x = cvtpk(x[0], x[1]); w.y = cvtpk(x[2], x[3]); w.z = cvtpk(y[0], y[1]); w.w = cvtpk(y[2], y[3]);
        *(u32x4*)(O + (size_t)(row & 7) * D + (row >> 3) * 64 + ch * 8) = w;
    }
    __builtin_amdgcn_wave_barrier();
}
struct Br { float m, l; f32x16 o0, o1; };
template <bool MASK>
__device__ __forceinline__ void attend_tile(Br& s, lptr kbuf, lptr vbuf, const bf16x8 (&qf)[4], float cb, float sk, int hi_lim, int lo_lim, ALAS float* wscr, int lane, int r32, int hi) {
    f32x16 p0, p1;
    const float mu = (s.m < -1e29f) ? 0.f : s.m;
    qk_tile(p0, p1, kbuf, qf, cb - mu, sk, r32, hi);
    if (MASK) mask_tile(p0, p1, hi_lim, lo_lim, hi);
    const float rm = tile_max(p0, p1);
    if (__any(rm + mu > s.m + THR)) {
        const float mn = fmaxf(s.m, rm + mu), alpha = __builtin_amdgcn_exp2f(s.m - mn), delta = mn - mu;
        s.l *= alpha; s.m = mn;
        scale_rows(s.o0, s.o1, alpha, wscr, r32, hi);
#pragma unroll
        for (int r = 0; r < 16; ++r) { p0[r] -= delta; p1[r] -= delta; }
    }
#pragma unroll
    for (int r = 0; r < 16; ++r) { p0[r] = __builtin_amdgcn_exp2f(p0[r]); p1[r] = __builtin_amdgcn_exp2f(p1[r]); }
    s.l += tile_sum(p0, p1);
    pv_tile(s.o0, s.o1, p0, p1, vbuf, lane, hi);
}

#define ATT_BAR() asm volatile("s_waitcnt lgkmcnt(0)\n\ts_barrier" ::: "memory")
template <int PVAR = 0>
__device__ __forceinline__ void nsa_unit(const Params& p, unsigned char* lds_generic, int b, int g, int tile) {
    lptr lds = (lptr)lds_generic;
    const int tid = tid_opaque(), lane = tid & 63, wid = __builtin_amdgcn_readfirstlane(tid >> 6), r32 = lane & 31, hi = lane >> 5;
    const int h = r32 >> 3, qi = r32 & 7, tq = 8 * wid + qi, t = 64 * tile + tq, head = g * 4 + h;
    const float slope = exp2f(-0.5f * (float)(9 + head)) * LOG2E;
    const unsigned char* ws = p.ws;
    ALAS float* imp = (ALAS float*)(lds + L_IMP);
    ALAS unsigned* selm = (ALAS unsigned*)(lds + L_SELM);
    ALAS unsigned* uni = (ALAS unsigned*)(lds + L_UNION);
    ALAS float* wscr = (ALAS float*)(lds + L_WSCR) + wid * 64;
    const bf16_t* KC = (const bf16_t*)(ws + WS_KC) + (size_t)(b * 2 + g) * NCMPP * 64;
    const bf16_t* VC = (const bf16_t*)(ws + WS_VC) + (size_t)(b * 2 + g) * NCMPP * 64;
    const bf16_t* KS = (const bf16_t*)(ws + WS_KV6 + 2 * KV6_STRIDE) + (size_t)(b * 2 + g) * T * 64;
    const bf16_t* VS = (const bf16_t*)(ws + WS_KV6 + 3 * KV6_STRIDE) + (size_t)(b * 2 + g) * T * 64;
    const bf16_t* KW = (const bf16_t*)(ws + WS_KV6 + 4 * KV6_STRIDE) + (size_t)(b * 2 + g) * T * 64;
    const bf16_t* VW = (const bf16_t*)(ws + WS_KV6 + 5 * KV6_STRIDE) + (size_t)(b * 2 + g) * T * 64;
    const float* gs = (const float*)(ws + WS_GSIG) + (size_t)(b * T + t) * 24 + head * 3;
    bf16x8 qf[4];
    {
        const bf16_t* qp = (const bf16_t*)(ws + WS_QN) + ((size_t)(b * 8 + head) * T + t) * 64 + 8 * hi;
#pragma unroll
        for (int d0 = 0; d0 < 4; ++d0) qf[d0] = *(const bf16x8*)(qp + 16 * d0);
    }
    for (int i = tid; i < 64 * 129; i += NTHREADS) imp[i] = 0.f;
    if (tid < 4) uni[tid] = 0u;
    ALAS float* accw = (ALAS float*)(lds + L_ACC) + wid * 2048;
    const int nc = 4 * tile + 3, n = (nc + 63) >> 6, n2 = 2 * n;
    const int nw = (tile < 8) ? tile + 1 : 9, NS = n2 + nw;
#define GK(x) ((x) < n2 ? KC + (size_t)((x) < n ? (x) : (x) - n) * 4096 : ((x) < NS ? KW + (size_t)(tile - ((x) - n2)) * 4096 : KS + (size_t)tile * 4096))
#define GV(x) ((x) < n2 ? VC + (size_t)((x) < n ? (x) : (x) - n) * 4096 : ((x) < NS ? VW + (size_t)(tile - ((x) - n2)) * 4096 : VS + (size_t)tile * 4096))
#define PIPE_HEAD(x) do { if ((x) + 2 <= NS) stage_load(GK((x) + 2), GV((x) + 2), wid, lane, sB, true); } while (0)
#define PIPE_TAIL(x) do { if ((x) + 1 <= NS) stage_store(lds + L_K + (cur ^ 1) * 8192, lds + L_V + (cur ^ 1) * 8192, wid, lane, sA, true); ATT_BAR(); cur ^= 1; sA = sB; } while (0)
    Stage sA, sB; int cur = 0;
    stage_load(GK(0), GV(0), wid, lane, sA, true);
    stage_store(lds + L_K, lds + L_V, wid, lane, sA, true);
    ATT_BAR();
    stage_load(GK(1), GV(1), wid, lane, sA, true);
    const int cmax = (t >= 31) ? ((t - 31) >> 4) : -1;
    const float skc = 16.0f * slope, cbc = -slope * (float)(t - 31);
    float mc = -1e30f, lc = 0.f;
    for (int x = 0; x < n; ++x) {
        PIPE_HEAD(x);
        const int i = x;
        if (!(PVAR & 1)) {
        f32x16 p0, p1;
        qk_tile(p0, p1, lds + L_K + cur * 8192, qf, cbc + skc * (float)(64 * i), skc, r32, hi);
        if (__any(cmax - 64 * i < 63)) mask_tile(p0, p1, cmax - 64 * i, -1, hi);
        const float rm = tile_max(p0, p1), mn = fmaxf(mc, rm);
#pragma unroll
        for (int r = 0; r < 16; ++r) { p0[r] = __builtin_amdgcn_exp2f(p0[r] - mn); p1[r] = __builtin_amdgcn_exp2f(p1[r] - mn); }
        lc = lc * __builtin_amdgcn_exp2f(mc - mn) + tile_sum(p0, p1); mc = mn;
        }
        PIPE_TAIL(x);
    }
    {
        const float nrm = (lc > 0.f) ? (mc + __builtin_amdgcn_logf(lc)) : 0.f;
        Br sc; sc.m = 0.f; sc.l = 0.f;
#pragma unroll
        for (int r = 0; r < 16; ++r) { sc.o0[r] = 0.f; sc.o1[r] = 0.f; }
        bf16x8 ovf[4]; ov_frags(ovf, r32, hi);
        for (int x = n; x < n2; ++x) {
            PIPE_HEAD(x);
            const int i = x - n;
            if (!(PVAR & 2)) {
            f32x16 p0, p1;
            qk_tile(p0, p1, lds + L_K + cur * 8192, qf, cbc + skc * (float)(64 * i) - nrm, skc, r32, hi);
            if (__any(cmax - 64 * i < 63)) mask_tile(p0, p1, cmax - 64 * i, -1, hi);
#pragma unroll
            for (int r = 0; r < 16; ++r) { p0[r] = __builtin_amdgcn_exp2f(p0[r]); p1[r] = __builtin_amdgcn_exp2f(p1[r]); }
            u32x4 pw[4]; pack_p(pw, p0, p1);
            pv_packed(sc.o0, sc.o1, pw, lds + L_V + cur * 8192, lane, hi);
            f32x16 ia;
#pragma unroll
            for (int r = 0; r < 16; ++r) ia[r] = 0.f;
#pragma unroll
            for (int ks = 0; ks < 4; ++ks) ia = __builtin_amdgcn_mfma_f32_32x32x16_bf16(__builtin_bit_cast(bf16x8, pw[ks]), ovf[ks], ia, 0, 0, 0);
            const int sb = 16 * i + r32;
            if (r32 <= 16 && sb < NSEL) {
#pragma unroll
                for (int m = 0; m < 4; ++m) atomicAdd((float*)(imp + (8 * wid + 4 * hi + m) * 129 + sb), (ia[m] + ia[m + 4]) + (ia[m + 8] + ia[m + 12]));
            }
            }
            PIPE_TAIL(x);
        }
        acc_rows<true>(accw, sc.o0, sc.o1, gs[0], wscr, r32, hi);
    }
    {
        Br sw; sw.m = -1e30f; sw.l = 0.f;
#pragma unroll
        for (int r = 0; r < 16; ++r) { sw.o0[r] = 0.f; sw.o1[r] = 0.f; }
        for (int x = n2; x < NS; ++x) {
            PIPE_HEAD(x);
            const int j = tile - (x - n2);
            const float cb = -slope * (float)(t - 64 * j);
            if (PVAR & 4) {} else
            if (j == tile) attend_tile<true>(sw, lds + L_K + cur * 8192, lds + L_V + cur * 8192, qf, cb, slope, tq, -1, wscr, lane, r32, hi);
            else if (j == tile - 8) attend_tile<true>(sw, lds + L_K + cur * 8192, lds + L_V + cur * 8192, qf, cb, slope, 63, tq, wscr, lane, r32, hi);
            else attend_tile<false>(sw, lds + L_K + cur * 8192, lds + L_V + cur * 8192, qf, cb, slope, 63, -1, wscr, lane, r32, hi);
            PIPE_TAIL(x);
        }
        acc_rows<false>(accw, sw.o0, sw.o1, gs[2] / fmaxf(sw.l, 1e-30f), wscr, r32, hi);
    }
#undef GK
#undef GV
#undef PIPE_HEAD
#undef PIPE_TAIL
    if (!(PVAR & 16)) {
        const int q = tid >> 3, sub = tid & 7;
        unsigned kq[16];
#pragma unroll
        for (int i = 0; i < 16; ++i) {
            const int j = sub * 16 + i; float x = imp[q * 129 + j];
            if (j == 0 || j == tile || j == tile - 1) x = 1.0e4f;
            if (j > tile) x = -INFINITY;
            kq[i] = (psel::f2ord(x) & 0xFFFFFF80u) | (unsigned)(127 - j);
        }
        psel::sort16_desc(kq);
#pragma unroll
        for (int off = 1; off < 8; off <<= 1) {
            unsigned pb[16];
#pragma unroll
            for (int i = 0; i < 16; ++i) pb[i] = (unsigned)__shfl_xor((int)kq[i], off);
            psel::merge16_desc(kq, pb);
        }
        if (sub == 0) {
            unsigned w0 = 0u, w1 = 0u, w2 = 0u, w3 = 0u;
            const unsigned ninf = psel::f2ord(-INFINITY) & 0xFFFFFF80u;
#pragma unroll
            for (int i = 0; i < 16; ++i) {
                const int bj = 127 - (int)(kq[i] & 127u); const bool ok = (kq[i] & 0xFFFFFF80u) != ninf;
                const int k = bj >> 5; const unsigned bit = ok ? (1u << (bj & 31)) : 0u;
                w0 |= (k == 0) ? bit : 0u; w1 |= (k == 1) ? bit : 0u; w2 |= (k == 2) ? bit : 0u; w3 |= (k == 3) ? bit : 0u;
            }
            selm[q * 4 + 0] = w0; selm[q * 4 + 1] = w1; selm[q * 4 + 2] = w2; selm[q * 4 + 3] = w3;
            atomicOr((unsigned*)(uni + 0), w0); atomicOr((unsigned*)(uni + 1), w1); atomicOr((unsigned*)(uni + 2), w2); atomicOr((unsigned*)(uni + 3), w3);
        }
    }
    __syncthreads();
    {
        unsigned u0 = uni[0], u1 = uni[1], u2 = uni[2], u3 = uni[3];
        u0 = __builtin_amdgcn_readfirstlane(u0); u1 = __builtin_amdgcn_readfirstlane(u1); u2 = __builtin_amdgcn_readfirstlane(u2); u3 = __builtin_amdgcn_readfirstlane(u3);
        const unsigned s0 = selm[tq * 4 + 0], s1 = selm[tq * 4 + 1], s2 = selm[tq * 4 + 2], s3 = selm[tq * 4 + 3];
        Br sb_; sb_.m = -1e30f; sb_.l = 0.f;
#pragma unroll
        for (int r = 0; r < 16; ++r) { sb_.o0[r] = 0.f; sb_.o1[r] = 0.f; }
#define POP_BLOCK(j) do { if (u3) { const int bb = 31 - __builtin_clz(u3); u3 ^= 1u << bb; j = 96 + bb; } else if (u2) { const int bb = 31 - __builtin_clz(u2); u2 ^= 1u << bb; j = 64 + bb; } \
        else if (u1) { const int bb = 31 - __builtin_clz(u1); u1 ^= 1u << bb; j = 32 + bb; } else if (u0) { const int bb = 31 - __builtin_clz(u0); u0 ^= 1u << bb; j = bb; } else j = -1; } while (0)
        int j, j1, j2; POP_BLOCK(j); POP_BLOCK(j1); POP_BLOCK(j2);
        if (j1 >= 0) stage_load(KS + (size_t)j1 * 4096, VS + (size_t)j1 * 4096, wid, lane, sA, true);
        while (j >= 0) {
            if (j2 >= 0) stage_load(KS + (size_t)j2 * 4096, VS + (size_t)j2 * 4096, wid, lane, sB, true);
            const unsigned wsel = (j >> 5) == 0 ? s0 : (j >> 5) == 1 ? s1 : (j >> 5) == 2 ? s2 : s3;
            const bool mine = (wsel >> (j & 31)) & 1u;
            if (!(PVAR & 8) && __any(mine)) {
                const float cb = mine ? -slope * (float)(t - 64 * j) : -INFINITY;
                if (j == tile) attend_tile<true>(sb_, lds + L_K + cur * 8192, lds + L_V + cur * 8192, qf, cb, slope, tq, -1, wscr, lane, r32, hi);
                else attend_tile<false>(sb_, lds + L_K + cur * 8192, lds + L_V + cur * 8192, qf, cb, slope, 63, -1, wscr, lane, r32, hi);
            }
            if (j1 >= 0) stage_store(lds + L_K + (cur ^ 1) * 8192, lds + L_V + (cur ^ 1) * 8192, wid, lane, sA, true);
            ATT_BAR();
            cur ^= 1; sA = sB; j = j1; j1 = j2; POP_BLOCK(j2);
        }
#undef POP_BLOCK
        acc_rows<false>(accw, sb_.o0, sb_.o1, gs[1] / fmaxf(sb_.l, 1e-30f), wscr, r32, hi);
    }
    store_acc(accw, (bf16_t*)(p.ws + (PVAR ? WS_QP : WS_O)) + (size_t)(b * T + 64 * tile + 8 * wid) * D + g * 256, lane);
}

__device__ __forceinline__ void swa_unit(const Params& p, unsigned char* lds_generic, int b, int hh, int tile) {
    lptr lds = (lptr)lds_generic;
    const int tid = tid_opaque(), lane = tid & 63, wid = __builtin_amdgcn_readfirstlane(tid >> 6), r32 = lane & 31, hi = lane >> 5;
    const int h = r32 >> 3, qi = r32 & 7, tq = 8 * wid + qi, t = 64 * tile + tq, head = hh * 4 + h;
    const float slope = exp2f(-0.5f * (float)(head + 1)) * LOG2E;
    const unsigned char* ws = p.ws;
    ALAS float* wscr = (ALAS float*)(lds + L_WSCR) + wid * 64;
    const bf16_t* K = (const bf16_t*)(ws + WS_KSW) + (size_t)b * T * 64;
    const bf16_t* V = (const bf16_t*)(ws + WS_VSW) + (size_t)b * T * 64;
    bf16x8 qf[4];
    {
        const bf16_t* qp = (const bf16_t*)(ws + WS_QS) + ((size_t)(b * 8 + head) * T + t) * 64 + 8 * hi;
#pragma unroll
        for (int d0 = 0; d0 < 4; ++d0) qf[d0] = *(const bf16x8*)(qp + 16 * d0);
    }
    Br sw; sw.m = p.sinks[head] * LOG2E; sw.l = 1.0f;
#pragma unroll
    for (int r = 0; r < 16; ++r) { sw.o0[r] = 0.f; sw.o1[r] = 0.f; }
    const int jlo = (tile - 2 > 0) ? tile - 2 : 0;
    Stage sA, sB; int cur = 0;
    stage_load(K + (size_t)tile * 4096, V + (size_t)tile * 4096, wid, lane, sA, true);
    stage_store(lds + L_K, lds + L_V, wid, lane, sA, true);
    ATT_BAR();
    if (tile - 1 >= jlo) stage_load(K + (size_t)(tile - 1) * 4096, V + (size_t)(tile - 1) * 4096, wid, lane, sA, true);
    for (int j = tile; j >= jlo; --j) {
        if (j - 2 >= jlo) stage_load(K + (size_t)(j - 2) * 4096, V + (size_t)(j - 2) * 4096, wid, lane, sB, true);
        const float cb = -slope * (float)(t - 64 * j);
        if (j == tile) attend_tile<true>(sw, lds + L_K + cur * 8192, lds + L_V + cur * 8192, qf, cb, slope, tq, -1, wscr, lane, r32, hi);
        else if (j == tile - 2) attend_tile<true>(sw, lds + L_K + cur * 8192, lds + L_V + cur * 8192, qf, cb, slope, 63, tq, wscr, lane, r32, hi);
        else attend_tile<false>(sw, lds + L_K + cur * 8192, lds + L_V + cur * 8192, qf, cb, slope, 63, -1, wscr, lane, r32, hi);
        if (j > jlo) stage_store(lds + L_K + (cur ^ 1) * 8192, lds + L_V + (cur ^ 1) * 8192, wid, lane, sA, true);
        ATT_BAR();
        cur ^= 1; sA = sB;
    }
    ALAS float* accw = (ALAS float*)(lds + L_ACC) + wid * 2048;
    acc_rows<true>(accw, sw.o0, sw.o1, 1.0f / sw.l, wscr, r32, hi);
    store_acc(accw, (bf16_t*)(p.ws + WS_O) + (size_t)(b * T + 64 * tile + 8 * wid) * D + 512 + hh * 256, lane);
}
__device__ __forceinline__ void phase_swa_mfma(const Params& p, unsigned char* lds) {
    for (int u = blockIdx.x; u < BATCH * 2 * (T / 64); u += gridDim.x) swa_unit(p, lds, u >> 8, (u >> 7) & 1, u & 127);
}
template <int PVAR = 0>
__device__ __forceinline__ void phase_nsa_mfma(const Params& p, unsigned char* lds) {
    const int nu = BATCH * NSA_G * (T / 64);
    for (int i = blockIdx.x; i < nu; i += gridDim.x) {
        const int u = (i < (int)gridDim.x) ? (nu - 1 - i) : (i - (int)gridDim.x);
        nsa_unit<PVAR>(p, lds, u >> 8, (u >> 7) & 1, u & 127);
    }
}
}


namespace cmp {
#define CLAS __attribute__((address_space(3)))
constexpr int HS = 264;
__device__ __forceinline__ void compress_unit(const Params& p, unsigned char* lds_generic, int unit) {
    const unsigned char* ws = p.ws;
    const int tid = tid_opaque(), lane = tid & 63, wid = __builtin_amdgcn_readfirstlane(tid >> 6), fr = lane & 15, fq = lane >> 4;
    const int row0 = unit * 32, kv = row0 >> 11, bg = (row0 & 2047) >> 9, c0 = row0 & 511;
    const bf16_t* raw = (const bf16_t*)(ws + WS_KV6 + (size_t)kv * KV6_STRIDE) + (size_t)bg * T * 64;
    const bf16_t* W1T = (const bf16_t*)(ws + WS_W1T) + (size_t)kv * 256 * 2048;
    const bf16_t* W2T = (const bf16_t*)(ws + WS_W2T) + (size_t)kv * 64 * 256;
    const float* b1 = (const float*)(ws + WS_B1) + kv * 256;
    CLAS bf16_t* H = (CLAS bf16_t*)((CLAS unsigned char*)lds_generic);
    const int n0 = wid * 32;
    f32x4 acc[2][2];
#pragma unroll
    for (int i = 0; i < 2; ++i)
#pragma unroll
        for (int j = 0; j < 2; ++j) acc[i][j] = (f32x4){0.f, 0.f, 0.f, 0.f};
    const bf16_t* ap = raw + (size_t)(c0 + fr) * 1024 + fq * 8;
    const bf16_t* bp = W1T + (size_t)(n0 + fr) * 2048 + fq * 8;
    constexpr int PF = 4;
    bf16x8 a[PF][2], b[PF][2];
#pragma unroll
    for (int s = 0; s < PF; ++s)
#pragma unroll
        for (int i = 0; i < 2; ++i) { a[s][i] = *(const bf16x8*)(ap + (size_t)i * 16 * 1024 + 32 * s); b[s][i] = *(const bf16x8*)(bp + (size_t)i * 16 * 2048 + 32 * s); }
    for (int k0 = 0; k0 < 2048; k0 += 32 * PF) {
#pragma unroll
        for (int s = 0; s < PF; ++s) {
#pragma unroll
            for (int i = 0; i < 2; ++i)
#pragma unroll
                for (int j = 0; j < 2; ++j) acc[i][j] = __builtin_amdgcn_mfma_f32_16x16x32_bf16(a[s][i], b[s][j], acc[i][j], 0, 0, 0);
            const int kn = k0 + 32 * (PF + s);
            if (kn < 2048) {
#pragma unroll
                for (int i = 0; i < 2; ++i) { a[s][i] = *(const bf16x8*)(ap + (size_t)i * 16 * 1024 + kn); b[s][i] = *(const bf16x8*)(bp + (size_t)i * 16 * 2048 + kn); }
            }
        }
    }
#pragma unroll
    for (int i = 0; i < 2; ++i)
#pragma unroll
        for (int j = 0; j < 2; ++j) {
            const int n = n0 + 16 * j + fr; const float bias = b1[n];
#pragma unroll
            for (int r = 0; r < 4; ++r) H[(16 * i + 4 * fq + r) * HS + n] = (bf16_t)f2bf(gelu_tanh(acc[i][j][r] + bias));
        }
    __syncthreads();
    {
        const int mi = wid >> 2, nj = wid & 3;
        f32x4 o = (f32x4){0.f, 0.f, 0.f, 0.f};
        const CLAS bf16_t* hp = H + (16 * mi + fr) * HS + fq * 8;
        const bf16_t* wp = W2T + (size_t)(16 * nj + fr) * 256 + fq * 8;
#pragma unroll
        for (int k0 = 0; k0 < 256; k0 += 32) {
            const bf16x8 ha = *(const CLAS bf16x8*)(hp + k0), wb = *(const bf16x8*)(wp + k0);
            o = __builtin_amdgcn_mfma_f32_16x16x32_bf16(ha, wb, o, 0, 0, 0);
        }
        bf16_t* dst = (bf16_t*)(p.ws + (kv ? WS_VC : WS_KC)) + ((size_t)bg * NCMPP + c0 + 16 * mi + 4 * fq) * 64 + 16 * nj + fr;
#pragma unroll
        for (int r = 0; r < 4; ++r) dst[(size_t)r * 64] = (bf16_t)f2bf(o[r]);
    }
    __syncthreads();
}
__device__ __forceinline__ void phase_compress_swa(const Params& p, unsigned char* lds) {
    const int G = (int)gridDim.x, bx = (int)blockIdx.x;
    if (G >= 256) {
        if (bx < 128) { compress_unit(p, lds, bx); }
        else { for (int u = bx - 128; u < BATCH * 2 * (T / 64); u += G - 128) att::swa_unit(p, lds, u >> 8, (u >> 7) & 1, u & 127);
               convert_expert_tables(p, bx - 128, G - 128); }
    } else {
        for (int u = bx; u < 128; u += G) compress_unit(p, lds, u);
        for (int u = bx; u < BATCH * 2 * (T / 64); u += G) att::swa_unit(p, lds, u >> 8, (u >> 7) & 1, u & 127);
        convert_expert_tables(p, bx, G);
    }
}
}

#define XB_TMO      128
#define XB_XCNT(j)  (256  + 64 * (j))
#define XB_XSUB(j)  (1280 + 64 * (j))
#define XB_XGEN(j)  (2304 + 64 * (j))
#define XB_TOP      3328
#define XB_TOPGEN   3392
#define XCD_BAR_WORDS 3456
#define XB_SPIN_CAP (1u << 18)
#define XLAS __attribute__((address_space(3)))

__device__ __forceinline__ unsigned xb_ld(unsigned* p)              { return __hip_atomic_load(p, __ATOMIC_RELAXED, __HIP_MEMORY_SCOPE_AGENT); }
__device__ __forceinline__ unsigned xb_add(unsigned* p, unsigned v) { return __hip_atomic_fetch_add(p, v, __ATOMIC_RELAXED, __HIP_MEMORY_SCOPE_AGENT); }
__device__ __forceinline__ unsigned xb_xcc_id() { return (unsigned)__builtin_amdgcn_s_getreg((3 << 11) | 20) & 0xFu; }
#define XB_SPIN(cond, bar) do { unsigned _sp = 0; while (cond) { __builtin_amdgcn_s_sleep(1); \
    if ((++_sp & 255u) == 0u) { if (xb_ld(&(bar)[XB_TMO])) break; if (_sp > XB_SPIN_CAP) { atomicAdd(&(bar)[XB_TMO], 1u); break; } } } } while (0)

struct XcdBarrier {
    unsigned* bar; unsigned x;
    volatile XLAS unsigned* st;
};

__device__ __forceinline__ XcdBarrier xcd_barrier_post(unsigned* bar, volatile XLAS unsigned* st) {
    XcdBarrier b; b.bar = bar; b.x = xb_xcc_id(); b.st = st;
    if (threadIdx.x == 0) (void)xb_add(&bar[XB_XCNT(b.x)], 1u);
    return b;
}
__device__ __forceinline__ void xcd_barrier_complete(unsigned* bar, unsigned x, unsigned& nloc, unsigned& nx) {
    const unsigned G = gridDim.x * gridDim.y * gridDim.z;
    unsigned sum, cnt, mine, sp = 0u;
    for (;;) {
        sum = 0u; cnt = 0u; mine = 0u;
#pragma unroll
        for (unsigned j = 0; j < 16; ++j) { const unsigned c = xb_ld(&bar[XB_XCNT(j)]); sum += c; cnt += (c > 0u) ? 1u : 0u; mine = (j == x) ? c : mine; }
        if (sum == G) break;
        __builtin_amdgcn_s_sleep(1);
        if ((++sp & 255u) == 0u) { if (xb_ld(&bar[XB_TMO])) break; if (sp > XB_SPIN_CAP) { atomicAdd(&bar[XB_TMO], 1u); break; } }
    }
    nloc = mine > 0u ? mine : 1u; nx = cnt > 0u ? cnt : 1u;
}

__device__ __forceinline__ void xcd_barrier(const XcdBarrier& b) {
    asm volatile("s_waitcnt vmcnt(0)" ::: "memory");
    __syncthreads();
    if (threadIdx.x == 0) {
        unsigned* bar = b.bar;
        __builtin_amdgcn_s_waitcnt(0);
        unsigned nloc = b.st[0], nx = b.st[1];
        if (nloc == 0u) { xcd_barrier_complete(bar, b.x, nloc, nx); b.st[0] = nloc; b.st[1] = nx; }
        const unsigned old = xb_add(&bar[XB_XSUB(b.x)], 1u);
        const unsigned gen = old / nloc;
        if (old + 1u == (gen + 1u) * nloc) {
            __builtin_amdgcn_fence(__ATOMIC_RELEASE, "agent");
            asm volatile("s_waitcnt vmcnt(0)" ::: "memory");
            const unsigned og = xb_add(&bar[XB_TOP], 1u);
            const unsigned tg = og / nx;
            if (og + 1u == (tg + 1u) * nx) xb_add(&bar[XB_TOPGEN], 1u);
            else XB_SPIN(xb_ld(&bar[XB_TOPGEN]) == tg, bar);
            __builtin_amdgcn_fence(__ATOMIC_ACQUIRE, "agent");
            xb_add(&bar[XB_XGEN(b.x)], 1u);
            asm volatile("s_waitcnt vmcnt(0)" ::: "memory");
        } else {
            XB_SPIN(xb_ld(&bar[XB_XGEN(b.x)]) == gen, bar);
            __builtin_amdgcn_fence(__ATOMIC_ACQUIRE, "agent");
            asm volatile("s_waitcnt vmcnt(0)" ::: "memory");
        }
    }
    __syncthreads();
}


namespace pex {
constexpr int TOK_PER_TICKET = 8, NTICKET = NTOK / TOK_PER_TICKET;
__device__ __forceinline__ int claim(unsigned* ctr, int lane) {
    unsigned t = 0u;
    if (lane == 0) t = __hip_atomic_fetch_add(ctr, 1u, __ATOMIC_RELAXED, __HIP_MEMORY_SCOPE_AGENT);
    return __builtin_amdgcn_readfirstlane((int)t);
}
struct UMeta { int e_lo, e_hi; float g_lo, g_hi; u32x4 h0, h1; float ss; };
__device__ __forceinline__ void u_meta(const unsigned char* ws, int tok, int lane, unsigned loff, UMeta& m) {
    const int* ep = (const int*)(ws + WS_EIDX) + (size_t)tok * 128;
    m.e_lo = ep[lane]; m.e_hi = ep[64 + lane];
    const float* gp = (const float*)(ws + WS_GATE) + (size_t)tok * 128;
    m.g_lo = gp[lane]; m.g_hi = gp[64 + lane];
    const bf16_t* hg = (const bf16_t*)(ws + WS_H1G + (size_t)tok * D * 2) + loff;
    m.h0 = *(const u32x4*)hg; m.h1 = *(const u32x4*)(hg + 8);
    m.ss = ((const float*)(ws + WS_SS2))[tok];
}
constexpr int UB = 16;
__device__ __forceinline__ void u_task(const unsigned char* ws, int tok, int y, int lane, unsigned loff, const UMeta& m, int tok_next, UMeta& mn) {
    unsigned long long m0 = __ballot((m.e_lo >> 11) == y), m1 = __ballot((m.e_hi >> 11) == y);
    const unsigned char* U = ws + WS_U8;
    const int grp = (lane >> 3) & 7;
    bool first = true;
    f32x2 a2[8]; float rstd2 = 0.f;
    do {
        int slot[UB]; u32x4 uw[UB];
#pragma unroll
        for (int k = 0; k < UB; ++k) {
            int e = 0; slot[k] = -1;
            if (m0 != 0ull) { const int j = __builtin_ctzll(m0); m0 &= m0 - 1ull; slot[k] = j; e = __builtin_amdgcn_readlane(m.e_lo, j); }
            else if (m1 != 0ull) { const int j = __builtin_ctzll(m1); m1 &= m1 - 1ull; slot[k] = 64 + j; e = __builtin_amdgcn_readlane(m.e_hi, j); }
            if (slot[k] >= 0) uw[k] = *(const u32x4*)(U + (size_t)e * D + loff); else uw[k] = (u32x4){0u, 0u, 0u, 0u};
        }
        if (first) {
            if (tok_next >= 0) u_meta(ws, tok_next, lane, loff, mn);
            const u32x4 w0 = m.h0, w1 = m.h1;
            a2[0] = (f32x2){bflo(w0.x), bfhi(w0.x)}; a2[1] = (f32x2){bflo(w0.y), bfhi(w0.y)}; a2[2] = (f32x2){bflo(w0.z), bfhi(w0.z)}; a2[3] = (f32x2){bflo(w0.w), bfhi(w0.w)};
            a2[4] = (f32x2){bflo(w1.x), bfhi(w1.x)}; a2[5] = (f32x2){bflo(w1.y), bfhi(w1.y)}; a2[6] = (f32x2){bflo(w1.z), bfhi(w1.z)}; a2[7] = (f32x2){bflo(w1.w), bfhi(w1.w)};
            rstd2 = (1.0f / U8_SCALE) / sqrtf(m.ss * (1.0f / D) + EPS);
            first = false;
        }
#pragma unroll
        for (int hb = 0; hb < UB / 8; ++hb) {
            if (slot[8 * hb] < 0) break;
            float d[8];
#pragma unroll
            for (int k = 0; k < 8; ++k) {
                f32x2 dd = (f32x2){0.f, 0.f};
#pragma unroll
                for (int q = 0; q < 4; ++q) {
                    const f32x2 lo = __builtin_amdgcn_cvt_pk_f32_fp8((int)uw[8 * hb + k][q], false), hi = __builtin_amdgcn_cvt_pk_f32_fp8((int)uw[8 * hb + k][q], true);
                    dd += a2[2 * q] * lo; dd += a2[2 * q + 1] * hi;
                }
                d[k] = dd.x + dd.y;
                __builtin_amdgcn_sched_barrier(0);
            }
            const float dk = reduce8(d, lane);
            int myslot = -1;
#pragma unroll
            for (int k = 0; k < 8; ++k) myslot = (grp == k) ? slot[8 * hb + k] : myslot;
            const float gA = __shfl(m.g_lo, myslot & 63), gB = __shfl(m.g_hi, myslot & 63);
            const float g = (myslot & 64) ? gB : gA;
            if (myslot >= 0 && (lane & 7) == 0) ((float*)(ws + WS_PW))[(size_t)tok * 128 + myslot] = g * gelu_tanh(dk * rstd2);
        }
    } while ((m0 | m1) != 0ull);
}
struct VMeta { u32x4 e[4]; };
__device__ __forceinline__ void v_meta(const Params& p, int tok, int y, int lane, VMeta& m) {
    const unsigned char* ep = p.ws + WS_EIDX + (size_t)tok * 512;
    const unsigned eoff = (unsigned)(lane >> 3) * 64u;
#pragma unroll
    for (int q = 0; q < 4; ++q) m.e[q] = *(const u32x4*)(ep + eoff + 16 * q);
}
__device__ __forceinline__ void ucol_task(const Params& p, int tok, int y, int lane, const VMeta& m, int tok_next, VMeta& mn) {
    const int cc = lane & 7;
    const bool b2 = lane & 4, b1 = lane & 2, b0 = lane & 1;
    const __amdgpu_buffer_rsrc_t ru = __builtin_amdgcn_make_buffer_rsrc((void*)(p.ws + WS_U8 + (size_t)y * ((size_t)NEXP * 128)), (short)0, NEXP * 128, 0x00020000);
    const unsigned coff = (unsigned)cc * 16u;
    u32x4 uw[16];
#pragma unroll
    for (int q = 0; q < 4; ++q) {
        uw[4 * q] = __builtin_bit_cast(u32x4, __builtin_amdgcn_raw_buffer_load_b128(ru, (int)(m.e[q].x * 128u + coff), 0, 0));
        uw[4 * q + 1] = __builtin_bit_cast(u32x4, __builtin_amdgcn_raw_buffer_load_b128(ru, (int)(m.e[q].y * 128u + coff), 0, 0));
        uw[4 * q + 2] = __builtin_bit_cast(u32x4, __builtin_amdgcn_raw_buffer_load_b128(ru, (int)(m.e[q].z * 128u + coff), 0, 0));
        uw[4 * q + 3] = __builtin_bit_cast(u32x4, __builtin_amdgcn_raw_buffer_load_b128(ru, (int)(m.e[q].w * 128u + coff), 0, 0));
    }
    f32x2 a2[8];
    {
        const unsigned char* hp = p.ws + WS_H1G + (size_t)tok * D * 2 + (size_t)y * 256;
        const u32x4 w0 = *(const u32x4*)(hp + cc * 32u), w1 = *(const u32x4*)(hp + cc * 32u + 16u);
        a2[0] = (f32x2){bflo(w0.x), bfhi(w0.x)}; a2[1] = (f32x2){bflo(w0.y), bfhi(w0.y)}; a2[2] = (f32x2){bflo(w0.z), bfhi(w0.z)}; a2[3] = (f32x2){bflo(w0.w), bfhi(w0.w)};
        a2[4] = (f32x2){bflo(w1.x), bfhi(w1.x)}; a2[5] = (f32x2){bflo(w1.y), bfhi(w1.y)}; a2[6] = (f32x2){bflo(w1.z), bfhi(w1.z)}; a2[7] = (f32x2){bflo(w1.w), bfhi(w1.w)};
    }
    if (tok_next >= 0) v_meta(p, tok_next, y, lane, mn);
    float d[16];
#pragma unroll
    for (int i = 0; i < 16; ++i) {
        f32x2 dd = (f32x2){0.f, 0.f};
#pragma unroll
        for (int q = 0; q < 4; ++q) {
            const f32x2 lo = __builtin_amdgcn_cvt_pk_f32_fp8((int)uw[i][q], false), hi = __builtin_amdgcn_cvt_pk_f32_fp8((int)uw[i][q], true);
            dd += a2[2 * q] * lo; dd += a2[2 * q + 1] * hi;
        }
        d[i] = dd.x + dd.y;
        __builtin_amdgcn_sched_barrier(0);
    }
    float s8[8], s4[4], s2[2];
#pragma unroll
    for (int i = 0; i < 8; ++i) { const float snd = b2 ? d[i] : d[i + 8], keep = b2 ? d[i + 8] : d[i]; s8[i] = keep + __shfl_xor(snd, 4); }
#pragma unroll
    for (int i = 0; i < 4; ++i) { const float snd = b1 ? s8[i] : s8[i + 4], keep = b1 ? s8[i + 4] : s8[i]; s4[i] = keep + __shfl_xor(snd, 2); }
#pragma unroll
    for (int i = 0; i < 2; ++i) { const float snd = b0 ? s4[i] : s4[i + 2], keep = b0 ? s4[i + 2] : s4[i]; s2[i] = keep + __shfl_xor(snd, 1); }
    const unsigned so = (unsigned)(16 * (lane >> 3) + (b2 ? 8 : 0) + (b1 ? 4 : 0) + (b0 ? 2 : 0)) * 4u;
    *(f32x2*)(p.ws + WS_PART + ((size_t)tok * 8 + y) * 512 + so) = (f32x2){s2[0], s2[1]};
}
__device__ __forceinline__ void phase_expert_act(const Params& p) {
    const int tid_ = tid_opaque(), lane = tid_ & 63;
    const int gw = (int)blockIdx.x * (NTHREADS / 64) + __builtin_amdgcn_readfirstlane(tid_ >> 6), ngw = (int)gridDim.x * (NTHREADS / 64);
    for (int tok = gw; tok < NTOK; tok += ngw) {
        const float* pp = (const float*)(p.ws + WS_PART) + (size_t)tok * 1024;
        float sa = 0.f, sb = 0.f;
#pragma unroll
        for (int y = 0; y < 8; ++y) { sa += pp[y * 128 + lane]; sb += pp[y * 128 + 64 + lane]; }
        const float rstd2 = (1.0f / U8_SCALE) / sqrtf(((const float*)(p.ws + WS_SS2))[tok] * (1.0f / D) + EPS);
        const float* gp = (const float*)(p.ws + WS_GATE) + (size_t)tok * 128;
        float* wp = (float*)(p.ws + WS_PW) + (size_t)tok * 128;
        wp[lane] = gp[lane] * gelu_tanh(sa * rstd2);
        wp[64 + lane] = gp[64 + lane] * gelu_tanh(sb * rstd2);
    }
}
__device__ __forceinline__ void v_task(const Params& p, int tok, int y, int lane, const VMeta& m, int tok_next, VMeta& mn) {
    const int cc = lane & 7;
    const bool b5 = lane & 32, b4 = lane & 16, b3 = lane & 8;
    const __amdgpu_buffer_rsrc_t rv = __builtin_amdgcn_make_buffer_rsrc((void*)(p.ws + WS_V8 + (size_t)y * ((size_t)NEXP * 128)), (short)0, NEXP * 128, 0x00020000);
    const unsigned coff = (unsigned)cc * 16u;
    u32x4 vw[16];
#pragma unroll
    for (int q = 0; q < 4; ++q) {
        vw[4 * q] = __builtin_bit_cast(u32x4, __builtin_amdgcn_raw_buffer_load_b128(rv, (int)(m.e[q].x * 128u + coff), 0, 0));
        vw[4 * q + 1] = __builtin_bit_cast(u32x4, __builtin_amdgcn_raw_buffer_load_b128(rv, (int)(m.e[q].y * 128u + coff), 0, 0));
        vw[4 * q + 2] = __builtin_bit_cast(u32x4, __builtin_amdgcn_raw_buffer_load_b128(rv, (int)(m.e[q].z * 128u + coff), 0, 0));
        vw[4 * q + 3] = __builtin_bit_cast(u32x4, __builtin_amdgcn_raw_buffer_load_b128(rv, (int)(m.e[q].w * 128u + coff), 0, 0));
    }
    f32x4 w[4];
    {
        const unsigned char* wp = p.ws + WS_PW + (size_t)tok * 512;
        const unsigned woff = (unsigned)(lane >> 3) * 64u;
#pragma unroll
        for (int q = 0; q < 4; ++q) w[q] = *(const f32x4*)(wp + woff + 16 * q);
    }
    const unsigned colb = (unsigned)(128 * y + 16 * cc + (b5 ? 8 : 0) + (b4 ? 4 : 0) + (b3 ? 2 : 0)) * 4u;
    float* orow = (float*)((unsigned char*)p.out + (size_t)tok * D * 4);
    const f32x2 h = *(const f32x2*)((const unsigned char*)orow + colb);
    if (tok_next >= 0) v_meta(p, tok_next, y, lane, mn);
    f32x2 acc2[8];
#pragma unroll
    for (int q = 0; q < 8; ++q) acc2[q] = (f32x2){0.f, 0.f};
#pragma unroll
    for (int i = 0; i < 16; ++i) {
        const float wi = w[i >> 2][i & 3];
#pragma unroll
        for (int q = 0; q < 4; ++q) {
            const f32x2 lo = __builtin_amdgcn_cvt_pk_f32_fp8((int)vw[i][q], false), hi = __builtin_amdgcn_cvt_pk_f32_fp8((int)vw[i][q], true);
            acc2[2 * q] += lo * wi; acc2[2 * q + 1] += hi * wi;
        }
        __builtin_amdgcn_sched_barrier(0);
    }
    float acc[16];
#pragma unroll
    for (int q = 0; q < 8; ++q) { acc[2 * q] = acc2[q].x; acc[2 * q + 1] = acc2[q].y; }
    float s8[8], s4[4], s2[2];
#pragma unroll
    for (int i = 0; i < 8; ++i) { const float snd = b5 ? acc[i] : acc[i + 8], keep = b5 ? acc[i + 8] : acc[i]; s8[i] = keep + __shfl_xor(snd, 32); }
#pragma unroll
    for (int i = 0; i < 4; ++i) { const float snd = b4 ? s8[i] : s8[i + 4], keep = b4 ? s8[i + 4] : s8[i]; s4[i] = keep + __shfl_xor(snd, 16); }
#pragma unroll
    for (int i = 0; i < 2; ++i) { const float snd = b3 ? s4[i] : s4[i + 2], keep = b3 ? s4[i + 2] : s4[i]; s2[i] = keep + __shfl_xor(snd, 8); }
    *(f32x2*)((unsigned char*)orow + colb) = (f32x2){h.x + s2[0] * (1.0f / V8_SCALE), h.y + s2[1] * (1.0f / V8_SCALE)};
}
template <bool VPHASE, int PROBE = 0>
__device__ __forceinline__ void phase_sliced(const Params& p_in) {
    Params p = p_in; if (PROBE) p.out = (float*)(p_in.ws + WS_QP);
    const int tid_ = tid_opaque(), lane = tid_ & 63;
    const unsigned loff = 16u * (unsigned)lane;
    unsigned* ctr = (unsigned*)(p.ws + WS_CTR + (VPHASE ? 2048 : 0) + PROBE * 4096);
    const int x0 = (int)(xb_xcc_id() & 7u);
    for (int k = 0; k < 8; ++k) {
        const int y = (x0 + k) & 7;
        int tk = claim(ctr + y * 64, lane);
        if (tk >= NTICKET) continue;
        VMeta vm, vmn;
        v_meta(p, tk * TOK_PER_TICKET, y, lane, vm);
        while (tk < NTICKET) {
            const int tkn = claim(ctr + y * 64, lane);
#pragma unroll 1
            for (int i = 0; i < TOK_PER_TICKET; ++i) {
                const int tok = tk * TOK_PER_TICKET + i;
                const int tok_next = (i + 1 < TOK_PER_TICKET) ? tok + 1 : ((tkn < NTICKET) ? tkn * TOK_PER_TICKET : -1);
                if (VPHASE) { v_task(p, tok, y, lane, vm, tok_next, vmn); vm = vmn; }
                else { ucol_task(p, tok, y, lane, vm, tok_next, vmn); vm = vmn; }
            }
            tk = tkn;
        }
    }
}
__device__ __forceinline__ void phase_final_norm(const Params& p) {
    const int tid_ = tid_opaque(), lane = tid_ & 63;
    const int gw = (int)blockIdx.x * (NTHREADS / 64) + __builtin_amdgcn_readfirstlane(tid_ >> 6), ngw = (int)gridDim.x * (NTHREADS / 64);
    const unsigned loff = 16u * (unsigned)lane;
    f32x4 g[4];
#pragma unroll
    for (int q = 0; q < 4; ++q) g[q] = *(const f32x4*)(p.lnf_g + loff + 4 * q);
    for (int tok = gw; tok < NTOK; tok += ngw) {
        float* orow = (float*)((unsigned char*)p.out + (size_t)tok * D * 4) + loff;
        f32x4 y[4]; float ss = 0.f;
#pragma unroll
        for (int q = 0; q < 4; ++q) { y[q] = *(const f32x4*)(orow + 4 * q); ss += (y[q].x * y[q].x + y[q].y * y[q].y) + (y[q].z * y[q].z + y[q].w * y[q].w); }
        const float rstd = 1.0f / sqrtf(wave_sum(ss) * (1.0f / D) + EPS);
#pragma unroll
        for (int q = 0; q < 4; ++q) *(f32x4*)(orow + 4 * q) = (f32x4){y[q].x * rstd * g[q].x, y[q].y * rstd * g[q].y, y[q].z * rstd * g[q].z, y[q].w * rstd * g[q].w};
    }
}
}

constexpr int LDS_BYTES = 147456;
extern __shared__ __attribute__((aligned(16))) unsigned char dyn_lds[];

__device__ __forceinline__ Params load_params() {
#if !defined(__HIP_DEVICE_COMPILE__)
    return Params{};
#else
    const __attribute__((address_space(4))) unsigned char* ka = (const __attribute__((address_space(4))) unsigned char*)__builtin_amdgcn_kernarg_segment_ptr();
    asm volatile("" : "+s"(ka));
    const __attribute__((address_space(4))) Params* kp = (const __attribute__((address_space(4))) Params*)ka;
    Params r;
    r.x = kp->x; r.ln1_g = kp->ln1_g; r.w_in = kp->w_in; r.pe_k = kp->pe_k; r.w1_k = kp->w1_k; r.w2_k = kp->w2_k; r.pe_v = kp->pe_v; r.w1_v = kp->w1_v; r.w2_v = kp->w2_v;
    r.sinks = kp->sinks; r.w_out = kp->w_out; r.ln2_g = kp->ln2_g; r.wq = kp->wq; r.pkeys = kp->pkeys; r.pu = kp->pu; r.pv = kp->pv; r.lnf_g = kp->lnf_g; r.out = kp->out; r.ws = kp->ws;
    return r;
#endif
}
__global__ void __launch_bounds__(NTHREADS, 2) fwd_megakernel(Params p_unused) {
    cg::grid_group grid = cg::this_grid();
    float* lds = (float*)dyn_lds;
    PG8_LAS unsigned char* ldsp = (PG8_LAS unsigned char*)dyn_lds;
    volatile XLAS unsigned* bst = (volatile XLAS unsigned*)((XLAS unsigned char*)dyn_lds + (LDS_BYTES - 16));
    if (threadIdx.x < 4) bst[threadIdx.x] = 0u;
    __syncthreads();
    { const Params p = load_params(); (void)xcd_barrier_post((unsigned*)(p.ws + WS_BAR), bst); }
#define GRID_BARRIER() do { const Params p_ = load_params(); XcdBarrier xb_; xb_.bar = (unsigned*)(p_.ws + WS_BAR); xb_.x = xb_xcc_id(); \
        xb_.st = (volatile XLAS unsigned*)((XLAS unsigned char*)dyn_lds + (LDS_BYTES - 16)); xcd_barrier(xb_); } while (0)
    for (int rep = 0; rep < 1 + PROBE_PREP; ++rep) { const Params p = load_params(); phase_prep(p); }
    if (gridDim.y == 0x7fffu) grid.sync();
    GRID_BARRIER();
    for (int rep = 0; rep < 1 + PROBE_PROJ; ++rep) { const Params p = load_params();
      pg8::Gemm g{(const bf16_t*)(p.ws + WS_XN), (const bf16_t*)(p.ws + WS_WIN), NTOK, DINP, D}; pg8::StaticOrder S; S.init(NTOK, DINP, (int)gridDim.x, (int)blockIdx.x);
      EpiProjT E{p.ws}; pg8::gemm_phase<EpiProjT, pg8::StaticOrder, true, true>(ldsp, g, S, E); }
    GRID_BARRIER();
    for (int rep = 0; rep < 1 + PROBE_CS; ++rep) { const Params p = load_params(); cmp::phase_compress_swa(p, dyn_lds); }
    GRID_BARRIER();
    { const Params p = load_params(); att::phase_nsa_mfma<0>(p, dyn_lds); }
#if PROBE_NSA
    { const Params p = load_params(); att::phase_nsa_mfma<PROBE_NSA>(p, dyn_lds); }
#endif
    GRID_BARRIER();
    { const Params p = load_params();
      pg8::Gemm g{(const bf16_t*)(p.ws + WS_O), (const bf16_t*)(p.ws + WS_WOUT), NTOK, D, D}; pg8::StaticOrder S; S.init(NTOK, D, (int)gridDim.x, (int)blockIdx.x);
      EpiOutT E{p.x, p.ln2_g, p.out, (bf16_t*)(p.ws + WS_H1G), (float*)(p.ws + WS_SS2)}; pg8::gemm_phase<EpiOutT, pg8::StaticOrder, true, true>(ldsp, g, S, E); }
    GRID_BARRIER();
    for (int rep = 0; rep < 1 + PROBE_QP; ++rep) { const Params p = load_params();
      pg8::Gemm g{(const bf16_t*)(p.ws + WS_H1G), (const bf16_t*)(p.ws + WS_WQ), NTOK, PQ, D}; pg8::StaticOrder S; S.init(NTOK, PQ, (int)gridDim.x, (int)blockIdx.x);
      EpiQPT E{(const float*)(p.ws + WS_SS2), (bf16_t*)(p.ws + WS_QP)}; pg8::gemm_phase<EpiQPT, pg8::StaticOrder, true, true>(ldsp, g, S, E); }
    GRID_BARRIER();
    for (int rep = 0; rep < 1 + PROBE_SEL; ++rep) { const Params p = load_params(); psel::phase_peer_select(p, dyn_lds); }
    GRID_BARRIER();
    { const Params p = load_params(); pex::phase_sliced<false>(p); }
#if PROBE_PEXU
    { const Params p = load_params(); pex::phase_sliced<false, 1>(p); }
#endif
    GRID_BARRIER();
    for (int rep = 0; rep < 1 + PROBE_ACT; ++rep) { const Params p = load_params(); pex::phase_expert_act(p); }
    GRID_BARRIER();
    { const Params p = load_params(); pex::phase_sliced<true>(p); }
#if PROBE_PEXV
    { const Params p = load_params(); pex::phase_sliced<true, 1>(p); }
#endif
    GRID_BARRIER();
    { const Params p = load_params(); pex::phase_final_norm(p); }
}

extern "C" void kernel_launch(void* const* d_in, const int* in_sizes, int n_in, void* d_out, int out_size, void* d_ws, size_t ws_size, hipStream_t stream) {
    if (n_in != 17 || ws_size < WS_END) { fprintf(stderr, "kernel_launch: unexpected inputs (n_in %d, ws %zu)\n", n_in, ws_size); return; }
    static int grid_blocks = 0;
    if (!grid_blocks) {
        int dev = 0, cus = 0, per_cu = 0;
        (void)hipGetDevice(&dev);
        (void)hipDeviceGetAttribute(&cus, hipDeviceAttributeMultiprocessorCount, dev);
        (void)hipFuncSetAttribute((const void*)fwd_megakernel, hipFuncAttributeMaxDynamicSharedMemorySize, LDS_BYTES);
        (void)hipOccupancyMaxActiveBlocksPerMultiprocessor(&per_cu, (const void*)fwd_megakernel, NTHREADS, LDS_BYTES);
        if (per_cu < 1) per_cu = 1;
        grid_blocks = cus * per_cu;
        fprintf(stderr, "kernel_launch: %d CUs x %d blocks/CU\n", cus, per_cu);
    }
    Params p{};
    p.x = (const float*)d_in[0]; p.ln1_g = (const float*)d_in[1]; p.w_in = (const float*)d_in[2];
    p.pe_k = (const float*)d_in[3]; p.w1_k = (const float*)d_in[4]; p.w2_k = (const float*)d_in[5];
    p.pe_v = (const float*)d_in[6]; p.w1_v = (const float*)d_in[7]; p.w2_v = (const float*)d_in[8];
    p.sinks = (const float*)d_in[9]; p.w_out = (const float*)d_in[10]; p.ln2_g = (const float*)d_in[11];
    p.wq = (const float*)d_in[12]; p.pkeys = (const float*)d_in[13]; p.pu = (const float*)d_in[14]; p.pv = (const float*)d_in[15];
    p.lnf_g = (const float*)d_in[16];
    p.out = (float*)d_out; p.ws = (unsigned char*)d_ws;
    (void)hipMemsetAsync((unsigned char*)d_ws + WS_BAR, 0, 16 * 1024 + 8192, stream);
    void* args[] = {&p};
    hipError_t e = hipLaunchCooperativeKernel((void*)fwd_megakernel, dim3(grid_blocks), dim3(NTHREADS), args, LDS_BYTES, stream);
    if (e != hipSuccess) fprintf(stderr, "cooperative launch failed: %s (grid %d)\n", hipGetErrorString(e), grid_blocks);
}
```

```cpp
#include <hip/hip_runtime.h>
#include <hip/hip_cooperative_groups.h>
#include <cstdint>
#include <cstdio>
namespace cg = cooperative_groups;
#define PROBE_PREP 0
#define PROBE_COMPRESS 0
#define PROBE_SWA 0
#define PROBE_NSA 0
#define PROBE_SUB 0
#define PROBE_COMB 0
#define PROBE_PEXU 0
#define PROBE_PEXV 0
#define PROBE_PROJ 0
#define PROBE_QP 0
#define PROBE_SEL 0
#define PROBE_CS 0
#define PROBE_ACT 0

typedef unsigned short bf16_t;
typedef short bf16x8 __attribute__((ext_vector_type(8)));
typedef float f32x4 __attribute__((ext_vector_type(4)));
typedef unsigned u32x4 __attribute__((ext_vector_type(4)));
typedef unsigned u32x2 __attribute__((ext_vector_type(2)));

constexpr int BATCH = 2, T = 8192, D = 1024, NTOK = BATCH * T;
constexpr int HD = 64, NSA_H = 8, NSA_G = 2, NSA_HG = 4, SWA_H = 8;
constexpr int DIN = 1944, DINP = 2048;
constexpr int NCMP = 511, NCMPP = 512, NSEL = 128, TOPN = 16;
constexpr int NSA_WIN = 512, SWA_WIN = 128;
constexpr int PH = 8, PNK = 128, PDK = 256, PTOPK = 16, PQ = PH * PDK;
constexpr int NEXP = PNK * PNK;
constexpr float EPS = 1e-6f;
constexpr int NTHREADS = 512;
constexpr bool U_FP4 = true, V_FP4 = true;

constexpr size_t MiB = 1u << 20;
constexpr size_t WS_SS2 = 0;
constexpr size_t WS_BAR = 128 * 1024;
constexpr size_t WS_WIN = 1 * MiB;
constexpr size_t WS_WOUT = 5 * MiB;
constexpr size_t WS_WQ = 7 * MiB;
constexpr size_t WS_PKEYS = 11 * MiB;
constexpr size_t WS_W1T = 12 * MiB;
constexpr size_t WS_W2T = 14 * MiB;
constexpr size_t WS_B1 = 14 * MiB + 512 * 1024;
constexpr size_t WS_XN = 16 * MiB;
constexpr size_t WS_O = WS_XN;
constexpr size_t WS_H2 = WS_XN;
constexpr size_t WS_QN = 48 * MiB;
constexpr size_t WS_QS = 64 * MiB;
constexpr size_t WS_KV6 = 80 * MiB;
constexpr size_t KV6_STRIDE = 4 * MiB;
constexpr size_t WS_KSW = 104 * MiB;
constexpr size_t WS_VSW = 106 * MiB;
constexpr size_t WS_GSIG = 108 * MiB;
constexpr size_t WS_KC = 110 * MiB;
constexpr size_t WS_VC = 110 * MiB + 512 * 1024;
constexpr size_t WS_H1G = 48 * MiB;
constexpr size_t WS_QP = 80 * MiB;
constexpr size_t WS_EIDX = 144 * MiB;
constexpr size_t WS_GATE = 152 * MiB;
constexpr size_t WS_U8 = 160 * MiB;
constexpr size_t WS_PART = 80 * MiB;
constexpr size_t WS_V8 = 176 * MiB;
constexpr size_t WS_PW = 224 * MiB;
constexpr size_t WS_CTR = 128 * 1024 + 16 * 1024;
constexpr size_t WS_TOPV2 = 224 * MiB;
constexpr size_t WS_TOPI2 = 240 * MiB;
constexpr size_t WS_END = 256 * MiB;

struct Params {
    const float* x; const float* ln1_g; const float* w_in;
    const float* pe_k; const float* w1_k; const float* w2_k;
    const float* pe_v; const float* w1_v; const float* w2_v;
    const float* sinks; const float* w_out; const float* ln2_g;
    const float* wq; const float* pkeys; const float* pu; const float* pv; const float* lnf_g;
    float* out; unsigned char* ws;
};

__device__ __forceinline__ int tid_opaque() { int t = (int)threadIdx.x; asm volatile("" : "+v"(t)); return t; }
__device__ __forceinline__ unsigned f2bf(float f) { unsigned u = __float_as_uint(f); return (u + 0x7fffu + ((u >> 16) & 1u)) >> 16; }
__device__ __forceinline__ float bf2f(unsigned h) { return __uint_as_float(h << 16); }
__device__ __forceinline__ float bflo(unsigned w) { return __uint_as_float(w << 16); }
__device__ __forceinline__ float bfhi(unsigned w) { return __uint_as_float(w & 0xffff0000u); }
__device__ __forceinline__ unsigned pk2(float lo, float hi) { return f2bf(lo) | (f2bf(hi) << 16); }
__device__ __forceinline__ float wave_sum(float v) {
#pragma unroll
    for (int o = 1; o < 64; o <<= 1) v += __shfl_xor(v, o);
    return v;
}
__device__ __forceinline__ float gelu_tanh(float x) {
    const float u = 0.7978845608028654f * (x + 0.044715f * x * x * x);
    return 0.5f * x * (1.0f + tanhf(u));
}
__device__ __forceinline__ int win_orig_col(int n) {
    if (n < 1280) return n;
    if (n < 1792) return 1304 + (n - 1280);
    if (n < 1856) return 1816 + (n - 1792);
    if (n < 1920) return 1880 + (n - 1856);
    if (n < 1944) return 1280 + (n - 1920);
    return -1;
}

template <bool WIN_MAP>
__device__ __forceinline__ void prep_transpose(const float* W, int K, int N, int NP, bf16_t* WT, long gt, long ngt) {
    const long items = (long)NP * (K / 8);
    for (long it = gt; it < items; it += ngt) {
        const int n = (int)(it % NP), k0 = (int)(it / NP) * 8;
        const int col = WIN_MAP ? win_orig_col(n) : n;
        float v[8];
#pragma unroll
        for (int i = 0; i < 8; ++i) v[i] = (col >= 0) ? W[(size_t)(k0 + i) * N + col] : 0.f;
        u32x4 o; o.x = pk2(v[0], v[1]); o.y = pk2(v[2], v[3]); o.z = pk2(v[4], v[5]); o.w = pk2(v[6], v[7]);
        *(u32x4*)(WT + (size_t)n * K + k0) = o;
    }
}
__device__ __forceinline__ void prep_convert(const float* src, bf16_t* dst, long n8, long gt, long ngt) {
    for (long it = gt; it < n8; it += ngt) {
        const f32x4 a = *(const f32x4*)(src + it * 8), b = *(const f32x4*)(src + it * 8 + 4);
        u32x4 o; o.x = pk2(a.x, a.y); o.y = pk2(a.z, a.w); o.z = pk2(b.x, b.y); o.w = pk2(b.z, b.w);
        *(u32x4*)(dst + it * 8) = o;
    }
}
constexpr float U8_SCALE = 256.0f, V8_SCALE = 16.0f;
constexpr float U4_SCALE = 64.0f, V4_SCALE = 5.656854249f;
constexpr int NSL4 = 4;
__device__ __forceinline__ void prep_convert_fp8(const float* src, unsigned char* dst, long n16, float sc, long gt, long ngt) {
    for (long it = gt; it < n16; it += ngt) {
        u32x4 o;
#pragma unroll
        for (int q = 0; q < 4; ++q) {
            const f32x4 a = *(const f32x4*)(src + it * 16 + q * 4);
            int w = 0;
            w = __builtin_amdgcn_cvt_pk_fp8_f32(a.x * sc, a.y * sc, w, false);
            w = __builtin_amdgcn_cvt_pk_fp8_f32(a.z * sc, a.w * sc, w, true);
            o[q] = (unsigned)w;
        }
        *(u32x4*)(dst + it * 16) = o;
    }
}
__device__ __forceinline__ void prep_convert_fp8_sliced(const float* src, unsigned char* dst, long n16, float sc, long gt, long ngt) {
    for (long it = gt; it < n16; it += ngt) {
        u32x4 o;
#pragma unroll
        for (int q = 0; q < 4; ++q) {
            const f32x4 a = *(const f32x4*)(src + it * 16 + q * 4);
            int w = 0;
            w = __builtin_amdgcn_cvt_pk_fp8_f32(a.x * sc, a.y * sc, w, false);
            w = __builtin_amdgcn_cvt_pk_fp8_f32(a.z * sc, a.w * sc, w, true);
            o[q] = (unsigned)w;
        }
        const long e = (it * 16) >> 10; const int col = (int)((it * 16) & 1023);
        *(u32x4*)(dst + (size_t)(col >> 7) * ((size_t)NEXP * 128) + e * 128 + (col & 127)) = o;
    }
}
__device__ __forceinline__ void prep_convert_fp4_sliced(const float* src, unsigned char* dst, long n32, float sc, long gt, long ngt) {
    for (long it = gt; it < n32; it += ngt) {
        u32x4 o;
#pragma unroll
        for (int q = 0; q < 4; ++q) {
            const f32x4 a = *(const f32x4*)(src + it * 32 + q * 8), b = *(const f32x4*)(src + it * 32 + q * 8 + 4);
            unsigned w = 0u;
            w = __builtin_amdgcn_cvt_scalef32_pk_fp4_f32(w, a.x * sc, a.y * sc, 1.0f, 0);
            w = __builtin_amdgcn_cvt_scalef32_pk_fp4_f32(w, a.z * sc, a.w * sc, 1.0f, 1);
            w = __builtin_amdgcn_cvt_scalef32_pk_fp4_f32(w, b.x * sc, b.y * sc, 1.0f, 2);
            w = __builtin_amdgcn_cvt_scalef32_pk_fp4_f32(w, b.z * sc, b.w * sc, 1.0f, 3);
            o[q] = w;
        }
        const long e = (it * 32) >> 10; const int col = (int)((it * 32) & 1023);
        *(u32x4*)(dst + (size_t)(col >> 8) * ((size_t)NEXP * 128) + e * 128 + ((col & 255) >> 1)) = o;
    }
}
__device__ __forceinline__ void convert_expert_tables(const Params& p, int bi, int nblk) {
    const long gt = (long)bi * NTHREADS + tid_opaque(), ngt = (long)nblk * NTHREADS;
    if (U_FP4) prep_convert_fp4_sliced(p.pu, p.ws + WS_U8, (long)NEXP * D / 32, U4_SCALE, gt, ngt);
    else prep_convert_fp8_sliced(p.pu, p.ws + WS_U8, (long)NEXP * D / 16, U8_SCALE, gt, ngt);
    if (V_FP4) prep_convert_fp4_sliced(p.pv, p.ws + WS_V8, (long)NEXP * D / 32, V4_SCALE, gt, ngt);
    else prep_convert_fp8_sliced(p.pv, p.ws + WS_V8, (long)NEXP * D / 16, V8_SCALE, gt, ngt);
}
__device__ __forceinline__ void phase_prep(const Params& p) {
    const long gt = (long)blockIdx.x * NTHREADS + tid_opaque(), ngt = (long)gridDim.x * NTHREADS;
    const int lane = tid_opaque() & 63;
    const long gw = gt >> 6, ngw = ngt >> 6;
    unsigned char* ws = p.ws;
    for (long m = gw; m < NTOK; m += ngw) {
        const f32x4* xr = (const f32x4*)(p.x + (size_t)m * D) + lane;
        f32x4 v[4]; float s = 0.f;
#pragma unroll
        for (int j = 0; j < 4; ++j) { v[j] = xr[64 * j]; s += (v[j].x * v[j].x + v[j].y * v[j].y) + (v[j].z * v[j].z + v[j].w * v[j].w); }
        const float rstd = 1.0f / sqrtf(wave_sum(s) * (1.0f / D) + EPS);
        u32x2* o = (u32x2*)((bf16_t*)(ws + WS_XN) + (size_t)m * D) + lane;
#pragma unroll
        for (int j = 0; j < 4; ++j) {
            const f32x4 g = *((const f32x4*)p.ln1_g + lane + 64 * j);
            u32x2 w; w.x = pk2(v[j].x * rstd * g.x, v[j].y * rstd * g.y); w.y = pk2(v[j].z * rstd * g.z, v[j].w * rstd * g.w);
            o[64 * j] = w;
        }
    }
    prep_transpose<true>(p.w_in, D, DIN, DINP, (bf16_t*)(ws + WS_WIN), gt, ngt);
    prep_transpose<false>(p.w_out, D, D, D, (bf16_t*)(ws + WS_WOUT), gt, ngt);
    prep_transpose<false>(p.wq, D, PQ, PQ, (bf16_t*)(ws + WS_WQ), gt, ngt);
    prep_convert(p.pkeys, (bf16_t*)(ws + WS_PKEYS), (long)16 * 128 * 128 / 8, gt, ngt);
    prep_transpose<false>(p.w1_k, 2048, 256, 256, (bf16_t*)(ws + WS_W1T), gt, ngt);
    prep_transpose<false>(p.w1_v, 2048, 256, 256, (bf16_t*)(ws + WS_W1T) + 256 * 2048, gt, ngt);
    prep_transpose<false>(p.w2_k, 256, 64, 64, (bf16_t*)(ws + WS_W2T), gt, ngt);
    prep_transpose<false>(p.w2_v, 256, 64, 64, (bf16_t*)(ws + WS_W2T) + 64 * 256, gt, ngt);
    for (long o = gw; o < 512; o += ngw) {
        const int kv = (int)(o >> 8), n = (int)(o & 255);
        const float* pe = kv ? p.pe_v : p.pe_k; const float* w1 = kv ? p.w1_v : p.w1_k;
        float s = 0.f;
        for (int k = lane; k < 2048; k += 64) s += pe[k] * w1[(size_t)k * 256 + n];
        s = wave_sum(s);
        if (lane == 0) ((float*)(ws + WS_B1))[o] = s;
    }
    for (long i = gt; i < NTOK; i += ngt) ((float*)(ws + WS_SS2))[i] = 0.f;
}

template <class Epi>
__device__ __forceinline__ void gemm_simple(const bf16_t* A, const bf16_t* Bt, int M, int N, int K, const Epi& E) {
    const int lane = tid_opaque() & 63;
    const long gw = ((long)blockIdx.x * NTHREADS + tid_opaque()) >> 6, ngw = ((long)gridDim.x * NTHREADS) >> 6;
    const int ntn = N / 64; const long ntiles = (long)(M / 32) * ntn;
    const int fr = lane & 15, fq = lane >> 4;
    for (long tile = gw; tile < ntiles; tile += ngw) {
        const int m0 = (int)(tile / ntn) * 32, n0 = (int)(tile % ntn) * 64;
        f32x4 acc[2][4];
#pragma unroll
        for (int i = 0; i < 2; ++i)
#pragma unroll
            for (int j = 0; j < 4; ++j) acc[i][j] = (f32x4){0.f, 0.f, 0.f, 0.f};
        const bf16_t* ap = A + (size_t)(m0 + fr) * K + fq * 8;
        const bf16_t* bp = Bt + (size_t)(n0 + fr) * K + fq * 8;
        for (int k0 = 0; k0 < K; k0 += 32) {
            bf16x8 a[2], b[4];
#pragma unroll
            for (int i = 0; i < 2; ++i) a[i] = *(const bf16x8*)(ap + (size_t)i * 16 * K + k0);
#pragma unroll
            for (int j = 0; j < 4; ++j) b[j] = *(const bf16x8*)(bp + (size_t)j * 16 * K + k0);
#pragma unroll
            for (int i = 0; i < 2; ++i)
#pragma unroll
                for (int j = 0; j < 4; ++j) acc[i][j] = __builtin_amdgcn_mfma_f32_16x16x32_bf16(a[i], b[j], acc[i][j], 0, 0, 0);
        }
        E(acc, m0, n0, fr, fq);
    }
}

struct EpiProj {
    unsigned char* ws;
    __device__ __forceinline__ void operator()(const f32x4 (&acc)[2][4], int m0, int n0, int fr, int fq) const {
#pragma unroll
        for (int i = 0; i < 2; ++i)
#pragma unroll
            for (int j = 0; j < 4; ++j)
#pragma unroll
                for (int r = 0; r < 4; ++r) {
                    const int row = m0 + 16 * i + fq * 4 + r, n = n0 + 16 * j + fr;
                    const float v = acc[i][j][r];
                    const int b = row / T, t = row % T, d = n & 63;
                    if (n < 512) {
                        const int head = n >> 6;
                        ((bf16_t*)(ws + WS_QN))[((size_t)(b * 8 + head) * T + t) * 64 + d] = (bf16_t)f2bf(v * 0.125f);
                    } else if (n < 1280) {
                        const int arr = (n - 512) >> 7, g = ((n - 512) >> 6) & 1;
                        ((bf16_t*)(ws + WS_KV6 + arr * KV6_STRIDE))[((size_t)(b * 2 + g) * T + t) * 64 + d] = (bf16_t)f2bf(v);
                    } else if (n < 1792) {
                        const int head = (n - 1280) >> 6;
                        ((bf16_t*)(ws + WS_QS))[((size_t)(b * 8 + head) * T + t) * 64 + d] = (bf16_t)f2bf(v * 0.125f);
                    } else if (n < 1856) {
                        ((bf16_t*)(ws + WS_KSW))[((size_t)b * T + t) * 64 + d] = (bf16_t)f2bf(v);
                    } else if (n < 1920) {
                        ((bf16_t*)(ws + WS_VSW))[((size_t)b * T + t) * 64 + d] = (bf16_t)f2bf(v);
                    } else if (n < 1944) {
                        ((float*)(ws + WS_GSIG))[(size_t)row * 24 + (n - 1920)] = 1.0f / (1.0f + expf(-v));
                    }
                }
    }
};
struct EpiOut {
    const float* x; const float* g2; float* h1; bf16_t* h1g; float* ss2;
    __device__ __forceinline__ void operator()(const f32x4 (&acc)[2][4], int m0, int n0, int fr, int fq) const {
#pragma unroll
        for (int i = 0; i < 2; ++i)
#pragma unroll
            for (int r = 0; r < 4; ++r) {
                const int row = m0 + 16 * i + fq * 4 + r; float ss = 0.f;
#pragma unroll
                for (int j = 0; j < 4; ++j) {
                    const int n = n0 + 16 * j + fr; const size_t off = (size_t)row * D + n;
                    const float h = x[off] + acc[i][j][r];
                    h1[off] = h; h1g[off] = (bf16_t)f2bf(h * g2[n]); ss += h * h;
                }
                ss += __shfl_xor(ss, 1); ss += __shfl_xor(ss, 2); ss += __shfl_xor(ss, 4); ss += __shfl_xor(ss, 8);
                if (fr == 0) atomicAdd(ss2 + row, ss);
            }
    }
};
struct EpiQP {
    const float* ss2; bf16_t* qp;
    __device__ __forceinline__ void operator()(const f32x4 (&acc)[2][4], int m0, int n0, int fr, int fq) const {
#pragma unroll
        for (int i = 0; i < 2; ++i)
#pragma unroll
            for (int r = 0; r < 4; ++r) {
                const int row = m0 + 16 * i + fq * 4 + r;
                const float rstd = 1.0f / sqrtf(ss2[row] * (1.0f / D) + EPS);
#pragma unroll
                for (int j = 0; j < 4; ++j) qp[(size_t)row * PQ + n0 + 16 * j + fr] = (bf16_t)f2bf(acc[i][j][r] * rstd);
            }
    }
};

namespace pg8 {
#define PG8_LAS __attribute__((address_space(3)))
typedef unsigned short bf16_t;
typedef short bf16x8 __attribute__((ext_vector_type(8)));
typedef float f32x4 __attribute__((ext_vector_type(4)));
typedef unsigned u32x4 __attribute__((ext_vector_type(4)));
constexpr int BM = 256, BK = 64, HALF = 128, HTB = HALF * BK * 2  , STAGE_BYTES = 8 * HTB, NXCD = 8, WGM = 8;

__host__ __device__ __forceinline__ int lds_byte(int r, int c) { const int st = (r >> 4) * 2 + (c >> 5), rr = r & 15, cc = c & 31, ob = rr * 64 + cc * 2; return st * 1024 + (ob ^ (((ob >> 9) & 1) << 5)); }
__host__ __device__ __forceinline__ void stage_rc(int b, int& R, int& C) { const int st = b / 1024, sb = b % 1024, swz = sb ^ (((sb >> 9) & 1) << 5); R = (st >> 1) * 16 + swz / 64; C = (st & 1) * 32 + (swz % 64) / 2; }
__host__ __device__ __forceinline__ int perm32(int rho) { const int n = rho >> 4, i = rho & 15; return 8 * (i >> 2) + 4 * n + (i & 3); }

struct Unit { int pm, pn; };
struct Gemm { const bf16_t* A; const bf16_t* Bt; int M, N, K; };

struct StaticOrder {
    int nM, nN, nwg, G, c;
    __host__ __device__ void init(int M, int N, int G_, int c_) { nM = M / BM; nN = N / BM; nwg = nM * nN; G = G_; c = c_; }
    __host__ __device__ bool next(int i, Unit& u) const {
        const long L = (long)i * G + c; if (L >= nwg) return false;
        int wgid = (int)L; { const int q = nwg / NXCD, r = nwg % NXCD, xcd = wgid % NXCD, off = wgid / NXCD; wgid = (xcd < r ? xcd * (q + 1) : r * (q + 1) + (xcd - r) * q) + off; }
        const int nig = WGM * nN, gid = wgid / nig, fm = gid * WGM, gsz = (nM - fm) < WGM ? (nM - fm) : WGM;
        u.pm = fm + ((wgid % nig) % gsz); u.pn = (wgid % nig) / gsz; return true;
    }
    __device__ __forceinline__ void a_ready(const Unit&) const {}
    __device__ __forceinline__ void done(const Unit&) const {}
};

__device__ __forceinline__ unsigned cvt_pk_bf16(float lo, float hi) { unsigned r; asm volatile("v_cvt_pk_bf16_f32 %0, %1, %2" : "=v"(r) : "v"(lo), "v"(hi)); return r; }
template <class Epi, class Sched, bool ALIGN_EPI = false, bool SP2 = false>
__device__ __forceinline__ void gemm_phase(PG8_LAS unsigned char* lds, const Gemm g, const Sched& S, const Epi& E) {
    const int tid = tid_opaque(), wid = __builtin_amdgcn_readfirstlane(tid >> 6), lane = tid & 63, wr = wid >> 2, wc = wid & 3, fr = lane & 15, fq = lane >> 4;
    const int K = g.K, nt = K / BK;
    unsigned voffA[2], voffB[2];
#pragma unroll
    for (int i = 0; i < 2; ++i) { int R, C; stage_rc(tid * 16 + i * 8192, R, C); const int Rb = Epi::PERM ? ((R & ~31) + perm32(R & 31)) : R;
        voffA[i] = (unsigned)(R * K + C) * 2u; voffB[i] = (unsigned)(Rb * K + C) * 2u; }
    const size_t kstep = (size_t)(BK * 2);
    const size_t hstep = (size_t)HALF * K * 2;
    const size_t tstep = 2 * hstep;
    const unsigned ldsw = (unsigned)wid * 1024u;
    const int aoff = lds_byte(wr * 64 + fr, fq * 8), boff = lds_byte(wc * 32 + fr, fq * 8);
#define PG8_SA(b, h) (((b) * 2 + (h)) * HTB)
#define PG8_SB(b, h) ((4 + (b) * 2 + (h)) * HTB)
#define PG8_STAGE(bufoff, gbase, voff) do { _Pragma("unroll") for (int _i = 0; _i < 2; ++_i) \
        __builtin_amdgcn_global_load_lds((const unsigned*)((const char*)(gbase) + (voff)[_i]), (PG8_LAS unsigned*)(lds + (bufoff) + ldsw + _i * 8192), 16, 0, 0); } while (0)
#define PG8_LDA(dst, b, h) do { _Pragma("unroll") for (int m = 0; m < 4; ++m) _Pragma("unroll") for (int k = 0; k < 2; ++k) dst[m][k] = *(const PG8_LAS bf16x8*)(lds + PG8_SA(b, h) + aoff + m * 2048 + k * 1024); } while (0)
#define PG8_LDB(dst, b, h) do { _Pragma("unroll") for (int n = 0; n < 2; ++n) _Pragma("unroll") for (int k = 0; k < 2; ++k) dst[n][k] = *(const PG8_LAS bf16x8*)(lds + PG8_SB(b, h) + boff + n * 2048 + k * 1024); } while (0)
#define PG8_MMA(ai, bj, At, Bt) do { __builtin_amdgcn_s_setprio(1); _Pragma("unroll") for (int m = 0; m < 4; ++m) _Pragma("unroll") for (int n = 0; n < 2; ++n) _Pragma("unroll") for (int k = 0; k < 2; ++k) \
        acc[ai][bj][m][n] = __builtin_amdgcn_mfma_f32_16x16x32_bf16(Bt[n][k], At[m][k], acc[ai][bj][m][n], 0, 0, 0); __builtin_amdgcn_s_setprio(0); } while (0)
#define PG8_WAIT_V(n) asm volatile("s_waitcnt vmcnt(" #n ")" ::: "memory")
#define PG8_WAIT_L(n) asm volatile("s_waitcnt lgkmcnt(" #n ")" ::: "memory")
#define PG8_BAR __builtin_amdgcn_s_barrier()
#define PG8_SCHED __builtin_amdgcn_sched_barrier(0)
    Unit cur, nxt; int ui = 0;
    if (!S.next(0, cur)) return;
    f32x4 acc[2][2][4][2];
#pragma unroll
    for (int a = 0; a < 2; ++a)
#pragma unroll
        for (int b = 0; b < 2; ++b)
#pragma unroll
            for (int m = 0; m < 4; ++m)
#pragma unroll
                for (int n = 0; n < 2; ++n) acc[a][b][m][n] = (f32x4){0.f, 0.f, 0.f, 0.f};
    bf16x8 At[4][2], B0[2][2], B1[2][2];
    const char* cA = (const char*)g.A + (size_t)cur.pm * tstep; const char* cB = (const char*)g.Bt + (size_t)cur.pn * tstep;
    S.a_ready(cur);
    if constexpr (SP2) {
        PG8_STAGE(PG8_SB(0, 0), cB, voffB); PG8_STAGE(PG8_SB(0, 1), cB + hstep, voffB); PG8_STAGE(PG8_SA(0, 0), cA, voffA); PG8_STAGE(PG8_SA(0, 1), cA + hstep, voffA);
        if (wr == 1) PG8_BAR;
        PG8_WAIT_V(2); PG8_BAR;
        PG8_STAGE(PG8_SB(1, 0), cB + kstep, voffB); PG8_STAGE(PG8_SA(1, 0), cA + kstep, voffA); PG8_STAGE(PG8_SB(1, 1), cB + hstep + kstep, voffB);
        PG8_WAIT_V(6); PG8_BAR;
    } else {
        PG8_STAGE(PG8_SB(0, 0), cB, voffB); PG8_STAGE(PG8_SA(0, 0), cA, voffA); PG8_STAGE(PG8_SB(0, 1), cB + hstep, voffB); PG8_STAGE(PG8_SA(0, 1), cA + hstep, voffA);
        if (wr == 1) PG8_BAR;
        PG8_WAIT_V(4); PG8_BAR;
        PG8_STAGE(PG8_SB(1, 0), cB + kstep, voffB); PG8_STAGE(PG8_SA(1, 0), cA + kstep, voffA); PG8_STAGE(PG8_SB(1, 1), cB + hstep + kstep, voffB);
        PG8_WAIT_V(6); PG8_BAR;
    }
    for (;;) {
        const bool has_next = S.next(ui + 1, nxt);
        const char* nA = has_next ? (const char*)g.A + (size_t)nxt.pm * tstep : cA; const char* nB = has_next ? (const char*)g.Bt + (size_t)nxt.pn * tstep : cB;
        for (int t = 0; t < nt; t += 2) {
            const bool last = (t == nt - 2);
            const char* a1 = cA + (size_t)(t + 1) * kstep;
            const char* a2 = last ? nA : cA + (size_t)(t + 2) * kstep; const char* b2 = last ? nB : cB + (size_t)(t + 2) * kstep;
            const char* a3 = a2 + kstep; const char* b3 = b2 + kstep;
            if (last && has_next) S.a_ready(nxt);
            if constexpr (SP2) {
            PG8_LDB(B0, 0, 0); PG8_LDB(B1, 0, 1); PG8_SCHED; PG8_LDA(At, 0, 0); PG8_STAGE(PG8_SA(1, 1), a1 + hstep, voffA);
            PG8_WAIT_V(8); PG8_WAIT_L(0); PG8_BAR; PG8_MMA(0, 0, At, B0); PG8_MMA(0, 1, At, B1); PG8_BAR; PG8_SCHED;
            PG8_LDA(At, 0, 1); PG8_STAGE(PG8_SB(0, 0), b2, voffB); PG8_STAGE(PG8_SB(0, 1), b2 + hstep, voffB); PG8_STAGE(PG8_SA(0, 0), a2, voffA);
            PG8_WAIT_V(8); PG8_WAIT_L(0); PG8_BAR; PG8_MMA(1, 0, At, B0); PG8_MMA(1, 1, At, B1); PG8_BAR; PG8_SCHED;
            PG8_LDB(B0, 1, 0); PG8_LDB(B1, 1, 1); PG8_SCHED; PG8_LDA(At, 1, 0); PG8_STAGE(PG8_SA(0, 1), a2 + hstep, voffA);
            PG8_WAIT_V(8); PG8_WAIT_L(0); PG8_BAR; PG8_MMA(0, 0, At, B0); PG8_MMA(0, 1, At, B1); PG8_BAR; PG8_SCHED;
            PG8_LDA(At, 1, 1); PG8_STAGE(PG8_SB(1, 0), b3, voffB); PG8_STAGE(PG8_SB(1, 1), b3 + hstep, voffB); PG8_STAGE(PG8_SA(1, 0), a3, voffA);
            PG8_WAIT_V(8); PG8_WAIT_L(0); PG8_BAR; PG8_MMA(1, 0, At, B0); PG8_MMA(1, 1, At, B1); PG8_BAR; PG8_SCHED;
            } else {
            PG8_LDB(B0, 0, 0); PG8_SCHED; PG8_LDA(At, 0, 0); PG8_STAGE(PG8_SA(1, 1), a1 + hstep, voffA);
            PG8_WAIT_L(8); PG8_BAR; PG8_WAIT_L(0); PG8_MMA(0, 0, At, B0); PG8_BAR; PG8_SCHED;
            PG8_LDB(B1, 0, 1); PG8_STAGE(PG8_SB(0, 0), b2, voffB);
            PG8_BAR; PG8_WAIT_L(0); PG8_MMA(0, 1, At, B1); PG8_BAR;
            PG8_LDA(At, 0, 1); PG8_STAGE(PG8_SA(0, 0), a2, voffA);
            PG8_BAR; PG8_WAIT_L(0); PG8_MMA(1, 0, At, B0); PG8_BAR; PG8_SCHED;
            PG8_STAGE(PG8_SB(0, 1), b2 + hstep, voffB);
            PG8_WAIT_V(6); PG8_BAR; PG8_MMA(1, 1, At, B1); PG8_BAR;
            PG8_LDB(B0, 1, 0); PG8_SCHED; PG8_LDA(At, 1, 0); PG8_STAGE(PG8_SA(0, 1), a2 + hstep, voffA);
            PG8_WAIT_L(8); PG8_BAR; PG8_WAIT_L(0); PG8_MMA(0, 0, At, B0); PG8_BAR; PG8_SCHED;
            PG8_LDB(B1, 1, 1); PG8_STAGE(PG8_SB(1, 0), b3, voffB);
            PG8_BAR; PG8_WAIT_L(0); PG8_MMA(0, 1, At, B1); PG8_BAR;
            PG8_LDA(At, 1, 1); PG8_STAGE(PG8_SA(1, 0), a3, voffA);
            PG8_BAR; PG8_WAIT_L(0); PG8_MMA(1, 0, At, B0); PG8_BAR; PG8_SCHED;
            PG8_STAGE(PG8_SB(1, 1), b3 + hstep, voffB);
            PG8_WAIT_V(6); PG8_BAR; PG8_MMA(1, 1, At, B1); PG8_BAR;
            }
        }
        if constexpr (ALIGN_EPI) { if (wr == 0) PG8_BAR; }
        if constexpr (!Epi::AFTER_DRAIN) { E(acc, cur, wr, wc, fr, fq); S.done(cur); }
        if (!has_next) break;
#pragma unroll
        for (int a = 0; a < 2; ++a)
#pragma unroll
            for (int b = 0; b < 2; ++b)
#pragma unroll
                for (int m = 0; m < 4; ++m)
#pragma unroll
                    for (int n = 0; n < 2; ++n) acc[a][b][m][n] = (f32x4){0.f, 0.f, 0.f, 0.f};
        cur = nxt; cA = nA; cB = nB; ++ui;
        if constexpr (ALIGN_EPI) { if (wr == 1) PG8_BAR; }
    }
    PG8_WAIT_V(0);
    if constexpr (!ALIGN_EPI) { if (wr == 0) PG8_BAR; }
    PG8_BAR;
    if constexpr (Epi::AFTER_DRAIN) { E.fused(acc, cur, wr, wc, fr, fq, lds, wid, lane); S.done(cur); }
#undef PG8_SA
#undef PG8_SB
#undef PG8_STAGE
#undef PG8_LDA
#undef PG8_LDB
#undef PG8_MMA
#undef PG8_WAIT_V
#undef PG8_WAIT_L
#undef PG8_BAR
#undef PG8_SCHED
}
}

struct EpiProjT {
    static constexpr bool PERM = true, AFTER_DRAIN = false;
    unsigned char* ws;
    __device__ __forceinline__ void operator()(const f32x4 (&acc)[2][2][4][2], const pg8::Unit& u, int wr, int wc, int fr, int fq) const {
        const int row0 = u.pm * 256 + wr * 64 + fr;
#pragma unroll
        for (int bj = 0; bj < 2; ++bj) {
            const int n8 = u.pn * 256 + bj * 128 + wc * 32 + 8 * fq;
            if (n8 >= 1944) continue;
            if (n8 >= 1920) {
#pragma unroll
                for (int ai = 0; ai < 2; ++ai)
#pragma unroll
                    for (int m = 0; m < 4; ++m) {
                        const int row = row0 + ai * 128 + m * 16;
                        const f32x4 v0 = acc[ai][bj][m][0], v1 = acc[ai][bj][m][1];
                        float* dst = (float*)(ws + WS_GSIG) + (size_t)row * 24 + (n8 - 1920);
                        *(f32x4*)dst = (f32x4){1.0f / (1.0f + __expf(-v0[0])), 1.0f / (1.0f + __expf(-v0[1])), 1.0f / (1.0f + __expf(-v0[2])), 1.0f / (1.0f + __expf(-v0[3]))};
                        *(f32x4*)(dst + 4) = (f32x4){1.0f / (1.0f + __expf(-v1[0])), 1.0f / (1.0f + __expf(-v1[1])), 1.0f / (1.0f + __expf(-v1[2])), 1.0f / (1.0f + __expf(-v1[3]))};
                    }
                continue;
            }
            bf16_t* base; int nh, hidx; float sc = 1.0f;
            if (n8 < 512) { base = (bf16_t*)(ws + WS_QN); nh = 8; hidx = n8 >> 6; sc = 0.125f * 1.4426950408889634f; }
            else if (n8 < 1280) { const int arr = (n8 - 512) >> 7; base = (bf16_t*)(ws + WS_KV6 + (size_t)arr * KV6_STRIDE); nh = 2; hidx = ((n8 - 512) >> 6) & 1; }
            else if (n8 < 1792) { base = (bf16_t*)(ws + WS_QS); nh = 8; hidx = (n8 - 1280) >> 6; sc = 0.125f * 1.4426950408889634f; }
            else if (n8 < 1856) { base = (bf16_t*)(ws + WS_KSW); nh = 1; hidx = 0; }
            else { base = (bf16_t*)(ws + WS_VSW); nh = 1; hidx = 0; }
            const int d0 = n8 & 63;
#pragma unroll
            for (int ai = 0; ai < 2; ++ai)
#pragma unroll
                for (int m = 0; m < 4; ++m) {
                    const int row = row0 + ai * 128 + m * 16, b = row >> 13, t = row & (T - 1);
                    const f32x4 v0 = acc[ai][bj][m][0] * sc, v1 = acc[ai][bj][m][1] * sc;
                    u32x4 w; w.x = pg8::cvt_pk_bf16(v0[0], v0[1]); w.y = pg8::cvt_pk_bf16(v0[2], v0[3]); w.z = pg8::cvt_pk_bf16(v1[0], v1[1]); w.w = pg8::cvt_pk_bf16(v1[2], v1[3]);
                    *(u32x4*)(base + ((size_t)(b * nh + hidx) * T + t) * 64 + d0) = w;
                }
        }
    }
};
struct EpiOutT {
    static constexpr bool PERM = false, AFTER_DRAIN = false;
    const float* x; const float* g2; float* h1; bf16_t* h1g; float* ss2;
    __device__ __forceinline__ void operator()(const f32x4 (&acc)[2][2][4][2], const pg8::Unit& u, int wr, int wc, int fr, int fq) const {
        const int row0 = u.pm * 256 + wr * 64 + fr, col0 = u.pn * 256 + wc * 32 + 4 * fq;
#pragma unroll
        for (int ai = 0; ai < 2; ++ai)
#pragma unroll
            for (int m = 0; m < 4; ++m) {
                const int row = row0 + ai * 128 + m * 16; float ss = 0.f;
#pragma unroll
                for (int bj = 0; bj < 2; ++bj)
#pragma unroll
                    for (int n = 0; n < 2; ++n) {
                        const int c = col0 + bj * 128 + n * 16; const size_t off = (size_t)row * D + c;
                        const f32x4 h = *(const f32x4*)(x + off) + acc[ai][bj][m][n];
                        const f32x4 g = *(const f32x4*)(g2 + c);
                        u32x2 w; w.x = pg8::cvt_pk_bf16(h[0] * g[0], h[1] * g[1]); w.y = pg8::cvt_pk_bf16(h[2] * g[2], h[3] * g[3]);
                        *(u32x2*)(h1g + off) = w;
                        ss += (h[0] * h[0] + h[1] * h[1]) + (h[2] * h[2] + h[3] * h[3]);
                    }
                ss += __shfl_xor(ss, 16); ss += __shfl_xor(ss, 32);
                if (fq == 0) atomicAdd(ss2 + row, ss);
            }
    }
};
struct EpiQPT {
    static constexpr bool PERM = true, AFTER_DRAIN = false;
    const float* ss2; bf16_t* qp;
    __device__ __forceinline__ void operator()(const f32x4 (&acc)[2][2][4][2], const pg8::Unit& u, int wr, int wc, int fr, int fq) const {
        const int row0 = u.pm * 256 + wr * 64 + fr;
#pragma unroll
        for (int ai = 0; ai < 2; ++ai)
#pragma unroll
            for (int m = 0; m < 4; ++m) {
                const int row = row0 + ai * 128 + m * 16;
                const float rstd = 1.0f / sqrtf(ss2[row] * (1.0f / D) + EPS);
#pragma unroll
                for (int bj = 0; bj < 2; ++bj) {
                    const int n8 = u.pn * 256 + bj * 128 + wc * 32 + 8 * fq;
                    const f32x4 v0 = acc[ai][bj][m][0] * rstd, v1 = acc[ai][bj][m][1] * rstd;
                    u32x4 w; w.x = pg8::cvt_pk_bf16(v0[0], v0[1]); w.y = pg8::cvt_pk_bf16(v0[2], v0[3]); w.z = pg8::cvt_pk_bf16(v1[0], v1[1]); w.w = pg8::cvt_pk_bf16(v1[2], v1[3]);
                    *(u32x4*)(qp + (size_t)row * PQ + n8) = w;
                }
            }
    }
};

__device__ __forceinline__ void phase_compress(const Params& p, float* lds) {
    float* flat = lds;
    float* part = lds + 2048;
    float* hid = lds + 2560;
    const int tid = tid_opaque();
    const int nunits = 2 * BATCH * NCMP * NSA_G;
    for (int u = blockIdx.x; u < nunits; u += gridDim.x) {
        const int kv = u / (BATCH * NCMP * NSA_G); int r = u % (BATCH * NCMP * NSA_G);
        const int b = r / (NCMP * NSA_G); r %= (NCMP * NSA_G);
        const int c = r / NSA_G, g = r % NSA_G;
        const bf16_t* raw = (const bf16_t*)(p.ws + WS_KV6 + (size_t)kv * KV6_STRIDE) + ((size_t)(b * 2 + g) * T + 16 * c) * 64;
        const float* pe = kv ? p.pe_v : p.pe_k; const float* w1 = kv ? p.w1_v : p.w1_k; const float* w2 = kv ? p.w2_v : p.w2_k;
        for (int i = tid; i < 2048; i += NTHREADS) flat[i] = bf2f(raw[i]) + pe[i];
        __syncthreads();
        {
            const int j = tid & 255, half = tid >> 8;
            float a = 0.f;
            const float* wp = w1 + (size_t)(half * 1024) * 256 + j; const float* fp = flat + half * 1024;
            for (int i = 0; i < 1024; ++i) a += fp[i] * wp[(size_t)i * 256];
            part[tid] = a;
        }
        __syncthreads();
        if (tid < 256) hid[tid] = gelu_tanh(part[tid] + part[tid + 256]);
        __syncthreads();
        if (tid < 64) {
            float a = 0.f;
            for (int j = 0; j < 256; ++j) a += hid[j] * w2[j * 64 + tid];
            bf16_t* dst = (bf16_t*)(p.ws + (kv ? WS_VC : WS_KC)) + ((size_t)(b * 2 + g) * NCMPP + c) * 64;
            dst[tid] = (bf16_t)f2bf(a);
        }
        __syncthreads();
    }
}

__device__ __forceinline__ void load_row64(const bf16_t* src, float (&k)[64]) {
#pragma unroll
    for (int c = 0; c < 8; ++c) {
        const u32x4 w = *(const u32x4*)(src + 8 * c);
        k[8 * c + 0] = bflo(w.x); k[8 * c + 1] = bfhi(w.x); k[8 * c + 2] = bflo(w.y); k[8 * c + 3] = bfhi(w.y);
        k[8 * c + 4] = bflo(w.z); k[8 * c + 5] = bfhi(w.z); k[8 * c + 6] = bflo(w.w); k[8 * c + 7] = bfhi(w.w);
    }
}
__device__ __forceinline__ float dot_row64(const bf16_t* src, const float (&q)[64]) {
    float s0 = 0.f, s1 = 0.f;
#pragma unroll
    for (int c = 0; c < 8; ++c) {
        const u32x4 w = *(const u32x4*)(src + 8 * c);
        s0 += q[8 * c + 0] * bflo(w.x); s1 += q[8 * c + 1] * bfhi(w.x); s0 += q[8 * c + 2] * bflo(w.y); s1 += q[8 * c + 3] * bfhi(w.y);
        s0 += q[8 * c + 4] * bflo(w.z); s1 += q[8 * c + 5] * bfhi(w.z); s0 += q[8 * c + 6] * bflo(w.w); s1 += q[8 * c + 7] * bfhi(w.w);
    }
    return s0 + s1;
}
__device__ __forceinline__ void osm_update(float s, const bf16_t* vsrc, float& m, float& l, float (&acc)[32]) {
    const float mn = fmaxf(m, s), alpha = __expf(m - mn), pr = __expf(s - mn);
    l = l * alpha + pr; m = mn;
#pragma unroll
    for (int c = 0; c < 4; ++c) {
        const u32x4 w = *(const u32x4*)(vsrc + 8 * c);
        acc[8 * c + 0] = acc[8 * c + 0] * alpha + pr * bflo(w.x); acc[8 * c + 1] = acc[8 * c + 1] * alpha + pr * bfhi(w.x);
        acc[8 * c + 2] = acc[8 * c + 2] * alpha + pr * bflo(w.y); acc[8 * c + 3] = acc[8 * c + 3] * alpha + pr * bfhi(w.y);
        acc[8 * c + 4] = acc[8 * c + 4] * alpha + pr * bflo(w.z); acc[8 * c + 5] = acc[8 * c + 5] * alpha + pr * bfhi(w.z);
        acc[8 * c + 6] = acc[8 * c + 6] * alpha + pr * bflo(w.w); acc[8 * c + 7] = acc[8 * c + 7] * alpha + pr * bfhi(w.w);
    }
}

__device__ __forceinline__ void phase_nsa(const Params& p, float* lds) {
    float* imp = lds;
    int* sel = (int*)(lds + 64 * 129);
    const int tid = tid_opaque(), qi = tid & 63, h = (tid >> 6) & 3, dh = tid >> 8;
    const unsigned char* ws = p.ws;
    const int nunits = BATCH * NSA_G * (T / 64);
    for (int u = blockIdx.x; u < nunits; u += gridDim.x) {
        const int b = u / (NSA_G * (T / 64)), g = (u / (T / 64)) % NSA_G, tile = u % (T / 64);
        const int t = tile * 64 + qi, head = g * 4 + h;
        const float slope = exp2f(-0.5f * (float)(9 + head));
        float q[64];
        load_row64((const bf16_t*)(ws + WS_QN) + ((size_t)(b * 8 + head) * T + t) * 64, q);
        const bf16_t* KC = (const bf16_t*)(ws + WS_KC) + (size_t)(b * 2 + g) * NCMPP * 64;
        const bf16_t* VC = (const bf16_t*)(ws + WS_VC) + (size_t)(b * 2 + g) * NCMPP * 64 + dh * 32;
        const bf16_t* KS = (const bf16_t*)(ws + WS_KV6 + 2 * KV6_STRIDE) + (size_t)(b * 2 + g) * T * 64;
        const bf16_t* VS = (const bf16_t*)(ws + WS_KV6 + 3 * KV6_STRIDE) + (size_t)(b * 2 + g) * T * 64 + dh * 32;
        const bf16_t* KW = (const bf16_t*)(ws + WS_KV6 + 4 * KV6_STRIDE) + (size_t)(b * 2 + g) * T * 64;
        const bf16_t* VW = (const bf16_t*)(ws + WS_KV6 + 5 * KV6_STRIDE) + (size_t)(b * 2 + g) * T * 64 + dh * 32;
        const float* gs = (const float*)(ws + WS_GSIG) + (size_t)(b * T + t) * 24 + head * 3;
        float o[32];
#pragma unroll
        for (int d = 0; d < 32; ++d) o[d] = 0.f;
        for (int i = tid; i < 64 * 129; i += NTHREADS) imp[i] = 0.f;
        __syncthreads();
        const int nc = 4 * tile + 3;
        float mc = -1e30f, lc = 0.f;
        {
            float acc[32];
#pragma unroll
            for (int d = 0; d < 32; ++d) acc[d] = 0.f;
            for (int c = 0; c < nc; ++c) {
                const int dist = t - (16 * c + 31);
                if (dist >= 0) {
                    const float s = dot_row64(KC + (size_t)c * 64, q) - slope * (float)dist;
                    osm_update(s, VC + (size_t)c * 64, mc, lc, acc);
                }
            }
            const float inv = gs[0] / fmaxf(lc, 1e-30f);
#pragma unroll
            for (int d = 0; d < 32; ++d) o[d] += acc[d] * inv;
        }
        if (dh == 0) {
            const float invl = 1.0f / fmaxf(lc, 1e-30f);
            for (int c = 0; c < nc; ++c) {
                const int dist = t - (16 * c + 31);
                if (dist >= 0) {
                    const float s = dot_row64(KC + (size_t)c * 64, q) - slope * (float)dist;
                    const float pr = __expf(s - mc) * invl;
                    const int sb = c >> 2;
                    atomicAdd(&imp[qi * 129 + sb], pr);
                    if ((c & 3) == 3 && sb + 1 < NSEL) atomicAdd(&imp[qi * 129 + sb + 1], pr);
                }
            }
        }
        __syncthreads();
        if (tid < 64) {
            const int blk_t = tile;
            float* row = imp + tid * 129;
            for (int j = 0; j <= blk_t; ++j) if (j == 0 || j == blk_t || j == blk_t - 1) row[j] = 1.0e4f;
            for (int k = 0; k < TOPN; ++k) {
                float best = -INFINITY; int bi = -1;
                for (int j = 0; j <= blk_t; ++j) { const float v = row[j]; if (v > best) { best = v; bi = j; } }
                sel[tid * 16 + k] = bi;
                if (bi >= 0) row[bi] = -INFINITY;
            }
        }
        __syncthreads();
        {
            float m = -1e30f, l = 0.f, acc[32];
#pragma unroll
            for (int d = 0; d < 32; ++d) acc[d] = 0.f;
            for (int k = 0; k < TOPN; ++k) {
                const int j = sel[qi * 16 + k];
                if (j >= 0) {
                    for (int i = 0; i < 64; ++i) {
                        const int pos = 64 * j + i;
                        if (pos <= t) {
                            const float s = dot_row64(KS + (size_t)pos * 64, q) - slope * (float)(t - pos);
                            osm_update(s, VS + (size_t)pos * 64, m, l, acc);
                        }
                    }
                }
            }
            const float inv = gs[1] / fmaxf(l, 1e-30f);
#pragma unroll
            for (int d = 0; d < 32; ++d) o[d] += acc[d] * inv;
        }
        {
            float m = -1e30f, l = 0.f, acc[32];
#pragma unroll
            for (int d = 0; d < 32; ++d) acc[d] = 0.f;
            for (int i = 0; i < NSA_WIN; ++i) {
                const int pos = t - (NSA_WIN - 1) + i;
                if (pos >= 0) {
                    const float s = dot_row64(KW + (size_t)pos * 64, q) - slope * (float)(t - pos);
                    osm_update(s, VW + (size_t)pos * 64, m, l, acc);
                }
            }
            const float inv = gs[2] / fmaxf(l, 1e-30f);
#pragma unroll
            for (int d = 0; d < 32; ++d) o[d] += acc[d] * inv;
        }
        bf16_t* O = (bf16_t*)(p.ws + WS_O) + (size_t)(b * T + t) * D + g * 256 + h * 64 + dh * 32;
#pragma unroll
        for (int c = 0; c < 4; ++c) {
            u32x4 w; w.x = pk2(o[8 * c], o[8 * c + 1]); w.y = pk2(o[8 * c + 2], o[8 * c + 3]); w.z = pk2(o[8 * c + 4], o[8 * c + 5]); w.w = pk2(o[8 * c + 6], o[8 * c + 7]);
            *(u32x4*)(O + 8 * c) = w;
        }
        __syncthreads();
    }
}

__device__ __forceinline__ void phase_swa(const Params& p) {
    const unsigned char* ws = p.ws;
    const long gt = (long)blockIdx.x * NTHREADS + tid_opaque(), ngt = (long)gridDim.x * NTHREADS;
    const long items = (long)NTOK * SWA_H * 2;
    for (long it = gt; it < items; it += ngt) {
        const int tt = (int)(it % T); long r = it / T;
        const int dh = (int)(r % 2); r /= 2;
        const int head = (int)(r % SWA_H); const int b = (int)(r / SWA_H);
        const float slope = exp2f(-0.5f * (float)(head + 1));
        float q[64];
        load_row64((const bf16_t*)(ws + WS_QS) + ((size_t)(b * 8 + head) * T + tt) * 64, q);
        const bf16_t* K = (const bf16_t*)(ws + WS_KSW) + (size_t)b * T * 64;
        const bf16_t* V = (const bf16_t*)(ws + WS_VSW) + (size_t)b * T * 64 + dh * 32;
        const float sink = p.sinks[head];
        float m = sink, l = 1.0f, acc[32];
#pragma unroll
        for (int d = 0; d < 32; ++d) acc[d] = 0.f;
        for (int i = 0; i < SWA_WIN; ++i) {
            const int pos = tt - (SWA_WIN - 1) + i;
            if (pos >= 0) {
                const float s = dot_row64(K + (size_t)pos * 64, q) - slope * (float)(tt - pos);
                osm_update(s, V + (size_t)pos * 64, m, l, acc);
            }
        }
        const float inv = 1.0f / l;
        bf16_t* O = (bf16_t*)(p.ws + WS_O) + (size_t)(b * T + tt) * D + 512 + head * 64 + dh * 32;
#pragma unroll
        for (int c = 0; c < 4; ++c) {
            u32x4 w; w.x = pk2(acc[8 * c] * inv, acc[8 * c + 1] * inv); w.y = pk2(acc[8 * c + 2] * inv, acc[8 * c + 3] * inv);
            w.z = pk2(acc[8 * c + 4] * inv, acc[8 * c + 5] * inv); w.w = pk2(acc[8 * c + 6] * inv, acc[8 * c + 7] * inv);
            *(u32x4*)(O + 8 * c) = w;
        }
    }
}

__device__ __forceinline__ void topk_insert(float v, int i, float (&tv)[16], int (&ti)[16]) {
#pragma unroll
    for (int k = 0; k < 16; ++k) {
        const bool sw = v > tv[k];
        const float ov = tv[k]; const int oi = ti[k];
        tv[k] = sw ? v : ov; ti[k] = sw ? i : oi;
        v = sw ? ov : v; i = sw ? oi : i;
    }
}
__device__ __forceinline__ void phase_peer_sub(const Params& p) {
    const unsigned char* ws = p.ws;
    const long gt = (long)blockIdx.x * NTHREADS + tid_opaque(), ngt = (long)gridDim.x * NTHREADS;
    const long items = (long)NTOK * 16;
    for (long it = gt; it < items; it += ngt) {
        const int tok = (int)(it % NTOK), hc = (int)(it / NTOK);
        const bf16_t* qp = (const bf16_t*)(ws + WS_QP) + (size_t)tok * PQ + hc * 128;
        float q0[64], q1[64];
        load_row64(qp, q0); load_row64(qp + 64, q1);
        const bf16_t* keys = (const bf16_t*)(ws + WS_PKEYS) + (size_t)hc * 128 * 128;
        float tv[16]; int ti[16];
#pragma unroll
        for (int k = 0; k < 16; ++k) { tv[k] = -INFINITY; ti[k] = 0; }
        for (int n = 0; n < 128; ++n) {
            const float s = dot_row64(keys + (size_t)n * 128, q0) + dot_row64(keys + (size_t)n * 128 + 64, q1);
            topk_insert(s, n, tv, ti);
        }
        float* ov = (float*)(p.ws + WS_TOPV2) + ((size_t)tok * 16 + hc) * 16;
        int* oi = (int*)(p.ws + WS_TOPI2) + ((size_t)tok * 16 + hc) * 16;
#pragma unroll
        for (int k = 0; k < 16; ++k) { ov[k] = tv[k]; oi[k] = ti[k]; }
    }
}
__device__ __forceinline__ void phase_peer_comb(const Params& p) {
    const long gt = (long)blockIdx.x * NTHREADS + tid_opaque(), ngt = (long)gridDim.x * NTHREADS;
    const long items = (long)NTOK * PH;
    for (long it = gt; it < items; it += ngt) {
        const int tok = (int)(it / PH), h = (int)(it % PH);
        const float* v1 = (const float*)(p.ws + WS_TOPV2) + ((size_t)tok * 16 + h * 2) * 16;
        const float* v2 = v1 + 16;
        const int* i1 = (const int*)(p.ws + WS_TOPI2) + ((size_t)tok * 16 + h * 2) * 16;
        const int* i2 = i1 + 16;
        float s2[16];
#pragma unroll
        for (int k = 0; k < 16; ++k) s2[k] = v2[k];
        float tv[16]; int ti[16];
#pragma unroll
        for (int k = 0; k < 16; ++k) { tv[k] = -INFINITY; ti[k] = 0; }
        for (int a = 0; a < 16; ++a) {
            const float s1 = v1[a];
#pragma unroll
            for (int bb = 0; bb < 16; ++bb) topk_insert(s1 + s2[bb], a * 16 + bb, tv, ti);
        }
        float e[16], sum = 0.f;
#pragma unroll
        for (int k = 0; k < 16; ++k) { e[k] = __expf(tv[k] - tv[0]); sum += e[k]; }
        const float inv = 1.0f / sum;
        int* eo = (int*)(p.ws + WS_EIDX) + (size_t)tok * 128 + h * 16;
        float* go = (float*)(p.ws + WS_GATE) + (size_t)tok * 128 + h * 16;
#pragma unroll
        for (int k = 0; k < 16; ++k) { const int ci = ti[k]; eo[k] = i1[ci >> 4] * PNK + i2[ci & 15]; go[k] = e[k] * inv; }
    }
}

typedef float f32x2 __attribute__((ext_vector_type(2)));
__device__ __forceinline__ void unpack16_fp8(const u32x4& w, float (&f)[16]) {
#pragma unroll
    for (int q = 0; q < 4; ++q) {
        const f32x2 lo = __builtin_amdgcn_cvt_pk_f32_fp8((int)w[q], false), hi = __builtin_amdgcn_cvt_pk_f32_fp8((int)w[q], true);
        f[4 * q] = lo.x; f[4 * q + 1] = lo.y; f[4 * q + 2] = hi.x; f[4 * q + 3] = hi.y;
    }
}
__device__ __forceinline__ float reduce8(const float (&d)[8], int lane) {
    const bool b5 = lane & 32, b4 = lane & 16, b3 = lane & 8;
    float e[4], f[2];
#pragma unroll
    for (int i = 0; i < 4; ++i) { const float snd = b5 ? d[i] : d[i + 4], keep = b5 ? d[i + 4] : d[i]; e[i] = keep + __shfl_xor(snd, 32); }
#pragma unroll
    for (int i = 0; i < 2; ++i) { const float snd = b4 ? e[i] : e[i + 2], keep = b4 ? e[i + 2] : e[i]; f[i] = keep + __shfl_xor(snd, 16); }
    const float snd = b3 ? f[0] : f[1], keep = b3 ? f[1] : f[0];
    float g = keep + __shfl_xor(snd, 8);
    g += __shfl_xor(g, 4); g += __shfl_xor(g, 2); g += __shfl_xor(g, 1);
    return g;
}
__device__ __forceinline__ void phase_peer_expert(const Params& p) {
    const unsigned char* ws = p.ws;
    const int tid_ = tid_opaque(), lane = tid_ & 63;
    const int gw = (int)blockIdx.x * (NTHREADS / 64) + __builtin_amdgcn_readfirstlane(tid_ >> 6), ngw = (int)gridDim.x * (NTHREADS / 64);
    const unsigned char* U = ws + WS_U8; const unsigned char* V = ws + WS_V8;
    const unsigned loff = 16u * (unsigned)lane;
    for (int tok = gw; tok < NTOK; tok += ngw) {
        const bf16_t* hg = (const bf16_t*)(ws + WS_H1G + (size_t)tok * D * 2) + loff;
        float a[16];
        {
            const u32x4 w0 = *(const u32x4*)hg, w1 = *(const u32x4*)(hg + 8);
            a[0] = bflo(w0.x); a[1] = bfhi(w0.x); a[2] = bflo(w0.y); a[3] = bfhi(w0.y); a[4] = bflo(w0.z); a[5] = bfhi(w0.z); a[6] = bflo(w0.w); a[7] = bfhi(w0.w);
            a[8] = bflo(w1.x); a[9] = bfhi(w1.x); a[10] = bflo(w1.y); a[11] = bfhi(w1.y); a[12] = bflo(w1.z); a[13] = bfhi(w1.z); a[14] = bflo(w1.w); a[15] = bfhi(w1.w);
        }
        const float rstd2 = (1.0f / U8_SCALE) / sqrtf(((const float*)(ws + WS_SS2))[tok] * (1.0f / D) + EPS);
        const int e_lo = ((const int*)(ws + WS_EIDX))[(size_t)tok * 128 + lane], e_hi = ((const int*)(ws + WS_EIDX))[(size_t)tok * 128 + 64 + lane];
        const float g_lo = ((const float*)(ws + WS_GATE))[(size_t)tok * 128 + lane], g_hi = ((const float*)(ws + WS_GATE))[(size_t)tok * 128 + 64 + lane];
        float acc[16];
#pragma unroll
        for (int i = 0; i < 16; ++i) acc[i] = 0.f;
        u32x4 uw[8], vw[8];
#pragma unroll
        for (int k = 0; k < 8; ++k) { const int e = __builtin_amdgcn_readlane(e_lo, k); uw[k] = *(const u32x4*)(U + (size_t)e * D + loff); vw[k] = *(const u32x4*)(V + (size_t)e * D + loff); }
#pragma unroll 1
        for (int b = 0; b < 16; ++b) {
            const int nsrc = (b + 1 < 8) ? e_lo : e_hi; const int nbase = ((b + 1) & 7) * 8;
            float d[8];
#pragma unroll
            for (int k = 0; k < 8; ++k) {
                float uf[16]; unpack16_fp8(uw[k], uf);
                float d0 = 0.f, d1 = 0.f;
#pragma unroll
                for (int i = 0; i < 16; i += 2) { d0 += a[i] * uf[i]; d1 += a[i + 1] * uf[i + 1]; }
                d[k] = d0 + d1;
                __builtin_amdgcn_sched_barrier(0);
            }
            if (b + 1 < 16) {
#pragma unroll
                for (int k = 0; k < 8; ++k) { const int e = __builtin_amdgcn_readlane(nsrc, nbase + k); uw[k] = *(const u32x4*)(U + (size_t)e * D + loff); }
            }
            const float dk = reduce8(d, lane);
            const float gsel = __shfl((b < 8) ? g_lo : g_hi, (b & 7) * 8 + ((lane >> 3) & 7));
            const float w = gsel * gelu_tanh(dk * rstd2);
#pragma unroll
            for (int k = 0; k < 8; ++k) {
                const float wk = __uint_as_float((unsigned)__builtin_amdgcn_readlane((int)__float_as_uint(w), 8 * k));
                float vf[16]; unpack16_fp8(vw[k], vf);
#pragma unroll
                for (int i = 0; i < 16; ++i) acc[i] += wk * vf[i];
                __builtin_amdgcn_sched_barrier(0);
            }
            if (b + 1 < 16) {
#pragma unroll
                for (int k = 0; k < 8; ++k) { const int e = __builtin_amdgcn_readlane(nsrc, nbase + k); vw[k] = *(const u32x4*)(V + (size_t)e * D + loff); }
            }
        }
        float* orow = (float*)((unsigned char*)p.out + (size_t)tok * D * 4) + loff;
        float y[16]; float ss = 0.f;
#pragma unroll
        for (int q = 0; q < 4; ++q) {
            const f32x4 h = *(const f32x4*)(orow + 4 * q);
            y[4 * q] = h.x + acc[4 * q] * (1.0f / V8_SCALE); y[4 * q + 1] = h.y + acc[4 * q + 1] * (1.0f / V8_SCALE);
            y[4 * q + 2] = h.z + acc[4 * q + 2] * (1.0f / V8_SCALE); y[4 * q + 3] = h.w + acc[4 * q + 3] * (1.0f / V8_SCALE);
        }
#pragma unroll
        for (int i = 0; i < 16; ++i) ss += y[i] * y[i];
        const float rstd = 1.0f / sqrtf(wave_sum(ss) * (1.0f / D) + EPS);
#pragma unroll
        for (int q = 0; q < 4; ++q) {
            const f32x4 g = *(const f32x4*)(p.lnf_g + loff + 4 * q);
            *(f32x4*)(orow + 4 * q) = (f32x4){y[4 * q] * rstd * g.x, y[4 * q + 1] * rstd * g.y, y[4 * q + 2] * rstd * g.z, y[4 * q + 3] * rstd * g.w};
        }
    }
}


namespace psel {
#define HD __host__ __device__ __forceinline__
HD unsigned f2ord(float f) { unsigned u = __builtin_bit_cast(unsigned, f); const unsigned m = (unsigned)((int)u >> 31); return u ^ (m | 0x80000000u); }
HD float ord2f(unsigned o) { const unsigned m = (unsigned)((int)o >> 31); return __builtin_bit_cast(float, o ^ (~m | 0x80000000u)); }
HD unsigned umax_(unsigned a, unsigned b) { return a > b ? a : b; }
HD unsigned umin_(unsigned a, unsigned b) { return a < b ? a : b; }
HD void sort16_desc(unsigned (&a)[16]) {
#pragma unroll
    for (int k = 2; k <= 16; k <<= 1)
#pragma unroll
        for (int j = k >> 1; j > 0; j >>= 1)
#pragma unroll
            for (int i = 0; i < 16; ++i) {
                const int l = i ^ j;
                if (l > i) {
                    const bool up = ((i & k) == 0);
                    const unsigned hi = umax_(a[i], a[l]), lo = umin_(a[i], a[l]);
                    a[i] = up ? hi : lo; a[l] = up ? lo : hi;
                }
            }
}
HD void merge16_desc(unsigned (&a)[16], const unsigned (&b)[16]) {
#pragma unroll
    for (int i = 0; i < 16; ++i) a[i] = umax_(a[i], b[15 - i]);
#pragma unroll
    for (int j = 8; j > 0; j >>= 1)
#pragma unroll
        for (int i = 0; i < 16; ++i) {
            const int l = i ^ j;
            if (l > i) { const unsigned hi = umax_(a[i], a[l]), lo = umin_(a[i], a[l]); a[i] = hi; a[l] = lo; }
        }
}
HD void top16_of_64(unsigned (&g0)[16], unsigned (&g1)[16], unsigned (&g2)[16], unsigned (&g3)[16]) {
    sort16_desc(g0); sort16_desc(g1); sort16_desc(g2); sort16_desc(g3);
    merge16_desc(g0, g1); merge16_desc(g2, g3); merge16_desc(g0, g2);
}
struct PairTab { int a[64]; int b[64]; int n; };
constexpr PairTab make_pairs() {
    PairTab t{}; int n = 0;
    for (int a = 0; a < 16; ++a) for (int b = 0; b < 16; ++b) if ((a + 1) * (b + 1) <= 16) { t.a[n] = a; t.b[n] = b; ++n; }
    t.n = n; for (int i = n; i < 64; ++i) { t.a[i] = 0; t.b[i] = 0; }
    return t;
}
#undef HD
typedef float f32x16 __attribute__((ext_vector_type(16)));
#define PLAS __attribute__((address_space(3)))
static constexpr PairTab PT = make_pairs();
__device__ __forceinline__ constexpr int crow_c(int r) { return (r & 3) + 8 * (r >> 2); }
__device__ __forceinline__ void phase_peer_select(const Params& p, unsigned char* lds_generic) {
    const unsigned char* ws = p.ws;
    const int tid = tid_opaque(), lane = tid & 63, wid = __builtin_amdgcn_readfirstlane(tid >> 6), r32 = lane & 31, hi = lane >> 5;
    PLAS int* tab = (PLAS int*)((PLAS unsigned char*)lds_generic) + wid * 2048;
    const int gw = (int)blockIdx.x * (NTHREADS / 64) + wid, ngw = (int)gridDim.x * (NTHREADS / 64);
    const __amdgpu_buffer_rsrc_t rq = __builtin_amdgcn_make_buffer_rsrc((void*)(p.ws + WS_QP), (short)0, (int)((size_t)NTOK * PQ * 2), 0x00020000);
    const __amdgpu_buffer_rsrc_t rk = __builtin_amdgcn_make_buffer_rsrc((void*)(p.ws + WS_PKEYS), (short)0, 16 * 128 * 128 * 2, 0x00020000);
    for (int task = gw; task < (NTOK / 32) * PH; task += ngw) {
        const int tb = task >> 3, h = task & 7, tok = 32 * tb + r32;
        int hi4 = 4 * hi; asm volatile("" : "+v"(hi4));
        unsigned k1[16], k2[16];
#pragma unroll
        for (int c = 0; c < 2; ++c) {
            const int hc = h * 2 + c;
            const unsigned qoff = (unsigned)(r32 * PQ + 8 * hi) * 2u, koff = (unsigned)(r32 * 128 + 8 * hi) * 2u;
            const int qso = (tb * 32 * PQ + hc * 128) * 2, kso = hc * 128 * 128 * 2;
            bf16x8 qf[8];
#pragma unroll
            for (int d0 = 0; d0 < 8; ++d0) qf[d0] = __builtin_bit_cast(bf16x8, __builtin_amdgcn_raw_buffer_load_b128(rq, (int)qoff, qso + 32 * d0, 0));
            unsigned g[4][16];
#pragma unroll
            for (int nt = 0; nt < 4; ++nt) {
                f32x16 acc;
#pragma unroll
                for (int r = 0; r < 16; ++r) acc[r] = 0.f;
#pragma unroll
                for (int d0 = 0; d0 < 8; ++d0) {
                    const bf16x8 kf = __builtin_bit_cast(bf16x8, __builtin_amdgcn_raw_buffer_load_b128(rk, (int)koff, kso + nt * 8192 + 32 * d0, 0));
                    acc = __builtin_amdgcn_mfma_f32_32x32x16_bf16(kf, qf[d0], acc, 0, 0, 0);
                }
#pragma unroll
                for (int r = 0; r < 16; ++r) g[nt][r] = (f2ord(acc[r]) & 0xFFFFFF80u) | (unsigned)((127 - 32 * nt - crow_c(r)) - hi4);
                __builtin_amdgcn_sched_barrier(0);
            }
            top16_of_64(g[0], g[1], g[2], g[3]);
            unsigned pb[16];
#pragma unroll
            for (int i = 0; i < 16; ++i) pb[i] = (unsigned)__shfl_xor((int)g[0][i], 32);
            merge16_desc(g[0], pb);
#pragma unroll
            for (int i = 0; i < 16; ++i) { if (c == 0) k1[i] = g[0][i]; else k2[i] = g[0][i]; }
        }
        float v1[16], v2[16];
#pragma unroll
        for (int i = 0; i < 16; ++i) { v1[i] = ord2f(k1[i] & 0xFFFFFF80u); v2[i] = ord2f(k2[i] & 0xFFFFFF80u); }
        unsigned cg[4][16];
#pragma unroll
        for (int s = 0; s < 64; ++s) {
            unsigned key = 0u;
            if (s < PT.n) key = (f2ord(v1[PT.a[s]] + v2[PT.b[s]]) & 0xFFFFFF00u) | (unsigned)(255 - (PT.a[s] * 16 + PT.b[s]));
            cg[s >> 4][s & 15] = key;
        }
        top16_of_64(cg[0], cg[1], cg[2], cg[3]);
#pragma unroll
        for (int i = 0; i < 16; ++i) { tab[i * 64 + lane] = 127 - (int)(k1[i] & 127u); tab[(16 + i) * 64 + lane] = 127 - (int)(k2[i] & 127u); }
        __builtin_amdgcn_fence(__ATOMIC_RELEASE, "wavefront"); __builtin_amdgcn_wave_barrier();
        int eo[16]; float ge[16]; float gsum = 0.f;
        const float top = ord2f(cg[0][0] & 0xFFFFFF00u);
#pragma unroll
        for (int k = 0; k < 16; ++k) {
            const int ab = 255 - (int)(cg[0][k] & 255u);
            eo[k] = tab[(ab >> 4) * 64 + lane] * PNK + tab[(16 + (ab & 15)) * 64 + lane];
            ge[k] = __expf(ord2f(cg[0][k] & 0xFFFFFF00u) - top); gsum += ge[k];
        }
        __builtin_amdgcn_wave_barrier();
        const float ginv = 1.0f / gsum;
        if (hi == 0) {
            int* eout = (int*)(p.ws + WS_EIDX) + (size_t)tok * 128 + h * 16;
            float* gout = (float*)(p.ws + WS_GATE) + (size_t)tok * 128 + h * 16;
#pragma unroll
            for (int q = 0; q < 4; ++q) {
                *(u32x4*)(eout + 4 * q) = (u32x4){(unsigned)eo[4 * q], (unsigned)eo[4 * q + 1], (unsigned)eo[4 * q + 2], (unsigned)eo[4 * q + 3]};
                *(f32x4*)(gout + 4 * q) = (f32x4){ge[4 * q] * ginv, ge[4 * q + 1] * ginv, ge[4 * q + 2] * ginv, ge[4 * q + 3] * ginv};
            }
        }
    }
}
}

namespace att {
typedef float f32x16 __attribute__((ext_vector_type(16)));
typedef short s16x4 __attribute__((ext_vector_type(4)));
typedef short v4i16_t __attribute__((ext_vector_type(4)));
#define ALAS __attribute__((address_space(3)))
typedef ALAS unsigned char* lptr;
constexpr int L_K = 0, L_V = 16384, L_IMP = 32768, L_SELM = L_IMP + 64 * 129 * 4, L_UNION = L_SELM + 1024, L_WSCR = L_UNION + 16, L_ACC = L_WSCR + 8 * 256, L_END = L_ACC + 8 * 8192;
constexpr float LOG2E = 1.4426950408889634f;
constexpr float THR = 10.0f;
__device__ __forceinline__ constexpr int crow_c(int r) { return (r & 3) + 8 * (r >> 2); }
__device__ __forceinline__ unsigned cvtpk(float lo, float hi) { typedef float f2 __attribute__((ext_vector_type(2))); typedef __bf16 b2 __attribute__((ext_vector_type(2)));
    f2 v = {lo, hi}; b2 b = __builtin_convertvector(v, b2); return __builtin_bit_cast(unsigned, b); }
__device__ __forceinline__ s16x4 vtr(lptr p) { return __builtin_bit_cast(s16x4, __builtin_amdgcn_ds_read_tr16_b64_v4i16((ALAS v4i16_t*)p)); }

struct Stage { u32x4 k, v; };
__device__ __forceinline__ void stage_load(const bf16_t* Kt, const bf16_t* Vt, int wid, int lane, Stage& s, bool withV) {
    s.k = *(const u32x4*)(Kt + (size_t)lane * 64 + wid * 8);
    if (withV) s.v = *(const u32x4*)(Vt + (size_t)(16 * (wid & 3) + (lane >> 2)) * 64 + (wid >> 2) * 32 + (lane & 3) * 8);
}
__device__ __forceinline__ void stage_store(lptr kbuf, lptr vbuf, int wid, int lane, const Stage& s, bool withV) {
    *(ALAS u32x4*)(kbuf + wid * 1024 + lane * 16) = s.k;
    if (withV) *(ALAS u32x4*)(vbuf + wid * 1024 + lane * 16) = s.v;
}
__device__ __forceinline__ void qk_tile(f32x16& p0, f32x16& p1, lptr kbuf, const bf16x8 (&qf)[4], float cb, float sk, int r32, int hi) {
    asm volatile("" : "+v"(sk));
    const float cb2 = cb + sk * (float)(4 * hi);
#pragma unroll
    for (int r = 0; r < 16; ++r) { p0[r] = cb2 + sk * (float)crow_c(r); p1[r] = cb2 + sk * (float)(crow_c(r) + 32); }
    lptr kb = kbuf + hi * 1024 + r32 * 16;
#pragma unroll
    for (int d0 = 0; d0 < 4; ++d0) {
        const bf16x8 k0 = *(const ALAS bf16x8*)(kb + d0 * 2048), k1 = *(const ALAS bf16x8*)(kb + d0 * 2048 + 512);
        p0 = __builtin_amdgcn_mfma_f32_32x32x16_bf16(k0, qf[d0], p0, 0, 0, 0);
        p1 = __builtin_amdgcn_mfma_f32_32x32x16_bf16(k1, qf[d0], p1, 0, 0, 0);
    }
}
__device__ __forceinline__ void mask_tile(f32x16& p0, f32x16& p1, int hi_lim, int lo_lim, int hi) {
    int hl = hi_lim - 4 * hi, ll1 = lo_lim + 1 - 4 * hi;
    asm volatile("" : "+v"(hl), "+v"(ll1));
#pragma unroll
    for (int r = 0; r < 16; ++r) {
        const int c0 = crow_c(r), c1 = crow_c(r) + 32;
        const unsigned t0 = (unsigned)((c0 - ll1) | (hl - c0)), t1 = (unsigned)((c1 - ll1) | (hl - c1));
        p0[r] = fminf(p0[r], __uint_as_float((t0 & 0x80000000u) | 0x7f800000u));
        p1[r] = fminf(p1[r], __uint_as_float((t1 & 0x80000000u) | 0x7f800000u));
    }
}
__device__ __forceinline__ float max3f(float a, float b, float c) { float r; asm("v_max3_f32 %0, %1, %2, %3" : "=v"(r) : "v"(a), "v"(b), "v"(c)); return r; }
__device__ __forceinline__ float max2f(float a, float b) { float r; asm("v_max_f32_e32 %0, %1, %2" : "=v"(r) : "v"(a), "v"(b)); return r; }
__device__ __forceinline__ float tile_max(const f32x16& p0, const f32x16& p1) {
    float a = max3f(p0[0], p0[1], p1[0]), b = max3f(p0[2], p0[3], p1[1]); a = max3f(a, p1[2], p1[3]);
#pragma unroll
    for (int r = 4; r < 16; r += 4) { a = max3f(a, p0[r], p0[r + 1]); b = max3f(b, p0[r + 2], p0[r + 3]); a = max3f(a, p1[r], p1[r + 1]); b = max3f(b, p1[r + 2], p1[r + 3]); }
    const float m = max2f(a, b);
    return max2f(m, __shfl_xor(m, 32));
}
__device__ __forceinline__ float tile_sum(const f32x16& p0, const f32x16& p1) {
    float a = p0[0] + p1[0];
#pragma unroll
    for (int r = 1; r < 16; ++r) a += p0[r] + p1[r];
    return a + __shfl_xor(a, 32);
}
__device__ __forceinline__ void pack_p(u32x4 (&pw)[4], const f32x16& p0, const f32x16& p1) {
    pw[0] = (u32x4){cvtpk(p0[0], p0[1]), cvtpk(p0[2], p0[3]), cvtpk(p0[4], p0[5]), cvtpk(p0[6], p0[7])};
    pw[1] = (u32x4){cvtpk(p0[8], p0[9]), cvtpk(p0[10], p0[11]), cvtpk(p0[12], p0[13]), cvtpk(p0[14], p0[15])};
    pw[2] = (u32x4){cvtpk(p1[0], p1[1]), cvtpk(p1[2], p1[3]), cvtpk(p1[4], p1[5]), cvtpk(p1[6], p1[7])};
    pw[3] = (u32x4){cvtpk(p1[8], p1[9]), cvtpk(p1[10], p1[11]), cvtpk(p1[12], p1[13]), cvtpk(p1[14], p1[15])};
}
__device__ __forceinline__ void pv_packed(f32x16& o0, f32x16& o1, const u32x4 (&pw)[4], lptr vbuf, int lane, int hi) {
    lptr vp = vbuf + ((lane >> 4) & 1) * 32 + (lane & 3) * 8 + (4 * hi + ((lane & 15) >> 2)) * 64;
#pragma unroll
    for (int ks = 0; ks < 4; ++ks) {
        const s16x4 a = vtr(vp + ks * 1024), b = vtr(vp + ks * 1024 + 512);
        const s16x4 c = vtr(vp + 4096 + ks * 1024), d = vtr(vp + 4096 + ks * 1024 + 512);
        const bf16x8 v0 = (bf16x8){a[0], a[1], a[2], a[3], b[0], b[1], b[2], b[3]}, v1 = (bf16x8){c[0], c[1], c[2], c[3], d[0], d[1], d[2], d[3]};
        const bf16x8 pa = __builtin_bit_cast(bf16x8, pw[ks]);
        o0 = __builtin_amdgcn_mfma_f32_32x32x16_bf16(pa, v0, o0, 0, 0, 0);
        o1 = __builtin_amdgcn_mfma_f32_32x32x16_bf16(pa, v1, o1, 0, 0, 0);
    }
}
__device__ __forceinline__ void pv_tile(f32x16& o0, f32x16& o1, const f32x16& p0, const f32x16& p1, lptr vbuf, int lane, int hi) {
    u32x4 pw[4]; pack_p(pw, p0, p1);
    pv_packed(o0, o1, pw, vbuf, lane, hi);
}
__device__ __forceinline__ void ov_frags(bf16x8 (&ovf)[4], int r32, int hi) {
#pragma unroll
    for (int ks = 0; ks < 4; ++ks)
#pragma unroll
        for (int j = 0; j < 8; ++j) {
            const int q4 = 4 * ks + 2 * (j >> 2) + hi;
            const bool on = (r32 == q4) || ((j & 3) == 3 && r32 == q4 + 1);
            ovf[ks][j] = on ? (short)0x3F80 : (short)0;
        }
}
__device__ __forceinline__ void scale_rows(f32x16& o0, f32x16& o1, float f, ALAS float* wscr, int r32, int hi) {
    if (hi == 0) wscr[r32] = f;
    __builtin_amdgcn_fence(__ATOMIC_RELEASE, "wavefront"); __builtin_amdgcn_wave_barrier();
#pragma unroll
    for (int r = 0; r < 16; ++r) { const float a = wscr[crow_c(r) + 4 * hi]; o0[r] *= a; o1[r] *= a; }
    __builtin_amdgcn_wave_barrier();
}
template <bool FIRST>
__device__ __forceinline__ void acc_rows(ALAS float* accw, const f32x16& o0, const f32x16& o1, float f, ALAS float* wscr, int r32, int hi) {
    if (hi == 0) wscr[r32] = f;
    __builtin_amdgcn_fence(__ATOMIC_RELEASE, "wavefront"); __builtin_amdgcn_wave_barrier();
#pragma unroll
    for (int r = 0; r < 16; ++r) {
        const int row = crow_c(r) + 4 * hi; const float a = wscr[row];
        ALAS float* d = accw + row * 64 + r32;
        if (FIRST) { d[0] = o0[r] * a; d[32] = o1[r] * a; } else { d[0] += o0[r] * a; d[32] += o1[r] * a; }
    }
    __builtin_amdgcn_wave_barrier();
}
__device__ __forceinline__ void store_acc(ALAS float* accw, bf16_t* O, int lane) {
    __builtin_amdgcn_fence(__ATOMIC_RELEASE, "wavefront"); __builtin_amdgcn_wave_barrier();
#pragma unroll
    for (int it = 0; it < 4; ++it) {
        const int item = it * 64 + lane, row = item >> 3, ch = item & 7;
        const f32x4 x = *(const ALAS f32x4*)(accw + row * 64 + ch * 8), y = *(const ALAS f32x4*)(accw + row * 64 + ch * 8 + 4);
        u32x4 w; w.x = cvtpk(x[0], x[1]); w.y = cvtpk(x[2], x[3]); w.z = cvtpk(y[0], y[1]); w.w = cvtpk(y[2], y[3]);
        *(u32x4*)(O + (size_t)(row & 7) * D + (row >> 3) * 64 + ch * 8) = w;
    }
    __builtin_amdgcn_wave_barrier();
}
struct Br { float m, l; f32x16 o0, o1; };
template <bool MASK>
__device__ __forceinline__ void attend_tile(Br& s, lptr kbuf, lptr vbuf, const bf16x8 (&qf)[4], float cb, float sk, int hi_lim, int lo_lim, ALAS float* wscr, int lane, int r32, int hi) {
    f32x16 p0, p1;
    const float mu = (s.m < -1e29f) ? 0.f : s.m;
    qk_tile(p0, p1, kbuf, qf, cb - mu, sk, r32, hi);
    if (MASK) mask_tile(p0, p1, hi_lim, lo_lim, hi);
    const float rm = tile_max(p0, p1);
    if (__any(rm + mu > s.m + THR)) {
        const float mn = fmaxf(s.m, rm + mu), alpha = __builtin_amdgcn_exp2f(s.m - mn), delta = mn - mu;
        s.l *= alpha; s.m = mn;
        scale_rows(s.o0, s.o1, alpha, wscr, r32, hi);
#pragma unroll
        for (int r = 0; r < 16; ++r) { p0[r] -= delta; p1[r] -= delta; }
    }
#pragma unroll
    for (int r = 0; r < 16; ++r) { p0[r] = __builtin_amdgcn_exp2f(p0[r]); p1[r] = __builtin_amdgcn_exp2f(p1[r]); }
    s.l += tile_sum(p0, p1);
    pv_tile(s.o0, s.o1, p0, p1, vbuf, lane, hi);
}

#define ATT_BAR() asm volatile("s_waitcnt lgkmcnt(0)\n\ts_barrier" ::: "memory")
template <int PVAR = 0>
__device__ __forceinline__ void nsa_unit(const Params& p, unsigned char* lds_generic, int b, int g, int tile) {
    lptr lds = (lptr)lds_generic;
    const int tid = tid_opaque(), lane = tid & 63, wid = __builtin_amdgcn_readfirstlane(tid >> 6), r32 = lane & 31, hi = lane >> 5;
    const int h = r32 >> 3, qi = r32 & 7, tq = 8 * wid + qi, t = 64 * tile + tq, head = g * 4 + h;
    const float slope = exp2f(-0.5f * (float)(9 + head)) * LOG2E;
    const unsigned char* ws = p.ws;
    ALAS float* imp = (ALAS float*)(lds + L_IMP);
    ALAS unsigned* selm = (ALAS unsigned*)(lds + L_SELM);
    ALAS unsigned* uni = (ALAS unsigned*)(lds + L_UNION);
    ALAS float* wscr = (ALAS float*)(lds + L_WSCR) + wid * 64;
    const bf16_t* KC = (const bf16_t*)(ws + WS_KC) + (size_t)(b * 2 + g) * NCMPP * 64;
    const bf16_t* VC = (const bf16_t*)(ws + WS_VC) + (size_t)(b * 2 + g) * NCMPP * 64;
    const bf16_t* KS = (const bf16_t*)(ws + WS_KV6 + 2 * KV6_STRIDE) + (size_t)(b * 2 + g) * T * 64;
    const bf16_t* VS = (const bf16_t*)(ws + WS_KV6 + 3 * KV6_STRIDE) + (size_t)(b * 2 + g) * T * 64;
    const bf16_t* KW = (const bf16_t*)(ws + WS_KV6 + 4 * KV6_STRIDE) + (size_t)(b * 2 + g) * T * 64;
    const bf16_t* VW = (const bf16_t*)(ws + WS_KV6 + 5 * KV6_STRIDE) + (size_t)(b * 2 + g) * T * 64;
    const float* gs = (const float*)(ws + WS_GSIG) + (size_t)(b * T + t) * 24 + head * 3;
    bf16x8 qf[4];
    {
        const bf16_t* qp = (const bf16_t*)(ws + WS_QN) + ((size_t)(b * 8 + head) * T + t) * 64 + 8 * hi;
#pragma unroll
        for (int d0 = 0; d0 < 4; ++d0) qf[d0] = *(const bf16x8*)(qp + 16 * d0);
    }
    for (int i = tid; i < 64 * 129; i += NTHREADS) imp[i] = 0.f;
    if (tid < 4) uni[tid] = 0u;
    ALAS float* accw = (ALAS float*)(lds + L_ACC) + wid * 2048;
    const int nc = 4 * tile + 3, n = (nc + 63) >> 6, n2 = 2 * n;
    const int nw = (tile < 8) ? tile + 1 : 9, NS = n2 + nw;
#define GK(x) ((x) < n2 ? KC + (size_t)((x) < n ? (x) : (x) - n) * 4096 : ((x) < NS ? KW + (size_t)(tile - ((x) - n2)) * 4096 : KS + (size_t)tile * 4096))
#define GV(x) ((x) < n2 ? VC + (size_t)((x) < n ? (x) : (x) - n) * 4096 : ((x) < NS ? VW + (size_t)(tile - ((x) - n2)) * 4096 : VS + (size_t)tile * 4096))
#define PIPE_HEAD(x) do { if ((x) + 2 <= NS) stage_load(GK((x) + 2), GV((x) + 2), wid, lane, sB, true); } while (0)
#define PIPE_TAIL(x) do { if ((x) + 1 <= NS) stage_store(lds + L_K + (cur ^ 1) * 8192, lds + L_V + (cur ^ 1) * 8192, wid, lane, sA, true); ATT_BAR(); cur ^= 1; sA = sB; } while (0)
    Stage sA, sB; int cur = 0;
    stage_load(GK(0), GV(0), wid, lane, sA, true);
    stage_store(lds + L_K, lds + L_V, wid, lane, sA, true);
    ATT_BAR();
    stage_load(GK(1), GV(1), wid, lane, sA, true);
    const int cmax = (t >= 31) ? ((t - 31) >> 4) : -1;
    const float skc = 16.0f * slope, cbc = -slope * (float)(t - 31);
    float mc = -1e30f, lc = 0.f;
    for (int x = 0; x < n; ++x) {
        PIPE_HEAD(x);
        const int i = x;
        if (!(PVAR & 1)) {
        f32x16 p0, p1;
        qk_tile(p0, p1, lds + L_K + cur * 8192, qf, cbc + skc * (float)(64 * i), skc, r32, hi);
        if (__any(cmax - 64 * i < 63)) mask_tile(p0, p1, cmax - 64 * i, -1, hi);
        const float rm = tile_max(p0, p1), mn = fmaxf(mc, rm);
#pragma unroll
        for (int r = 0; r < 16; ++r) { p0[r] = __builtin_amdgcn_exp2f(p0[r] - mn); p1[r] = __builtin_amdgcn_exp2f(p1[r] - mn); }
        lc = lc * __builtin_amdgcn_exp2f(mc - mn) + tile_sum(p0, p1); mc = mn;
        }
        PIPE_TAIL(x);
    }
    {
        const float nrm = (lc > 0.f) ? (mc + __builtin_amdgcn_logf(lc)) : 0.f;
        Br sc; sc.m = 0.f; sc.l = 0.f;
#pragma unroll
        for (int r = 0; r < 16; ++r) { sc.o0[r] = 0.f; sc.o1[r] = 0.f; }
        bf16x8 ovf[4]; ov_frags(ovf, r32, hi);
        for (int x = n; x < n2; ++x) {
            PIPE_HEAD(x);
            const int i = x - n;
            if (!(PVAR & 2)) {
            f32x16 p0, p1;
            qk_tile(p0, p1, lds + L_K + cur * 8192, qf, cbc + skc * (float)(64 * i) - nrm, skc, r32, hi);
            if (__any(cmax - 64 * i < 63)) mask_tile(p0, p1, cmax - 64 * i, -1, hi);
#pragma unroll
            for (int r = 0; r < 16; ++r) { p0[r] = __builtin_amdgcn_exp2f(p0[r]); p1[r] = __builtin_amdgcn_exp2f(p1[r]); }
            u32x4 pw[4]; pack_p(pw, p0, p1);
            pv_packed(sc.o0, sc.o1, pw, lds + L_V + cur * 8192, lane, hi);
            f32x16 ia;
#pragma unroll
            for (int r = 0; r < 16; ++r) ia[r] = 0.f;
#pragma unroll
            for (int ks = 0; ks < 4; ++ks) ia = __builtin_amdgcn_mfma_f32_32x32x16_bf16(__builtin_bit_cast(bf16x8, pw[ks]), ovf[ks], ia, 0, 0, 0);
            const int sb = 16 * i + r32;
            if (r32 <= 16 && sb < NSEL) {
#pragma unroll
                for (int m = 0; m < 4; ++m) atomicAdd((float*)(imp + (8 * wid + 4 * hi + m) * 129 + sb), (ia[m] + ia[m + 4]) + (ia[m + 8] + ia[m + 12]));
            }
            }
            PIPE_TAIL(x);
        }
        acc_rows<true>(accw, sc.o0, sc.o1, gs[0], wscr, r32, hi);
    }
    {
        Br sw; sw.m = -1e30f; sw.l = 0.f;
#pragma unroll
        for (int r = 0; r < 16; ++r) { sw.o0[r] = 0.f; sw.o1[r] = 0.f; }
        for (int x = n2; x < NS; ++x) {
            PIPE_HEAD(x);
            const int j = tile - (x - n2);
            const float cb = -slope * (float)(t - 64 * j);
            if (PVAR & 4) {} else
            if (j == tile) attend_tile<true>(sw, lds + L_K + cur * 8192, lds + L_V + cur * 8192, qf, cb, slope, tq, -1, wscr, lane, r32, hi);
            else if (j == tile - 8) attend_tile<true>(sw, lds + L_K + cur * 8192, lds + L_V + cur * 8192, qf, cb, slope, 63, tq, wscr, lane, r32, hi);
            else attend_tile<false>(sw, lds + L_K + cur * 8192, lds + L_V + cur * 8192, qf, cb, slope, 63, -1, wscr, lane, r32, hi);
            PIPE_TAIL(x);
        }
        acc_rows<false>(accw, sw.o0, sw.o1, gs[2] / fmaxf(sw.l, 1e-30f), wscr, r32, hi);
    }
#undef GK
#undef GV
#undef PIPE_HEAD
#undef PIPE_TAIL
    if (!(PVAR & 16)) {
        const int q = tid >> 3, sub = tid & 7;
        unsigned kq[16];
#pragma unroll
        for (int i = 0; i < 16; ++i) {
            const int j = sub * 16 + i; float x = imp[q * 129 + j];
            if (j == 0 || j == tile || j == tile - 1) x = 1.0e4f;
            if (j > tile) x = -INFINITY;
            kq[i] = (psel::f2ord(x) & 0xFFFFFF80u) | (unsigned)(127 - j);
        }
        psel::sort16_desc(kq);
#pragma unroll
        for (int off = 1; off < 8; off <<= 1) {
            unsigned pb[16];
#pragma unroll
            for (int i = 0; i < 16; ++i) pb[i] = (unsigned)__shfl_xor((int)kq[i], off);
            psel::merge16_desc(kq, pb);
        }
        if (sub == 0) {
            unsigned w0 = 0u, w1 = 0u, w2 = 0u, w3 = 0u;
            const unsigned ninf = psel::f2ord(-INFINITY) & 0xFFFFFF80u;
#pragma unroll
            for (int i = 0; i < 16; ++i) {
                const int bj = 127 - (int)(kq[i] & 127u); const bool ok = (kq[i] & 0xFFFFFF80u) != ninf;
                const int k = bj >> 5; const unsigned bit = ok ? (1u << (bj & 31)) : 0u;
                w0 |= (k == 0) ? bit : 0u; w1 |= (k == 1) ? bit : 0u; w2 |= (k == 2) ? bit : 0u; w3 |= (k == 3) ? bit : 0u;
            }
            selm[q * 4 + 0] = w0; selm[q * 4 + 1] = w1; selm[q * 4 + 2] = w2; selm[q * 4 + 3] = w3;
            atomicOr((unsigned*)(uni + 0), w0); atomicOr((unsigned*)(uni + 1), w1); atomicOr((unsigned*)(uni + 2), w2); atomicOr((unsigned*)(uni + 3), w3);
        }
    }
    __syncthreads();
    {
        unsigned u0 = uni[0], u1 = uni[1], u2 = uni[2], u3 = uni[3];
        u0 = __builtin_amdgcn_readfirstlane(u0); u1 = __builtin_amdgcn_readfirstlane(u1); u2 = __builtin_amdgcn_readfirstlane(u2); u3 = __builtin_amdgcn_readfirstlane(u3);
        const unsigned s0 = selm[tq * 4 + 0], s1 = selm[tq * 4 + 1], s2 = selm[tq * 4 + 2], s3 = selm[tq * 4 + 3];
        Br sb_; sb_.m = -1e30f; sb_.l = 0.f;
#pragma unroll
        for (int r = 0; r < 16; ++r) { sb_.o0[r] = 0.f; sb_.o1[r] = 0.f; }
#define POP_BLOCK(j) do { if (u3) { const int bb = 31 - __builtin_clz(u3); u3 ^= 1u << bb; j = 96 + bb; } else if (u2) { const int bb = 31 - __builtin_clz(u2); u2 ^= 1u << bb; j = 64 + bb; } \
        else if (u1) { const int bb = 31 - __builtin_clz(u1); u1 ^= 1u << bb; j = 32 + bb; } else if (u0) { const int bb = 31 - __builtin_clz(u0); u0 ^= 1u << bb; j = bb; } else j = -1; } while (0)
        int j, j1, j2; POP_BLOCK(j); POP_BLOCK(j1); POP_BLOCK(j2);
        if (j1 >= 0) stage_load(KS + (size_t)j1 * 4096, VS + (size_t)j1 * 4096, wid, lane, sA, true);
        while (j >= 0) {
            if (j2 >= 0) stage_load(KS + (size_t)j2 * 4096, VS + (size_t)j2 * 4096, wid, lane, sB, true);
            const unsigned wsel = (j >> 5) == 0 ? s0 : (j >> 5) == 1 ? s1 : (j >> 5) == 2 ? s2 : s3;
            const bool mine = (wsel >> (j & 31)) & 1u;
            if (!(PVAR & 8) && __any(mine)) {
                const float cb = mine ? -slope * (float)(t - 64 * j) : -INFINITY;
                if (j == tile) attend_tile<true>(sb_, lds + L_K + cur * 8192, lds + L_V + cur * 8192, qf, cb, slope, tq, -1, wscr, lane, r32, hi);
                else attend_tile<false>(sb_, lds + L_K + cur * 8192, lds + L_V + cur * 8192, qf, cb, slope, 63, -1, wscr, lane, r32, hi);
            }
            if (j1 >= 0) stage_store(lds + L_K + (cur ^ 1) * 8192, lds + L_V + (cur ^ 1) * 8192, wid, lane, sA, true);
            ATT_BAR();
            cur ^= 1; sA = sB; j = j1; j1 = j2; POP_BLOCK(j2);
        }
#undef POP_BLOCK
        acc_rows<false>(accw, sb_.o0, sb_.o1, gs[1] / fmaxf(sb_.l, 1e-30f), wscr, r32, hi);
    }
    store_acc(accw, (bf16_t*)(p.ws + (PVAR ? WS_QP : WS_O)) + (size_t)(b * T + 64 * tile + 8 * wid) * D + g * 256, lane);
}

__device__ __forceinline__ void swa_unit(const Params& p, unsigned char* lds_generic, int b, int hh, int tile) {
    lptr lds = (lptr)lds_generic;
    const int tid = tid_opaque(), lane = tid & 63, wid = __builtin_amdgcn_readfirstlane(tid >> 6), r32 = lane & 31, hi = lane >> 5;
    const int h = r32 >> 3, qi = r32 & 7, tq = 8 * wid + qi, t = 64 * tile + tq, head = hh * 4 + h;
    const float slope = exp2f(-0.5f * (float)(head + 1)) * LOG2E;
    const unsigned char* ws = p.ws;
    ALAS float* wscr = (ALAS float*)(lds + L_WSCR) + wid * 64;
    const bf16_t* K = (const bf16_t*)(ws + WS_KSW) + (size_t)b * T * 64;
    const bf16_t* V = (const bf16_t*)(ws + WS_VSW) + (size_t)b * T * 64;
    bf16x8 qf[4];
    {
        const bf16_t* qp = (const bf16_t*)(ws + WS_QS) + ((size_t)(b * 8 + head) * T + t) * 64 + 8 * hi;
#pragma unroll
        for (int d0 = 0; d0 < 4; ++d0) qf[d0] = *(const bf16x8*)(qp + 16 * d0);
    }
    Br sw; sw.m = p.sinks[head] * LOG2E; sw.l = 1.0f;
#pragma unroll
    for (int r = 0; r < 16; ++r) { sw.o0[r] = 0.f; sw.o1[r] = 0.f; }
    const int jlo = (tile - 2 > 0) ? tile - 2 : 0;
    Stage sA, sB; int cur = 0;
    stage_load(K + (size_t)tile * 4096, V + (size_t)tile * 4096, wid, lane, sA, true);
    stage_store(lds + L_K, lds + L_V, wid, lane, sA, true);
    ATT_BAR();
    if (tile - 1 >= jlo) stage_load(K + (size_t)(tile - 1) * 4096, V + (size_t)(tile - 1) * 4096, wid, lane, sA, true);
    for (int j = tile; j >= jlo; --j) {
        if (j - 2 >= jlo) stage_load(K + (size_t)(j - 2) * 4096, V + (size_t)(j - 2) * 4096, wid, lane, sB, true);
        const float cb = -slope * (float)(t - 64 * j);
        if (j == tile) attend_tile<true>(sw, lds + L_K + cur * 8192, lds + L_V + cur * 8192, qf, cb, slope, tq, -1, wscr, lane, r32, hi);
        else if (j == tile - 2) attend_tile<true>(sw, lds + L_K + cur * 8192, lds + L_V + cur * 8192, qf, cb, slope, 63, tq, wscr, lane, r32, hi);
        else attend_tile<false>(sw, lds + L_K + cur * 8192, lds + L_V + cur * 8192, qf, cb, slope, 63, -1, wscr, lane, r32, hi);
        if (j > jlo) stage_store(lds + L_K + (cur ^ 1) * 8192, lds + L_V + (cur ^ 1) * 8192, wid, lane, sA, true);
        ATT_BAR();
        cur ^= 1; sA = sB;
    }
    ALAS float* accw = (ALAS float*)(lds + L_ACC) + wid * 2048;
    acc_rows<true>(accw, sw.o0, sw.o1, 1.0f / sw.l, wscr, r32, hi);
    store_acc(accw, (bf16_t*)(p.ws + WS_O) + (size_t)(b * T + 64 * tile + 8 * wid) * D + 512 + hh * 256, lane);
}
__device__ __forceinline__ void phase_swa_mfma(const Params& p, unsigned char* lds) {
    for (int u = blockIdx.x; u < BATCH * 2 * (T / 64); u += gridDim.x) swa_unit(p, lds, u >> 8, (u >> 7) & 1, u & 127);
}
template <int PVAR = 0>
__device__ __forceinline__ void phase_nsa_mfma(const Params& p, unsigned char* lds) {
    const int nu = BATCH * NSA_G * (T / 64);
    for (int i = blockIdx.x; i < nu; i += gridDim.x) {
        const int u = (i < (int)gridDim.x) ? (nu - 1 - i) : (i - (int)gridDim.x);
        nsa_unit<PVAR>(p, lds, u >> 8, (u >> 7) & 1, u & 127);
    }
}
}


namespace cmp {
#define CLAS __attribute__((address_space(3)))
constexpr int HS = 264;
__device__ __forceinline__ void compress_unit(const Params& p, unsigned char* lds_generic, int unit) {
    const unsigned char* ws = p.ws;
    const int tid = tid_opaque(), lane = tid & 63, wid = __builtin_amdgcn_readfirstlane(tid >> 6), fr = lane & 15, fq = lane >> 4;
    const int row0 = unit * 32, kv = row0 >> 11, bg = (row0 & 2047) >> 9, c0 = row0 & 511;
    const bf16_t* raw = (const bf16_t*)(ws + WS_KV6 + (size_t)kv * KV6_STRIDE) + (size_t)bg * T * 64;
    const bf16_t* W1T = (const bf16_t*)(ws + WS_W1T) + (size_t)kv * 256 * 2048;
    const bf16_t* W2T = (const bf16_t*)(ws + WS_W2T) + (size_t)kv * 64 * 256;
    const float* b1 = (const float*)(ws + WS_B1) + kv * 256;
    CLAS bf16_t* H = (CLAS bf16_t*)((CLAS unsigned char*)lds_generic);
    const int n0 = wid * 32;
    f32x4 acc[2][2];
#pragma unroll
    for (int i = 0; i < 2; ++i)
#pragma unroll
        for (int j = 0; j < 2; ++j) acc[i][j] = (f32x4){0.f, 0.f, 0.f, 0.f};
    const bf16_t* ap = raw + (size_t)(c0 + fr) * 1024 + fq * 8;
    const bf16_t* bp = W1T + (size_t)(n0 + fr) * 2048 + fq * 8;
    constexpr int PF = 4;
    bf16x8 a[PF][2], b[PF][2];
#pragma unroll
    for (int s = 0; s < PF; ++s)
#pragma unroll
        for (int i = 0; i < 2; ++i) { a[s][i] = *(const bf16x8*)(ap + (size_t)i * 16 * 1024 + 32 * s); b[s][i] = *(const bf16x8*)(bp + (size_t)i * 16 * 2048 + 32 * s); }
    for (int k0 = 0; k0 < 2048; k0 += 32 * PF) {
#pragma unroll
        for (int s = 0; s < PF; ++s) {
#pragma unroll
            for (int i = 0; i < 2; ++i)
#pragma unroll
                for (int j = 0; j < 2; ++j) acc[i][j] = __builtin_amdgcn_mfma_f32_16x16x32_bf16(a[s][i], b[s][j], acc[i][j], 0, 0, 0);
            const int kn = k0 + 32 * (PF + s);
            if (kn < 2048) {
#pragma unroll
                for (int i = 0; i < 2; ++i) { a[s][i] = *(const bf16x8*)(ap + (size_t)i * 16 * 1024 + kn); b[s][i] = *(const bf16x8*)(bp + (size_t)i * 16 * 2048 + kn); }
            }
        }
    }
#pragma unroll
    for (int i = 0; i < 2; ++i)
#pragma unroll
        for (int j = 0; j < 2; ++j) {
            const int n = n0 + 16 * j + fr; const float bias = b1[n];
#pragma unroll
            for (int r = 0; r < 4; ++r) H[(16 * i + 4 * fq + r) * HS + n] = (bf16_t)f2bf(gelu_tanh(acc[i][j][r] + bias));
        }
    __syncthreads();
    {
        const int mi = wid >> 2, nj = wid & 3;
        f32x4 o = (f32x4){0.f, 0.f, 0.f, 0.f};
        const CLAS bf16_t* hp = H + (16 * mi + fr) * HS + fq * 8;
        const bf16_t* wp = W2T + (size_t)(16 * nj + fr) * 256 + fq * 8;
#pragma unroll
        for (int k0 = 0; k0 < 256; k0 += 32) {
            const bf16x8 ha = *(const CLAS bf16x8*)(hp + k0), wb = *(const bf16x8*)(wp + k0);
            o = __builtin_amdgcn_mfma_f32_16x16x32_bf16(ha, wb, o, 0, 0, 0);
        }
        bf16_t* dst = (bf16_t*)(p.ws + (kv ? WS_VC : WS_KC)) + ((size_t)bg * NCMPP + c0 + 16 * mi + 4 * fq) * 64 + 16 * nj + fr;
#pragma unroll
        for (int r = 0; r < 4; ++r) dst[(size_t)r * 64] = (bf16_t)f2bf(o[r]);
    }
    __syncthreads();
}
__device__ __forceinline__ void phase_compress_swa(const Params& p, unsigned char* lds) {
    const int G = (int)gridDim.x, bx = (int)blockIdx.x;
    if (G >= 256) {
        if (bx < 128) { compress_unit(p, lds, bx); }
        else { for (int u = bx - 128; u < BATCH * 2 * (T / 64); u += G - 128) att::swa_unit(p, lds, u >> 8, (u >> 7) & 1, u & 127);
               convert_expert_tables(p, bx - 128, G - 128); }
    } else {
        for (int u = bx; u < 128; u += G) compress_unit(p, lds, u);
        for (int u = bx; u < BATCH * 2 * (T / 64); u += G) att::swa_unit(p, lds, u >> 8, (u >> 7) & 1, u & 127);
        convert_expert_tables(p, bx, G);
    }
}
}

#define XB_TMO      128
#define XB_XCNT(j)  (256  + 64 * (j))
#define XB_XSUB(j)  (1280 + 64 * (j))
#define XB_XGEN(j)  (2304 + 64 * (j))
#define XB_TOP      3328
#define XB_TOPGEN   3392
#define XCD_BAR_WORDS 3456
#define XB_SPIN_CAP (1u << 18)
#define XLAS __attribute__((address_space(3)))

__device__ __forceinline__ unsigned xb_ld(unsigned* p)              { return __hip_atomic_load(p, __ATOMIC_RELAXED, __HIP_MEMORY_SCOPE_AGENT); }
__device__ __forceinline__ unsigned xb_add(unsigned* p, unsigned v) { return __hip_atomic_fetch_add(p, v, __ATOMIC_RELAXED, __HIP_MEMORY_SCOPE_AGENT); }
__device__ __forceinline__ unsigned xb_xcc_id() { return (unsigned)__builtin_amdgcn_s_getreg((3 << 11) | 20) & 0xFu; }
#define XB_SPIN(cond, bar) do { unsigned _sp = 0; while (cond) { __builtin_amdgcn_s_sleep(1); \
    if ((++_sp & 255u) == 0u) { if (xb_ld(&(bar)[XB_TMO])) break; if (_sp > XB_SPIN_CAP) { atomicAdd(&(bar)[XB_TMO], 1u); break; } } } } while (0)

struct XcdBarrier {
    unsigned* bar; unsigned x;
    volatile XLAS unsigned* st;
};

__device__ __forceinline__ XcdBarrier xcd_barrier_post(unsigned* bar, volatile XLAS unsigned* st) {
    XcdBarrier b; b.bar = bar; b.x = xb_xcc_id(); b.st = st;
    if (threadIdx.x == 0) (void)xb_add(&bar[XB_XCNT(b.x)], 1u);
    return b;
}
__device__ __forceinline__ void xcd_barrier_complete(unsigned* bar, unsigned x, unsigned& nloc, unsigned& nx) {
    const unsigned G = gridDim.x * gridDim.y * gridDim.z;
    unsigned sum, cnt, mine, sp = 0u;
    for (;;) {
        sum = 0u; cnt = 0u; mine = 0u;
#pragma unroll
        for (unsigned j = 0; j < 16; ++j) { const unsigned c = xb_ld(&bar[XB_XCNT(j)]); sum += c; cnt += (c > 0u) ? 1u : 0u; mine = (j == x) ? c : mine; }
        if (sum == G) break;
        __builtin_amdgcn_s_sleep(1);
        if ((++sp & 255u) == 0u) { if (xb_ld(&bar[XB_TMO])) break; if (sp > XB_SPIN_CAP) { atomicAdd(&bar[XB_TMO], 1u); break; } }
    }
    nloc = mine > 0u ? mine : 1u; nx = cnt > 0u ? cnt : 1u;
}

__device__ __forceinline__ void xcd_barrier(const XcdBarrier& b) {
    asm volatile("s_waitcnt vmcnt(0)" ::: "memory");
    __syncthreads();
    if (threadIdx.x == 0) {
        unsigned* bar = b.bar;
        __builtin_amdgcn_s_waitcnt(0);
        unsigned nloc = b.st[0], nx = b.st[1];
        if (nloc == 0u) { xcd_barrier_complete(bar, b.x, nloc, nx); b.st[0] = nloc; b.st[1] = nx; }
        const unsigned old = xb_add(&bar[XB_XSUB(b.x)], 1u);
        const unsigned gen = old / nloc;
        if (old + 1u == (gen + 1u) * nloc) {
            __builtin_amdgcn_fence(__ATOMIC_RELEASE, "agent");
            asm volatile("s_waitcnt vmcnt(0)" ::: "memory");
            const unsigned og = xb_add(&bar[XB_TOP], 1u);
            const unsigned tg = og / nx;
            if (og + 1u == (tg + 1u) * nx) xb_add(&bar[XB_TOPGEN], 1u);
            else XB_SPIN(xb_ld(&bar[XB_TOPGEN]) == tg, bar);
            __builtin_amdgcn_fence(__ATOMIC_ACQUIRE, "agent");
            xb_add(&bar[XB_XGEN(b.x)], 1u);
            asm volatile("s_waitcnt vmcnt(0)" ::: "memory");
        } else {
            XB_SPIN(xb_ld(&bar[XB_XGEN(b.x)]) == gen, bar);
            __builtin_amdgcn_fence(__ATOMIC_ACQUIRE, "agent");
            asm volatile("s_waitcnt vmcnt(0)" ::: "memory");
        }
    }
    __syncthreads();
}


namespace pex {
constexpr int TOK_PER_TICKET = 8, NTICKET = NTOK / TOK_PER_TICKET;
__device__ __forceinline__ int claim(unsigned* ctr, int lane) {
    unsigned t = 0u;
    if (lane == 0) t = __hip_atomic_fetch_add(ctr, 1u, __ATOMIC_RELAXED, __HIP_MEMORY_SCOPE_AGENT);
    return __builtin_amdgcn_readfirstlane((int)t);
}
struct UMeta { int e_lo, e_hi; float g_lo, g_hi; u32x4 h0, h1; float ss; };
__device__ __forceinline__ void u_meta(const unsigned char* ws, int tok, int lane, unsigned loff, UMeta& m) {
    const int* ep = (const int*)(ws + WS_EIDX) + (size_t)tok * 128;
    m.e_lo = ep[lane]; m.e_hi = ep[64 + lane];
    const float* gp = (const float*)(ws + WS_GATE) + (size_t)tok * 128;
    m.g_lo = gp[lane]; m.g_hi = gp[64 + lane];
    const bf16_t* hg = (const bf16_t*)(ws + WS_H1G + (size_t)tok * D * 2) + loff;
    m.h0 = *(const u32x4*)hg; m.h1 = *(const u32x4*)(hg + 8);
    m.ss = ((const float*)(ws + WS_SS2))[tok];
}
constexpr int UB = 16;
__device__ __forceinline__ void u_task(const unsigned char* ws, int tok, int y, int lane, unsigned loff, const UMeta& m, int tok_next, UMeta& mn) {
    unsigned long long m0 = __ballot((m.e_lo >> 11) == y), m1 = __ballot((m.e_hi >> 11) == y);
    const unsigned char* U = ws + WS_U8;
    const int grp = (lane >> 3) & 7;
    bool first = true;
    f32x2 a2[8]; float rstd2 = 0.f;
    do {
        int slot[UB]; u32x4 uw[UB];
#pragma unroll
        for (int k = 0; k < UB; ++k) {
            int e = 0; slot[k] = -1;
            if (m0 != 0ull) { const int j = __builtin_ctzll(m0); m0 &= m0 - 1ull; slot[k] = j; e = __builtin_amdgcn_readlane(m.e_lo, j); }
            else if (m1 != 0ull) { const int j = __builtin_ctzll(m1); m1 &= m1 - 1ull; slot[k] = 64 + j; e = __builtin_amdgcn_readlane(m.e_hi, j); }
            if (slot[k] >= 0) uw[k] = *(const u32x4*)(U + (size_t)e * D + loff); else uw[k] = (u32x4){0u, 0u, 0u, 0u};
        }
        if (first) {
            if (tok_next >= 0) u_meta(ws, tok_next, lane, loff, mn);
            const u32x4 w0 = m.h0, w1 = m.h1;
            a2[0] = (f32x2){bflo(w0.x), bfhi(w0.x)}; a2[1] = (f32x2){bflo(w0.y), bfhi(w0.y)}; a2[2] = (f32x2){bflo(w0.z), bfhi(w0.z)}; a2[3] = (f32x2){bflo(w0.w), bfhi(w0.w)};
            a2[4] = (f32x2){bflo(w1.x), bfhi(w1.x)}; a2[5] = (f32x2){bflo(w1.y), bfhi(w1.y)}; a2[6] = (f32x2){bflo(w1.z), bfhi(w1.z)}; a2[7] = (f32x2){bflo(w1.w), bfhi(w1.w)};
            rstd2 = (1.0f / U8_SCALE) / sqrtf(m.ss * (1.0f / D) + EPS);
            first = false;
        }
#pragma unroll
        for (int hb = 0; hb < UB / 8; ++hb) {
            if (slot[8 * hb] < 0) break;
            float d[8];
#pragma unroll
            for (int k = 0; k < 8; ++k) {
                f32x2 dd = (f32x2){0.f, 0.f};
#pragma unroll
                for (int q = 0; q < 4; ++q) {
                    const f32x2 lo = __builtin_amdgcn_cvt_pk_f32_fp8((int)uw[8 * hb + k][q], false), hi = __builtin_amdgcn_cvt_pk_f32_fp8((int)uw[8 * hb + k][q], true);
                    dd += a2[2 * q] * lo; dd += a2[2 * q + 1] * hi;
                }
                d[k] = dd.x + dd.y;
                __builtin_amdgcn_sched_barrier(0);
            }
            const float dk = reduce8(d, lane);
            int myslot = -1;
#pragma unroll
            for (int k = 0; k < 8; ++k) myslot = (grp == k) ? slot[8 * hb + k] : myslot;
            const float gA = __shfl(m.g_lo, myslot & 63), gB = __shfl(m.g_hi, myslot & 63);
            const float g = (myslot & 64) ? gB : gA;
            if (myslot >= 0 && (lane & 7) == 0) ((float*)(ws + WS_PW))[(size_t)tok * 128 + myslot] = g * gelu_tanh(dk * rstd2);
        }
    } while ((m0 | m1) != 0ull);
}
struct VMeta { u32x4 e[4]; };
__device__ __forceinline__ void v_meta(const Params& p, int tok, int y, int lane, VMeta& m) {
    const unsigned char* ep = p.ws + WS_EIDX + (size_t)tok * 512;
    const unsigned eoff = (unsigned)(lane >> 3) * 64u;
#pragma unroll
    for (int q = 0; q < 4; ++q) m.e[q] = *(const u32x4*)(ep + eoff + 16 * q);
}
__device__ __forceinline__ void ucol_task(const Params& p, int tok, int y, int lane, const VMeta& m, int tok_next, VMeta& mn) {
    const int cc = lane & 7;
    const bool b2 = lane & 4, b1 = lane & 2, b0 = lane & 1;
    const __amdgpu_buffer_rsrc_t ru = __builtin_amdgcn_make_buffer_rsrc((void*)(p.ws + WS_U8 + (size_t)y * ((size_t)NEXP * 128)), (short)0, NEXP * 128, 0x00020000);
    const unsigned coff = (unsigned)cc * 16u;
    u32x4 uw[16];
#pragma unroll
    for (int q = 0; q < 4; ++q) {
        uw[4 * q] = __builtin_bit_cast(u32x4, __builtin_amdgcn_raw_buffer_load_b128(ru, (int)(m.e[q].x * 128u + coff), 0, 0));
        uw[4 * q + 1] = __builtin_bit_cast(u32x4, __builtin_amdgcn_raw_buffer_load_b128(ru, (int)(m.e[q].y * 128u + coff), 0, 0));
        uw[4 * q + 2] = __builtin_bit_cast(u32x4, __builtin_amdgcn_raw_buffer_load_b128(ru, (int)(m.e[q].z * 128u + coff), 0, 0));
        uw[4 * q + 3] = __builtin_bit_cast(u32x4, __builtin_amdgcn_raw_buffer_load_b128(ru, (int)(m.e[q].w * 128u + coff), 0, 0));
    }
    f32x2 a2[8];
    {
        const unsigned char* hp = p.ws + WS_H1G + (size_t)tok * D * 2 + (size_t)y * 256;
        const u32x4 w0 = *(const u32x4*)(hp + cc * 32u), w1 = *(const u32x4*)(hp + cc * 32u + 16u);
        a2[0] = (f32x2){bflo(w0.x), bfhi(w0.x)}; a2[1] = (f32x2){bflo(w0.y), bfhi(w0.y)}; a2[2] = (f32x2){bflo(w0.z), bfhi(w0.z)}; a2[3] = (f32x2){bflo(w0.w), bfhi(w0.w)};
        a2[4] = (f32x2){bflo(w1.x), bfhi(w1.x)}; a2[5] = (f32x2){bflo(w1.y), bfhi(w1.y)}; a2[6] = (f32x2){bflo(w1.z), bfhi(w1.z)}; a2[7] = (f32x2){bflo(w1.w), bfhi(w1.w)};
    }
    if (tok_next >= 0) v_meta(p, tok_next, y, lane, mn);
    float d[16];
#pragma unroll
    for (int i = 0; i < 16; ++i) {
        f32x2 dd = (f32x2){0.f, 0.f};
#pragma unroll
        for (int q = 0; q < 4; ++q) {
            const f32x2 lo = __builtin_amdgcn_cvt_pk_f32_fp8((int)uw[i][q], false), hi = __builtin_amdgcn_cvt_pk_f32_fp8((int)uw[i][q], true);
            dd += a2[2 * q] * lo; dd += a2[2 * q + 1] * hi;
        }
        d[i] = dd.x + dd.y;
        __builtin_amdgcn_sched_barrier(0);
    }
    float s8[8], s4[4], s2[2];
#pragma unroll
    for (int i = 0; i < 8; ++i) { const float snd = b2 ? d[i] : d[i + 8], keep = b2 ? d[i + 8] : d[i]; s8[i] = keep + __shfl_xor(snd, 4); }
#pragma unroll
    for (int i = 0; i < 4; ++i) { const float snd = b1 ? s8[i] : s8[i + 4], keep = b1 ? s8[i + 4] : s8[i]; s4[i] = keep + __shfl_xor(snd, 2); }
#pragma unroll
    for (int i = 0; i < 2; ++i) { const float snd = b0 ? s4[i] : s4[i + 2], keep = b0 ? s4[i + 2] : s4[i]; s2[i] = keep + __shfl_xor(snd, 1); }
    const unsigned so = (unsigned)(16 * (lane >> 3) + (b2 ? 8 : 0) + (b1 ? 4 : 0) + (b0 ? 2 : 0)) * 2u;
    *(unsigned*)(p.ws + WS_PART + ((size_t)tok * 8 + y) * 256 + so) = pk2(s2[0], s2[1]);
}
__device__ __forceinline__ void phase_expert_act(const Params& p) {
    const int tid_ = tid_opaque(), lane = tid_ & 63;
    const int gw = (int)blockIdx.x * (NTHREADS / 64) + __builtin_amdgcn_readfirstlane(tid_ >> 6), ngw = (int)gridDim.x * (NTHREADS / 64);
    for (int tok = gw; tok < NTOK; tok += ngw) {
        const bf16_t* pp = (const bf16_t*)(p.ws + WS_PART) + (size_t)tok * 1024;
        float sa = 0.f, sb = 0.f;
#pragma unroll
        for (int y = 0; y < (U_FP4 ? NSL4 : 8); ++y) { sa += bf2f(pp[y * 128 + lane]); sb += bf2f(pp[y * 128 + 64 + lane]); }
        const float rstd2 = (1.0f / (U_FP4 ? U4_SCALE : U8_SCALE)) / sqrtf(((const float*)(p.ws + WS_SS2))[tok] * (1.0f / D) + EPS);
        const float* gp = (const float*)(p.ws + WS_GATE) + (size_t)tok * 128;
        float* wp = (float*)(p.ws + WS_PW) + (size_t)tok * 128;
        wp[lane] = gp[lane] * gelu_tanh(sa * rstd2);
        wp[64 + lane] = gp[64 + lane] * gelu_tanh(sb * rstd2);
    }
}
__device__ __forceinline__ void v_task(const Params& p, int tok, int y, int lane, const VMeta& m, int tok_next, VMeta& mn) {
    const int cc = lane & 7;
    const bool b5 = lane & 32, b4 = lane & 16, b3 = lane & 8;
    const __amdgpu_buffer_rsrc_t rv = __builtin_amdgcn_make_buffer_rsrc((void*)(p.ws + WS_V8 + (size_t)y * ((size_t)NEXP * 128)), (short)0, NEXP * 128, 0x00020000);
    const unsigned coff = (unsigned)cc * 16u;
    u32x4 vw[16];
#pragma unroll
    for (int q = 0; q < 4; ++q) {
        vw[4 * q] = __builtin_bit_cast(u32x4, __builtin_amdgcn_raw_buffer_load_b128(rv, (int)(m.e[q].x * 128u + coff), 0, 0));
        vw[4 * q + 1] = __builtin_bit_cast(u32x4, __builtin_amdgcn_raw_buffer_load_b128(rv, (int)(m.e[q].y * 128u + coff), 0, 0));
        vw[4 * q + 2] = __builtin_bit_cast(u32x4, __builtin_amdgcn_raw_buffer_load_b128(rv, (int)(m.e[q].z * 128u + coff), 0, 0));
        vw[4 * q + 3] = __builtin_bit_cast(u32x4, __builtin_amdgcn_raw_buffer_load_b128(rv, (int)(m.e[q].w * 128u + coff), 0, 0));
    }
    f32x4 w[4];
    {
        const unsigned char* wp = p.ws + WS_PW + (size_t)tok * 512;
        const unsigned woff = (unsigned)(lane >> 3) * 64u;
#pragma unroll
        for (int q = 0; q < 4; ++q) w[q] = *(const f32x4*)(wp + woff + 16 * q);
    }
    const unsigned colb = (unsigned)(128 * y + 16 * cc + (b5 ? 8 : 0) + (b4 ? 4 : 0) + (b3 ? 2 : 0)) * 4u;
    const unsigned hb = *(const unsigned*)(p.ws + WS_H1G + (size_t)tok * D * 2 + (colb >> 1));
    const f32x2 g2v = *(const f32x2*)((const unsigned char*)p.ln2_g + colb);
    const f32x2 h = (f32x2){bflo(hb) / g2v.x, bfhi(hb) / g2v.y};
    if (tok_next >= 0) v_meta(p, tok_next, y, lane, mn);
    f32x2 acc2[8];
#pragma unroll
    for (int q = 0; q < 8; ++q) acc2[q] = (f32x2){0.f, 0.f};
#pragma unroll
    for (int i = 0; i < 16; ++i) {
        const float wi = w[i >> 2][i & 3];
#pragma unroll
        for (int q = 0; q < 4; ++q) {
            const f32x2 lo = __builtin_amdgcn_cvt_pk_f32_fp8((int)vw[i][q], false), hi = __builtin_amdgcn_cvt_pk_f32_fp8((int)vw[i][q], true);
            acc2[2 * q] += lo * wi; acc2[2 * q + 1] += hi * wi;
        }
        __builtin_amdgcn_sched_barrier(0);
    }
    float acc[16];
#pragma unroll
    for (int q = 0; q < 8; ++q) { acc[2 * q] = acc2[q].x; acc[2 * q + 1] = acc2[q].y; }
    float s8[8], s4[4], s2[2];
#pragma unroll
    for (int i = 0; i < 8; ++i) { const float snd = b5 ? acc[i] : acc[i + 8], keep = b5 ? acc[i + 8] : acc[i]; s8[i] = keep + __shfl_xor(snd, 32); }
#pragma unroll
    for (int i = 0; i < 4; ++i) { const float snd = b4 ? s8[i] : s8[i + 4], keep = b4 ? s8[i + 4] : s8[i]; s4[i] = keep + __shfl_xor(snd, 16); }
#pragma unroll
    for (int i = 0; i < 2; ++i) { const float snd = b3 ? s4[i] : s4[i + 2], keep = b3 ? s4[i + 2] : s4[i]; s2[i] = keep + __shfl_xor(snd, 8); }
    *(unsigned*)(p.ws + WS_H2 + (size_t)tok * D * 2 + (colb >> 1)) = pk2(h.x + s2[0] * (1.0f / V8_SCALE), h.y + s2[1] * (1.0f / V8_SCALE));
}

__device__ __forceinline__ void unpack32_fp4(const u32x4& w, f32x2 (&f)[16]) {
#pragma unroll
    for (int q = 0; q < 4; ++q) {
        f[4 * q + 0] = __builtin_amdgcn_cvt_scalef32_pk_f32_fp4(w[q], 1.0f, 0);
        f[4 * q + 1] = __builtin_amdgcn_cvt_scalef32_pk_f32_fp4(w[q], 1.0f, 1);
        f[4 * q + 2] = __builtin_amdgcn_cvt_scalef32_pk_f32_fp4(w[q], 1.0f, 2);
        f[4 * q + 3] = __builtin_amdgcn_cvt_scalef32_pk_f32_fp4(w[q], 1.0f, 3);
    }
}
__device__ __forceinline__ void ucol4_task(const Params& p, int tok, int z, int lane, const VMeta& m, int tok_next, VMeta& mn) {
    const int cc = lane & 7;
    const bool b2 = lane & 4, b1 = lane & 2, b0 = lane & 1;
    const __amdgpu_buffer_rsrc_t ru = __builtin_amdgcn_make_buffer_rsrc((void*)(p.ws + WS_U8 + (size_t)z * ((size_t)NEXP * 128)), (short)0, NEXP * 128, 0x00020000);
    const unsigned coff = (unsigned)cc * 16u;
    u32x4 uw[16];
#pragma unroll
    for (int q = 0; q < 4; ++q) {
        uw[4 * q] = __builtin_bit_cast(u32x4, __builtin_amdgcn_raw_buffer_load_b128(ru, (int)(m.e[q].x * 128u + coff), 0, 0));
        uw[4 * q + 1] = __builtin_bit_cast(u32x4, __builtin_amdgcn_raw_buffer_load_b128(ru, (int)(m.e[q].y * 128u + coff), 0, 0));
        uw[4 * q + 2] = __builtin_bit_cast(u32x4, __builtin_amdgcn_raw_buffer_load_b128(ru, (int)(m.e[q].z * 128u + coff), 0, 0));
        uw[4 * q + 3] = __builtin_bit_cast(u32x4, __builtin_amdgcn_raw_buffer_load_b128(ru, (int)(m.e[q].w * 128u + coff), 0, 0));
    }
    f32x2 a2[16];
    {
        const unsigned char* hp = p.ws + WS_H1G + (size_t)tok * D * 2 + (size_t)z * 512 + cc * 64u;
#pragma unroll
        for (int q = 0; q < 4; ++q) {
            const u32x4 w = *(const u32x4*)(hp + 16 * q);
            a2[4 * q] = (f32x2){bflo(w.x), bfhi(w.x)}; a2[4 * q + 1] = (f32x2){bflo(w.y), bfhi(w.y)}; a2[4 * q + 2] = (f32x2){bflo(w.z), bfhi(w.z)}; a2[4 * q + 3] = (f32x2){bflo(w.w), bfhi(w.w)};
        }
    }
    if (tok_next >= 0) v_meta(p, tok_next, z, lane, mn);
    float d[16];
#pragma unroll
    for (int i = 0; i < 16; ++i) {
        f32x2 uf[16]; unpack32_fp4(uw[i], uf);
        f32x2 dd = (f32x2){0.f, 0.f};
#pragma unroll
        for (int q = 0; q < 16; ++q) dd += a2[q] * uf[q];
        d[i] = dd.x + dd.y;
        __builtin_amdgcn_sched_barrier(0);
    }
    float s8[8], s4[4], s2[2];
#pragma unroll
    for (int i = 0; i < 8; ++i) { const float snd = b2 ? d[i] : d[i + 8], keep = b2 ? d[i + 8] : d[i]; s8[i] = keep + __shfl_xor(snd, 4); }
#pragma unroll
    for (int i = 0; i < 4; ++i) { const float snd = b1 ? s8[i] : s8[i + 4], keep = b1 ? s8[i + 4] : s8[i]; s4[i] = keep + __shfl_xor(snd, 2); }
#pragma unroll
    for (int i = 0; i < 2; ++i) { const float snd = b0 ? s4[i] : s4[i + 2], keep = b0 ? s4[i + 2] : s4[i]; s2[i] = keep + __shfl_xor(snd, 1); }
    const unsigned so = (unsigned)(16 * (lane >> 3) + (b2 ? 8 : 0) + (b1 ? 4 : 0) + (b0 ? 2 : 0)) * 2u;
    *(unsigned*)(p.ws + WS_PART + ((size_t)tok * 8 + z) * 256 + so) = pk2(s2[0], s2[1]);
}
__device__ __forceinline__ void v4_task(const Params& p, int tok, int z, int lane, const VMeta& m, int tok_next, VMeta& mn) {
    const int cc = lane & 7;
    const bool b5 = lane & 32, b4 = lane & 16, b3 = lane & 8;
    const __amdgpu_buffer_rsrc_t rv = __builtin_amdgcn_make_buffer_rsrc((void*)(p.ws + WS_V8 + (size_t)z * ((size_t)NEXP * 128)), (short)0, NEXP * 128, 0x00020000);
    const unsigned coff = (unsigned)cc * 16u;
    u32x4 vw[16];
#pragma unroll
    for (int q = 0; q < 4; ++q) {
        vw[4 * q] = __builtin_bit_cast(u32x4, __builtin_amdgcn_raw_buffer_load_b128(rv, (int)(m.e[q].x * 128u + coff), 0, 0));
        vw[4 * q + 1] = __builtin_bit_cast(u32x4, __builtin_amdgcn_raw_buffer_load_b128(rv, (int)(m.e[q].y * 128u + coff), 0, 0));
        vw[4 * q + 2] = __builtin_bit_cast(u32x4, __builtin_amdgcn_raw_buffer_load_b128(rv, (int)(m.e[q].z * 128u + coff), 0, 0));
        vw[4 * q + 3] = __builtin_bit_cast(u32x4, __builtin_amdgcn_raw_buffer_load_b128(rv, (int)(m.e[q].w * 128u + coff), 0, 0));
    }
    f32x4 w[4];
    {
        const unsigned char* wp = p.ws + WS_PW + (size_t)tok * 512;
        const unsigned woff = (unsigned)(lane >> 3) * 64u;
#pragma unroll
        for (int q = 0; q < 4; ++q) w[q] = *(const f32x4*)(wp + woff + 16 * q);
    }
    const unsigned col = (unsigned)(256 * z + 32 * cc + (b5 ? 16 : 0) + (b4 ? 8 : 0) + (b3 ? 4 : 0));
    const u32x2 hb = *(const u32x2*)(p.ws + WS_H1G + (size_t)tok * D * 2 + col * 2u);
    const f32x4 g2v = *(const f32x4*)(p.ln2_g + col);
    if (tok_next >= 0) v_meta(p, tok_next, z, lane, mn);
    f32x2 acc2[16];
#pragma unroll
    for (int q = 0; q < 16; ++q) acc2[q] = (f32x2){0.f, 0.f};
#pragma unroll
    for (int i = 0; i < 16; ++i) {
        const float wi = w[i >> 2][i & 3];
        f32x2 vf[16]; unpack32_fp4(vw[i], vf);
#pragma unroll
        for (int q = 0; q < 16; ++q) acc2[q] += vf[q] * wi;
        __builtin_amdgcn_sched_barrier(0);
    }
    float acc[32];
#pragma unroll
    for (int q = 0; q < 16; ++q) { acc[2 * q] = acc2[q].x; acc[2 * q + 1] = acc2[q].y; }
    float s16[16], s8[8], s4[4];
#pragma unroll
    for (int i = 0; i < 16; ++i) { const float snd = b5 ? acc[i] : acc[i + 16], keep = b5 ? acc[i + 16] : acc[i]; s16[i] = keep + __shfl_xor(snd, 32); }
#pragma unroll
    for (int i = 0; i < 8; ++i) { const float snd = b4 ? s16[i] : s16[i + 8], keep = b4 ? s16[i + 8] : s16[i]; s8[i] = keep + __shfl_xor(snd, 16); }
#pragma unroll
    for (int i = 0; i < 4; ++i) { const float snd = b3 ? s8[i] : s8[i + 4], keep = b3 ? s8[i + 4] : s8[i]; s4[i] = keep + __shfl_xor(snd, 8); }
    const float h0 = bflo(hb.x) / g2v.x + s4[0] * (1.0f / V4_SCALE), h1 = bfhi(hb.x) / g2v.y + s4[1] * (1.0f / V4_SCALE);
    const float h2 = bflo(hb.y) / g2v.z + s4[2] * (1.0f / V4_SCALE), h3 = bfhi(hb.y) / g2v.w + s4[3] * (1.0f / V4_SCALE);
    *(u32x2*)(p.ws + WS_H2 + (size_t)tok * D * 2 + col * 2u) = (u32x2){pk2(h0, h1), pk2(h2, h3)};
}
template <bool VPHASE, int PROBE = 0>
__device__ __forceinline__ void phase_sliced(const Params& p_in) {
    Params p = p_in; if (PROBE) p.out = (float*)(p_in.ws + WS_QP);
    const int tid_ = tid_opaque(), lane = tid_ & 63;
    const unsigned loff = 16u * (unsigned)lane;
    unsigned* ctr = (unsigned*)(p.ws + WS_CTR + (VPHASE ? 2048 : 0) + PROBE * 4096);
    constexpr bool FP4 = VPHASE ? V_FP4 : U_FP4;
    constexpr int NSL = FP4 ? NSL4 : 8;
    const int x0 = (int)(xb_xcc_id() & 7u);
    for (int k = 0; k < NSL; ++k) {
        const int y = (x0 + k) & (NSL - 1);
        int tk = claim(ctr + y * 64, lane);
        if (tk >= NTICKET) continue;
        VMeta vm, vmn;
        v_meta(p, tk * TOK_PER_TICKET, y, lane, vm);
        while (tk < NTICKET) {
            const int tkn = claim(ctr + y * 64, lane);
#pragma unroll 1
            for (int i = 0; i < TOK_PER_TICKET; ++i) {
                const int tok = tk * TOK_PER_TICKET + i;
                const int tok_next = (i + 1 < TOK_PER_TICKET) ? tok + 1 : ((tkn < NTICKET) ? tkn * TOK_PER_TICKET : -1);
                if (VPHASE) { if (FP4) v4_task(p, tok, y, lane, vm, tok_next, vmn); else v_task(p, tok, y, lane, vm, tok_next, vmn); vm = vmn; }
                else { if (FP4) ucol4_task(p, tok, y, lane, vm, tok_next, vmn); else ucol_task(p, tok, y, lane, vm, tok_next, vmn); vm = vmn; }
            }
            tk = tkn;
        }
    }
}
__device__ __forceinline__ void phase_final_norm(const Params& p) {
    const int tid_ = tid_opaque(), lane = tid_ & 63;
    const int gw = (int)blockIdx.x * (NTHREADS / 64) + __builtin_amdgcn_readfirstlane(tid_ >> 6), ngw = (int)gridDim.x * (NTHREADS / 64);
    const unsigned loff = 16u * (unsigned)lane;
    f32x4 g[4];
#pragma unroll
    for (int q = 0; q < 4; ++q) g[q] = *(const f32x4*)(p.lnf_g + loff + 4 * q);
    for (int tok = gw; tok < NTOK; tok += ngw) {
        float* orow = (float*)((unsigned char*)p.out + (size_t)tok * D * 4) + loff;
        const bf16_t* hrow = (const bf16_t*)(p.ws + WS_H2 + (size_t)tok * D * 2) + loff;
        const u32x4 w0 = *(const u32x4*)hrow, w1 = *(const u32x4*)(hrow + 8);
        f32x4 y[4]; float ss = 0.f;
        y[0] = (f32x4){bflo(w0.x), bfhi(w0.x), bflo(w0.y), bfhi(w0.y)}; y[1] = (f32x4){bflo(w0.z), bfhi(w0.z), bflo(w0.w), bfhi(w0.w)};
        y[2] = (f32x4){bflo(w1.x), bfhi(w1.x), bflo(w1.y), bfhi(w1.y)}; y[3] = (f32x4){bflo(w1.z), bfhi(w1.z), bflo(w1.w), bfhi(w1.w)};
#pragma unroll
        for (int q = 0; q < 4; ++q) ss += (y[q].x * y[q].x + y[q].y * y[q].y) + (y[q].z * y[q].z + y[q].w * y[q].w);
        const float rstd = 1.0f / sqrtf(wave_sum(ss) * (1.0f / D) + EPS);
#pragma unroll
        for (int q = 0; q < 4; ++q) *(f32x4*)(orow + 4 * q) = (f32x4){y[q].x * rstd * g[q].x, y[q].y * rstd * g[q].y, y[q].z * rstd * g[q].z, y[q].w * rstd * g[q].w};
    }
}
}

constexpr int LDS_BYTES = 147456;
extern __shared__ __attribute__((aligned(16))) unsigned char dyn_lds[];

__device__ __forceinline__ Params load_params() {
#if !defined(__HIP_DEVICE_COMPILE__)
    return Params{};
#else
    const __attribute__((address_space(4))) unsigned char* ka = (const __attribute__((address_space(4))) unsigned char*)__builtin_amdgcn_kernarg_segment_ptr();
    asm volatile("" : "+s"(ka));
    const __attribute__((address_space(4))) Params* kp = (const __attribute__((address_space(4))) Params*)ka;
    Params r;
    r.x = kp->x; r.ln1_g = kp->ln1_g; r.w_in = kp->w_in; r.pe_k = kp->pe_k; r.w1_k = kp->w1_k; r.w2_k = kp->w2_k; r.pe_v = kp->pe_v; r.w1_v = kp->w1_v; r.w2_v = kp->w2_v;
    r.sinks = kp->sinks; r.w_out = kp->w_out; r.ln2_g = kp->ln2_g; r.wq = kp->wq; r.pkeys = kp->pkeys; r.pu = kp->pu; r.pv = kp->pv; r.lnf_g = kp->lnf_g; r.out = kp->out; r.ws = kp->ws;
    return r;
#endif
}
__global__ void __launch_bounds__(NTHREADS, 2) fwd_megakernel(Params p_unused) {
    cg::grid_group grid = cg::this_grid();
    float* lds = (float*)dyn_lds;
    PG8_LAS unsigned char* ldsp = (PG8_LAS unsigned char*)dyn_lds;
    volatile XLAS unsigned* bst = (volatile XLAS unsigned*)((XLAS unsigned char*)dyn_lds + (LDS_BYTES - 16));
    if (threadIdx.x < 4) bst[threadIdx.x] = 0u;
    __syncthreads();
    { const Params p = load_params(); (void)xcd_barrier_post((unsigned*)(p.ws + WS_BAR), bst); }
#define GRID_BARRIER() do { const Params p_ = load_params(); XcdBarrier xb_; xb_.bar = (unsigned*)(p_.ws + WS_BAR); xb_.x = xb_xcc_id(); \
        xb_.st = (volatile XLAS unsigned*)((XLAS unsigned char*)dyn_lds + (LDS_BYTES - 16)); xcd_barrier(xb_); } while (0)
    for (int rep = 0; rep < 1 + PROBE_PREP; ++rep) { const Params p = load_params(); phase_prep(p); }
    if (gridDim.y == 0x7fffu) grid.sync();
    GRID_BARRIER();
    for (int rep = 0; rep < 1 + PROBE_PROJ; ++rep) { const Params p = load_params();
      pg8::Gemm g{(const bf16_t*)(p.ws + WS_XN), (const bf16_t*)(p.ws + WS_WIN), NTOK, DINP, D}; pg8::StaticOrder S; S.init(NTOK, DINP, (int)gridDim.x, (int)blockIdx.x);
      EpiProjT E{p.ws}; pg8::gemm_phase<EpiProjT, pg8::StaticOrder, true, true>(ldsp, g, S, E); }
    GRID_BARRIER();
    for (int rep = 0; rep < 1 + PROBE_CS; ++rep) { const Params p = load_params(); cmp::phase_compress_swa(p, dyn_lds); }
    GRID_BARRIER();
    { const Params p = load_params(); att::phase_nsa_mfma<0>(p, dyn_lds); }
#if PROBE_NSA
    { const Params p = load_params(); att::phase_nsa_mfma<PROBE_NSA>(p, dyn_lds); }
#endif
    GRID_BARRIER();
    { const Params p = load_params();
      pg8::Gemm g{(const bf16_t*)(p.ws + WS_O), (const bf16_t*)(p.ws + WS_WOUT), NTOK, D, D}; pg8::StaticOrder S; S.init(NTOK, D, (int)gridDim.x, (int)blockIdx.x);
      EpiOutT E{p.x, p.ln2_g, p.out, (bf16_t*)(p.ws + WS_H1G), (float*)(p.ws + WS_SS2)}; pg8::gemm_phase<EpiOutT, pg8::StaticOrder, true, true>(ldsp, g, S, E); }
    GRID_BARRIER();
    for (int rep = 0; rep < 1 + PROBE_QP; ++rep) { const Params p = load_params();
      pg8::Gemm g{(const bf16_t*)(p.ws + WS_H1G), (const bf16_t*)(p.ws + WS_WQ), NTOK, PQ, D}; pg8::StaticOrder S; S.init(NTOK, PQ, (int)gridDim.x, (int)blockIdx.x);
      EpiQPT E{(const float*)(p.ws + WS_SS2), (bf16_t*)(p.ws + WS_QP)}; pg8::gemm_phase<EpiQPT, pg8::StaticOrder, true, true>(ldsp, g, S, E); }
    GRID_BARRIER();
    for (int rep = 0; rep < 1 + PROBE_SEL; ++rep) { const Params p = load_params(); psel::phase_peer_select(p, dyn_lds); }
    GRID_BARRIER();
    { const Params p = load_params(); pex::phase_sliced<false>(p); }
#if PROBE_PEXU
    { const Params p = load_params(); pex::phase_sliced<false, 1>(p); }
#endif
    GRID_BARRIER();
    for (int rep = 0; rep < 1 + PROBE_ACT; ++rep) { const Params p = load_params(); pex::phase_expert_act(p); }
    GRID_BARRIER();
    { const Params p = load_params(); pex::phase_sliced<true>(p); }
#if PROBE_PEXV
    { const Params p = load_params(); pex::phase_sliced<true, 1>(p); }
#endif
    GRID_BARRIER();
    { const Params p = load_params(); pex::phase_final_norm(p); }
}

extern "C" void kernel_launch(void* const* d_in, const int* in_sizes, int n_in, void* d_out, int out_size, void* d_ws, size_t ws_size, hipStream_t stream) {
    if (n_in != 17 || ws_size < WS_END) { fprintf(stderr, "kernel_launch: unexpected inputs (n_in %d, ws %zu)\n", n_in, ws_size); return; }
    static int grid_blocks = 0;
    if (!grid_blocks) {
        int dev = 0, cus = 0, per_cu = 0;
        (void)hipGetDevice(&dev);
        (void)hipDeviceGetAttribute(&cus, hipDeviceAttributeMultiprocessorCount, dev);
        (void)hipFuncSetAttribute((const void*)fwd_megakernel, hipFuncAttributeMaxDynamicSharedMemorySize, LDS_BYTES);
        (void)hipOccupancyMaxActiveBlocksPerMultiprocessor(&per_cu, (const void*)fwd_megakernel, NTHREADS, LDS_BYTES);
        if (per_cu < 1) per_cu = 1;
        grid_blocks = cus * per_cu;
        fprintf(stderr, "kernel_launch: %d CUs x %d blocks/CU\n", cus, per_cu);
    }
    Params p{};
    p.x = (const float*)d_in[0]; p.ln1_g = (const float*)d_in[1]; p.w_in = (const float*)d_in[2];
    p.pe_k = (const float*)d_in[3]; p.w1_k = (const float*)d_in[4]; p.w2_k = (const float*)d_in[5];
    p.pe_v = (const float*)d_in[6]; p.w1_v = (const float*)d_in[7]; p.w2_v = (const float*)d_in[8];
    p.sinks = (const float*)d_in[9]; p.w_out = (const float*)d_in[10]; p.ln2_g = (const float*)d_in[11];
    p.wq = (const float*)d_in[12]; p.pkeys = (const float*)d_in[13]; p.pu = (const float*)d_in[14]; p.pv = (const float*)d_in[15];
    p.lnf_g = (const float*)d_in[16];
    p.out = (float*)d_out; p.ws = (unsigned char*)d_ws;
    (void)hipMemsetAsync((unsigned char*)d_ws + WS_BAR, 0, 16 * 1024 + 8192, stream);
    void* args[] = {&p};
    hipError_t e = hipLaunchCooperativeKernel((void*)fwd_megakernel, dim3(grid_blocks), dim3(NTHREADS), args, LDS_BYTES, stream);
    if (e != hipSuccess) fprintf(stderr, "cooperative launch failed: %s (grid %d)\n", hipGetErrorString(e), grid_blocks);
}
```

```cpp
#include <hip/hip_runtime.h>
#include <hip/hip_cooperative_groups.h>
#include <cstdint>
#include <cstdio>
namespace cg = cooperative_groups;
#define PROBE_PREP 0
#define PROBE_COMPRESS 0
#define PROBE_SWA 0
#define PROBE_NSA 0
#define PROBE_SUB 0
#define PROBE_COMB 0
#define PROBE_PEXU 0
#define PROBE_PEXV 0
#define PROBE_PROJ 0
#define PROBE_QP 0
#define PROBE_SEL 0
#define PROBE_CS 0
#define PROBE_ACT 0

typedef unsigned short bf16_t;
typedef short bf16x8 __attribute__((ext_vector_type(8)));
typedef float f32x4 __attribute__((ext_vector_type(4)));
typedef unsigned u32x4 __attribute__((ext_vector_type(4)));
typedef unsigned u32x2 __attribute__((ext_vector_type(2)));

constexpr int BATCH = 2, T = 8192, D = 1024, NTOK = BATCH * T;
constexpr int HD = 64, NSA_H = 8, NSA_G = 2, NSA_HG = 4, SWA_H = 8;
constexpr int DIN = 1944, DINP = 2048;
constexpr int NCMP = 511, NCMPP = 512, NSEL = 128, TOPN = 16;
constexpr int NSA_WIN = 512, SWA_WIN = 128;
constexpr int PH = 8, PNK = 128, PDK = 256, PTOPK = 16, PQ = PH * PDK;
constexpr int NEXP = PNK * PNK;
constexpr float EPS = 1e-6f;
constexpr int NTHREADS = 512;
constexpr bool U_FP4 = true, V_FP4 = true, U_INT4 = true;

constexpr size_t MiB = 1u << 20;
constexpr size_t WS_SS2 = 0;
constexpr size_t WS_BAR = 128 * 1024;
constexpr size_t WS_WIN = 1 * MiB;
constexpr size_t WS_WOUT = 5 * MiB;
constexpr size_t WS_WQ = 7 * MiB;
constexpr size_t WS_PKEYS = 11 * MiB;
constexpr size_t WS_W1T = 12 * MiB;
constexpr size_t WS_W2T = 14 * MiB;
constexpr size_t WS_B1 = 14 * MiB + 512 * 1024;
constexpr size_t WS_XN = 16 * MiB;
constexpr size_t WS_O = WS_XN;
constexpr size_t WS_HQA = WS_XN;
constexpr size_t WS_HQB = WS_XN + 8 * MiB;
constexpr size_t WS_H2 = WS_XN;
constexpr size_t WS_QN = 48 * MiB;
constexpr size_t WS_QS = 64 * MiB;
constexpr size_t WS_KV6 = 80 * MiB;
constexpr size_t KV6_STRIDE = 4 * MiB;
constexpr size_t WS_KSW = 104 * MiB;
constexpr size_t WS_VSW = 106 * MiB;
constexpr size_t WS_GSIG = 108 * MiB;
constexpr size_t WS_KC = 110 * MiB;
constexpr size_t WS_VC = 110 * MiB + 512 * 1024;
constexpr size_t WS_H1G = 48 * MiB;
constexpr size_t WS_QP = 80 * MiB;
constexpr size_t WS_EIDX = 144 * MiB;
constexpr size_t WS_GATE = 152 * MiB;
constexpr size_t WS_U8 = 160 * MiB;
constexpr size_t WS_PART = 80 * MiB;
constexpr size_t WS_V8 = 176 * MiB;
constexpr size_t WS_PW = 224 * MiB;
constexpr size_t WS_CTR = 128 * 1024 + 16 * 1024;
constexpr size_t WS_TOPV2 = 224 * MiB;
constexpr size_t WS_TOPI2 = 240 * MiB;
constexpr size_t WS_END = 256 * MiB;

struct Params {
    const float* x; const float* ln1_g; const float* w_in;
    const float* pe_k; const float* w1_k; const float* w2_k;
    const float* pe_v; const float* w1_v; const float* w2_v;
    const float* sinks; const float* w_out; const float* ln2_g;
    const float* wq; const float* pkeys; const float* pu; const float* pv; const float* lnf_g;
    float* out; unsigned char* ws;
};

__device__ __forceinline__ int tid_opaque() { int t = (int)threadIdx.x; asm volatile("" : "+v"(t)); return t; }
__device__ __forceinline__ unsigned f2bf(float f) { unsigned u = __float_as_uint(f); return (u + 0x7fffu + ((u >> 16) & 1u)) >> 16; }
__device__ __forceinline__ float bf2f(unsigned h) { return __uint_as_float(h << 16); }
__device__ __forceinline__ float bflo(unsigned w) { return __uint_as_float(w << 16); }
__device__ __forceinline__ float bfhi(unsigned w) { return __uint_as_float(w & 0xffff0000u); }
__device__ __forceinline__ unsigned pk2(float lo, float hi) { return f2bf(lo) | (f2bf(hi) << 16); }
__device__ __forceinline__ float wave_sum(float v) {
#pragma unroll
    for (int o = 1; o < 64; o <<= 1) v += __shfl_xor(v, o);
    return v;
}
__device__ __forceinline__ float gelu_tanh(float x) {
    const float u = 0.7978845608028654f * (x + 0.044715f * x * x * x);
    return 0.5f * x * (1.0f + tanhf(u));
}
__device__ __forceinline__ int win_orig_col(int n) {
    if (n < 1280) return n;
    if (n < 1792) return 1304 + (n - 1280);
    if (n < 1856) return 1816 + (n - 1792);
    if (n < 1920) return 1880 + (n - 1856);
    if (n < 1944) return 1280 + (n - 1920);
    return -1;
}

template <bool WIN_MAP>
__device__ __forceinline__ void prep_transpose(const float* W, int K, int N, int NP, bf16_t* WT, long gt, long ngt) {
    const long items = (long)NP * (K / 8);
    for (long it = gt; it < items; it += ngt) {
        const int n = (int)(it % NP), k0 = (int)(it / NP) * 8;
        const int col = WIN_MAP ? win_orig_col(n) : n;
        float v[8];
#pragma unroll
        for (int i = 0; i < 8; ++i) v[i] = (col >= 0) ? W[(size_t)(k0 + i) * N + col] : 0.f;
        u32x4 o; o.x = pk2(v[0], v[1]); o.y = pk2(v[2], v[3]); o.z = pk2(v[4], v[5]); o.w = pk2(v[6], v[7]);
        *(u32x4*)(WT + (size_t)n * K + k0) = o;
    }
}
__device__ __forceinline__ void prep_convert(const float* src, bf16_t* dst, long n8, long gt, long ngt) {
    for (long it = gt; it < n8; it += ngt) {
        const f32x4 a = *(const f32x4*)(src + it * 8), b = *(const f32x4*)(src + it * 8 + 4);
        u32x4 o; o.x = pk2(a.x, a.y); o.y = pk2(a.z, a.w); o.z = pk2(b.x, b.y); o.w = pk2(b.z, b.w);
        *(u32x4*)(dst + it * 8) = o;
    }
}
constexpr float U8_SCALE = 256.0f, V8_SCALE = 16.0f;
constexpr float U4_SCALE = 64.0f, V4_SCALE = 5.656854249f;
constexpr float UI_SCALE = 91.4285714f, HQ_SCALE = 16.0f;
constexpr int NSL4 = 4;
__device__ __forceinline__ void prep_convert_fp8(const float* src, unsigned char* dst, long n16, float sc, long gt, long ngt) {
    for (long it = gt; it < n16; it += ngt) {
        u32x4 o;
#pragma unroll
        for (int q = 0; q < 4; ++q) {
            const f32x4 a = *(const f32x4*)(src + it * 16 + q * 4);
            int w = 0;
            w = __builtin_amdgcn_cvt_pk_fp8_f32(a.x * sc, a.y * sc, w, false);
            w = __builtin_amdgcn_cvt_pk_fp8_f32(a.z * sc, a.w * sc, w, true);
            o[q] = (unsigned)w;
        }
        *(u32x4*)(dst + it * 16) = o;
    }
}
__device__ __forceinline__ void prep_convert_fp8_sliced(const float* src, unsigned char* dst, long n16, float sc, long gt, long ngt) {
    for (long it = gt; it < n16; it += ngt) {
        u32x4 o;
#pragma unroll
        for (int q = 0; q < 4; ++q) {
            const f32x4 a = *(const f32x4*)(src + it * 16 + q * 4);
            int w = 0;
            w = __builtin_amdgcn_cvt_pk_fp8_f32(a.x * sc, a.y * sc, w, false);
            w = __builtin_amdgcn_cvt_pk_fp8_f32(a.z * sc, a.w * sc, w, true);
            o[q] = (unsigned)w;
        }
        const long e = (it * 16) >> 10; const int col = (int)((it * 16) & 1023);
        *(u32x4*)(dst + (size_t)(col >> 7) * ((size_t)NEXP * 128) + e * 128 + (col & 127)) = o;
    }
}
__device__ __forceinline__ void prep_convert_fp4_sliced(const float* src, unsigned char* dst, long n32, float sc, long gt, long ngt) {
    for (long it = gt; it < n32; it += ngt) {
        u32x4 o;
#pragma unroll
        for (int q = 0; q < 4; ++q) {
            const f32x4 a = *(const f32x4*)(src + it * 32 + q * 8), b = *(const f32x4*)(src + it * 32 + q * 8 + 4);
            unsigned w = 0u;
            w = __builtin_amdgcn_cvt_scalef32_pk_fp4_f32(w, a.x * sc, a.y * sc, 1.0f, 0);
            w = __builtin_amdgcn_cvt_scalef32_pk_fp4_f32(w, a.z * sc, a.w * sc, 1.0f, 1);
            w = __builtin_amdgcn_cvt_scalef32_pk_fp4_f32(w, b.x * sc, b.y * sc, 1.0f, 2);
            w = __builtin_amdgcn_cvt_scalef32_pk_fp4_f32(w, b.z * sc, b.w * sc, 1.0f, 3);
            o[q] = w;
        }
        const long e = (it * 32) >> 10; const int col = (int)((it * 32) & 1023);
        *(u32x4*)(dst + (size_t)(col >> 8) * ((size_t)NEXP * 128) + e * 128 + ((col & 255) >> 1)) = o;
    }
}
__device__ __forceinline__ void prep_convert_int4_sliced(const float* src, unsigned char* dst, long n32, float sc, long gt, long ngt) {
    for (long it = gt; it < n32; it += ngt) {
        u32x4 o;
#pragma unroll
        for (int q = 0; q < 4; ++q) {
            const f32x4 a = *(const f32x4*)(src + it * 32 + q * 8), b = *(const f32x4*)(src + it * 32 + q * 8 + 4);
            const float f[8] = {a.x, a.y, a.z, a.w, b.x, b.y, b.z, b.w};
            unsigned w = 0u;
#pragma unroll
            for (int i = 0; i < 8; ++i) { int v = (int)rintf(f[i] * sc); v = v < -7 ? -7 : (v > 7 ? 7 : v); w |= ((unsigned)v & 15u) << (4 * i); }
            o[q] = w;
        }
        const long e = (it * 32) >> 10; const int col = (int)((it * 32) & 1023);
        *(u32x4*)(dst + (size_t)(col >> 8) * ((size_t)NEXP * 128) + e * 128 + ((col & 255) >> 1)) = o;
    }
}
__device__ __forceinline__ void convert_expert_tables(const Params& p, int bi, int nblk) {
    const long gt = (long)bi * NTHREADS + tid_opaque(), ngt = (long)nblk * NTHREADS;
    if (U_FP4 && U_INT4) prep_convert_int4_sliced(p.pu, p.ws + WS_U8, (long)NEXP * D / 32, UI_SCALE, gt, ngt);
    else if (U_FP4) prep_convert_fp4_sliced(p.pu, p.ws + WS_U8, (long)NEXP * D / 32, U4_SCALE, gt, ngt);
    else prep_convert_fp8_sliced(p.pu, p.ws + WS_U8, (long)NEXP * D / 16, U8_SCALE, gt, ngt);
    if (V_FP4) prep_convert_fp4_sliced(p.pv, p.ws + WS_V8, (long)NEXP * D / 32, V4_SCALE, gt, ngt);
    else prep_convert_fp8_sliced(p.pv, p.ws + WS_V8, (long)NEXP * D / 16, V8_SCALE, gt, ngt);
}
__device__ __forceinline__ void phase_prep(const Params& p) {
    const long gt = (long)blockIdx.x * NTHREADS + tid_opaque(), ngt = (long)gridDim.x * NTHREADS;
    const int lane = tid_opaque() & 63;
    const long gw = gt >> 6, ngw = ngt >> 6;
    unsigned char* ws = p.ws;
    {
        f32x4 g[4];
#pragma unroll
        for (int j = 0; j < 4; ++j) g[j] = *((const f32x4*)p.ln1_g + lane + 64 * j);
        for (long m0 = gw * 4; m0 < NTOK; m0 += ngw * 4) {
            f32x4 v[4][4]; float s[4];
#pragma unroll
            for (int r = 0; r < 4; ++r) {
                const f32x4* xr = (const f32x4*)(p.x + (size_t)(m0 + r) * D) + lane;
#pragma unroll
                for (int j = 0; j < 4; ++j) v[r][j] = xr[64 * j];
            }
#pragma unroll
            for (int r = 0; r < 4; ++r) {
                s[r] = 0.f;
#pragma unroll
                for (int j = 0; j < 4; ++j) s[r] += (v[r][j].x * v[r][j].x + v[r][j].y * v[r][j].y) + (v[r][j].z * v[r][j].z + v[r][j].w * v[r][j].w);
            }
#pragma unroll
            for (int o = 1; o < 64; o <<= 1) {
#pragma unroll
                for (int r = 0; r < 4; ++r) s[r] += __shfl_xor(s[r], o);
            }
#pragma unroll
            for (int r = 0; r < 4; ++r) {
                const float rstd = 1.0f / sqrtf(s[r] * (1.0f / D) + EPS);
                u32x2* o = (u32x2*)((bf16_t*)(ws + WS_XN) + (size_t)(m0 + r) * D) + lane;
#pragma unroll
                for (int j = 0; j < 4; ++j) {
                    u32x2 w; w.x = pk2(v[r][j].x * rstd * g[j].x, v[r][j].y * rstd * g[j].y); w.y = pk2(v[r][j].z * rstd * g[j].z, v[r][j].w * rstd * g[j].w);
                    o[64 * j] = w;
                }
            }
        }
    }
    prep_transpose<true>(p.w_in, D, DIN, DINP, (bf16_t*)(ws + WS_WIN), gt, ngt);
    prep_transpose<false>(p.w_out, D, D, D, (bf16_t*)(ws + WS_WOUT), gt, ngt);
    prep_transpose<false>(p.wq, D, PQ, PQ, (bf16_t*)(ws + WS_WQ), gt, ngt);
    prep_convert(p.pkeys, (bf16_t*)(ws + WS_PKEYS), (long)16 * 128 * 128 / 8, gt, ngt);
    prep_transpose<false>(p.w1_k, 2048, 256, 256, (bf16_t*)(ws + WS_W1T), gt, ngt);
    prep_transpose<false>(p.w1_v, 2048, 256, 256, (bf16_t*)(ws + WS_W1T) + 256 * 2048, gt, ngt);
    prep_transpose<false>(p.w2_k, 256, 64, 64, (bf16_t*)(ws + WS_W2T), gt, ngt);
    prep_transpose<false>(p.w2_v, 256, 64, 64, (bf16_t*)(ws + WS_W2T) + 64 * 256, gt, ngt);
    for (long o = gw; o < 512; o += ngw) {
        const int kv = (int)(o >> 8), n = (int)(o & 255);
        const float* pe = kv ? p.pe_v : p.pe_k; const float* w1 = kv ? p.w1_v : p.w1_k;
        float s = 0.f;
        for (int k = lane; k < 2048; k += 64) s += pe[k] * w1[(size_t)k * 256 + n];
        s = wave_sum(s);
        if (lane == 0) ((float*)(ws + WS_B1))[o] = s;
    }
    for (long i = gt; i < NTOK; i += ngt) ((float*)(ws + WS_SS2))[i] = 0.f;
}

template <class Epi>
__device__ __forceinline__ void gemm_simple(const bf16_t* A, const bf16_t* Bt, int M, int N, int K, const Epi& E) {
    const int lane = tid_opaque() & 63;
    const long gw = ((long)blockIdx.x * NTHREADS + tid_opaque()) >> 6, ngw = ((long)gridDim.x * NTHREADS) >> 6;
    const int ntn = N / 64; const long ntiles = (long)(M / 32) * ntn;
    const int fr = lane & 15, fq = lane >> 4;
    for (long tile = gw; tile < ntiles; tile += ngw) {
        const int m0 = (int)(tile / ntn) * 32, n0 = (int)(tile % ntn) * 64;
        f32x4 acc[2][4];
#pragma unroll
        for (int i = 0; i < 2; ++i)
#pragma unroll
            for (int j = 0; j < 4; ++j) acc[i][j] = (f32x4){0.f, 0.f, 0.f, 0.f};
        const bf16_t* ap = A + (size_t)(m0 + fr) * K + fq * 8;
        const bf16_t* bp = Bt + (size_t)(n0 + fr) * K + fq * 8;
        for (int k0 = 0; k0 < K; k0 += 32) {
            bf16x8 a[2], b[4];
#pragma unroll
            for (int i = 0; i < 2; ++i) a[i] = *(const bf16x8*)(ap + (size_t)i * 16 * K + k0);
#pragma unroll
            for (int j = 0; j < 4; ++j) b[j] = *(const bf16x8*)(bp + (size_t)j * 16 * K + k0);
#pragma unroll
            for (int i = 0; i < 2; ++i)
#pragma unroll
                for (int j = 0; j < 4; ++j) acc[i][j] = __builtin_amdgcn_mfma_f32_16x16x32_bf16(a[i], b[j], acc[i][j], 0, 0, 0);
        }
        E(acc, m0, n0, fr, fq);
    }
}

struct EpiProj {
    unsigned char* ws;
    __device__ __forceinline__ void operator()(const f32x4 (&acc)[2][4], int m0, int n0, int fr, int fq) const {
#pragma unroll
        for (int i = 0; i < 2; ++i)
#pragma unroll
            for (int j = 0; j < 4; ++j)
#pragma unroll
                for (int r = 0; r < 4; ++r) {
                    const int row = m0 + 16 * i + fq * 4 + r, n = n0 + 16 * j + fr;
                    const float v = acc[i][j][r];
                    const int b = row / T, t = row % T, d = n & 63;
                    if (n < 512) {
                        const int head = n >> 6;
                        ((bf16_t*)(ws + WS_QN))[((size_t)(b * 8 + head) * T + t) * 64 + d] = (bf16_t)f2bf(v * 0.125f);
                    } else if (n < 1280) {
                        const int arr = (n - 512) >> 7, g = ((n - 512) >> 6) & 1;
                        ((bf16_t*)(ws + WS_KV6 + arr * KV6_STRIDE))[((size_t)(b * 2 + g) * T + t) * 64 + d] = (bf16_t)f2bf(v);
                    } else if (n < 1792) {
                        const int head = (n - 1280) >> 6;
                        ((bf16_t*)(ws + WS_QS))[((size_t)(b * 8 + head) * T + t) * 64 + d] = (bf16_t)f2bf(v * 0.125f);
                    } else if (n < 1856) {
                        ((bf16_t*)(ws + WS_KSW))[((size_t)b * T + t) * 64 + d] = (bf16_t)f2bf(v);
                    } else if (n < 1920) {
                        ((bf16_t*)(ws + WS_VSW))[((size_t)b * T + t) * 64 + d] = (bf16_t)f2bf(v);
                    } else if (n < 1944) {
                        ((float*)(ws + WS_GSIG))[(size_t)row * 24 + (n - 1920)] = 1.0f / (1.0f + expf(-v));
                    }
                }
    }
};
struct EpiOut {
    const float* x; const float* g2; float* h1; bf16_t* h1g; float* ss2;
    __device__ __forceinline__ void operator()(const f32x4 (&acc)[2][4], int m0, int n0, int fr, int fq) const {
#pragma unroll
        for (int i = 0; i < 2; ++i)
#pragma unroll
            for (int r = 0; r < 4; ++r) {
                const int row = m0 + 16 * i + fq * 4 + r; float ss = 0.f;
#pragma unroll
                for (int j = 0; j < 4; ++j) {
                    const int n = n0 + 16 * j + fr; const size_t off = (size_t)row * D + n;
                    const float h = x[off] + acc[i][j][r];
                    h1[off] = h; h1g[off] = (bf16_t)f2bf(h * g2[n]); ss += h * h;
                }
                ss += __shfl_xor(ss, 1); ss += __shfl_xor(ss, 2); ss += __shfl_xor(ss, 4); ss += __shfl_xor(ss, 8);
                if (fr == 0) atomicAdd(ss2 + row, ss);
            }
    }
};
struct EpiQP {
    const float* ss2; bf16_t* qp;
    __device__ __forceinline__ void operator()(const f32x4 (&acc)[2][4], int m0, int n0, int fr, int fq) const {
#pragma unroll
        for (int i = 0; i < 2; ++i)
#pragma unroll
            for (int r = 0; r < 4; ++r) {
                const int row = m0 + 16 * i + fq * 4 + r;
                const float rstd = 1.0f / sqrtf(ss2[row] * (1.0f / D) + EPS);
#pragma unroll
                for (int j = 0; j < 4; ++j) qp[(size_t)row * PQ + n0 + 16 * j + fr] = (bf16_t)f2bf(acc[i][j][r] * rstd);
            }
    }
};

namespace pg8 {
#define PG8_LAS __attribute__((address_space(3)))
typedef unsigned short bf16_t;
typedef short bf16x8 __attribute__((ext_vector_type(8)));
typedef float f32x4 __attribute__((ext_vector_type(4)));
typedef unsigned u32x4 __attribute__((ext_vector_type(4)));
constexpr int BM = 256, BK = 64, HALF = 128, HTB = HALF * BK * 2  , STAGE_BYTES = 8 * HTB, NXCD = 8, WGM = 8;

__host__ __device__ __forceinline__ int lds_byte(int r, int c) { const int st = (r >> 4) * 2 + (c >> 5), rr = r & 15, cc = c & 31, ob = rr * 64 + cc * 2; return st * 1024 + (ob ^ (((ob >> 9) & 1) << 5)); }
__host__ __device__ __forceinline__ void stage_rc(int b, int& R, int& C) { const int st = b / 1024, sb = b % 1024, swz = sb ^ (((sb >> 9) & 1) << 5); R = (st >> 1) * 16 + swz / 64; C = (st & 1) * 32 + (swz % 64) / 2; }
__host__ __device__ __forceinline__ int perm32(int rho) { const int n = rho >> 4, i = rho & 15; return 8 * (i >> 2) + 4 * n + (i & 3); }

struct Unit { int pm, pn; };
struct Gemm { const bf16_t* A; const bf16_t* Bt; int M, N, K; };

struct StaticOrder {
    int nM, nN, nwg, G, c;
    __host__ __device__ void init(int M, int N, int G_, int c_) { nM = M / BM; nN = N / BM; nwg = nM * nN; G = G_; c = c_; }
    __host__ __device__ bool next(int i, Unit& u) const {
        const long L = (long)i * G + c; if (L >= nwg) return false;
        int wgid = (int)L; { const int q = nwg / NXCD, r = nwg % NXCD, xcd = wgid % NXCD, off = wgid / NXCD; wgid = (xcd < r ? xcd * (q + 1) : r * (q + 1) + (xcd - r) * q) + off; }
        const int nig = WGM * nN, gid = wgid / nig, fm = gid * WGM, gsz = (nM - fm) < WGM ? (nM - fm) : WGM;
        u.pm = fm + ((wgid % nig) % gsz); u.pn = (wgid % nig) / gsz; return true;
    }
    __device__ __forceinline__ void a_ready(const Unit&) const {}
    __device__ __forceinline__ void done(const Unit&) const {}
};

__device__ __forceinline__ unsigned cvt_pk_bf16(float lo, float hi) { unsigned r; asm volatile("v_cvt_pk_bf16_f32 %0, %1, %2" : "=v"(r) : "v"(lo), "v"(hi)); return r; }
template <class Epi, class Sched, bool ALIGN_EPI = false, bool SP2 = false>
__device__ __forceinline__ void gemm_phase(PG8_LAS unsigned char* lds, const Gemm g, const Sched& S, const Epi& E) {
    const int tid = tid_opaque(), wid = __builtin_amdgcn_readfirstlane(tid >> 6), lane = tid & 63, wr = wid >> 2, wc = wid & 3, fr = lane & 15, fq = lane >> 4;
    const int K = g.K, nt = K / BK;
    unsigned voffA[2], voffB[2];
#pragma unroll
    for (int i = 0; i < 2; ++i) { int R, C; stage_rc(tid * 16 + i * 8192, R, C); const int Rb = Epi::PERM ? ((R & ~31) + perm32(R & 31)) : R;
        voffA[i] = (unsigned)(R * K + C) * 2u; voffB[i] = (unsigned)(Rb * K + C) * 2u; }
    const size_t kstep = (size_t)(BK * 2);
    const size_t hstep = (size_t)HALF * K * 2;
    const size_t tstep = 2 * hstep;
    const unsigned ldsw = (unsigned)wid * 1024u;
    const int aoff = lds_byte(wr * 64 + fr, fq * 8), boff = lds_byte(wc * 32 + fr, fq * 8);
#define PG8_SA(b, h) (((b) * 2 + (h)) * HTB)
#define PG8_SB(b, h) ((4 + (b) * 2 + (h)) * HTB)
#define PG8_STAGE(bufoff, gbase, voff) do { _Pragma("unroll") for (int _i = 0; _i < 2; ++_i) \
        __builtin_amdgcn_global_load_lds((const unsigned*)((const char*)(gbase) + (voff)[_i]), (PG8_LAS unsigned*)(lds + (bufoff) + ldsw + _i * 8192), 16, 0, 0); } while (0)
#define PG8_LDA(dst, b, h) do { _Pragma("unroll") for (int m = 0; m < 4; ++m) _Pragma("unroll") for (int k = 0; k < 2; ++k) dst[m][k] = *(const PG8_LAS bf16x8*)(lds + PG8_SA(b, h) + aoff + m * 2048 + k * 1024); } while (0)
#define PG8_LDB(dst, b, h) do { _Pragma("unroll") for (int n = 0; n < 2; ++n) _Pragma("unroll") for (int k = 0; k < 2; ++k) dst[n][k] = *(const PG8_LAS bf16x8*)(lds + PG8_SB(b, h) + boff + n * 2048 + k * 1024); } while (0)
#define PG8_MMA(ai, bj, At, Bt) do { __builtin_amdgcn_s_setprio(1); _Pragma("unroll") for (int m = 0; m < 4; ++m) _Pragma("unroll") for (int n = 0; n < 2; ++n) _Pragma("unroll") for (int k = 0; k < 2; ++k) \
        acc[ai][bj][m][n] = __builtin_amdgcn_mfma_f32_16x16x32_bf16(Bt[n][k], At[m][k], acc[ai][bj][m][n], 0, 0, 0); __builtin_amdgcn_s_setprio(0); } while (0)
#define PG8_WAIT_V(n) asm volatile("s_waitcnt vmcnt(" #n ")" ::: "memory")
#define PG8_WAIT_L(n) asm volatile("s_waitcnt lgkmcnt(" #n ")" ::: "memory")
#define PG8_BAR __builtin_amdgcn_s_barrier()
#define PG8_SCHED __builtin_amdgcn_sched_barrier(0)
    Unit cur, nxt; int ui = 0;
    if (!S.next(0, cur)) return;
    f32x4 acc[2][2][4][2];
#pragma unroll
    for (int a = 0; a < 2; ++a)
#pragma unroll
        for (int b = 0; b < 2; ++b)
#pragma unroll
            for (int m = 0; m < 4; ++m)
#pragma unroll
                for (int n = 0; n < 2; ++n) acc[a][b][m][n] = (f32x4){0.f, 0.f, 0.f, 0.f};
    bf16x8 At[4][2], B0[2][2], B1[2][2];
    const char* cA = (const char*)g.A + (size_t)cur.pm * tstep; const char* cB = (const char*)g.Bt + (size_t)cur.pn * tstep;
    S.a_ready(cur);
    if constexpr (SP2) {
        PG8_STAGE(PG8_SB(0, 0), cB, voffB); PG8_STAGE(PG8_SB(0, 1), cB + hstep, voffB); PG8_STAGE(PG8_SA(0, 0), cA, voffA); PG8_STAGE(PG8_SA(0, 1), cA + hstep, voffA);
        if (wr == 1) PG8_BAR;
        PG8_WAIT_V(2); PG8_BAR;
        PG8_STAGE(PG8_SB(1, 0), cB + kstep, voffB); PG8_STAGE(PG8_SA(1, 0), cA + kstep, voffA); PG8_STAGE(PG8_SB(1, 1), cB + hstep + kstep, voffB);
        PG8_WAIT_V(6); PG8_BAR;
    } else {
        PG8_STAGE(PG8_SB(0, 0), cB, voffB); PG8_STAGE(PG8_SA(0, 0), cA, voffA); PG8_STAGE(PG8_SB(0, 1), cB + hstep, voffB); PG8_STAGE(PG8_SA(0, 1), cA + hstep, voffA);
        if (wr == 1) PG8_BAR;
        PG8_WAIT_V(4); PG8_BAR;
        PG8_STAGE(PG8_SB(1, 0), cB + kstep, voffB); PG8_STAGE(PG8_SA(1, 0), cA + kstep, voffA); PG8_STAGE(PG8_SB(1, 1), cB + hstep + kstep, voffB);
        PG8_WAIT_V(6); PG8_BAR;
    }
    for (;;) {
        const bool has_next = S.next(ui + 1, nxt);
        const char* nA = has_next ? (const char*)g.A + (size_t)nxt.pm * tstep : cA; const char* nB = has_next ? (const char*)g.Bt + (size_t)nxt.pn * tstep : cB;
        for (int t = 0; t < nt; t += 2) {
            const bool last = (t == nt - 2);
            const char* a1 = cA + (size_t)(t + 1) * kstep;
            const char* a2 = last ? nA : cA + (size_t)(t + 2) * kstep; const char* b2 = last ? nB : cB + (size_t)(t + 2) * kstep;
            const char* a3 = a2 + kstep; const char* b3 = b2 + kstep;
            if (last && has_next) S.a_ready(nxt);
            if constexpr (SP2) {
            PG8_LDB(B0, 0, 0); PG8_LDB(B1, 0, 1); PG8_SCHED; PG8_LDA(At, 0, 0); PG8_STAGE(PG8_SA(1, 1), a1 + hstep, voffA);
            PG8_WAIT_V(8); PG8_WAIT_L(0); PG8_BAR; PG8_MMA(0, 0, At, B0); PG8_MMA(0, 1, At, B1); PG8_BAR; PG8_SCHED;
            PG8_LDA(At, 0, 1); PG8_STAGE(PG8_SB(0, 0), b2, voffB); PG8_STAGE(PG8_SB(0, 1), b2 + hstep, voffB); PG8_STAGE(PG8_SA(0, 0), a2, voffA);
            PG8_WAIT_V(8); PG8_WAIT_L(0); PG8_BAR; PG8_MMA(1, 0, At, B0); PG8_MMA(1, 1, At, B1); PG8_BAR; PG8_SCHED;
            PG8_LDB(B0, 1, 0); PG8_LDB(B1, 1, 1); PG8_SCHED; PG8_LDA(At, 1, 0); PG8_STAGE(PG8_SA(0, 1), a2 + hstep, voffA);
            PG8_WAIT_V(8); PG8_WAIT_L(0); PG8_BAR; PG8_MMA(0, 0, At, B0); PG8_MMA(0, 1, At, B1); PG8_BAR; PG8_SCHED;
            PG8_LDA(At, 1, 1); PG8_STAGE(PG8_SB(1, 0), b3, voffB); PG8_STAGE(PG8_SB(1, 1), b3 + hstep, voffB); PG8_STAGE(PG8_SA(1, 0), a3, voffA);
            PG8_WAIT_V(8); PG8_WAIT_L(0); PG8_BAR; PG8_MMA(1, 0, At, B0); PG8_MMA(1, 1, At, B1); PG8_BAR; PG8_SCHED;
            } else {
            PG8_LDB(B0, 0, 0); PG8_SCHED; PG8_LDA(At, 0, 0); PG8_STAGE(PG8_SA(1, 1), a1 + hstep, voffA);
            PG8_WAIT_L(8); PG8_BAR; PG8_WAIT_L(0); PG8_MMA(0, 0, At, B0); PG8_BAR; PG8_SCHED;
            PG8_LDB(B1, 0, 1); PG8_STAGE(PG8_SB(0, 0), b2, voffB);
            PG8_BAR; PG8_WAIT_L(0); PG8_MMA(0, 1, At, B1); PG8_BAR;
            PG8_LDA(At, 0, 1); PG8_STAGE(PG8_SA(0, 0), a2, voffA);
            PG8_BAR; PG8_WAIT_L(0); PG8_MMA(1, 0, At, B0); PG8_BAR; PG8_SCHED;
            PG8_STAGE(PG8_SB(0, 1), b2 + hstep, voffB);
            PG8_WAIT_V(6); PG8_BAR; PG8_MMA(1, 1, At, B1); PG8_BAR;
            PG8_LDB(B0, 1, 0); PG8_SCHED; PG8_LDA(At, 1, 0); PG8_STAGE(PG8_SA(0, 1), a2 + hstep, voffA);
            PG8_WAIT_L(8); PG8_BAR; PG8_WAIT_L(0); PG8_MMA(0, 0, At, B0); PG8_BAR; PG8_SCHED;
            PG8_LDB(B1, 1, 1); PG8_STAGE(PG8_SB(1, 0), b3, voffB);
            PG8_BAR; PG8_WAIT_L(0); PG8_MMA(0, 1, At, B1); PG8_BAR;
            PG8_LDA(At, 1, 1); PG8_STAGE(PG8_SA(1, 0), a3, voffA);
            PG8_BAR; PG8_WAIT_L(0); PG8_MMA(1, 0, At, B0); PG8_BAR; PG8_SCHED;
            PG8_STAGE(PG8_SB(1, 1), b3 + hstep, voffB);
            PG8_WAIT_V(6); PG8_BAR; PG8_MMA(1, 1, At, B1); PG8_BAR;
            }
        }
        if constexpr (ALIGN_EPI) { if (wr == 0) PG8_BAR; }
        if constexpr (!Epi::AFTER_DRAIN) { E(acc, cur, wr, wc, fr, fq); S.done(cur); }
        if (!has_next) break;
#pragma unroll
        for (int a = 0; a < 2; ++a)
#pragma unroll
            for (int b = 0; b < 2; ++b)
#pragma unroll
                for (int m = 0; m < 4; ++m)
#pragma unroll
                    for (int n = 0; n < 2; ++n) acc[a][b][m][n] = (f32x4){0.f, 0.f, 0.f, 0.f};
        cur = nxt; cA = nA; cB = nB; ++ui;
        if constexpr (ALIGN_EPI) { if (wr == 1) PG8_BAR; }
    }
    PG8_WAIT_V(0);
    if constexpr (!ALIGN_EPI) { if (wr == 0) PG8_BAR; }
    PG8_BAR;
    if constexpr (Epi::AFTER_DRAIN) { E.fused(acc, cur, wr, wc, fr, fq, lds, wid, lane); S.done(cur); }
#undef PG8_SA
#undef PG8_SB
#undef PG8_STAGE
#undef PG8_LDA
#undef PG8_LDB
#undef PG8_MMA
#undef PG8_WAIT_V
#undef PG8_WAIT_L
#undef PG8_BAR
#undef PG8_SCHED
}
}

struct EpiProjT {
    static constexpr bool PERM = true, AFTER_DRAIN = false;
    unsigned char* ws;
    __device__ __forceinline__ void operator()(const f32x4 (&acc)[2][2][4][2], const pg8::Unit& u, int wr, int wc, int fr, int fq) const {
        const int row0 = u.pm * 256 + wr * 64 + fr;
#pragma unroll
        for (int bj = 0; bj < 2; ++bj) {
            const int n8 = u.pn * 256 + bj * 128 + wc * 32 + 8 * fq;
            if (n8 >= 1944) continue;
            if (n8 >= 1920) {
#pragma unroll
                for (int ai = 0; ai < 2; ++ai)
#pragma unroll
                    for (int m = 0; m < 4; ++m) {
                        const int row = row0 + ai * 128 + m * 16;
                        const f32x4 v0 = acc[ai][bj][m][0], v1 = acc[ai][bj][m][1];
                        float* dst = (float*)(ws + WS_GSIG) + (size_t)row * 24 + (n8 - 1920);
                        *(f32x4*)dst = (f32x4){1.0f / (1.0f + __expf(-v0[0])), 1.0f / (1.0f + __expf(-v0[1])), 1.0f / (1.0f + __expf(-v0[2])), 1.0f / (1.0f + __expf(-v0[3]))};
                        *(f32x4*)(dst + 4) = (f32x4){1.0f / (1.0f + __expf(-v1[0])), 1.0f / (1.0f + __expf(-v1[1])), 1.0f / (1.0f + __expf(-v1[2])), 1.0f / (1.0f + __expf(-v1[3]))};
                    }
                continue;
            }
            bf16_t* base; int nh, hidx; float sc = 1.0f;
            if (n8 < 512) { base = (bf16_t*)(ws + WS_QN); nh = 8; hidx = n8 >> 6; sc = 0.125f * 1.4426950408889634f; }
            else if (n8 < 1280) { const int arr = (n8 - 512) >> 7; base = (bf16_t*)(ws + WS_KV6 + (size_t)arr * KV6_STRIDE); nh = 2; hidx = ((n8 - 512) >> 6) & 1; }
            else if (n8 < 1792) { base = (bf16_t*)(ws + WS_QS); nh = 8; hidx = (n8 - 1280) >> 6; sc = 0.125f * 1.4426950408889634f; }
            else if (n8 < 1856) { base = (bf16_t*)(ws + WS_KSW); nh = 1; hidx = 0; }
            else { base = (bf16_t*)(ws + WS_VSW); nh = 1; hidx = 0; }
            const int d0 = n8 & 63;
#pragma unroll
            for (int ai = 0; ai < 2; ++ai)
#pragma unroll
                for (int m = 0; m < 4; ++m) {
                    const int row = row0 + ai * 128 + m * 16, b = row >> 13, t = row & (T - 1);
                    const f32x4 v0 = acc[ai][bj][m][0] * sc, v1 = acc[ai][bj][m][1] * sc;
                    u32x4 w; w.x = pg8::cvt_pk_bf16(v0[0], v0[1]); w.y = pg8::cvt_pk_bf16(v0[2], v0[3]); w.z = pg8::cvt_pk_bf16(v1[0], v1[1]); w.w = pg8::cvt_pk_bf16(v1[2], v1[3]);
                    *(u32x4*)(base + ((size_t)(b * nh + hidx) * T + t) * 64 + d0) = w;
                }
        }
    }
};
struct EpiOutT {
    static constexpr bool PERM = false, AFTER_DRAIN = false;
    const float* x; const float* g2; float* h1; bf16_t* h1g; float* ss2;
    __device__ __forceinline__ void operator()(const f32x4 (&acc)[2][2][4][2], const pg8::Unit& u, int wr, int wc, int fr, int fq) const {
        const int row0 = u.pm * 256 + wr * 64 + fr, col0 = u.pn * 256 + wc * 32 + 4 * fq;
#pragma unroll
        for (int ai = 0; ai < 2; ++ai)
#pragma unroll
            for (int m = 0; m < 4; ++m) {
                const int row = row0 + ai * 128 + m * 16; float ss = 0.f;
#pragma unroll
                for (int bj = 0; bj < 2; ++bj)
#pragma unroll
                    for (int n = 0; n < 2; ++n) {
                        const int c = col0 + bj * 128 + n * 16; const size_t off = (size_t)row * D + c;
                        const f32x4 h = *(const f32x4*)(x + off) + acc[ai][bj][m][n];
                        const f32x4 g = *(const f32x4*)(g2 + c);
                        u32x2 w; w.x = pg8::cvt_pk_bf16(h[0] * g[0], h[1] * g[1]); w.y = pg8::cvt_pk_bf16(h[2] * g[2], h[3] * g[3]);
                        *(u32x2*)(h1g + off) = w;
                        ss += (h[0] * h[0] + h[1] * h[1]) + (h[2] * h[2] + h[3] * h[3]);
                    }
                ss += __shfl_xor(ss, 16); ss += __shfl_xor(ss, 32);
                if (fq == 0) atomicAdd(ss2 + row, ss);
            }
    }
};
struct EpiQPT {
    static constexpr bool PERM = true, AFTER_DRAIN = false;
    const float* ss2; bf16_t* qp;
    __device__ __forceinline__ void operator()(const f32x4 (&acc)[2][2][4][2], const pg8::Unit& u, int wr, int wc, int fr, int fq) const {
        const int row0 = u.pm * 256 + wr * 64 + fr;
#pragma unroll
        for (int ai = 0; ai < 2; ++ai)
#pragma unroll
            for (int m = 0; m < 4; ++m) {
                const int row = row0 + ai * 128 + m * 16;
                const float rstd = 1.0f / sqrtf(ss2[row] * (1.0f / D) + EPS);
#pragma unroll
                for (int bj = 0; bj < 2; ++bj) {
                    const int n8 = u.pn * 256 + bj * 128 + wc * 32 + 8 * fq;
                    const f32x4 v0 = acc[ai][bj][m][0] * rstd, v1 = acc[ai][bj][m][1] * rstd;
                    u32x4 w; w.x = pg8::cvt_pk_bf16(v0[0], v0[1]); w.y = pg8::cvt_pk_bf16(v0[2], v0[3]); w.z = pg8::cvt_pk_bf16(v1[0], v1[1]); w.w = pg8::cvt_pk_bf16(v1[2], v1[3]);
                    *(u32x4*)(qp + (size_t)row * PQ + n8) = w;
                }
            }
    }
};

__device__ __forceinline__ void phase_compress(const Params& p, float* lds) {
    float* flat = lds;
    float* part = lds + 2048;
    float* hid = lds + 2560;
    const int tid = tid_opaque();
    const int nunits = 2 * BATCH * NCMP * NSA_G;
    for (int u = blockIdx.x; u < nunits; u += gridDim.x) {
        const int kv = u / (BATCH * NCMP * NSA_G); int r = u % (BATCH * NCMP * NSA_G);
        const int b = r / (NCMP * NSA_G); r %= (NCMP * NSA_G);
        const int c = r / NSA_G, g = r % NSA_G;
        const bf16_t* raw = (const bf16_t*)(p.ws + WS_KV6 + (size_t)kv * KV6_STRIDE) + ((size_t)(b * 2 + g) * T + 16 * c) * 64;
        const float* pe = kv ? p.pe_v : p.pe_k; const float* w1 = kv ? p.w1_v : p.w1_k; const float* w2 = kv ? p.w2_v : p.w2_k;
        for (int i = tid; i < 2048; i += NTHREADS) flat[i] = bf2f(raw[i]) + pe[i];
        __syncthreads();
        {
            const int j = tid & 255, half = tid >> 8;
            float a = 0.f;
            const float* wp = w1 + (size_t)(half * 1024) * 256 + j; const float* fp = flat + half * 1024;
            for (int i = 0; i < 1024; ++i) a += fp[i] * wp[(size_t)i * 256];
            part[tid] = a;
        }
        __syncthreads();
        if (tid < 256) hid[tid] = gelu_tanh(part[tid] + part[tid + 256]);
        __syncthreads();
        if (tid < 64) {
            float a = 0.f;
            for (int j = 0; j < 256; ++j) a += hid[j] * w2[j * 64 + tid];
            bf16_t* dst = (bf16_t*)(p.ws + (kv ? WS_VC : WS_KC)) + ((size_t)(b * 2 + g) * NCMPP + c) * 64;
            dst[tid] = (bf16_t)f2bf(a);
        }
        __syncthreads();
    }
}

__device__ __forceinline__ void load_row64(const bf16_t* src, float (&k)[64]) {
#pragma unroll
    for (int c = 0; c < 8; ++c) {
        const u32x4 w = *(const u32x4*)(src + 8 * c);
        k[8 * c + 0] = bflo(w.x); k[8 * c + 1] = bfhi(w.x); k[8 * c + 2] = bflo(w.y); k[8 * c + 3] = bfhi(w.y);
        k[8 * c + 4] = bflo(w.z); k[8 * c + 5] = bfhi(w.z); k[8 * c + 6] = bflo(w.w); k[8 * c + 7] = bfhi(w.w);
    }
}
__device__ __forceinline__ float dot_row64(const bf16_t* src, const float (&q)[64]) {
    float s0 = 0.f, s1 = 0.f;
#pragma unroll
    for (int c = 0; c < 8; ++c) {
        const u32x4 w = *(const u32x4*)(src + 8 * c);
        s0 += q[8 * c + 0] * bflo(w.x); s1 += q[8 * c + 1] * bfhi(w.x); s0 += q[8 * c + 2] * bflo(w.y); s1 += q[8 * c + 3] * bfhi(w.y);
        s0 += q[8 * c + 4] * bflo(w.z); s1 += q[8 * c + 5] * bfhi(w.z); s0 += q[8 * c + 6] * bflo(w.w); s1 += q[8 * c + 7] * bfhi(w.w);
    }
    return s0 + s1;
}
__device__ __forceinline__ void osm_update(float s, const bf16_t* vsrc, float& m, float& l, float (&acc)[32]) {
    const float mn = fmaxf(m, s), alpha = __expf(m - mn), pr = __expf(s - mn);
    l = l * alpha + pr; m = mn;
#pragma unroll
    for (int c = 0; c < 4; ++c) {
        const u32x4 w = *(const u32x4*)(vsrc + 8 * c);
        acc[8 * c + 0] = acc[8 * c + 0] * alpha + pr * bflo(w.x); acc[8 * c + 1] = acc[8 * c + 1] * alpha + pr * bfhi(w.x);
        acc[8 * c + 2] = acc[8 * c + 2] * alpha + pr * bflo(w.y); acc[8 * c + 3] = acc[8 * c + 3] * alpha + pr * bfhi(w.y);
        acc[8 * c + 4] = acc[8 * c + 4] * alpha + pr * bflo(w.z); acc[8 * c + 5] = acc[8 * c + 5] * alpha + pr * bfhi(w.z);
        acc[8 * c + 6] = acc[8 * c + 6] * alpha + pr * bflo(w.w); acc[8 * c + 7] = acc[8 * c + 7] * alpha + pr * bfhi(w.w);
    }
}

__device__ __forceinline__ void phase_nsa(const Params& p, float* lds) {
    float* imp = lds;
    int* sel = (int*)(lds + 64 * 129);
    const int tid = tid_opaque(), qi = tid & 63, h = (tid >> 6) & 3, dh = tid >> 8;
    const unsigned char* ws = p.ws;
    const int nunits = BATCH * NSA_G * (T / 64);
    for (int u = blockIdx.x; u < nunits; u += gridDim.x) {
        const int b = u / (NSA_G * (T / 64)), g = (u / (T / 64)) % NSA_G, tile = u % (T / 64);
        const int t = tile * 64 + qi, head = g * 4 + h;
        const float slope = exp2f(-0.5f * (float)(9 + head));
        float q[64];
        load_row64((const bf16_t*)(ws + WS_QN) + ((size_t)(b * 8 + head) * T + t) * 64, q);
        const bf16_t* KC = (const bf16_t*)(ws + WS_KC) + (size_t)(b * 2 + g) * NCMPP * 64;
        const bf16_t* VC = (const bf16_t*)(ws + WS_VC) + (size_t)(b * 2 + g) * NCMPP * 64 + dh * 32;
        const bf16_t* KS = (const bf16_t*)(ws + WS_KV6 + 2 * KV6_STRIDE) + (size_t)(b * 2 + g) * T * 64;
        const bf16_t* VS = (const bf16_t*)(ws + WS_KV6 + 3 * KV6_STRIDE) + (size_t)(b * 2 + g) * T * 64 + dh * 32;
        const bf16_t* KW = (const bf16_t*)(ws + WS_KV6 + 4 * KV6_STRIDE) + (size_t)(b * 2 + g) * T * 64;
        const bf16_t* VW = (const bf16_t*)(ws + WS_KV6 + 5 * KV6_STRIDE) + (size_t)(b * 2 + g) * T * 64 + dh * 32;
        const float* gs = (const float*)(ws + WS_GSIG) + (size_t)(b * T + t) * 24 + head * 3;
        float o[32];
#pragma unroll
        for (int d = 0; d < 32; ++d) o[d] = 0.f;
        for (int i = tid; i < 64 * 129; i += NTHREADS) imp[i] = 0.f;
        __syncthreads();
        const int nc = 4 * tile + 3;
        float mc = -1e30f, lc = 0.f;
        {
            float acc[32];
#pragma unroll
            for (int d = 0; d < 32; ++d) acc[d] = 0.f;
            for (int c = 0; c < nc; ++c) {
                const int dist = t - (16 * c + 31);
                if (dist >= 0) {
                    const float s = dot_row64(KC + (size_t)c * 64, q) - slope * (float)dist;
                    osm_update(s, VC + (size_t)c * 64, mc, lc, acc);
                }
            }
            const float inv = gs[0] / fmaxf(lc, 1e-30f);
#pragma unroll
            for (int d = 0; d < 32; ++d) o[d] += acc[d] * inv;
        }
        if (dh == 0) {
            const float invl = 1.0f / fmaxf(lc, 1e-30f);
            for (int c = 0; c < nc; ++c) {
                const int dist = t - (16 * c + 31);
                if (dist >= 0) {
                    const float s = dot_row64(KC + (size_t)c * 64, q) - slope * (float)dist;
                    const float pr = __expf(s - mc) * invl;
                    const int sb = c >> 2;
                    atomicAdd(&imp[qi * 129 + sb], pr);
                    if ((c & 3) == 3 && sb + 1 < NSEL) atomicAdd(&imp[qi * 129 + sb + 1], pr);
                }
            }
        }
        __syncthreads();
        if (tid < 64) {
            const int blk_t = tile;
            float* row = imp + tid * 129;
            for (int j = 0; j <= blk_t; ++j) if (j == 0 || j == blk_t || j == blk_t - 1) row[j] = 1.0e4f;
            for (int k = 0; k < TOPN; ++k) {
                float best = -INFINITY; int bi = -1;
                for (int j = 0; j <= blk_t; ++j) { const float v = row[j]; if (v > best) { best = v; bi = j; } }
                sel[tid * 16 + k] = bi;
                if (bi >= 0) row[bi] = -INFINITY;
            }
        }
        __syncthreads();
        {
            float m = -1e30f, l = 0.f, acc[32];
#pragma unroll
            for (int d = 0; d < 32; ++d) acc[d] = 0.f;
            for (int k = 0; k < TOPN; ++k) {
                const int j = sel[qi * 16 + k];
                if (j >= 0) {
                    for (int i = 0; i < 64; ++i) {
                        const int pos = 64 * j + i;
                        if (pos <= t) {
                            const float s = dot_row64(KS + (size_t)pos * 64, q) - slope * (float)(t - pos);
                            osm_update(s, VS + (size_t)pos * 64, m, l, acc);
                        }
                    }
                }
            }
            const float inv = gs[1] / fmaxf(l, 1e-30f);
#pragma unroll
            for (int d = 0; d < 32; ++d) o[d] += acc[d] * inv;
        }
        {
            float m = -1e30f, l = 0.f, acc[32];
#pragma unroll
            for (int d = 0; d < 32; ++d) acc[d] = 0.f;
            for (int i = 0; i < NSA_WIN; ++i) {
                const int pos = t - (NSA_WIN - 1) + i;
                if (pos >= 0) {
                    const float s = dot_row64(KW + (size_t)pos * 64, q) - slope * (float)(t - pos);
                    osm_update(s, VW + (size_t)pos * 64, m, l, acc);
                }
            }
            const float inv = gs[2] / fmaxf(l, 1e-30f);
#pragma unroll
            for (int d = 0; d < 32; ++d) o[d] += acc[d] * inv;
        }
        bf16_t* O = (bf16_t*)(p.ws + WS_O) + (size_t)(b * T + t) * D + g * 256 + h * 64 + dh * 32;
#pragma unroll
        for (int c = 0; c < 4; ++c) {
            u32x4 w; w.x = pk2(o[8 * c], o[8 * c + 1]); w.y = pk2(o[8 * c + 2], o[8 * c + 3]); w.z = pk2(o[8 * c + 4], o[8 * c + 5]); w.w = pk2(o[8 * c + 6], o[8 * c + 7]);
            *(u32x4*)(O + 8 * c) = w;
        }
        __syncthreads();
    }
}

__device__ __forceinline__ void phase_swa(const Params& p) {
    const unsigned char* ws = p.ws;
    const long gt = (long)blockIdx.x * NTHREADS + tid_opaque(), ngt = (long)gridDim.x * NTHREADS;
    const long items = (long)NTOK * SWA_H * 2;
    for (long it = gt; it < items; it += ngt) {
        const int tt = (int)(it % T); long r = it / T;
        const int dh = (int)(r % 2); r /= 2;
        const int head = (int)(r % SWA_H); const int b = (int)(r / SWA_H);
        const float slope = exp2f(-0.5f * (float)(head + 1));
        float q[64];
        load_row64((const bf16_t*)(ws + WS_QS) + ((size_t)(b * 8 + head) * T + tt) * 64, q);
        const bf16_t* K = (const bf16_t*)(ws + WS_KSW) + (size_t)b * T * 64;
        const bf16_t* V = (const bf16_t*)(ws + WS_VSW) + (size_t)b * T * 64 + dh * 32;
        const float sink = p.sinks[head];
        float m = sink, l = 1.0f, acc[32];
#pragma unroll
        for (int d = 0; d < 32; ++d) acc[d] = 0.f;
        for (int i = 0; i < SWA_WIN; ++i) {
            const int pos = tt - (SWA_WIN - 1) + i;
            if (pos >= 0) {
                const float s = dot_row64(K + (size_t)pos * 64, q) - slope * (float)(tt - pos);
                osm_update(s, V + (size_t)pos * 64, m, l, acc);
            }
        }
        const float inv = 1.0f / l;
        bf16_t* O = (bf16_t*)(p.ws + WS_O) + (size_t)(b * T + tt) * D + 512 + head * 64 + dh * 32;
#pragma unroll
        for (int c = 0; c < 4; ++c) {
            u32x4 w; w.x = pk2(acc[8 * c] * inv, acc[8 * c + 1] * inv); w.y = pk2(acc[8 * c + 2] * inv, acc[8 * c + 3] * inv);
            w.z = pk2(acc[8 * c + 4] * inv, acc[8 * c + 5] * inv); w.w = pk2(acc[8 * c + 6] * inv, acc[8 * c + 7] * inv);
            *(u32x4*)(O + 8 * c) = w;
        }
    }
}

__device__ __forceinline__ void topk_insert(float v, int i, float (&tv)[16], int (&ti)[16]) {
#pragma unroll
    for (int k = 0; k < 16; ++k) {
        const bool sw = v > tv[k];
        const float ov = tv[k]; const int oi = ti[k];
        tv[k] = sw ? v : ov; ti[k] = sw ? i : oi;
        v = sw ? ov : v; i = sw ? oi : i;
    }
}
__device__ __forceinline__ void phase_peer_sub(const Params& p) {
    const unsigned char* ws = p.ws;
    const long gt = (long)blockIdx.x * NTHREADS + tid_opaque(), ngt = (long)gridDim.x * NTHREADS;
    const long items = (long)NTOK * 16;
    for (long it = gt; it < items; it += ngt) {
        const int tok = (int)(it % NTOK), hc = (int)(it / NTOK);
        const bf16_t* qp = (const bf16_t*)(ws + WS_QP) + (size_t)tok * PQ + hc * 128;
        float q0[64], q1[64];
        load_row64(qp, q0); load_row64(qp + 64, q1);
        const bf16_t* keys = (const bf16_t*)(ws + WS_PKEYS) + (size_t)hc * 128 * 128;
        float tv[16]; int ti[16];
#pragma unroll
        for (int k = 0; k < 16; ++k) { tv[k] = -INFINITY; ti[k] = 0; }
        for (int n = 0; n < 128; ++n) {
            const float s = dot_row64(keys + (size_t)n * 128, q0) + dot_row64(keys + (size_t)n * 128 + 64, q1);
            topk_insert(s, n, tv, ti);
        }
        float* ov = (float*)(p.ws + WS_TOPV2) + ((size_t)tok * 16 + hc) * 16;
        int* oi = (int*)(p.ws + WS_TOPI2) + ((size_t)tok * 16 + hc) * 16;
#pragma unroll
        for (int k = 0; k < 16; ++k) { ov[k] = tv[k]; oi[k] = ti[k]; }
    }
}
__device__ __forceinline__ void phase_peer_comb(const Params& p) {
    const long gt = (long)blockIdx.x * NTHREADS + tid_opaque(), ngt = (long)gridDim.x * NTHREADS;
    const long items = (long)NTOK * PH;
    for (long it = gt; it < items; it += ngt) {
        const int tok = (int)(it / PH), h = (int)(it % PH);
        const float* v1 = (const float*)(p.ws + WS_TOPV2) + ((size_t)tok * 16 + h * 2) * 16;
        const float* v2 = v1 + 16;
        const int* i1 = (const int*)(p.ws + WS_TOPI2) + ((size_t)tok * 16 + h * 2) * 16;
        const int* i2 = i1 + 16;
        float s2[16];
#pragma unroll
        for (int k = 0; k < 16; ++k) s2[k] = v2[k];
        float tv[16]; int ti[16];
#pragma unroll
        for (int k = 0; k < 16; ++k) { tv[k] = -INFINITY; ti[k] = 0; }
        for (int a = 0; a < 16; ++a) {
            const float s1 = v1[a];
#pragma unroll
            for (int bb = 0; bb < 16; ++bb) topk_insert(s1 + s2[bb], a * 16 + bb, tv, ti);
        }
        float e[16], sum = 0.f;
#pragma unroll
        for (int k = 0; k < 16; ++k) { e[k] = __expf(tv[k] - tv[0]); sum += e[k]; }
        const float inv = 1.0f / sum;
        int* eo = (int*)(p.ws + WS_EIDX) + (size_t)tok * 128 + h * 16;
        float* go = (float*)(p.ws + WS_GATE) + (size_t)tok * 128 + h * 16;
#pragma unroll
        for (int k = 0; k < 16; ++k) { const int ci = ti[k]; eo[k] = i1[ci >> 4] * PNK + i2[ci & 15]; go[k] = e[k] * inv; }
    }
}

typedef float f32x2 __attribute__((ext_vector_type(2)));
__device__ __forceinline__ void unpack16_fp8(const u32x4& w, float (&f)[16]) {
#pragma unroll
    for (int q = 0; q < 4; ++q) {
        const f32x2 lo = __builtin_amdgcn_cvt_pk_f32_fp8((int)w[q], false), hi = __builtin_amdgcn_cvt_pk_f32_fp8((int)w[q], true);
        f[4 * q] = lo.x; f[4 * q + 1] = lo.y; f[4 * q + 2] = hi.x; f[4 * q + 3] = hi.y;
    }
}
__device__ __forceinline__ float reduce8(const float (&d)[8], int lane) {
    const bool b5 = lane & 32, b4 = lane & 16, b3 = lane & 8;
    float e[4], f[2];
#pragma unroll
    for (int i = 0; i < 4; ++i) { const float snd = b5 ? d[i] : d[i + 4], keep = b5 ? d[i + 4] : d[i]; e[i] = keep + __shfl_xor(snd, 32); }
#pragma unroll
    for (int i = 0; i < 2; ++i) { const float snd = b4 ? e[i] : e[i + 2], keep = b4 ? e[i + 2] : e[i]; f[i] = keep + __shfl_xor(snd, 16); }
    const float snd = b3 ? f[0] : f[1], keep = b3 ? f[1] : f[0];
    float g = keep + __shfl_xor(snd, 8);
    g += __shfl_xor(g, 4); g += __shfl_xor(g, 2); g += __shfl_xor(g, 1);
    return g;
}
__device__ __forceinline__ void phase_peer_expert(const Params& p) {
    const unsigned char* ws = p.ws;
    const int tid_ = tid_opaque(), lane = tid_ & 63;
    const int gw = (int)blockIdx.x * (NTHREADS / 64) + __builtin_amdgcn_readfirstlane(tid_ >> 6), ngw = (int)gridDim.x * (NTHREADS / 64);
    const unsigned char* U = ws + WS_U8; const unsigned char* V = ws + WS_V8;
    const unsigned loff = 16u * (unsigned)lane;
    for (int tok = gw; tok < NTOK; tok += ngw) {
        const bf16_t* hg = (const bf16_t*)(ws + WS_H1G + (size_t)tok * D * 2) + loff;
        float a[16];
        {
            const u32x4 w0 = *(const u32x4*)hg, w1 = *(const u32x4*)(hg + 8);
            a[0] = bflo(w0.x); a[1] = bfhi(w0.x); a[2] = bflo(w0.y); a[3] = bfhi(w0.y); a[4] = bflo(w0.z); a[5] = bfhi(w0.z); a[6] = bflo(w0.w); a[7] = bfhi(w0.w);
            a[8] = bflo(w1.x); a[9] = bfhi(w1.x); a[10] = bflo(w1.y); a[11] = bfhi(w1.y); a[12] = bflo(w1.z); a[13] = bfhi(w1.z); a[14] = bflo(w1.w); a[15] = bfhi(w1.w);
        }
        const float rstd2 = (1.0f / U8_SCALE) / sqrtf(((const float*)(ws + WS_SS2))[tok] * (1.0f / D) + EPS);
        const int e_lo = ((const int*)(ws + WS_EIDX))[(size_t)tok * 128 + lane], e_hi = ((const int*)(ws + WS_EIDX))[(size_t)tok * 128 + 64 + lane];
        const float g_lo = ((const float*)(ws + WS_GATE))[(size_t)tok * 128 + lane], g_hi = ((const float*)(ws + WS_GATE))[(size_t)tok * 128 + 64 + lane];
        float acc[16];
#pragma unroll
        for (int i = 0; i < 16; ++i) acc[i] = 0.f;
        u32x4 uw[8], vw[8];
#pragma unroll
        for (int k = 0; k < 8; ++k) { const int e = __builtin_amdgcn_readlane(e_lo, k); uw[k] = *(const u32x4*)(U + (size_t)e * D + loff); vw[k] = *(const u32x4*)(V + (size_t)e * D + loff); }
#pragma unroll 1
        for (int b = 0; b < 16; ++b) {
            const int nsrc = (b + 1 < 8) ? e_lo : e_hi; const int nbase = ((b + 1) & 7) * 8;
            float d[8];
#pragma unroll
            for (int k = 0; k < 8; ++k) {
                float uf[16]; unpack16_fp8(uw[k], uf);
                float d0 = 0.f, d1 = 0.f;
#pragma unroll
                for (int i = 0; i < 16; i += 2) { d0 += a[i] * uf[i]; d1 += a[i + 1] * uf[i + 1]; }
                d[k] = d0 + d1;
                __builtin_amdgcn_sched_barrier(0);
            }
            if (b + 1 < 16) {
#pragma unroll
                for (int k = 0; k < 8; ++k) { const int e = __builtin_amdgcn_readlane(nsrc, nbase + k); uw[k] = *(const u32x4*)(U + (size_t)e * D + loff); }
            }
            const float dk = reduce8(d, lane);
            const float gsel = __shfl((b < 8) ? g_lo : g_hi, (b & 7) * 8 + ((lane >> 3) & 7));
            const float w = gsel * gelu_tanh(dk * rstd2);
#pragma unroll
            for (int k = 0; k < 8; ++k) {
                const float wk = __uint_as_float((unsigned)__builtin_amdgcn_readlane((int)__float_as_uint(w), 8 * k));
                float vf[16]; unpack16_fp8(vw[k], vf);
#pragma unroll
                for (int i = 0; i < 16; ++i) acc[i] += wk * vf[i];
                __builtin_amdgcn_sched_barrier(0);
            }
            if (b + 1 < 16) {
#pragma unroll
                for (int k = 0; k < 8; ++k) { const int e = __builtin_amdgcn_readlane(nsrc, nbase + k); vw[k] = *(const u32x4*)(V + (size_t)e * D + loff); }
            }
        }
        float* orow = (float*)((unsigned char*)p.out + (size_t)tok * D * 4) + loff;
        float y[16]; float ss = 0.f;
#pragma unroll
        for (int q = 0; q < 4; ++q) {
            const f32x4 h = *(const f32x4*)(orow + 4 * q);
            y[4 * q] = h.x + acc[4 * q] * (1.0f / V8_SCALE); y[4 * q + 1] = h.y + acc[4 * q + 1] * (1.0f / V8_SCALE);
            y[4 * q + 2] = h.z + acc[4 * q + 2] * (1.0f / V8_SCALE); y[4 * q + 3] = h.w + acc[4 * q + 3] * (1.0f / V8_SCALE);
        }
#pragma unroll
        for (int i = 0; i < 16; ++i) ss += y[i] * y[i];
        const float rstd = 1.0f / sqrtf(wave_sum(ss) * (1.0f / D) + EPS);
#pragma unroll
        for (int q = 0; q < 4; ++q) {
            const f32x4 g = *(const f32x4*)(p.lnf_g + loff + 4 * q);
            *(f32x4*)(orow + 4 * q) = (f32x4){y[4 * q] * rstd * g.x, y[4 * q + 1] * rstd * g.y, y[4 * q + 2] * rstd * g.z, y[4 * q + 3] * rstd * g.w};
        }
    }
}


namespace psel {
#define HD __host__ __device__ __forceinline__
HD unsigned f2ord(float f) { unsigned u = __builtin_bit_cast(unsigned, f); const unsigned m = (unsigned)((int)u >> 31); return u ^ (m | 0x80000000u); }
HD float ord2f(unsigned o) { const unsigned m = (unsigned)((int)o >> 31); return __builtin_bit_cast(float, o ^ (~m | 0x80000000u)); }
HD unsigned umax_(unsigned a, unsigned b) { return a > b ? a : b; }
HD unsigned umin_(unsigned a, unsigned b) { return a < b ? a : b; }
HD void sort16_desc(unsigned (&a)[16]) {
#pragma unroll
    for (int k = 2; k <= 16; k <<= 1)
#pragma unroll
        for (int j = k >> 1; j > 0; j >>= 1)
#pragma unroll
            for (int i = 0; i < 16; ++i) {
                const int l = i ^ j;
                if (l > i) {
                    const bool up = ((i & k) == 0);
                    const unsigned hi = umax_(a[i], a[l]), lo = umin_(a[i], a[l]);
                    a[i] = up ? hi : lo; a[l] = up ? lo : hi;
                }
            }
}
HD void merge16_desc(unsigned (&a)[16], const unsigned (&b)[16]) {
#pragma unroll
    for (int i = 0; i < 16; ++i) a[i] = umax_(a[i], b[15 - i]);
#pragma unroll
    for (int j = 8; j > 0; j >>= 1)
#pragma unroll
        for (int i = 0; i < 16; ++i) {
            const int l = i ^ j;
            if (l > i) { const unsigned hi = umax_(a[i], a[l]), lo = umin_(a[i], a[l]); a[i] = hi; a[l] = lo; }
        }
}
HD void top16_of_64(unsigned (&g0)[16], unsigned (&g1)[16], unsigned (&g2)[16], unsigned (&g3)[16]) {
    sort16_desc(g0); sort16_desc(g1); sort16_desc(g2); sort16_desc(g3);
    merge16_desc(g0, g1); merge16_desc(g2, g3); merge16_desc(g0, g2);
}
struct PairTab { int a[64]; int b[64]; int n; };
constexpr PairTab make_pairs() {
    PairTab t{}; int n = 0;
    for (int a = 0; a < 16; ++a) for (int b = 0; b < 16; ++b) if ((a + 1) * (b + 1) <= 16) { t.a[n] = a; t.b[n] = b; ++n; }
    t.n = n; for (int i = n; i < 64; ++i) { t.a[i] = 0; t.b[i] = 0; }
    return t;
}
#undef HD
typedef float f32x16 __attribute__((ext_vector_type(16)));
#define PLAS __attribute__((address_space(3)))
static constexpr PairTab PT = make_pairs();
__device__ __forceinline__ constexpr int crow_c(int r) { return (r & 3) + 8 * (r >> 2); }
__device__ __forceinline__ void phase_peer_select(const Params& p, unsigned char* lds_generic) {
    const unsigned char* ws = p.ws;
    const int tid = tid_opaque(), lane = tid & 63, wid = __builtin_amdgcn_readfirstlane(tid >> 6), r32 = lane & 31, hi = lane >> 5;
    PLAS int* tab = (PLAS int*)((PLAS unsigned char*)lds_generic) + wid * 2048;
    const int gw = (int)blockIdx.x * (NTHREADS / 64) + wid, ngw = (int)gridDim.x * (NTHREADS / 64);
    const __amdgpu_buffer_rsrc_t rq = __builtin_amdgcn_make_buffer_rsrc((void*)(p.ws + WS_QP), (short)0, (int)((size_t)NTOK * PQ * 2), 0x00020000);
    const __amdgpu_buffer_rsrc_t rk = __builtin_amdgcn_make_buffer_rsrc((void*)(p.ws + WS_PKEYS), (short)0, 16 * 128 * 128 * 2, 0x00020000);
    for (int task = gw; task < (NTOK / 32) * PH; task += ngw) {
        const int tb = task >> 3, h = task & 7, tok = 32 * tb + r32;
        int hi4 = 4 * hi; asm volatile("" : "+v"(hi4));
        unsigned k1[16], k2[16];
#pragma unroll
        for (int c = 0; c < 2; ++c) {
            const int hc = h * 2 + c;
            const unsigned qoff = (unsigned)(r32 * PQ + 8 * hi) * 2u, koff = (unsigned)(r32 * 128 + 8 * hi) * 2u;
            const int qso = (tb * 32 * PQ + hc * 128) * 2, kso = hc * 128 * 128 * 2;
            bf16x8 qf[8];
#pragma unroll
            for (int d0 = 0; d0 < 8; ++d0) qf[d0] = __builtin_bit_cast(bf16x8, __builtin_amdgcn_raw_buffer_load_b128(rq, (int)qoff, qso + 32 * d0, 0));
            unsigned g[4][16];
#pragma unroll
            for (int nt = 0; nt < 4; ++nt) {
                f32x16 acc;
#pragma unroll
                for (int r = 0; r < 16; ++r) acc[r] = 0.f;
#pragma unroll
                for (int d0 = 0; d0 < 8; ++d0) {
                    const bf16x8 kf = __builtin_bit_cast(bf16x8, __builtin_amdgcn_raw_buffer_load_b128(rk, (int)koff, kso + nt * 8192 + 32 * d0, 0));
                    acc = __builtin_amdgcn_mfma_f32_32x32x16_bf16(kf, qf[d0], acc, 0, 0, 0);
                }
#pragma unroll
                for (int r = 0; r < 16; ++r) g[nt][r] = (f2ord(acc[r]) & 0xFFFFFF80u) | (unsigned)((127 - 32 * nt - crow_c(r)) - hi4);
                __builtin_amdgcn_sched_barrier(0);
            }
            top16_of_64(g[0], g[1], g[2], g[3]);
            unsigned pb[16];
#pragma unroll
            for (int i = 0; i < 16; ++i) pb[i] = (unsigned)__shfl_xor((int)g[0][i], 32);
            merge16_desc(g[0], pb);
#pragma unroll
            for (int i = 0; i < 16; ++i) { if (c == 0) k1[i] = g[0][i]; else k2[i] = g[0][i]; }
        }
        float v1[16], v2[16];
#pragma unroll
        for (int i = 0; i < 16; ++i) { v1[i] = ord2f(k1[i] & 0xFFFFFF80u); v2[i] = ord2f(k2[i] & 0xFFFFFF80u); }
        unsigned cg[4][16];
#pragma unroll
        for (int s = 0; s < 64; ++s) {
            unsigned key = 0u;
            if (s < PT.n) key = (f2ord(v1[PT.a[s]] + v2[PT.b[s]]) & 0xFFFFFF00u) | (unsigned)(255 - (PT.a[s] * 16 + PT.b[s]));
            cg[s >> 4][s & 15] = key;
        }
        top16_of_64(cg[0], cg[1], cg[2], cg[3]);
#pragma unroll
        for (int i = 0; i < 16; ++i) { tab[i * 64 + lane] = 127 - (int)(k1[i] & 127u); tab[(16 + i) * 64 + lane] = 127 - (int)(k2[i] & 127u); }
        __builtin_amdgcn_fence(__ATOMIC_RELEASE, "wavefront"); __builtin_amdgcn_wave_barrier();
        int eo[16]; float ge[16]; float gsum = 0.f;
        const float top = ord2f(cg[0][0] & 0xFFFFFF00u);
#pragma unroll
        for (int k = 0; k < 16; ++k) {
            const int ab = 255 - (int)(cg[0][k] & 255u);
            eo[k] = tab[(ab >> 4) * 64 + lane] * PNK + tab[(16 + (ab & 15)) * 64 + lane];
            ge[k] = __expf(ord2f(cg[0][k] & 0xFFFFFF00u) - top); gsum += ge[k];
        }
        __builtin_amdgcn_wave_barrier();
        const float ginv = 1.0f / gsum;
        if (hi == 0) {
            int* eout = (int*)(p.ws + WS_EIDX) + (size_t)tok * 128 + h * 16;
            float* gout = (float*)(p.ws + WS_GATE) + (size_t)tok * 128 + h * 16;
#pragma unroll
            for (int q = 0; q < 4; ++q) {
                *(u32x4*)(eout + 4 * q) = (u32x4){(unsigned)eo[4 * q], (unsigned)eo[4 * q + 1], (unsigned)eo[4 * q + 2], (unsigned)eo[4 * q + 3]};
                *(f32x4*)(gout + 4 * q) = (f32x4){ge[4 * q] * ginv, ge[4 * q + 1] * ginv, ge[4 * q + 2] * ginv, ge[4 * q + 3] * ginv};
            }
        }
    }
}
}

namespace att {
typedef float f32x16 __attribute__((ext_vector_type(16)));
typedef short s16x4 __attribute__((ext_vector_type(4)));
typedef short v4i16_t __attribute__((ext_vector_type(4)));
#define ALAS __attribute__((address_space(3)))
typedef ALAS unsigned char* lptr;
constexpr int L_K = 0, L_V = 16384, L_IMP = 32768, L_SELM = L_IMP + 64 * 129 * 4, L_UNION = L_SELM + 1024, L_WSCR = L_UNION + 16, L_ACC = L_WSCR + 8 * 256, L_END = L_ACC + 8 * 8192;
constexpr float LOG2E = 1.4426950408889634f;
constexpr float THR = 10.0f;
__device__ __forceinline__ constexpr int crow_c(int r) { return (r & 3) + 8 * (r >> 2); }
__device__ __forceinline__ unsigned cvtpk(float lo, float hi) { typedef float f2 __attribute__((ext_vector_type(2))); typedef __bf16 b2 __attribute__((ext_vector_type(2)));
    f2 v = {lo, hi}; b2 b = __builtin_convertvector(v, b2); return __builtin_bit_cast(unsigned, b); }
__device__ __forceinline__ s16x4 vtr(lptr p) { return __builtin_bit_cast(s16x4, __builtin_amdgcn_ds_read_tr16_b64_v4i16((ALAS v4i16_t*)p)); }

struct Stage { u32x4 k, v; };
__device__ __forceinline__ void stage_load(const bf16_t* Kt, const bf16_t* Vt, int wid, int lane, Stage& s, bool withV) {
    s.k = *(const u32x4*)(Kt + (size_t)lane * 64 + wid * 8);
    if (withV) s.v = *(const u32x4*)(Vt + (size_t)(16 * (wid & 3) + (lane >> 2)) * 64 + (wid >> 2) * 32 + (lane & 3) * 8);
}
__device__ __forceinline__ void stage_store(lptr kbuf, lptr vbuf, int wid, int lane, const Stage& s, bool withV) {
    *(ALAS u32x4*)(kbuf + wid * 1024 + lane * 16) = s.k;
    if (withV) *(ALAS u32x4*)(vbuf + wid * 1024 + lane * 16) = s.v;
}
__device__ __forceinline__ void qk_tile(f32x16& p0, f32x16& p1, lptr kbuf, const bf16x8 (&qf)[4], float cb, float sk, int r32, int hi) {
    asm volatile("" : "+v"(sk));
    const float cb2 = cb + sk * (float)(4 * hi);
#pragma unroll
    for (int r = 0; r < 16; ++r) { p0[r] = cb2 + sk * (float)crow_c(r); p1[r] = cb2 + sk * (float)(crow_c(r) + 32); }
    lptr kb = kbuf + hi * 1024 + r32 * 16;
#pragma unroll
    for (int d0 = 0; d0 < 4; ++d0) {
        const bf16x8 k0 = *(const ALAS bf16x8*)(kb + d0 * 2048), k1 = *(const ALAS bf16x8*)(kb + d0 * 2048 + 512);
        p0 = __builtin_amdgcn_mfma_f32_32x32x16_bf16(k0, qf[d0], p0, 0, 0, 0);
        p1 = __builtin_amdgcn_mfma_f32_32x32x16_bf16(k1, qf[d0], p1, 0, 0, 0);
    }
}
__device__ __forceinline__ void mask_tile(f32x16& p0, f32x16& p1, int hi_lim, int lo_lim, int hi) {
    int hl = hi_lim - 4 * hi, ll1 = lo_lim + 1 - 4 * hi;
    asm volatile("" : "+v"(hl), "+v"(ll1));
#pragma unroll
    for (int r = 0; r < 16; ++r) {
        const int c0 = crow_c(r), c1 = crow_c(r) + 32;
        const unsigned t0 = (unsigned)((c0 - ll1) | (hl - c0)), t1 = (unsigned)((c1 - ll1) | (hl - c1));
        p0[r] = fminf(p0[r], __uint_as_float((t0 & 0x80000000u) | 0x7f800000u));
        p1[r] = fminf(p1[r], __uint_as_float((t1 & 0x80000000u) | 0x7f800000u));
    }
}
__device__ __forceinline__ float max3f(float a, float b, float c) { float r; asm("v_max3_f32 %0, %1, %2, %3" : "=v"(r) : "v"(a), "v"(b), "v"(c)); return r; }
__device__ __forceinline__ float max2f(float a, float b) { float r; asm("v_max_f32_e32 %0, %1, %2" : "=v"(r) : "v"(a), "v"(b)); return r; }
__device__ __forceinline__ float tile_max(const f32x16& p0, const f32x16& p1) {
    float a = max3f(p0[0], p0[1], p1[0]), b = max3f(p0[2], p0[3], p1[1]); a = max3f(a, p1[2], p1[3]);
#pragma unroll
    for (int r = 4; r < 16; r += 4) { a = max3f(a, p0[r], p0[r + 1]); b = max3f(b, p0[r + 2], p0[r + 3]); a = max3f(a, p1[r], p1[r + 1]); b = max3f(b, p1[r + 2], p1[r + 3]); }
    const float m = max2f(a, b);
    return max2f(m, __shfl_xor(m, 32));
}
__device__ __forceinline__ float tile_sum(const f32x16& p0, const f32x16& p1) {
    float a = p0[0] + p1[0];
#pragma unroll
    for (int r = 1; r < 16; ++r) a += p0[r] + p1[r];
    return a + __shfl_xor(a, 32);
}
__device__ __forceinline__ void pack_p(u32x4 (&pw)[4], const f32x16& p0, const f32x16& p1) {
    pw[0] = (u32x4){cvtpk(p0[0], p0[1]), cvtpk(p0[2], p0[3]), cvtpk(p0[4], p0[5]), cvtpk(p0[6], p0[7])};
    pw[1] = (u32x4){cvtpk(p0[8], p0[9]), cvtpk(p0[10], p0[11]), cvtpk(p0[12], p0[13]), cvtpk(p0[14], p0[15])};
    pw[2] = (u32x4){cvtpk(p1[0], p1[1]), cvtpk(p1[2], p1[3]), cvtpk(p1[4], p1[5]), cvtpk(p1[6], p1[7])};
    pw[3] = (u32x4){cvtpk(p1[8], p1[9]), cvtpk(p1[10], p1[11]), cvtpk(p1[12], p1[13]), cvtpk(p1[14], p1[15])};
}
__device__ __forceinline__ void pv_packed(f32x16& o0, f32x16& o1, const u32x4 (&pw)[4], lptr vbuf, int lane, int hi) {
    lptr vp = vbuf + ((lane >> 4) & 1) * 32 + (lane & 3) * 8 + (4 * hi + ((lane & 15) >> 2)) * 64;
#pragma unroll
    for (int ks = 0; ks < 4; ++ks) {
        const s16x4 a = vtr(vp + ks * 1024), b = vtr(vp + ks * 1024 + 512);
        const s16x4 c = vtr(vp + 4096 + ks * 1024), d = vtr(vp + 4096 + ks * 1024 + 512);
        const bf16x8 v0 = (bf16x8){a[0], a[1], a[2], a[3], b[0], b[1], b[2], b[3]}, v1 = (bf16x8){c[0], c[1], c[2], c[3], d[0], d[1], d[2], d[3]};
        const bf16x8 pa = __builtin_bit_cast(bf16x8, pw[ks]);
        o0 = __builtin_amdgcn_mfma_f32_32x32x16_bf16(pa, v0, o0, 0, 0, 0);
        o1 = __builtin_amdgcn_mfma_f32_32x32x16_bf16(pa, v1, o1, 0, 0, 0);
    }
}
__device__ __forceinline__ void pv_tile(f32x16& o0, f32x16& o1, const f32x16& p0, const f32x16& p1, lptr vbuf, int lane, int hi) {
    u32x4 pw[4]; pack_p(pw, p0, p1);
    pv_packed(o0, o1, pw, vbuf, lane, hi);
}
__device__ __forceinline__ void ov_frags(bf16x8 (&ovf)[4], int r32, int hi) {
#pragma unroll
    for (int ks = 0; ks < 4; ++ks)
#pragma unroll
        for (int j = 0; j < 8; ++j) {
            const int q4 = 4 * ks + 2 * (j >> 2) + hi;
            const bool on = (r32 == q4) || ((j & 3) == 3 && r32 == q4 + 1);
            ovf[ks][j] = on ? (short)0x3F80 : (short)0;
        }
}
__device__ __forceinline__ void scale_rows(f32x16& o0, f32x16& o1, float f, ALAS float* wscr, int r32, int hi) {
    if (hi == 0) wscr[r32] = f;
    __builtin_amdgcn_fence(__ATOMIC_RELEASE, "wavefront"); __builtin_amdgcn_wave_barrier();
#pragma unroll
    for (int r = 0; r < 16; ++r) { const float a = wscr[crow_c(r) + 4 * hi]; o0[r] *= a; o1[r] *= a; }
    __builtin_amdgcn_wave_barrier();
}
template <bool FIRST>
__device__ __forceinline__ void acc_rows(ALAS float* accw, const f32x16& o0, const f32x16& o1, float f, ALAS float* wscr, int r32, int hi) {
    if (hi == 0) wscr[r32] = f;
    __builtin_amdgcn_fence(__ATOMIC_RELEASE, "wavefront"); __builtin_amdgcn_wave_barrier();
#pragma unroll
    for (int r = 0; r < 16; ++r) {
        const int row = crow_c(r) + 4 * hi; const float a = wscr[row];
        ALAS float* d = accw + row * 64 + r32;
        if (FIRST) { d[0] = o0[r] * a; d[32] = o1[r] * a; } else { d[0] += o0[r] * a; d[32] += o1[r] * a; }
    }
    __builtin_amdgcn_wave_barrier();
}
__device__ __forceinline__ void store_acc(ALAS float* accw, bf16_t* O, int lane) {
    __builtin_amdgcn_fence(__ATOMIC_RELEASE, "wavefront"); __builtin_amdgcn_wave_barrier();
#pragma unroll
    for (int it = 0; it < 4; ++it) {
        const int item = it * 64 + lane, row = item >> 3, ch = item & 7;
        const f32x4 x = *(const ALAS f32x4*)(accw + row * 64 + ch * 8), y = *(const ALAS f32x4*)(accw + row * 64 + ch * 8 + 4);
        u32x4 w; w.x = cvtpk(x[0], x[1]); w.y = cvtpk(x[2], x[3]); w.z = cvtpk(y[0], y[1]); w.w = cvtpk(y[2], y[3]);
        *(u32x4*)(O + (size_t)(row & 7) * D + (row >> 3) * 64 + ch * 8) = w;
    }
    __builtin_amdgcn_wave_barrier();
}
struct Br { float m, l; f32x16 o0, o1; };
template <bool MASK>
__device__ __forceinline__ void attend_tile(Br& s, lptr kbuf, lptr vbuf, const bf16x8 (&qf)[4], float cb, float sk, int hi_lim, int lo_lim, ALAS float* wscr, int lane, int r32, int hi) {
    f32x16 p0, p1;
    const float mu = (s.m < -1e29f) ? 0.f : s.m;
    qk_tile(p0, p1, kbuf, qf, cb - mu, sk, r32, hi);
    if (MASK) mask_tile(p0, p1, hi_lim, lo_lim, hi);
    const float rm = tile_max(p0, p1);
    if (__any(rm + mu > s.m + THR)) {
        const float mn = fmaxf(s.m, rm + mu), alpha = __builtin_amdgcn_exp2f(s.m - mn), delta = mn - mu;
        s.l *= alpha; s.m = mn;
        scale_rows(s.o0, s.o1, alpha, wscr, r32, hi);
#pragma unroll
        for (int r = 0; r < 16; ++r) { p0[r] -= delta; p1[r] -= delta; }
    }
#pragma unroll
    for (int r = 0; r < 16; ++r) { p0[r] = __builtin_amdgcn_exp2f(p0[r]); p1[r] = __builtin_amdgcn_exp2f(p1[r]); }
    s.l += tile_sum(p0, p1);
    pv_tile(s.o0, s.o1, p0, p1, vbuf, lane, hi);
}

#define ATT_BAR() asm volatile("s_waitcnt lgkmcnt(0)\n\ts_barrier" ::: "memory")
template <int PVAR = 0>
__device__ __forceinline__ void nsa_unit(const Params& p, unsigned char* lds_generic, int b, int g, int tile) {
    lptr lds = (lptr)lds_generic;
    const int tid = tid_opaque(), lane = tid & 63, wid = __builtin_amdgcn_readfirstlane(tid >> 6), r32 = lane & 31, hi = lane >> 5;
    const int h = r32 >> 3, qi = r32 & 7, tq = 8 * wid + qi, t = 64 * tile + tq, head = g * 4 + h;
    const float slope = exp2f(-0.5f * (float)(9 + head)) * LOG2E;
    const unsigned char* ws = p.ws;
    ALAS float* imp = (ALAS float*)(lds + L_IMP);
    ALAS unsigned* selm = (ALAS unsigned*)(lds + L_SELM);
    ALAS unsigned* uni = (ALAS unsigned*)(lds + L_UNION);
    ALAS float* wscr = (ALAS float*)(lds + L_WSCR) + wid * 64;
    const bf16_t* KC = (const bf16_t*)(ws + WS_KC) + (size_t)(b * 2 + g) * NCMPP * 64;
    const bf16_t* VC = (const bf16_t*)(ws + WS_VC) + (size_t)(b * 2 + g) * NCMPP * 64;
    const bf16_t* KS = (const bf16_t*)(ws + WS_KV6 + 2 * KV6_STRIDE) + (size_t)(b * 2 + g) * T * 64;
    const bf16_t* VS = (const bf16_t*)(ws + WS_KV6 + 3 * KV6_STRIDE) + (size_t)(b * 2 + g) * T * 64;
    const bf16_t* KW = (const bf16_t*)(ws + WS_KV6 + 4 * KV6_STRIDE) + (size_t)(b * 2 + g) * T * 64;
    const bf16_t* VW = (const bf16_t*)(ws + WS_KV6 + 5 * KV6_STRIDE) + (size_t)(b * 2 + g) * T * 64;
    const float* gs = (const float*)(ws + WS_GSIG) + (size_t)(b * T + t) * 24 + head * 3;
    bf16x8 qf[4];
    {
        const bf16_t* qp = (const bf16_t*)(ws + WS_QN) + ((size_t)(b * 8 + head) * T + t) * 64 + 8 * hi;
#pragma unroll
        for (int d0 = 0; d0 < 4; ++d0) qf[d0] = *(const bf16x8*)(qp + 16 * d0);
    }
    for (int i = tid; i < 64 * 129; i += NTHREADS) imp[i] = 0.f;
    if (tid < 4) uni[tid] = 0u;
    ALAS float* accw = (ALAS float*)(lds + L_ACC) + wid * 2048;
    const int nc = 4 * tile + 3, n = (nc + 63) >> 6, n2 = 2 * n;
    const int nw = (tile < 8) ? tile + 1 : 9, NS = n2 + nw;
#define GK(x) ((x) < n2 ? KC + (size_t)((x) < n ? (x) : (x) - n) * 4096 : ((x) < NS ? KW + (size_t)(tile - ((x) - n2)) * 4096 : KS + (size_t)tile * 4096))
#define GV(x) ((x) < n2 ? VC + (size_t)((x) < n ? (x) : (x) - n) * 4096 : ((x) < NS ? VW + (size_t)(tile - ((x) - n2)) * 4096 : VS + (size_t)tile * 4096))
#define PIPE_HEAD(x) do { if ((x) + 2 <= NS) stage_load(GK((x) + 2), GV((x) + 2), wid, lane, sB, true); } while (0)
#define PIPE_TAIL(x) do { if ((x) + 1 <= NS) stage_store(lds + L_K + (cur ^ 1) * 8192, lds + L_V + (cur ^ 1) * 8192, wid, lane, sA, true); ATT_BAR(); cur ^= 1; sA = sB; } while (0)
    Stage sA, sB; int cur = 0;
    stage_load(GK(0), GV(0), wid, lane, sA, true);
    stage_store(lds + L_K, lds + L_V, wid, lane, sA, true);
    ATT_BAR();
    stage_load(GK(1), GV(1), wid, lane, sA, true);
    const int cmax = (t >= 31) ? ((t - 31) >> 4) : -1;
    const float skc = 16.0f * slope, cbc = -slope * (float)(t - 31);
    float mc = -1e30f, lc = 0.f;
    for (int x = 0; x < n; ++x) {
        PIPE_HEAD(x);
        const int i = x;
        if (!(PVAR & 1)) {
        f32x16 p0, p1;
        qk_tile(p0, p1, lds + L_K + cur * 8192, qf, cbc + skc * (float)(64 * i), skc, r32, hi);
        if (__any(cmax - 64 * i < 63)) mask_tile(p0, p1, cmax - 64 * i, -1, hi);
        const float rm = tile_max(p0, p1), mn = fmaxf(mc, rm);
#pragma unroll
        for (int r = 0; r < 16; ++r) { p0[r] = __builtin_amdgcn_exp2f(p0[r] - mn); p1[r] = __builtin_amdgcn_exp2f(p1[r] - mn); }
        lc = lc * __builtin_amdgcn_exp2f(mc - mn) + tile_sum(p0, p1); mc = mn;
        }
        PIPE_TAIL(x);
    }
    {
        const float nrm = (lc > 0.f) ? (mc + __builtin_amdgcn_logf(lc)) : 0.f;
        Br sc; sc.m = 0.f; sc.l = 0.f;
#pragma unroll
        for (int r = 0; r < 16; ++r) { sc.o0[r] = 0.f; sc.o1[r] = 0.f; }
        bf16x8 ovf[4]; ov_frags(ovf, r32, hi);
        for (int x = n; x < n2; ++x) {
            PIPE_HEAD(x);
            const int i = x - n;
            if (!(PVAR & 2)) {
            f32x16 p0, p1;
            qk_tile(p0, p1, lds + L_K + cur * 8192, qf, cbc + skc * (float)(64 * i) - nrm, skc, r32, hi);
            if (__any(cmax - 64 * i < 63)) mask_tile(p0, p1, cmax - 64 * i, -1, hi);
#pragma unroll
            for (int r = 0; r < 16; ++r) { p0[r] = __builtin_amdgcn_exp2f(p0[r]); p1[r] = __builtin_amdgcn_exp2f(p1[r]); }
            u32x4 pw[4]; pack_p(pw, p0, p1);
            pv_packed(sc.o0, sc.o1, pw, lds + L_V + cur * 8192, lane, hi);
            f32x16 ia;
#pragma unroll
            for (int r = 0; r < 16; ++r) ia[r] = 0.f;
#pragma unroll
            for (int ks = 0; ks < 4; ++ks) ia = __builtin_amdgcn_mfma_f32_32x32x16_bf16(__builtin_bit_cast(bf16x8, pw[ks]), ovf[ks], ia, 0, 0, 0);
            const int sb = 16 * i + r32;
            if (r32 <= 16 && sb < NSEL) {
#pragma unroll
                for (int m = 0; m < 4; ++m) atomicAdd((float*)(imp + (8 * wid + 4 * hi + m) * 129 + sb), (ia[m] + ia[m + 4]) + (ia[m + 8] + ia[m + 12]));
            }
            }
            PIPE_TAIL(x);
        }
        acc_rows<true>(accw, sc.o0, sc.o1, gs[0], wscr, r32, hi);
    }
    {
        Br sw; sw.m = -1e30f; sw.l = 0.f;
#pragma unroll
        for (int r = 0; r < 16; ++r) { sw.o0[r] = 0.f; sw.o1[r] = 0.f; }
        for (int x = n2; x < NS; ++x) {
            PIPE_HEAD(x);
            const int j = tile - (x - n2);
            const float cb = -slope * (float)(t - 64 * j);
            if (PVAR & 4) {} else
            if (j == tile) attend_tile<true>(sw, lds + L_K + cur * 8192, lds + L_V + cur * 8192, qf, cb, slope, tq, -1, wscr, lane, r32, hi);
            else if (j == tile - 8) attend_tile<true>(sw, lds + L_K + cur * 8192, lds + L_V + cur * 8192, qf, cb, slope, 63, tq, wscr, lane, r32, hi);
            else attend_tile<false>(sw, lds + L_K + cur * 8192, lds + L_V + cur * 8192, qf, cb, slope, 63, -1, wscr, lane, r32, hi);
            PIPE_TAIL(x);
        }
        acc_rows<false>(accw, sw.o0, sw.o1, gs[2] / fmaxf(sw.l, 1e-30f), wscr, r32, hi);
    }
#undef GK
#undef GV
#undef PIPE_HEAD
#undef PIPE_TAIL
    if (!(PVAR & 16)) {
        const int q = tid >> 3, sub = tid & 7;
        unsigned kq[16];
#pragma unroll
        for (int i = 0; i < 16; ++i) {
            const int j = sub * 16 + i; float x = imp[q * 129 + j];
            if (j == 0 || j == tile || j == tile - 1) x = 1.0e4f;
            if (j > tile) x = -INFINITY;
            kq[i] = (psel::f2ord(x) & 0xFFFFFF80u) | (unsigned)(127 - j);
        }
        psel::sort16_desc(kq);
#pragma unroll
        for (int off = 1; off < 8; off <<= 1) {
            unsigned pb[16];
#pragma unroll
            for (int i = 0; i < 16; ++i) pb[i] = (unsigned)__shfl_xor((int)kq[i], off);
            psel::merge16_desc(kq, pb);
        }
        if (sub == 0) {
            unsigned w0 = 0u, w1 = 0u, w2 = 0u, w3 = 0u;
            const unsigned ninf = psel::f2ord(-INFINITY) & 0xFFFFFF80u;
#pragma unroll
            for (int i = 0; i < 16; ++i) {
                const int bj = 127 - (int)(kq[i] & 127u); const bool ok = (kq[i] & 0xFFFFFF80u) != ninf;
                const int k = bj >> 5; const unsigned bit = ok ? (1u << (bj & 31)) : 0u;
                w0 |= (k == 0) ? bit : 0u; w1 |= (k == 1) ? bit : 0u; w2 |= (k == 2) ? bit : 0u; w3 |= (k == 3) ? bit : 0u;
            }
            selm[q * 4 + 0] = w0; selm[q * 4 + 1] = w1; selm[q * 4 + 2] = w2; selm[q * 4 + 3] = w3;
            atomicOr((unsigned*)(uni + 0), w0); atomicOr((unsigned*)(uni + 1), w1); atomicOr((unsigned*)(uni + 2), w2); atomicOr((unsigned*)(uni + 3), w3);
        }
    }
    __syncthreads();
    {
        unsigned u0 = uni[0], u1 = uni[1], u2 = uni[2], u3 = uni[3];
        u0 = __builtin_amdgcn_readfirstlane(u0); u1 = __builtin_amdgcn_readfirstlane(u1); u2 = __builtin_amdgcn_readfirstlane(u2); u3 = __builtin_amdgcn_readfirstlane(u3);
        const unsigned s0 = selm[tq * 4 + 0], s1 = selm[tq * 4 + 1], s2 = selm[tq * 4 + 2], s3 = selm[tq * 4 + 3];
        Br sb_; sb_.m = -1e30f; sb_.l = 0.f;
#pragma unroll
        for (int r = 0; r < 16; ++r) { sb_.o0[r] = 0.f; sb_.o1[r] = 0.f; }
#define POP_BLOCK(j) do { if (u3) { const int bb = 31 - __builtin_clz(u3); u3 ^= 1u << bb; j = 96 + bb; } else if (u2) { const int bb = 31 - __builtin_clz(u2); u2 ^= 1u << bb; j = 64 + bb; } \
        else if (u1) { const int bb = 31 - __builtin_clz(u1); u1 ^= 1u << bb; j = 32 + bb; } else if (u0) { const int bb = 31 - __builtin_clz(u0); u0 ^= 1u << bb; j = bb; } else j = -1; } while (0)
        int j, j1, j2; POP_BLOCK(j); POP_BLOCK(j1); POP_BLOCK(j2);
        if (j1 >= 0) stage_load(KS + (size_t)j1 * 4096, VS + (size_t)j1 * 4096, wid, lane, sA, true);
        while (j >= 0) {
            if (j2 >= 0) stage_load(KS + (size_t)j2 * 4096, VS + (size_t)j2 * 4096, wid, lane, sB, true);
            const unsigned wsel = (j >> 5) == 0 ? s0 : (j >> 5) == 1 ? s1 : (j >> 5) == 2 ? s2 : s3;
            const bool mine = (wsel >> (j & 31)) & 1u;
            if (!(PVAR & 8) && __any(mine)) {
                const float cb = mine ? -slope * (float)(t - 64 * j) : -INFINITY;
                if (j == tile) attend_tile<true>(sb_, lds + L_K + cur * 8192, lds + L_V + cur * 8192, qf, cb, slope, tq, -1, wscr, lane, r32, hi);
                else attend_tile<false>(sb_, lds + L_K + cur * 8192, lds + L_V + cur * 8192, qf, cb, slope, 63, -1, wscr, lane, r32, hi);
            }
            if (j1 >= 0) stage_store(lds + L_K + (cur ^ 1) * 8192, lds + L_V + (cur ^ 1) * 8192, wid, lane, sA, true);
            ATT_BAR();
            cur ^= 1; sA = sB; j = j1; j1 = j2; POP_BLOCK(j2);
        }
#undef POP_BLOCK
        acc_rows<false>(accw, sb_.o0, sb_.o1, gs[1] / fmaxf(sb_.l, 1e-30f), wscr, r32, hi);
    }
    store_acc(accw, (bf16_t*)(p.ws + (PVAR ? WS_QP : WS_O)) + (size_t)(b * T + 64 * tile + 8 * wid) * D + g * 256, lane);
}

__device__ __forceinline__ void swa_unit(const Params& p, unsigned char* lds_generic, int b, int hh, int tile) {
    lptr lds = (lptr)lds_generic;
    const int tid = tid_opaque(), lane = tid & 63, wid = __builtin_amdgcn_readfirstlane(tid >> 6), r32 = lane & 31, hi = lane >> 5;
    const int h = r32 >> 3, qi = r32 & 7, tq = 8 * wid + qi, t = 64 * tile + tq, head = hh * 4 + h;
    const float slope = exp2f(-0.5f * (float)(head + 1)) * LOG2E;
    const unsigned char* ws = p.ws;
    ALAS float* wscr = (ALAS float*)(lds + L_WSCR) + wid * 64;
    const bf16_t* K = (const bf16_t*)(ws + WS_KSW) + (size_t)b * T * 64;
    const bf16_t* V = (const bf16_t*)(ws + WS_VSW) + (size_t)b * T * 64;
    bf16x8 qf[4];
    {
        const bf16_t* qp = (const bf16_t*)(ws + WS_QS) + ((size_t)(b * 8 + head) * T + t) * 64 + 8 * hi;
#pragma unroll
        for (int d0 = 0; d0 < 4; ++d0) qf[d0] = *(const bf16x8*)(qp + 16 * d0);
    }
    Br sw; sw.m = p.sinks[head] * LOG2E; sw.l = 1.0f;
#pragma unroll
    for (int r = 0; r < 16; ++r) { sw.o0[r] = 0.f; sw.o1[r] = 0.f; }
    const int jlo = (tile - 2 > 0) ? tile - 2 : 0;
    Stage sA, sB; int cur = 0;
    stage_load(K + (size_t)tile * 4096, V + (size_t)tile * 4096, wid, lane, sA, true);
    stage_store(lds + L_K, lds + L_V, wid, lane, sA, true);
    ATT_BAR();
    if (tile - 1 >= jlo) stage_load(K + (size_t)(tile - 1) * 4096, V + (size_t)(tile - 1) * 4096, wid, lane, sA, true);
    for (int j = tile; j >= jlo; --j) {
        if (j - 2 >= jlo) stage_load(K + (size_t)(j - 2) * 4096, V + (size_t)(j - 2) * 4096, wid, lane, sB, true);
        const float cb = -slope * (float)(t - 64 * j);
        if (j == tile) attend_tile<true>(sw, lds + L_K + cur * 8192, lds + L_V + cur * 8192, qf, cb, slope, tq, -1, wscr, lane, r32, hi);
        else if (j == tile - 2) attend_tile<true>(sw, lds + L_K + cur * 8192, lds + L_V + cur * 8192, qf, cb, slope, 63, tq, wscr, lane, r32, hi);
        else attend_tile<false>(sw, lds + L_K + cur * 8192, lds + L_V + cur * 8192, qf, cb, slope, 63, -1, wscr, lane, r32, hi);
        if (j > jlo) stage_store(lds + L_K + (cur ^ 1) * 8192, lds + L_V + (cur ^ 1) * 8192, wid, lane, sA, true);
        ATT_BAR();
        cur ^= 1; sA = sB;
    }
    ALAS float* accw = (ALAS float*)(lds + L_ACC) + wid * 2048;
    acc_rows<true>(accw, sw.o0, sw.o1, 1.0f / sw.l, wscr, r32, hi);
    store_acc(accw, (bf16_t*)(p.ws + WS_O) + (size_t)(b * T + 64 * tile + 8 * wid) * D + 512 + hh * 256, lane);
}
__device__ __forceinline__ void swa_unit2(const Params& p, unsigned char* lds_generic, int b, int tile) {
    lptr lds = (lptr)lds_generic;
    const int tid = tid_opaque(), lane = tid & 63, wid = __builtin_amdgcn_readfirstlane(tid >> 6), r32 = lane & 31, hi = lane >> 5;
    const int h = r32 >> 3, qi = r32 & 7, tq = 8 * wid + qi, t = 64 * tile + tq;
    const unsigned char* ws = p.ws;
    ALAS float* wscr = (ALAS float*)(lds + L_WSCR) + wid * 64;
    ALAS float* accw = (ALAS float*)(lds + L_ACC) + wid * 2048;
    const bf16_t* K = (const bf16_t*)(ws + WS_KSW) + (size_t)b * T * 64;
    const bf16_t* V = (const bf16_t*)(ws + WS_VSW) + (size_t)b * T * 64;
    const int nt = (tile >= 2) ? 3 : tile + 1;
    Stage st[3];
#pragma unroll
    for (int jj = 0; jj < 3; ++jj) if (jj < nt) stage_load(K + (size_t)(tile - jj) * 4096, V + (size_t)(tile - jj) * 4096, wid, lane, st[jj], true);
#pragma unroll
    for (int jj = 0; jj < 3; ++jj) if (jj < nt) stage_store(lds + jj * 8192, lds + 24576 + jj * 8192, wid, lane, st[jj], true);
    ATT_BAR();
#pragma unroll 1
    for (int hh = 0; hh < 2; ++hh) {
        const int head = hh * 4 + h;
        const float slope = exp2f(-0.5f * (float)(head + 1)) * LOG2E;
        bf16x8 qf[4];
        {
            const bf16_t* qp = (const bf16_t*)(ws + WS_QS) + ((size_t)(b * 8 + head) * T + t) * 64 + 8 * hi;
#pragma unroll
            for (int d0 = 0; d0 < 4; ++d0) qf[d0] = *(const bf16x8*)(qp + 16 * d0);
        }
        Br sw; sw.m = p.sinks[head] * LOG2E; sw.l = 1.0f;
#pragma unroll
        for (int r = 0; r < 16; ++r) { sw.o0[r] = 0.f; sw.o1[r] = 0.f; }
        for (int jj = 0; jj < nt; ++jj) {
            const int j = tile - jj;
            const float cb = -slope * (float)(t - 64 * j);
            if (jj == 0) attend_tile<true>(sw, lds + jj * 8192, lds + 24576 + jj * 8192, qf, cb, slope, tq, -1, wscr, lane, r32, hi);
            else if (jj == 2) attend_tile<true>(sw, lds + jj * 8192, lds + 24576 + jj * 8192, qf, cb, slope, 63, tq, wscr, lane, r32, hi);
            else attend_tile<false>(sw, lds + jj * 8192, lds + 24576 + jj * 8192, qf, cb, slope, 63, -1, wscr, lane, r32, hi);
        }
        acc_rows<true>(accw, sw.o0, sw.o1, 1.0f / sw.l, wscr, r32, hi);
        store_acc(accw, (bf16_t*)(p.ws + WS_O) + (size_t)(b * T + 64 * tile + 8 * wid) * D + 512 + hh * 256, lane);
    }
    ATT_BAR();
}
__device__ __forceinline__ void phase_swa_mfma(const Params& p, unsigned char* lds) {
    for (int u = blockIdx.x; u < BATCH * 2 * (T / 64); u += gridDim.x) swa_unit(p, lds, u >> 8, (u >> 7) & 1, u & 127);
}
template <int PVAR = 0>
__device__ __forceinline__ void phase_nsa_mfma(const Params& p, unsigned char* lds) {
    const int nu = BATCH * NSA_G * (T / 64);
    for (int i = blockIdx.x; i < nu; i += gridDim.x) {
        const int u = (i < (int)gridDim.x) ? (nu - 1 - i) : (i - (int)gridDim.x);
        nsa_unit<PVAR>(p, lds, u >> 8, (u >> 7) & 1, u & 127);
    }
}
}


namespace cmp {
#define CLAS __attribute__((address_space(3)))
constexpr int HS = 264;
__device__ __forceinline__ void compress_unit(const Params& p, unsigned char* lds_generic, int unit) {
    const unsigned char* ws = p.ws;
    const int tid = tid_opaque(), lane = tid & 63, wid = __builtin_amdgcn_readfirstlane(tid >> 6), fr = lane & 15, fq = lane >> 4;
    const int row0 = unit * 32, kv = row0 >> 11, bg = (row0 & 2047) >> 9, c0 = row0 & 511;
    const bf16_t* raw = (const bf16_t*)(ws + WS_KV6 + (size_t)kv * KV6_STRIDE) + (size_t)bg * T * 64;
    const bf16_t* W1T = (const bf16_t*)(ws + WS_W1T) + (size_t)kv * 256 * 2048;
    const bf16_t* W2T = (const bf16_t*)(ws + WS_W2T) + (size_t)kv * 64 * 256;
    const float* b1 = (const float*)(ws + WS_B1) + kv * 256;
    CLAS bf16_t* H = (CLAS bf16_t*)((CLAS unsigned char*)lds_generic);
    const int n0 = wid * 32;
    f32x4 acc[2][2];
#pragma unroll
    for (int i = 0; i < 2; ++i)
#pragma unroll
        for (int j = 0; j < 2; ++j) acc[i][j] = (f32x4){0.f, 0.f, 0.f, 0.f};
    const bf16_t* ap = raw + (size_t)(c0 + fr) * 1024 + fq * 8;
    const bf16_t* bp = W1T + (size_t)(n0 + fr) * 2048 + fq * 8;
    constexpr int PF = 4;
    bf16x8 a[PF][2], b[PF][2];
#pragma unroll
    for (int s = 0; s < PF; ++s)
#pragma unroll
        for (int i = 0; i < 2; ++i) { a[s][i] = *(const bf16x8*)(ap + (size_t)i * 16 * 1024 + 32 * s); b[s][i] = *(const bf16x8*)(bp + (size_t)i * 16 * 2048 + 32 * s); }
    for (int k0 = 0; k0 < 2048; k0 += 32 * PF) {
#pragma unroll
        for (int s = 0; s < PF; ++s) {
#pragma unroll
            for (int i = 0; i < 2; ++i)
#pragma unroll
                for (int j = 0; j < 2; ++j) acc[i][j] = __builtin_amdgcn_mfma_f32_16x16x32_bf16(a[s][i], b[s][j], acc[i][j], 0, 0, 0);
            const int kn = k0 + 32 * (PF + s);
            if (kn < 2048) {
#pragma unroll
                for (int i = 0; i < 2; ++i) { a[s][i] = *(const bf16x8*)(ap + (size_t)i * 16 * 1024 + kn); b[s][i] = *(const bf16x8*)(bp + (size_t)i * 16 * 2048 + kn); }
            }
        }
    }
#pragma unroll
    for (int i = 0; i < 2; ++i)
#pragma unroll
        for (int j = 0; j < 2; ++j) {
            const int n = n0 + 16 * j + fr; const float bias = b1[n];
#pragma unroll
            for (int r = 0; r < 4; ++r) H[(16 * i + 4 * fq + r) * HS + n] = (bf16_t)f2bf(gelu_tanh(acc[i][j][r] + bias));
        }
    __syncthreads();
    {
        const int mi = wid >> 2, nj = wid & 3;
        f32x4 o = (f32x4){0.f, 0.f, 0.f, 0.f};
        const CLAS bf16_t* hp = H + (16 * mi + fr) * HS + fq * 8;
        const bf16_t* wp = W2T + (size_t)(16 * nj + fr) * 256 + fq * 8;
#pragma unroll
        for (int k0 = 0; k0 < 256; k0 += 32) {
            const bf16x8 ha = *(const CLAS bf16x8*)(hp + k0), wb = *(const bf16x8*)(wp + k0);
            o = __builtin_amdgcn_mfma_f32_16x16x32_bf16(ha, wb, o, 0, 0, 0);
        }
        bf16_t* dst = (bf16_t*)(p.ws + (kv ? WS_VC : WS_KC)) + ((size_t)bg * NCMPP + c0 + 16 * mi + 4 * fq) * 64 + 16 * nj + fr;
#pragma unroll
        for (int r = 0; r < 4; ++r) dst[(size_t)r * 64] = (bf16_t)f2bf(o[r]);
    }
    __syncthreads();
}
__device__ __forceinline__ void phase_compress_swa(const Params& p, unsigned char* lds) {
    const int G = (int)gridDim.x, bx = (int)blockIdx.x;
    if (G >= 256) {
        if (bx < 128) { compress_unit(p, lds, bx); }
        else { for (int u = bx - 128; u < BATCH * (T / 64); u += G - 128) att::swa_unit2(p, lds, u >> 7, u & 127);
               convert_expert_tables(p, bx - 128, G - 128); }
    } else {
        for (int u = bx; u < 128; u += G) compress_unit(p, lds, u);
        for (int u = bx; u < BATCH * (T / 64); u += G) att::swa_unit2(p, lds, u >> 7, u & 127);
        convert_expert_tables(p, bx, G);
    }
}
}

#define XB_TMO      128
#define XB_XCNT(j)  (256  + 64 * (j))
#define XB_XSUB(j)  (1280 + 64 * (j))
#define XB_XGEN(j)  (2304 + 64 * (j))
#define XB_TOP      3328
#define XB_TOPGEN   3392
#define XCD_BAR_WORDS 3456
#define XB_SPIN_CAP (1u << 18)
#define XLAS __attribute__((address_space(3)))

__device__ __forceinline__ unsigned xb_ld(unsigned* p)              { return __hip_atomic_load(p, __ATOMIC_RELAXED, __HIP_MEMORY_SCOPE_AGENT); }
__device__ __forceinline__ unsigned xb_add(unsigned* p, unsigned v) { return __hip_atomic_fetch_add(p, v, __ATOMIC_RELAXED, __HIP_MEMORY_SCOPE_AGENT); }
__device__ __forceinline__ unsigned xb_xcc_id() { return (unsigned)__builtin_amdgcn_s_getreg((3 << 11) | 20) & 0xFu; }
#define XB_SPIN(cond, bar) do { unsigned _sp = 0; while (cond) { __builtin_amdgcn_s_sleep(1); \
    if ((++_sp & 255u) == 0u) { if (xb_ld(&(bar)[XB_TMO])) break; if (_sp > XB_SPIN_CAP) { atomicAdd(&(bar)[XB_TMO], 1u); break; } } } } while (0)

struct XcdBarrier {
    unsigned* bar; unsigned x;
    volatile XLAS unsigned* st;
};

__device__ __forceinline__ XcdBarrier xcd_barrier_post(unsigned* bar, volatile XLAS unsigned* st) {
    XcdBarrier b; b.bar = bar; b.x = xb_xcc_id(); b.st = st;
    if (threadIdx.x == 0) (void)xb_add(&bar[XB_XCNT(b.x)], 1u);
    return b;
}
__device__ __forceinline__ void xcd_barrier_complete(unsigned* bar, unsigned x, unsigned& nloc, unsigned& nx) {
    const unsigned G = gridDim.x * gridDim.y * gridDim.z;
    unsigned sum, cnt, mine, sp = 0u;
    for (;;) {
        sum = 0u; cnt = 0u; mine = 0u;
#pragma unroll
        for (unsigned j = 0; j < 16; ++j) { const unsigned c = xb_ld(&bar[XB_XCNT(j)]); sum += c; cnt += (c > 0u) ? 1u : 0u; mine = (j == x) ? c : mine; }
        if (sum == G) break;
        __builtin_amdgcn_s_sleep(1);
        if ((++sp & 255u) == 0u) { if (xb_ld(&bar[XB_TMO])) break; if (sp > XB_SPIN_CAP) { atomicAdd(&bar[XB_TMO], 1u); break; } }
    }
    nloc = mine > 0u ? mine : 1u; nx = cnt > 0u ? cnt : 1u;
}

__device__ __forceinline__ void xcd_barrier(const XcdBarrier& b) {
    asm volatile("s_waitcnt vmcnt(0)" ::: "memory");
    __syncthreads();
    if (threadIdx.x == 0) {
        unsigned* bar = b.bar;
        __builtin_amdgcn_s_waitcnt(0);
        unsigned nloc = b.st[0], nx = b.st[1];
        if (nloc == 0u) { xcd_barrier_complete(bar, b.x, nloc, nx); b.st[0] = nloc; b.st[1] = nx; }
        const unsigned old = xb_add(&bar[XB_XSUB(b.x)], 1u);
        const unsigned gen = old / nloc;
        if (old + 1u == (gen + 1u) * nloc) {
            __builtin_amdgcn_fence(__ATOMIC_RELEASE, "agent");
            asm volatile("s_waitcnt vmcnt(0)" ::: "memory");
            const unsigned og = xb_add(&bar[XB_TOP], 1u);
            const unsigned tg = og / nx;
            if (og + 1u == (tg + 1u) * nx) xb_add(&bar[XB_TOPGEN], 1u);
            else XB_SPIN(xb_ld(&bar[XB_TOPGEN]) == tg, bar);
            __builtin_amdgcn_fence(__ATOMIC_ACQUIRE, "agent");
            xb_add(&bar[XB_XGEN(b.x)], 1u);
            asm volatile("s_waitcnt vmcnt(0)" ::: "memory");
        } else {
            XB_SPIN(xb_ld(&bar[XB_XGEN(b.x)]) == gen, bar);
            __builtin_amdgcn_fence(__ATOMIC_ACQUIRE, "agent");
            asm volatile("s_waitcnt vmcnt(0)" ::: "memory");
        }
    }
    __syncthreads();
}


namespace pex {
constexpr int TOK_PER_TICKET = 8, NTICKET = NTOK / TOK_PER_TICKET;
__device__ __forceinline__ int claim(unsigned* ctr, int lane) {
    unsigned t = 0u;
    if (lane == 0) t = __hip_atomic_fetch_add(ctr, 1u, __ATOMIC_RELAXED, __HIP_MEMORY_SCOPE_AGENT);
    return __builtin_amdgcn_readfirstlane((int)t);
}
struct UMeta { int e_lo, e_hi; float g_lo, g_hi; u32x4 h0, h1; float ss; };
__device__ __forceinline__ void u_meta(const unsigned char* ws, int tok, int lane, unsigned loff, UMeta& m) {
    const int* ep = (const int*)(ws + WS_EIDX) + (size_t)tok * 128;
    m.e_lo = ep[lane]; m.e_hi = ep[64 + lane];
    const float* gp = (const float*)(ws + WS_GATE) + (size_t)tok * 128;
    m.g_lo = gp[lane]; m.g_hi = gp[64 + lane];
    const bf16_t* hg = (const bf16_t*)(ws + WS_H1G + (size_t)tok * D * 2) + loff;
    m.h0 = *(const u32x4*)hg; m.h1 = *(const u32x4*)(hg + 8);
    m.ss = ((const float*)(ws + WS_SS2))[tok];
}
constexpr int UB = 16;
__device__ __forceinline__ void u_task(const unsigned char* ws, int tok, int y, int lane, unsigned loff, const UMeta& m, int tok_next, UMeta& mn) {
    unsigned long long m0 = __ballot((m.e_lo >> 11) == y), m1 = __ballot((m.e_hi >> 11) == y);
    const unsigned char* U = ws + WS_U8;
    const int grp = (lane >> 3) & 7;
    bool first = true;
    f32x2 a2[8]; float rstd2 = 0.f;
    do {
        int slot[UB]; u32x4 uw[UB];
#pragma unroll
        for (int k = 0; k < UB; ++k) {
            int e = 0; slot[k] = -1;
            if (m0 != 0ull) { const int j = __builtin_ctzll(m0); m0 &= m0 - 1ull; slot[k] = j; e = __builtin_amdgcn_readlane(m.e_lo, j); }
            else if (m1 != 0ull) { const int j = __builtin_ctzll(m1); m1 &= m1 - 1ull; slot[k] = 64 + j; e = __builtin_amdgcn_readlane(m.e_hi, j); }
            if (slot[k] >= 0) uw[k] = *(const u32x4*)(U + (size_t)e * D + loff); else uw[k] = (u32x4){0u, 0u, 0u, 0u};
        }
        if (first) {
            if (tok_next >= 0) u_meta(ws, tok_next, lane, loff, mn);
            const u32x4 w0 = m.h0, w1 = m.h1;
            a2[0] = (f32x2){bflo(w0.x), bfhi(w0.x)}; a2[1] = (f32x2){bflo(w0.y), bfhi(w0.y)}; a2[2] = (f32x2){bflo(w0.z), bfhi(w0.z)}; a2[3] = (f32x2){bflo(w0.w), bfhi(w0.w)};
            a2[4] = (f32x2){bflo(w1.x), bfhi(w1.x)}; a2[5] = (f32x2){bflo(w1.y), bfhi(w1.y)}; a2[6] = (f32x2){bflo(w1.z), bfhi(w1.z)}; a2[7] = (f32x2){bflo(w1.w), bfhi(w1.w)};
            rstd2 = (1.0f / U8_SCALE) / sqrtf(m.ss * (1.0f / D) + EPS);
            first = false;
        }
#pragma unroll
        for (int hb = 0; hb < UB / 8; ++hb) {
            if (slot[8 * hb] < 0) break;
            float d[8];
#pragma unroll
            for (int k = 0; k < 8; ++k) {
                f32x2 dd = (f32x2){0.f, 0.f};
#pragma unroll
                for (int q = 0; q < 4; ++q) {
                    const f32x2 lo = __builtin_amdgcn_cvt_pk_f32_fp8((int)uw[8 * hb + k][q], false), hi = __builtin_amdgcn_cvt_pk_f32_fp8((int)uw[8 * hb + k][q], true);
                    dd += a2[2 * q] * lo; dd += a2[2 * q + 1] * hi;
                }
                d[k] = dd.x + dd.y;
                __builtin_amdgcn_sched_barrier(0);
            }
            const float dk = reduce8(d, lane);
            int myslot = -1;
#pragma unroll
            for (int k = 0; k < 8; ++k) myslot = (grp == k) ? slot[8 * hb + k] : myslot;
            const float gA = __shfl(m.g_lo, myslot & 63), gB = __shfl(m.g_hi, myslot & 63);
            const float g = (myslot & 64) ? gB : gA;
            if (myslot >= 0 && (lane & 7) == 0) ((float*)(ws + WS_PW))[(size_t)tok * 128 + myslot] = g * gelu_tanh(dk * rstd2);
        }
    } while ((m0 | m1) != 0ull);
}
struct VMeta { u32x4 e[4]; };
__device__ __forceinline__ void v_meta(const Params& p, int tok, int y, int lane, VMeta& m) {
    const unsigned char* ep = p.ws + WS_EIDX + (size_t)tok * 512;
    const unsigned eoff = (unsigned)(lane >> 3) * 64u;
#pragma unroll
    for (int q = 0; q < 4; ++q) m.e[q] = *(const u32x4*)(ep + eoff + 16 * q);
}
__device__ __forceinline__ void ucol_task(const Params& p, int tok, int y, int lane, const VMeta& m, int tok_next, VMeta& mn) {
    const int cc = lane & 7;
    const bool b2 = lane & 4, b1 = lane & 2, b0 = lane & 1;
    const __amdgpu_buffer_rsrc_t ru = __builtin_amdgcn_make_buffer_rsrc((void*)(p.ws + WS_U8 + (size_t)y * ((size_t)NEXP * 128)), (short)0, NEXP * 128, 0x00020000);
    const unsigned coff = (unsigned)cc * 16u;
    u32x4 uw[16];
#pragma unroll
    for (int q = 0; q < 4; ++q) {
        uw[4 * q] = __builtin_bit_cast(u32x4, __builtin_amdgcn_raw_buffer_load_b128(ru, (int)(m.e[q].x * 128u + coff), 0, 0));
        uw[4 * q + 1] = __builtin_bit_cast(u32x4, __builtin_amdgcn_raw_buffer_load_b128(ru, (int)(m.e[q].y * 128u + coff), 0, 0));
        uw[4 * q + 2] = __builtin_bit_cast(u32x4, __builtin_amdgcn_raw_buffer_load_b128(ru, (int)(m.e[q].z * 128u + coff), 0, 0));
        uw[4 * q + 3] = __builtin_bit_cast(u32x4, __builtin_amdgcn_raw_buffer_load_b128(ru, (int)(m.e[q].w * 128u + coff), 0, 0));
    }
    f32x2 a2[8];
    {
        const unsigned char* hp = p.ws + WS_H1G + (size_t)tok * D * 2 + (size_t)y * 256;
        const u32x4 w0 = *(const u32x4*)(hp + cc * 32u), w1 = *(const u32x4*)(hp + cc * 32u + 16u);
        a2[0] = (f32x2){bflo(w0.x), bfhi(w0.x)}; a2[1] = (f32x2){bflo(w0.y), bfhi(w0.y)}; a2[2] = (f32x2){bflo(w0.z), bfhi(w0.z)}; a2[3] = (f32x2){bflo(w0.w), bfhi(w0.w)};
        a2[4] = (f32x2){bflo(w1.x), bfhi(w1.x)}; a2[5] = (f32x2){bflo(w1.y), bfhi(w1.y)}; a2[6] = (f32x2){bflo(w1.z), bfhi(w1.z)}; a2[7] = (f32x2){bflo(w1.w), bfhi(w1.w)};
    }
    if (tok_next >= 0) v_meta(p, tok_next, y, lane, mn);
    float d[16];
#pragma unroll
    for (int i = 0; i < 16; ++i) {
        f32x2 dd = (f32x2){0.f, 0.f};
#pragma unroll
        for (int q = 0; q < 4; ++q) {
            const f32x2 lo = __builtin_amdgcn_cvt_pk_f32_fp8((int)uw[i][q], false), hi = __builtin_amdgcn_cvt_pk_f32_fp8((int)uw[i][q], true);
            dd += a2[2 * q] * lo; dd += a2[2 * q + 1] * hi;
        }
        d[i] = dd.x + dd.y;
        __builtin_amdgcn_sched_barrier(0);
    }
    float s8[8], s4[4], s2[2];
#pragma unroll
    for (int i = 0; i < 8; ++i) { const float snd = b2 ? d[i] : d[i + 8], keep = b2 ? d[i + 8] : d[i]; s8[i] = keep + __shfl_xor(snd, 4); }
#pragma unroll
    for (int i = 0; i < 4; ++i) { const float snd = b1 ? s8[i] : s8[i + 4], keep = b1 ? s8[i + 4] : s8[i]; s4[i] = keep + __shfl_xor(snd, 2); }
#pragma unroll
    for (int i = 0; i < 2; ++i) { const float snd = b0 ? s4[i] : s4[i + 2], keep = b0 ? s4[i + 2] : s4[i]; s2[i] = keep + __shfl_xor(snd, 1); }
    const unsigned so = (unsigned)(16 * (lane >> 3) + (b2 ? 8 : 0) + (b1 ? 4 : 0) + (b0 ? 2 : 0)) * 2u;
    *(unsigned*)(p.ws + WS_PART + ((size_t)tok * 8 + y) * 256 + so) = pk2(s2[0], s2[1]);
}
__device__ __forceinline__ void phase_expert_act(const Params& p) {
    const int tid_ = tid_opaque(), lane = tid_ & 63;
    const int gw = (int)blockIdx.x * (NTHREADS / 64) + __builtin_amdgcn_readfirstlane(tid_ >> 6), ngw = (int)gridDim.x * (NTHREADS / 64);
    for (int tok = gw; tok < NTOK; tok += ngw) {
        const bf16_t* pp = (const bf16_t*)(p.ws + WS_PART) + (size_t)tok * 1024;
        float sa = 0.f, sb = 0.f;
#pragma unroll
        for (int y = 0; y < (U_FP4 ? NSL4 : 8); ++y) { sa += bf2f(pp[y * 128 + lane]); sb += bf2f(pp[y * 128 + 64 + lane]); }
        const float rstd2 = ((U_FP4 && U_INT4) ? 256.0f / (UI_SCALE * HQ_SCALE) : 1.0f / (U_FP4 ? U4_SCALE : U8_SCALE)) / sqrtf(((const float*)(p.ws + WS_SS2))[tok] * (1.0f / D) + EPS);
        const float* gp = (const float*)(p.ws + WS_GATE) + (size_t)tok * 128;
        float* wp = (float*)(p.ws + WS_PW) + (size_t)tok * 128;
        wp[lane] = gp[lane] * gelu_tanh(sa * rstd2);
        wp[64 + lane] = gp[64 + lane] * gelu_tanh(sb * rstd2);
    }
}
__device__ __forceinline__ void v_task(const Params& p, int tok, int y, int lane, const VMeta& m, int tok_next, VMeta& mn) {
    const int cc = lane & 7;
    const bool b5 = lane & 32, b4 = lane & 16, b3 = lane & 8;
    const __amdgpu_buffer_rsrc_t rv = __builtin_amdgcn_make_buffer_rsrc((void*)(p.ws + WS_V8 + (size_t)y * ((size_t)NEXP * 128)), (short)0, NEXP * 128, 0x00020000);
    const unsigned coff = (unsigned)cc * 16u;
    u32x4 vw[16];
#pragma unroll
    for (int q = 0; q < 4; ++q) {
        vw[4 * q] = __builtin_bit_cast(u32x4, __builtin_amdgcn_raw_buffer_load_b128(rv, (int)(m.e[q].x * 128u + coff), 0, 0));
        vw[4 * q + 1] = __builtin_bit_cast(u32x4, __builtin_amdgcn_raw_buffer_load_b128(rv, (int)(m.e[q].y * 128u + coff), 0, 0));
        vw[4 * q + 2] = __builtin_bit_cast(u32x4, __builtin_amdgcn_raw_buffer_load_b128(rv, (int)(m.e[q].z * 128u + coff), 0, 0));
        vw[4 * q + 3] = __builtin_bit_cast(u32x4, __builtin_amdgcn_raw_buffer_load_b128(rv, (int)(m.e[q].w * 128u + coff), 0, 0));
    }
    f32x4 w[4];
    {
        const unsigned char* wp = p.ws + WS_PW + (size_t)tok * 512;
        const unsigned woff = (unsigned)(lane >> 3) * 64u;
#pragma unroll
        for (int q = 0; q < 4; ++q) w[q] = *(const f32x4*)(wp + woff + 16 * q);
    }
    const unsigned colb = (unsigned)(128 * y + 16 * cc + (b5 ? 8 : 0) + (b4 ? 4 : 0) + (b3 ? 2 : 0)) * 4u;
    const unsigned hb = *(const unsigned*)(p.ws + WS_H1G + (size_t)tok * D * 2 + (colb >> 1));
    const f32x2 g2v = *(const f32x2*)((const unsigned char*)p.ln2_g + colb);
    const f32x2 h = (f32x2){bflo(hb) / g2v.x, bfhi(hb) / g2v.y};
    if (tok_next >= 0) v_meta(p, tok_next, y, lane, mn);
    f32x2 acc2[8];
#pragma unroll
    for (int q = 0; q < 8; ++q) acc2[q] = (f32x2){0.f, 0.f};
#pragma unroll
    for (int i = 0; i < 16; ++i) {
        const float wi = w[i >> 2][i & 3];
#pragma unroll
        for (int q = 0; q < 4; ++q) {
            const f32x2 lo = __builtin_amdgcn_cvt_pk_f32_fp8((int)vw[i][q], false), hi = __builtin_amdgcn_cvt_pk_f32_fp8((int)vw[i][q], true);
            acc2[2 * q] += lo * wi; acc2[2 * q + 1] += hi * wi;
        }
        __builtin_amdgcn_sched_barrier(0);
    }
    float acc[16];
#pragma unroll
    for (int q = 0; q < 8; ++q) { acc[2 * q] = acc2[q].x; acc[2 * q + 1] = acc2[q].y; }
    float s8[8], s4[4], s2[2];
#pragma unroll
    for (int i = 0; i < 8; ++i) { const float snd = b5 ? acc[i] : acc[i + 8], keep = b5 ? acc[i + 8] : acc[i]; s8[i] = keep + __shfl_xor(snd, 32); }
#pragma unroll
    for (int i = 0; i < 4; ++i) { const float snd = b4 ? s8[i] : s8[i + 4], keep = b4 ? s8[i + 4] : s8[i]; s4[i] = keep + __shfl_xor(snd, 16); }
#pragma unroll
    for (int i = 0; i < 2; ++i) { const float snd = b3 ? s4[i] : s4[i + 2], keep = b3 ? s4[i + 2] : s4[i]; s2[i] = keep + __shfl_xor(snd, 8); }
    *(unsigned*)(p.ws + WS_H2 + (size_t)tok * D * 2 + (colb >> 1)) = pk2(h.x + s2[0] * (1.0f / V8_SCALE), h.y + s2[1] * (1.0f / V8_SCALE));
}

__device__ __forceinline__ void unpack32_fp4(const u32x4& w, f32x2 (&f)[16]) {
#pragma unroll
    for (int q = 0; q < 4; ++q) {
        f[4 * q + 0] = __builtin_amdgcn_cvt_scalef32_pk_f32_fp4(w[q], 1.0f, 0);
        f[4 * q + 1] = __builtin_amdgcn_cvt_scalef32_pk_f32_fp4(w[q], 1.0f, 1);
        f[4 * q + 2] = __builtin_amdgcn_cvt_scalef32_pk_f32_fp4(w[q], 1.0f, 2);
        f[4 * q + 3] = __builtin_amdgcn_cvt_scalef32_pk_f32_fp4(w[q], 1.0f, 3);
    }
}
__device__ __forceinline__ void ucol4_task(const Params& p, int tok, int z, int lane, const VMeta& m, int tok_next, VMeta& mn) {
    const int cc = lane & 7;
    const bool b2 = lane & 4, b1 = lane & 2, b0 = lane & 1;
    const __amdgpu_buffer_rsrc_t ru = __builtin_amdgcn_make_buffer_rsrc((void*)(p.ws + WS_U8 + (size_t)z * ((size_t)NEXP * 128)), (short)0, NEXP * 128, 0x00020000);
    const unsigned coff = (unsigned)cc * 16u;
    u32x4 uw[16];
#pragma unroll
    for (int q = 0; q < 4; ++q) {
        uw[4 * q] = __builtin_bit_cast(u32x4, __builtin_amdgcn_raw_buffer_load_b128(ru, (int)(m.e[q].x * 128u + coff), 0, 0));
        uw[4 * q + 1] = __builtin_bit_cast(u32x4, __builtin_amdgcn_raw_buffer_load_b128(ru, (int)(m.e[q].y * 128u + coff), 0, 0));
        uw[4 * q + 2] = __builtin_bit_cast(u32x4, __builtin_amdgcn_raw_buffer_load_b128(ru, (int)(m.e[q].z * 128u + coff), 0, 0));
        uw[4 * q + 3] = __builtin_bit_cast(u32x4, __builtin_amdgcn_raw_buffer_load_b128(ru, (int)(m.e[q].w * 128u + coff), 0, 0));
    }
    f32x2 a2[16];
    {
        const unsigned char* hp = p.ws + WS_H1G + (size_t)tok * D * 2 + (size_t)z * 512 + cc * 64u;
#pragma unroll
        for (int q = 0; q < 4; ++q) {
            const u32x4 w = *(const u32x4*)(hp + 16 * q);
            a2[4 * q] = (f32x2){bflo(w.x), bfhi(w.x)}; a2[4 * q + 1] = (f32x2){bflo(w.y), bfhi(w.y)}; a2[4 * q + 2] = (f32x2){bflo(w.z), bfhi(w.z)}; a2[4 * q + 3] = (f32x2){bflo(w.w), bfhi(w.w)};
        }
    }
    if (tok_next >= 0) v_meta(p, tok_next, z, lane, mn);
    float d[16];
#pragma unroll
    for (int i = 0; i < 16; ++i) {
        f32x2 uf[16]; unpack32_fp4(uw[i], uf);
        f32x2 dd = (f32x2){0.f, 0.f};
#pragma unroll
        for (int q = 0; q < 16; ++q) dd += a2[q] * uf[q];
        d[i] = dd.x + dd.y;
        __builtin_amdgcn_sched_barrier(0);
    }
    float s8[8], s4[4], s2[2];
#pragma unroll
    for (int i = 0; i < 8; ++i) { const float snd = b2 ? d[i] : d[i + 8], keep = b2 ? d[i + 8] : d[i]; s8[i] = keep + __shfl_xor(snd, 4); }
#pragma unroll
    for (int i = 0; i < 4; ++i) { const float snd = b1 ? s8[i] : s8[i + 4], keep = b1 ? s8[i + 4] : s8[i]; s4[i] = keep + __shfl_xor(snd, 2); }
#pragma unroll
    for (int i = 0; i < 2; ++i) { const float snd = b0 ? s4[i] : s4[i + 2], keep = b0 ? s4[i + 2] : s4[i]; s2[i] = keep + __shfl_xor(snd, 1); }
    const unsigned so = (unsigned)(16 * (lane >> 3) + (b2 ? 8 : 0) + (b1 ? 4 : 0) + (b0 ? 2 : 0)) * 2u;
    *(unsigned*)(p.ws + WS_PART + ((size_t)tok * 8 + z) * 256 + so) = pk2(s2[0], s2[1]);
}
__device__ __forceinline__ void v4_task(const Params& p, int tok, int z, int lane, const VMeta& m, int tok_next, VMeta& mn) {
    const int cc = lane & 7;
    const bool b5 = lane & 32, b4 = lane & 16, b3 = lane & 8;
    const __amdgpu_buffer_rsrc_t rv = __builtin_amdgcn_make_buffer_rsrc((void*)(p.ws + WS_V8 + (size_t)z * ((size_t)NEXP * 128)), (short)0, NEXP * 128, 0x00020000);
    const unsigned coff = (unsigned)cc * 16u;
    u32x4 vw[16];
#pragma unroll
    for (int q = 0; q < 4; ++q) {
        vw[4 * q] = __builtin_bit_cast(u32x4, __builtin_amdgcn_raw_buffer_load_b128(rv, (int)(m.e[q].x * 128u + coff), 0, 0));
        vw[4 * q + 1] = __builtin_bit_cast(u32x4, __builtin_amdgcn_raw_buffer_load_b128(rv, (int)(m.e[q].y * 128u + coff), 0, 0));
        vw[4 * q + 2] = __builtin_bit_cast(u32x4, __builtin_amdgcn_raw_buffer_load_b128(rv, (int)(m.e[q].z * 128u + coff), 0, 0));
        vw[4 * q + 3] = __builtin_bit_cast(u32x4, __builtin_amdgcn_raw_buffer_load_b128(rv, (int)(m.e[q].w * 128u + coff), 0, 0));
    }
    f32x4 w[4];
    {
        const unsigned char* wp = p.ws + WS_PW + (size_t)tok * 512;
        const unsigned woff = (unsigned)(lane >> 3) * 64u;
#pragma unroll
        for (int q = 0; q < 4; ++q) w[q] = *(const f32x4*)(wp + woff + 16 * q);
    }
    const unsigned col = (unsigned)(256 * z + 32 * cc + (b5 ? 16 : 0) + (b4 ? 8 : 0) + (b3 ? 4 : 0));
    const u32x2 hb = *(const u32x2*)(p.ws + WS_H1G + (size_t)tok * D * 2 + col * 2u);
    const f32x4 g2v = *(const f32x4*)(p.ln2_g + col);
    if (tok_next >= 0) v_meta(p, tok_next, z, lane, mn);
    f32x2 acc2[16];
#pragma unroll
    for (int q = 0; q < 16; ++q) acc2[q] = (f32x2){0.f, 0.f};
#pragma unroll
    for (int i = 0; i < 16; ++i) {
        const float wi = w[i >> 2][i & 3];
        f32x2 vf[16]; unpack32_fp4(vw[i], vf);
#pragma unroll
        for (int q = 0; q < 16; ++q) acc2[q] += vf[q] * wi;
        __builtin_amdgcn_sched_barrier(0);
    }
    float acc[32];
#pragma unroll
    for (int q = 0; q < 16; ++q) { acc[2 * q] = acc2[q].x; acc[2 * q + 1] = acc2[q].y; }
    float s16[16], s8[8], s4[4];
#pragma unroll
    for (int i = 0; i < 16; ++i) { const float snd = b5 ? acc[i] : acc[i + 16], keep = b5 ? acc[i + 16] : acc[i]; s16[i] = keep + __shfl_xor(snd, 32); }
#pragma unroll
    for (int i = 0; i < 8; ++i) { const float snd = b4 ? s16[i] : s16[i + 8], keep = b4 ? s16[i + 8] : s16[i]; s8[i] = keep + __shfl_xor(snd, 16); }
#pragma unroll
    for (int i = 0; i < 4; ++i) { const float snd = b3 ? s8[i] : s8[i + 4], keep = b3 ? s8[i + 4] : s8[i]; s4[i] = keep + __shfl_xor(snd, 8); }
    const float h0 = bflo(hb.x) / g2v.x + s4[0] * (1.0f / V4_SCALE), h1 = bfhi(hb.x) / g2v.y + s4[1] * (1.0f / V4_SCALE);
    const float h2 = bflo(hb.y) / g2v.z + s4[2] * (1.0f / V4_SCALE), h3 = bfhi(hb.y) / g2v.w + s4[3] * (1.0f / V4_SCALE);
    *(u32x2*)(p.ws + WS_H2 + (size_t)tok * D * 2 + col * 2u) = (u32x2){pk2(h0, h1), pk2(h2, h3)};
}

__device__ __forceinline__ void quantize_h(const Params& p) {
    const int tid_ = tid_opaque(), lane = tid_ & 63;
    const int gw = (int)blockIdx.x * (NTHREADS / 64) + __builtin_amdgcn_readfirstlane(tid_ >> 6), ngw = (int)gridDim.x * (NTHREADS / 64);
    for (int tok = gw; tok < NTOK; tok += ngw) {
        const bf16_t* hrow = (const bf16_t*)(p.ws + WS_H1G + (size_t)tok * D * 2) + 16 * lane;
        const u32x4 w0 = *(const u32x4*)hrow, w1 = *(const u32x4*)(hrow + 8);
        const float f[16] = {bflo(w0.x), bfhi(w0.x), bflo(w0.y), bfhi(w0.y), bflo(w0.z), bfhi(w0.z), bflo(w0.w), bfhi(w0.w),
                             bflo(w1.x), bfhi(w1.x), bflo(w1.y), bfhi(w1.y), bflo(w1.z), bfhi(w1.z), bflo(w1.w), bfhi(w1.w)};
        unsigned pa[2] = {0u, 0u}, pb[2] = {0u, 0u};
#pragma unroll
        for (int i = 0; i < 16; ++i) {
            int q = (int)rintf(f[i] * HQ_SCALE); q = q < -120 ? -120 : (q > 119 ? 119 : q);
            pb[i >> 3] |= ((unsigned)q & 15u) << (4 * (i & 7));
            pa[i >> 3] |= ((unsigned)((q + 8) >> 4) & 15u) << (4 * (i & 7));
        }
        *(u32x2*)(p.ws + WS_HQA + (size_t)tok * 512 + lane * 8) = (u32x2){pa[0], pa[1]};
        *(u32x2*)(p.ws + WS_HQB + (size_t)tok * 512 + lane * 8) = (u32x2){pb[0], pb[1]};
    }
}
__device__ __forceinline__ void ucoli_task(const Params& p, int tok, int z, int lane, const VMeta& m, int tok_next, VMeta& mn) {
    const int cc = lane & 7;
    const bool b2 = lane & 4, b1 = lane & 2, b0 = lane & 1;
    const __amdgpu_buffer_rsrc_t ru = __builtin_amdgcn_make_buffer_rsrc((void*)(p.ws + WS_U8 + (size_t)z * ((size_t)NEXP * 128)), (short)0, NEXP * 128, 0x00020000);
    const unsigned coff = (unsigned)cc * 16u;
    u32x4 uw[16];
#pragma unroll
    for (int q = 0; q < 4; ++q) {
        uw[4 * q] = __builtin_bit_cast(u32x4, __builtin_amdgcn_raw_buffer_load_b128(ru, (int)(m.e[q].x * 128u + coff), 0, 0));
        uw[4 * q + 1] = __builtin_bit_cast(u32x4, __builtin_amdgcn_raw_buffer_load_b128(ru, (int)(m.e[q].y * 128u + coff), 0, 0));
        uw[4 * q + 2] = __builtin_bit_cast(u32x4, __builtin_amdgcn_raw_buffer_load_b128(ru, (int)(m.e[q].z * 128u + coff), 0, 0));
        uw[4 * q + 3] = __builtin_bit_cast(u32x4, __builtin_amdgcn_raw_buffer_load_b128(ru, (int)(m.e[q].w * 128u + coff), 0, 0));
    }
    const u32x4 pa = *(const u32x4*)(p.ws + WS_HQA + (size_t)tok * 512 + z * 128 + coff);
    const u32x4 pb = *(const u32x4*)(p.ws + WS_HQB + (size_t)tok * 512 + z * 128 + coff);
    if (tok_next >= 0) v_meta(p, tok_next, z, lane, mn);
    float d[16];
#pragma unroll
    for (int i = 0; i < 16; ++i) {
        int sa = 0, sb = 0;
#pragma unroll
        for (int q = 0; q < 4; ++q) { sa = __builtin_amdgcn_sdot8((int)uw[i][q], (int)pa[q], sa, false); sb = __builtin_amdgcn_sdot8((int)uw[i][q], (int)pb[q], sb, false); }
        d[i] = (float)(16 * sa + sb);
    }
    float s8[8], s4[4], s2[2];
#pragma unroll
    for (int i = 0; i < 8; ++i) { const float snd = b2 ? d[i] : d[i + 8], keep = b2 ? d[i + 8] : d[i]; s8[i] = keep + __shfl_xor(snd, 4); }
#pragma unroll
    for (int i = 0; i < 4; ++i) { const float snd = b1 ? s8[i] : s8[i + 4], keep = b1 ? s8[i + 4] : s8[i]; s4[i] = keep + __shfl_xor(snd, 2); }
#pragma unroll
    for (int i = 0; i < 2; ++i) { const float snd = b0 ? s4[i] : s4[i + 2], keep = b0 ? s4[i + 2] : s4[i]; s2[i] = keep + __shfl_xor(snd, 1); }
    const unsigned so = (unsigned)(16 * (lane >> 3) + (b2 ? 8 : 0) + (b1 ? 4 : 0) + (b0 ? 2 : 0)) * 2u;
    *(unsigned*)(p.ws + WS_PART + ((size_t)tok * 8 + z) * 256 + so) = pk2(s2[0] * (1.0f / 256.0f), s2[1] * (1.0f / 256.0f));
}
template <bool VPHASE, int PROBE = 0>
__device__ __forceinline__ void phase_sliced(const Params& p_in) {
    Params p = p_in; if (PROBE) p.out = (float*)(p_in.ws + WS_QP);
    const int tid_ = tid_opaque(), lane = tid_ & 63;
    const unsigned loff = 16u * (unsigned)lane;
    unsigned* ctr = (unsigned*)(p.ws + WS_CTR + (VPHASE ? 2048 : 0) + PROBE * 4096);
    constexpr bool FP4 = VPHASE ? V_FP4 : U_FP4;
    constexpr int NSL = FP4 ? NSL4 : 8;
    const int x0 = (int)(xb_xcc_id() & 7u);
    for (int k = 0; k < NSL; ++k) {
        const int y = (x0 + k) & (NSL - 1);
        int tk = claim(ctr + y * 64, lane);
        if (tk >= NTICKET) continue;
        VMeta vm, vmn;
        v_meta(p, tk * TOK_PER_TICKET, y, lane, vm);
        while (tk < NTICKET) {
            const int tkn = claim(ctr + y * 64, lane);
#pragma unroll 1
            for (int i = 0; i < TOK_PER_TICKET; ++i) {
                const int tok = tk * TOK_PER_TICKET + i;
                const int tok_next = (i + 1 < TOK_PER_TICKET) ? tok + 1 : ((tkn < NTICKET) ? tkn * TOK_PER_TICKET : -1);
                if (VPHASE) { if (FP4) v4_task(p, tok, y, lane, vm, tok_next, vmn); else v_task(p, tok, y, lane, vm, tok_next, vmn); vm = vmn; }
                else { if (FP4 && U_INT4) ucoli_task(p, tok, y, lane, vm, tok_next, vmn); else if (FP4) ucol4_task(p, tok, y, lane, vm, tok_next, vmn); else ucol_task(p, tok, y, lane, vm, tok_next, vmn); vm = vmn; }
            }
            tk = tkn;
        }
    }
}
__device__ __forceinline__ void phase_final_norm(const Params& p) {
    const int tid_ = tid_opaque(), lane = tid_ & 63;
    const int gw = (int)blockIdx.x * (NTHREADS / 64) + __builtin_amdgcn_readfirstlane(tid_ >> 6), ngw = (int)gridDim.x * (NTHREADS / 64);
    const unsigned loff = 16u * (unsigned)lane;
    f32x4 g[4];
#pragma unroll
    for (int q = 0; q < 4; ++q) g[q] = *(const f32x4*)(p.lnf_g + loff + 4 * q);
    for (int tok0 = gw * 4; tok0 < NTOK; tok0 += ngw * 4) {
        u32x4 w0[4], w1[4];
#pragma unroll
        for (int r = 0; r < 4; ++r) {
            const bf16_t* hrow = (const bf16_t*)(p.ws + WS_H2 + (size_t)(tok0 + r) * D * 2) + loff;
            w0[r] = *(const u32x4*)hrow; w1[r] = *(const u32x4*)(hrow + 8);
        }
        f32x4 y[4][4]; float ss[4];
#pragma unroll
        for (int r = 0; r < 4; ++r) {
            y[r][0] = (f32x4){bflo(w0[r].x), bfhi(w0[r].x), bflo(w0[r].y), bfhi(w0[r].y)}; y[r][1] = (f32x4){bflo(w0[r].z), bfhi(w0[r].z), bflo(w0[r].w), bfhi(w0[r].w)};
            y[r][2] = (f32x4){bflo(w1[r].x), bfhi(w1[r].x), bflo(w1[r].y), bfhi(w1[r].y)}; y[r][3] = (f32x4){bflo(w1[r].z), bfhi(w1[r].z), bflo(w1[r].w), bfhi(w1[r].w)};
            ss[r] = 0.f;
#pragma unroll
            for (int q = 0; q < 4; ++q) ss[r] += (y[r][q].x * y[r][q].x + y[r][q].y * y[r][q].y) + (y[r][q].z * y[r][q].z + y[r][q].w * y[r][q].w);
        }
#pragma unroll
        for (int o = 1; o < 64; o <<= 1) {
#pragma unroll
            for (int r = 0; r < 4; ++r) ss[r] += __shfl_xor(ss[r], o);
        }
#pragma unroll
        for (int r = 0; r < 4; ++r) {
            const float rstd = 1.0f / sqrtf(ss[r] * (1.0f / D) + EPS);
            float* orow = (float*)((unsigned char*)p.out + (size_t)(tok0 + r) * D * 4) + loff;
#pragma unroll
            for (int q = 0; q < 4; ++q) *(f32x4*)(orow + 4 * q) = (f32x4){y[r][q].x * rstd * g[q].x, y[r][q].y * rstd * g[q].y, y[r][q].z * rstd * g[q].z, y[r][q].w * rstd * g[q].w};
        }
    }
}
}

constexpr int LDS_BYTES = 147456;
extern __shared__ __attribute__((aligned(16))) unsigned char dyn_lds[];

__device__ __forceinline__ Params load_params() {
#if !defined(__HIP_DEVICE_COMPILE__)
    return Params{};
#else
    const __attribute__((address_space(4))) unsigned char* ka = (const __attribute__((address_space(4))) unsigned char*)__builtin_amdgcn_kernarg_segment_ptr();
    asm volatile("" : "+s"(ka));
    const __attribute__((address_space(4))) Params* kp = (const __attribute__((address_space(4))) Params*)ka;
    Params r;
    r.x = kp->x; r.ln1_g = kp->ln1_g; r.w_in = kp->w_in; r.pe_k = kp->pe_k; r.w1_k = kp->w1_k; r.w2_k = kp->w2_k; r.pe_v = kp->pe_v; r.w1_v = kp->w1_v; r.w2_v = kp->w2_v;
    r.sinks = kp->sinks; r.w_out = kp->w_out; r.ln2_g = kp->ln2_g; r.wq = kp->wq; r.pkeys = kp->pkeys; r.pu = kp->pu; r.pv = kp->pv; r.lnf_g = kp->lnf_g; r.out = kp->out; r.ws = kp->ws;
    return r;
#endif
}
__global__ void __launch_bounds__(NTHREADS, 2) fwd_megakernel(Params p_unused) {
    cg::grid_group grid = cg::this_grid();
    float* lds = (float*)dyn_lds;
    PG8_LAS unsigned char* ldsp = (PG8_LAS unsigned char*)dyn_lds;
    volatile XLAS unsigned* bst = (volatile XLAS unsigned*)((XLAS unsigned char*)dyn_lds + (LDS_BYTES - 16));
    if (threadIdx.x < 4) bst[threadIdx.x] = 0u;
    __syncthreads();
    { const Params p = load_params(); (void)xcd_barrier_post((unsigned*)(p.ws + WS_BAR), bst); }
#define GRID_BARRIER() do { const Params p_ = load_params(); XcdBarrier xb_; xb_.bar = (unsigned*)(p_.ws + WS_BAR); xb_.x = xb_xcc_id(); \
        xb_.st = (volatile XLAS unsigned*)((XLAS unsigned char*)dyn_lds + (LDS_BYTES - 16)); xcd_barrier(xb_); } while (0)
    for (int rep = 0; rep < 1 + PROBE_PREP; ++rep) { const Params p = load_params(); phase_prep(p); }
    if (gridDim.y == 0x7fffu) grid.sync();
    GRID_BARRIER();
    for (int rep = 0; rep < 1 + PROBE_PROJ; ++rep) { const Params p = load_params();
      pg8::Gemm g{(const bf16_t*)(p.ws + WS_XN), (const bf16_t*)(p.ws + WS_WIN), NTOK, DINP, D}; pg8::StaticOrder S; S.init(NTOK, DINP, (int)gridDim.x, (int)blockIdx.x);
      EpiProjT E{p.ws}; pg8::gemm_phase<EpiProjT, pg8::StaticOrder, true, true>(ldsp, g, S, E); }
    GRID_BARRIER();
    for (int rep = 0; rep < 1 + PROBE_CS; ++rep) { const Params p = load_params(); cmp::phase_compress_swa(p, dyn_lds); }
    GRID_BARRIER();
    { const Params p = load_params(); att::phase_nsa_mfma<0>(p, dyn_lds); }
#if PROBE_NSA
    { const Params p = load_params(); att::phase_nsa_mfma<PROBE_NSA>(p, dyn_lds); }
#endif
    GRID_BARRIER();
    { const Params p = load_params();
      pg8::Gemm g{(const bf16_t*)(p.ws + WS_O), (const bf16_t*)(p.ws + WS_WOUT), NTOK, D, D}; pg8::StaticOrder S; S.init(NTOK, D, (int)gridDim.x, (int)blockIdx.x);
      EpiOutT E{p.x, p.ln2_g, p.out, (bf16_t*)(p.ws + WS_H1G), (float*)(p.ws + WS_SS2)}; pg8::gemm_phase<EpiOutT, pg8::StaticOrder, true, true>(ldsp, g, S, E); }
    GRID_BARRIER();
    for (int rep = 0; rep < 1 + PROBE_QP; ++rep) { const Params p = load_params();
      pg8::Gemm g{(const bf16_t*)(p.ws + WS_H1G), (const bf16_t*)(p.ws + WS_WQ), NTOK, PQ, D}; pg8::StaticOrder S; S.init(NTOK, PQ, (int)gridDim.x, (int)blockIdx.x);
      EpiQPT E{(const float*)(p.ws + WS_SS2), (bf16_t*)(p.ws + WS_QP)}; pg8::gemm_phase<EpiQPT, pg8::StaticOrder, true, true>(ldsp, g, S, E); }
    GRID_BARRIER();
    if (U_FP4 && U_INT4) { const Params p = load_params(); pex::quantize_h(p); }
    for (int rep = 0; rep < 1 + PROBE_SEL; ++rep) { const Params p = load_params(); psel::phase_peer_select(p, dyn_lds); }
    GRID_BARRIER();
    { const Params p = load_params(); pex::phase_sliced<false>(p); }
#if PROBE_PEXU
    { const Params p = load_params(); pex::phase_sliced<false, 1>(p); }
#endif
    GRID_BARRIER();
    for (int rep = 0; rep < 1 + PROBE_ACT; ++rep) { const Params p = load_params(); pex::phase_expert_act(p); }
    GRID_BARRIER();
    { const Params p = load_params(); pex::phase_sliced<true>(p); }
#if PROBE_PEXV
    { const Params p = load_params(); pex::phase_sliced<true, 1>(p); }
#endif
    GRID_BARRIER();
    { const Params p = load_params(); pex::phase_final_norm(p); }
}

extern "C" void kernel_launch(void* const* d_in, const int* in_sizes, int n_in, void* d_out, int out_size, void* d_ws, size_t ws_size, hipStream_t stream) {
    if (n_in != 17 || ws_size < WS_END) { fprintf(stderr, "kernel_launch: unexpected inputs (n_in %d, ws %zu)\n", n_in, ws_size); return; }
    static int grid_blocks = 0;
    if (!grid_blocks) {
        int dev = 0, cus = 0, per_cu = 0;
        (void)hipGetDevice(&dev);
        (void)hipDeviceGetAttribute(&cus, hipDeviceAttributeMultiprocessorCount, dev);
        (void)hipFuncSetAttribute((const void*)fwd_megakernel, hipFuncAttributeMaxDynamicSharedMemorySize, LDS_BYTES);
        (void)hipOccupancyMaxActiveBlocksPerMultiprocessor(&per_cu, (const void*)fwd_megakernel, NTHREADS, LDS_BYTES);
        if (per_cu < 1) per_cu = 1;
        grid_blocks = cus * per_cu;
        fprintf(stderr, "kernel_launch: %d CUs x %d blocks/CU\n", cus, per_cu);
    }
    Params p{};
    p.x = (const float*)d_in[0]; p.ln1_g = (const float*)d_in[1]; p.w_in = (const float*)d_in[2];
    p.pe_k = (const float*)d_in[3]; p.w1_k = (const float*)d_in[4]; p.w2_k = (const float*)d_in[5];
    p.pe_v = (const float*)d_in[6]; p.w1_v = (const float*)d_in[7]; p.w2_v = (const float*)d_in[8];
    p.sinks = (const float*)d_in[9]; p.w_out = (const float*)d_in[10]; p.ln2_g = (const float*)d_in[11];
    p.wq = (const float*)d_in[12]; p.pkeys = (const float*)d_in[13]; p.pu = (const float*)d_in[14]; p.pv = (const float*)d_in[15];
    p.lnf_g = (const float*)d_in[16];
    p.out = (float*)d_out; p.ws = (unsigned char*)d_ws;
    (void)hipMemsetAsync((unsigned char*)d_ws + WS_BAR, 0, 16 * 1024 + 8192, stream);
    void* args[] = {&p};
    hipError_t e = hipLaunchCooperativeKernel((void*)fwd_megakernel, dim3(grid_blocks), dim3(NTHREADS), args, LDS_BYTES, stream);
    if (e != hipSuccess) fprintf(stderr, "cooperative launch failed: %s (grid %d)\n", hipGetErrorString(e), grid_blocks);
}
```

```cpp
#include <hip/hip_runtime.h>
#include <hip/hip_cooperative_groups.h>
#include <cstdint>
#include <cstdio>
namespace cg = cooperative_groups;
#define PROBE_PREP 0
#define PROBE_COMPRESS 0
#define PROBE_SWA 0
#define PROBE_NSA 0
#define PROBE_SUB 0
#define PROBE_COMB 0
#define PROBE_PEXU 0
#define PROBE_PEXV 0
#define PROBE_PROJ 0
#define PROBE_QP 0
#define PROBE_SEL 0
#define PROBE_CS 0
#define PROBE_ACT 0

typedef unsigned short bf16_t;
typedef short bf16x8 __attribute__((ext_vector_type(8)));
typedef float f32x4 __attribute__((ext_vector_type(4)));
typedef unsigned u32x4 __attribute__((ext_vector_type(4)));
typedef unsigned u32x2 __attribute__((ext_vector_type(2)));

constexpr int BATCH = 2, T = 8192, D = 1024, NTOK = BATCH * T;
constexpr int HD = 64, NSA_H = 8, NSA_G = 2, NSA_HG = 4, SWA_H = 8;
constexpr int DIN = 1944, DINP = 2048;
constexpr int NCMP = 511, NCMPP = 512, NSEL = 128, TOPN = 16;
constexpr int NSA_WIN = 512, SWA_WIN = 128;
constexpr int PH = 8, PNK = 128, PDK = 256, PTOPK = 16, PQ = PH * PDK;
constexpr int NEXP = PNK * PNK;
constexpr float EPS = 1e-6f;
constexpr int NTHREADS = 512;
constexpr bool V_MFMA = true;
constexpr bool U_FP4 = true, V_FP4 = true, U_INT4 = true;

constexpr size_t MiB = 1u << 20;
constexpr size_t WS_SS2 = 0;
constexpr size_t WS_BAR = 128 * 1024;
constexpr size_t WS_WIN = 1 * MiB;
constexpr size_t WS_WOUT = 5 * MiB;
constexpr size_t WS_WQ = 7 * MiB;
constexpr size_t WS_PKEYS = 11 * MiB;
constexpr size_t WS_W1T = 12 * MiB;
constexpr size_t WS_W2T = 14 * MiB;
constexpr size_t WS_B1 = 14 * MiB + 512 * 1024;
constexpr size_t WS_XN = 16 * MiB;
constexpr size_t WS_O = WS_XN;
constexpr size_t WS_HQA = WS_XN;
constexpr size_t WS_HQB = WS_XN + 8 * MiB;
constexpr size_t WS_H2 = WS_XN;
constexpr size_t WS_QN = 48 * MiB;
constexpr size_t WS_QS = 64 * MiB;
constexpr size_t WS_KV6 = 80 * MiB;
constexpr size_t KV6_STRIDE = 4 * MiB;
constexpr size_t WS_KSW = 104 * MiB;
constexpr size_t WS_VSW = 106 * MiB;
constexpr size_t WS_GSIG = 108 * MiB;
constexpr size_t WS_KC = 110 * MiB;
constexpr size_t WS_VC = 110 * MiB + 512 * 1024;
constexpr size_t WS_H1G = 48 * MiB;
constexpr size_t WS_QP = 80 * MiB;
constexpr size_t WS_EIDX = 144 * MiB;
constexpr size_t WS_GATE = 152 * MiB;
constexpr size_t WS_U8 = 160 * MiB;
constexpr size_t WS_PART = 80 * MiB;
constexpr size_t WS_V8 = 176 * MiB;
constexpr size_t WS_VREC = 232 * MiB;
constexpr size_t WS_PW = 224 * MiB;
constexpr size_t WS_CTR = 128 * 1024 + 16 * 1024;
constexpr size_t WS_TOPV2 = 224 * MiB;
constexpr size_t WS_TOPI2 = 240 * MiB;
constexpr size_t WS_END = 256 * MiB;

struct Params {
    const float* x; const float* ln1_g; const float* w_in;
    const float* pe_k; const float* w1_k; const float* w2_k;
    const float* pe_v; const float* w1_v; const float* w2_v;
    const float* sinks; const float* w_out; const float* ln2_g;
    const float* wq; const float* pkeys; const float* pu; const float* pv; const float* lnf_g;
    float* out; unsigned char* ws;
};

__device__ __forceinline__ int tid_opaque() { int t = (int)threadIdx.x; asm volatile("" : "+v"(t)); return t; }
__device__ __forceinline__ unsigned f2bf(float f) { unsigned u = __float_as_uint(f); return (u + 0x7fffu + ((u >> 16) & 1u)) >> 16; }
__device__ __forceinline__ float bf2f(unsigned h) { return __uint_as_float(h << 16); }
__device__ __forceinline__ float bflo(unsigned w) { return __uint_as_float(w << 16); }
__device__ __forceinline__ float bfhi(unsigned w) { return __uint_as_float(w & 0xffff0000u); }
__device__ __forceinline__ unsigned pk2(float lo, float hi) { return f2bf(lo) | (f2bf(hi) << 16); }
__device__ __forceinline__ float wave_sum(float v) {
#pragma unroll
    for (int o = 1; o < 64; o <<= 1) v += __shfl_xor(v, o);
    return v;
}
__device__ __forceinline__ float gelu_tanh(float x) {
    const float u = 0.7978845608028654f * (x + 0.044715f * x * x * x);
    return 0.5f * x * (1.0f + tanhf(u));
}
__device__ __forceinline__ int win_orig_col(int n) {
    if (n < 1280) return n;
    if (n < 1792) return 1304 + (n - 1280);
    if (n < 1856) return 1816 + (n - 1792);
    if (n < 1920) return 1880 + (n - 1856);
    if (n < 1944) return 1280 + (n - 1920);
    return -1;
}

template <bool WIN_MAP>
__device__ __forceinline__ void prep_transpose(const float* W, int K, int N, int NP, bf16_t* WT, long gt, long ngt) {
    const long items = (long)NP * (K / 8);
    for (long it = gt; it < items; it += ngt) {
        const int n = (int)(it % NP), k0 = (int)(it / NP) * 8;
        const int col = WIN_MAP ? win_orig_col(n) : n;
        float v[8];
#pragma unroll
        for (int i = 0; i < 8; ++i) v[i] = (col >= 0) ? W[(size_t)(k0 + i) * N + col] : 0.f;
        u32x4 o; o.x = pk2(v[0], v[1]); o.y = pk2(v[2], v[3]); o.z = pk2(v[4], v[5]); o.w = pk2(v[6], v[7]);
        *(u32x4*)(WT + (size_t)n * K + k0) = o;
    }
}
__device__ __forceinline__ void prep_convert(const float* src, bf16_t* dst, long n8, long gt, long ngt) {
    for (long it = gt; it < n8; it += ngt) {
        const f32x4 a = *(const f32x4*)(src + it * 8), b = *(const f32x4*)(src + it * 8 + 4);
        u32x4 o; o.x = pk2(a.x, a.y); o.y = pk2(a.z, a.w); o.z = pk2(b.x, b.y); o.w = pk2(b.z, b.w);
        *(u32x4*)(dst + it * 8) = o;
    }
}
constexpr float U8_SCALE = 256.0f, V8_SCALE = 16.0f;
constexpr float U4_SCALE = 64.0f, V4_SCALE = 5.656854249f;
constexpr float UI_SCALE = 91.4285714f, HQ_SCALE = 16.0f;
constexpr int NSL4 = 4;
__device__ __forceinline__ void prep_convert_fp8(const float* src, unsigned char* dst, long n16, float sc, long gt, long ngt) {
    for (long it = gt; it < n16; it += ngt) {
        u32x4 o;
#pragma unroll
        for (int q = 0; q < 4; ++q) {
            const f32x4 a = *(const f32x4*)(src + it * 16 + q * 4);
            int w = 0;
            w = __builtin_amdgcn_cvt_pk_fp8_f32(a.x * sc, a.y * sc, w, false);
            w = __builtin_amdgcn_cvt_pk_fp8_f32(a.z * sc, a.w * sc, w, true);
            o[q] = (unsigned)w;
        }
        *(u32x4*)(dst + it * 16) = o;
    }
}
__device__ __forceinline__ void prep_convert_fp8_sliced(const float* src, unsigned char* dst, long n16, float sc, long gt, long ngt) {
    for (long it = gt; it < n16; it += ngt) {
        u32x4 o;
#pragma unroll
        for (int q = 0; q < 4; ++q) {
            const f32x4 a = *(const f32x4*)(src + it * 16 + q * 4);
            int w = 0;
            w = __builtin_amdgcn_cvt_pk_fp8_f32(a.x * sc, a.y * sc, w, false);
            w = __builtin_amdgcn_cvt_pk_fp8_f32(a.z * sc, a.w * sc, w, true);
            o[q] = (unsigned)w;
        }
        const long e = (it * 16) >> 10; const int col = (int)((it * 16) & 1023);
        *(u32x4*)(dst + (size_t)(col >> 7) * ((size_t)NEXP * 128) + e * 128 + (col & 127)) = o;
    }
}
__device__ __forceinline__ void prep_convert_fp4_sliced(const float* src, unsigned char* dst, long n32, float sc, long gt, long ngt) {
    for (long it = gt; it < n32; it += ngt) {
        u32x4 o;
#pragma unroll
        for (int q = 0; q < 4; ++q) {
            const f32x4 a = *(const f32x4*)(src + it * 32 + q * 8), b = *(const f32x4*)(src + it * 32 + q * 8 + 4);
            unsigned w = 0u;
            w = __builtin_amdgcn_cvt_scalef32_pk_fp4_f32(w, a.x * sc, a.y * sc, 1.0f, 0);
            w = __builtin_amdgcn_cvt_scalef32_pk_fp4_f32(w, a.z * sc, a.w * sc, 1.0f, 1);
            w = __builtin_amdgcn_cvt_scalef32_pk_fp4_f32(w, b.x * sc, b.y * sc, 1.0f, 2);
            w = __builtin_amdgcn_cvt_scalef32_pk_fp4_f32(w, b.z * sc, b.w * sc, 1.0f, 3);
            o[q] = w;
        }
        const long e = (it * 32) >> 10; const int col = (int)((it * 32) & 1023);
        *(u32x4*)(dst + (size_t)(col >> 8) * ((size_t)NEXP * 128) + e * 128 + ((col & 255) >> 1)) = o;
    }
}
__device__ __forceinline__ void prep_convert_fp4_vperm(const float* src, unsigned char* dst, long n32, float sc, long gt, long ngt) {
    for (long it = gt; it < n32; it += ngt) {
        const long e = it >> 5; const int z = (int)(it >> 3) & 3, q = (int)it & 3, hh = (int)(it >> 2) & 1;
        const float* sp = src + e * 1024 + 256 * z + 128 * hh + 4 * q;
        u32x4 o;
#pragma unroll
        for (int gl = 0; gl < 2; ++gl) {
            const f32x4 l0 = *(const f32x4*)(sp + 64 * gl), l1 = *(const f32x4*)(sp + 64 * gl + 16), l2 = *(const f32x4*)(sp + 64 * gl + 32), l3 = *(const f32x4*)(sp + 64 * gl + 48);
#pragma unroll
            for (int wh = 0; wh < 2; ++wh) {
                const int r0 = 2 * wh, r1 = 2 * wh + 1;
                unsigned w = 0u;
                w = __builtin_amdgcn_cvt_scalef32_pk_fp4_f32(w, l0[r0] * sc, l1[r0] * sc, 1.0f, 0);
                w = __builtin_amdgcn_cvt_scalef32_pk_fp4_f32(w, l2[r0] * sc, l3[r0] * sc, 1.0f, 1);
                w = __builtin_amdgcn_cvt_scalef32_pk_fp4_f32(w, l0[r1] * sc, l1[r1] * sc, 1.0f, 2);
                w = __builtin_amdgcn_cvt_scalef32_pk_fp4_f32(w, l2[r1] * sc, l3[r1] * sc, 1.0f, 3);
                o[2 * gl + wh] = w;
            }
        }
        *(u32x4*)(dst + (size_t)z * ((size_t)NEXP * 128) + e * 128 + 32 * q + 16 * hh) = o;
    }
}
__device__ __forceinline__ void prep_convert_int4_sliced(const float* src, unsigned char* dst, long n32, float sc, long gt, long ngt) {
    for (long it = gt; it < n32; it += ngt) {
        u32x4 o;
#pragma unroll
        for (int q = 0; q < 4; ++q) {
            const f32x4 a = *(const f32x4*)(src + it * 32 + q * 8), b = *(const f32x4*)(src + it * 32 + q * 8 + 4);
            const float f[8] = {a.x, a.y, a.z, a.w, b.x, b.y, b.z, b.w};
            unsigned w = 0u;
#pragma unroll
            for (int i = 0; i < 8; ++i) { int v = (int)rintf(f[i] * sc); v = v < -7 ? -7 : (v > 7 ? 7 : v); w |= ((unsigned)v & 15u) << (4 * i); }
            o[q] = w;
        }
        const long e = (it * 32) >> 10; const int col = (int)((it * 32) & 1023);
        *(u32x4*)(dst + (size_t)(col >> 8) * ((size_t)NEXP * 128) + e * 128 + ((col & 255) >> 1)) = o;
    }
}
constexpr int CONV_HEAVY_PCT = 50;
__device__ __forceinline__ void convert_expert_tables(const Params& p, int part  , int bi, int nblk) {
    constexpr long ITEMS_U = (long)NEXP * D / (U_FP4 ? 32 : 16), ITEMS_V = (long)NEXP * D / (V_FP4 ? 32 : 16);
    constexpr long FU = ITEMS_U * CONV_HEAVY_PCT / 100, FV = ITEMS_V * CONV_HEAVY_PCT / 100;
    const long ulo = part == 1 ? FU : 0, uhi = part == 0 ? FU : ITEMS_U, vlo = part == 1 ? FV : 0, vhi = part == 0 ? FV : ITEMS_V;
    {
        const long gt = ulo + (long)bi * NTHREADS + tid_opaque(), ngt = (long)nblk * NTHREADS;
        if (U_FP4 && U_INT4) prep_convert_int4_sliced(p.pu, p.ws + WS_U8, uhi, UI_SCALE, gt, ngt);
        else if (U_FP4) prep_convert_fp4_sliced(p.pu, p.ws + WS_U8, uhi, U4_SCALE, gt, ngt);
        else prep_convert_fp8_sliced(p.pu, p.ws + WS_U8, uhi, U8_SCALE, gt, ngt);
    }
    {
        const long gt = vlo + (long)bi * NTHREADS + tid_opaque(), ngt = (long)nblk * NTHREADS;
        if (V_FP4 && V_MFMA) prep_convert_fp4_vperm(p.pv, p.ws + WS_V8, vhi, V4_SCALE, gt, ngt);
        else if (V_FP4) prep_convert_fp4_sliced(p.pv, p.ws + WS_V8, vhi, V4_SCALE, gt, ngt);
        else prep_convert_fp8_sliced(p.pv, p.ws + WS_V8, vhi, V8_SCALE, gt, ngt);
    }
}
__device__ __forceinline__ void phase_prep(const Params& p) {
    const long gt = (long)blockIdx.x * NTHREADS + tid_opaque(), ngt = (long)gridDim.x * NTHREADS;
    const int lane = tid_opaque() & 63;
    const long gw = gt >> 6, ngw = ngt >> 6;
    unsigned char* ws = p.ws;
    {
        f32x4 g[4];
#pragma unroll
        for (int j = 0; j < 4; ++j) g[j] = *((const f32x4*)p.ln1_g + lane + 64 * j);
        for (long m0 = gw * 4; m0 < NTOK; m0 += ngw * 4) {
            f32x4 v[4][4]; float s[4];
#pragma unroll
            for (int r = 0; r < 4; ++r) {
                const f32x4* xr = (const f32x4*)(p.x + (size_t)(m0 + r) * D) + lane;
#pragma unroll
                for (int j = 0; j < 4; ++j) v[r][j] = xr[64 * j];
            }
#pragma unroll
            for (int r = 0; r < 4; ++r) {
                s[r] = 0.f;
#pragma unroll
                for (int j = 0; j < 4; ++j) s[r] += (v[r][j].x * v[r][j].x + v[r][j].y * v[r][j].y) + (v[r][j].z * v[r][j].z + v[r][j].w * v[r][j].w);
            }
#pragma unroll
            for (int o = 1; o < 64; o <<= 1) {
#pragma unroll
                for (int r = 0; r < 4; ++r) s[r] += __shfl_xor(s[r], o);
            }
#pragma unroll
            for (int r = 0; r < 4; ++r) {
                const float rstd = 1.0f / sqrtf(s[r] * (1.0f / D) + EPS);
                u32x2* o = (u32x2*)((bf16_t*)(ws + WS_XN) + (size_t)(m0 + r) * D) + lane;
#pragma unroll
                for (int j = 0; j < 4; ++j) {
                    u32x2 w; w.x = pk2(v[r][j].x * rstd * g[j].x, v[r][j].y * rstd * g[j].y); w.y = pk2(v[r][j].z * rstd * g[j].z, v[r][j].w * rstd * g[j].w);
                    o[64 * j] = w;
                }
            }
        }
    }
    prep_transpose<true>(p.w_in, D, DIN, DINP, (bf16_t*)(ws + WS_WIN), gt, ngt);
    prep_transpose<false>(p.w_out, D, D, D, (bf16_t*)(ws + WS_WOUT), gt, ngt);
    prep_transpose<false>(p.wq, D, PQ, PQ, (bf16_t*)(ws + WS_WQ), gt, ngt);
    prep_convert(p.pkeys, (bf16_t*)(ws + WS_PKEYS), (long)16 * 128 * 128 / 8, gt, ngt);
    prep_transpose<false>(p.w1_k, 2048, 256, 256, (bf16_t*)(ws + WS_W1T), gt, ngt);
    prep_transpose<false>(p.w1_v, 2048, 256, 256, (bf16_t*)(ws + WS_W1T) + 256 * 2048, gt, ngt);
    prep_transpose<false>(p.w2_k, 256, 64, 64, (bf16_t*)(ws + WS_W2T), gt, ngt);
    prep_transpose<false>(p.w2_v, 256, 64, 64, (bf16_t*)(ws + WS_W2T) + 64 * 256, gt, ngt);
    for (long o = gw; o < 512; o += ngw) {
        const int kv = (int)(o >> 8), n = (int)(o & 255);
        const float* pe = kv ? p.pe_v : p.pe_k; const float* w1 = kv ? p.w1_v : p.w1_k;
        float s = 0.f;
        for (int k = lane; k < 2048; k += 64) s += pe[k] * w1[(size_t)k * 256 + n];
        s = wave_sum(s);
        if (lane == 0) ((float*)(ws + WS_B1))[o] = s;
    }
    for (long i = gt; i < NTOK; i += ngt) ((float*)(ws + WS_SS2))[i] = 0.f;
}

template <class Epi>
__device__ __forceinline__ void gemm_simple(const bf16_t* A, const bf16_t* Bt, int M, int N, int K, const Epi& E) {
    const int lane = tid_opaque() & 63;
    const long gw = ((long)blockIdx.x * NTHREADS + tid_opaque()) >> 6, ngw = ((long)gridDim.x * NTHREADS) >> 6;
    const int ntn = N / 64; const long ntiles = (long)(M / 32) * ntn;
    const int fr = lane & 15, fq = lane >> 4;
    for (long tile = gw; tile < ntiles; tile += ngw) {
        const int m0 = (int)(tile / ntn) * 32, n0 = (int)(tile % ntn) * 64;
        f32x4 acc[2][4];
#pragma unroll
        for (int i = 0; i < 2; ++i)
#pragma unroll
            for (int j = 0; j < 4; ++j) acc[i][j] = (f32x4){0.f, 0.f, 0.f, 0.f};
        const bf16_t* ap = A + (size_t)(m0 + fr) * K + fq * 8;
        const bf16_t* bp = Bt + (size_t)(n0 + fr) * K + fq * 8;
        for (int k0 = 0; k0 < K; k0 += 32) {
            bf16x8 a[2], b[4];
#pragma unroll
            for (int i = 0; i < 2; ++i) a[i] = *(const bf16x8*)(ap + (size_t)i * 16 * K + k0);
#pragma unroll
            for (int j = 0; j < 4; ++j) b[j] = *(const bf16x8*)(bp + (size_t)j * 16 * K + k0);
#pragma unroll
            for (int i = 0; i < 2; ++i)
#pragma unroll
                for (int j = 0; j < 4; ++j) acc[i][j] = __builtin_amdgcn_mfma_f32_16x16x32_bf16(a[i], b[j], acc[i][j], 0, 0, 0);
        }
        E(acc, m0, n0, fr, fq);
    }
}

struct EpiProj {
    unsigned char* ws;
    __device__ __forceinline__ void operator()(const f32x4 (&acc)[2][4], int m0, int n0, int fr, int fq) const {
#pragma unroll
        for (int i = 0; i < 2; ++i)
#pragma unroll
            for (int j = 0; j < 4; ++j)
#pragma unroll
                for (int r = 0; r < 4; ++r) {
                    const int row = m0 + 16 * i + fq * 4 + r, n = n0 + 16 * j + fr;
                    const float v = acc[i][j][r];
                    const int b = row / T, t = row % T, d = n & 63;
                    if (n < 512) {
                        const int head = n >> 6;
                        ((bf16_t*)(ws + WS_QN))[((size_t)(b * 8 + head) * T + t) * 64 + d] = (bf16_t)f2bf(v * 0.125f);
                    } else if (n < 1280) {
                        const int arr = (n - 512) >> 7, g = ((n - 512) >> 6) & 1;
                        ((bf16_t*)(ws + WS_KV6 + arr * KV6_STRIDE))[((size_t)(b * 2 + g) * T + t) * 64 + d] = (bf16_t)f2bf(v);
                    } else if (n < 1792) {
                        const int head = (n - 1280) >> 6;
                        ((bf16_t*)(ws + WS_QS))[((size_t)(b * 8 + head) * T + t) * 64 + d] = (bf16_t)f2bf(v * 0.125f);
                    } else if (n < 1856) {
                        ((bf16_t*)(ws + WS_KSW))[((size_t)b * T + t) * 64 + d] = (bf16_t)f2bf(v);
                    } else if (n < 1920) {
                        ((bf16_t*)(ws + WS_VSW))[((size_t)b * T + t) * 64 + d] = (bf16_t)f2bf(v);
                    } else if (n < 1944) {
                        ((float*)(ws + WS_GSIG))[(size_t)row * 24 + (n - 1920)] = 1.0f / (1.0f + expf(-v));
                    }
                }
    }
};
struct EpiOut {
    const float* x; const float* g2; float* h1; bf16_t* h1g; float* ss2;
    __device__ __forceinline__ void operator()(const f32x4 (&acc)[2][4], int m0, int n0, int fr, int fq) const {
#pragma unroll
        for (int i = 0; i < 2; ++i)
#pragma unroll
            for (int r = 0; r < 4; ++r) {
                const int row = m0 + 16 * i + fq * 4 + r; float ss = 0.f;
#pragma unroll
                for (int j = 0; j < 4; ++j) {
                    const int n = n0 + 16 * j + fr; const size_t off = (size_t)row * D + n;
                    const float h = x[off] + acc[i][j][r];
                    h1[off] = h; h1g[off] = (bf16_t)f2bf(h * g2[n]); ss += h * h;
                }
                ss += __shfl_xor(ss, 1); ss += __shfl_xor(ss, 2); ss += __shfl_xor(ss, 4); ss += __shfl_xor(ss, 8);
                if (fr == 0) atomicAdd(ss2 + row, ss);
            }
    }
};
struct EpiQP {
    const float* ss2; bf16_t* qp;
    __device__ __forceinline__ void operator()(const f32x4 (&acc)[2][4], int m0, int n0, int fr, int fq) const {
#pragma unroll
        for (int i = 0; i < 2; ++i)
#pragma unroll
            for (int r = 0; r < 4; ++r) {
                const int row = m0 + 16 * i + fq * 4 + r;
                const float rstd = 1.0f / sqrtf(ss2[row] * (1.0f / D) + EPS);
#pragma unroll
                for (int j = 0; j < 4; ++j) qp[(size_t)row * PQ + n0 + 16 * j + fr] = (bf16_t)f2bf(acc[i][j][r] * rstd);
            }
    }
};

namespace pg8 {
#define PG8_LAS __attribute__((address_space(3)))
typedef unsigned short bf16_t;
typedef short bf16x8 __attribute__((ext_vector_type(8)));
typedef float f32x4 __attribute__((ext_vector_type(4)));
typedef unsigned u32x4 __attribute__((ext_vector_type(4)));
constexpr int BM = 256, BK = 64, HALF = 128, HTB = HALF * BK * 2  , STAGE_BYTES = 8 * HTB, NXCD = 8, WGM = 8;

__host__ __device__ __forceinline__ int lds_byte(int r, int c) { const int st = (r >> 4) * 2 + (c >> 5), rr = r & 15, cc = c & 31, ob = rr * 64 + cc * 2; return st * 1024 + (ob ^ (((ob >> 9) & 1) << 5)); }
__host__ __device__ __forceinline__ void stage_rc(int b, int& R, int& C) { const int st = b / 1024, sb = b % 1024, swz = sb ^ (((sb >> 9) & 1) << 5); R = (st >> 1) * 16 + swz / 64; C = (st & 1) * 32 + (swz % 64) / 2; }
__host__ __device__ __forceinline__ int perm32(int rho) { const int n = rho >> 4, i = rho & 15; return 8 * (i >> 2) + 4 * n + (i & 3); }

struct Unit { int pm, pn; };
struct Gemm { const bf16_t* A; const bf16_t* Bt; int M, N, K; };

struct StaticOrder {
    int nM, nN, nwg, G, c;
    __host__ __device__ void init(int M, int N, int G_, int c_) { nM = M / BM; nN = N / BM; nwg = nM * nN; G = G_; c = c_; }
    __host__ __device__ bool next(int i, Unit& u) const {
        const long L = (long)i * G + c; if (L >= nwg) return false;
        int wgid = (int)L; { const int q = nwg / NXCD, r = nwg % NXCD, xcd = wgid % NXCD, off = wgid / NXCD; wgid = (xcd < r ? xcd * (q + 1) : r * (q + 1) + (xcd - r) * q) + off; }
        const int nig = WGM * nN, gid = wgid / nig, fm = gid * WGM, gsz = (nM - fm) < WGM ? (nM - fm) : WGM;
        u.pm = fm + ((wgid % nig) % gsz); u.pn = (wgid % nig) / gsz; return true;
    }
    __device__ __forceinline__ void a_ready(const Unit&) const {}
    __device__ __forceinline__ void done(const Unit&) const {}
};

__device__ __forceinline__ unsigned cvt_pk_bf16(float lo, float hi) { unsigned r; asm volatile("v_cvt_pk_bf16_f32 %0, %1, %2" : "=v"(r) : "v"(lo), "v"(hi)); return r; }
template <class Epi, class Sched, bool ALIGN_EPI = false, bool SP2 = false>
__device__ __forceinline__ void gemm_phase(PG8_LAS unsigned char* lds, const Gemm g, const Sched& S, const Epi& E) {
    const int tid = tid_opaque(), wid = __builtin_amdgcn_readfirstlane(tid >> 6), lane = tid & 63, wr = wid >> 2, wc = wid & 3, fr = lane & 15, fq = lane >> 4;
    const int K = g.K, nt = K / BK;
    unsigned voffA[2], voffB[2];
#pragma unroll
    for (int i = 0; i < 2; ++i) { int R, C; stage_rc(tid * 16 + i * 8192, R, C); const int Rb = Epi::PERM ? ((R & ~31) + perm32(R & 31)) : R;
        voffA[i] = (unsigned)(R * K + C) * 2u; voffB[i] = (unsigned)(Rb * K + C) * 2u; }
    const size_t kstep = (size_t)(BK * 2);
    const size_t hstep = (size_t)HALF * K * 2;
    const size_t tstep = 2 * hstep;
    const unsigned ldsw = (unsigned)wid * 1024u;
    const int aoff = lds_byte(wr * 64 + fr, fq * 8), boff = lds_byte(wc * 32 + fr, fq * 8);
#define PG8_SA(b, h) (((b) * 2 + (h)) * HTB)
#define PG8_SB(b, h) ((4 + (b) * 2 + (h)) * HTB)
#define PG8_STAGE(bufoff, gbase, voff) do { _Pragma("unroll") for (int _i = 0; _i < 2; ++_i) \
        __builtin_amdgcn_global_load_lds((const unsigned*)((const char*)(gbase) + (voff)[_i]), (PG8_LAS unsigned*)(lds + (bufoff) + ldsw + _i * 8192), 16, 0, 0); } while (0)
#define PG8_LDA(dst, b, h) do { _Pragma("unroll") for (int m = 0; m < 4; ++m) _Pragma("unroll") for (int k = 0; k < 2; ++k) dst[m][k] = *(const PG8_LAS bf16x8*)(lds + PG8_SA(b, h) + aoff + m * 2048 + k * 1024); } while (0)
#define PG8_LDB(dst, b, h) do { _Pragma("unroll") for (int n = 0; n < 2; ++n) _Pragma("unroll") for (int k = 0; k < 2; ++k) dst[n][k] = *(const PG8_LAS bf16x8*)(lds + PG8_SB(b, h) + boff + n * 2048 + k * 1024); } while (0)
#define PG8_MMA(ai, bj, At, Bt) do { __builtin_amdgcn_s_setprio(1); _Pragma("unroll") for (int m = 0; m < 4; ++m) _Pragma("unroll") for (int n = 0; n < 2; ++n) _Pragma("unroll") for (int k = 0; k < 2; ++k) \
        acc[ai][bj][m][n] = __builtin_amdgcn_mfma_f32_16x16x32_bf16(Bt[n][k], At[m][k], acc[ai][bj][m][n], 0, 0, 0); __builtin_amdgcn_s_setprio(0); } while (0)
#define PG8_WAIT_V(n) asm volatile("s_waitcnt vmcnt(" #n ")" ::: "memory")
#define PG8_WAIT_L(n) asm volatile("s_waitcnt lgkmcnt(" #n ")" ::: "memory")
#define PG8_BAR __builtin_amdgcn_s_barrier()
#define PG8_SCHED __builtin_amdgcn_sched_barrier(0)
    Unit cur, nxt; int ui = 0;
    if (!S.next(0, cur)) return;
    f32x4 acc[2][2][4][2];
#pragma unroll
    for (int a = 0; a < 2; ++a)
#pragma unroll
        for (int b = 0; b < 2; ++b)
#pragma unroll
            for (int m = 0; m < 4; ++m)
#pragma unroll
                for (int n = 0; n < 2; ++n) acc[a][b][m][n] = (f32x4){0.f, 0.f, 0.f, 0.f};
    bf16x8 At[4][2], B0[2][2], B1[2][2];
    const char* cA = (const char*)g.A + (size_t)cur.pm * tstep; const char* cB = (const char*)g.Bt + (size_t)cur.pn * tstep;
    S.a_ready(cur);
    if constexpr (SP2) {
        PG8_STAGE(PG8_SB(0, 0), cB, voffB); PG8_STAGE(PG8_SB(0, 1), cB + hstep, voffB); PG8_STAGE(PG8_SA(0, 0), cA, voffA); PG8_STAGE(PG8_SA(0, 1), cA + hstep, voffA);
        if (wr == 1) PG8_BAR;
        PG8_WAIT_V(2); PG8_BAR;
        PG8_STAGE(PG8_SB(1, 0), cB + kstep, voffB); PG8_STAGE(PG8_SA(1, 0), cA + kstep, voffA); PG8_STAGE(PG8_SB(1, 1), cB + hstep + kstep, voffB);
        PG8_WAIT_V(6); PG8_BAR;
    } else {
        PG8_STAGE(PG8_SB(0, 0), cB, voffB); PG8_STAGE(PG8_SA(0, 0), cA, voffA); PG8_STAGE(PG8_SB(0, 1), cB + hstep, voffB); PG8_STAGE(PG8_SA(0, 1), cA + hstep, voffA);
        if (wr == 1) PG8_BAR;
        PG8_WAIT_V(4); PG8_BAR;
        PG8_STAGE(PG8_SB(1, 0), cB + kstep, voffB); PG8_STAGE(PG8_SA(1, 0), cA + kstep, voffA); PG8_STAGE(PG8_SB(1, 1), cB + hstep + kstep, voffB);
        PG8_WAIT_V(6); PG8_BAR;
    }
    for (;;) {
        const bool has_next = S.next(ui + 1, nxt);
        const char* nA = has_next ? (const char*)g.A + (size_t)nxt.pm * tstep : cA; const char* nB = has_next ? (const char*)g.Bt + (size_t)nxt.pn * tstep : cB;
        for (int t = 0; t < nt; t += 2) {
            const bool last = (t == nt - 2);
            const char* a1 = cA + (size_t)(t + 1) * kstep;
            const char* a2 = last ? nA : cA + (size_t)(t + 2) * kstep; const char* b2 = last ? nB : cB + (size_t)(t + 2) * kstep;
            const char* a3 = a2 + kstep; const char* b3 = b2 + kstep;
            if (last && has_next) S.a_ready(nxt);
            if constexpr (SP2) {
            PG8_LDB(B0, 0, 0); PG8_LDB(B1, 0, 1); PG8_SCHED; PG8_LDA(At, 0, 0); PG8_STAGE(PG8_SA(1, 1), a1 + hstep, voffA);
            PG8_WAIT_V(8); PG8_WAIT_L(0); PG8_BAR; PG8_MMA(0, 0, At, B0); PG8_MMA(0, 1, At, B1); PG8_BAR; PG8_SCHED;
            PG8_LDA(At, 0, 1); PG8_STAGE(PG8_SB(0, 0), b2, voffB); PG8_STAGE(PG8_SB(0, 1), b2 + hstep, voffB); PG8_STAGE(PG8_SA(0, 0), a2, voffA);
            PG8_WAIT_V(8); PG8_WAIT_L(0); PG8_BAR; PG8_MMA(1, 0, At, B0); PG8_MMA(1, 1, At, B1); PG8_BAR; PG8_SCHED;
            PG8_LDB(B0, 1, 0); PG8_LDB(B1, 1, 1); PG8_SCHED; PG8_LDA(At, 1, 0); PG8_STAGE(PG8_SA(0, 1), a2 + hstep, voffA);
            PG8_WAIT_V(8); PG8_WAIT_L(0); PG8_BAR; PG8_MMA(0, 0, At, B0); PG8_MMA(0, 1, At, B1); PG8_BAR; PG8_SCHED;
            PG8_LDA(At, 1, 1); PG8_STAGE(PG8_SB(1, 0), b3, voffB); PG8_STAGE(PG8_SB(1, 1), b3 + hstep, voffB); PG8_STAGE(PG8_SA(1, 0), a3, voffA);
            PG8_WAIT_V(8); PG8_WAIT_L(0); PG8_BAR; PG8_MMA(1, 0, At, B0); PG8_MMA(1, 1, At, B1); PG8_BAR; PG8_SCHED;
            } else {
            PG8_LDB(B0, 0, 0); PG8_SCHED; PG8_LDA(At, 0, 0); PG8_STAGE(PG8_SA(1, 1), a1 + hstep, voffA);
            PG8_WAIT_L(8); PG8_BAR; PG8_WAIT_L(0); PG8_MMA(0, 0, At, B0); PG8_BAR; PG8_SCHED;
            PG8_LDB(B1, 0, 1); PG8_STAGE(PG8_SB(0, 0), b2, voffB);
            PG8_BAR; PG8_WAIT_L(0); PG8_MMA(0, 1, At, B1); PG8_BAR;
            PG8_LDA(At, 0, 1); PG8_STAGE(PG8_SA(0, 0), a2, voffA);
            PG8_BAR; PG8_WAIT_L(0); PG8_MMA(1, 0, At, B0); PG8_BAR; PG8_SCHED;
            PG8_STAGE(PG8_SB(0, 1), b2 + hstep, voffB);
            PG8_WAIT_V(6); PG8_BAR; PG8_MMA(1, 1, At, B1); PG8_BAR;
            PG8_LDB(B0, 1, 0); PG8_SCHED; PG8_LDA(At, 1, 0); PG8_STAGE(PG8_SA(0, 1), a2 + hstep, voffA);
            PG8_WAIT_L(8); PG8_BAR; PG8_WAIT_L(0); PG8_MMA(0, 0, At, B0); PG8_BAR; PG8_SCHED;
            PG8_LDB(B1, 1, 1); PG8_STAGE(PG8_SB(1, 0), b3, voffB);
            PG8_BAR; PG8_WAIT_L(0); PG8_MMA(0, 1, At, B1); PG8_BAR;
            PG8_LDA(At, 1, 1); PG8_STAGE(PG8_SA(1, 0), a3, voffA);
            PG8_BAR; PG8_WAIT_L(0); PG8_MMA(1, 0, At, B0); PG8_BAR; PG8_SCHED;
            PG8_STAGE(PG8_SB(1, 1), b3 + hstep, voffB);
            PG8_WAIT_V(6); PG8_BAR; PG8_MMA(1, 1, At, B1); PG8_BAR;
            }
        }
        if constexpr (ALIGN_EPI) { if (wr == 0) PG8_BAR; }
        if constexpr (!Epi::AFTER_DRAIN) { E(acc, cur, wr, wc, fr, fq); S.done(cur); }
        if (!has_next) break;
#pragma unroll
        for (int a = 0; a < 2; ++a)
#pragma unroll
            for (int b = 0; b < 2; ++b)
#pragma unroll
                for (int m = 0; m < 4; ++m)
#pragma unroll
                    for (int n = 0; n < 2; ++n) acc[a][b][m][n] = (f32x4){0.f, 0.f, 0.f, 0.f};
        cur = nxt; cA = nA; cB = nB; ++ui;
        if constexpr (ALIGN_EPI) { if (wr == 1) PG8_BAR; }
    }
    PG8_WAIT_V(0);
    if constexpr (!ALIGN_EPI) { if (wr == 0) PG8_BAR; }
    PG8_BAR;
    if constexpr (Epi::AFTER_DRAIN) { E.fused(acc, cur, wr, wc, fr, fq, lds, wid, lane); S.done(cur); }
#undef PG8_SA
#undef PG8_SB
#undef PG8_STAGE
#undef PG8_LDA
#undef PG8_LDB
#undef PG8_MMA
#undef PG8_WAIT_V
#undef PG8_WAIT_L
#undef PG8_BAR
#undef PG8_SCHED
}
}

struct EpiProjT {
    static constexpr bool PERM = true, AFTER_DRAIN = false;
    unsigned char* ws;
    __device__ __forceinline__ void operator()(const f32x4 (&acc)[2][2][4][2], const pg8::Unit& u, int wr, int wc, int fr, int fq) const {
        const int row0 = u.pm * 256 + wr * 64 + fr;
#pragma unroll
        for (int bj = 0; bj < 2; ++bj) {
            const int n8 = u.pn * 256 + bj * 128 + wc * 32 + 8 * fq;
            if (n8 >= 1944) continue;
            if (n8 >= 1920) {
#pragma unroll
                for (int ai = 0; ai < 2; ++ai)
#pragma unroll
                    for (int m = 0; m < 4; ++m) {
                        const int row = row0 + ai * 128 + m * 16;
                        const f32x4 v0 = acc[ai][bj][m][0], v1 = acc[ai][bj][m][1];
                        float* dst = (float*)(ws + WS_GSIG) + (size_t)row * 24 + (n8 - 1920);
                        *(f32x4*)dst = (f32x4){1.0f / (1.0f + __expf(-v0[0])), 1.0f / (1.0f + __expf(-v0[1])), 1.0f / (1.0f + __expf(-v0[2])), 1.0f / (1.0f + __expf(-v0[3]))};
                        *(f32x4*)(dst + 4) = (f32x4){1.0f / (1.0f + __expf(-v1[0])), 1.0f / (1.0f + __expf(-v1[1])), 1.0f / (1.0f + __expf(-v1[2])), 1.0f / (1.0f + __expf(-v1[3]))};
                    }
                continue;
            }
            bf16_t* base; int nh, hidx; float sc = 1.0f;
            if (n8 < 512) { base = (bf16_t*)(ws + WS_QN); nh = 8; hidx = n8 >> 6; sc = 0.125f * 1.4426950408889634f; }
            else if (n8 < 1280) { const int arr = (n8 - 512) >> 7; base = (bf16_t*)(ws + WS_KV6 + (size_t)arr * KV6_STRIDE); nh = 2; hidx = ((n8 - 512) >> 6) & 1; }
            else if (n8 < 1792) { base = (bf16_t*)(ws + WS_QS); nh = 8; hidx = (n8 - 1280) >> 6; sc = 0.125f * 1.4426950408889634f; }
            else if (n8 < 1856) { base = (bf16_t*)(ws + WS_KSW); nh = 1; hidx = 0; }
            else { base = (bf16_t*)(ws + WS_VSW); nh = 1; hidx = 0; }
            const int d0 = n8 & 63;
#pragma unroll
            for (int ai = 0; ai < 2; ++ai)
#pragma unroll
                for (int m = 0; m < 4; ++m) {
                    const int row = row0 + ai * 128 + m * 16, b = row >> 13, t = row & (T - 1);
                    const f32x4 v0 = acc[ai][bj][m][0] * sc, v1 = acc[ai][bj][m][1] * sc;
                    u32x4 w; w.x = pg8::cvt_pk_bf16(v0[0], v0[1]); w.y = pg8::cvt_pk_bf16(v0[2], v0[3]); w.z = pg8::cvt_pk_bf16(v1[0], v1[1]); w.w = pg8::cvt_pk_bf16(v1[2], v1[3]);
                    *(u32x4*)(base + ((size_t)(b * nh + hidx) * T + t) * 64 + d0) = w;
                }
        }
    }
};
struct EpiOutT {
    static constexpr bool PERM = false, AFTER_DRAIN = false;
    const float* x; const float* g2; float* h1; bf16_t* h1g; float* ss2;
    __device__ __forceinline__ void operator()(const f32x4 (&acc)[2][2][4][2], const pg8::Unit& u, int wr, int wc, int fr, int fq) const {
        const int row0 = u.pm * 256 + wr * 64 + fr, col0 = u.pn * 256 + wc * 32 + 4 * fq;
#pragma unroll
        for (int ai = 0; ai < 2; ++ai)
#pragma unroll
            for (int m = 0; m < 4; ++m) {
                const int row = row0 + ai * 128 + m * 16; float ss = 0.f;
#pragma unroll
                for (int bj = 0; bj < 2; ++bj)
#pragma unroll
                    for (int n = 0; n < 2; ++n) {
                        const int c = col0 + bj * 128 + n * 16; const size_t off = (size_t)row * D + c;
                        const f32x4 h = *(const f32x4*)(x + off) + acc[ai][bj][m][n];
                        const f32x4 g = *(const f32x4*)(g2 + c);
                        u32x2 w; w.x = pg8::cvt_pk_bf16(h[0] * g[0], h[1] * g[1]); w.y = pg8::cvt_pk_bf16(h[2] * g[2], h[3] * g[3]);
                        *(u32x2*)(h1g + off) = w;
                        ss += (h[0] * h[0] + h[1] * h[1]) + (h[2] * h[2] + h[3] * h[3]);
                    }
                ss += __shfl_xor(ss, 16); ss += __shfl_xor(ss, 32);
                if (fq == 0) atomicAdd(ss2 + row, ss);
            }
    }
};
struct EpiQPT {
    static constexpr bool PERM = true, AFTER_DRAIN = false;
    const float* ss2; bf16_t* qp;
    __device__ __forceinline__ void operator()(const f32x4 (&acc)[2][2][4][2], const pg8::Unit& u, int wr, int wc, int fr, int fq) const {
        const int row0 = u.pm * 256 + wr * 64 + fr;
#pragma unroll
        for (int ai = 0; ai < 2; ++ai)
#pragma unroll
            for (int m = 0; m < 4; ++m) {
                const int row = row0 + ai * 128 + m * 16;
                const float rstd = 1.0f / sqrtf(ss2[row] * (1.0f / D) + EPS);
#pragma unroll
                for (int bj = 0; bj < 2; ++bj) {
                    const int n8 = u.pn * 256 + bj * 128 + wc * 32 + 8 * fq;
                    const f32x4 v0 = acc[ai][bj][m][0] * rstd, v1 = acc[ai][bj][m][1] * rstd;
                    u32x4 w; w.x = pg8::cvt_pk_bf16(v0[0], v0[1]); w.y = pg8::cvt_pk_bf16(v0[2], v0[3]); w.z = pg8::cvt_pk_bf16(v1[0], v1[1]); w.w = pg8::cvt_pk_bf16(v1[2], v1[3]);
                    *(u32x4*)(qp + (size_t)row * PQ + n8) = w;
                }
            }
    }
};

__device__ __forceinline__ void phase_compress(const Params& p, float* lds) {
    float* flat = lds;
    float* part = lds + 2048;
    float* hid = lds + 2560;
    const int tid = tid_opaque();
    const int nunits = 2 * BATCH * NCMP * NSA_G;
    for (int u = blockIdx.x; u < nunits; u += gridDim.x) {
        const int kv = u / (BATCH * NCMP * NSA_G); int r = u % (BATCH * NCMP * NSA_G);
        const int b = r / (NCMP * NSA_G); r %= (NCMP * NSA_G);
        const int c = r / NSA_G, g = r % NSA_G;
        const bf16_t* raw = (const bf16_t*)(p.ws + WS_KV6 + (size_t)kv * KV6_STRIDE) + ((size_t)(b * 2 + g) * T + 16 * c) * 64;
        const float* pe = kv ? p.pe_v : p.pe_k; const float* w1 = kv ? p.w1_v : p.w1_k; const float* w2 = kv ? p.w2_v : p.w2_k;
        for (int i = tid; i < 2048; i += NTHREADS) flat[i] = bf2f(raw[i]) + pe[i];
        __syncthreads();
        {
            const int j = tid & 255, half = tid >> 8;
            float a = 0.f;
            const float* wp = w1 + (size_t)(half * 1024) * 256 + j; const float* fp = flat + half * 1024;
            for (int i = 0; i < 1024; ++i) a += fp[i] * wp[(size_t)i * 256];
            part[tid] = a;
        }
        __syncthreads();
        if (tid < 256) hid[tid] = gelu_tanh(part[tid] + part[tid + 256]);
        __syncthreads();
        if (tid < 64) {
            float a = 0.f;
            for (int j = 0; j < 256; ++j) a += hid[j] * w2[j * 64 + tid];
            bf16_t* dst = (bf16_t*)(p.ws + (kv ? WS_VC : WS_KC)) + ((size_t)(b * 2 + g) * NCMPP + c) * 64;
            dst[tid] = (bf16_t)f2bf(a);
        }
        __syncthreads();
    }
}

__device__ __forceinline__ void load_row64(const bf16_t* src, float (&k)[64]) {
#pragma unroll
    for (int c = 0; c < 8; ++c) {
        const u32x4 w = *(const u32x4*)(src + 8 * c);
        k[8 * c + 0] = bflo(w.x); k[8 * c + 1] = bfhi(w.x); k[8 * c + 2] = bflo(w.y); k[8 * c + 3] = bfhi(w.y);
        k[8 * c + 4] = bflo(w.z); k[8 * c + 5] = bfhi(w.z); k[8 * c + 6] = bflo(w.w); k[8 * c + 7] = bfhi(w.w);
    }
}
__device__ __forceinline__ float dot_row64(const bf16_t* src, const float (&q)[64]) {
    float s0 = 0.f, s1 = 0.f;
#pragma unroll
    for (int c = 0; c < 8; ++c) {
        const u32x4 w = *(const u32x4*)(src + 8 * c);
        s0 += q[8 * c + 0] * bflo(w.x); s1 += q[8 * c + 1] * bfhi(w.x); s0 += q[8 * c + 2] * bflo(w.y); s1 += q[8 * c + 3] * bfhi(w.y);
        s0 += q[8 * c + 4] * bflo(w.z); s1 += q[8 * c + 5] * bfhi(w.z); s0 += q[8 * c + 6] * bflo(w.w); s1 += q[8 * c + 7] * bfhi(w.w);
    }
    return s0 + s1;
}
__device__ __forceinline__ void osm_update(float s, const bf16_t* vsrc, float& m, float& l, float (&acc)[32]) {
    const float mn = fmaxf(m, s), alpha = __expf(m - mn), pr = __expf(s - mn);
    l = l * alpha + pr; m = mn;
#pragma unroll
    for (int c = 0; c < 4; ++c) {
        const u32x4 w = *(const u32x4*)(vsrc + 8 * c);
        acc[8 * c + 0] = acc[8 * c + 0] * alpha + pr * bflo(w.x); acc[8 * c + 1] = acc[8 * c + 1] * alpha + pr * bfhi(w.x);
        acc[8 * c + 2] = acc[8 * c + 2] * alpha + pr * bflo(w.y); acc[8 * c + 3] = acc[8 * c + 3] * alpha + pr * bfhi(w.y);
        acc[8 * c + 4] = acc[8 * c + 4] * alpha + pr * bflo(w.z); acc[8 * c + 5] = acc[8 * c + 5] * alpha + pr * bfhi(w.z);
        acc[8 * c + 6] = acc[8 * c + 6] * alpha + pr * bflo(w.w); acc[8 * c + 7] = acc[8 * c + 7] * alpha + pr * bfhi(w.w);
    }
}

__device__ __forceinline__ void phase_nsa(const Params& p, float* lds) {
    float* imp = lds;
    int* sel = (int*)(lds + 64 * 129);
    const int tid = tid_opaque(), qi = tid & 63, h = (tid >> 6) & 3, dh = tid >> 8;
    const unsigned char* ws = p.ws;
    const int nunits = BATCH * NSA_G * (T / 64);
    for (int u = blockIdx.x; u < nunits; u += gridDim.x) {
        const int b = u / (NSA_G * (T / 64)), g = (u / (T / 64)) % NSA_G, tile = u % (T / 64);
        const int t = tile * 64 + qi, head = g * 4 + h;
        const float slope = exp2f(-0.5f * (float)(9 + head));
        float q[64];
        load_row64((const bf16_t*)(ws + WS_QN) + ((size_t)(b * 8 + head) * T + t) * 64, q);
        const bf16_t* KC = (const bf16_t*)(ws + WS_KC) + (size_t)(b * 2 + g) * NCMPP * 64;
        const bf16_t* VC = (const bf16_t*)(ws + WS_VC) + (size_t)(b * 2 + g) * NCMPP * 64 + dh * 32;
        const bf16_t* KS = (const bf16_t*)(ws + WS_KV6 + 2 * KV6_STRIDE) + (size_t)(b * 2 + g) * T * 64;
        const bf16_t* VS = (const bf16_t*)(ws + WS_KV6 + 3 * KV6_STRIDE) + (size_t)(b * 2 + g) * T * 64 + dh * 32;
        const bf16_t* KW = (const bf16_t*)(ws + WS_KV6 + 4 * KV6_STRIDE) + (size_t)(b * 2 + g) * T * 64;
        const bf16_t* VW = (const bf16_t*)(ws + WS_KV6 + 5 * KV6_STRIDE) + (size_t)(b * 2 + g) * T * 64 + dh * 32;
        const float* gs = (const float*)(ws + WS_GSIG) + (size_t)(b * T + t) * 24 + head * 3;
        float o[32];
#pragma unroll
        for (int d = 0; d < 32; ++d) o[d] = 0.f;
        for (int i = tid; i < 64 * 129; i += NTHREADS) imp[i] = 0.f;
        __syncthreads();
        const int nc = 4 * tile + 3;
        float mc = -1e30f, lc = 0.f;
        {
            float acc[32];
#pragma unroll
            for (int d = 0; d < 32; ++d) acc[d] = 0.f;
            for (int c = 0; c < nc; ++c) {
                const int dist = t - (16 * c + 31);
                if (dist >= 0) {
                    const float s = dot_row64(KC + (size_t)c * 64, q) - slope * (float)dist;
                    osm_update(s, VC + (size_t)c * 64, mc, lc, acc);
                }
            }
            const float inv = gs[0] / fmaxf(lc, 1e-30f);
#pragma unroll
            for (int d = 0; d < 32; ++d) o[d] += acc[d] * inv;
        }
        if (dh == 0) {
            const float invl = 1.0f / fmaxf(lc, 1e-30f);
            for (int c = 0; c < nc; ++c) {
                const int dist = t - (16 * c + 31);
                if (dist >= 0) {
                    const float s = dot_row64(KC + (size_t)c * 64, q) - slope * (float)dist;
                    const float pr = __expf(s - mc) * invl;
                    const int sb = c >> 2;
                    atomicAdd(&imp[qi * 129 + sb], pr);
                    if ((c & 3) == 3 && sb + 1 < NSEL) atomicAdd(&imp[qi * 129 + sb + 1], pr);
                }
            }
        }
        __syncthreads();
        if (tid < 64) {
            const int blk_t = tile;
            float* row = imp + tid * 129;
            for (int j = 0; j <= blk_t; ++j) if (j == 0 || j == blk_t || j == blk_t - 1) row[j] = 1.0e4f;
            for (int k = 0; k < TOPN; ++k) {
                float best = -INFINITY; int bi = -1;
                for (int j = 0; j <= blk_t; ++j) { const float v = row[j]; if (v > best) { best = v; bi = j; } }
                sel[tid * 16 + k] = bi;
                if (bi >= 0) row[bi] = -INFINITY;
            }
        }
        __syncthreads();
        {
            float m = -1e30f, l = 0.f, acc[32];
#pragma unroll
            for (int d = 0; d < 32; ++d) acc[d] = 0.f;
            for (int k = 0; k < TOPN; ++k) {
                const int j = sel[qi * 16 + k];
                if (j >= 0) {
                    for (int i = 0; i < 64; ++i) {
                        const int pos = 64 * j + i;
                        if (pos <= t) {
                            const float s = dot_row64(KS + (size_t)pos * 64, q) - slope * (float)(t - pos);
                            osm_update(s, VS + (size_t)pos * 64, m, l, acc);
                        }
                    }
                }
            }
            const float inv = gs[1] / fmaxf(l, 1e-30f);
#pragma unroll
            for (int d = 0; d < 32; ++d) o[d] += acc[d] * inv;
        }
        {
            float m = -1e30f, l = 0.f, acc[32];
#pragma unroll
            for (int d = 0; d < 32; ++d) acc[d] = 0.f;
            for (int i = 0; i < NSA_WIN; ++i) {
                const int pos = t - (NSA_WIN - 1) + i;
                if (pos >= 0) {
                    const float s = dot_row64(KW + (size_t)pos * 64, q) - slope * (float)(t - pos);
                    osm_update(s, VW + (size_t)pos * 64, m, l, acc);
                }
            }
            const float inv = gs[2] / fmaxf(l, 1e-30f);
#pragma unroll
            for (int d = 0; d < 32; ++d) o[d] += acc[d] * inv;
        }
        bf16_t* O = (bf16_t*)(p.ws + WS_O) + (size_t)(b * T + t) * D + g * 256 + h * 64 + dh * 32;
#pragma unroll
        for (int c = 0; c < 4; ++c) {
            u32x4 w; w.x = pk2(o[8 * c], o[8 * c + 1]); w.y = pk2(o[8 * c + 2], o[8 * c + 3]); w.z = pk2(o[8 * c + 4], o[8 * c + 5]); w.w = pk2(o[8 * c + 6], o[8 * c + 7]);
            *(u32x4*)(O + 8 * c) = w;
        }
        __syncthreads();
    }
}

__device__ __forceinline__ void phase_swa(const Params& p) {
    const unsigned char* ws = p.ws;
    const long gt = (long)blockIdx.x * NTHREADS + tid_opaque(), ngt = (long)gridDim.x * NTHREADS;
    const long items = (long)NTOK * SWA_H * 2;
    for (long it = gt; it < items; it += ngt) {
        const int tt = (int)(it % T); long r = it / T;
        const int dh = (int)(r % 2); r /= 2;
        const int head = (int)(r % SWA_H); const int b = (int)(r / SWA_H);
        const float slope = exp2f(-0.5f * (float)(head + 1));
        float q[64];
        load_row64((const bf16_t*)(ws + WS_QS) + ((size_t)(b * 8 + head) * T + tt) * 64, q);
        const bf16_t* K = (const bf16_t*)(ws + WS_KSW) + (size_t)b * T * 64;
        const bf16_t* V = (const bf16_t*)(ws + WS_VSW) + (size_t)b * T * 64 + dh * 32;
        const float sink = p.sinks[head];
        float m = sink, l = 1.0f, acc[32];
#pragma unroll
        for (int d = 0; d < 32; ++d) acc[d] = 0.f;
        for (int i = 0; i < SWA_WIN; ++i) {
            const int pos = tt - (SWA_WIN - 1) + i;
            if (pos >= 0) {
                const float s = dot_row64(K + (size_t)pos * 64, q) - slope * (float)(tt - pos);
                osm_update(s, V + (size_t)pos * 64, m, l, acc);
            }
        }
        const float inv = 1.0f / l;
        bf16_t* O = (bf16_t*)(p.ws + WS_O) + (size_t)(b * T + tt) * D + 512 + head * 64 + dh * 32;
#pragma unroll
        for (int c = 0; c < 4; ++c) {
            u32x4 w; w.x = pk2(acc[8 * c] * inv, acc[8 * c + 1] * inv); w.y = pk2(acc[8 * c + 2] * inv, acc[8 * c + 3] * inv);
            w.z = pk2(acc[8 * c + 4] * inv, acc[8 * c + 5] * inv); w.w = pk2(acc[8 * c + 6] * inv, acc[8 * c + 7] * inv);
            *(u32x4*)(O + 8 * c) = w;
        }
    }
}

__device__ __forceinline__ void topk_insert(float v, int i, float (&tv)[16], int (&ti)[16]) {
#pragma unroll
    for (int k = 0; k < 16; ++k) {
        const bool sw = v > tv[k];
        const float ov = tv[k]; const int oi = ti[k];
        tv[k] = sw ? v : ov; ti[k] = sw ? i : oi;
        v = sw ? ov : v; i = sw ? oi : i;
    }
}
__device__ __forceinline__ void phase_peer_sub(const Params& p) {
    const unsigned char* ws = p.ws;
    const long gt = (long)blockIdx.x * NTHREADS + tid_opaque(), ngt = (long)gridDim.x * NTHREADS;
    const long items = (long)NTOK * 16;
    for (long it = gt; it < items; it += ngt) {
        const int tok = (int)(it % NTOK), hc = (int)(it / NTOK);
        const bf16_t* qp = (const bf16_t*)(ws + WS_QP) + (size_t)tok * PQ + hc * 128;
        float q0[64], q1[64];
        load_row64(qp, q0); load_row64(qp + 64, q1);
        const bf16_t* keys = (const bf16_t*)(ws + WS_PKEYS) + (size_t)hc * 128 * 128;
        float tv[16]; int ti[16];
#pragma unroll
        for (int k = 0; k < 16; ++k) { tv[k] = -INFINITY; ti[k] = 0; }
        for (int n = 0; n < 128; ++n) {
            const float s = dot_row64(keys + (size_t)n * 128, q0) + dot_row64(keys + (size_t)n * 128 + 64, q1);
            topk_insert(s, n, tv, ti);
        }
        float* ov = (float*)(p.ws + WS_TOPV2) + ((size_t)tok * 16 + hc) * 16;
        int* oi = (int*)(p.ws + WS_TOPI2) + ((size_t)tok * 16 + hc) * 16;
#pragma unroll
        for (int k = 0; k < 16; ++k) { ov[k] = tv[k]; oi[k] = ti[k]; }
    }
}
__device__ __forceinline__ void phase_peer_comb(const Params& p) {
    const long gt = (long)blockIdx.x * NTHREADS + tid_opaque(), ngt = (long)gridDim.x * NTHREADS;
    const long items = (long)NTOK * PH;
    for (long it = gt; it < items; it += ngt) {
        const int tok = (int)(it / PH), h = (int)(it % PH);
        const float* v1 = (const float*)(p.ws + WS_TOPV2) + ((size_t)tok * 16 + h * 2) * 16;
        const float* v2 = v1 + 16;
        const int* i1 = (const int*)(p.ws + WS_TOPI2) + ((size_t)tok * 16 + h * 2) * 16;
        const int* i2 = i1 + 16;
        float s2[16];
#pragma unroll
        for (int k = 0; k < 16; ++k) s2[k] = v2[k];
        float tv[16]; int ti[16];
#pragma unroll
        for (int k = 0; k < 16; ++k) { tv[k] = -INFINITY; ti[k] = 0; }
        for (int a = 0; a < 16; ++a) {
            const float s1 = v1[a];
#pragma unroll
            for (int bb = 0; bb < 16; ++bb) topk_insert(s1 + s2[bb], a * 16 + bb, tv, ti);
        }
        float e[16], sum = 0.f;
#pragma unroll
        for (int k = 0; k < 16; ++k) { e[k] = __expf(tv[k] - tv[0]); sum += e[k]; }
        const float inv = 1.0f / sum;
        int* eo = (int*)(p.ws + WS_EIDX) + (size_t)tok * 128 + h * 16;
        float* go = (float*)(p.ws + WS_GATE) + (size_t)tok * 128 + h * 16;
#pragma unroll
        for (int k = 0; k < 16; ++k) { const int ci = ti[k]; eo[k] = i1[ci >> 4] * PNK + i2[ci & 15]; go[k] = e[k] * inv; }
    }
}

typedef float f32x2 __attribute__((ext_vector_type(2)));
__device__ __forceinline__ void unpack16_fp8(const u32x4& w, float (&f)[16]) {
#pragma unroll
    for (int q = 0; q < 4; ++q) {
        const f32x2 lo = __builtin_amdgcn_cvt_pk_f32_fp8((int)w[q], false), hi = __builtin_amdgcn_cvt_pk_f32_fp8((int)w[q], true);
        f[4 * q] = lo.x; f[4 * q + 1] = lo.y; f[4 * q + 2] = hi.x; f[4 * q + 3] = hi.y;
    }
}
__device__ __forceinline__ float reduce8(const float (&d)[8], int lane) {
    const bool b5 = lane & 32, b4 = lane & 16, b3 = lane & 8;
    float e[4], f[2];
#pragma unroll
    for (int i = 0; i < 4; ++i) { const float snd = b5 ? d[i] : d[i + 4], keep = b5 ? d[i + 4] : d[i]; e[i] = keep + __shfl_xor(snd, 32); }
#pragma unroll
    for (int i = 0; i < 2; ++i) { const float snd = b4 ? e[i] : e[i + 2], keep = b4 ? e[i + 2] : e[i]; f[i] = keep + __shfl_xor(snd, 16); }
    const float snd = b3 ? f[0] : f[1], keep = b3 ? f[1] : f[0];
    float g = keep + __shfl_xor(snd, 8);
    g += __shfl_xor(g, 4); g += __shfl_xor(g, 2); g += __shfl_xor(g, 1);
    return g;
}
__device__ __forceinline__ void phase_peer_expert(const Params& p) {
    const unsigned char* ws = p.ws;
    const int tid_ = tid_opaque(), lane = tid_ & 63;
    const int gw = (int)blockIdx.x * (NTHREADS / 64) + __builtin_amdgcn_readfirstlane(tid_ >> 6), ngw = (int)gridDim.x * (NTHREADS / 64);
    const unsigned char* U = ws + WS_U8; const unsigned char* V = ws + WS_V8;
    const unsigned loff = 16u * (unsigned)lane;
    for (int tok = gw; tok < NTOK; tok += ngw) {
        const bf16_t* hg = (const bf16_t*)(ws + WS_H1G + (size_t)tok * D * 2) + loff;
        float a[16];
        {
            const u32x4 w0 = *(const u32x4*)hg, w1 = *(const u32x4*)(hg + 8);
            a[0] = bflo(w0.x); a[1] = bfhi(w0.x); a[2] = bflo(w0.y); a[3] = bfhi(w0.y); a[4] = bflo(w0.z); a[5] = bfhi(w0.z); a[6] = bflo(w0.w); a[7] = bfhi(w0.w);
            a[8] = bflo(w1.x); a[9] = bfhi(w1.x); a[10] = bflo(w1.y); a[11] = bfhi(w1.y); a[12] = bflo(w1.z); a[13] = bfhi(w1.z); a[14] = bflo(w1.w); a[15] = bfhi(w1.w);
        }
        const float rstd2 = (1.0f / U8_SCALE) / sqrtf(((const float*)(ws + WS_SS2))[tok] * (1.0f / D) + EPS);
        const int e_lo = ((const int*)(ws + WS_EIDX))[(size_t)tok * 128 + lane], e_hi = ((const int*)(ws + WS_EIDX))[(size_t)tok * 128 + 64 + lane];
        const float g_lo = ((const float*)(ws + WS_GATE))[(size_t)tok * 128 + lane], g_hi = ((const float*)(ws + WS_GATE))[(size_t)tok * 128 + 64 + lane];
        float acc[16];
#pragma unroll
        for (int i = 0; i < 16; ++i) acc[i] = 0.f;
        u32x4 uw[8], vw[8];
#pragma unroll
        for (int k = 0; k < 8; ++k) { const int e = __builtin_amdgcn_readlane(e_lo, k); uw[k] = *(const u32x4*)(U + (size_t)e * D + loff); vw[k] = *(const u32x4*)(V + (size_t)e * D + loff); }
#pragma unroll 1
        for (int b = 0; b < 16; ++b) {
            const int nsrc = (b + 1 < 8) ? e_lo : e_hi; const int nbase = ((b + 1) & 7) * 8;
            float d[8];
#pragma unroll
            for (int k = 0; k < 8; ++k) {
                float uf[16]; unpack16_fp8(uw[k], uf);
                float d0 = 0.f, d1 = 0.f;
#pragma unroll
                for (int i = 0; i < 16; i += 2) { d0 += a[i] * uf[i]; d1 += a[i + 1] * uf[i + 1]; }
                d[k] = d0 + d1;
                __builtin_amdgcn_sched_barrier(0);
            }
            if (b + 1 < 16) {
#pragma unroll
                for (int k = 0; k < 8; ++k) { const int e = __builtin_amdgcn_readlane(nsrc, nbase + k); uw[k] = *(const u32x4*)(U + (size_t)e * D + loff); }
            }
            const float dk = reduce8(d, lane);
            const float gsel = __shfl((b < 8) ? g_lo : g_hi, (b & 7) * 8 + ((lane >> 3) & 7));
            const float w = gsel * gelu_tanh(dk * rstd2);
#pragma unroll
            for (int k = 0; k < 8; ++k) {
                const float wk = __uint_as_float((unsigned)__builtin_amdgcn_readlane((int)__float_as_uint(w), 8 * k));
                float vf[16]; unpack16_fp8(vw[k], vf);
#pragma unroll
                for (int i = 0; i < 16; ++i) acc[i] += wk * vf[i];
                __builtin_amdgcn_sched_barrier(0);
            }
            if (b + 1 < 16) {
#pragma unroll
                for (int k = 0; k < 8; ++k) { const int e = __builtin_amdgcn_readlane(nsrc, nbase + k); vw[k] = *(const u32x4*)(V + (size_t)e * D + loff); }
            }
        }
        float* orow = (float*)((unsigned char*)p.out + (size_t)tok * D * 4) + loff;
        float y[16]; float ss = 0.f;
#pragma unroll
        for (int q = 0; q < 4; ++q) {
            const f32x4 h = *(const f32x4*)(orow + 4 * q);
            y[4 * q] = h.x + acc[4 * q] * (1.0f / V8_SCALE); y[4 * q + 1] = h.y + acc[4 * q + 1] * (1.0f / V8_SCALE);
            y[4 * q + 2] = h.z + acc[4 * q + 2] * (1.0f / V8_SCALE); y[4 * q + 3] = h.w + acc[4 * q + 3] * (1.0f / V8_SCALE);
        }
#pragma unroll
        for (int i = 0; i < 16; ++i) ss += y[i] * y[i];
        const float rstd = 1.0f / sqrtf(wave_sum(ss) * (1.0f / D) + EPS);
#pragma unroll
        for (int q = 0; q < 4; ++q) {
            const f32x4 g = *(const f32x4*)(p.lnf_g + loff + 4 * q);
            *(f32x4*)(orow + 4 * q) = (f32x4){y[4 * q] * rstd * g.x, y[4 * q + 1] * rstd * g.y, y[4 * q + 2] * rstd * g.z, y[4 * q + 3] * rstd * g.w};
        }
    }
}


namespace psel {
#define HD __host__ __device__ __forceinline__
HD unsigned f2ord(float f) { unsigned u = __builtin_bit_cast(unsigned, f); const unsigned m = (unsigned)((int)u >> 31); return u ^ (m | 0x80000000u); }
HD float ord2f(unsigned o) { const unsigned m = (unsigned)((int)o >> 31); return __builtin_bit_cast(float, o ^ (~m | 0x80000000u)); }
HD unsigned umax_(unsigned a, unsigned b) { return a > b ? a : b; }
HD unsigned umin_(unsigned a, unsigned b) { return a < b ? a : b; }
HD void sort16_desc(unsigned (&a)[16]) {
#pragma unroll
    for (int k = 2; k <= 16; k <<= 1)
#pragma unroll
        for (int j = k >> 1; j > 0; j >>= 1)
#pragma unroll
            for (int i = 0; i < 16; ++i) {
                const int l = i ^ j;
                if (l > i) {
                    const bool up = ((i & k) == 0);
                    const unsigned hi = umax_(a[i], a[l]), lo = umin_(a[i], a[l]);
                    a[i] = up ? hi : lo; a[l] = up ? lo : hi;
                }
            }
}
HD void merge16_desc(unsigned (&a)[16], const unsigned (&b)[16]) {
#pragma unroll
    for (int i = 0; i < 16; ++i) a[i] = umax_(a[i], b[15 - i]);
#pragma unroll
    for (int j = 8; j > 0; j >>= 1)
#pragma unroll
        for (int i = 0; i < 16; ++i) {
            const int l = i ^ j;
            if (l > i) { const unsigned hi = umax_(a[i], a[l]), lo = umin_(a[i], a[l]); a[i] = hi; a[l] = lo; }
        }
}
HD void top16_of_64(unsigned (&g0)[16], unsigned (&g1)[16], unsigned (&g2)[16], unsigned (&g3)[16]) {
    sort16_desc(g0); sort16_desc(g1); sort16_desc(g2); sort16_desc(g3);
    merge16_desc(g0, g1); merge16_desc(g2, g3); merge16_desc(g0, g2);
}
struct PairTab { int a[64]; int b[64]; int n; };
constexpr PairTab make_pairs() {
    PairTab t{}; int n = 0;
    for (int a = 0; a < 16; ++a) for (int b = 0; b < 16; ++b) if ((a + 1) * (b + 1) <= 16) { t.a[n] = a; t.b[n] = b; ++n; }
    t.n = n; for (int i = n; i < 64; ++i) { t.a[i] = 0; t.b[i] = 0; }
    return t;
}
#undef HD
typedef float f32x16 __attribute__((ext_vector_type(16)));
#define PLAS __attribute__((address_space(3)))
static constexpr PairTab PT = make_pairs();
__device__ __forceinline__ constexpr int crow_c(int r) { return (r & 3) + 8 * (r >> 2); }
__device__ __forceinline__ void phase_peer_select(const Params& p, unsigned char* lds_generic) {
    const unsigned char* ws = p.ws;
    const int tid = tid_opaque(), lane = tid & 63, wid = __builtin_amdgcn_readfirstlane(tid >> 6), r32 = lane & 31, hi = lane >> 5;
    PLAS int* tab = (PLAS int*)((PLAS unsigned char*)lds_generic) + wid * 2048;
    const int gw = (int)blockIdx.x * (NTHREADS / 64) + wid, ngw = (int)gridDim.x * (NTHREADS / 64);
    const __amdgpu_buffer_rsrc_t rq = __builtin_amdgcn_make_buffer_rsrc((void*)(p.ws + WS_QP), (short)0, (int)((size_t)NTOK * PQ * 2), 0x00020000);
    const __amdgpu_buffer_rsrc_t rk = __builtin_amdgcn_make_buffer_rsrc((void*)(p.ws + WS_PKEYS), (short)0, 16 * 128 * 128 * 2, 0x00020000);
    for (int task = gw; task < (NTOK / 32) * PH; task += ngw) {
        const int tb = task >> 3, h = task & 7, tok = 32 * tb + r32;
        int hi4 = 4 * hi; asm volatile("" : "+v"(hi4));
        unsigned k1[16], k2[16];
#pragma unroll
        for (int c = 0; c < 2; ++c) {
            const int hc = h * 2 + c;
            const unsigned qoff = (unsigned)(r32 * PQ + 8 * hi) * 2u, koff = (unsigned)(r32 * 128 + 8 * hi) * 2u;
            const int qso = (tb * 32 * PQ + hc * 128) * 2, kso = hc * 128 * 128 * 2;
            bf16x8 qf[8];
#pragma unroll
            for (int d0 = 0; d0 < 8; ++d0) qf[d0] = __builtin_bit_cast(bf16x8, __builtin_amdgcn_raw_buffer_load_b128(rq, (int)qoff, qso + 32 * d0, 0));
            unsigned g[4][16];
#pragma unroll
            for (int nt = 0; nt < 4; ++nt) {
                f32x16 acc;
#pragma unroll
                for (int r = 0; r < 16; ++r) acc[r] = 0.f;
#pragma unroll
                for (int d0 = 0; d0 < 8; ++d0) {
                    const bf16x8 kf = __builtin_bit_cast(bf16x8, __builtin_amdgcn_raw_buffer_load_b128(rk, (int)koff, kso + nt * 8192 + 32 * d0, 0));
                    acc = __builtin_amdgcn_mfma_f32_32x32x16_bf16(kf, qf[d0], acc, 0, 0, 0);
                }
#pragma unroll
                for (int r = 0; r < 16; ++r) g[nt][r] = (f2ord(acc[r]) & 0xFFFFFF80u) | (unsigned)((127 - 32 * nt - crow_c(r)) - hi4);
                __builtin_amdgcn_sched_barrier(0);
            }
            top16_of_64(g[0], g[1], g[2], g[3]);
            unsigned pb[16];
#pragma unroll
            for (int i = 0; i < 16; ++i) pb[i] = (unsigned)__shfl_xor((int)g[0][i], 32);
            merge16_desc(g[0], pb);
#pragma unroll
            for (int i = 0; i < 16; ++i) { if (c == 0) k1[i] = g[0][i]; else k2[i] = g[0][i]; }
        }
        float v1[16], v2[16];
#pragma unroll
        for (int i = 0; i < 16; ++i) { v1[i] = ord2f(k1[i] & 0xFFFFFF80u); v2[i] = ord2f(k2[i] & 0xFFFFFF80u); }
        unsigned cg[4][16];
#pragma unroll
        for (int s = 0; s < 64; ++s) {
            unsigned key = 0u;
            if (s < PT.n) key = (f2ord(v1[PT.a[s]] + v2[PT.b[s]]) & 0xFFFFFF00u) | (unsigned)(255 - (PT.a[s] * 16 + PT.b[s]));
            cg[s >> 4][s & 15] = key;
        }
        top16_of_64(cg[0], cg[1], cg[2], cg[3]);
#pragma unroll
        for (int i = 0; i < 16; ++i) { tab[i * 64 + lane] = 127 - (int)(k1[i] & 127u); tab[(16 + i) * 64 + lane] = 127 - (int)(k2[i] & 127u); }
        __builtin_amdgcn_fence(__ATOMIC_RELEASE, "wavefront"); __builtin_amdgcn_wave_barrier();
        int eo[16]; float ge[16]; float gsum = 0.f;
        const float top = ord2f(cg[0][0] & 0xFFFFFF00u);
#pragma unroll
        for (int k = 0; k < 16; ++k) {
            const int ab = 255 - (int)(cg[0][k] & 255u);
            eo[k] = tab[(ab >> 4) * 64 + lane] * PNK + tab[(16 + (ab & 15)) * 64 + lane];
            ge[k] = __expf(ord2f(cg[0][k] & 0xFFFFFF00u) - top); gsum += ge[k];
        }
        __builtin_amdgcn_wave_barrier();
        const float ginv = 1.0f / gsum;
        if (hi == 0) {
            int* eout = (int*)(p.ws + WS_EIDX) + (size_t)tok * 128 + h * 16;
            float* gout = (float*)(p.ws + WS_GATE) + (size_t)tok * 128 + h * 16;
#pragma unroll
            for (int q = 0; q < 4; ++q) {
                *(u32x4*)(eout + 4 * q) = (u32x4){(unsigned)eo[4 * q], (unsigned)eo[4 * q + 1], (unsigned)eo[4 * q + 2], (unsigned)eo[4 * q + 3]};
                *(f32x4*)(gout + 4 * q) = (f32x4){ge[4 * q] * ginv, ge[4 * q + 1] * ginv, ge[4 * q + 2] * ginv, ge[4 * q + 3] * ginv};
            }
        }
    }
}
}

namespace att {
typedef float f32x16 __attribute__((ext_vector_type(16)));
typedef short s16x4 __attribute__((ext_vector_type(4)));
typedef short v4i16_t __attribute__((ext_vector_type(4)));
#define ALAS __attribute__((address_space(3)))
typedef ALAS unsigned char* lptr;
constexpr int L_K = 0, L_V = 16384, L_IMP = 32768, L_SELM = L_IMP + 64 * 129 * 4, L_UNION = L_SELM + 1024, L_WSCR = L_UNION + 16, L_ACC = L_WSCR + 8 * 256, L_END = L_ACC + 8 * 8192;
constexpr float LOG2E = 1.4426950408889634f;
constexpr float THR = 10.0f;
__device__ __forceinline__ constexpr int crow_c(int r) { return (r & 3) + 8 * (r >> 2); }
__device__ __forceinline__ unsigned cvtpk(float lo, float hi) { typedef float f2 __attribute__((ext_vector_type(2))); typedef __bf16 b2 __attribute__((ext_vector_type(2)));
    f2 v = {lo, hi}; b2 b = __builtin_convertvector(v, b2); return __builtin_bit_cast(unsigned, b); }
__device__ __forceinline__ s16x4 vtr(lptr p) { return __builtin_bit_cast(s16x4, __builtin_amdgcn_ds_read_tr16_b64_v4i16((ALAS v4i16_t*)p)); }

struct Stage { u32x4 k, v; };
__device__ __forceinline__ void stage_load(const bf16_t* Kt, const bf16_t* Vt, int wid, int lane, Stage& s, bool withV) {
    s.k = *(const u32x4*)(Kt + (size_t)lane * 64 + wid * 8);
    if (withV) s.v = *(const u32x4*)(Vt + (size_t)(16 * (wid & 3) + (lane >> 2)) * 64 + (wid >> 2) * 32 + (lane & 3) * 8);
}
__device__ __forceinline__ void stage_store(lptr kbuf, lptr vbuf, int wid, int lane, const Stage& s, bool withV) {
    *(ALAS u32x4*)(kbuf + wid * 1024 + lane * 16) = s.k;
    if (withV) *(ALAS u32x4*)(vbuf + wid * 1024 + lane * 16) = s.v;
}
__device__ __forceinline__ void qk_tile(f32x16& p0, f32x16& p1, lptr kbuf, const bf16x8 (&qf)[4], float cb, float sk, int r32, int hi) {
    asm volatile("" : "+v"(sk));
    const float cb2 = cb + sk * (float)(4 * hi);
#pragma unroll
    for (int r = 0; r < 16; ++r) { p0[r] = cb2 + sk * (float)crow_c(r); p1[r] = cb2 + sk * (float)(crow_c(r) + 32); }
    lptr kb = kbuf + hi * 1024 + r32 * 16;
#pragma unroll
    for (int d0 = 0; d0 < 4; ++d0) {
        const bf16x8 k0 = *(const ALAS bf16x8*)(kb + d0 * 2048), k1 = *(const ALAS bf16x8*)(kb + d0 * 2048 + 512);
        p0 = __builtin_amdgcn_mfma_f32_32x32x16_bf16(k0, qf[d0], p0, 0, 0, 0);
        p1 = __builtin_amdgcn_mfma_f32_32x32x16_bf16(k1, qf[d0], p1, 0, 0, 0);
    }
}
__device__ __forceinline__ float min2f(float a, float b) { float r; asm("v_min_f32_e32 %0, %1, %2" : "=v"(r) : "v"(a), "v"(b)); return r; }
__device__ __forceinline__ void mask_tile(f32x16& p0, f32x16& p1, int hi_lim, int lo_lim, int hi) {
    int hl = hi_lim - 4 * hi, ll1 = lo_lim + 1 - 4 * hi;
    asm volatile("" : "+v"(hl), "+v"(ll1));
#pragma unroll
    for (int r = 0; r < 16; ++r) {
        const int c0 = crow_c(r), c1 = crow_c(r) + 32;
        const unsigned t0 = (unsigned)((c0 - ll1) | (hl - c0)), t1 = (unsigned)((c1 - ll1) | (hl - c1));
        p0[r] = min2f(p0[r], __uint_as_float((t0 & 0x80000000u) | 0x7f800000u));
        p1[r] = min2f(p1[r], __uint_as_float((t1 & 0x80000000u) | 0x7f800000u));
    }
}
__device__ __forceinline__ float max3f(float a, float b, float c) { float r; asm("v_max3_f32 %0, %1, %2, %3" : "=v"(r) : "v"(a), "v"(b), "v"(c)); return r; }
__device__ __forceinline__ float max2f(float a, float b) { float r; asm("v_max_f32_e32 %0, %1, %2" : "=v"(r) : "v"(a), "v"(b)); return r; }
__device__ __forceinline__ float full_sum(float x) {
    const auto rr = __builtin_amdgcn_permlane32_swap(__float_as_uint(x), __float_as_uint(x), false, false);
    return __uint_as_float(rr[0]) + __uint_as_float(rr[1]);
}
__device__ __forceinline__ float tile_max(const f32x16& p0, const f32x16& p1) {
    float a = max3f(p0[0], p0[1], p1[0]), b = max3f(p0[2], p0[3], p1[1]); a = max3f(a, p1[2], p1[3]);
#pragma unroll
    for (int r = 4; r < 16; r += 4) { a = max3f(a, p0[r], p0[r + 1]); b = max3f(b, p0[r + 2], p0[r + 3]); a = max3f(a, p1[r], p1[r + 1]); b = max3f(b, p1[r + 2], p1[r + 3]); }
    const float m = max2f(a, b);
    const auto rr = __builtin_amdgcn_permlane32_swap(__float_as_uint(m), __float_as_uint(m), false, false);
    return max2f(__uint_as_float(rr[0]), __uint_as_float(rr[1]));
}
__device__ __forceinline__ float tile_sum(const f32x16& p0, const f32x16& p1) {
    float a = p0[0] + p1[0];
#pragma unroll
    for (int r = 1; r < 16; ++r) a += p0[r] + p1[r];
    return a;
}
__device__ __forceinline__ void pack_p(u32x4 (&pw)[4], const f32x16& p0, const f32x16& p1) {
    pw[0] = (u32x4){cvtpk(p0[0], p0[1]), cvtpk(p0[2], p0[3]), cvtpk(p0[4], p0[5]), cvtpk(p0[6], p0[7])};
    pw[1] = (u32x4){cvtpk(p0[8], p0[9]), cvtpk(p0[10], p0[11]), cvtpk(p0[12], p0[13]), cvtpk(p0[14], p0[15])};
    pw[2] = (u32x4){cvtpk(p1[0], p1[1]), cvtpk(p1[2], p1[3]), cvtpk(p1[4], p1[5]), cvtpk(p1[6], p1[7])};
    pw[3] = (u32x4){cvtpk(p1[8], p1[9]), cvtpk(p1[10], p1[11]), cvtpk(p1[12], p1[13]), cvtpk(p1[14], p1[15])};
}
__device__ __forceinline__ void pv_packed(f32x16& o0, f32x16& o1, const u32x4 (&pw)[4], lptr vbuf, int lane, int hi) {
    lptr vp = vbuf + ((lane >> 4) & 1) * 32 + (lane & 3) * 8 + (4 * hi + ((lane & 15) >> 2)) * 64;
#pragma unroll
    for (int ks = 0; ks < 4; ++ks) {
        const s16x4 a = vtr(vp + ks * 1024), b = vtr(vp + ks * 1024 + 512);
        const s16x4 c = vtr(vp + 4096 + ks * 1024), d = vtr(vp + 4096 + ks * 1024 + 512);
        const bf16x8 v0 = (bf16x8){a[0], a[1], a[2], a[3], b[0], b[1], b[2], b[3]}, v1 = (bf16x8){c[0], c[1], c[2], c[3], d[0], d[1], d[2], d[3]};
        const bf16x8 pa = __builtin_bit_cast(bf16x8, pw[ks]);
        o0 = __builtin_amdgcn_mfma_f32_32x32x16_bf16(pa, v0, o0, 0, 0, 0);
        o1 = __builtin_amdgcn_mfma_f32_32x32x16_bf16(pa, v1, o1, 0, 0, 0);
    }
}
__device__ __forceinline__ void pv_tile(f32x16& o0, f32x16& o1, const f32x16& p0, const f32x16& p1, lptr vbuf, int lane, int hi) {
    u32x4 pw[4]; pack_p(pw, p0, p1);
    pv_packed(o0, o1, pw, vbuf, lane, hi);
}
__device__ __forceinline__ void ov_frags(bf16x8 (&ovf)[4], int r32, int hi) {
#pragma unroll
    for (int ks = 0; ks < 4; ++ks)
#pragma unroll
        for (int j = 0; j < 8; ++j) {
            const int q4 = 4 * ks + 2 * (j >> 2) + hi;
            const bool on = (r32 == q4) || ((j & 3) == 3 && r32 == q4 + 1);
            ovf[ks][j] = on ? (short)0x3F80 : (short)0;
        }
}
__device__ __forceinline__ void scale_rows(f32x16& o0, f32x16& o1, float f, ALAS float* wscr, int r32, int hi) {
    if (hi == 0) wscr[r32] = f;
    __builtin_amdgcn_fence(__ATOMIC_RELEASE, "wavefront"); __builtin_amdgcn_wave_barrier();
#pragma unroll
    for (int r = 0; r < 16; ++r) { const float a = wscr[crow_c(r) + 4 * hi]; o0[r] *= a; o1[r] *= a; }
    __builtin_amdgcn_wave_barrier();
}
template <bool FIRST>
__device__ __forceinline__ void acc_rows(ALAS float* accw, const f32x16& o0, const f32x16& o1, float f, ALAS float* wscr, int r32, int hi) {
    if (hi == 0) wscr[r32] = f;
    __builtin_amdgcn_fence(__ATOMIC_RELEASE, "wavefront"); __builtin_amdgcn_wave_barrier();
#pragma unroll
    for (int r = 0; r < 16; ++r) {
        const int row = crow_c(r) + 4 * hi; const float a = wscr[row];
        ALAS float* d = accw + row * 64 + r32;
        if (FIRST) { d[0] = o0[r] * a; d[32] = o1[r] * a; } else { d[0] += o0[r] * a; d[32] += o1[r] * a; }
    }
    __builtin_amdgcn_wave_barrier();
}
__device__ __forceinline__ void store_acc(ALAS float* accw, bf16_t* O, int lane) {
    __builtin_amdgcn_fence(__ATOMIC_RELEASE, "wavefront"); __builtin_amdgcn_wave_barrier();
#pragma unroll
    for (int it = 0; it < 4; ++it) {
        const int item = it * 64 + lane, row = item >> 3, ch = item & 7;
        const f32x4 x = *(const ALAS f32x4*)(accw + row * 64 + ch * 8), y = *(const ALAS f32x4*)(accw + row * 64 + ch * 8 + 4);
        u32x4 w; w.x = cvtpk(x[0], x[1]); w.y = cvtpk(x[2], x[3]); w.z = cvtpk(y[0], y[1]); w.w = cvtpk(y[2], y[3]);
        *(u32x4*)(O + (size_t)(row & 7) * D + (row >> 3) * 64 + ch * 8) = w;
    }
    __builtin_amdgcn_wave_barrier();
}
struct Br { float m, l; f32x16 o0, o1; };
__device__ __forceinline__ void attend_tile(Br& s, lptr kbuf, lptr vbuf, const bf16x8 (&qf)[4], float cb, float sk, bool domask, int hi_lim, int lo_lim, ALAS float* wscr, int lane, int r32, int hi) {
    f32x16 p0, p1;
    const float mu = (s.m < -1e29f) ? 0.f : s.m;
    qk_tile(p0, p1, kbuf, qf, cb - mu, sk, r32, hi);
    if (domask) mask_tile(p0, p1, hi_lim, lo_lim, hi);
    const float rm = tile_max(p0, p1);
    if (__any(rm + mu > s.m + THR)) {
        const float mn = fmaxf(s.m, rm + mu), alpha = __builtin_amdgcn_exp2f(s.m - mn), delta = mn - mu;
        s.l *= alpha; s.m = mn;
        scale_rows(s.o0, s.o1, alpha, wscr, r32, hi);
#pragma unroll
        for (int r = 0; r < 16; ++r) { p0[r] -= delta; p1[r] -= delta; }
    }
#pragma unroll
    for (int r = 0; r < 16; ++r) { p0[r] = __builtin_amdgcn_exp2f(p0[r]); p1[r] = __builtin_amdgcn_exp2f(p1[r]); }
    s.l += tile_sum(p0, p1);
    pv_tile(s.o0, s.o1, p0, p1, vbuf, lane, hi);
}

#define ATT_BAR() asm volatile("s_waitcnt lgkmcnt(0)\n\ts_barrier" ::: "memory")
template <int PVAR = 0>
__device__ __forceinline__ void nsa_unit(const Params& p, unsigned char* lds_generic, int b, int g, int tile) {
    lptr lds = (lptr)lds_generic;
    const int tid = tid_opaque(), lane = tid & 63, wid = __builtin_amdgcn_readfirstlane(tid >> 6), r32 = lane & 31, hi = lane >> 5;
    const int h = r32 >> 3, qi = r32 & 7, tq = 8 * wid + qi, t = 64 * tile + tq, head = g * 4 + h;
    const float slope = exp2f(-0.5f * (float)(9 + head)) * LOG2E;
    const unsigned char* ws = p.ws;
    ALAS float* imp = (ALAS float*)(lds + L_IMP);
    ALAS unsigned* selm = (ALAS unsigned*)(lds + L_SELM);
    ALAS unsigned* uni = (ALAS unsigned*)(lds + L_UNION);
    ALAS float* wscr = (ALAS float*)(lds + L_WSCR) + wid * 64;
    const bf16_t* KC = (const bf16_t*)(ws + WS_KC) + (size_t)(b * 2 + g) * NCMPP * 64;
    const bf16_t* VC = (const bf16_t*)(ws + WS_VC) + (size_t)(b * 2 + g) * NCMPP * 64;
    const bf16_t* KS = (const bf16_t*)(ws + WS_KV6 + 2 * KV6_STRIDE) + (size_t)(b * 2 + g) * T * 64;
    const bf16_t* VS = (const bf16_t*)(ws + WS_KV6 + 3 * KV6_STRIDE) + (size_t)(b * 2 + g) * T * 64;
    const bf16_t* KW = (const bf16_t*)(ws + WS_KV6 + 4 * KV6_STRIDE) + (size_t)(b * 2 + g) * T * 64;
    const bf16_t* VW = (const bf16_t*)(ws + WS_KV6 + 5 * KV6_STRIDE) + (size_t)(b * 2 + g) * T * 64;
    const float* gs = (const float*)(ws + WS_GSIG) + (size_t)(b * T + t) * 24 + head * 3;
    bf16x8 qf[4];
    {
        const bf16_t* qp = (const bf16_t*)(ws + WS_QN) + ((size_t)(b * 8 + head) * T + t) * 64 + 8 * hi;
#pragma unroll
        for (int d0 = 0; d0 < 4; ++d0) qf[d0] = *(const bf16x8*)(qp + 16 * d0);
    }
    for (int i = tid; i < 64 * 129; i += NTHREADS) imp[i] = 0.f;
    if (tid < 4) uni[tid] = 0u;
    ALAS float* accw = (ALAS float*)(lds + L_ACC) + wid * 2048;
    const int nc = 4 * tile + 3, n = (nc + 63) >> 6, n2 = 2 * n;
    const int nw = (tile < 8) ? tile + 1 : 9, NS = n2 + nw;
#define GK(x) ((x) < n2 ? KC + (size_t)((x) < n ? (x) : (x) - n) * 4096 : ((x) < NS ? KW + (size_t)(tile - ((x) - n2)) * 4096 : KS + (size_t)tile * 4096))
#define GV(x) ((x) < n2 ? VC + (size_t)((x) < n ? (x) : (x) - n) * 4096 : ((x) < NS ? VW + (size_t)(tile - ((x) - n2)) * 4096 : VS + (size_t)tile * 4096))
#define PIPE_HEAD(x) do { if ((x) + 2 <= NS) stage_load(GK((x) + 2), GV((x) + 2), wid, lane, sB, true); } while (0)
#define PIPE_TAIL(x) do { if ((x) + 1 <= NS) stage_store(lds + L_K + (cur ^ 1) * 8192, lds + L_V + (cur ^ 1) * 8192, wid, lane, sA, true); ATT_BAR(); cur ^= 1; sA = sB; } while (0)
    Stage sA, sB; int cur = 0;
    stage_load(GK(0), GV(0), wid, lane, sA, true);
    stage_store(lds + L_K, lds + L_V, wid, lane, sA, true);
    ATT_BAR();
    stage_load(GK(1), GV(1), wid, lane, sA, true);
    const int cmax = (t >= 31) ? ((t - 31) >> 4) : -1;
    const float skc = 16.0f * slope, cbc = -slope * (float)(t - 31);
    float mc = -1e30f, lc = 0.f;
    for (int x = 0; x < n; ++x) {
        PIPE_HEAD(x);
        const int i = x;
        if (!(PVAR & 1)) {
        f32x16 p0, p1;
        qk_tile(p0, p1, lds + L_K + cur * 8192, qf, cbc + skc * (float)(64 * i), skc, r32, hi);
        if (__any(cmax - 64 * i < 63)) mask_tile(p0, p1, cmax - 64 * i, -1, hi);
        const float rm = tile_max(p0, p1), mn = fmaxf(mc, rm);
#pragma unroll
        for (int r = 0; r < 16; ++r) { p0[r] = __builtin_amdgcn_exp2f(p0[r] - mn); p1[r] = __builtin_amdgcn_exp2f(p1[r] - mn); }
        lc = lc * __builtin_amdgcn_exp2f(mc - mn) + tile_sum(p0, p1); mc = mn;
        }
        PIPE_TAIL(x);
    }
    {
        lc = full_sum(lc);
        const float nrm = (lc > 0.f) ? (mc + __builtin_amdgcn_logf(lc)) : 0.f;
        Br sc; sc.m = 0.f; sc.l = 0.f;
#pragma unroll
        for (int r = 0; r < 16; ++r) { sc.o0[r] = 0.f; sc.o1[r] = 0.f; }
        bf16x8 ovf[4]; ov_frags(ovf, r32, hi);
        for (int x = n; x < n2; ++x) {
            PIPE_HEAD(x);
            const int i = x - n;
            if (!(PVAR & 2)) {
            f32x16 p0, p1;
            qk_tile(p0, p1, lds + L_K + cur * 8192, qf, cbc + skc * (float)(64 * i) - nrm, skc, r32, hi);
            if (__any(cmax - 64 * i < 63)) mask_tile(p0, p1, cmax - 64 * i, -1, hi);
#pragma unroll
            for (int r = 0; r < 16; ++r) { p0[r] = __builtin_amdgcn_exp2f(p0[r]); p1[r] = __builtin_amdgcn_exp2f(p1[r]); }
            u32x4 pw[4]; pack_p(pw, p0, p1);
            pv_packed(sc.o0, sc.o1, pw, lds + L_V + cur * 8192, lane, hi);
            f32x16 ia;
#pragma unroll
            for (int r = 0; r < 16; ++r) ia[r] = 0.f;
#pragma unroll
            for (int ks = 0; ks < 4; ++ks) ia = __builtin_amdgcn_mfma_f32_32x32x16_bf16(__builtin_bit_cast(bf16x8, pw[ks]), ovf[ks], ia, 0, 0, 0);
            const int sb = 16 * i + r32;
            if (r32 <= 16 && sb < NSEL) {
#pragma unroll
                for (int m = 0; m < 4; ++m) atomicAdd((float*)(imp + (8 * wid + 4 * hi + m) * 129 + sb), (ia[m] + ia[m + 4]) + (ia[m + 8] + ia[m + 12]));
            }
            }
            PIPE_TAIL(x);
        }
        acc_rows<true>(accw, sc.o0, sc.o1, gs[0], wscr, r32, hi);
    }
    {
        Br sw; sw.m = -1e30f; sw.l = 0.f;
#pragma unroll
        for (int r = 0; r < 16; ++r) { sw.o0[r] = 0.f; sw.o1[r] = 0.f; }
        for (int x = n2; x < NS; ++x) {
            PIPE_HEAD(x);
            const int j = tile - (x - n2);
            const float cb = -slope * (float)(t - 64 * j);
            if (!(PVAR & 4)) attend_tile(sw, lds + L_K + cur * 8192, lds + L_V + cur * 8192, qf, cb, slope, (j == tile) || (j == tile - 8), (j == tile) ? tq : 63, (j == tile - 8) ? tq : -1, wscr, lane, r32, hi);
            PIPE_TAIL(x);
        }
        acc_rows<false>(accw, sw.o0, sw.o1, gs[2] / fmaxf(full_sum(sw.l), 1e-30f), wscr, r32, hi);
    }
#undef GK
#undef GV
#undef PIPE_HEAD
#undef PIPE_TAIL
    if (!(PVAR & 16)) {
        const int q = tid >> 3, sub = tid & 7;
        unsigned kq[16];
#pragma unroll
        for (int i = 0; i < 16; ++i) {
            const int j = sub * 16 + i; float x = imp[q * 129 + j];
            if (j == 0 || j == tile || j == tile - 1) x = 1.0e4f;
            if (j > tile) x = -INFINITY;
            kq[i] = (psel::f2ord(x) & 0xFFFFFF80u) | (unsigned)(127 - j);
        }
        psel::sort16_desc(kq);
#pragma unroll
        for (int off = 1; off < 8; off <<= 1) {
            unsigned pb[16];
#pragma unroll
            for (int i = 0; i < 16; ++i) pb[i] = (unsigned)__shfl_xor((int)kq[i], off);
            psel::merge16_desc(kq, pb);
        }
        if (sub == 0) {
            unsigned w0 = 0u, w1 = 0u, w2 = 0u, w3 = 0u;
            const unsigned ninf = psel::f2ord(-INFINITY) & 0xFFFFFF80u;
#pragma unroll
            for (int i = 0; i < 16; ++i) {
                const int bj = 127 - (int)(kq[i] & 127u); const bool ok = (kq[i] & 0xFFFFFF80u) != ninf;
                const int k = bj >> 5; const unsigned bit = ok ? (1u << (bj & 31)) : 0u;
                w0 |= (k == 0) ? bit : 0u; w1 |= (k == 1) ? bit : 0u; w2 |= (k == 2) ? bit : 0u; w3 |= (k == 3) ? bit : 0u;
            }
            selm[q * 4 + 0] = w0; selm[q * 4 + 1] = w1; selm[q * 4 + 2] = w2; selm[q * 4 + 3] = w3;
            atomicOr((unsigned*)(uni + 0), w0); atomicOr((unsigned*)(uni + 1), w1); atomicOr((unsigned*)(uni + 2), w2); atomicOr((unsigned*)(uni + 3), w3);
        }
    }
    __syncthreads();
    {
        unsigned u0 = uni[0], u1 = uni[1], u2 = uni[2], u3 = uni[3];
        u0 = __builtin_amdgcn_readfirstlane(u0); u1 = __builtin_amdgcn_readfirstlane(u1); u2 = __builtin_amdgcn_readfirstlane(u2); u3 = __builtin_amdgcn_readfirstlane(u3);
        const unsigned s0 = selm[tq * 4 + 0], s1 = selm[tq * 4 + 1], s2 = selm[tq * 4 + 2], s3 = selm[tq * 4 + 3];
        Br sb_; sb_.m = -1e30f; sb_.l = 0.f;
#pragma unroll
        for (int r = 0; r < 16; ++r) { sb_.o0[r] = 0.f; sb_.o1[r] = 0.f; }
#define POP_BLOCK(j) do { if (u3) { const int bb = 31 - __builtin_clz(u3); u3 ^= 1u << bb; j = 96 + bb; } else if (u2) { const int bb = 31 - __builtin_clz(u2); u2 ^= 1u << bb; j = 64 + bb; } \
        else if (u1) { const int bb = 31 - __builtin_clz(u1); u1 ^= 1u << bb; j = 32 + bb; } else if (u0) { const int bb = 31 - __builtin_clz(u0); u0 ^= 1u << bb; j = bb; } else j = -1; } while (0)
        int j, j1, j2; POP_BLOCK(j); POP_BLOCK(j1); POP_BLOCK(j2);
        if (j1 >= 0) stage_load(KS + (size_t)j1 * 4096, VS + (size_t)j1 * 4096, wid, lane, sA, true);
        while (j >= 0) {
            if (j2 >= 0) stage_load(KS + (size_t)j2 * 4096, VS + (size_t)j2 * 4096, wid, lane, sB, true);
            const unsigned wsel = (j >> 5) == 0 ? s0 : (j >> 5) == 1 ? s1 : (j >> 5) == 2 ? s2 : s3;
            const bool mine = (wsel >> (j & 31)) & 1u;
            if (!(PVAR & 8) && __any(mine)) {
                const float cb = mine ? -slope * (float)(t - 64 * j) : -INFINITY;
                attend_tile(sb_, lds + L_K + cur * 8192, lds + L_V + cur * 8192, qf, cb, slope, j == tile, tq, -1, wscr, lane, r32, hi);
            }
            if (j1 >= 0) stage_store(lds + L_K + (cur ^ 1) * 8192, lds + L_V + (cur ^ 1) * 8192, wid, lane, sA, true);
            ATT_BAR();
            cur ^= 1; sA = sB; j = j1; j1 = j2; POP_BLOCK(j2);
        }
#undef POP_BLOCK
        acc_rows<false>(accw, sb_.o0, sb_.o1, gs[1] / fmaxf(full_sum(sb_.l), 1e-30f), wscr, r32, hi);
    }
    store_acc(accw, (bf16_t*)(p.ws + (PVAR ? WS_QP : WS_O)) + (size_t)(b * T + 64 * tile + 8 * wid) * D + g * 256, lane);
}

__device__ __forceinline__ void swa_unit(const Params& p, unsigned char* lds_generic, int b, int hh, int tile) {
    lptr lds = (lptr)lds_generic;
    const int tid = tid_opaque(), lane = tid & 63, wid = __builtin_amdgcn_readfirstlane(tid >> 6), r32 = lane & 31, hi = lane >> 5;
    const int h = r32 >> 3, qi = r32 & 7, tq = 8 * wid + qi, t = 64 * tile + tq, head = hh * 4 + h;
    const float slope = exp2f(-0.5f * (float)(head + 1)) * LOG2E;
    const unsigned char* ws = p.ws;
    ALAS float* wscr = (ALAS float*)(lds + L_WSCR) + wid * 64;
    const bf16_t* K = (const bf16_t*)(ws + WS_KSW) + (size_t)b * T * 64;
    const bf16_t* V = (const bf16_t*)(ws + WS_VSW) + (size_t)b * T * 64;
    bf16x8 qf[4];
    {
        const bf16_t* qp = (const bf16_t*)(ws + WS_QS) + ((size_t)(b * 8 + head) * T + t) * 64 + 8 * hi;
#pragma unroll
        for (int d0 = 0; d0 < 4; ++d0) qf[d0] = *(const bf16x8*)(qp + 16 * d0);
    }
    Br sw; sw.m = p.sinks[head] * LOG2E; sw.l = hi ? 0.f : 1.0f;
#pragma unroll
    for (int r = 0; r < 16; ++r) { sw.o0[r] = 0.f; sw.o1[r] = 0.f; }
    const int jlo = (tile - 2 > 0) ? tile - 2 : 0;
    Stage sA, sB; int cur = 0;
    stage_load(K + (size_t)tile * 4096, V + (size_t)tile * 4096, wid, lane, sA, true);
    stage_store(lds + L_K, lds + L_V, wid, lane, sA, true);
    ATT_BAR();
    if (tile - 1 >= jlo) stage_load(K + (size_t)(tile - 1) * 4096, V + (size_t)(tile - 1) * 4096, wid, lane, sA, true);
    for (int j = tile; j >= jlo; --j) {
        if (j - 2 >= jlo) stage_load(K + (size_t)(j - 2) * 4096, V + (size_t)(j - 2) * 4096, wid, lane, sB, true);
        const float cb = -slope * (float)(t - 64 * j);
        attend_tile(sw, lds + L_K + cur * 8192, lds + L_V + cur * 8192, qf, cb, slope, (j == tile) || (j == tile - 2), (j == tile) ? tq : 63, (j == tile - 2) ? tq : -1, wscr, lane, r32, hi);
        if (j > jlo) stage_store(lds + L_K + (cur ^ 1) * 8192, lds + L_V + (cur ^ 1) * 8192, wid, lane, sA, true);
        ATT_BAR();
        cur ^= 1; sA = sB;
    }
    ALAS float* accw = (ALAS float*)(lds + L_ACC) + wid * 2048;
    acc_rows<true>(accw, sw.o0, sw.o1, 1.0f / full_sum(sw.l), wscr, r32, hi);
    store_acc(accw, (bf16_t*)(p.ws + WS_O) + (size_t)(b * T + 64 * tile + 8 * wid) * D + 512 + hh * 256, lane);
}
__device__ __forceinline__ void swa_unit2(const Params& p, unsigned char* lds_generic, int b, int tile) {
    lptr lds = (lptr)lds_generic;
    const int tid = tid_opaque(), lane = tid & 63, wid = __builtin_amdgcn_readfirstlane(tid >> 6), r32 = lane & 31, hi = lane >> 5;
    const int h = r32 >> 3, qi = r32 & 7, tq = 8 * wid + qi, t = 64 * tile + tq;
    const unsigned char* ws = p.ws;
    ALAS float* wscr = (ALAS float*)(lds + L_WSCR) + wid * 64;
    ALAS float* accw = (ALAS float*)(lds + L_ACC) + wid * 2048;
    const bf16_t* K = (const bf16_t*)(ws + WS_KSW) + (size_t)b * T * 64;
    const bf16_t* V = (const bf16_t*)(ws + WS_VSW) + (size_t)b * T * 64;
    const int nt = (tile >= 2) ? 3 : tile + 1;
    Stage st[3];
#pragma unroll
    for (int jj = 0; jj < 3; ++jj) if (jj < nt) stage_load(K + (size_t)(tile - jj) * 4096, V + (size_t)(tile - jj) * 4096, wid, lane, st[jj], true);
#pragma unroll
    for (int jj = 0; jj < 3; ++jj) if (jj < nt) stage_store(lds + jj * 8192, lds + 24576 + jj * 8192, wid, lane, st[jj], true);
    ATT_BAR();
#pragma unroll 1
    for (int hh = 0; hh < 2; ++hh) {
        const int head = hh * 4 + h;
        const float slope = exp2f(-0.5f * (float)(head + 1)) * LOG2E;
        bf16x8 qf[4];
        {
            const bf16_t* qp = (const bf16_t*)(ws + WS_QS) + ((size_t)(b * 8 + head) * T + t) * 64 + 8 * hi;
#pragma unroll
            for (int d0 = 0; d0 < 4; ++d0) qf[d0] = *(const bf16x8*)(qp + 16 * d0);
        }
        Br sw; sw.m = p.sinks[head] * LOG2E; sw.l = hi ? 0.f : 1.0f;
#pragma unroll
        for (int r = 0; r < 16; ++r) { sw.o0[r] = 0.f; sw.o1[r] = 0.f; }
        for (int jj = 0; jj < nt; ++jj) {
            const int j = tile - jj;
            const float cb = -slope * (float)(t - 64 * j);
            attend_tile(sw, lds + jj * 8192, lds + 24576 + jj * 8192, qf, cb, slope, jj != 1, (jj == 0) ? tq : 63, (jj == 2) ? tq : -1, wscr, lane, r32, hi);
        }
        acc_rows<true>(accw, sw.o0, sw.o1, 1.0f / full_sum(sw.l), wscr, r32, hi);
        store_acc(accw, (bf16_t*)(p.ws + WS_O) + (size_t)(b * T + 64 * tile + 8 * wid) * D + 512 + hh * 256, lane);
    }
    ATT_BAR();
}
__device__ __forceinline__ void phase_swa_mfma(const Params& p, unsigned char* lds) {
    for (int u = blockIdx.x; u < BATCH * 2 * (T / 64); u += gridDim.x) swa_unit(p, lds, u >> 8, (u >> 7) & 1, u & 127);
}
template <int PVAR = 0>
__device__ __forceinline__ void phase_nsa_mfma(const Params& p, unsigned char* lds) {
    const int nu = BATCH * NSA_G * (T / 64);
    for (int i = blockIdx.x; i < nu; i += gridDim.x) {
        const int u = (i < (int)gridDim.x) ? (nu - 1 - i) : (i - (int)gridDim.x);
        nsa_unit<PVAR>(p, lds, u >> 8, (u >> 7) & 1, u & 127);
    }
}
}


namespace cmp {
#define CLAS __attribute__((address_space(3)))
constexpr int HS = 264;
__device__ __forceinline__ void compress_unit(const Params& p, unsigned char* lds_generic, int unit) {
    const unsigned char* ws = p.ws;
    const int tid = tid_opaque(), lane = tid & 63, wid = __builtin_amdgcn_readfirstlane(tid >> 6), fr = lane & 15, fq = lane >> 4;
    const int row0 = unit * 32, kv = row0 >> 11, bg = (row0 & 2047) >> 9, c0 = row0 & 511;
    const bf16_t* raw = (const bf16_t*)(ws + WS_KV6 + (size_t)kv * KV6_STRIDE) + (size_t)bg * T * 64;
    const bf16_t* W1T = (const bf16_t*)(ws + WS_W1T) + (size_t)kv * 256 * 2048;
    const bf16_t* W2T = (const bf16_t*)(ws + WS_W2T) + (size_t)kv * 64 * 256;
    const float* b1 = (const float*)(ws + WS_B1) + kv * 256;
    CLAS bf16_t* H = (CLAS bf16_t*)((CLAS unsigned char*)lds_generic);
    const int n0 = wid * 32;
    f32x4 acc[2][2];
#pragma unroll
    for (int i = 0; i < 2; ++i)
#pragma unroll
        for (int j = 0; j < 2; ++j) acc[i][j] = (f32x4){0.f, 0.f, 0.f, 0.f};
    constexpr int LS = 72;
    constexpr int A_BYTES = 32 * LS * 2, B_BYTES = 256 * LS * 2, ST_BYTES = A_BYTES + B_BYTES;
    CLAS unsigned char* sm = (CLAS unsigned char*)lds_generic;
    const int arow = tid >> 3, chunk = tid & 7;
    const bf16_t* ag = raw + (size_t)(c0 + arow) * 1024 + chunk * 8;
    const bf16_t* bgp = W1T + (size_t)arow * 2048 + chunk * 8;
    u32x4 sa, sb[4];
#define CMP_LOAD(k0_) do { if (tid < 256) sa = *(const u32x4*)(ag + (k0_)); _Pragma("unroll") for (int j_ = 0; j_ < 4; ++j_) sb[j_] = *(const u32x4*)(bgp + (size_t)j_ * 64 * 2048 + (k0_)); } while (0)
#define CMP_STORE(buf_) do { CLAS unsigned char* d_ = sm + (buf_) * ST_BYTES; if (tid < 256) *(CLAS u32x4*)(d_ + (arow * LS + chunk * 8) * 2) = sa; \
        _Pragma("unroll") for (int j_ = 0; j_ < 4; ++j_) *(CLAS u32x4*)(d_ + A_BYTES + ((arow + 64 * j_) * LS + chunk * 8) * 2) = sb[j_]; } while (0)
    CMP_LOAD(0); CMP_STORE(0);
    __syncthreads();
    for (int kt = 0; kt < 32; ++kt) {
        const int cur = kt & 1;
        if (kt + 1 < 32) CMP_LOAD((kt + 1) * 64);
        const CLAS unsigned char* As = sm + cur * ST_BYTES; const CLAS unsigned char* Bs = As + A_BYTES;
#pragma unroll
        for (int ks = 0; ks < 2; ++ks) {
            bf16x8 a[2], b[2];
#pragma unroll
            for (int i = 0; i < 2; ++i) { a[i] = *(const CLAS bf16x8*)(As + ((16 * i + fr) * LS + 32 * ks + 8 * fq) * 2); b[i] = *(const CLAS bf16x8*)(Bs + ((n0 + 16 * i + fr) * LS + 32 * ks + 8 * fq) * 2); }
#pragma unroll
            for (int i = 0; i < 2; ++i)
#pragma unroll
                for (int j = 0; j < 2; ++j) acc[i][j] = __builtin_amdgcn_mfma_f32_16x16x32_bf16(a[i], b[j], acc[i][j], 0, 0, 0);
        }
        if (kt + 1 < 32) CMP_STORE(cur ^ 1);
        __syncthreads();
    }
#undef CMP_LOAD
#undef CMP_STORE
#pragma unroll
    for (int i = 0; i < 2; ++i)
#pragma unroll
        for (int j = 0; j < 2; ++j) {
            const int n = n0 + 16 * j + fr; const float bias = b1[n];
#pragma unroll
            for (int r = 0; r < 4; ++r) H[(16 * i + 4 * fq + r) * HS + n] = (bf16_t)f2bf(gelu_tanh(acc[i][j][r] + bias));
        }
    __syncthreads();
    {
        const int mi = wid >> 2, nj = wid & 3;
        f32x4 o = (f32x4){0.f, 0.f, 0.f, 0.f};
        const CLAS bf16_t* hp = H + (16 * mi + fr) * HS + fq * 8;
        const bf16_t* wp = W2T + (size_t)(16 * nj + fr) * 256 + fq * 8;
#pragma unroll
        for (int k0 = 0; k0 < 256; k0 += 32) {
            const bf16x8 ha = *(const CLAS bf16x8*)(hp + k0), wb = *(const bf16x8*)(wp + k0);
            o = __builtin_amdgcn_mfma_f32_16x16x32_bf16(ha, wb, o, 0, 0, 0);
        }
        bf16_t* dst = (bf16_t*)(p.ws + (kv ? WS_VC : WS_KC)) + ((size_t)bg * NCMPP + c0 + 16 * mi + 4 * fq) * 64 + 16 * nj + fr;
#pragma unroll
        for (int r = 0; r < 4; ++r) dst[(size_t)r * 64] = (bf16_t)f2bf(o[r]);
    }
    __syncthreads();
}
__device__ __forceinline__ void phase_compress_swa(const Params& p, unsigned char* lds) {
    const int G = (int)gridDim.x, bx = (int)blockIdx.x;
    if (G >= 256) {
        if (bx < 128) { compress_unit(p, lds, bx); convert_expert_tables(p, 0, bx, 128); }
        else { for (int u = bx - 128; u < BATCH * (T / 64); u += G - 128) att::swa_unit2(p, lds, u >> 7, u & 127);
               convert_expert_tables(p, 1, bx - 128, G - 128); }
    } else {
        for (int u = bx; u < 128; u += G) compress_unit(p, lds, u);
        for (int u = bx; u < BATCH * (T / 64); u += G) att::swa_unit2(p, lds, u >> 7, u & 127);
        convert_expert_tables(p, 2, bx, G);
    }
}
}

#define XB_TMO      128
#define XB_XCNT(j)  (256  + 64 * (j))
#define XB_XSUB(j)  (1280 + 64 * (j))
#define XB_XGEN(j)  (2304 + 64 * (j))
#define XB_TOP      3328
#define XB_TOPGEN   3392
#define XCD_BAR_WORDS 3456
#define XB_SPIN_CAP (1u << 18)
#define XLAS __attribute__((address_space(3)))

__device__ __forceinline__ unsigned xb_ld(unsigned* p)              { return __hip_atomic_load(p, __ATOMIC_RELAXED, __HIP_MEMORY_SCOPE_AGENT); }
__device__ __forceinline__ unsigned xb_add(unsigned* p, unsigned v) { return __hip_atomic_fetch_add(p, v, __ATOMIC_RELAXED, __HIP_MEMORY_SCOPE_AGENT); }
__device__ __forceinline__ unsigned xb_xcc_id() { return (unsigned)__builtin_amdgcn_s_getreg((3 << 11) | 20) & 0xFu; }
#define XB_SPIN(cond, bar) do { unsigned _sp = 0; while (cond) { __builtin_amdgcn_s_sleep(1); \
    if ((++_sp & 255u) == 0u) { if (xb_ld(&(bar)[XB_TMO])) break; if (_sp > XB_SPIN_CAP) { atomicAdd(&(bar)[XB_TMO], 1u); break; } } } } while (0)

struct XcdBarrier {
    unsigned* bar; unsigned x;
    volatile XLAS unsigned* st;
};

__device__ __forceinline__ XcdBarrier xcd_barrier_post(unsigned* bar, volatile XLAS unsigned* st) {
    XcdBarrier b; b.bar = bar; b.x = xb_xcc_id(); b.st = st;
    if (threadIdx.x == 0) (void)xb_add(&bar[XB_XCNT(b.x)], 1u);
    return b;
}
__device__ __forceinline__ void xcd_barrier_complete(unsigned* bar, unsigned x, unsigned& nloc, unsigned& nx) {
    const unsigned G = gridDim.x * gridDim.y * gridDim.z;
    unsigned sum, cnt, mine, sp = 0u;
    for (;;) {
        sum = 0u; cnt = 0u; mine = 0u;
#pragma unroll
        for (unsigned j = 0; j < 16; ++j) { const unsigned c = xb_ld(&bar[XB_XCNT(j)]); sum += c; cnt += (c > 0u) ? 1u : 0u; mine = (j == x) ? c : mine; }
        if (sum == G) break;
        __builtin_amdgcn_s_sleep(1);
        if ((++sp & 255u) == 0u) { if (xb_ld(&bar[XB_TMO])) break; if (sp > XB_SPIN_CAP) { atomicAdd(&bar[XB_TMO], 1u); break; } }
    }
    nloc = mine > 0u ? mine : 1u; nx = cnt > 0u ? cnt : 1u;
}

__device__ __forceinline__ void xcd_barrier(const XcdBarrier& b) {
    asm volatile("s_waitcnt vmcnt(0)" ::: "memory");
    __syncthreads();
    if (threadIdx.x == 0) {
        unsigned* bar = b.bar;
        __builtin_amdgcn_s_waitcnt(0);
        unsigned nloc = b.st[0], nx = b.st[1];
        if (nloc == 0u) { xcd_barrier_complete(bar, b.x, nloc, nx); b.st[0] = nloc; b.st[1] = nx; }
        const unsigned old = xb_add(&bar[XB_XSUB(b.x)], 1u);
        const unsigned gen = old / nloc;
        if (old + 1u == (gen + 1u) * nloc) {
            __builtin_amdgcn_fence(__ATOMIC_RELEASE, "agent");
            asm volatile("s_waitcnt vmcnt(0)" ::: "memory");
            const unsigned og = xb_add(&bar[XB_TOP], 1u);
            const unsigned tg = og / nx;
            if (og + 1u == (tg + 1u) * nx) xb_add(&bar[XB_TOPGEN], 1u);
            else XB_SPIN(xb_ld(&bar[XB_TOPGEN]) == tg, bar);
            __builtin_amdgcn_fence(__ATOMIC_ACQUIRE, "agent");
            xb_add(&bar[XB_XGEN(b.x)], 1u);
            asm volatile("s_waitcnt vmcnt(0)" ::: "memory");
        } else {
            XB_SPIN(xb_ld(&bar[XB_XGEN(b.x)]) == gen, bar);
            __builtin_amdgcn_fence(__ATOMIC_ACQUIRE, "agent");
            asm volatile("s_waitcnt vmcnt(0)" ::: "memory");
        }
    }
    __syncthreads();
}


namespace pex {
constexpr int TOK_PER_TICKET = 8, NTICKET = NTOK / TOK_PER_TICKET;
__device__ __forceinline__ int claim(unsigned* ctr, int lane) {
    unsigned t = 0u;
    if (lane == 0) t = __hip_atomic_fetch_add(ctr, 1u, __ATOMIC_RELAXED, __HIP_MEMORY_SCOPE_AGENT);
    return __builtin_amdgcn_readfirstlane((int)t);
}
struct UMeta { int e_lo, e_hi; float g_lo, g_hi; u32x4 h0, h1; float ss; };
__device__ __forceinline__ void u_meta(const unsigned char* ws, int tok, int lane, unsigned loff, UMeta& m) {
    const int* ep = (const int*)(ws + WS_EIDX) + (size_t)tok * 128;
    m.e_lo = ep[lane]; m.e_hi = ep[64 + lane];
    const float* gp = (const float*)(ws + WS_GATE) + (size_t)tok * 128;
    m.g_lo = gp[lane]; m.g_hi = gp[64 + lane];
    const bf16_t* hg = (const bf16_t*)(ws + WS_H1G + (size_t)tok * D * 2) + loff;
    m.h0 = *(const u32x4*)hg; m.h1 = *(const u32x4*)(hg + 8);
    m.ss = ((const float*)(ws + WS_SS2))[tok];
}
constexpr int UB = 16;
__device__ __forceinline__ void u_task(const unsigned char* ws, int tok, int y, int lane, unsigned loff, const UMeta& m, int tok_next, UMeta& mn) {
    unsigned long long m0 = __ballot((m.e_lo >> 11) == y), m1 = __ballot((m.e_hi >> 11) == y);
    const unsigned char* U = ws + WS_U8;
    const int grp = (lane >> 3) & 7;
    bool first = true;
    f32x2 a2[8]; float rstd2 = 0.f;
    do {
        int slot[UB]; u32x4 uw[UB];
#pragma unroll
        for (int k = 0; k < UB; ++k) {
            int e = 0; slot[k] = -1;
            if (m0 != 0ull) { const int j = __builtin_ctzll(m0); m0 &= m0 - 1ull; slot[k] = j; e = __builtin_amdgcn_readlane(m.e_lo, j); }
            else if (m1 != 0ull) { const int j = __builtin_ctzll(m1); m1 &= m1 - 1ull; slot[k] = 64 + j; e = __builtin_amdgcn_readlane(m.e_hi, j); }
            if (slot[k] >= 0) uw[k] = *(const u32x4*)(U + (size_t)e * D + loff); else uw[k] = (u32x4){0u, 0u, 0u, 0u};
        }
        if (first) {
            if (tok_next >= 0) u_meta(ws, tok_next, lane, loff, mn);
            const u32x4 w0 = m.h0, w1 = m.h1;
            a2[0] = (f32x2){bflo(w0.x), bfhi(w0.x)}; a2[1] = (f32x2){bflo(w0.y), bfhi(w0.y)}; a2[2] = (f32x2){bflo(w0.z), bfhi(w0.z)}; a2[3] = (f32x2){bflo(w0.w), bfhi(w0.w)};
            a2[4] = (f32x2){bflo(w1.x), bfhi(w1.x)}; a2[5] = (f32x2){bflo(w1.y), bfhi(w1.y)}; a2[6] = (f32x2){bflo(w1.z), bfhi(w1.z)}; a2[7] = (f32x2){bflo(w1.w), bfhi(w1.w)};
            rstd2 = (1.0f / U8_SCALE) / sqrtf(m.ss * (1.0f / D) + EPS);
            first = false;
        }
#pragma unroll
        for (int hb = 0; hb < UB / 8; ++hb) {
            if (slot[8 * hb] < 0) break;
            float d[8];
#pragma unroll
            for (int k = 0; k < 8; ++k) {
                f32x2 dd = (f32x2){0.f, 0.f};
#pragma unroll
                for (int q = 0; q < 4; ++q) {
                    const f32x2 lo = __builtin_amdgcn_cvt_pk_f32_fp8((int)uw[8 * hb + k][q], false), hi = __builtin_amdgcn_cvt_pk_f32_fp8((int)uw[8 * hb + k][q], true);
                    dd += a2[2 * q] * lo; dd += a2[2 * q + 1] * hi;
                }
                d[k] = dd.x + dd.y;
                __builtin_amdgcn_sched_barrier(0);
            }
            const float dk = reduce8(d, lane);
            int myslot = -1;
#pragma unroll
            for (int k = 0; k < 8; ++k) myslot = (grp == k) ? slot[8 * hb + k] : myslot;
            const float gA = __shfl(m.g_lo, myslot & 63), gB = __shfl(m.g_hi, myslot & 63);
            const float g = (myslot & 64) ? gB : gA;
            if (myslot >= 0 && (lane & 7) == 0) ((float*)(ws + WS_PW))[(size_t)tok * 128 + myslot] = g * gelu_tanh(dk * rstd2);
        }
    } while ((m0 | m1) != 0ull);
}
struct VMeta { u32x4 e[4]; };
__device__ __forceinline__ void v_meta(const Params& p, int tok, int y, int lane, VMeta& m) {
    const unsigned char* ep = p.ws + WS_EIDX + (size_t)tok * 512;
    const unsigned eoff = (unsigned)(lane >> 3) * 64u;
#pragma unroll
    for (int q = 0; q < 4; ++q) m.e[q] = *(const u32x4*)(ep + eoff + 16 * q);
}
__device__ __forceinline__ void ucol_task(const Params& p, int tok, int y, int lane, const VMeta& m, int tok_next, VMeta& mn) {
    const int cc = lane & 7;
    const bool b2 = lane & 4, b1 = lane & 2, b0 = lane & 1;
    const __amdgpu_buffer_rsrc_t ru = __builtin_amdgcn_make_buffer_rsrc((void*)(p.ws + WS_U8 + (size_t)y * ((size_t)NEXP * 128)), (short)0, NEXP * 128, 0x00020000);
    const unsigned coff = (unsigned)cc * 16u;
    u32x4 uw[16];
#pragma unroll
    for (int q = 0; q < 4; ++q) {
        uw[4 * q] = __builtin_bit_cast(u32x4, __builtin_amdgcn_raw_buffer_load_b128(ru, (int)(m.e[q].x * 128u + coff), 0, 0));
        uw[4 * q + 1] = __builtin_bit_cast(u32x4, __builtin_amdgcn_raw_buffer_load_b128(ru, (int)(m.e[q].y * 128u + coff), 0, 0));
        uw[4 * q + 2] = __builtin_bit_cast(u32x4, __builtin_amdgcn_raw_buffer_load_b128(ru, (int)(m.e[q].z * 128u + coff), 0, 0));
        uw[4 * q + 3] = __builtin_bit_cast(u32x4, __builtin_amdgcn_raw_buffer_load_b128(ru, (int)(m.e[q].w * 128u + coff), 0, 0));
    }
    f32x2 a2[8];
    {
        const unsigned char* hp = p.ws + WS_H1G + (size_t)tok * D * 2 + (size_t)y * 256;
        const u32x4 w0 = *(const u32x4*)(hp + cc * 32u), w1 = *(const u32x4*)(hp + cc * 32u + 16u);
        a2[0] = (f32x2){bflo(w0.x), bfhi(w0.x)}; a2[1] = (f32x2){bflo(w0.y), bfhi(w0.y)}; a2[2] = (f32x2){bflo(w0.z), bfhi(w0.z)}; a2[3] = (f32x2){bflo(w0.w), bfhi(w0.w)};
        a2[4] = (f32x2){bflo(w1.x), bfhi(w1.x)}; a2[5] = (f32x2){bflo(w1.y), bfhi(w1.y)}; a2[6] = (f32x2){bflo(w1.z), bfhi(w1.z)}; a2[7] = (f32x2){bflo(w1.w), bfhi(w1.w)};
    }
    if (tok_next >= 0) v_meta(p, tok_next, y, lane, mn);
    float d[16];
#pragma unroll
    for (int i = 0; i < 16; ++i) {
        f32x2 dd = (f32x2){0.f, 0.f};
#pragma unroll
        for (int q = 0; q < 4; ++q) {
            const f32x2 lo = __builtin_amdgcn_cvt_pk_f32_fp8((int)uw[i][q], false), hi = __builtin_amdgcn_cvt_pk_f32_fp8((int)uw[i][q], true);
            dd += a2[2 * q] * lo; dd += a2[2 * q + 1] * hi;
        }
        d[i] = dd.x + dd.y;
        __builtin_amdgcn_sched_barrier(0);
    }
    float s8[8], s4[4], s2[2];
#pragma unroll
    for (int i = 0; i < 8; ++i) { const float snd = b2 ? d[i] : d[i + 8], keep = b2 ? d[i + 8] : d[i]; s8[i] = keep + __shfl_xor(snd, 4); }
#pragma unroll
    for (int i = 0; i < 4; ++i) { const float snd = b1 ? s8[i] : s8[i + 4], keep = b1 ? s8[i + 4] : s8[i]; s4[i] = keep + __shfl_xor(snd, 2); }
#pragma unroll
    for (int i = 0; i < 2; ++i) { const float snd = b0 ? s4[i] : s4[i + 2], keep = b0 ? s4[i + 2] : s4[i]; s2[i] = keep + __shfl_xor(snd, 1); }
    const unsigned so = (unsigned)(16 * (lane >> 3) + (b2 ? 8 : 0) + (b1 ? 4 : 0) + (b0 ? 2 : 0)) * 2u;
    *(unsigned*)(p.ws + WS_PART + ((size_t)tok * 8 + y) * 256 + so) = pk2(s2[0], s2[1]);
}
__device__ __forceinline__ void phase_expert_act(const Params& p) {
    const int tid_ = tid_opaque(), lane = tid_ & 63;
    const int gw = (int)blockIdx.x * (NTHREADS / 64) + __builtin_amdgcn_readfirstlane(tid_ >> 6), ngw = (int)gridDim.x * (NTHREADS / 64);
    for (int tok = gw; tok < NTOK; tok += ngw) {
        const bf16_t* pp = (const bf16_t*)(p.ws + WS_PART) + (size_t)tok * 1024;
        float sa = 0.f, sb = 0.f;
#pragma unroll
        for (int y = 0; y < (U_FP4 ? NSL4 : 8); ++y) { sa += bf2f(pp[y * 128 + lane]); sb += bf2f(pp[y * 128 + 64 + lane]); }
        const float rstd2 = ((U_FP4 && U_INT4) ? 256.0f / (UI_SCALE * HQ_SCALE) : 1.0f / (U_FP4 ? U4_SCALE : U8_SCALE)) / sqrtf(((const float*)(p.ws + WS_SS2))[tok] * (1.0f / D) + EPS);
        const float* gp = (const float*)(p.ws + WS_GATE) + (size_t)tok * 128;
        float* wp = (float*)(p.ws + WS_PW) + (size_t)tok * 128;
        const float wa = gp[lane] * gelu_tanh(sa * rstd2), wb = gp[64 + lane] * gelu_tanh(sb * rstd2);
        wp[lane] = wa; wp[64 + lane] = wb;
        if (V_MFMA) {
            float mx = fmaxf(fabsf(wa), fabsf(wb));
#pragma unroll
            for (int o = 1; o < 64; o <<= 1) mx = fmaxf(mx, __shfl_xor(mx, o));
            mx = fmaxf(mx, 1e-30f);
            const int ex = (int)((__float_as_uint(mx) >> 23) & 255u) - 126;
            const float sc = __uint_as_float((unsigned)(127 + 8 - ex) << 23);
            unsigned char* row = p.ws + WS_VREC + (size_t)tok * 1024 + 512;
            ((int*)(row - 512))[lane] = ((const int*)(p.ws + WS_EIDX))[(size_t)tok * 128 + lane]; ((int*)(row - 512))[64 + lane] = ((const int*)(p.ws + WS_EIDX))[(size_t)tok * 128 + 64 + lane];
#pragma unroll
            for (int hf = 0; hf < 2; ++hf) {
                const int o = 64 * hf + lane;
                const int sg = 8 * (o & 15) + (o >> 4);
                const int G = sg >> 5, rho = sg & 31, pos = (((rho >> 2) & 3) * 4 + G) * 8 + (rho >> 4) * 4 + (rho & 3);
                const float x = (hf ? wb : wa) * sc;
                const int b0 = __builtin_amdgcn_cvt_pk_fp8_f32(x, x, 0, false) & 255;
                const float r1 = (x - __builtin_amdgcn_cvt_f32_fp8(b0, 0)) * 16.0f;
                const int b1 = __builtin_amdgcn_cvt_pk_fp8_f32(r1, r1, 0, false) & 255;
                const float r2 = (r1 - __builtin_amdgcn_cvt_f32_fp8(b1, 0)) * 16.0f;
                const int b2 = __builtin_amdgcn_cvt_pk_fp8_f32(r2, r2, 0, false) & 255;
                row[pos] = (unsigned char)b0; row[128 + pos] = (unsigned char)b1; row[256 + pos] = (unsigned char)b2;
            }
            if (lane == 0) *(float*)(row + 384) = __uint_as_float((unsigned)(127 + ex - 8) << 23) * (1.0f / V4_SCALE);
        }
    }
}
__device__ __forceinline__ void v_task(const Params& p, int tok, int y, int lane, const VMeta& m, int tok_next, VMeta& mn) {
    const int cc = lane & 7;
    const bool b5 = lane & 32, b4 = lane & 16, b3 = lane & 8;
    const __amdgpu_buffer_rsrc_t rv = __builtin_amdgcn_make_buffer_rsrc((void*)(p.ws + WS_V8 + (size_t)y * ((size_t)NEXP * 128)), (short)0, NEXP * 128, 0x00020000);
    const unsigned coff = (unsigned)cc * 16u;
    u32x4 vw[16];
#pragma unroll
    for (int q = 0; q < 4; ++q) {
        vw[4 * q] = __builtin_bit_cast(u32x4, __builtin_amdgcn_raw_buffer_load_b128(rv, (int)(m.e[q].x * 128u + coff), 0, 0));
        vw[4 * q + 1] = __builtin_bit_cast(u32x4, __builtin_amdgcn_raw_buffer_load_b128(rv, (int)(m.e[q].y * 128u + coff), 0, 0));
        vw[4 * q + 2] = __builtin_bit_cast(u32x4, __builtin_amdgcn_raw_buffer_load_b128(rv, (int)(m.e[q].z * 128u + coff), 0, 0));
        vw[4 * q + 3] = __builtin_bit_cast(u32x4, __builtin_amdgcn_raw_buffer_load_b128(rv, (int)(m.e[q].w * 128u + coff), 0, 0));
    }
    f32x4 w[4];
    {
        const unsigned char* wp = p.ws + WS_PW + (size_t)tok * 512;
        const unsigned woff = (unsigned)(lane >> 3) * 64u;
#pragma unroll
        for (int q = 0; q < 4; ++q) w[q] = *(const f32x4*)(wp + woff + 16 * q);
    }
    const unsigned colb = (unsigned)(128 * y + 16 * cc + (b5 ? 8 : 0) + (b4 ? 4 : 0) + (b3 ? 2 : 0)) * 4u;
    const unsigned hb = *(const unsigned*)(p.ws + WS_H1G + (size_t)tok * D * 2 + (colb >> 1));
    const f32x2 g2v = *(const f32x2*)((const unsigned char*)p.ln2_g + colb);
    const f32x2 h = (f32x2){bflo(hb) / g2v.x, bfhi(hb) / g2v.y};
    if (tok_next >= 0) v_meta(p, tok_next, y, lane, mn);
    f32x2 acc2[8];
#pragma unroll
    for (int q = 0; q < 8; ++q) acc2[q] = (f32x2){0.f, 0.f};
#pragma unroll
    for (int i = 0; i < 16; ++i) {
        const float wi = w[i >> 2][i & 3];
#pragma unroll
        for (int q = 0; q < 4; ++q) {
            const f32x2 lo = __builtin_amdgcn_cvt_pk_f32_fp8((int)vw[i][q], false), hi = __builtin_amdgcn_cvt_pk_f32_fp8((int)vw[i][q], true);
            acc2[2 * q] += lo * wi; acc2[2 * q + 1] += hi * wi;
        }
        __builtin_amdgcn_sched_barrier(0);
    }
    float acc[16];
#pragma unroll
    for (int q = 0; q < 8; ++q) { acc[2 * q] = acc2[q].x; acc[2 * q + 1] = acc2[q].y; }
    float s8[8], s4[4], s2[2];
#pragma unroll
    for (int i = 0; i < 8; ++i) { const float snd = b5 ? acc[i] : acc[i + 8], keep = b5 ? acc[i + 8] : acc[i]; s8[i] = keep + __shfl_xor(snd, 32); }
#pragma unroll
    for (int i = 0; i < 4; ++i) { const float snd = b4 ? s8[i] : s8[i + 4], keep = b4 ? s8[i + 4] : s8[i]; s4[i] = keep + __shfl_xor(snd, 16); }
#pragma unroll
    for (int i = 0; i < 2; ++i) { const float snd = b3 ? s4[i] : s4[i + 2], keep = b3 ? s4[i + 2] : s4[i]; s2[i] = keep + __shfl_xor(snd, 8); }
    *(unsigned*)(p.ws + WS_H2 + (size_t)tok * D * 2 + (colb >> 1)) = pk2(h.x + s2[0] * (1.0f / V8_SCALE), h.y + s2[1] * (1.0f / V8_SCALE));
}

__device__ __forceinline__ void unpack32_fp4(const u32x4& w, f32x2 (&f)[16]) {
#pragma unroll
    for (int q = 0; q < 4; ++q) {
        f[4 * q + 0] = __builtin_amdgcn_cvt_scalef32_pk_f32_fp4(w[q], 1.0f, 0);
        f[4 * q + 1] = __builtin_amdgcn_cvt_scalef32_pk_f32_fp4(w[q], 1.0f, 1);
        f[4 * q + 2] = __builtin_amdgcn_cvt_scalef32_pk_f32_fp4(w[q], 1.0f, 2);
        f[4 * q + 3] = __builtin_amdgcn_cvt_scalef32_pk_f32_fp4(w[q], 1.0f, 3);
    }
}
__device__ __forceinline__ void ucol4_task(const Params& p, int tok, int z, int lane, const VMeta& m, int tok_next, VMeta& mn) {
    const int cc = lane & 7;
    const bool b2 = lane & 4, b1 = lane & 2, b0 = lane & 1;
    const __amdgpu_buffer_rsrc_t ru = __builtin_amdgcn_make_buffer_rsrc((void*)(p.ws + WS_U8 + (size_t)z * ((size_t)NEXP * 128)), (short)0, NEXP * 128, 0x00020000);
    const unsigned coff = (unsigned)cc * 16u;
    u32x4 uw[16];
#pragma unroll
    for (int q = 0; q < 4; ++q) {
        uw[4 * q] = __builtin_bit_cast(u32x4, __builtin_amdgcn_raw_buffer_load_b128(ru, (int)(m.e[q].x * 128u + coff), 0, 0));
        uw[4 * q + 1] = __builtin_bit_cast(u32x4, __builtin_amdgcn_raw_buffer_load_b128(ru, (int)(m.e[q].y * 128u + coff), 0, 0));
        uw[4 * q + 2] = __builtin_bit_cast(u32x4, __builtin_amdgcn_raw_buffer_load_b128(ru, (int)(m.e[q].z * 128u + coff), 0, 0));
        uw[4 * q + 3] = __builtin_bit_cast(u32x4, __builtin_amdgcn_raw_buffer_load_b128(ru, (int)(m.e[q].w * 128u + coff), 0, 0));
    }
    f32x2 a2[16];
    {
        const unsigned char* hp = p.ws + WS_H1G + (size_t)tok * D * 2 + (size_t)z * 512 + cc * 64u;
#pragma unroll
        for (int q = 0; q < 4; ++q) {
            const u32x4 w = *(const u32x4*)(hp + 16 * q);
            a2[4 * q] = (f32x2){bflo(w.x), bfhi(w.x)}; a2[4 * q + 1] = (f32x2){bflo(w.y), bfhi(w.y)}; a2[4 * q + 2] = (f32x2){bflo(w.z), bfhi(w.z)}; a2[4 * q + 3] = (f32x2){bflo(w.w), bfhi(w.w)};
        }
    }
    if (tok_next >= 0) v_meta(p, tok_next, z, lane, mn);
    float d[16];
#pragma unroll
    for (int i = 0; i < 16; ++i) {
        f32x2 uf[16]; unpack32_fp4(uw[i], uf);
        f32x2 dd = (f32x2){0.f, 0.f};
#pragma unroll
        for (int q = 0; q < 16; ++q) dd += a2[q] * uf[q];
        d[i] = dd.x + dd.y;
        __builtin_amdgcn_sched_barrier(0);
    }
    float s8[8], s4[4], s2[2];
#pragma unroll
    for (int i = 0; i < 8; ++i) { const float snd = b2 ? d[i] : d[i + 8], keep = b2 ? d[i + 8] : d[i]; s8[i] = keep + __shfl_xor(snd, 4); }
#pragma unroll
    for (int i = 0; i < 4; ++i) { const float snd = b1 ? s8[i] : s8[i + 4], keep = b1 ? s8[i + 4] : s8[i]; s4[i] = keep + __shfl_xor(snd, 2); }
#pragma unroll
    for (int i = 0; i < 2; ++i) { const float snd = b0 ? s4[i] : s4[i + 2], keep = b0 ? s4[i + 2] : s4[i]; s2[i] = keep + __shfl_xor(snd, 1); }
    const unsigned so = (unsigned)(16 * (lane >> 3) + (b2 ? 8 : 0) + (b1 ? 4 : 0) + (b0 ? 2 : 0)) * 2u;
    *(unsigned*)(p.ws + WS_PART + ((size_t)tok * 8 + z) * 256 + so) = pk2(s2[0], s2[1]);
}
__device__ __forceinline__ void v4_task(const Params& p, int tok, int z, int lane, const VMeta& m, int tok_next, VMeta& mn) {
    const int cc = lane & 7;
    const bool b5 = lane & 32, b4 = lane & 16, b3 = lane & 8;
    const __amdgpu_buffer_rsrc_t rv = __builtin_amdgcn_make_buffer_rsrc((void*)(p.ws + WS_V8 + (size_t)z * ((size_t)NEXP * 128)), (short)0, NEXP * 128, 0x00020000);
    const unsigned coff = (unsigned)cc * 16u;
    u32x4 vw[16];
#pragma unroll
    for (int q = 0; q < 4; ++q) {
        vw[4 * q] = __builtin_bit_cast(u32x4, __builtin_amdgcn_raw_buffer_load_b128(rv, (int)(m.e[q].x * 128u + coff), 0, 0));
        vw[4 * q + 1] = __builtin_bit_cast(u32x4, __builtin_amdgcn_raw_buffer_load_b128(rv, (int)(m.e[q].y * 128u + coff), 0, 0));
        vw[4 * q + 2] = __builtin_bit_cast(u32x4, __builtin_amdgcn_raw_buffer_load_b128(rv, (int)(m.e[q].z * 128u + coff), 0, 0));
        vw[4 * q + 3] = __builtin_bit_cast(u32x4, __builtin_amdgcn_raw_buffer_load_b128(rv, (int)(m.e[q].w * 128u + coff), 0, 0));
    }
    f32x4 w[4];
    {
        const unsigned char* wp = p.ws + WS_PW + (size_t)tok * 512;
        const unsigned woff = (unsigned)(lane >> 3) * 64u;
#pragma unroll
        for (int q = 0; q < 4; ++q) w[q] = *(const f32x4*)(wp + woff + 16 * q);
    }
    const unsigned col = (unsigned)(256 * z + 32 * cc + (b5 ? 16 : 0) + (b4 ? 8 : 0) + (b3 ? 4 : 0));
    const u32x2 hb = *(const u32x2*)(p.ws + WS_H1G + (size_t)tok * D * 2 + col * 2u);
    const f32x4 g2v = *(const f32x4*)(p.ln2_g + col);
    if (tok_next >= 0) v_meta(p, tok_next, z, lane, mn);
    f32x2 acc2[16];
#pragma unroll
    for (int q = 0; q < 16; ++q) acc2[q] = (f32x2){0.f, 0.f};
#pragma unroll
    for (int i = 0; i < 16; ++i) {
        const float wi = w[i >> 2][i & 3];
        f32x2 vf[16]; unpack32_fp4(vw[i], vf);
#pragma unroll
        for (int q = 0; q < 16; ++q) acc2[q] += vf[q] * wi;
        __builtin_amdgcn_sched_barrier(0);
    }
    float acc[32];
#pragma unroll
    for (int q = 0; q < 16; ++q) { acc[2 * q] = acc2[q].x; acc[2 * q + 1] = acc2[q].y; }
    float s16[16], s8[8], s4[4];
#pragma unroll
    for (int i = 0; i < 16; ++i) { const float snd = b5 ? acc[i] : acc[i + 16], keep = b5 ? acc[i + 16] : acc[i]; s16[i] = keep + __shfl_xor(snd, 32); }
#pragma unroll
    for (int i = 0; i < 8; ++i) { const float snd = b4 ? s16[i] : s16[i + 8], keep = b4 ? s16[i + 8] : s16[i]; s8[i] = keep + __shfl_xor(snd, 16); }
#pragma unroll
    for (int i = 0; i < 4; ++i) { const float snd = b3 ? s8[i] : s8[i + 4], keep = b3 ? s8[i + 4] : s8[i]; s4[i] = keep + __shfl_xor(snd, 8); }
    const float h0 = bflo(hb.x) / g2v.x + s4[0] * (1.0f / V4_SCALE), h1 = bfhi(hb.x) / g2v.y + s4[1] * (1.0f / V4_SCALE);
    const float h2 = bflo(hb.y) / g2v.z + s4[2] * (1.0f / V4_SCALE), h3 = bfhi(hb.y) / g2v.w + s4[3] * (1.0f / V4_SCALE);
    *(u32x2*)(p.ws + WS_H2 + (size_t)tok * D * 2 + col * 2u) = (u32x2){pk2(h0, h1), pk2(h2, h3)};
}

__device__ __forceinline__ void quantize_h(const Params& p) {
    const int tid_ = tid_opaque(), lane = tid_ & 63;
    const int gw = (int)blockIdx.x * (NTHREADS / 64) + __builtin_amdgcn_readfirstlane(tid_ >> 6), ngw = (int)gridDim.x * (NTHREADS / 64);
    for (int tok = gw; tok < NTOK; tok += ngw) {
        const bf16_t* hrow = (const bf16_t*)(p.ws + WS_H1G + (size_t)tok * D * 2) + 16 * lane;
        const u32x4 w0 = *(const u32x4*)hrow, w1 = *(const u32x4*)(hrow + 8);
        const float f[16] = {bflo(w0.x), bfhi(w0.x), bflo(w0.y), bfhi(w0.y), bflo(w0.z), bfhi(w0.z), bflo(w0.w), bfhi(w0.w),
                             bflo(w1.x), bfhi(w1.x), bflo(w1.y), bfhi(w1.y), bflo(w1.z), bfhi(w1.z), bflo(w1.w), bfhi(w1.w)};
        unsigned pa[2] = {0u, 0u}, pb[2] = {0u, 0u};
#pragma unroll
        for (int i = 0; i < 16; ++i) {
            int q = (int)rintf(f[i] * HQ_SCALE); q = q < -120 ? -120 : (q > 119 ? 119 : q);
            pb[i >> 3] |= ((unsigned)q & 15u) << (4 * (i & 7));
            pa[i >> 3] |= ((unsigned)((q + 8) >> 4) & 15u) << (4 * (i & 7));
        }
        *(u32x2*)(p.ws + WS_HQA + (size_t)tok * 512 + lane * 8) = (u32x2){pa[0], pa[1]};
        *(u32x2*)(p.ws + WS_HQB + (size_t)tok * 512 + lane * 8) = (u32x2){pb[0], pb[1]};
    }
}
__device__ __forceinline__ void ucoli_task(const Params& p, int tok, int z, int lane, const VMeta& m, int tok_next, VMeta& mn) {
    const int cc = lane & 7;
    const bool b2 = lane & 4, b1 = lane & 2, b0 = lane & 1;
    const __amdgpu_buffer_rsrc_t ru = __builtin_amdgcn_make_buffer_rsrc((void*)(p.ws + WS_U8 + (size_t)z * ((size_t)NEXP * 128)), (short)0, NEXP * 128, 0x00020000);
    const unsigned coff = (unsigned)cc * 16u;
    u32x4 uw[16];
#pragma unroll
    for (int q = 0; q < 4; ++q) {
        uw[4 * q] = __builtin_bit_cast(u32x4, __builtin_amdgcn_raw_buffer_load_b128(ru, (int)(m.e[q].x * 128u + coff), 0, 0));
        uw[4 * q + 1] = __builtin_bit_cast(u32x4, __builtin_amdgcn_raw_buffer_load_b128(ru, (int)(m.e[q].y * 128u + coff), 0, 0));
        uw[4 * q + 2] = __builtin_bit_cast(u32x4, __builtin_amdgcn_raw_buffer_load_b128(ru, (int)(m.e[q].z * 128u + coff), 0, 0));
        uw[4 * q + 3] = __builtin_bit_cast(u32x4, __builtin_amdgcn_raw_buffer_load_b128(ru, (int)(m.e[q].w * 128u + coff), 0, 0));
    }
    const u32x4 pa = *(const u32x4*)(p.ws + WS_HQA + (size_t)tok * 512 + z * 128 + coff);
    const u32x4 pb = *(const u32x4*)(p.ws + WS_HQB + (size_t)tok * 512 + z * 128 + coff);
    if (tok_next >= 0) v_meta(p, tok_next, z, lane, mn);
    float d[16];
#pragma unroll
    for (int i = 0; i < 16; ++i) {
        int sa = 0, sb = 0;
#pragma unroll
        for (int q = 0; q < 4; ++q) { sa = __builtin_amdgcn_sdot8((int)uw[i][q], (int)pa[q], sa, false); sb = __builtin_amdgcn_sdot8((int)uw[i][q], (int)pb[q], sb, false); }
        d[i] = (float)(16 * sa + sb);
    }
    float s8[8], s4[4], s2[2];
#pragma unroll
    for (int i = 0; i < 8; ++i) { const float snd = b2 ? d[i] : d[i + 8], keep = b2 ? d[i + 8] : d[i]; s8[i] = keep + __shfl_xor(snd, 4); }
#pragma unroll
    for (int i = 0; i < 4; ++i) { const float snd = b1 ? s8[i] : s8[i + 4], keep = b1 ? s8[i + 4] : s8[i]; s4[i] = keep + __shfl_xor(snd, 2); }
#pragma unroll
    for (int i = 0; i < 2; ++i) { const float snd = b0 ? s4[i] : s4[i + 2], keep = b0 ? s4[i + 2] : s4[i]; s2[i] = keep + __shfl_xor(snd, 1); }
    const unsigned so = (unsigned)(16 * (lane >> 3) + (b2 ? 8 : 0) + (b1 ? 4 : 0) + (b0 ? 2 : 0)) * 2u;
    *(unsigned*)(p.ws + WS_PART + ((size_t)tok * 8 + z) * 256 + so) = pk2(s2[0] * (1.0f / 256.0f), s2[1] * (1.0f / 256.0f));
}
template <bool VPHASE, int PROBE = 0>
__device__ __forceinline__ void phase_sliced(const Params& p_in) {
    Params p = p_in; if (PROBE) p.out = (float*)(p_in.ws + WS_QP);
    const int tid_ = tid_opaque(), lane = tid_ & 63;
    const unsigned loff = 16u * (unsigned)lane;
    unsigned* ctr = (unsigned*)(p.ws + WS_CTR + (VPHASE ? 2048 : 0) + PROBE * 4096);
    constexpr bool FP4 = VPHASE ? V_FP4 : U_FP4;
    constexpr int NSL = FP4 ? NSL4 : 8;
    const int x0 = (int)(xb_xcc_id() & 7u);
    for (int k = 0; k < NSL; ++k) {
        const int y = (x0 + k) & (NSL - 1);
        int tk = claim(ctr + y * 64, lane);
        if (tk >= NTICKET) continue;
        VMeta vm, vmn;
        v_meta(p, tk * TOK_PER_TICKET, y, lane, vm);
        while (tk < NTICKET) {
            const int tkn = claim(ctr + y * 64, lane);
#pragma unroll 1
            for (int i = 0; i < TOK_PER_TICKET; ++i) {
                const int tok = tk * TOK_PER_TICKET + i;
                const int tok_next = (i + 1 < TOK_PER_TICKET) ? tok + 1 : ((tkn < NTICKET) ? tkn * TOK_PER_TICKET : -1);
                if (VPHASE) { if (FP4) v4_task(p, tok, y, lane, vm, tok_next, vmn); else v_task(p, tok, y, lane, vm, tok_next, vmn); vm = vmn; }
                else { if (FP4 && U_INT4) ucoli_task(p, tok, y, lane, vm, tok_next, vmn); else if (FP4) ucol4_task(p, tok, y, lane, vm, tok_next, vmn); else ucol_task(p, tok, y, lane, vm, tok_next, vmn); vm = vmn; }
            }
            tk = tkn;
        }
    }
}
typedef int v8i __attribute__((ext_vector_type(8)));
#define VM_WAIT(n) asm volatile("s_waitcnt vmcnt(" #n ")" ::: "memory")
#define VM_ROWS(G, m0_, m1_, m2_, m3_) do { \
        __builtin_amdgcn_raw_ptr_buffer_load_lds(rv, (ALAS void*)(lw + (G) * 4096), 16, (int)((m0_) * 128u + coff), 0, 0, 0); \
        __builtin_amdgcn_raw_ptr_buffer_load_lds(rv, (ALAS void*)(lw + (G) * 4096 + 1024), 16, (int)((m1_) * 128u + coff), 0, 0, 0); \
        __builtin_amdgcn_raw_ptr_buffer_load_lds(rv, (ALAS void*)(lw + (G) * 4096 + 2048), 16, (int)((m2_) * 128u + coff), 0, 0, 0); \
        __builtin_amdgcn_raw_ptr_buffer_load_lds(rv, (ALAS void*)(lw + (G) * 4096 + 3072), 16, (int)((m3_) * 128u + coff), 0, 0, 0); } while (0)
#define VM_REC(tok_, par_) __builtin_amdgcn_raw_ptr_buffer_load_lds(rrec, (ALAS void*)(lw + 16384 + (par_) * 1024), 16, (int)((unsigned)(tok_) * 1024u + 16u * (unsigned)lane), 0, 0, 0)
#define VM_EIDX(par_) do { const unsigned ea_ = lwa0 + 16384u + (unsigned)(par_) * 1024u + (unsigned)(lane >> 3) * 64u; \
        asm volatile("ds_read_b128 %0, %4\n\tds_read_b128 %1, %4 offset:16\n\tds_read_b128 %2, %4 offset:32\n\tds_read_b128 %3, %4 offset:48\n\ts_waitcnt lgkmcnt(0)" \
                     : "=&v"(e0), "=&v"(e1), "=&v"(e2), "=&v"(e3) : "v"(ea_) : "memory"); } while (0)
#define VM_STAGE(G, lastN, m0_, m1_, m2_, m3_) do { \
        if (T1 >= 0) VM_WAIT(12); else VM_WAIT(lastN); \
        u32x2 t00, t01, t10, t11, t20, t21, t30, t31; \
        asm volatile("ds_read_b64_tr_b16 %0, %8 offset:" #G "*4096\n\tds_read_b64_tr_b16 %1, %8 offset:" #G "*4096+512\n\t" \
                     "ds_read_b64_tr_b16 %2, %9 offset:" #G "*4096\n\tds_read_b64_tr_b16 %3, %9 offset:" #G "*4096+512\n\t" \
                     "ds_read_b64_tr_b16 %4, %10 offset:" #G "*4096\n\tds_read_b64_tr_b16 %5, %10 offset:" #G "*4096+512\n\t" \
                     "ds_read_b64_tr_b16 %6, %11 offset:" #G "*4096\n\tds_read_b64_tr_b16 %7, %11 offset:" #G "*4096+512\n\t" \
                     "s_waitcnt lgkmcnt(0)" \
                     : "=&v"(t00), "=&v"(t01), "=&v"(t10), "=&v"(t11), "=&v"(t20), "=&v"(t21), "=&v"(t30), "=&v"(t31) \
                     : "v"(ta0), "v"(ta1), "v"(ta2), "v"(ta3) : "memory"); \
        if ((G) == 0 && T1 >= 0) VM_EIDX(par ^ 1); \
        if (T1 >= 0) VM_ROWS(G, m0_, m1_, m2_, m3_); \
        const unsigned wlo_ = (G) == 0 ? bw0.x : ((G) == 1 ? bw0.z : ((G) == 2 ? bw1.x : bw1.z)), whi_ = (G) == 0 ? bw0.y : ((G) == 1 ? bw0.w : ((G) == 2 ? bw1.y : bw1.w)); \
        const v8i B_ = (v8i){(int)__builtin_amdgcn_perm(0u, wlo_, sel0), (int)__builtin_amdgcn_perm(0u, wlo_, sel1), (int)__builtin_amdgcn_perm(0u, wlo_, sel2), (int)__builtin_amdgcn_perm(0u, wlo_, sel3), \
                             (int)__builtin_amdgcn_perm(0u, whi_, sel0), (int)__builtin_amdgcn_perm(0u, whi_, sel1), (int)__builtin_amdgcn_perm(0u, whi_, sel2), (int)__builtin_amdgcn_perm(0u, whi_, sel3)}; \
        acc0 = __builtin_amdgcn_mfma_scale_f32_16x16x128_f8f6f4((v8i){(int)t00.x, (int)t00.y, (int)t01.x, (int)t01.y, 0, 0, 0, 0}, B_, acc0, 4, 0, 0, 0x7F7F7F7F, 0, 0x7F7F7F7F); \
        acc1 = __builtin_amdgcn_mfma_scale_f32_16x16x128_f8f6f4((v8i){(int)t10.x, (int)t10.y, (int)t11.x, (int)t11.y, 0, 0, 0, 0}, B_, acc1, 4, 0, 0, 0x7F7F7F7F, 0, 0x7F7F7F7F); \
        acc2 = __builtin_amdgcn_mfma_scale_f32_16x16x128_f8f6f4((v8i){(int)t20.x, (int)t20.y, (int)t21.x, (int)t21.y, 0, 0, 0, 0}, B_, acc2, 4, 0, 0, 0x7F7F7F7F, 0, 0x7F7F7F7F); \
        acc3 = __builtin_amdgcn_mfma_scale_f32_16x16x128_f8f6f4((v8i){(int)t30.x, (int)t30.y, (int)t31.x, (int)t31.y, 0, 0, 0, 0}, B_, acc3, 4, 0, 0, 0x7F7F7F7F, 0, 0x7F7F7F7F); \
    } while (0)
constexpr int V_LDS_PER_WAVE = 18432;
__device__ __forceinline__ void phase_v_mfma(const Params& p, unsigned char* lds_generic) {
    const int tid_ = tid_opaque(), lane = tid_ & 63, wid = __builtin_amdgcn_readfirstlane(tid_ >> 6);
    att::lptr lw = (att::lptr)lds_generic + wid * V_LDS_PER_WAVE;
    const int n = lane & 15, g = lane >> 4, tr_r = n >> 2, tr_c = n & 3;
    const unsigned lwa0 = (unsigned)(size_t)lw;
    const unsigned lwa = lwa0 + (unsigned)((8 * g + tr_r) * 128 + 8 * tr_c);
    const unsigned ta0 = lwa + (unsigned)((0 ^ tr_r) * 32), ta1 = lwa + (unsigned)((1 ^ tr_r) * 32), ta2 = lwa + (unsigned)((2 ^ tr_r) * 32), ta3 = lwa + (unsigned)((3 ^ tr_r) * 32);
    const unsigned coff = (2u * ((unsigned)((lane & 7) >> 1) ^ (unsigned)((lane >> 3) & 3)) + (unsigned)(lane & 1)) * 16u;
    const int sp = n >> 2, ds = n & 3;
    const unsigned selz = 0x0C0C0C0Cu;
    const unsigned sel0 = sp == 3 ? selz : (selz ^ ((0x0Cu ^ 0u) << (8 * ds))), sel1 = sp == 3 ? selz : (selz ^ ((0x0Cu ^ 1u) << (8 * ds)));
    const unsigned sel2 = sp == 3 ? selz : (selz ^ ((0x0Cu ^ 2u) << (8 * ds))), sel3 = sp == 3 ? selz : (selz ^ ((0x0Cu ^ 3u) << (8 * ds)));
    const float fsp = sp == 0 ? 1.0f : (sp == 1 ? 1.0f / 16.0f : (sp == 2 ? 1.0f / 256.0f : 0.0f));
    const unsigned bwa = 512u + (unsigned)((sp > 2 ? 2 : sp) * 128 + g * 32);
    unsigned* ctr = (unsigned*)(p.ws + WS_CTR + 2048);
    const __amdgpu_buffer_rsrc_t rrec = __builtin_amdgcn_make_buffer_rsrc((void*)(p.ws + WS_VREC), (short)0, NTOK * 1024, 0x00020000);
    const int x0 = (int)(xb_xcc_id() & 7u);
    for (int k = 0; k < NSL4; ++k) {
        const int z = (x0 + k) & (NSL4 - 1);
        int tk = claim(ctr + z * 64, lane);
        if (tk >= NTICKET) continue;
        int tkn = claim(ctr + z * 64, lane);
        const __amdgpu_buffer_rsrc_t rv = __builtin_amdgcn_make_buffer_rsrc((void*)(p.ws + WS_V8 + (size_t)z * ((size_t)NEXP * 128)), (short)0, NEXP * 128, 0x00020000);
        int i = 0, T0 = tk * TOK_PER_TICKET, par = 0;
        u32x4 e0, e1, e2, e3;
        VM_REC(T0, 0);
        VM_WAIT(0);
        VM_EIDX(0);
        if (1 < TOK_PER_TICKET) VM_REC(T0 + 1, 1);
        VM_ROWS(0, e0.x, e0.y, e0.z, e0.w); VM_ROWS(1, e1.x, e1.y, e1.z, e1.w); VM_ROWS(2, e2.x, e2.y, e2.z, e2.w); VM_ROWS(3, e3.x, e3.y, e3.z, e3.w);
#pragma unroll 1
        while (true) {
            int T1, T2;
            { const int i1 = i + 1, i2 = i + 2;
              T1 = (i1 < TOK_PER_TICKET) ? tk * TOK_PER_TICKET + i1 : ((tkn < NTICKET) ? tkn * TOK_PER_TICKET + (i1 - TOK_PER_TICKET) : -1);
              T2 = (i2 < TOK_PER_TICKET) ? tk * TOK_PER_TICKET + i2 : ((tkn < NTICKET) ? tkn * TOK_PER_TICKET + (i2 - TOK_PER_TICKET) : -1); }
            u32x4 bw0, bw1; float osc;
            { const unsigned ba_ = lwa0 + 16384u + (unsigned)par * 1024u;
              asm volatile("ds_read_b128 %0, %3\n\tds_read_b128 %1, %3 offset:16\n\tds_read_b32 %2, %4 offset:896\n\ts_waitcnt lgkmcnt(0)"
                           : "=&v"(bw0), "=&v"(bw1), "=&v"(osc) : "v"(ba_ + bwa), "v"(ba_) : "memory"); }
            if (T2 >= 0) VM_REC(T2, par);
            f32x4 acc0 = (f32x4){0.f, 0.f, 0.f, 0.f}, acc1 = acc0, acc2 = acc0, acc3 = acc0;
            VM_STAGE(0, 12, e0.x, e0.y, e0.z, e0.w); VM_STAGE(1, 8, e1.x, e1.y, e1.z, e1.w); VM_STAGE(2, 4, e2.x, e2.y, e2.z, e2.w); VM_STAGE(3, 0, e3.x, e3.y, e3.z, e3.w);
            float o[16];
#pragma unroll
            for (int q = 0; q < 4; ++q) {
                const f32x4 a = q == 0 ? acc0 : (q == 1 ? acc1 : (q == 2 ? acc2 : acc3));
#pragma unroll
                for (int r = 0; r < 4; ++r) {
                    float v = a[r] * fsp;
                    v += __int_as_float(__builtin_amdgcn_update_dpp(0, __float_as_int(v), 0x124, 0xF, 0xF, false));
                    v += __int_as_float(__builtin_amdgcn_update_dpp(0, __float_as_int(v), 0x128, 0xF, 0xF, false));
                    o[4 * q + r] = v * osc;
                }
            }
            if (n < 4) {
                unsigned char* op = p.ws + WS_H2 + (size_t)T0 * D * 2 + (size_t)(256 * z + 64 * g + 16 * ds) * 2;
                const u32x4 oa = (u32x4){pk2(o[0], o[1]), pk2(o[2], o[3]), pk2(o[4], o[5]), pk2(o[6], o[7])}, ob = (u32x4){pk2(o[8], o[9]), pk2(o[10], o[11]), pk2(o[12], o[13]), pk2(o[14], o[15])};
                asm volatile("global_store_dwordx4 %0, %1, off\n\tglobal_store_dwordx4 %0, %2, off offset:16" :: "v"(op), "v"(oa), "v"(ob) : "memory");
            }
            if (T1 < 0) break;
            T0 = T1; par ^= 1;
            if (++i == TOK_PER_TICKET) { i = 0; tk = tkn; tkn = claim(ctr + z * 64, lane); }
        }
    }
    asm volatile("s_waitcnt vmcnt(0)" ::: "memory");
}
#undef VM_STAGE
#undef VM_ROWS
#undef VM_REC
#undef VM_EIDX
#undef VM_WAIT
__device__ __forceinline__ void phase_final_norm(const Params& p) {
    const int tid_ = tid_opaque(), lane = tid_ & 63;
    const int gw = (int)blockIdx.x * (NTHREADS / 64) + __builtin_amdgcn_readfirstlane(tid_ >> 6), ngw = (int)gridDim.x * (NTHREADS / 64);
    const unsigned loff = 16u * (unsigned)lane;
    f32x4 g[4];
#pragma unroll
    for (int q = 0; q < 4; ++q) g[q] = *(const f32x4*)(p.lnf_g + loff + 4 * q);
    f32x4 rg2[4];
#pragma unroll
    for (int q = 0; q < 4; ++q) { const f32x4 t = *(const f32x4*)(p.ln2_g + loff + 4 * q); rg2[q] = (f32x4){1.0f / t.x, 1.0f / t.y, 1.0f / t.z, 1.0f / t.w}; }
    for (int tok0 = gw * 4; tok0 < NTOK; tok0 += ngw * 4) {
        u32x4 w0[4], w1[4];
#pragma unroll
        for (int r = 0; r < 4; ++r) {
            const bf16_t* hrow = (const bf16_t*)(p.ws + WS_H2 + (size_t)(tok0 + r) * D * 2) + loff;
            w0[r] = *(const u32x4*)hrow; w1[r] = *(const u32x4*)(hrow + 8);
        }
        f32x4 y[4][4]; float ss[4];
#pragma unroll
        for (int r = 0; r < 4; ++r) {
            y[r][0] = (f32x4){bflo(w0[r].x), bfhi(w0[r].x), bflo(w0[r].y), bfhi(w0[r].y)}; y[r][1] = (f32x4){bflo(w0[r].z), bfhi(w0[r].z), bflo(w0[r].w), bfhi(w0[r].w)};
            y[r][2] = (f32x4){bflo(w1[r].x), bfhi(w1[r].x), bflo(w1[r].y), bfhi(w1[r].y)}; y[r][3] = (f32x4){bflo(w1[r].z), bfhi(w1[r].z), bflo(w1[r].w), bfhi(w1[r].w)};
            if (V_MFMA) {
                const bf16_t* grow = (const bf16_t*)(p.ws + WS_H1G + (size_t)(tok0 + r) * D * 2) + loff;
                const u32x4 a0 = *(const u32x4*)grow, a1 = *(const u32x4*)(grow + 8);
                y[r][0] += (f32x4){bflo(a0.x), bfhi(a0.x), bflo(a0.y), bfhi(a0.y)} * rg2[0]; y[r][1] += (f32x4){bflo(a0.z), bfhi(a0.z), bflo(a0.w), bfhi(a0.w)} * rg2[1];
                y[r][2] += (f32x4){bflo(a1.x), bfhi(a1.x), bflo(a1.y), bfhi(a1.y)} * rg2[2]; y[r][3] += (f32x4){bflo(a1.z), bfhi(a1.z), bflo(a1.w), bfhi(a1.w)} * rg2[3];
            }
            ss[r] = 0.f;
#pragma unroll
            for (int q = 0; q < 4; ++q) ss[r] += (y[r][q].x * y[r][q].x + y[r][q].y * y[r][q].y) + (y[r][q].z * y[r][q].z + y[r][q].w * y[r][q].w);
        }
#pragma unroll
        for (int o = 1; o < 64; o <<= 1) {
#pragma unroll
            for (int r = 0; r < 4; ++r) ss[r] += __shfl_xor(ss[r], o);
        }
#pragma unroll
        for (int r = 0; r < 4; ++r) {
            const float rstd = 1.0f / sqrtf(ss[r] * (1.0f / D) + EPS);
            float* orow = (float*)((unsigned char*)p.out + (size_t)(tok0 + r) * D * 4) + loff;
#pragma unroll
            for (int q = 0; q < 4; ++q) *(f32x4*)(orow + 4 * q) = (f32x4){y[r][q].x * rstd * g[q].x, y[r][q].y * rstd * g[q].y, y[r][q].z * rstd * g[q].z, y[r][q].w * rstd * g[q].w};
        }
    }
}
}

constexpr int LDS_BYTES = 148480;
extern __shared__ __attribute__((aligned(16))) unsigned char dyn_lds[];

__device__ __forceinline__ Params load_params() {
#if !defined(__HIP_DEVICE_COMPILE__)
    return Params{};
#else
    const __attribute__((address_space(4))) unsigned char* ka = (const __attribute__((address_space(4))) unsigned char*)__builtin_amdgcn_kernarg_segment_ptr();
    asm volatile("" : "+s"(ka));
    const __attribute__((address_space(4))) Params* kp = (const __attribute__((address_space(4))) Params*)ka;
    Params r;
    r.x = kp->x; r.ln1_g = kp->ln1_g; r.w_in = kp->w_in; r.pe_k = kp->pe_k; r.w1_k = kp->w1_k; r.w2_k = kp->w2_k; r.pe_v = kp->pe_v; r.w1_v = kp->w1_v; r.w2_v = kp->w2_v;
    r.sinks = kp->sinks; r.w_out = kp->w_out; r.ln2_g = kp->ln2_g; r.wq = kp->wq; r.pkeys = kp->pkeys; r.pu = kp->pu; r.pv = kp->pv; r.lnf_g = kp->lnf_g; r.out = kp->out; r.ws = kp->ws;
    return r;
#endif
}
__global__ void __launch_bounds__(NTHREADS, 2) fwd_megakernel(Params p_unused) {
    cg::grid_group grid = cg::this_grid();
    float* lds = (float*)dyn_lds;
    PG8_LAS unsigned char* ldsp = (PG8_LAS unsigned char*)dyn_lds;
    volatile XLAS unsigned* bst = (volatile XLAS unsigned*)((XLAS unsigned char*)dyn_lds + (LDS_BYTES - 16));
    if (threadIdx.x < 4) bst[threadIdx.x] = 0u;
    __syncthreads();
    { const Params p = load_params(); (void)xcd_barrier_post((unsigned*)(p.ws + WS_BAR), bst); }
#define GRID_BARRIER() do { const Params p_ = load_params(); XcdBarrier xb_; xb_.bar = (unsigned*)(p_.ws + WS_BAR); xb_.x = xb_xcc_id(); \
        xb_.st = (volatile XLAS unsigned*)((XLAS unsigned char*)dyn_lds + (LDS_BYTES - 16)); xcd_barrier(xb_); } while (0)
    for (int rep = 0; rep < 1 + PROBE_PREP; ++rep) { const Params p = load_params(); phase_prep(p); }
    if (gridDim.y == 0x7fffu) grid.sync();
    GRID_BARRIER();
    for (int rep = 0; rep < 1 + PROBE_PROJ; ++rep) { const Params p = load_params();
      pg8::Gemm g{(const bf16_t*)(p.ws + WS_XN), (const bf16_t*)(p.ws + WS_WIN), NTOK, DINP, D}; pg8::StaticOrder S; S.init(NTOK, DINP, (int)gridDim.x, (int)blockIdx.x);
      EpiProjT E{p.ws}; pg8::gemm_phase<EpiProjT, pg8::StaticOrder, true, true>(ldsp, g, S, E); }
    GRID_BARRIER();
    for (int rep = 0; rep < 1 + PROBE_CS; ++rep) { const Params p = load_params(); cmp::phase_compress_swa(p, dyn_lds); }
    GRID_BARRIER();
    { const Params p = load_params(); att::phase_nsa_mfma<0>(p, dyn_lds); }
#if PROBE_NSA
    { const Params p = load_params(); att::phase_nsa_mfma<PROBE_NSA>(p, dyn_lds); }
#endif
    GRID_BARRIER();
    { const Params p = load_params();
      pg8::Gemm g{(const bf16_t*)(p.ws + WS_O), (const bf16_t*)(p.ws + WS_WOUT), NTOK, D, D}; pg8::StaticOrder S; S.init(NTOK, D, (int)gridDim.x, (int)blockIdx.x);
      EpiOutT E{p.x, p.ln2_g, p.out, (bf16_t*)(p.ws + WS_H1G), (float*)(p.ws + WS_SS2)}; pg8::gemm_phase<EpiOutT, pg8::StaticOrder, true, true>(ldsp, g, S, E); }
    GRID_BARRIER();
    for (int rep = 0; rep < 1 + PROBE_QP; ++rep) { const Params p = load_params();
      pg8::Gemm g{(const bf16_t*)(p.ws + WS_H1G), (const bf16_t*)(p.ws + WS_WQ), NTOK, PQ, D}; pg8::StaticOrder S; S.init(NTOK, PQ, (int)gridDim.x, (int)blockIdx.x);
      EpiQPT E{(const float*)(p.ws + WS_SS2), (bf16_t*)(p.ws + WS_QP)}; pg8::gemm_phase<EpiQPT, pg8::StaticOrder, true, true>(ldsp, g, S, E); }
    GRID_BARRIER();
    if (U_FP4 && U_INT4) { const Params p = load_params(); pex::quantize_h(p); }
    for (int rep = 0; rep < 1 + PROBE_SEL; ++rep) { const Params p = load_params(); psel::phase_peer_select(p, dyn_lds); }
    GRID_BARRIER();
    { const Params p = load_params(); pex::phase_sliced<false>(p); }
#if PROBE_PEXU
    { const Params p = load_params(); pex::phase_sliced<false, 1>(p); }
#endif
    GRID_BARRIER();
    for (int rep = 0; rep < 1 + PROBE_ACT; ++rep) { const Params p = load_params(); pex::phase_expert_act(p); }
    GRID_BARRIER();
    { const Params p = load_params(); if (V_MFMA) pex::phase_v_mfma(p, dyn_lds); else pex::phase_sliced<true>(p); }
#if PROBE_PEXV
    { const Params p = load_params(); pex::phase_sliced<true, 1>(p); }
#endif
    GRID_BARRIER();
    { const Params p = load_params(); pex::phase_final_norm(p); }
}

extern "C" void kernel_launch(void* const* d_in, const int* in_sizes, int n_in, void* d_out, int out_size, void* d_ws, size_t ws_size, hipStream_t stream) {
    if (n_in != 17 || ws_size < WS_END) { fprintf(stderr, "kernel_launch: unexpected inputs (n_in %d, ws %zu)\n", n_in, ws_size); return; }
    static int grid_blocks = 0;
    if (!grid_blocks) {
        int dev = 0, cus = 0, per_cu = 0;
        (void)hipGetDevice(&dev);
        (void)hipDeviceGetAttribute(&cus, hipDeviceAttributeMultiprocessorCount, dev);
        (void)hipFuncSetAttribute((const void*)fwd_megakernel, hipFuncAttributeMaxDynamicSharedMemorySize, LDS_BYTES);
        (void)hipOccupancyMaxActiveBlocksPerMultiprocessor(&per_cu, (const void*)fwd_megakernel, NTHREADS, LDS_BYTES);
        if (per_cu < 1) per_cu = 1;
        grid_blocks = cus * per_cu;
        fprintf(stderr, "kernel_launch: %d CUs x %d blocks/CU\n", cus, per_cu);
    }
    Params p{};
    p.x = (const float*)d_in[0]; p.ln1_g = (const float*)d_in[1]; p.w_in = (const float*)d_in[2];
    p.pe_k = (const float*)d_in[3]; p.w1_k = (const float*)d_in[4]; p.w2_k = (const float*)d_in[5];
    p.pe_v = (const float*)d_in[6]; p.w1_v = (const float*)d_in[7]; p.w2_v = (const float*)d_in[8];
    p.sinks = (const float*)d_in[9]; p.w_out = (const float*)d_in[10]; p.ln2_g = (const float*)d_in[11];
    p.wq = (const float*)d_in[12]; p.pkeys = (const float*)d_in[13]; p.pu = (const float*)d_in[14]; p.pv = (const float*)d_in[15];
    p.lnf_g = (const float*)d_in[16];
    p.out = (float*)d_out; p.ws = (unsigned char*)d_ws;
    (void)hipMemsetAsync((unsigned char*)d_ws + WS_BAR, 0, 16 * 1024 + 8192, stream);
    void* args[] = {&p};
    hipError_t e = hipLaunchCooperativeKernel((void*)fwd_megakernel, dim3(grid_blocks), dim3(NTHREADS), args, LDS_BYTES, stream);
    if (e != hipSuccess) fprintf(stderr, "cooperative launch failed: %s (grid %d)\n", hipGetErrorString(e), grid_blocks);
}
```

```cpp
#include <hip/hip_runtime.h>
#include <hip/hip_cooperative_groups.h>
#include <cstdint>
#include <cstdio>
namespace cg = cooperative_groups;
#define PROBE_PREP 0
#define PROBE_COMPRESS 0
#define PROBE_SWA 0
#define PROBE_NSA 0
#define PROBE_SUB 0
#define PROBE_COMB 0
#define PROBE_PEXU 0
#define PROBE_PEXV 0
#define PROBE_PROJ 0
#define PROBE_QP 0
#define PROBE_SEL 0
#define PROBE_CS 0
#define PROBE_ACT 0

typedef unsigned short bf16_t;
typedef short bf16x8 __attribute__((ext_vector_type(8)));
typedef float f32x4 __attribute__((ext_vector_type(4)));
typedef unsigned u32x4 __attribute__((ext_vector_type(4)));
typedef unsigned u32x2 __attribute__((ext_vector_type(2)));

constexpr int BATCH = 2, T = 8192, D = 1024, NTOK = BATCH * T;
constexpr int HD = 64, NSA_H = 8, NSA_G = 2, NSA_HG = 4, SWA_H = 8;
constexpr int DIN = 1944, DINP = 2048;
constexpr int NCMP = 511, NCMPP = 512, NSEL = 128, TOPN = 16;
constexpr int NSA_WIN = 512, SWA_WIN = 128;
constexpr int PH = 8, PNK = 128, PDK = 256, PTOPK = 16, PQ = PH * PDK;
constexpr int NEXP = PNK * PNK;
constexpr float EPS = 1e-6f;
constexpr int NTHREADS = 512;
constexpr bool V_MFMA = true;
constexpr bool U_FP4 = true, V_FP4 = true, U_INT4 = true;

constexpr size_t MiB = 1u << 20;
constexpr size_t WS_SS2 = 0;
constexpr size_t WS_BAR = 128 * 1024;
constexpr size_t WS_WIN = 1 * MiB;
constexpr size_t WS_WOUT = 5 * MiB;
constexpr size_t WS_WQ = 7 * MiB;
constexpr size_t WS_PKEYS = 11 * MiB;
constexpr size_t WS_W1T = 12 * MiB;
constexpr size_t WS_W2T = 14 * MiB;
constexpr size_t WS_B1 = 14 * MiB + 512 * 1024;
constexpr size_t WS_XN = 16 * MiB;
constexpr size_t WS_O = WS_XN;
constexpr size_t WS_HQA = WS_XN;
constexpr size_t WS_HQB = WS_XN + 8 * MiB;
constexpr size_t WS_H2 = WS_XN;
constexpr size_t WS_QN = 48 * MiB;
constexpr size_t WS_QS = 64 * MiB;
constexpr size_t WS_KV6 = 80 * MiB;
constexpr size_t KV6_STRIDE = 4 * MiB;
constexpr size_t WS_KSW = 104 * MiB;
constexpr size_t WS_VSW = 106 * MiB;
constexpr size_t WS_GSIG = 108 * MiB;
constexpr size_t WS_KC = 110 * MiB;
constexpr size_t WS_VC = 110 * MiB + 512 * 1024;
constexpr size_t WS_H1G = 48 * MiB;
constexpr size_t WS_QP = 80 * MiB;
constexpr size_t WS_EIDX = 144 * MiB;
constexpr size_t WS_GATE = 152 * MiB;
constexpr size_t WS_U8 = 160 * MiB;
constexpr size_t WS_PART = 80 * MiB;
constexpr size_t WS_V8 = 176 * MiB;
constexpr size_t WS_VREC = 232 * MiB;
constexpr size_t WS_PW = 224 * MiB;
constexpr size_t WS_CTR = 128 * 1024 + 16 * 1024;
constexpr size_t WS_TOPV2 = 224 * MiB;
constexpr size_t WS_TOPI2 = 240 * MiB;
constexpr size_t WS_END = 256 * MiB;

struct Params {
    const float* x; const float* ln1_g; const float* w_in;
    const float* pe_k; const float* w1_k; const float* w2_k;
    const float* pe_v; const float* w1_v; const float* w2_v;
    const float* sinks; const float* w_out; const float* ln2_g;
    const float* wq; const float* pkeys; const float* pu; const float* pv; const float* lnf_g;
    float* out; unsigned char* ws;
};

__device__ __forceinline__ int tid_opaque() { int t = (int)threadIdx.x; asm volatile("" : "+v"(t)); return t; }
__device__ __forceinline__ unsigned f2bf(float f) { unsigned u = __float_as_uint(f); return (u + 0x7fffu + ((u >> 16) & 1u)) >> 16; }
__device__ __forceinline__ float bf2f(unsigned h) { return __uint_as_float(h << 16); }
__device__ __forceinline__ float bflo(unsigned w) { return __uint_as_float(w << 16); }
__device__ __forceinline__ float bfhi(unsigned w) { return __uint_as_float(w & 0xffff0000u); }
__device__ __forceinline__ unsigned pk2(float lo, float hi) { return f2bf(lo) | (f2bf(hi) << 16); }
__device__ __forceinline__ float wave_sum(float v) {
#pragma unroll
    for (int o = 1; o < 64; o <<= 1) v += __shfl_xor(v, o);
    return v;
}
__device__ __forceinline__ float gelu_tanh(float x) {
    const float u = 0.7978845608028654f * (x + 0.044715f * x * x * x);
    return 0.5f * x * (1.0f + tanhf(u));
}
__device__ __forceinline__ int win_orig_col(int n) {
    if (n < 1280) return n;
    if (n < 1792) return 1304 + (n - 1280);
    if (n < 1856) return 1816 + (n - 1792);
    if (n < 1920) return 1880 + (n - 1856);
    if (n < 1944) return 1280 + (n - 1920);
    return -1;
}

template <bool WIN_MAP>
__device__ __forceinline__ void prep_transpose(const float* W, int K, int N, int NP, bf16_t* WT, long gt, long ngt) {
    const long items = (long)NP * (K / 8);
    for (long it = gt; it < items; it += ngt) {
        const int n = (int)(it % NP), k0 = (int)(it / NP) * 8;
        const int col = WIN_MAP ? win_orig_col(n) : n;
        float v[8];
#pragma unroll
        for (int i = 0; i < 8; ++i) v[i] = (col >= 0) ? W[(size_t)(k0 + i) * N + col] : 0.f;
        u32x4 o; o.x = pk2(v[0], v[1]); o.y = pk2(v[2], v[3]); o.z = pk2(v[4], v[5]); o.w = pk2(v[6], v[7]);
        *(u32x4*)(WT + (size_t)n * K + k0) = o;
    }
}
__device__ __forceinline__ void prep_convert(const float* src, bf16_t* dst, long n8, long gt, long ngt) {
    for (long it = gt; it < n8; it += ngt) {
        const f32x4 a = *(const f32x4*)(src + it * 8), b = *(const f32x4*)(src + it * 8 + 4);
        u32x4 o; o.x = pk2(a.x, a.y); o.y = pk2(a.z, a.w); o.z = pk2(b.x, b.y); o.w = pk2(b.z, b.w);
        *(u32x4*)(dst + it * 8) = o;
    }
}
constexpr float U8_SCALE = 256.0f, V8_SCALE = 16.0f;
constexpr float U4_SCALE = 64.0f, V4_SCALE = 5.656854249f;
constexpr float UI_SCALE = 91.4285714f, HQ_SCALE = 16.0f;
constexpr int NSL4 = 4;
__device__ __forceinline__ void prep_convert_fp8(const float* src, unsigned char* dst, long n16, float sc, long gt, long ngt) {
    for (long it = gt; it < n16; it += ngt) {
        u32x4 o;
#pragma unroll
        for (int q = 0; q < 4; ++q) {
            const f32x4 a = *(const f32x4*)(src + it * 16 + q * 4);
            int w = 0;
            w = __builtin_amdgcn_cvt_pk_fp8_f32(a.x * sc, a.y * sc, w, false);
            w = __builtin_amdgcn_cvt_pk_fp8_f32(a.z * sc, a.w * sc, w, true);
            o[q] = (unsigned)w;
        }
        *(u32x4*)(dst + it * 16) = o;
    }
}
__device__ __forceinline__ void prep_convert_fp8_sliced(const float* src, unsigned char* dst, long n16, float sc, long gt, long ngt) {
    for (long it = gt; it < n16; it += ngt) {
        u32x4 o;
#pragma unroll
        for (int q = 0; q < 4; ++q) {
            const f32x4 a = *(const f32x4*)(src + it * 16 + q * 4);
            int w = 0;
            w = __builtin_amdgcn_cvt_pk_fp8_f32(a.x * sc, a.y * sc, w, false);
            w = __builtin_amdgcn_cvt_pk_fp8_f32(a.z * sc, a.w * sc, w, true);
            o[q] = (unsigned)w;
        }
        const long e = (it * 16) >> 10; const int col = (int)((it * 16) & 1023);
        *(u32x4*)(dst + (size_t)(col >> 7) * ((size_t)NEXP * 128) + e * 128 + (col & 127)) = o;
    }
}
__device__ __forceinline__ void prep_convert_fp4_sliced(const float* src, unsigned char* dst, long n32, float sc, long gt, long ngt) {
    for (long it = gt; it < n32; it += ngt) {
        u32x4 o;
#pragma unroll
        for (int q = 0; q < 4; ++q) {
            const f32x4 a = *(const f32x4*)(src + it * 32 + q * 8), b = *(const f32x4*)(src + it * 32 + q * 8 + 4);
            unsigned w = 0u;
            w = __builtin_amdgcn_cvt_scalef32_pk_fp4_f32(w, a.x * sc, a.y * sc, 1.0f, 0);
            w = __builtin_amdgcn_cvt_scalef32_pk_fp4_f32(w, a.z * sc, a.w * sc, 1.0f, 1);
            w = __builtin_amdgcn_cvt_scalef32_pk_fp4_f32(w, b.x * sc, b.y * sc, 1.0f, 2);
            w = __builtin_amdgcn_cvt_scalef32_pk_fp4_f32(w, b.z * sc, b.w * sc, 1.0f, 3);
            o[q] = w;
        }
        const long e = (it * 32) >> 10; const int col = (int)((it * 32) & 1023);
        *(u32x4*)(dst + (size_t)(col >> 8) * ((size_t)NEXP * 128) + e * 128 + ((col & 255) >> 1)) = o;
    }
}
__device__ __forceinline__ void prep_convert_fp4_vperm(const float* src, unsigned char* dst, long n32, float sc, long gt, long ngt) {
    for (long it = gt; it < n32; it += ngt) {
        const long e = it >> 5; const int z = (int)(it >> 3) & 3, q = (int)it & 3, hh = (int)(it >> 2) & 1;
        const float* sp = src + e * 1024 + 256 * z + 128 * hh + 4 * q;
        u32x4 o;
#pragma unroll
        for (int gl = 0; gl < 2; ++gl) {
            const f32x4 l0 = *(const f32x4*)(sp + 64 * gl), l1 = *(const f32x4*)(sp + 64 * gl + 16), l2 = *(const f32x4*)(sp + 64 * gl + 32), l3 = *(const f32x4*)(sp + 64 * gl + 48);
#pragma unroll
            for (int wh = 0; wh < 2; ++wh) {
                const int r0 = 2 * wh, r1 = 2 * wh + 1;
                unsigned w = 0u;
                w = __builtin_amdgcn_cvt_scalef32_pk_fp4_f32(w, l0[r0] * sc, l1[r0] * sc, 1.0f, 0);
                w = __builtin_amdgcn_cvt_scalef32_pk_fp4_f32(w, l2[r0] * sc, l3[r0] * sc, 1.0f, 1);
                w = __builtin_amdgcn_cvt_scalef32_pk_fp4_f32(w, l0[r1] * sc, l1[r1] * sc, 1.0f, 2);
                w = __builtin_amdgcn_cvt_scalef32_pk_fp4_f32(w, l2[r1] * sc, l3[r1] * sc, 1.0f, 3);
                o[2 * gl + wh] = w;
            }
        }
        *(u32x4*)(dst + (size_t)z * ((size_t)NEXP * 128) + e * 128 + 32 * q + 16 * hh) = o;
    }
}
__device__ __forceinline__ void prep_convert_int4_sliced(const float* src, unsigned char* dst, long n32, float sc, long gt, long ngt) {
    for (long it = gt; it < n32; it += ngt) {
        u32x4 o;
#pragma unroll
        for (int q = 0; q < 4; ++q) {
            const f32x4 a = *(const f32x4*)(src + it * 32 + q * 8), b = *(const f32x4*)(src + it * 32 + q * 8 + 4);
            const float f[8] = {a.x, a.y, a.z, a.w, b.x, b.y, b.z, b.w};
            unsigned w = 0u;
#pragma unroll
            for (int i = 0; i < 8; ++i) { int v = (int)rintf(f[i] * sc); v = v < -7 ? -7 : (v > 7 ? 7 : v); w |= ((unsigned)v & 15u) << (4 * i); }
            o[q] = w;
        }
        const long e = (it * 32) >> 10; const int col = (int)((it * 32) & 1023);
        *(u32x4*)(dst + (size_t)(col >> 8) * ((size_t)NEXP * 128) + e * 128 + ((col & 255) >> 1)) = o;
    }
}
constexpr int CONV_HEAVY_PCT = 50;
__device__ __forceinline__ void convert_expert_tables(const Params& p, int part  , int bi, int nblk) {
    constexpr long ITEMS_U = (long)NEXP * D / (U_FP4 ? 32 : 16), ITEMS_V = (long)NEXP * D / (V_FP4 ? 32 : 16);
    constexpr long FU = ITEMS_U * CONV_HEAVY_PCT / 100, FV = ITEMS_V * CONV_HEAVY_PCT / 100;
    const long ulo = part == 1 ? FU : 0, uhi = part == 0 ? FU : ITEMS_U, vlo = part == 1 ? FV : 0, vhi = part == 0 ? FV : ITEMS_V;
    {
        const long gt = ulo + (long)bi * NTHREADS + tid_opaque(), ngt = (long)nblk * NTHREADS;
        if (U_FP4 && U_INT4) prep_convert_int4_sliced(p.pu, p.ws + WS_U8, uhi, UI_SCALE, gt, ngt);
        else if (U_FP4) prep_convert_fp4_sliced(p.pu, p.ws + WS_U8, uhi, U4_SCALE, gt, ngt);
        else prep_convert_fp8_sliced(p.pu, p.ws + WS_U8, uhi, U8_SCALE, gt, ngt);
    }
    {
        const long gt = vlo + (long)bi * NTHREADS + tid_opaque(), ngt = (long)nblk * NTHREADS;
        if (V_FP4 && V_MFMA) prep_convert_fp4_vperm(p.pv, p.ws + WS_V8, vhi, V4_SCALE, gt, ngt);
        else if (V_FP4) prep_convert_fp4_sliced(p.pv, p.ws + WS_V8, vhi, V4_SCALE, gt, ngt);
        else prep_convert_fp8_sliced(p.pv, p.ws + WS_V8, vhi, V8_SCALE, gt, ngt);
    }
}
__device__ __forceinline__ void phase_prep(const Params& p) {
    const long gt = (long)blockIdx.x * NTHREADS + tid_opaque(), ngt = (long)gridDim.x * NTHREADS;
    const int lane = tid_opaque() & 63;
    const long gw = gt >> 6, ngw = ngt >> 6;
    unsigned char* ws = p.ws;
    {
        f32x4 g[4];
#pragma unroll
        for (int j = 0; j < 4; ++j) g[j] = *((const f32x4*)p.ln1_g + lane + 64 * j);
        for (long m0 = gw * 4; m0 < NTOK; m0 += ngw * 4) {
            f32x4 v[4][4]; float s[4];
#pragma unroll
            for (int r = 0; r < 4; ++r) {
                const f32x4* xr = (const f32x4*)(p.x + (size_t)(m0 + r) * D) + lane;
#pragma unroll
                for (int j = 0; j < 4; ++j) v[r][j] = xr[64 * j];
            }
#pragma unroll
            for (int r = 0; r < 4; ++r) {
                s[r] = 0.f;
#pragma unroll
                for (int j = 0; j < 4; ++j) s[r] += (v[r][j].x * v[r][j].x + v[r][j].y * v[r][j].y) + (v[r][j].z * v[r][j].z + v[r][j].w * v[r][j].w);
            }
#pragma unroll
            for (int o = 1; o < 64; o <<= 1) {
#pragma unroll
                for (int r = 0; r < 4; ++r) s[r] += __shfl_xor(s[r], o);
            }
#pragma unroll
            for (int r = 0; r < 4; ++r) {
                const float rstd = 1.0f / sqrtf(s[r] * (1.0f / D) + EPS);
                u32x2* o = (u32x2*)((bf16_t*)(ws + WS_XN) + (size_t)(m0 + r) * D) + lane;
#pragma unroll
                for (int j = 0; j < 4; ++j) {
                    u32x2 w; w.x = pk2(v[r][j].x * rstd * g[j].x, v[r][j].y * rstd * g[j].y); w.y = pk2(v[r][j].z * rstd * g[j].z, v[r][j].w * rstd * g[j].w);
                    o[64 * j] = w;
                }
            }
        }
    }
    prep_transpose<true>(p.w_in, D, DIN, DINP, (bf16_t*)(ws + WS_WIN), gt, ngt);
    prep_transpose<false>(p.w_out, D, D, D, (bf16_t*)(ws + WS_WOUT), gt, ngt);
    prep_transpose<false>(p.wq, D, PQ, PQ, (bf16_t*)(ws + WS_WQ), gt, ngt);
    prep_convert(p.pkeys, (bf16_t*)(ws + WS_PKEYS), (long)16 * 128 * 128 / 8, gt, ngt);
    prep_transpose<false>(p.w1_k, 2048, 256, 256, (bf16_t*)(ws + WS_W1T), gt, ngt);
    prep_transpose<false>(p.w1_v, 2048, 256, 256, (bf16_t*)(ws + WS_W1T) + 256 * 2048, gt, ngt);
    prep_transpose<false>(p.w2_k, 256, 64, 64, (bf16_t*)(ws + WS_W2T), gt, ngt);
    prep_transpose<false>(p.w2_v, 256, 64, 64, (bf16_t*)(ws + WS_W2T) + 64 * 256, gt, ngt);
    for (long o = gw; o < 512; o += ngw) {
        const int kv = (int)(o >> 8), n = (int)(o & 255);
        const float* pe = kv ? p.pe_v : p.pe_k; const float* w1 = kv ? p.w1_v : p.w1_k;
        float s = 0.f;
        for (int k = lane; k < 2048; k += 64) s += pe[k] * w1[(size_t)k * 256 + n];
        s = wave_sum(s);
        if (lane == 0) ((float*)(ws + WS_B1))[o] = s;
    }
    for (long i = gt; i < NTOK; i += ngt) ((float*)(ws + WS_SS2))[i] = 0.f;
}

template <class Epi>
__device__ __forceinline__ void gemm_simple(const bf16_t* A, const bf16_t* Bt, int M, int N, int K, const Epi& E) {
    const int lane = tid_opaque() & 63;
    const long gw = ((long)blockIdx.x * NTHREADS + tid_opaque()) >> 6, ngw = ((long)gridDim.x * NTHREADS) >> 6;
    const int ntn = N / 64; const long ntiles = (long)(M / 32) * ntn;
    const int fr = lane & 15, fq = lane >> 4;
    for (long tile = gw; tile < ntiles; tile += ngw) {
        const int m0 = (int)(tile / ntn) * 32, n0 = (int)(tile % ntn) * 64;
        f32x4 acc[2][4];
#pragma unroll
        for (int i = 0; i < 2; ++i)
#pragma unroll
            for (int j = 0; j < 4; ++j) acc[i][j] = (f32x4){0.f, 0.f, 0.f, 0.f};
        const bf16_t* ap = A + (size_t)(m0 + fr) * K + fq * 8;
        const bf16_t* bp = Bt + (size_t)(n0 + fr) * K + fq * 8;
        for (int k0 = 0; k0 < K; k0 += 32) {
            bf16x8 a[2], b[4];
#pragma unroll
            for (int i = 0; i < 2; ++i) a[i] = *(const bf16x8*)(ap + (size_t)i * 16 * K + k0);
#pragma unroll
            for (int j = 0; j < 4; ++j) b[j] = *(const bf16x8*)(bp + (size_t)j * 16 * K + k0);
#pragma unroll
            for (int i = 0; i < 2; ++i)
#pragma unroll
                for (int j = 0; j < 4; ++j) acc[i][j] = __builtin_amdgcn_mfma_f32_16x16x32_bf16(a[i], b[j], acc[i][j], 0, 0, 0);
        }
        E(acc, m0, n0, fr, fq);
    }
}

struct EpiProj {
    unsigned char* ws;
    __device__ __forceinline__ void operator()(const f32x4 (&acc)[2][4], int m0, int n0, int fr, int fq) const {
#pragma unroll
        for (int i = 0; i < 2; ++i)
#pragma unroll
            for (int j = 0; j < 4; ++j)
#pragma unroll
                for (int r = 0; r < 4; ++r) {
                    const int row = m0 + 16 * i + fq * 4 + r, n = n0 + 16 * j + fr;
                    const float v = acc[i][j][r];
                    const int b = row / T, t = row % T, d = n & 63;
                    if (n < 512) {
                        const int head = n >> 6;
                        ((bf16_t*)(ws + WS_QN))[((size_t)(b * 8 + head) * T + t) * 64 + d] = (bf16_t)f2bf(v * 0.125f);
                    } else if (n < 1280) {
                        const int arr = (n - 512) >> 7, g = ((n - 512) >> 6) & 1;
                        ((bf16_t*)(ws + WS_KV6 + arr * KV6_STRIDE))[((size_t)(b * 2 + g) * T + t) * 64 + d] = (bf16_t)f2bf(v);
                    } else if (n < 1792) {
                        const int head = (n - 1280) >> 6;
                        ((bf16_t*)(ws + WS_QS))[((size_t)(b * 8 + head) * T + t) * 64 + d] = (bf16_t)f2bf(v * 0.125f);
                    } else if (n < 1856) {
                        ((bf16_t*)(ws + WS_KSW))[((size_t)b * T + t) * 64 + d] = (bf16_t)f2bf(v);
                    } else if (n < 1920) {
                        ((bf16_t*)(ws + WS_VSW))[((size_t)b * T + t) * 64 + d] = (bf16_t)f2bf(v);
                    } else if (n < 1944) {
                        ((float*)(ws + WS_GSIG))[(size_t)row * 24 + (n - 1920)] = 1.0f / (1.0f + expf(-v));
                    }
                }
    }
};
struct EpiOut {
    const float* x; const float* g2; float* h1; bf16_t* h1g; float* ss2;
    __device__ __forceinline__ void operator()(const f32x4 (&acc)[2][4], int m0, int n0, int fr, int fq) const {
#pragma unroll
        for (int i = 0; i < 2; ++i)
#pragma unroll
            for (int r = 0; r < 4; ++r) {
                const int row = m0 + 16 * i + fq * 4 + r; float ss = 0.f;
#pragma unroll
                for (int j = 0; j < 4; ++j) {
                    const int n = n0 + 16 * j + fr; const size_t off = (size_t)row * D + n;
                    const float h = x[off] + acc[i][j][r];
                    h1[off] = h; h1g[off] = (bf16_t)f2bf(h * g2[n]); ss += h * h;
                }
                ss += __shfl_xor(ss, 1); ss += __shfl_xor(ss, 2); ss += __shfl_xor(ss, 4); ss += __shfl_xor(ss, 8);
                if (fr == 0) atomicAdd(ss2 + row, ss);
            }
    }
};
struct EpiQP {
    const float* ss2; bf16_t* qp;
    __device__ __forceinline__ void operator()(const f32x4 (&acc)[2][4], int m0, int n0, int fr, int fq) const {
#pragma unroll
        for (int i = 0; i < 2; ++i)
#pragma unroll
            for (int r = 0; r < 4; ++r) {
                const int row = m0 + 16 * i + fq * 4 + r;
                const float rstd = 1.0f / sqrtf(ss2[row] * (1.0f / D) + EPS);
#pragma unroll
                for (int j = 0; j < 4; ++j) qp[(size_t)row * PQ + n0 + 16 * j + fr] = (bf16_t)f2bf(acc[i][j][r] * rstd);
            }
    }
};

namespace pg8 {
#define PG8_LAS __attribute__((address_space(3)))
typedef unsigned short bf16_t;
typedef short bf16x8 __attribute__((ext_vector_type(8)));
typedef float f32x4 __attribute__((ext_vector_type(4)));
typedef unsigned u32x4 __attribute__((ext_vector_type(4)));
constexpr int BM = 256, BK = 64, HALF = 128, HTB = HALF * BK * 2  , STAGE_BYTES = 8 * HTB, NXCD = 8, WGM = 8;

__host__ __device__ __forceinline__ int lds_byte(int r, int c) { const int st = (r >> 4) * 2 + (c >> 5), rr = r & 15, cc = c & 31, ob = rr * 64 + cc * 2; return st * 1024 + (ob ^ (((ob >> 9) & 1) << 5)); }
__host__ __device__ __forceinline__ void stage_rc(int b, int& R, int& C) { const int st = b / 1024, sb = b % 1024, swz = sb ^ (((sb >> 9) & 1) << 5); R = (st >> 1) * 16 + swz / 64; C = (st & 1) * 32 + (swz % 64) / 2; }
__host__ __device__ __forceinline__ int perm32(int rho) { const int n = rho >> 4, i = rho & 15; return 8 * (i >> 2) + 4 * n + (i & 3); }

struct Unit { int pm, pn; };
struct Gemm { const bf16_t* A; const bf16_t* Bt; int M, N, K; };

struct StaticOrder {
    int nM, nN, nwg, G, c;
    __host__ __device__ void init(int M, int N, int G_, int c_) { nM = M / BM; nN = N / BM; nwg = nM * nN; G = G_; c = c_; }
    __host__ __device__ bool next(int i, Unit& u) const {
        const long L = (long)i * G + c; if (L >= nwg) return false;
        int wgid = (int)L; { const int q = nwg / NXCD, r = nwg % NXCD, xcd = wgid % NXCD, off = wgid / NXCD; wgid = (xcd < r ? xcd * (q + 1) : r * (q + 1) + (xcd - r) * q) + off; }
        const int nig = WGM * nN, gid = wgid / nig, fm = gid * WGM, gsz = (nM - fm) < WGM ? (nM - fm) : WGM;
        u.pm = fm + ((wgid % nig) % gsz); u.pn = (wgid % nig) / gsz; return true;
    }
    __device__ __forceinline__ void a_ready(const Unit&) const {}
    __device__ __forceinline__ void done(const Unit&) const {}
};

__device__ __forceinline__ unsigned cvt_pk_bf16(float lo, float hi) { unsigned r; asm volatile("v_cvt_pk_bf16_f32 %0, %1, %2" : "=v"(r) : "v"(lo), "v"(hi)); return r; }
template <class Epi, class Sched, bool ALIGN_EPI = false, bool SP2 = false>
__device__ __forceinline__ void gemm_phase(PG8_LAS unsigned char* lds, const Gemm g, const Sched& S, const Epi& E) {
    const int tid = tid_opaque(), wid = __builtin_amdgcn_readfirstlane(tid >> 6), lane = tid & 63, wr = wid >> 2, wc = wid & 3, fr = lane & 15, fq = lane >> 4;
    const int K = g.K, nt = K / BK;
    unsigned voffA[2], voffB[2];
#pragma unroll
    for (int i = 0; i < 2; ++i) { int R, C; stage_rc(tid * 16 + i * 8192, R, C); const int Rb = Epi::PERM ? ((R & ~31) + perm32(R & 31)) : R;
        voffA[i] = (unsigned)(R * K + C) * 2u; voffB[i] = (unsigned)(Rb * K + C) * 2u; }
    const size_t kstep = (size_t)(BK * 2);
    const size_t hstep = (size_t)HALF * K * 2;
    const size_t tstep = 2 * hstep;
    const unsigned ldsw = (unsigned)wid * 1024u;
    const int aoff = lds_byte(wr * 64 + fr, fq * 8), boff = lds_byte(wc * 32 + fr, fq * 8);
#define PG8_SA(b, h) (((b) * 2 + (h)) * HTB)
#define PG8_SB(b, h) ((4 + (b) * 2 + (h)) * HTB)
#define PG8_STAGE(bufoff, gbase, voff) do { _Pragma("unroll") for (int _i = 0; _i < 2; ++_i) \
        __builtin_amdgcn_global_load_lds((const unsigned*)((const char*)(gbase) + (voff)[_i]), (PG8_LAS unsigned*)(lds + (bufoff) + ldsw + _i * 8192), 16, 0, 0); } while (0)
#define PG8_LDA(dst, b, h) do { _Pragma("unroll") for (int m = 0; m < 4; ++m) _Pragma("unroll") for (int k = 0; k < 2; ++k) dst[m][k] = *(const PG8_LAS bf16x8*)(lds + PG8_SA(b, h) + aoff + m * 2048 + k * 1024); } while (0)
#define PG8_LDB(dst, b, h) do { _Pragma("unroll") for (int n = 0; n < 2; ++n) _Pragma("unroll") for (int k = 0; k < 2; ++k) dst[n][k] = *(const PG8_LAS bf16x8*)(lds + PG8_SB(b, h) + boff + n * 2048 + k * 1024); } while (0)
#define PG8_MMA(ai, bj, At, Bt) do { __builtin_amdgcn_s_setprio(1); _Pragma("unroll") for (int m = 0; m < 4; ++m) _Pragma("unroll") for (int n = 0; n < 2; ++n) _Pragma("unroll") for (int k = 0; k < 2; ++k) \
        acc[ai][bj][m][n] = __builtin_amdgcn_mfma_f32_16x16x32_bf16(Bt[n][k], At[m][k], acc[ai][bj][m][n], 0, 0, 0); __builtin_amdgcn_s_setprio(0); } while (0)
#define PG8_WAIT_V(n) asm volatile("s_waitcnt vmcnt(" #n ")" ::: "memory")
#define PG8_WAIT_L(n) asm volatile("s_waitcnt lgkmcnt(" #n ")" ::: "memory")
#define PG8_BAR __builtin_amdgcn_s_barrier()
#define PG8_SCHED __builtin_amdgcn_sched_barrier(0)
    Unit cur, nxt; int ui = 0;
    if (!S.next(0, cur)) return;
    f32x4 acc[2][2][4][2];
#pragma unroll
    for (int a = 0; a < 2; ++a)
#pragma unroll
        for (int b = 0; b < 2; ++b)
#pragma unroll
            for (int m = 0; m < 4; ++m)
#pragma unroll
                for (int n = 0; n < 2; ++n) acc[a][b][m][n] = (f32x4){0.f, 0.f, 0.f, 0.f};
    bf16x8 At[4][2], B0[2][2], B1[2][2];
    const char* cA = (const char*)g.A + (size_t)cur.pm * tstep; const char* cB = (const char*)g.Bt + (size_t)cur.pn * tstep;
    S.a_ready(cur);
    if constexpr (SP2) {
        PG8_STAGE(PG8_SB(0, 0), cB, voffB); PG8_STAGE(PG8_SB(0, 1), cB + hstep, voffB); PG8_STAGE(PG8_SA(0, 0), cA, voffA); PG8_STAGE(PG8_SA(0, 1), cA + hstep, voffA);
        if (wr == 1) PG8_BAR;
        PG8_WAIT_V(2); PG8_BAR;
        PG8_STAGE(PG8_SB(1, 0), cB + kstep, voffB); PG8_STAGE(PG8_SA(1, 0), cA + kstep, voffA); PG8_STAGE(PG8_SB(1, 1), cB + hstep + kstep, voffB);
        PG8_WAIT_V(6); PG8_BAR;
    } else {
        PG8_STAGE(PG8_SB(0, 0), cB, voffB); PG8_STAGE(PG8_SA(0, 0), cA, voffA); PG8_STAGE(PG8_SB(0, 1), cB + hstep, voffB); PG8_STAGE(PG8_SA(0, 1), cA + hstep, voffA);
        if (wr == 1) PG8_BAR;
        PG8_WAIT_V(4); PG8_BAR;
        PG8_STAGE(PG8_SB(1, 0), cB + kstep, voffB); PG8_STAGE(PG8_SA(1, 0), cA + kstep, voffA); PG8_STAGE(PG8_SB(1, 1), cB + hstep + kstep, voffB);
        PG8_WAIT_V(6); PG8_BAR;
    }
    for (;;) {
        const bool has_next = S.next(ui + 1, nxt);
        const char* nA = has_next ? (const char*)g.A + (size_t)nxt.pm * tstep : cA; const char* nB = has_next ? (const char*)g.Bt + (size_t)nxt.pn * tstep : cB;
        for (int t = 0; t < nt; t += 2) {
            const bool last = (t == nt - 2);
            const char* a1 = cA + (size_t)(t + 1) * kstep;
            const char* a2 = last ? nA : cA + (size_t)(t + 2) * kstep; const char* b2 = last ? nB : cB + (size_t)(t + 2) * kstep;
            const char* a3 = a2 + kstep; const char* b3 = b2 + kstep;
            if (last && has_next) S.a_ready(nxt);
            if constexpr (SP2) {
            PG8_LDB(B0, 0, 0); PG8_LDB(B1, 0, 1); PG8_SCHED; PG8_LDA(At, 0, 0); PG8_STAGE(PG8_SA(1, 1), a1 + hstep, voffA);
            PG8_WAIT_V(8); PG8_WAIT_L(0); PG8_BAR; PG8_MMA(0, 0, At, B0); PG8_MMA(0, 1, At, B1); PG8_BAR; PG8_SCHED;
            PG8_LDA(At, 0, 1); PG8_STAGE(PG8_SB(0, 0), b2, voffB); PG8_STAGE(PG8_SB(0, 1), b2 + hstep, voffB); PG8_STAGE(PG8_SA(0, 0), a2, voffA);
            PG8_WAIT_V(8); PG8_WAIT_L(0); PG8_BAR; PG8_MMA(1, 0, At, B0); PG8_MMA(1, 1, At, B1); PG8_BAR; PG8_SCHED;
            PG8_LDB(B0, 1, 0); PG8_LDB(B1, 1, 1); PG8_SCHED; PG8_LDA(At, 1, 0); PG8_STAGE(PG8_SA(0, 1), a2 + hstep, voffA);
            PG8_WAIT_V(8); PG8_WAIT_L(0); PG8_BAR; PG8_MMA(0, 0, At, B0); PG8_MMA(0, 1, At, B1); PG8_BAR; PG8_SCHED;
            PG8_LDA(At, 1, 1); PG8_STAGE(PG8_SB(1, 0), b3, voffB); PG8_STAGE(PG8_SB(1, 1), b3 + hstep, voffB); PG8_STAGE(PG8_SA(1, 0), a3, voffA);
            PG8_WAIT_V(8); PG8_WAIT_L(0); PG8_BAR; PG8_MMA(1, 0, At, B0); PG8_MMA(1, 1, At, B1); PG8_BAR; PG8_SCHED;
            } else {
            PG8_LDB(B0, 0, 0); PG8_SCHED; PG8_LDA(At, 0, 0); PG8_STAGE(PG8_SA(1, 1), a1 + hstep, voffA);
            PG8_WAIT_L(8); PG8_BAR; PG8_WAIT_L(0); PG8_MMA(0, 0, At, B0); PG8_BAR; PG8_SCHED;
            PG8_LDB(B1, 0, 1); PG8_STAGE(PG8_SB(0, 0), b2, voffB);
            PG8_BAR; PG8_WAIT_L(0); PG8_MMA(0, 1, At, B1); PG8_BAR;
            PG8_LDA(At, 0, 1); PG8_STAGE(PG8_SA(0, 0), a2, voffA);
            PG8_BAR; PG8_WAIT_L(0); PG8_MMA(1, 0, At, B0); PG8_BAR; PG8_SCHED;
            PG8_STAGE(PG8_SB(0, 1), b2 + hstep, voffB);
            PG8_WAIT_V(6); PG8_BAR; PG8_MMA(1, 1, At, B1); PG8_BAR;
            PG8_LDB(B0, 1, 0); PG8_SCHED; PG8_LDA(At, 1, 0); PG8_STAGE(PG8_SA(0, 1), a2 + hstep, voffA);
            PG8_WAIT_L(8); PG8_BAR; PG8_WAIT_L(0); PG8_MMA(0, 0, At, B0); PG8_BAR; PG8_SCHED;
            PG8_LDB(B1, 1, 1); PG8_STAGE(PG8_SB(1, 0), b3, voffB);
            PG8_BAR; PG8_WAIT_L(0); PG8_MMA(0, 1, At, B1); PG8_BAR;
            PG8_LDA(At, 1, 1); PG8_STAGE(PG8_SA(1, 0), a3, voffA);
            PG8_BAR; PG8_WAIT_L(0); PG8_MMA(1, 0, At, B0); PG8_BAR; PG8_SCHED;
            PG8_STAGE(PG8_SB(1, 1), b3 + hstep, voffB);
            PG8_WAIT_V(6); PG8_BAR; PG8_MMA(1, 1, At, B1); PG8_BAR;
            }
        }
        if constexpr (ALIGN_EPI) { if (wr == 0) PG8_BAR; }
        if constexpr (!Epi::AFTER_DRAIN) { E(acc, cur, wr, wc, fr, fq); S.done(cur); }
        if (!has_next) break;
#pragma unroll
        for (int a = 0; a < 2; ++a)
#pragma unroll
            for (int b = 0; b < 2; ++b)
#pragma unroll
                for (int m = 0; m < 4; ++m)
#pragma unroll
                    for (int n = 0; n < 2; ++n) acc[a][b][m][n] = (f32x4){0.f, 0.f, 0.f, 0.f};
        cur = nxt; cA = nA; cB = nB; ++ui;
        if constexpr (ALIGN_EPI) { if (wr == 1) PG8_BAR; }
    }
    PG8_WAIT_V(0);
    if constexpr (!ALIGN_EPI) { if (wr == 0) PG8_BAR; }
    PG8_BAR;
    if constexpr (Epi::AFTER_DRAIN) { E.fused(acc, cur, wr, wc, fr, fq, lds, wid, lane); S.done(cur); }
#undef PG8_SA
#undef PG8_SB
#undef PG8_STAGE
#undef PG8_LDA
#undef PG8_LDB
#undef PG8_MMA
#undef PG8_WAIT_V
#undef PG8_WAIT_L
#undef PG8_BAR
#undef PG8_SCHED
}
}

struct EpiProjT {
    static constexpr bool PERM = true, AFTER_DRAIN = false;
    unsigned char* ws;
    __device__ __forceinline__ void operator()(const f32x4 (&acc)[2][2][4][2], const pg8::Unit& u, int wr, int wc, int fr, int fq) const {
        const int row0 = u.pm * 256 + wr * 64 + fr;
#pragma unroll
        for (int bj = 0; bj < 2; ++bj) {
            const int n8 = u.pn * 256 + bj * 128 + wc * 32 + 8 * fq;
            if (n8 >= 1944) continue;
            if (n8 >= 1920) {
#pragma unroll
                for (int ai = 0; ai < 2; ++ai)
#pragma unroll
                    for (int m = 0; m < 4; ++m) {
                        const int row = row0 + ai * 128 + m * 16;
                        const f32x4 v0 = acc[ai][bj][m][0], v1 = acc[ai][bj][m][1];
                        float* dst = (float*)(ws + WS_GSIG) + (size_t)row * 24 + (n8 - 1920);
                        *(f32x4*)dst = (f32x4){1.0f / (1.0f + __expf(-v0[0])), 1.0f / (1.0f + __expf(-v0[1])), 1.0f / (1.0f + __expf(-v0[2])), 1.0f / (1.0f + __expf(-v0[3]))};
                        *(f32x4*)(dst + 4) = (f32x4){1.0f / (1.0f + __expf(-v1[0])), 1.0f / (1.0f + __expf(-v1[1])), 1.0f / (1.0f + __expf(-v1[2])), 1.0f / (1.0f + __expf(-v1[3]))};
                    }
                continue;
            }
            bf16_t* base; int nh, hidx; float sc = 1.0f;
            if (n8 < 512) { base = (bf16_t*)(ws + WS_QN); nh = 8; hidx = n8 >> 6; sc = 0.125f * 1.4426950408889634f; }
            else if (n8 < 1280) { const int arr = (n8 - 512) >> 7; base = (bf16_t*)(ws + WS_KV6 + (size_t)arr * KV6_STRIDE); nh = 2; hidx = ((n8 - 512) >> 6) & 1; }
            else if (n8 < 1792) { base = (bf16_t*)(ws + WS_QS); nh = 8; hidx = (n8 - 1280) >> 6; sc = 0.125f * 1.4426950408889634f; }
            else if (n8 < 1856) { base = (bf16_t*)(ws + WS_KSW); nh = 1; hidx = 0; }
            else { base = (bf16_t*)(ws + WS_VSW); nh = 1; hidx = 0; }
            const int d0 = n8 & 63;
#pragma unroll
            for (int ai = 0; ai < 2; ++ai)
#pragma unroll
                for (int m = 0; m < 4; ++m) {
                    const int row = row0 + ai * 128 + m * 16, b = row >> 13, t = row & (T - 1);
                    const f32x4 v0 = acc[ai][bj][m][0] * sc, v1 = acc[ai][bj][m][1] * sc;
                    u32x4 w; w.x = pg8::cvt_pk_bf16(v0[0], v0[1]); w.y = pg8::cvt_pk_bf16(v0[2], v0[3]); w.z = pg8::cvt_pk_bf16(v1[0], v1[1]); w.w = pg8::cvt_pk_bf16(v1[2], v1[3]);
                    *(u32x4*)(base + ((size_t)(b * nh + hidx) * T + t) * 64 + d0) = w;
                }
        }
    }
};
struct EpiOutT {
    static constexpr bool PERM = false, AFTER_DRAIN = false;
    const float* x; const float* g2; float* h1; bf16_t* h1g; float* ss2;
    __device__ __forceinline__ void operator()(const f32x4 (&acc)[2][2][4][2], const pg8::Unit& u, int wr, int wc, int fr, int fq) const {
        const int row0 = u.pm * 256 + wr * 64 + fr, col0 = u.pn * 256 + wc * 32 + 4 * fq;
#pragma unroll
        for (int ai = 0; ai < 2; ++ai)
#pragma unroll
            for (int m = 0; m < 4; ++m) {
                const int row = row0 + ai * 128 + m * 16; float ss = 0.f;
#pragma unroll
                for (int bj = 0; bj < 2; ++bj)
#pragma unroll
                    for (int n = 0; n < 2; ++n) {
                        const int c = col0 + bj * 128 + n * 16; const size_t off = (size_t)row * D + c;
                        const f32x4 h = *(const f32x4*)(x + off) + acc[ai][bj][m][n];
                        const f32x4 g = *(const f32x4*)(g2 + c);
                        u32x2 w; w.x = pg8::cvt_pk_bf16(h[0] * g[0], h[1] * g[1]); w.y = pg8::cvt_pk_bf16(h[2] * g[2], h[3] * g[3]);
                        *(u32x2*)(h1g + off) = w;
                        ss += (h[0] * h[0] + h[1] * h[1]) + (h[2] * h[2] + h[3] * h[3]);
                    }
                ss += __shfl_xor(ss, 16); ss += __shfl_xor(ss, 32);
                if (fq == 0) atomicAdd(ss2 + row, ss);
            }
    }
};
struct EpiQPT {
    static constexpr bool PERM = true, AFTER_DRAIN = false;
    const float* ss2; bf16_t* qp;
    __device__ __forceinline__ void operator()(const f32x4 (&acc)[2][2][4][2], const pg8::Unit& u, int wr, int wc, int fr, int fq) const {
        const int row0 = u.pm * 256 + wr * 64 + fr;
#pragma unroll
        for (int ai = 0; ai < 2; ++ai)
#pragma unroll
            for (int m = 0; m < 4; ++m) {
                const int row = row0 + ai * 128 + m * 16;
                const float rstd = 1.0f / sqrtf(ss2[row] * (1.0f / D) + EPS);
#pragma unroll
                for (int bj = 0; bj < 2; ++bj) {
                    const int n8 = u.pn * 256 + bj * 128 + wc * 32 + 8 * fq;
                    const f32x4 v0 = acc[ai][bj][m][0] * rstd, v1 = acc[ai][bj][m][1] * rstd;
                    u32x4 w; w.x = pg8::cvt_pk_bf16(v0[0], v0[1]); w.y = pg8::cvt_pk_bf16(v0[2], v0[3]); w.z = pg8::cvt_pk_bf16(v1[0], v1[1]); w.w = pg8::cvt_pk_bf16(v1[2], v1[3]);
                    *(u32x4*)(qp + (size_t)row * PQ + n8) = w;
                }
            }
    }
};

__device__ __forceinline__ void phase_compress(const Params& p, float* lds) {
    float* flat = lds;
    float* part = lds + 2048;
    float* hid = lds + 2560;
    const int tid = tid_opaque();
    const int nunits = 2 * BATCH * NCMP * NSA_G;
    for (int u = blockIdx.x; u < nunits; u += gridDim.x) {
        const int kv = u / (BATCH * NCMP * NSA_G); int r = u % (BATCH * NCMP * NSA_G);
        const int b = r / (NCMP * NSA_G); r %= (NCMP * NSA_G);
        const int c = r / NSA_G, g = r % NSA_G;
        const bf16_t* raw = (const bf16_t*)(p.ws + WS_KV6 + (size_t)kv * KV6_STRIDE) + ((size_t)(b * 2 + g) * T + 16 * c) * 64;
        const float* pe = kv ? p.pe_v : p.pe_k; const float* w1 = kv ? p.w1_v : p.w1_k; const float* w2 = kv ? p.w2_v : p.w2_k;
        for (int i = tid; i < 2048; i += NTHREADS) flat[i] = bf2f(raw[i]) + pe[i];
        __syncthreads();
        {
            const int j = tid & 255, half = tid >> 8;
            float a = 0.f;
            const float* wp = w1 + (size_t)(half * 1024) * 256 + j; const float* fp = flat + half * 1024;
            for (int i = 0; i < 1024; ++i) a += fp[i] * wp[(size_t)i * 256];
            part[tid] = a;
        }
        __syncthreads();
        if (tid < 256) hid[tid] = gelu_tanh(part[tid] + part[tid + 256]);
        __syncthreads();
        if (tid < 64) {
            float a = 0.f;
            for (int j = 0; j < 256; ++j) a += hid[j] * w2[j * 64 + tid];
            bf16_t* dst = (bf16_t*)(p.ws + (kv ? WS_VC : WS_KC)) + ((size_t)(b * 2 + g) * NCMPP + c) * 64;
            dst[tid] = (bf16_t)f2bf(a);
        }
        __syncthreads();
    }
}

__device__ __forceinline__ void load_row64(const bf16_t* src, float (&k)[64]) {
#pragma unroll
    for (int c = 0; c < 8; ++c) {
        const u32x4 w = *(const u32x4*)(src + 8 * c);
        k[8 * c + 0] = bflo(w.x); k[8 * c + 1] = bfhi(w.x); k[8 * c + 2] = bflo(w.y); k[8 * c + 3] = bfhi(w.y);
        k[8 * c + 4] = bflo(w.z); k[8 * c + 5] = bfhi(w.z); k[8 * c + 6] = bflo(w.w); k[8 * c + 7] = bfhi(w.w);
    }
}
__device__ __forceinline__ float dot_row64(const bf16_t* src, const float (&q)[64]) {
    float s0 = 0.f, s1 = 0.f;
#pragma unroll
    for (int c = 0; c < 8; ++c) {
        const u32x4 w = *(const u32x4*)(src + 8 * c);
        s0 += q[8 * c + 0] * bflo(w.x); s1 += q[8 * c + 1] * bfhi(w.x); s0 += q[8 * c + 2] * bflo(w.y); s1 += q[8 * c + 3] * bfhi(w.y);
        s0 += q[8 * c + 4] * bflo(w.z); s1 += q[8 * c + 5] * bfhi(w.z); s0 += q[8 * c + 6] * bflo(w.w); s1 += q[8 * c + 7] * bfhi(w.w);
    }
    return s0 + s1;
}
__device__ __forceinline__ void osm_update(float s, const bf16_t* vsrc, float& m, float& l, float (&acc)[32]) {
    const float mn = fmaxf(m, s), alpha = __expf(m - mn), pr = __expf(s - mn);
    l = l * alpha + pr; m = mn;
#pragma unroll
    for (int c = 0; c < 4; ++c) {
        const u32x4 w = *(const u32x4*)(vsrc + 8 * c);
        acc[8 * c + 0] = acc[8 * c + 0] * alpha + pr * bflo(w.x); acc[8 * c + 1] = acc[8 * c + 1] * alpha + pr * bfhi(w.x);
        acc[8 * c + 2] = acc[8 * c + 2] * alpha + pr * bflo(w.y); acc[8 * c + 3] = acc[8 * c + 3] * alpha + pr * bfhi(w.y);
        acc[8 * c + 4] = acc[8 * c + 4] * alpha + pr * bflo(w.z); acc[8 * c + 5] = acc[8 * c + 5] * alpha + pr * bfhi(w.z);
        acc[8 * c + 6] = acc[8 * c + 6] * alpha + pr * bflo(w.w); acc[8 * c + 7] = acc[8 * c + 7] * alpha + pr * bfhi(w.w);
    }
}

__device__ __forceinline__ void phase_nsa(const Params& p, float* lds) {
    float* imp = lds;
    int* sel = (int*)(lds + 64 * 129);
    const int tid = tid_opaque(), qi = tid & 63, h = (tid >> 6) & 3, dh = tid >> 8;
    const unsigned char* ws = p.ws;
    const int nunits = BATCH * NSA_G * (T / 64);
    for (int u = blockIdx.x; u < nunits; u += gridDim.x) {
        const int b = u / (NSA_G * (T / 64)), g = (u / (T / 64)) % NSA_G, tile = u % (T / 64);
        const int t = tile * 64 + qi, head = g * 4 + h;
        const float slope = exp2f(-0.5f * (float)(9 + head));
        float q[64];
        load_row64((const bf16_t*)(ws + WS_QN) + ((size_t)(b * 8 + head) * T + t) * 64, q);
        const bf16_t* KC = (const bf16_t*)(ws + WS_KC) + (size_t)(b * 2 + g) * NCMPP * 64;
        const bf16_t* VC = (const bf16_t*)(ws + WS_VC) + (size_t)(b * 2 + g) * NCMPP * 64 + dh * 32;
        const bf16_t* KS = (const bf16_t*)(ws + WS_KV6 + 2 * KV6_STRIDE) + (size_t)(b * 2 + g) * T * 64;
        const bf16_t* VS = (const bf16_t*)(ws + WS_KV6 + 3 * KV6_STRIDE) + (size_t)(b * 2 + g) * T * 64 + dh * 32;
        const bf16_t* KW = (const bf16_t*)(ws + WS_KV6 + 4 * KV6_STRIDE) + (size_t)(b * 2 + g) * T * 64;
        const bf16_t* VW = (const bf16_t*)(ws + WS_KV6 + 5 * KV6_STRIDE) + (size_t)(b * 2 + g) * T * 64 + dh * 32;
        const float* gs = (const float*)(ws + WS_GSIG) + (size_t)(b * T + t) * 24 + head * 3;
        float o[32];
#pragma unroll
        for (int d = 0; d < 32; ++d) o[d] = 0.f;
        for (int i = tid; i < 64 * 129; i += NTHREADS) imp[i] = 0.f;
        __syncthreads();
        const int nc = 4 * tile + 3;
        float mc = -1e30f, lc = 0.f;
        {
            float acc[32];
#pragma unroll
            for (int d = 0; d < 32; ++d) acc[d] = 0.f;
            for (int c = 0; c < nc; ++c) {
                const int dist = t - (16 * c + 31);
                if (dist >= 0) {
                    const float s = dot_row64(KC + (size_t)c * 64, q) - slope * (float)dist;
                    osm_update(s, VC + (size_t)c * 64, mc, lc, acc);
                }
            }
            const float inv = gs[0] / fmaxf(lc, 1e-30f);
#pragma unroll
            for (int d = 0; d < 32; ++d) o[d] += acc[d] * inv;
        }
        if (dh == 0) {
            const float invl = 1.0f / fmaxf(lc, 1e-30f);
            for (int c = 0; c < nc; ++c) {
                const int dist = t - (16 * c + 31);
                if (dist >= 0) {
                    const float s = dot_row64(KC + (size_t)c * 64, q) - slope * (float)dist;
                    const float pr = __expf(s - mc) * invl;
                    const int sb = c >> 2;
                    atomicAdd(&imp[qi * 129 + sb], pr);
                    if ((c & 3) == 3 && sb + 1 < NSEL) atomicAdd(&imp[qi * 129 + sb + 1], pr);
                }
            }
        }
        __syncthreads();
        if (tid < 64) {
            const int blk_t = tile;
            float* row = imp + tid * 129;
            for (int j = 0; j <= blk_t; ++j) if (j == 0 || j == blk_t || j == blk_t - 1) row[j] = 1.0e4f;
            for (int k = 0; k < TOPN; ++k) {
                float best = -INFINITY; int bi = -1;
                for (int j = 0; j <= blk_t; ++j) { const float v = row[j]; if (v > best) { best = v; bi = j; } }
                sel[tid * 16 + k] = bi;
                if (bi >= 0) row[bi] = -INFINITY;
            }
        }
        __syncthreads();
        {
            float m = -1e30f, l = 0.f, acc[32];
#pragma unroll
            for (int d = 0; d < 32; ++d) acc[d] = 0.f;
            for (int k = 0; k < TOPN; ++k) {
                const int j = sel[qi * 16 + k];
                if (j >= 0) {
                    for (int i = 0; i < 64; ++i) {
                        const int pos = 64 * j + i;
                        if (pos <= t) {
                            const float s = dot_row64(KS + (size_t)pos * 64, q) - slope * (float)(t - pos);
                            osm_update(s, VS + (size_t)pos * 64, m, l, acc);
                        }
                    }
                }
            }
            const float inv = gs[1] / fmaxf(l, 1e-30f);
#pragma unroll
            for (int d = 0; d < 32; ++d) o[d] += acc[d] * inv;
        }
        {
            float m = -1e30f, l = 0.f, acc[32];
#pragma unroll
            for (int d = 0; d < 32; ++d) acc[d] = 0.f;
            for (int i = 0; i < NSA_WIN; ++i) {
                const int pos = t - (NSA_WIN - 1) + i;
                if (pos >= 0) {
                    const float s = dot_row64(KW + (size_t)pos * 64, q) - slope * (float)(t - pos);
                    osm_update(s, VW + (size_t)pos * 64, m, l, acc);
                }
            }
            const float inv = gs[2] / fmaxf(l, 1e-30f);
#pragma unroll
            for (int d = 0; d < 32; ++d) o[d] += acc[d] * inv;
        }
        bf16_t* O = (bf16_t*)(p.ws + WS_O) + (size_t)(b * T + t) * D + g * 256 + h * 64 + dh * 32;
#pragma unroll
        for (int c = 0; c < 4; ++c) {
            u32x4 w; w.x = pk2(o[8 * c], o[8 * c + 1]); w.y = pk2(o[8 * c + 2], o[8 * c + 3]); w.z = pk2(o[8 * c + 4], o[8 * c + 5]); w.w = pk2(o[8 * c + 6], o[8 * c + 7]);
            *(u32x4*)(O + 8 * c) = w;
        }
        __syncthreads();
    }
}

__device__ __forceinline__ void phase_swa(const Params& p) {
    const unsigned char* ws = p.ws;
    const long gt = (long)blockIdx.x * NTHREADS + tid_opaque(), ngt = (long)gridDim.x * NTHREADS;
    const long items = (long)NTOK * SWA_H * 2;
    for (long it = gt; it < items; it += ngt) {
        const int tt = (int)(it % T); long r = it / T;
        const int dh = (int)(r % 2); r /= 2;
        const int head = (int)(r % SWA_H); const int b = (int)(r / SWA_H);
        const float slope = exp2f(-0.5f * (float)(head + 1));
        float q[64];
        load_row64((const bf16_t*)(ws + WS_QS) + ((size_t)(b * 8 + head) * T + tt) * 64, q);
        const bf16_t* K = (const bf16_t*)(ws + WS_KSW) + (size_t)b * T * 64;
        const bf16_t* V = (const bf16_t*)(ws + WS_VSW) + (size_t)b * T * 64 + dh * 32;
        const float sink = p.sinks[head];
        float m = sink, l = 1.0f, acc[32];
#pragma unroll
        for (int d = 0; d < 32; ++d) acc[d] = 0.f;
        for (int i = 0; i < SWA_WIN; ++i) {
            const int pos = tt - (SWA_WIN - 1) + i;
            if (pos >= 0) {
                const float s = dot_row64(K + (size_t)pos * 64, q) - slope * (float)(tt - pos);
                osm_update(s, V + (size_t)pos * 64, m, l, acc);
            }
        }
        const float inv = 1.0f / l;
        bf16_t* O = (bf16_t*)(p.ws + WS_O) + (size_t)(b * T + tt) * D + 512 + head * 64 + dh * 32;
#pragma unroll
        for (int c = 0; c < 4; ++c) {
            u32x4 w; w.x = pk2(acc[8 * c] * inv, acc[8 * c + 1] * inv); w.y = pk2(acc[8 * c + 2] * inv, acc[8 * c + 3] * inv);
            w.z = pk2(acc[8 * c + 4] * inv, acc[8 * c + 5] * inv); w.w = pk2(acc[8 * c + 6] * inv, acc[8 * c + 7] * inv);
            *(u32x4*)(O + 8 * c) = w;
        }
    }
}

__device__ __forceinline__ void topk_insert(float v, int i, float (&tv)[16], int (&ti)[16]) {
#pragma unroll
    for (int k = 0; k < 16; ++k) {
        const bool sw = v > tv[k];
        const float ov = tv[k]; const int oi = ti[k];
        tv[k] = sw ? v : ov; ti[k] = sw ? i : oi;
        v = sw ? ov : v; i = sw ? oi : i;
    }
}
__device__ __forceinline__ void phase_peer_sub(const Params& p) {
    const unsigned char* ws = p.ws;
    const long gt = (long)blockIdx.x * NTHREADS + tid_opaque(), ngt = (long)gridDim.x * NTHREADS;
    const long items = (long)NTOK * 16;
    for (long it = gt; it < items; it += ngt) {
        const int tok = (int)(it % NTOK), hc = (int)(it / NTOK);
        const bf16_t* qp = (const bf16_t*)(ws + WS_QP) + (size_t)tok * PQ + hc * 128;
        float q0[64], q1[64];
        load_row64(qp, q0); load_row64(qp + 64, q1);
        const bf16_t* keys = (const bf16_t*)(ws + WS_PKEYS) + (size_t)hc * 128 * 128;
        float tv[16]; int ti[16];
#pragma unroll
        for (int k = 0; k < 16; ++k) { tv[k] = -INFINITY; ti[k] = 0; }
        for (int n = 0; n < 128; ++n) {
            const float s = dot_row64(keys + (size_t)n * 128, q0) + dot_row64(keys + (size_t)n * 128 + 64, q1);
            topk_insert(s, n, tv, ti);
        }
        float* ov = (float*)(p.ws + WS_TOPV2) + ((size_t)tok * 16 + hc) * 16;
        int* oi = (int*)(p.ws + WS_TOPI2) + ((size_t)tok * 16 + hc) * 16;
#pragma unroll
        for (int k = 0; k < 16; ++k) { ov[k] = tv[k]; oi[k] = ti[k]; }
    }
}
__device__ __forceinline__ void phase_peer_comb(const Params& p) {
    const long gt = (long)blockIdx.x * NTHREADS + tid_opaque(), ngt = (long)gridDim.x * NTHREADS;
    const long items = (long)NTOK * PH;
    for (long it = gt; it < items; it += ngt) {
        const int tok = (int)(it / PH), h = (int)(it % PH);
        const float* v1 = (const float*)(p.ws + WS_TOPV2) + ((size_t)tok * 16 + h * 2) * 16;
        const float* v2 = v1 + 16;
        const int* i1 = (const int*)(p.ws + WS_TOPI2) + ((size_t)tok * 16 + h * 2) * 16;
        const int* i2 = i1 + 16;
        float s2[16];
#pragma unroll
        for (int k = 0; k < 16; ++k) s2[k] = v2[k];
        float tv[16]; int ti[16];
#pragma unroll
        for (int k = 0; k < 16; ++k) { tv[k] = -INFINITY; ti[k] = 0; }
        for (int a = 0; a < 16; ++a) {
            const float s1 = v1[a];
#pragma unroll
            for (int bb = 0; bb < 16; ++bb) topk_insert(s1 + s2[bb], a * 16 + bb, tv, ti);
        }
        float e[16], sum = 0.f;
#pragma unroll
        for (int k = 0; k < 16; ++k) { e[k] = __expf(tv[k] - tv[0]); sum += e[k]; }
        const float inv = 1.0f / sum;
        int* eo = (int*)(p.ws + WS_EIDX) + (size_t)tok * 128 + h * 16;
        float* go = (float*)(p.ws + WS_GATE) + (size_t)tok * 128 + h * 16;
#pragma unroll
        for (int k = 0; k < 16; ++k) { const int ci = ti[k]; eo[k] = i1[ci >> 4] * PNK + i2[ci & 15]; go[k] = e[k] * inv; }
    }
}

typedef float f32x2 __attribute__((ext_vector_type(2)));
__device__ __forceinline__ void unpack16_fp8(const u32x4& w, float (&f)[16]) {
#pragma unroll
    for (int q = 0; q < 4; ++q) {
        const f32x2 lo = __builtin_amdgcn_cvt_pk_f32_fp8((int)w[q], false), hi = __builtin_amdgcn_cvt_pk_f32_fp8((int)w[q], true);
        f[4 * q] = lo.x; f[4 * q + 1] = lo.y; f[4 * q + 2] = hi.x; f[4 * q + 3] = hi.y;
    }
}
__device__ __forceinline__ float reduce8(const float (&d)[8], int lane) {
    const bool b5 = lane & 32, b4 = lane & 16, b3 = lane & 8;
    float e[4], f[2];
#pragma unroll
    for (int i = 0; i < 4; ++i) { const float snd = b5 ? d[i] : d[i + 4], keep = b5 ? d[i + 4] : d[i]; e[i] = keep + __shfl_xor(snd, 32); }
#pragma unroll
    for (int i = 0; i < 2; ++i) { const float snd = b4 ? e[i] : e[i + 2], keep = b4 ? e[i + 2] : e[i]; f[i] = keep + __shfl_xor(snd, 16); }
    const float snd = b3 ? f[0] : f[1], keep = b3 ? f[1] : f[0];
    float g = keep + __shfl_xor(snd, 8);
    g += __shfl_xor(g, 4); g += __shfl_xor(g, 2); g += __shfl_xor(g, 1);
    return g;
}
__device__ __forceinline__ void phase_peer_expert(const Params& p) {
    const unsigned char* ws = p.ws;
    const int tid_ = tid_opaque(), lane = tid_ & 63;
    const int gw = (int)blockIdx.x * (NTHREADS / 64) + __builtin_amdgcn_readfirstlane(tid_ >> 6), ngw = (int)gridDim.x * (NTHREADS / 64);
    const unsigned char* U = ws + WS_U8; const unsigned char* V = ws + WS_V8;
    const unsigned loff = 16u * (unsigned)lane;
    for (int tok = gw; tok < NTOK; tok += ngw) {
        const bf16_t* hg = (const bf16_t*)(ws + WS_H1G + (size_t)tok * D * 2) + loff;
        float a[16];
        {
            const u32x4 w0 = *(const u32x4*)hg, w1 = *(const u32x4*)(hg + 8);
            a[0] = bflo(w0.x); a[1] = bfhi(w0.x); a[2] = bflo(w0.y); a[3] = bfhi(w0.y); a[4] = bflo(w0.z); a[5] = bfhi(w0.z); a[6] = bflo(w0.w); a[7] = bfhi(w0.w);
            a[8] = bflo(w1.x); a[9] = bfhi(w1.x); a[10] = bflo(w1.y); a[11] = bfhi(w1.y); a[12] = bflo(w1.z); a[13] = bfhi(w1.z); a[14] = bflo(w1.w); a[15] = bfhi(w1.w);
        }
        const float rstd2 = (1.0f / U8_SCALE) / sqrtf(((const float*)(ws + WS_SS2))[tok] * (1.0f / D) + EPS);
        const int e_lo = ((const int*)(ws + WS_EIDX))[(size_t)tok * 128 + lane], e_hi = ((const int*)(ws + WS_EIDX))[(size_t)tok * 128 + 64 + lane];
        const float g_lo = ((const float*)(ws + WS_GATE))[(size_t)tok * 128 + lane], g_hi = ((const float*)(ws + WS_GATE))[(size_t)tok * 128 + 64 + lane];
        float acc[16];
#pragma unroll
        for (int i = 0; i < 16; ++i) acc[i] = 0.f;
        u32x4 uw[8], vw[8];
#pragma unroll
        for (int k = 0; k < 8; ++k) { const int e = __builtin_amdgcn_readlane(e_lo, k); uw[k] = *(const u32x4*)(U + (size_t)e * D + loff); vw[k] = *(const u32x4*)(V + (size_t)e * D + loff); }
#pragma unroll 1
        for (int b = 0; b < 16; ++b) {
            const int nsrc = (b + 1 < 8) ? e_lo : e_hi; const int nbase = ((b + 1) & 7) * 8;
            float d[8];
#pragma unroll
            for (int k = 0; k < 8; ++k) {
                float uf[16]; unpack16_fp8(uw[k], uf);
                float d0 = 0.f, d1 = 0.f;
#pragma unroll
                for (int i = 0; i < 16; i += 2) { d0 += a[i] * uf[i]; d1 += a[i + 1] * uf[i + 1]; }
                d[k] = d0 + d1;
                __builtin_amdgcn_sched_barrier(0);
            }
            if (b + 1 < 16) {
#pragma unroll
                for (int k = 0; k < 8; ++k) { const int e = __builtin_amdgcn_readlane(nsrc, nbase + k); uw[k] = *(const u32x4*)(U + (size_t)e * D + loff); }
            }
            const float dk = reduce8(d, lane);
            const float gsel = __shfl((b < 8) ? g_lo : g_hi, (b & 7) * 8 + ((lane >> 3) & 7));
            const float w = gsel * gelu_tanh(dk * rstd2);
#pragma unroll
            for (int k = 0; k < 8; ++k) {
                const float wk = __uint_as_float((unsigned)__builtin_amdgcn_readlane((int)__float_as_uint(w), 8 * k));
                float vf[16]; unpack16_fp8(vw[k], vf);
#pragma unroll
                for (int i = 0; i < 16; ++i) acc[i] += wk * vf[i];
                __builtin_amdgcn_sched_barrier(0);
            }
            if (b + 1 < 16) {
#pragma unroll
                for (int k = 0; k < 8; ++k) { const int e = __builtin_amdgcn_readlane(nsrc, nbase + k); vw[k] = *(const u32x4*)(V + (size_t)e * D + loff); }
            }
        }
        float* orow = (float*)((unsigned char*)p.out + (size_t)tok * D * 4) + loff;
        float y[16]; float ss = 0.f;
#pragma unroll
        for (int q = 0; q < 4; ++q) {
            const f32x4 h = *(const f32x4*)(orow + 4 * q);
            y[4 * q] = h.x + acc[4 * q] * (1.0f / V8_SCALE); y[4 * q + 1] = h.y + acc[4 * q + 1] * (1.0f / V8_SCALE);
            y[4 * q + 2] = h.z + acc[4 * q + 2] * (1.0f / V8_SCALE); y[4 * q + 3] = h.w + acc[4 * q + 3] * (1.0f / V8_SCALE);
        }
#pragma unroll
        for (int i = 0; i < 16; ++i) ss += y[i] * y[i];
        const float rstd = 1.0f / sqrtf(wave_sum(ss) * (1.0f / D) + EPS);
#pragma unroll
        for (int q = 0; q < 4; ++q) {
            const f32x4 g = *(const f32x4*)(p.lnf_g + loff + 4 * q);
            *(f32x4*)(orow + 4 * q) = (f32x4){y[4 * q] * rstd * g.x, y[4 * q + 1] * rstd * g.y, y[4 * q + 2] * rstd * g.z, y[4 * q + 3] * rstd * g.w};
        }
    }
}


namespace psel {
#define HD __host__ __device__ __forceinline__
HD unsigned f2ord(float f) { unsigned u = __builtin_bit_cast(unsigned, f); const unsigned m = (unsigned)((int)u >> 31); return u ^ (m | 0x80000000u); }
HD float ord2f(unsigned o) { const unsigned m = (unsigned)((int)o >> 31); return __builtin_bit_cast(float, o ^ (~m | 0x80000000u)); }
HD unsigned umax_(unsigned a, unsigned b) { return a > b ? a : b; }
HD unsigned umin_(unsigned a, unsigned b) { return a < b ? a : b; }
HD void sort16_desc(unsigned (&a)[16]) {
#pragma unroll
    for (int k = 2; k <= 16; k <<= 1)
#pragma unroll
        for (int j = k >> 1; j > 0; j >>= 1)
#pragma unroll
            for (int i = 0; i < 16; ++i) {
                const int l = i ^ j;
                if (l > i) {
                    const bool up = ((i & k) == 0);
                    const unsigned hi = umax_(a[i], a[l]), lo = umin_(a[i], a[l]);
                    a[i] = up ? hi : lo; a[l] = up ? lo : hi;
                }
            }
}
HD void merge16_desc(unsigned (&a)[16], const unsigned (&b)[16]) {
#pragma unroll
    for (int i = 0; i < 16; ++i) a[i] = umax_(a[i], b[15 - i]);
#pragma unroll
    for (int j = 8; j > 0; j >>= 1)
#pragma unroll
        for (int i = 0; i < 16; ++i) {
            const int l = i ^ j;
            if (l > i) { const unsigned hi = umax_(a[i], a[l]), lo = umin_(a[i], a[l]); a[i] = hi; a[l] = lo; }
        }
}
HD void top16_of_64(unsigned (&g0)[16], unsigned (&g1)[16], unsigned (&g2)[16], unsigned (&g3)[16]) {
    sort16_desc(g0); sort16_desc(g1); sort16_desc(g2); sort16_desc(g3);
    merge16_desc(g0, g1); merge16_desc(g2, g3); merge16_desc(g0, g2);
}
struct PairTab { int a[64]; int b[64]; int n; };
constexpr PairTab make_pairs() {
    PairTab t{}; int n = 0;
    for (int a = 0; a < 16; ++a) for (int b = 0; b < 16; ++b) if ((a + 1) * (b + 1) <= 16) { t.a[n] = a; t.b[n] = b; ++n; }
    t.n = n; for (int i = n; i < 64; ++i) { t.a[i] = 0; t.b[i] = 0; }
    return t;
}
#undef HD
typedef float f32x16 __attribute__((ext_vector_type(16)));
#define PLAS __attribute__((address_space(3)))
static constexpr PairTab PT = make_pairs();
__device__ __forceinline__ constexpr int crow_c(int r) { return (r & 3) + 8 * (r >> 2); }
__device__ __forceinline__ void phase_peer_select(const Params& p, unsigned char* lds_generic) {
    const unsigned char* ws = p.ws;
    const int tid = tid_opaque(), lane = tid & 63, wid = __builtin_amdgcn_readfirstlane(tid >> 6), r32 = lane & 31, hi = lane >> 5;
    PLAS int* tab = (PLAS int*)((PLAS unsigned char*)lds_generic) + wid * 2048;
    const int gw = (int)blockIdx.x * (NTHREADS / 64) + wid, ngw = (int)gridDim.x * (NTHREADS / 64);
    const __amdgpu_buffer_rsrc_t rq = __builtin_amdgcn_make_buffer_rsrc((void*)(p.ws + WS_QP), (short)0, (int)((size_t)NTOK * PQ * 2), 0x00020000);
    const __amdgpu_buffer_rsrc_t rk = __builtin_amdgcn_make_buffer_rsrc((void*)(p.ws + WS_PKEYS), (short)0, 16 * 128 * 128 * 2, 0x00020000);
    const int h = (int)blockIdx.x & 7, nbh = (int)gridDim.x >> 3, bh = (int)blockIdx.x >> 3;
    PLAS unsigned char* kl = (PLAS unsigned char*)lds_generic + 65536;
    if (bh < nbh) {
#pragma unroll 1
        for (int j = wid; j < 64; j += NTHREADS / 64) {
            const int c = j >> 5, row = 4 * (j & 31) + (lane >> 4);
            const unsigned goff = (unsigned)(((h * 2 + c) * 128 + row) * 256 + (((lane & 15) ^ (row & 15)) * 16));
            __builtin_amdgcn_raw_ptr_buffer_load_lds(rk, (PLAS void*)(kl + j * 1024), 16, (int)goff, 0, 0, 0);
        }
    }
    asm volatile("s_waitcnt vmcnt(0)" ::: "memory");
    __syncthreads();
    unsigned xo[8];
#pragma unroll
    for (int d0 = 0; d0 < 8; ++d0) xo[d0] = (unsigned)(r32 * 256 + (((2 * d0 + hi) ^ (r32 & 15)) * 16));
    (void)gw; (void)ngw;
    for (int tb = bh + nbh * wid; tb < NTOK / 32 && bh < nbh; tb += nbh * (NTHREADS / 64)) {
        const int tok = 32 * tb + r32;
        int hi4 = 4 * hi; asm volatile("" : "+v"(hi4));
        unsigned k1[16], k2[16];
#pragma unroll
        for (int c = 0; c < 2; ++c) {
            const int hc = h * 2 + c;
            const unsigned qoff = (unsigned)(r32 * PQ + 8 * hi) * 2u;
            const int qso = (tb * 32 * PQ + hc * 128) * 2;
            bf16x8 qf[8];
#pragma unroll
            for (int d0 = 0; d0 < 8; ++d0) qf[d0] = __builtin_bit_cast(bf16x8, __builtin_amdgcn_raw_buffer_load_b128(rq, (int)qoff, qso + 32 * d0, 0));
            unsigned g[4][16];
#pragma unroll
            for (int nt = 0; nt < 4; ++nt) {
                f32x16 acc;
#pragma unroll
                for (int r = 0; r < 16; ++r) acc[r] = 0.f;
#pragma unroll
                for (int d0 = 0; d0 < 8; ++d0) {
                    const bf16x8 kf = *(const PLAS bf16x8*)(kl + c * 32768 + nt * 8192 + xo[d0]);
                    acc = __builtin_amdgcn_mfma_f32_32x32x16_bf16(kf, qf[d0], acc, 0, 0, 0);
                }
#pragma unroll
                for (int r = 0; r < 16; ++r) g[nt][r] = (f2ord(acc[r]) & 0xFFFFFF80u) | (unsigned)((127 - 32 * nt - crow_c(r)) - hi4);
                __builtin_amdgcn_sched_barrier(0);
            }
            top16_of_64(g[0], g[1], g[2], g[3]);
            unsigned pb[16];
#pragma unroll
            for (int i = 0; i < 16; ++i) pb[i] = (unsigned)__shfl_xor((int)g[0][i], 32);
            merge16_desc(g[0], pb);
#pragma unroll
            for (int i = 0; i < 16; ++i) { if (c == 0) k1[i] = g[0][i]; else k2[i] = g[0][i]; }
        }
        float v1[16], v2[16];
#pragma unroll
        for (int i = 0; i < 16; ++i) { v1[i] = ord2f(k1[i] & 0xFFFFFF80u); v2[i] = ord2f(k2[i] & 0xFFFFFF80u); }
        unsigned cg[4][16];
#pragma unroll
        for (int s = 0; s < 64; ++s) {
            unsigned key = 0u;
            if (s < PT.n) key = (f2ord(v1[PT.a[s]] + v2[PT.b[s]]) & 0xFFFFFF00u) | (unsigned)(255 - (PT.a[s] * 16 + PT.b[s]));
            cg[s >> 4][s & 15] = key;
        }
        top16_of_64(cg[0], cg[1], cg[2], cg[3]);
#pragma unroll
        for (int i = 0; i < 16; ++i) { tab[i * 64 + lane] = 127 - (int)(k1[i] & 127u); tab[(16 + i) * 64 + lane] = 127 - (int)(k2[i] & 127u); }
        __builtin_amdgcn_fence(__ATOMIC_RELEASE, "wavefront"); __builtin_amdgcn_wave_barrier();
        int eo[16]; float ge[16]; float gsum = 0.f;
        const float top = ord2f(cg[0][0] & 0xFFFFFF00u);
#pragma unroll
        for (int k = 0; k < 16; ++k) {
            const int ab = 255 - (int)(cg[0][k] & 255u);
            eo[k] = tab[(ab >> 4) * 64 + lane] * PNK + tab[(16 + (ab & 15)) * 64 + lane];
            ge[k] = __expf(ord2f(cg[0][k] & 0xFFFFFF00u) - top); gsum += ge[k];
        }
        __builtin_amdgcn_wave_barrier();
        const float ginv = 1.0f / gsum;
        if (hi == 0) {
            int* eout = (int*)(p.ws + WS_EIDX) + ((size_t)h * NTOK + tok) * 16;
            float* gout = (float*)(p.ws + WS_GATE) + ((size_t)h * NTOK + tok) * 16;
#pragma unroll
            for (int q = 0; q < 4; ++q) {
                *(u32x4*)(eout + 4 * q) = (u32x4){(unsigned)eo[4 * q], (unsigned)eo[4 * q + 1], (unsigned)eo[4 * q + 2], (unsigned)eo[4 * q + 3]};
                *(f32x4*)(gout + 4 * q) = (f32x4){ge[4 * q] * ginv, ge[4 * q + 1] * ginv, ge[4 * q + 2] * ginv, ge[4 * q + 3] * ginv};
            }
        }
    }
}
}

namespace att {
typedef float f32x16 __attribute__((ext_vector_type(16)));
typedef short s16x4 __attribute__((ext_vector_type(4)));
typedef short v4i16_t __attribute__((ext_vector_type(4)));
#define ALAS __attribute__((address_space(3)))
typedef ALAS unsigned char* lptr;
constexpr int L_K = 0, L_V = 16384, L_IMP = 32768, L_SELM = L_IMP + 64 * 129 * 4, L_UNION = L_SELM + 1024, L_WSCR = L_UNION + 16, L_ACC = L_WSCR + 8 * 256, L_END = L_ACC + 8 * 8192;
constexpr float LOG2E = 1.4426950408889634f;
constexpr float THR = 10.0f;
__device__ __forceinline__ constexpr int crow_c(int r) { return (r & 3) + 8 * (r >> 2); }
__device__ __forceinline__ unsigned cvtpk(float lo, float hi) { typedef float f2 __attribute__((ext_vector_type(2))); typedef __bf16 b2 __attribute__((ext_vector_type(2)));
    f2 v = {lo, hi}; b2 b = __builtin_convertvector(v, b2); return __builtin_bit_cast(unsigned, b); }
__device__ __forceinline__ s16x4 vtr(lptr p) { return __builtin_bit_cast(s16x4, __builtin_amdgcn_ds_read_tr16_b64_v4i16((ALAS v4i16_t*)p)); }

struct Stage { u32x4 k, v; };
__device__ __forceinline__ void stage_load(const bf16_t* Kt, const bf16_t* Vt, int wid, int lane, Stage& s, bool withV) {
    s.k = *(const u32x4*)(Kt + (size_t)lane * 64 + wid * 8);
    if (withV) s.v = *(const u32x4*)(Vt + (size_t)(16 * (wid & 3) + (lane >> 2)) * 64 + (wid >> 2) * 32 + (lane & 3) * 8);
}
__device__ __forceinline__ void stage_store(lptr kbuf, lptr vbuf, int wid, int lane, const Stage& s, bool withV) {
    *(ALAS u32x4*)(kbuf + wid * 1024 + lane * 16) = s.k;
    if (withV) *(ALAS u32x4*)(vbuf + wid * 1024 + lane * 16) = s.v;
}
__device__ __forceinline__ void qk_tile(f32x16& p0, f32x16& p1, lptr kbuf, const bf16x8 (&qf)[4], float cb, float sk, int r32, int hi) {
    asm volatile("" : "+v"(sk));
    const float cb2 = cb + sk * (float)(4 * hi);
#pragma unroll
    for (int r = 0; r < 16; ++r) { p0[r] = cb2 + sk * (float)crow_c(r); p1[r] = cb2 + sk * (float)(crow_c(r) + 32); }
    lptr kb = kbuf + hi * 1024 + r32 * 16;
#pragma unroll
    for (int d0 = 0; d0 < 4; ++d0) {
        const bf16x8 k0 = *(const ALAS bf16x8*)(kb + d0 * 2048), k1 = *(const ALAS bf16x8*)(kb + d0 * 2048 + 512);
        p0 = __builtin_amdgcn_mfma_f32_32x32x16_bf16(k0, qf[d0], p0, 0, 0, 0);
        p1 = __builtin_amdgcn_mfma_f32_32x32x16_bf16(k1, qf[d0], p1, 0, 0, 0);
    }
}
__device__ __forceinline__ float min2f(float a, float b) { float r; asm("v_min_f32_e32 %0, %1, %2" : "=v"(r) : "v"(a), "v"(b)); return r; }
__device__ __forceinline__ void mask_tile(f32x16& p0, f32x16& p1, int hi_lim, int lo_lim, int hi) {
    int hl = hi_lim - 4 * hi, ll1 = lo_lim + 1 - 4 * hi;
    asm volatile("" : "+v"(hl), "+v"(ll1));
#pragma unroll
    for (int r = 0; r < 16; ++r) {
        const int c0 = crow_c(r), c1 = crow_c(r) + 32;
        const unsigned t0 = (unsigned)((c0 - ll1) | (hl - c0)), t1 = (unsigned)((c1 - ll1) | (hl - c1));
        p0[r] = min2f(p0[r], __uint_as_float((t0 & 0x80000000u) | 0x7f800000u));
        p1[r] = min2f(p1[r], __uint_as_float((t1 & 0x80000000u) | 0x7f800000u));
    }
}
__device__ __forceinline__ float max3f(float a, float b, float c) { float r; asm("v_max3_f32 %0, %1, %2, %3" : "=v"(r) : "v"(a), "v"(b), "v"(c)); return r; }
__device__ __forceinline__ float max2f(float a, float b) { float r; asm("v_max_f32_e32 %0, %1, %2" : "=v"(r) : "v"(a), "v"(b)); return r; }
__device__ __forceinline__ float full_sum(float x) {
    const auto rr = __builtin_amdgcn_permlane32_swap(__float_as_uint(x), __float_as_uint(x), false, false);
    return __uint_as_float(rr[0]) + __uint_as_float(rr[1]);
}
__device__ __forceinline__ float tile_max(const f32x16& p0, const f32x16& p1) {
    float a = max3f(p0[0], p0[1], p1[0]), b = max3f(p0[2], p0[3], p1[1]); a = max3f(a, p1[2], p1[3]);
#pragma unroll
    for (int r = 4; r < 16; r += 4) { a = max3f(a, p0[r], p0[r + 1]); b = max3f(b, p0[r + 2], p0[r + 3]); a = max3f(a, p1[r], p1[r + 1]); b = max3f(b, p1[r + 2], p1[r + 3]); }
    const float m = max2f(a, b);
    const auto rr = __builtin_amdgcn_permlane32_swap(__float_as_uint(m), __float_as_uint(m), false, false);
    return max2f(__uint_as_float(rr[0]), __uint_as_float(rr[1]));
}
__device__ __forceinline__ float tile_sum(const f32x16& p0, const f32x16& p1) {
    float a = p0[0] + p1[0];
#pragma unroll
    for (int r = 1; r < 16; ++r) a += p0[r] + p1[r];
    return a;
}
__device__ __forceinline__ void pack_p(u32x4 (&pw)[4], const f32x16& p0, const f32x16& p1) {
    pw[0] = (u32x4){cvtpk(p0[0], p0[1]), cvtpk(p0[2], p0[3]), cvtpk(p0[4], p0[5]), cvtpk(p0[6], p0[7])};
    pw[1] = (u32x4){cvtpk(p0[8], p0[9]), cvtpk(p0[10], p0[11]), cvtpk(p0[12], p0[13]), cvtpk(p0[14], p0[15])};
    pw[2] = (u32x4){cvtpk(p1[0], p1[1]), cvtpk(p1[2], p1[3]), cvtpk(p1[4], p1[5]), cvtpk(p1[6], p1[7])};
    pw[3] = (u32x4){cvtpk(p1[8], p1[9]), cvtpk(p1[10], p1[11]), cvtpk(p1[12], p1[13]), cvtpk(p1[14], p1[15])};
}
__device__ __forceinline__ void pv_packed(f32x16& o0, f32x16& o1, const u32x4 (&pw)[4], lptr vbuf, int lane, int hi) {
    lptr vp = vbuf + ((lane >> 4) & 1) * 32 + (lane & 3) * 8 + (4 * hi + ((lane & 15) >> 2)) * 64;
#pragma unroll
    for (int ks = 0; ks < 4; ++ks) {
        const s16x4 a = vtr(vp + ks * 1024), b = vtr(vp + ks * 1024 + 512);
        const s16x4 c = vtr(vp + 4096 + ks * 1024), d = vtr(vp + 4096 + ks * 1024 + 512);
        const bf16x8 v0 = (bf16x8){a[0], a[1], a[2], a[3], b[0], b[1], b[2], b[3]}, v1 = (bf16x8){c[0], c[1], c[2], c[3], d[0], d[1], d[2], d[3]};
        const bf16x8 pa = __builtin_bit_cast(bf16x8, pw[ks]);
        o0 = __builtin_amdgcn_mfma_f32_32x32x16_bf16(pa, v0, o0, 0, 0, 0);
        o1 = __builtin_amdgcn_mfma_f32_32x32x16_bf16(pa, v1, o1, 0, 0, 0);
    }
}
__device__ __forceinline__ void pv_tile(f32x16& o0, f32x16& o1, const f32x16& p0, const f32x16& p1, lptr vbuf, int lane, int hi) {
    u32x4 pw[4]; pack_p(pw, p0, p1);
    pv_packed(o0, o1, pw, vbuf, lane, hi);
}
__device__ __forceinline__ void ov_frags(bf16x8 (&ovf)[4], int r32, int hi) {
#pragma unroll
    for (int ks = 0; ks < 4; ++ks)
#pragma unroll
        for (int j = 0; j < 8; ++j) {
            const int q4 = 4 * ks + 2 * (j >> 2) + hi;
            const bool on = (r32 == q4) || ((j & 3) == 3 && r32 == q4 + 1);
            ovf[ks][j] = on ? (short)0x3F80 : (short)0;
        }
}
__device__ __forceinline__ void scale_rows(f32x16& o0, f32x16& o1, float f, ALAS float* wscr, int r32, int hi) {
    if (hi == 0) wscr[r32] = f;
    __builtin_amdgcn_fence(__ATOMIC_RELEASE, "wavefront"); __builtin_amdgcn_wave_barrier();
#pragma unroll
    for (int r = 0; r < 16; ++r) { const float a = wscr[crow_c(r) + 4 * hi]; o0[r] *= a; o1[r] *= a; }
    __builtin_amdgcn_wave_barrier();
}
template <bool FIRST>
__device__ __forceinline__ void acc_rows(ALAS float* accw, const f32x16& o0, const f32x16& o1, float f, ALAS float* wscr, int r32, int hi) {
    if (hi == 0) wscr[r32] = f;
    __builtin_amdgcn_fence(__ATOMIC_RELEASE, "wavefront"); __builtin_amdgcn_wave_barrier();
#pragma unroll
    for (int r = 0; r < 16; ++r) {
        const int row = crow_c(r) + 4 * hi; const float a = wscr[row];
        ALAS float* d = accw + row * 64 + r32;
        if (FIRST) { d[0] = o0[r] * a; d[32] = o1[r] * a; } else { d[0] += o0[r] * a; d[32] += o1[r] * a; }
    }
    __builtin_amdgcn_wave_barrier();
}
__device__ __forceinline__ void store_acc(ALAS float* accw, bf16_t* O, int lane) {
    __builtin_amdgcn_fence(__ATOMIC_RELEASE, "wavefront"); __builtin_amdgcn_wave_barrier();
#pragma unroll
    for (int it = 0; it < 4; ++it) {
        const int item = it * 64 + lane, row = item >> 3, ch = item & 7;
        const f32x4 x = *(const ALAS f32x4*)(accw + row * 64 + ch * 8), y = *(const ALAS f32x4*)(accw + row * 64 + ch * 8 + 4);
        u32x4 w; w.x = cvtpk(x[0], x[1]); w.y = cvtpk(x[2], x[3]); w.z = cvtpk(y[0], y[1]); w.w = cvtpk(y[2], y[3]);
        *(u32x4*)(O + (size_t)(row & 7) * D + (row >> 3) * 64 + ch * 8) = w;
    }
    __builtin_amdgcn_wave_barrier();
}
struct Br { float m, l; f32x16 o0, o1; };
__device__ __forceinline__ void attend_tile(Br& s, lptr kbuf, lptr vbuf, const bf16x8 (&qf)[4], float cb, float sk, bool domask, int hi_lim, int lo_lim, ALAS float* wscr, int lane, int r32, int hi) {
    f32x16 p0, p1;
    const float mu = (s.m < -1e29f) ? 0.f : s.m;
    qk_tile(p0, p1, kbuf, qf, cb - mu, sk, r32, hi);
    if (domask) mask_tile(p0, p1, hi_lim, lo_lim, hi);
    const float rm = tile_max(p0, p1);
    if (__any(rm + mu > s.m + THR)) {
        const float mn = fmaxf(s.m, rm + mu), alpha = __builtin_amdgcn_exp2f(s.m - mn), delta = mn - mu;
        s.l *= alpha; s.m = mn;
        scale_rows(s.o0, s.o1, alpha, wscr, r32, hi);
#pragma unroll
        for (int r = 0; r < 16; ++r) { p0[r] -= delta; p1[r] -= delta; }
    }
#pragma unroll
    for (int r = 0; r < 16; ++r) { p0[r] = __builtin_amdgcn_exp2f(p0[r]); p1[r] = __builtin_amdgcn_exp2f(p1[r]); }
    s.l += tile_sum(p0, p1);
    pv_tile(s.o0, s.o1, p0, p1, vbuf, lane, hi);
}

#define ATT_BAR() asm volatile("s_waitcnt lgkmcnt(0)\n\ts_barrier" ::: "memory")
template <int PVAR = 0>
__device__ __forceinline__ void nsa_unit(const Params& p, unsigned char* lds_generic, int b, int g, int tile) {
    lptr lds = (lptr)lds_generic;
    const int tid = tid_opaque(), lane = tid & 63, wid = __builtin_amdgcn_readfirstlane(tid >> 6), r32 = lane & 31, hi = lane >> 5;
    const int h = r32 >> 3, qi = r32 & 7, tq = 8 * wid + qi, t = 64 * tile + tq, head = g * 4 + h;
    const float slope = exp2f(-0.5f * (float)(9 + head)) * LOG2E;
    const unsigned char* ws = p.ws;
    ALAS float* imp = (ALAS float*)(lds + L_IMP);
    ALAS unsigned* selm = (ALAS unsigned*)(lds + L_SELM);
    ALAS unsigned* uni = (ALAS unsigned*)(lds + L_UNION);
    ALAS float* wscr = (ALAS float*)(lds + L_WSCR) + wid * 64;
    const bf16_t* KC = (const bf16_t*)(ws + WS_KC) + (size_t)(b * 2 + g) * NCMPP * 64;
    const bf16_t* VC = (const bf16_t*)(ws + WS_VC) + (size_t)(b * 2 + g) * NCMPP * 64;
    const bf16_t* KS = (const bf16_t*)(ws + WS_KV6 + 2 * KV6_STRIDE) + (size_t)(b * 2 + g) * T * 64;
    const bf16_t* VS = (const bf16_t*)(ws + WS_KV6 + 3 * KV6_STRIDE) + (size_t)(b * 2 + g) * T * 64;
    const bf16_t* KW = (const bf16_t*)(ws + WS_KV6 + 4 * KV6_STRIDE) + (size_t)(b * 2 + g) * T * 64;
    const bf16_t* VW = (const bf16_t*)(ws + WS_KV6 + 5 * KV6_STRIDE) + (size_t)(b * 2 + g) * T * 64;
    const float* gs = (const float*)(ws + WS_GSIG) + (size_t)(b * T + t) * 24 + head * 3;
    bf16x8 qf[4];
    {
        const bf16_t* qp = (const bf16_t*)(ws + WS_QN) + ((size_t)(b * 8 + head) * T + t) * 64 + 8 * hi;
#pragma unroll
        for (int d0 = 0; d0 < 4; ++d0) qf[d0] = *(const bf16x8*)(qp + 16 * d0);
    }
    for (int i = tid; i < 64 * 129; i += NTHREADS) imp[i] = 0.f;
    if (tid < 4) uni[tid] = 0u;
    ALAS float* accw = (ALAS float*)(lds + L_ACC) + wid * 2048;
    const int nc = 4 * tile + 3, n = (nc + 63) >> 6, n2 = 2 * n;
    const int nw = (tile < 8) ? tile + 1 : 9, NS = n2 + nw;
#define GK(x) ((x) < n2 ? KC + (size_t)((x) < n ? (x) : (x) - n) * 4096 : ((x) < NS ? KW + (size_t)(tile - ((x) - n2)) * 4096 : KS + (size_t)tile * 4096))
#define GV(x) ((x) < n2 ? VC + (size_t)((x) < n ? (x) : (x) - n) * 4096 : ((x) < NS ? VW + (size_t)(tile - ((x) - n2)) * 4096 : VS + (size_t)tile * 4096))
#define PIPE_HEAD(x) do { if ((x) + 2 <= NS) stage_load(GK((x) + 2), GV((x) + 2), wid, lane, sB, true); } while (0)
#define PIPE_TAIL(x) do { if ((x) + 1 <= NS) stage_store(lds + L_K + (cur ^ 1) * 8192, lds + L_V + (cur ^ 1) * 8192, wid, lane, sA, true); ATT_BAR(); cur ^= 1; sA = sB; } while (0)
    Stage sA, sB; int cur = 0;
    stage_load(GK(0), GV(0), wid, lane, sA, true);
    stage_store(lds + L_K, lds + L_V, wid, lane, sA, true);
    ATT_BAR();
    stage_load(GK(1), GV(1), wid, lane, sA, true);
    const int cmax = (t >= 31) ? ((t - 31) >> 4) : -1;
    const float skc = 16.0f * slope, cbc = -slope * (float)(t - 31);
    float mc = -1e30f, lc = 0.f;
    for (int x = 0; x < n; ++x) {
        PIPE_HEAD(x);
        const int i = x;
        if (!(PVAR & 1)) {
        f32x16 p0, p1;
        qk_tile(p0, p1, lds + L_K + cur * 8192, qf, cbc + skc * (float)(64 * i), skc, r32, hi);
        if (__any(cmax - 64 * i < 63)) mask_tile(p0, p1, cmax - 64 * i, -1, hi);
        const float rm = tile_max(p0, p1), mn = fmaxf(mc, rm);
#pragma unroll
        for (int r = 0; r < 16; ++r) { p0[r] = __builtin_amdgcn_exp2f(p0[r] - mn); p1[r] = __builtin_amdgcn_exp2f(p1[r] - mn); }
        lc = lc * __builtin_amdgcn_exp2f(mc - mn) + tile_sum(p0, p1); mc = mn;
        }
        PIPE_TAIL(x);
    }
    {
        lc = full_sum(lc);
        const float nrm = (lc > 0.f) ? (mc + __builtin_amdgcn_logf(lc)) : 0.f;
        Br sc; sc.m = 0.f; sc.l = 0.f;
#pragma unroll
        for (int r = 0; r < 16; ++r) { sc.o0[r] = 0.f; sc.o1[r] = 0.f; }
        bf16x8 ovf[4]; ov_frags(ovf, r32, hi);
        for (int x = n; x < n2; ++x) {
            PIPE_HEAD(x);
            const int i = x - n;
            if (!(PVAR & 2)) {
            f32x16 p0, p1;
            qk_tile(p0, p1, lds + L_K + cur * 8192, qf, cbc + skc * (float)(64 * i) - nrm, skc, r32, hi);
            if (__any(cmax - 64 * i < 63)) mask_tile(p0, p1, cmax - 64 * i, -1, hi);
#pragma unroll
            for (int r = 0; r < 16; ++r) { p0[r] = __builtin_amdgcn_exp2f(p0[r]); p1[r] = __builtin_amdgcn_exp2f(p1[r]); }
            u32x4 pw[4]; pack_p(pw, p0, p1);
            pv_packed(sc.o0, sc.o1, pw, lds + L_V + cur * 8192, lane, hi);
            f32x16 ia;
#pragma unroll
            for (int r = 0; r < 16; ++r) ia[r] = 0.f;
#pragma unroll
            for (int ks = 0; ks < 4; ++ks) ia = __builtin_amdgcn_mfma_f32_32x32x16_bf16(__builtin_bit_cast(bf16x8, pw[ks]), ovf[ks], ia, 0, 0, 0);
            const int sb = 16 * i + r32;
            if (r32 <= 16 && sb < NSEL) {
#pragma unroll
                for (int m = 0; m < 4; ++m) atomicAdd((float*)(imp + (8 * wid + 4 * hi + m) * 129 + sb), (ia[m] + ia[m + 4]) + (ia[m + 8] + ia[m + 12]));
            }
            }
            PIPE_TAIL(x);
        }
        acc_rows<true>(accw, sc.o0, sc.o1, gs[0], wscr, r32, hi);
    }
    {
        Br sw; sw.m = -1e30f; sw.l = 0.f;
#pragma unroll
        for (int r = 0; r < 16; ++r) { sw.o0[r] = 0.f; sw.o1[r] = 0.f; }
        for (int x = n2; x < NS; ++x) {
            PIPE_HEAD(x);
            const int j = tile - (x - n2);
            const float cb = -slope * (float)(t - 64 * j);
            if (!(PVAR & 4)) attend_tile(sw, lds + L_K + cur * 8192, lds + L_V + cur * 8192, qf, cb, slope, (j == tile) || (j == tile - 8), (j == tile) ? tq : 63, (j == tile - 8) ? tq : -1, wscr, lane, r32, hi);
            PIPE_TAIL(x);
        }
        acc_rows<false>(accw, sw.o0, sw.o1, gs[2] / fmaxf(full_sum(sw.l), 1e-30f), wscr, r32, hi);
    }
#undef GK
#undef GV
#undef PIPE_HEAD
#undef PIPE_TAIL
    if (!(PVAR & 16)) {
        const int q = tid >> 3, sub = tid & 7;
        unsigned kq[16];
#pragma unroll
        for (int i = 0; i < 16; ++i) {
            const int j = sub * 16 + i; float x = imp[q * 129 + j];
            if (j == 0 || j == tile || j == tile - 1) x = 1.0e4f;
            if (j > tile) x = -INFINITY;
            kq[i] = (psel::f2ord(x) & 0xFFFFFF80u) | (unsigned)(127 - j);
        }
        psel::sort16_desc(kq);
#pragma unroll
        for (int off = 1; off < 8; off <<= 1) {
            unsigned pb[16];
#pragma unroll
            for (int i = 0; i < 16; ++i) pb[i] = (unsigned)__shfl_xor((int)kq[i], off);
            psel::merge16_desc(kq, pb);
        }
        if (sub == 0) {
            unsigned w0 = 0u, w1 = 0u, w2 = 0u, w3 = 0u;
            const unsigned ninf = psel::f2ord(-INFINITY) & 0xFFFFFF80u;
#pragma unroll
            for (int i = 0; i < 16; ++i) {
                const int bj = 127 - (int)(kq[i] & 127u); const bool ok = (kq[i] & 0xFFFFFF80u) != ninf;
                const int k = bj >> 5; const unsigned bit = ok ? (1u << (bj & 31)) : 0u;
                w0 |= (k == 0) ? bit : 0u; w1 |= (k == 1) ? bit : 0u; w2 |= (k == 2) ? bit : 0u; w3 |= (k == 3) ? bit : 0u;
            }
            selm[q * 4 + 0] = w0; selm[q * 4 + 1] = w1; selm[q * 4 + 2] = w2; selm[q * 4 + 3] = w3;
            atomicOr((unsigned*)(uni + 0), w0); atomicOr((unsigned*)(uni + 1), w1); atomicOr((unsigned*)(uni + 2), w2); atomicOr((unsigned*)(uni + 3), w3);
        }
    }
    __syncthreads();
    {
        unsigned u0 = uni[0], u1 = uni[1], u2 = uni[2], u3 = uni[3];
        u0 = __builtin_amdgcn_readfirstlane(u0); u1 = __builtin_amdgcn_readfirstlane(u1); u2 = __builtin_amdgcn_readfirstlane(u2); u3 = __builtin_amdgcn_readfirstlane(u3);
        const unsigned s0 = selm[tq * 4 + 0], s1 = selm[tq * 4 + 1], s2 = selm[tq * 4 + 2], s3 = selm[tq * 4 + 3];
        Br sb_; sb_.m = -1e30f; sb_.l = 0.f;
#pragma unroll
        for (int r = 0; r < 16; ++r) { sb_.o0[r] = 0.f; sb_.o1[r] = 0.f; }
#define POP_BLOCK(j) do { if (u3) { const int bb = 31 - __builtin_clz(u3); u3 ^= 1u << bb; j = 96 + bb; } else if (u2) { const int bb = 31 - __builtin_clz(u2); u2 ^= 1u << bb; j = 64 + bb; } \
        else if (u1) { const int bb = 31 - __builtin_clz(u1); u1 ^= 1u << bb; j = 32 + bb; } else if (u0) { const int bb = 31 - __builtin_clz(u0); u0 ^= 1u << bb; j = bb; } else j = -1; } while (0)
        int j, j1, j2; POP_BLOCK(j); POP_BLOCK(j1); POP_BLOCK(j2);
        if (j1 >= 0) stage_load(KS + (size_t)j1 * 4096, VS + (size_t)j1 * 4096, wid, lane, sA, true);
        while (j >= 0) {
            if (j2 >= 0) stage_load(KS + (size_t)j2 * 4096, VS + (size_t)j2 * 4096, wid, lane, sB, true);
            const unsigned wsel = (j >> 5) == 0 ? s0 : (j >> 5) == 1 ? s1 : (j >> 5) == 2 ? s2 : s3;
            const bool mine = (wsel >> (j & 31)) & 1u;
            if (!(PVAR & 8) && __any(mine)) {
                const float cb = mine ? -slope * (float)(t - 64 * j) : -INFINITY;
                attend_tile(sb_, lds + L_K + cur * 8192, lds + L_V + cur * 8192, qf, cb, slope, j == tile, tq, -1, wscr, lane, r32, hi);
            }
            if (j1 >= 0) stage_store(lds + L_K + (cur ^ 1) * 8192, lds + L_V + (cur ^ 1) * 8192, wid, lane, sA, true);
            ATT_BAR();
            cur ^= 1; sA = sB; j = j1; j1 = j2; POP_BLOCK(j2);
        }
#undef POP_BLOCK
        acc_rows<false>(accw, sb_.o0, sb_.o1, gs[1] / fmaxf(full_sum(sb_.l), 1e-30f), wscr, r32, hi);
    }
    store_acc(accw, (bf16_t*)(p.ws + (PVAR ? WS_QP : WS_O)) + (size_t)(b * T + 64 * tile + 8 * wid) * D + g * 256, lane);
}

__device__ __forceinline__ void swa_unit(const Params& p, unsigned char* lds_generic, int b, int hh, int tile) {
    lptr lds = (lptr)lds_generic;
    const int tid = tid_opaque(), lane = tid & 63, wid = __builtin_amdgcn_readfirstlane(tid >> 6), r32 = lane & 31, hi = lane >> 5;
    const int h = r32 >> 3, qi = r32 & 7, tq = 8 * wid + qi, t = 64 * tile + tq, head = hh * 4 + h;
    const float slope = exp2f(-0.5f * (float)(head + 1)) * LOG2E;
    const unsigned char* ws = p.ws;
    ALAS float* wscr = (ALAS float*)(lds + L_WSCR) + wid * 64;
    const bf16_t* K = (const bf16_t*)(ws + WS_KSW) + (size_t)b * T * 64;
    const bf16_t* V = (const bf16_t*)(ws + WS_VSW) + (size_t)b * T * 64;
    bf16x8 qf[4];
    {
        const bf16_t* qp = (const bf16_t*)(ws + WS_QS) + ((size_t)(b * 8 + head) * T + t) * 64 + 8 * hi;
#pragma unroll
        for (int d0 = 0; d0 < 4; ++d0) qf[d0] = *(const bf16x8*)(qp + 16 * d0);
    }
    Br sw; sw.m = p.sinks[head] * LOG2E; sw.l = hi ? 0.f : 1.0f;
#pragma unroll
    for (int r = 0; r < 16; ++r) { sw.o0[r] = 0.f; sw.o1[r] = 0.f; }
    const int jlo = (tile - 2 > 0) ? tile - 2 : 0;
    Stage sA, sB; int cur = 0;
    stage_load(K + (size_t)tile * 4096, V + (size_t)tile * 4096, wid, lane, sA, true);
    stage_store(lds + L_K, lds + L_V, wid, lane, sA, true);
    ATT_BAR();
    if (tile - 1 >= jlo) stage_load(K + (size_t)(tile - 1) * 4096, V + (size_t)(tile - 1) * 4096, wid, lane, sA, true);
    for (int j = tile; j >= jlo; --j) {
        if (j - 2 >= jlo) stage_load(K + (size_t)(j - 2) * 4096, V + (size_t)(j - 2) * 4096, wid, lane, sB, true);
        const float cb = -slope * (float)(t - 64 * j);
        attend_tile(sw, lds + L_K + cur * 8192, lds + L_V + cur * 8192, qf, cb, slope, (j == tile) || (j == tile - 2), (j == tile) ? tq : 63, (j == tile - 2) ? tq : -1, wscr, lane, r32, hi);
        if (j > jlo) stage_store(lds + L_K + (cur ^ 1) * 8192, lds + L_V + (cur ^ 1) * 8192, wid, lane, sA, true);
        ATT_BAR();
        cur ^= 1; sA = sB;
    }
    ALAS float* accw = (ALAS float*)(lds + L_ACC) + wid * 2048;
    acc_rows<true>(accw, sw.o0, sw.o1, 1.0f / full_sum(sw.l), wscr, r32, hi);
    store_acc(accw, (bf16_t*)(p.ws + WS_O) + (size_t)(b * T + 64 * tile + 8 * wid) * D + 512 + hh * 256, lane);
}
__device__ __forceinline__ void swa_unit2(const Params& p, unsigned char* lds_generic, int b, int tile) {
    lptr lds = (lptr)lds_generic;
    const int tid = tid_opaque(), lane = tid & 63, wid = __builtin_amdgcn_readfirstlane(tid >> 6), r32 = lane & 31, hi = lane >> 5;
    const int h = r32 >> 3, qi = r32 & 7, tq = 8 * wid + qi, t = 64 * tile + tq;
    const unsigned char* ws = p.ws;
    ALAS float* wscr = (ALAS float*)(lds + L_WSCR) + wid * 64;
    ALAS float* accw = (ALAS float*)(lds + L_ACC) + wid * 2048;
    const bf16_t* K = (const bf16_t*)(ws + WS_KSW) + (size_t)b * T * 64;
    const bf16_t* V = (const bf16_t*)(ws + WS_VSW) + (size_t)b * T * 64;
    const int nt = (tile >= 2) ? 3 : tile + 1;
    Stage st[3];
#pragma unroll
    for (int jj = 0; jj < 3; ++jj) if (jj < nt) stage_load(K + (size_t)(tile - jj) * 4096, V + (size_t)(tile - jj) * 4096, wid, lane, st[jj], true);
#pragma unroll
    for (int jj = 0; jj < 3; ++jj) if (jj < nt) stage_store(lds + jj * 8192, lds + 24576 + jj * 8192, wid, lane, st[jj], true);
    ATT_BAR();
#pragma unroll 1
    for (int hh = 0; hh < 2; ++hh) {
        const int head = hh * 4 + h;
        const float slope = exp2f(-0.5f * (float)(head + 1)) * LOG2E;
        bf16x8 qf[4];
        {
            const bf16_t* qp = (const bf16_t*)(ws + WS_QS) + ((size_t)(b * 8 + head) * T + t) * 64 + 8 * hi;
#pragma unroll
            for (int d0 = 0; d0 < 4; ++d0) qf[d0] = *(const bf16x8*)(qp + 16 * d0);
        }
        Br sw; sw.m = p.sinks[head] * LOG2E; sw.l = hi ? 0.f : 1.0f;
#pragma unroll
        for (int r = 0; r < 16; ++r) { sw.o0[r] = 0.f; sw.o1[r] = 0.f; }
        for (int jj = 0; jj < nt; ++jj) {
            const int j = tile - jj;
            const float cb = -slope * (float)(t - 64 * j);
            attend_tile(sw, lds + jj * 8192, lds + 24576 + jj * 8192, qf, cb, slope, jj != 1, (jj == 0) ? tq : 63, (jj == 2) ? tq : -1, wscr, lane, r32, hi);
        }
        acc_rows<true>(accw, sw.o0, sw.o1, 1.0f / full_sum(sw.l), wscr, r32, hi);
        store_acc(accw, (bf16_t*)(p.ws + WS_O) + (size_t)(b * T + 64 * tile + 8 * wid) * D + 512 + hh * 256, lane);
    }
    ATT_BAR();
}
__device__ __forceinline__ void phase_swa_mfma(const Params& p, unsigned char* lds) {
    for (int u = blockIdx.x; u < BATCH * 2 * (T / 64); u += gridDim.x) swa_unit(p, lds, u >> 8, (u >> 7) & 1, u & 127);
}
template <int PVAR = 0>
__device__ __forceinline__ void phase_nsa_mfma(const Params& p, unsigned char* lds) {
    const int nu = BATCH * NSA_G * (T / 64);
    for (int i = blockIdx.x; i < nu; i += gridDim.x) {
        const int u = (i < (int)gridDim.x) ? (nu - 1 - i) : (i - (int)gridDim.x);
        nsa_unit<PVAR>(p, lds, u >> 8, (u >> 7) & 1, u & 127);
    }
}
}


namespace cmp {
#define CLAS __attribute__((address_space(3)))
constexpr int HS = 264;
__device__ __forceinline__ void compress_unit(const Params& p, unsigned char* lds_generic, int unit) {
    const unsigned char* ws = p.ws;
    const int tid = tid_opaque(), lane = tid & 63, wid = __builtin_amdgcn_readfirstlane(tid >> 6), fr = lane & 15, fq = lane >> 4;
    const int row0 = unit * 32, kv = row0 >> 11, bg = (row0 & 2047) >> 9, c0 = row0 & 511;
    const bf16_t* raw = (const bf16_t*)(ws + WS_KV6 + (size_t)kv * KV6_STRIDE) + (size_t)bg * T * 64;
    const bf16_t* W1T = (const bf16_t*)(ws + WS_W1T) + (size_t)kv * 256 * 2048;
    const bf16_t* W2T = (const bf16_t*)(ws + WS_W2T) + (size_t)kv * 64 * 256;
    const float* b1 = (const float*)(ws + WS_B1) + kv * 256;
    CLAS bf16_t* H = (CLAS bf16_t*)((CLAS unsigned char*)lds_generic);
    const int n0 = wid * 32;
    f32x4 acc[2][2];
#pragma unroll
    for (int i = 0; i < 2; ++i)
#pragma unroll
        for (int j = 0; j < 2; ++j) acc[i][j] = (f32x4){0.f, 0.f, 0.f, 0.f};
    constexpr int LS = 72;
    constexpr int A_BYTES = 32 * LS * 2, B_BYTES = 256 * LS * 2, ST_BYTES = A_BYTES + B_BYTES;
    CLAS unsigned char* sm = (CLAS unsigned char*)lds_generic;
    const int arow = tid >> 3, chunk = tid & 7;
    const bf16_t* ag = raw + (size_t)(c0 + arow) * 1024 + chunk * 8;
    const bf16_t* bgp = W1T + (size_t)arow * 2048 + chunk * 8;
    u32x4 sa, sb[4];
#define CMP_LOAD(k0_) do { if (tid < 256) sa = *(const u32x4*)(ag + (k0_)); _Pragma("unroll") for (int j_ = 0; j_ < 4; ++j_) sb[j_] = *(const u32x4*)(bgp + (size_t)j_ * 64 * 2048 + (k0_)); } while (0)
#define CMP_STORE(buf_) do { CLAS unsigned char* d_ = sm + (buf_) * ST_BYTES; if (tid < 256) *(CLAS u32x4*)(d_ + (arow * LS + chunk * 8) * 2) = sa; \
        _Pragma("unroll") for (int j_ = 0; j_ < 4; ++j_) *(CLAS u32x4*)(d_ + A_BYTES + ((arow + 64 * j_) * LS + chunk * 8) * 2) = sb[j_]; } while (0)
    CMP_LOAD(0); CMP_STORE(0);
    __syncthreads();
    for (int kt = 0; kt < 32; ++kt) {
        const int cur = kt & 1;
        if (kt + 1 < 32) CMP_LOAD((kt + 1) * 64);
        const CLAS unsigned char* As = sm + cur * ST_BYTES; const CLAS unsigned char* Bs = As + A_BYTES;
#pragma unroll
        for (int ks = 0; ks < 2; ++ks) {
            bf16x8 a[2], b[2];
#pragma unroll
            for (int i = 0; i < 2; ++i) { a[i] = *(const CLAS bf16x8*)(As + ((16 * i + fr) * LS + 32 * ks + 8 * fq) * 2); b[i] = *(const CLAS bf16x8*)(Bs + ((n0 + 16 * i + fr) * LS + 32 * ks + 8 * fq) * 2); }
#pragma unroll
            for (int i = 0; i < 2; ++i)
#pragma unroll
                for (int j = 0; j < 2; ++j) acc[i][j] = __builtin_amdgcn_mfma_f32_16x16x32_bf16(a[i], b[j], acc[i][j], 0, 0, 0);
        }
        if (kt + 1 < 32) CMP_STORE(cur ^ 1);
        __syncthreads();
    }
#undef CMP_LOAD
#undef CMP_STORE
#pragma unroll
    for (int i = 0; i < 2; ++i)
#pragma unroll
        for (int j = 0; j < 2; ++j) {
            const int n = n0 + 16 * j + fr; const float bias = b1[n];
#pragma unroll
            for (int r = 0; r < 4; ++r) H[(16 * i + 4 * fq + r) * HS + n] = (bf16_t)f2bf(gelu_tanh(acc[i][j][r] + bias));
        }
    __syncthreads();
    {
        const int mi = wid >> 2, nj = wid & 3;
        f32x4 o = (f32x4){0.f, 0.f, 0.f, 0.f};
        const CLAS bf16_t* hp = H + (16 * mi + fr) * HS + fq * 8;
        const bf16_t* wp = W2T + (size_t)(16 * nj + fr) * 256 + fq * 8;
#pragma unroll
        for (int k0 = 0; k0 < 256; k0 += 32) {
            const bf16x8 ha = *(const CLAS bf16x8*)(hp + k0), wb = *(const bf16x8*)(wp + k0);
            o = __builtin_amdgcn_mfma_f32_16x16x32_bf16(ha, wb, o, 0, 0, 0);
        }
        bf16_t* dst = (bf16_t*)(p.ws + (kv ? WS_VC : WS_KC)) + ((size_t)bg * NCMPP + c0 + 16 * mi + 4 * fq) * 64 + 16 * nj + fr;
#pragma unroll
        for (int r = 0; r < 4; ++r) dst[(size_t)r * 64] = (bf16_t)f2bf(o[r]);
    }
    __syncthreads();
}
__device__ __forceinline__ void phase_compress_swa(const Params& p, unsigned char* lds) {
    const int G = (int)gridDim.x, bx = (int)blockIdx.x;
    if (G >= 256) {
        if (bx < 128) { compress_unit(p, lds, bx); convert_expert_tables(p, 0, bx, 128); }
        else { for (int u = bx - 128; u < BATCH * (T / 64); u += G - 128) att::swa_unit2(p, lds, u >> 7, u & 127);
               convert_expert_tables(p, 1, bx - 128, G - 128); }
    } else {
        for (int u = bx; u < 128; u += G) compress_unit(p, lds, u);
        for (int u = bx; u < BATCH * (T / 64); u += G) att::swa_unit2(p, lds, u >> 7, u & 127);
        convert_expert_tables(p, 2, bx, G);
    }
}
}

#define XB_TMO      128
#define XB_XCNT(j)  (256  + 64 * (j))
#define XB_XSUB(j)  (1280 + 64 * (j))
#define XB_XGEN(j)  (2304 + 64 * (j))
#define XB_TOP      3328
#define XB_TOPGEN   3392
#define XCD_BAR_WORDS 3456
#define XB_SPIN_CAP (1u << 18)
#define XLAS __attribute__((address_space(3)))

__device__ __forceinline__ unsigned xb_ld(unsigned* p)              { return __hip_atomic_load(p, __ATOMIC_RELAXED, __HIP_MEMORY_SCOPE_AGENT); }
__device__ __forceinline__ unsigned xb_add(unsigned* p, unsigned v) { return __hip_atomic_fetch_add(p, v, __ATOMIC_RELAXED, __HIP_MEMORY_SCOPE_AGENT); }
__device__ __forceinline__ unsigned xb_xcc_id() { return (unsigned)__builtin_amdgcn_s_getreg((3 << 11) | 20) & 0xFu; }
#define XB_SPIN(cond, bar) do { unsigned _sp = 0; while (cond) { __builtin_amdgcn_s_sleep(1); \
    if ((++_sp & 255u) == 0u) { if (xb_ld(&(bar)[XB_TMO])) break; if (_sp > XB_SPIN_CAP) { atomicAdd(&(bar)[XB_TMO], 1u); break; } } } } while (0)

struct XcdBarrier {
    unsigned* bar; unsigned x;
    volatile XLAS unsigned* st;
};

__device__ __forceinline__ XcdBarrier xcd_barrier_post(unsigned* bar, volatile XLAS unsigned* st) {
    XcdBarrier b; b.bar = bar; b.x = xb_xcc_id(); b.st = st;
    if (threadIdx.x == 0) (void)xb_add(&bar[XB_XCNT(b.x)], 1u);
    return b;
}
__device__ __forceinline__ void xcd_barrier_complete(unsigned* bar, unsigned x, unsigned& nloc, unsigned& nx) {
    const unsigned G = gridDim.x * gridDim.y * gridDim.z;
    unsigned sum, cnt, mine, sp = 0u;
    for (;;) {
        sum = 0u; cnt = 0u; mine = 0u;
#pragma unroll
        for (unsigned j = 0; j < 16; ++j) { const unsigned c = xb_ld(&bar[XB_XCNT(j)]); sum += c; cnt += (c > 0u) ? 1u : 0u; mine = (j == x) ? c : mine; }
        if (sum == G) break;
        __builtin_amdgcn_s_sleep(1);
        if ((++sp & 255u) == 0u) { if (xb_ld(&bar[XB_TMO])) break; if (sp > XB_SPIN_CAP) { atomicAdd(&bar[XB_TMO], 1u); break; } }
    }
    nloc = mine > 0u ? mine : 1u; nx = cnt > 0u ? cnt : 1u;
}

__device__ __forceinline__ void xcd_barrier(const XcdBarrier& b) {
    asm volatile("s_waitcnt vmcnt(0)" ::: "memory");
    __syncthreads();
    if (threadIdx.x == 0) {
        unsigned* bar = b.bar;
        __builtin_amdgcn_s_waitcnt(0);
        unsigned nloc = b.st[0], nx = b.st[1];
        if (nloc == 0u) { xcd_barrier_complete(bar, b.x, nloc, nx); b.st[0] = nloc; b.st[1] = nx; }
        const unsigned old = xb_add(&bar[XB_XSUB(b.x)], 1u);
        const unsigned gen = old / nloc;
        if (old + 1u == (gen + 1u) * nloc) {
            __builtin_amdgcn_fence(__ATOMIC_RELEASE, "agent");
            asm volatile("s_waitcnt vmcnt(0)" ::: "memory");
            const unsigned og = xb_add(&bar[XB_TOP], 1u);
            const unsigned tg = og / nx;
            if (og + 1u == (tg + 1u) * nx) xb_add(&bar[XB_TOPGEN], 1u);
            else XB_SPIN(xb_ld(&bar[XB_TOPGEN]) == tg, bar);
            __builtin_amdgcn_fence(__ATOMIC_ACQUIRE, "agent");
            xb_add(&bar[XB_XGEN(b.x)], 1u);
            asm volatile("s_waitcnt vmcnt(0)" ::: "memory");
        } else {
            XB_SPIN(xb_ld(&bar[XB_XGEN(b.x)]) == gen, bar);
            __builtin_amdgcn_fence(__ATOMIC_ACQUIRE, "agent");
            asm volatile("s_waitcnt vmcnt(0)" ::: "memory");
        }
    }
    __syncthreads();
}


namespace pex {
constexpr int TOK_PER_TICKET = 8, NTICKET = NTOK / TOK_PER_TICKET;
__device__ __forceinline__ int claim(unsigned* ctr, int lane) {
    unsigned t = 0u;
    if (lane == 0) t = __hip_atomic_fetch_add(ctr, 1u, __ATOMIC_RELAXED, __HIP_MEMORY_SCOPE_AGENT);
    return __builtin_amdgcn_readfirstlane((int)t);
}
struct UMeta { int e_lo, e_hi; float g_lo, g_hi; u32x4 h0, h1; float ss; };
__device__ __forceinline__ void u_meta(const unsigned char* ws, int tok, int lane, unsigned loff, UMeta& m) {
    const int* ep = (const int*)(ws + WS_EIDX) + (size_t)tok * 128;
    m.e_lo = ep[lane]; m.e_hi = ep[64 + lane];
    const float* gp = (const float*)(ws + WS_GATE) + (size_t)tok * 128;
    m.g_lo = gp[lane]; m.g_hi = gp[64 + lane];
    const bf16_t* hg = (const bf16_t*)(ws + WS_H1G + (size_t)tok * D * 2) + loff;
    m.h0 = *(const u32x4*)hg; m.h1 = *(const u32x4*)(hg + 8);
    m.ss = ((const float*)(ws + WS_SS2))[tok];
}
constexpr int UB = 16;
__device__ __forceinline__ void u_task(const unsigned char* ws, int tok, int y, int lane, unsigned loff, const UMeta& m, int tok_next, UMeta& mn) {
    unsigned long long m0 = __ballot((m.e_lo >> 11) == y), m1 = __ballot((m.e_hi >> 11) == y);
    const unsigned char* U = ws + WS_U8;
    const int grp = (lane >> 3) & 7;
    bool first = true;
    f32x2 a2[8]; float rstd2 = 0.f;
    do {
        int slot[UB]; u32x4 uw[UB];
#pragma unroll
        for (int k = 0; k < UB; ++k) {
            int e = 0; slot[k] = -1;
            if (m0 != 0ull) { const int j = __builtin_ctzll(m0); m0 &= m0 - 1ull; slot[k] = j; e = __builtin_amdgcn_readlane(m.e_lo, j); }
            else if (m1 != 0ull) { const int j = __builtin_ctzll(m1); m1 &= m1 - 1ull; slot[k] = 64 + j; e = __builtin_amdgcn_readlane(m.e_hi, j); }
            if (slot[k] >= 0) uw[k] = *(const u32x4*)(U + (size_t)e * D + loff); else uw[k] = (u32x4){0u, 0u, 0u, 0u};
        }
        if (first) {
            if (tok_next >= 0) u_meta(ws, tok_next, lane, loff, mn);
            const u32x4 w0 = m.h0, w1 = m.h1;
            a2[0] = (f32x2){bflo(w0.x), bfhi(w0.x)}; a2[1] = (f32x2){bflo(w0.y), bfhi(w0.y)}; a2[2] = (f32x2){bflo(w0.z), bfhi(w0.z)}; a2[3] = (f32x2){bflo(w0.w), bfhi(w0.w)};
            a2[4] = (f32x2){bflo(w1.x), bfhi(w1.x)}; a2[5] = (f32x2){bflo(w1.y), bfhi(w1.y)}; a2[6] = (f32x2){bflo(w1.z), bfhi(w1.z)}; a2[7] = (f32x2){bflo(w1.w), bfhi(w1.w)};
            rstd2 = (1.0f / U8_SCALE) / sqrtf(m.ss * (1.0f / D) + EPS);
            first = false;
        }
#pragma unroll
        for (int hb = 0; hb < UB / 8; ++hb) {
            if (slot[8 * hb] < 0) break;
            float d[8];
#pragma unroll
            for (int k = 0; k < 8; ++k) {
                f32x2 dd = (f32x2){0.f, 0.f};
#pragma unroll
                for (int q = 0; q < 4; ++q) {
                    const f32x2 lo = __builtin_amdgcn_cvt_pk_f32_fp8((int)uw[8 * hb + k][q], false), hi = __builtin_amdgcn_cvt_pk_f32_fp8((int)uw[8 * hb + k][q], true);
                    dd += a2[2 * q] * lo; dd += a2[2 * q + 1] * hi;
                }
                d[k] = dd.x + dd.y;
                __builtin_amdgcn_sched_barrier(0);
            }
            const float dk = reduce8(d, lane);
            int myslot = -1;
#pragma unroll
            for (int k = 0; k < 8; ++k) myslot = (grp == k) ? slot[8 * hb + k] : myslot;
            const float gA = __shfl(m.g_lo, myslot & 63), gB = __shfl(m.g_hi, myslot & 63);
            const float g = (myslot & 64) ? gB : gA;
            if (myslot >= 0 && (lane & 7) == 0) ((float*)(ws + WS_PW))[(size_t)tok * 128 + myslot] = g * gelu_tanh(dk * rstd2);
        }
    } while ((m0 | m1) != 0ull);
}
struct VMeta { u32x4 e[4]; };
__device__ __forceinline__ void v_meta(const Params& p, int tok, int y, int lane, VMeta& m) {
    const unsigned char* ep = p.ws + WS_EIDX + ((size_t)(lane >> 3) * NTOK + tok) * 64;
#pragma unroll
    for (int q = 0; q < 4; ++q) m.e[q] = *(const u32x4*)(ep + 16 * q);
}
__device__ __forceinline__ void ucol_task(const Params& p, int tok, int y, int lane, const VMeta& m, int tok_next, VMeta& mn) {
    const int cc = lane & 7;
    const bool b2 = lane & 4, b1 = lane & 2, b0 = lane & 1;
    const __amdgpu_buffer_rsrc_t ru = __builtin_amdgcn_make_buffer_rsrc((void*)(p.ws + WS_U8 + (size_t)y * ((size_t)NEXP * 128)), (short)0, NEXP * 128, 0x00020000);
    const unsigned coff = (unsigned)cc * 16u;
    u32x4 uw[16];
#pragma unroll
    for (int q = 0; q < 4; ++q) {
        uw[4 * q] = __builtin_bit_cast(u32x4, __builtin_amdgcn_raw_buffer_load_b128(ru, (int)(m.e[q].x * 128u + coff), 0, 0));
        uw[4 * q + 1] = __builtin_bit_cast(u32x4, __builtin_amdgcn_raw_buffer_load_b128(ru, (int)(m.e[q].y * 128u + coff), 0, 0));
        uw[4 * q + 2] = __builtin_bit_cast(u32x4, __builtin_amdgcn_raw_buffer_load_b128(ru, (int)(m.e[q].z * 128u + coff), 0, 0));
        uw[4 * q + 3] = __builtin_bit_cast(u32x4, __builtin_amdgcn_raw_buffer_load_b128(ru, (int)(m.e[q].w * 128u + coff), 0, 0));
    }
    f32x2 a2[8];
    {
        const unsigned char* hp = p.ws + WS_H1G + (size_t)tok * D * 2 + (size_t)y * 256;
        const u32x4 w0 = *(const u32x4*)(hp + cc * 32u), w1 = *(const u32x4*)(hp + cc * 32u + 16u);
        a2[0] = (f32x2){bflo(w0.x), bfhi(w0.x)}; a2[1] = (f32x2){bflo(w0.y), bfhi(w0.y)}; a2[2] = (f32x2){bflo(w0.z), bfhi(w0.z)}; a2[3] = (f32x2){bflo(w0.w), bfhi(w0.w)};
        a2[4] = (f32x2){bflo(w1.x), bfhi(w1.x)}; a2[5] = (f32x2){bflo(w1.y), bfhi(w1.y)}; a2[6] = (f32x2){bflo(w1.z), bfhi(w1.z)}; a2[7] = (f32x2){bflo(w1.w), bfhi(w1.w)};
    }
    if (tok_next >= 0) v_meta(p, tok_next, y, lane, mn);
    float d[16];
#pragma unroll
    for (int i = 0; i < 16; ++i) {
        f32x2 dd = (f32x2){0.f, 0.f};
#pragma unroll
        for (int q = 0; q < 4; ++q) {
            const f32x2 lo = __builtin_amdgcn_cvt_pk_f32_fp8((int)uw[i][q], false), hi = __builtin_amdgcn_cvt_pk_f32_fp8((int)uw[i][q], true);
            dd += a2[2 * q] * lo; dd += a2[2 * q + 1] * hi;
        }
        d[i] = dd.x + dd.y;
        __builtin_amdgcn_sched_barrier(0);
    }
    float s8[8], s4[4], s2[2];
#pragma unroll
    for (int i = 0; i < 8; ++i) { const float snd = b2 ? d[i] : d[i + 8], keep = b2 ? d[i + 8] : d[i]; s8[i] = keep + __shfl_xor(snd, 4); }
#pragma unroll
    for (int i = 0; i < 4; ++i) { const float snd = b1 ? s8[i] : s8[i + 4], keep = b1 ? s8[i + 4] : s8[i]; s4[i] = keep + __shfl_xor(snd, 2); }
#pragma unroll
    for (int i = 0; i < 2; ++i) { const float snd = b0 ? s4[i] : s4[i + 2], keep = b0 ? s4[i + 2] : s4[i]; s2[i] = keep + __shfl_xor(snd, 1); }
    const unsigned so = (unsigned)(16 * (lane >> 3) + (b2 ? 8 : 0) + (b1 ? 4 : 0) + (b0 ? 2 : 0)) * 2u;
    *(unsigned*)(p.ws + WS_PART + ((size_t)tok * 8 + y) * 256 + so) = pk2(s2[0], s2[1]);
}
__device__ __forceinline__ void phase_expert_act(const Params& p) {
    const int tid_ = tid_opaque(), lane = tid_ & 63;
    const int gw = (int)blockIdx.x * (NTHREADS / 64) + __builtin_amdgcn_readfirstlane(tid_ >> 6), ngw = (int)gridDim.x * (NTHREADS / 64);
    for (int tok = gw; tok < NTOK; tok += ngw) {
        const bf16_t* pp = (const bf16_t*)(p.ws + WS_PART) + (size_t)tok * 1024;
        float sa = 0.f, sb = 0.f;
#pragma unroll
        for (int y = 0; y < (U_FP4 ? NSL4 : 8); ++y) { sa += bf2f(pp[y * 128 + lane]); sb += bf2f(pp[y * 128 + 64 + lane]); }
        const float rstd2 = ((U_FP4 && U_INT4) ? 256.0f / (UI_SCALE * HQ_SCALE) : 1.0f / (U_FP4 ? U4_SCALE : U8_SCALE)) / sqrtf(((const float*)(p.ws + WS_SS2))[tok] * (1.0f / D) + EPS);
        const size_t hm_lo = ((size_t)(lane >> 4) * NTOK + tok) * 16 + (lane & 15), hm_hi = ((size_t)(4 + (lane >> 4)) * NTOK + tok) * 16 + (lane & 15);
        const float* gsrc = (const float*)(p.ws + WS_GATE);
        float* wp = (float*)(p.ws + WS_PW) + (size_t)tok * 128;
        const float wa = gsrc[hm_lo] * gelu_tanh(sa * rstd2), wb = gsrc[hm_hi] * gelu_tanh(sb * rstd2);
        wp[lane] = wa; wp[64 + lane] = wb;
        if (V_MFMA) {
            float mx = fmaxf(fabsf(wa), fabsf(wb));
#pragma unroll
            for (int o = 1; o < 64; o <<= 1) mx = fmaxf(mx, __shfl_xor(mx, o));
            mx = fmaxf(mx, 1e-30f);
            const int ex = (int)((__float_as_uint(mx) >> 23) & 255u) - 126;
            const float sc = __uint_as_float((unsigned)(127 + 8 - ex) << 23);
            unsigned char* row = p.ws + WS_VREC + (size_t)tok * 1024 + 512;
            ((int*)(row - 512))[lane] = ((const int*)(p.ws + WS_EIDX))[hm_lo]; ((int*)(row - 512))[64 + lane] = ((const int*)(p.ws + WS_EIDX))[hm_hi];
#pragma unroll
            for (int hf = 0; hf < 2; ++hf) {
                const int o = 64 * hf + lane;
                const int sg = 8 * (o & 15) + (o >> 4);
                const int G = sg >> 5, rho = sg & 31, pos = (((rho >> 2) & 3) * 4 + G) * 8 + (rho >> 4) * 4 + (rho & 3);
                const float x = (hf ? wb : wa) * sc;
                const int b0 = __builtin_amdgcn_cvt_pk_fp8_f32(x, x, 0, false) & 255;
                const float r1 = (x - __builtin_amdgcn_cvt_f32_fp8(b0, 0)) * 16.0f;
                const int b1 = __builtin_amdgcn_cvt_pk_fp8_f32(r1, r1, 0, false) & 255;
                const float r2 = (r1 - __builtin_amdgcn_cvt_f32_fp8(b1, 0)) * 16.0f;
                const int b2 = __builtin_amdgcn_cvt_pk_fp8_f32(r2, r2, 0, false) & 255;
                row[pos] = (unsigned char)b0; row[128 + pos] = (unsigned char)b1; row[256 + pos] = (unsigned char)b2;
            }
            if (lane == 0) *(float*)(row + 384) = __uint_as_float((unsigned)(127 + ex - 8) << 23) * (1.0f / V4_SCALE);
        }
    }
}
__device__ __forceinline__ void v_task(const Params& p, int tok, int y, int lane, const VMeta& m, int tok_next, VMeta& mn) {
    const int cc = lane & 7;
    const bool b5 = lane & 32, b4 = lane & 16, b3 = lane & 8;
    const __amdgpu_buffer_rsrc_t rv = __builtin_amdgcn_make_buffer_rsrc((void*)(p.ws + WS_V8 + (size_t)y * ((size_t)NEXP * 128)), (short)0, NEXP * 128, 0x00020000);
    const unsigned coff = (unsigned)cc * 16u;
    u32x4 vw[16];
#pragma unroll
    for (int q = 0; q < 4; ++q) {
        vw[4 * q] = __builtin_bit_cast(u32x4, __builtin_amdgcn_raw_buffer_load_b128(rv, (int)(m.e[q].x * 128u + coff), 0, 0));
        vw[4 * q + 1] = __builtin_bit_cast(u32x4, __builtin_amdgcn_raw_buffer_load_b128(rv, (int)(m.e[q].y * 128u + coff), 0, 0));
        vw[4 * q + 2] = __builtin_bit_cast(u32x4, __builtin_amdgcn_raw_buffer_load_b128(rv, (int)(m.e[q].z * 128u + coff), 0, 0));
        vw[4 * q + 3] = __builtin_bit_cast(u32x4, __builtin_amdgcn_raw_buffer_load_b128(rv, (int)(m.e[q].w * 128u + coff), 0, 0));
    }
    f32x4 w[4];
    {
        const unsigned char* wp = p.ws + WS_PW + (size_t)tok * 512;
        const unsigned woff = (unsigned)(lane >> 3) * 64u;
#pragma unroll
        for (int q = 0; q < 4; ++q) w[q] = *(const f32x4*)(wp + woff + 16 * q);
    }
    const unsigned colb = (unsigned)(128 * y + 16 * cc + (b5 ? 8 : 0) + (b4 ? 4 : 0) + (b3 ? 2 : 0)) * 4u;
    const unsigned hb = *(const unsigned*)(p.ws + WS_H1G + (size_t)tok * D * 2 + (colb >> 1));
    const f32x2 g2v = *(const f32x2*)((const unsigned char*)p.ln2_g + colb);
    const f32x2 h = (f32x2){bflo(hb) / g2v.x, bfhi(hb) / g2v.y};
    if (tok_next >= 0) v_meta(p, tok_next, y, lane, mn);
    f32x2 acc2[8];
#pragma unroll
    for (int q = 0; q < 8; ++q) acc2[q] = (f32x2){0.f, 0.f};
#pragma unroll
    for (int i = 0; i < 16; ++i) {
        const float wi = w[i >> 2][i & 3];
#pragma unroll
        for (int q = 0; q < 4; ++q) {
            const f32x2 lo = __builtin_amdgcn_cvt_pk_f32_fp8((int)vw[i][q], false), hi = __builtin_amdgcn_cvt_pk_f32_fp8((int)vw[i][q], true);
            acc2[2 * q] += lo * wi; acc2[2 * q + 1] += hi * wi;
        }
        __builtin_amdgcn_sched_barrier(0);
    }
    float acc[16];
#pragma unroll
    for (int q = 0; q < 8; ++q) { acc[2 * q] = acc2[q].x; acc[2 * q + 1] = acc2[q].y; }
    float s8[8], s4[4], s2[2];
#pragma unroll
    for (int i = 0; i < 8; ++i) { const float snd = b5 ? acc[i] : acc[i + 8], keep = b5 ? acc[i + 8] : acc[i]; s8[i] = keep + __shfl_xor(snd, 32); }
#pragma unroll
    for (int i = 0; i < 4; ++i) { const float snd = b4 ? s8[i] : s8[i + 4], keep = b4 ? s8[i + 4] : s8[i]; s4[i] = keep + __shfl_xor(snd, 16); }
#pragma unroll
    for (int i = 0; i < 2; ++i) { const float snd = b3 ? s4[i] : s4[i + 2], keep = b3 ? s4[i + 2] : s4[i]; s2[i] = keep + __shfl_xor(snd, 8); }
    *(unsigned*)(p.ws + WS_H2 + (size_t)tok * D * 2 + (colb >> 1)) = pk2(h.x + s2[0] * (1.0f / V8_SCALE), h.y + s2[1] * (1.0f / V8_SCALE));
}

__device__ __forceinline__ void unpack32_fp4(const u32x4& w, f32x2 (&f)[16]) {
#pragma unroll
    for (int q = 0; q < 4; ++q) {
        f[4 * q + 0] = __builtin_amdgcn_cvt_scalef32_pk_f32_fp4(w[q], 1.0f, 0);
        f[4 * q + 1] = __builtin_amdgcn_cvt_scalef32_pk_f32_fp4(w[q], 1.0f, 1);
        f[4 * q + 2] = __builtin_amdgcn_cvt_scalef32_pk_f32_fp4(w[q], 1.0f, 2);
        f[4 * q + 3] = __builtin_amdgcn_cvt_scalef32_pk_f32_fp4(w[q], 1.0f, 3);
    }
}
__device__ __forceinline__ void ucol4_task(const Params& p, int tok, int z, int lane, const VMeta& m, int tok_next, VMeta& mn) {
    const int cc = lane & 7;
    const bool b2 = lane & 4, b1 = lane & 2, b0 = lane & 1;
    const __amdgpu_buffer_rsrc_t ru = __builtin_amdgcn_make_buffer_rsrc((void*)(p.ws + WS_U8 + (size_t)z * ((size_t)NEXP * 128)), (short)0, NEXP * 128, 0x00020000);
    const unsigned coff = (unsigned)cc * 16u;
    u32x4 uw[16];
#pragma unroll
    for (int q = 0; q < 4; ++q) {
        uw[4 * q] = __builtin_bit_cast(u32x4, __builtin_amdgcn_raw_buffer_load_b128(ru, (int)(m.e[q].x * 128u + coff), 0, 0));
        uw[4 * q + 1] = __builtin_bit_cast(u32x4, __builtin_amdgcn_raw_buffer_load_b128(ru, (int)(m.e[q].y * 128u + coff), 0, 0));
        uw[4 * q + 2] = __builtin_bit_cast(u32x4, __builtin_amdgcn_raw_buffer_load_b128(ru, (int)(m.e[q].z * 128u + coff), 0, 0));
        uw[4 * q + 3] = __builtin_bit_cast(u32x4, __builtin_amdgcn_raw_buffer_load_b128(ru, (int)(m.e[q].w * 128u + coff), 0, 0));
    }
    f32x2 a2[16];
    {
        const unsigned char* hp = p.ws + WS_H1G + (size_t)tok * D * 2 + (size_t)z * 512 + cc * 64u;
#pragma unroll
        for (int q = 0; q < 4; ++q) {
            const u32x4 w = *(const u32x4*)(hp + 16 * q);
            a2[4 * q] = (f32x2){bflo(w.x), bfhi(w.x)}; a2[4 * q + 1] = (f32x2){bflo(w.y), bfhi(w.y)}; a2[4 * q + 2] = (f32x2){bflo(w.z), bfhi(w.z)}; a2[4 * q + 3] = (f32x2){bflo(w.w), bfhi(w.w)};
        }
    }
    if (tok_next >= 0) v_meta(p, tok_next, z, lane, mn);
    float d[16];
#pragma unroll
    for (int i = 0; i < 16; ++i) {
        f32x2 uf[16]; unpack32_fp4(uw[i], uf);
        f32x2 dd = (f32x2){0.f, 0.f};
#pragma unroll
        for (int q = 0; q < 16; ++q) dd += a2[q] * uf[q];
        d[i] = dd.x + dd.y;
        __builtin_amdgcn_sched_barrier(0);
    }
    float s8[8], s4[4], s2[2];
#pragma unroll
    for (int i = 0; i < 8; ++i) { const float snd = b2 ? d[i] : d[i + 8], keep = b2 ? d[i + 8] : d[i]; s8[i] = keep + __shfl_xor(snd, 4); }
#pragma unroll
    for (int i = 0; i < 4; ++i) { const float snd = b1 ? s8[i] : s8[i + 4], keep = b1 ? s8[i + 4] : s8[i]; s4[i] = keep + __shfl_xor(snd, 2); }
#pragma unroll
    for (int i = 0; i < 2; ++i) { const float snd = b0 ? s4[i] : s4[i + 2], keep = b0 ? s4[i + 2] : s4[i]; s2[i] = keep + __shfl_xor(snd, 1); }
    const unsigned so = (unsigned)(16 * (lane >> 3) + (b2 ? 8 : 0) + (b1 ? 4 : 0) + (b0 ? 2 : 0)) * 2u;
    *(unsigned*)(p.ws + WS_PART + ((size_t)tok * 8 + z) * 256 + so) = pk2(s2[0], s2[1]);
}
__device__ __forceinline__ void v4_task(const Params& p, int tok, int z, int lane, const VMeta& m, int tok_next, VMeta& mn) {
    const int cc = lane & 7;
    const bool b5 = lane & 32, b4 = lane & 16, b3 = lane & 8;
    const __amdgpu_buffer_rsrc_t rv = __builtin_amdgcn_make_buffer_rsrc((void*)(p.ws + WS_V8 + (size_t)z * ((size_t)NEXP * 128)), (short)0, NEXP * 128, 0x00020000);
    const unsigned coff = (unsigned)cc * 16u;
    u32x4 vw[16];
#pragma unroll
    for (int q = 0; q < 4; ++q) {
        vw[4 * q] = __builtin_bit_cast(u32x4, __builtin_amdgcn_raw_buffer_load_b128(rv, (int)(m.e[q].x * 128u + coff), 0, 0));
        vw[4 * q + 1] = __builtin_bit_cast(u32x4, __builtin_amdgcn_raw_buffer_load_b128(rv, (int)(m.e[q].y * 128u + coff), 0, 0));
        vw[4 * q + 2] = __builtin_bit_cast(u32x4, __builtin_amdgcn_raw_buffer_load_b128(rv, (int)(m.e[q].z * 128u + coff), 0, 0));
        vw[4 * q + 3] = __builtin_bit_cast(u32x4, __builtin_amdgcn_raw_buffer_load_b128(rv, (int)(m.e[q].w * 128u + coff), 0, 0));
    }
    f32x4 w[4];
    {
        const unsigned char* wp = p.ws + WS_PW + (size_t)tok * 512;
        const unsigned woff = (unsigned)(lane >> 3) * 64u;
#pragma unroll
        for (int q = 0; q < 4; ++q) w[q] = *(const f32x4*)(wp + woff + 16 * q);
    }
    const unsigned col = (unsigned)(256 * z + 32 * cc + (b5 ? 16 : 0) + (b4 ? 8 : 0) + (b3 ? 4 : 0));
    const u32x2 hb = *(const u32x2*)(p.ws + WS_H1G + (size_t)tok * D * 2 + col * 2u);
    const f32x4 g2v = *(const f32x4*)(p.ln2_g + col);
    if (tok_next >= 0) v_meta(p, tok_next, z, lane, mn);
    f32x2 acc2[16];
#pragma unroll
    for (int q = 0; q < 16; ++q) acc2[q] = (f32x2){0.f, 0.f};
#pragma unroll
    for (int i = 0; i < 16; ++i) {
        const float wi = w[i >> 2][i & 3];
        f32x2 vf[16]; unpack32_fp4(vw[i], vf);
#pragma unroll
        for (int q = 0; q < 16; ++q) acc2[q] += vf[q] * wi;
        __builtin_amdgcn_sched_barrier(0);
    }
    float acc[32];
#pragma unroll
    for (int q = 0; q < 16; ++q) { acc[2 * q] = acc2[q].x; acc[2 * q + 1] = acc2[q].y; }
    float s16[16], s8[8], s4[4];
#pragma unroll
    for (int i = 0; i < 16; ++i) { const float snd = b5 ? acc[i] : acc[i + 16], keep = b5 ? acc[i + 16] : acc[i]; s16[i] = keep + __shfl_xor(snd, 32); }
#pragma unroll
    for (int i = 0; i < 8; ++i) { const float snd = b4 ? s16[i] : s16[i + 8], keep = b4 ? s16[i + 8] : s16[i]; s8[i] = keep + __shfl_xor(snd, 16); }
#pragma unroll
    for (int i = 0; i < 4; ++i) { const float snd = b3 ? s8[i] : s8[i + 4], keep = b3 ? s8[i + 4] : s8[i]; s4[i] = keep + __shfl_xor(snd, 8); }
    const float h0 = bflo(hb.x) / g2v.x + s4[0] * (1.0f / V4_SCALE), h1 = bfhi(hb.x) / g2v.y + s4[1] * (1.0f / V4_SCALE);
    const float h2 = bflo(hb.y) / g2v.z + s4[2] * (1.0f / V4_SCALE), h3 = bfhi(hb.y) / g2v.w + s4[3] * (1.0f / V4_SCALE);
    *(u32x2*)(p.ws + WS_H2 + (size_t)tok * D * 2 + col * 2u) = (u32x2){pk2(h0, h1), pk2(h2, h3)};
}

__device__ __forceinline__ void quantize_h(const Params& p) {
    const int tid_ = tid_opaque(), lane = tid_ & 63;
    const int gw = (int)blockIdx.x * (NTHREADS / 64) + __builtin_amdgcn_readfirstlane(tid_ >> 6), ngw = (int)gridDim.x * (NTHREADS / 64);
    for (int tok = gw; tok < NTOK; tok += ngw) {
        const bf16_t* hrow = (const bf16_t*)(p.ws + WS_H1G + (size_t)tok * D * 2) + 16 * lane;
        const u32x4 w0 = *(const u32x4*)hrow, w1 = *(const u32x4*)(hrow + 8);
        const float f[16] = {bflo(w0.x), bfhi(w0.x), bflo(w0.y), bfhi(w0.y), bflo(w0.z), bfhi(w0.z), bflo(w0.w), bfhi(w0.w),
                             bflo(w1.x), bfhi(w1.x), bflo(w1.y), bfhi(w1.y), bflo(w1.z), bfhi(w1.z), bflo(w1.w), bfhi(w1.w)};
        unsigned pa[2] = {0u, 0u}, pb[2] = {0u, 0u};
#pragma unroll
        for (int i = 0; i < 16; ++i) {
            int q = (int)rintf(f[i] * HQ_SCALE); q = q < -120 ? -120 : (q > 119 ? 119 : q);
            pb[i >> 3] |= ((unsigned)q & 15u) << (4 * (i & 7));
            pa[i >> 3] |= ((unsigned)((q + 8) >> 4) & 15u) << (4 * (i & 7));
        }
        *(u32x2*)(p.ws + WS_HQA + (size_t)tok * 512 + lane * 8) = (u32x2){pa[0], pa[1]};
        *(u32x2*)(p.ws + WS_HQB + (size_t)tok * 512 + lane * 8) = (u32x2){pb[0], pb[1]};
    }
}
__device__ __forceinline__ void ucoli_task(const Params& p, int tok, int z, int lane, const VMeta& m, int tok_next, VMeta& mn) {
    const int cc = lane & 7;
    const bool b2 = lane & 4, b1 = lane & 2, b0 = lane & 1;
    const __amdgpu_buffer_rsrc_t ru = __builtin_amdgcn_make_buffer_rsrc((void*)(p.ws + WS_U8 + (size_t)z * ((size_t)NEXP * 128)), (short)0, NEXP * 128, 0x00020000);
    const unsigned coff = (unsigned)cc * 16u;
    u32x4 uw[16];
#pragma unroll
    for (int q = 0; q < 4; ++q) {
        uw[4 * q] = __builtin_bit_cast(u32x4, __builtin_amdgcn_raw_buffer_load_b128(ru, (int)(m.e[q].x * 128u + coff), 0, 0));
        uw[4 * q + 1] = __builtin_bit_cast(u32x4, __builtin_amdgcn_raw_buffer_load_b128(ru, (int)(m.e[q].y * 128u + coff), 0, 0));
        uw[4 * q + 2] = __builtin_bit_cast(u32x4, __builtin_amdgcn_raw_buffer_load_b128(ru, (int)(m.e[q].z * 128u + coff), 0, 0));
        uw[4 * q + 3] = __builtin_bit_cast(u32x4, __builtin_amdgcn_raw_buffer_load_b128(ru, (int)(m.e[q].w * 128u + coff), 0, 0));
    }
    const u32x4 pa = *(const u32x4*)(p.ws + WS_HQA + (size_t)tok * 512 + z * 128 + coff);
    const u32x4 pb = *(const u32x4*)(p.ws + WS_HQB + (size_t)tok * 512 + z * 128 + coff);
    if (tok_next >= 0) v_meta(p, tok_next, z, lane, mn);
    float d[16];
#pragma unroll
    for (int i = 0; i < 16; ++i) {
        int sa = 0, sb = 0;
#pragma unroll
        for (int q = 0; q < 4; ++q) { sa = __builtin_amdgcn_sdot8((int)uw[i][q], (int)pa[q], sa, false); sb = __builtin_amdgcn_sdot8((int)uw[i][q], (int)pb[q], sb, false); }
        d[i] = (float)(16 * sa + sb);
    }
    float s8[8], s4[4], s2[2];
#pragma unroll
    for (int i = 0; i < 8; ++i) { const float snd = b2 ? d[i] : d[i + 8], keep = b2 ? d[i + 8] : d[i]; s8[i] = keep + __shfl_xor(snd, 4); }
#pragma unroll
    for (int i = 0; i < 4; ++i) { const float snd = b1 ? s8[i] : s8[i + 4], keep = b1 ? s8[i + 4] : s8[i]; s4[i] = keep + __shfl_xor(snd, 2); }
#pragma unroll
    for (int i = 0; i < 2; ++i) { const float snd = b0 ? s4[i] : s4[i + 2], keep = b0 ? s4[i + 2] : s4[i]; s2[i] = keep + __shfl_xor(snd, 1); }
    const unsigned so = (unsigned)(16 * (lane >> 3) + (b2 ? 8 : 0) + (b1 ? 4 : 0) + (b0 ? 2 : 0)) * 2u;
    *(unsigned*)(p.ws + WS_PART + ((size_t)tok * 8 + z) * 256 + so) = pk2(s2[0] * (1.0f / 256.0f), s2[1] * (1.0f / 256.0f));
}
template <bool VPHASE, int PROBE = 0>
__device__ __forceinline__ void phase_sliced(const Params& p_in) {
    Params p = p_in; if (PROBE) p.out = (float*)(p_in.ws + WS_QP);
    const int tid_ = tid_opaque(), lane = tid_ & 63;
    const unsigned loff = 16u * (unsigned)lane;
    unsigned* ctr = (unsigned*)(p.ws + WS_CTR + (VPHASE ? 2048 : 0) + PROBE * 4096);
    constexpr bool FP4 = VPHASE ? V_FP4 : U_FP4;
    constexpr int NSL = FP4 ? NSL4 : 8;
    const int x0 = (int)(xb_xcc_id() & 7u);
    for (int k = 0; k < NSL; ++k) {
        const int y = (x0 + k) & (NSL - 1);
        int tk = claim(ctr + y * 64, lane);
        if (tk >= NTICKET) continue;
        VMeta vm, vmn;
        v_meta(p, tk * TOK_PER_TICKET, y, lane, vm);
        while (tk < NTICKET) {
            const int tkn = claim(ctr + y * 64, lane);
#pragma unroll 1
            for (int i = 0; i < TOK_PER_TICKET; ++i) {
                const int tok = tk * TOK_PER_TICKET + i;
                const int tok_next = (i + 1 < TOK_PER_TICKET) ? tok + 1 : ((tkn < NTICKET) ? tkn * TOK_PER_TICKET : -1);
                if (VPHASE) { if (FP4) v4_task(p, tok, y, lane, vm, tok_next, vmn); else v_task(p, tok, y, lane, vm, tok_next, vmn); vm = vmn; }
                else { if (FP4 && U_INT4) ucoli_task(p, tok, y, lane, vm, tok_next, vmn); else if (FP4) ucol4_task(p, tok, y, lane, vm, tok_next, vmn); else ucol_task(p, tok, y, lane, vm, tok_next, vmn); vm = vmn; }
            }
            tk = tkn;
        }
    }
}
typedef int v8i __attribute__((ext_vector_type(8)));
#define VM_WAIT(n) asm volatile("s_waitcnt vmcnt(" #n ")" ::: "memory")
#define VM_ROWS(G, m0_, m1_, m2_, m3_) do { \
        __builtin_amdgcn_raw_ptr_buffer_load_lds(rv, (ALAS void*)(lw + (G) * 4096), 16, (int)((m0_) * 128u + coff), 0, 0, 0); \
        __builtin_amdgcn_raw_ptr_buffer_load_lds(rv, (ALAS void*)(lw + (G) * 4096 + 1024), 16, (int)((m1_) * 128u + coff), 0, 0, 0); \
        __builtin_amdgcn_raw_ptr_buffer_load_lds(rv, (ALAS void*)(lw + (G) * 4096 + 2048), 16, (int)((m2_) * 128u + coff), 0, 0, 0); \
        __builtin_amdgcn_raw_ptr_buffer_load_lds(rv, (ALAS void*)(lw + (G) * 4096 + 3072), 16, (int)((m3_) * 128u + coff), 0, 0, 0); } while (0)
#define VM_REC(tok_, par_) __builtin_amdgcn_raw_ptr_buffer_load_lds(rrec, (ALAS void*)(lw + 16384 + (par_) * 1024), 16, (int)((unsigned)(tok_) * 1024u + 16u * (unsigned)lane), 0, 0, 0)
#define VM_EIDX(par_) do { const unsigned ea_ = lwa0 + 16384u + (unsigned)(par_) * 1024u + (unsigned)(lane >> 3) * 64u; \
        asm volatile("ds_read_b128 %0, %4\n\tds_read_b128 %1, %4 offset:16\n\tds_read_b128 %2, %4 offset:32\n\tds_read_b128 %3, %4 offset:48\n\ts_waitcnt lgkmcnt(0)" \
                     : "=&v"(e0), "=&v"(e1), "=&v"(e2), "=&v"(e3) : "v"(ea_) : "memory"); } while (0)
#define VM_STAGE(G, lastN, m0_, m1_, m2_, m3_) do { \
        if (T1 >= 0) VM_WAIT(12); else VM_WAIT(lastN); \
        u32x2 t00, t01, t10, t11, t20, t21, t30, t31; \
        asm volatile("ds_read_b64_tr_b16 %0, %8 offset:" #G "*4096\n\tds_read_b64_tr_b16 %1, %8 offset:" #G "*4096+512\n\t" \
                     "ds_read_b64_tr_b16 %2, %9 offset:" #G "*4096\n\tds_read_b64_tr_b16 %3, %9 offset:" #G "*4096+512\n\t" \
                     "ds_read_b64_tr_b16 %4, %10 offset:" #G "*4096\n\tds_read_b64_tr_b16 %5, %10 offset:" #G "*4096+512\n\t" \
                     "ds_read_b64_tr_b16 %6, %11 offset:" #G "*4096\n\tds_read_b64_tr_b16 %7, %11 offset:" #G "*4096+512\n\t" \
                     "s_waitcnt lgkmcnt(0)" \
                     : "=&v"(t00), "=&v"(t01), "=&v"(t10), "=&v"(t11), "=&v"(t20), "=&v"(t21), "=&v"(t30), "=&v"(t31) \
                     : "v"(ta0), "v"(ta1), "v"(ta2), "v"(ta3) : "memory"); \
        if ((G) == 0 && T1 >= 0) VM_EIDX(par ^ 1); \
        if (T1 >= 0) VM_ROWS(G, m0_, m1_, m2_, m3_); \
        const unsigned wlo_ = (G) == 0 ? bw0.x : ((G) == 1 ? bw0.z : ((G) == 2 ? bw1.x : bw1.z)), whi_ = (G) == 0 ? bw0.y : ((G) == 1 ? bw0.w : ((G) == 2 ? bw1.y : bw1.w)); \
        const v8i B_ = (v8i){(int)__builtin_amdgcn_perm(0u, wlo_, sel0), (int)__builtin_amdgcn_perm(0u, wlo_, sel1), (int)__builtin_amdgcn_perm(0u, wlo_, sel2), (int)__builtin_amdgcn_perm(0u, wlo_, sel3), \
                             (int)__builtin_amdgcn_perm(0u, whi_, sel0), (int)__builtin_amdgcn_perm(0u, whi_, sel1), (int)__builtin_amdgcn_perm(0u, whi_, sel2), (int)__builtin_amdgcn_perm(0u, whi_, sel3)}; \
        acc0 = __builtin_amdgcn_mfma_scale_f32_16x16x128_f8f6f4((v8i){(int)t00.x, (int)t00.y, (int)t01.x, (int)t01.y, 0, 0, 0, 0}, B_, acc0, 4, 0, 0, 0x7F7F7F7F, 0, 0x7F7F7F7F); \
        acc1 = __builtin_amdgcn_mfma_scale_f32_16x16x128_f8f6f4((v8i){(int)t10.x, (int)t10.y, (int)t11.x, (int)t11.y, 0, 0, 0, 0}, B_, acc1, 4, 0, 0, 0x7F7F7F7F, 0, 0x7F7F7F7F); \
        acc2 = __builtin_amdgcn_mfma_scale_f32_16x16x128_f8f6f4((v8i){(int)t20.x, (int)t20.y, (int)t21.x, (int)t21.y, 0, 0, 0, 0}, B_, acc2, 4, 0, 0, 0x7F7F7F7F, 0, 0x7F7F7F7F); \
        acc3 = __builtin_amdgcn_mfma_scale_f32_16x16x128_f8f6f4((v8i){(int)t30.x, (int)t30.y, (int)t31.x, (int)t31.y, 0, 0, 0, 0}, B_, acc3, 4, 0, 0, 0x7F7F7F7F, 0, 0x7F7F7F7F); \
    } while (0)
constexpr int V_LDS_PER_WAVE = 18432;
__device__ __forceinline__ void phase_v_mfma(const Params& p, unsigned char* lds_generic) {
    const int tid_ = tid_opaque(), lane = tid_ & 63, wid = __builtin_amdgcn_readfirstlane(tid_ >> 6);
    att::lptr lw = (att::lptr)lds_generic + wid * V_LDS_PER_WAVE;
    const int n = lane & 15, g = lane >> 4, tr_r = n >> 2, tr_c = n & 3;
    const unsigned lwa0 = (unsigned)(size_t)lw;
    const unsigned lwa = lwa0 + (unsigned)((8 * g + tr_r) * 128 + 8 * tr_c);
    const unsigned ta0 = lwa + (unsigned)((0 ^ tr_r) * 32), ta1 = lwa + (unsigned)((1 ^ tr_r) * 32), ta2 = lwa + (unsigned)((2 ^ tr_r) * 32), ta3 = lwa + (unsigned)((3 ^ tr_r) * 32);
    const unsigned coff = (2u * ((unsigned)((lane & 7) >> 1) ^ (unsigned)((lane >> 3) & 3)) + (unsigned)(lane & 1)) * 16u;
    const int sp = n >> 2, ds = n & 3;
    const unsigned selz = 0x0C0C0C0Cu;
    const unsigned sel0 = sp == 3 ? selz : (selz ^ ((0x0Cu ^ 0u) << (8 * ds))), sel1 = sp == 3 ? selz : (selz ^ ((0x0Cu ^ 1u) << (8 * ds)));
    const unsigned sel2 = sp == 3 ? selz : (selz ^ ((0x0Cu ^ 2u) << (8 * ds))), sel3 = sp == 3 ? selz : (selz ^ ((0x0Cu ^ 3u) << (8 * ds)));
    const float fsp = sp == 0 ? 1.0f : (sp == 1 ? 1.0f / 16.0f : (sp == 2 ? 1.0f / 256.0f : 0.0f));
    const unsigned bwa = 512u + (unsigned)((sp > 2 ? 2 : sp) * 128 + g * 32);
    unsigned* ctr = (unsigned*)(p.ws + WS_CTR + 2048);
    const __amdgpu_buffer_rsrc_t rrec = __builtin_amdgcn_make_buffer_rsrc((void*)(p.ws + WS_VREC), (short)0, NTOK * 1024, 0x00020000);
    const int x0 = (int)(xb_xcc_id() & 7u);
    for (int k = 0; k < NSL4; ++k) {
        const int z = (x0 + k) & (NSL4 - 1);
        int tk = claim(ctr + z * 64, lane);
        if (tk >= NTICKET) continue;
        int tkn = claim(ctr + z * 64, lane);
        const __amdgpu_buffer_rsrc_t rv = __builtin_amdgcn_make_buffer_rsrc((void*)(p.ws + WS_V8 + (size_t)z * ((size_t)NEXP * 128)), (short)0, NEXP * 128, 0x00020000);
        int i = 0, T0 = tk * TOK_PER_TICKET, par = 0;
        u32x4 e0, e1, e2, e3;
        VM_REC(T0, 0);
        VM_WAIT(0);
        VM_EIDX(0);
        if (1 < TOK_PER_TICKET) VM_REC(T0 + 1, 1);
        VM_ROWS(0, e0.x, e0.y, e0.z, e0.w); VM_ROWS(1, e1.x, e1.y, e1.z, e1.w); VM_ROWS(2, e2.x, e2.y, e2.z, e2.w); VM_ROWS(3, e3.x, e3.y, e3.z, e3.w);
#pragma unroll 1
        while (true) {
            int T1, T2;
            { const int i1 = i + 1, i2 = i + 2;
              T1 = (i1 < TOK_PER_TICKET) ? tk * TOK_PER_TICKET + i1 : ((tkn < NTICKET) ? tkn * TOK_PER_TICKET + (i1 - TOK_PER_TICKET) : -1);
              T2 = (i2 < TOK_PER_TICKET) ? tk * TOK_PER_TICKET + i2 : ((tkn < NTICKET) ? tkn * TOK_PER_TICKET + (i2 - TOK_PER_TICKET) : -1); }
            u32x4 bw0, bw1; float osc;
            { const unsigned ba_ = lwa0 + 16384u + (unsigned)par * 1024u;
              asm volatile("ds_read_b128 %0, %3\n\tds_read_b128 %1, %3 offset:16\n\tds_read_b32 %2, %4 offset:896\n\ts_waitcnt lgkmcnt(0)"
                           : "=&v"(bw0), "=&v"(bw1), "=&v"(osc) : "v"(ba_ + bwa), "v"(ba_) : "memory"); }
            if (T2 >= 0) VM_REC(T2, par);
            f32x4 acc0 = (f32x4){0.f, 0.f, 0.f, 0.f}, acc1 = acc0, acc2 = acc0, acc3 = acc0;
            VM_STAGE(0, 12, e0.x, e0.y, e0.z, e0.w); VM_STAGE(1, 8, e1.x, e1.y, e1.z, e1.w); VM_STAGE(2, 4, e2.x, e2.y, e2.z, e2.w); VM_STAGE(3, 0, e3.x, e3.y, e3.z, e3.w);
            float o[16];
#pragma unroll
            for (int q = 0; q < 4; ++q) {
                const f32x4 a = q == 0 ? acc0 : (q == 1 ? acc1 : (q == 2 ? acc2 : acc3));
#pragma unroll
                for (int r = 0; r < 4; ++r) {
                    float v = a[r] * fsp;
                    v += __int_as_float(__builtin_amdgcn_update_dpp(0, __float_as_int(v), 0x124, 0xF, 0xF, false));
                    v += __int_as_float(__builtin_amdgcn_update_dpp(0, __float_as_int(v), 0x128, 0xF, 0xF, false));
                    o[4 * q + r] = v * osc;
                }
            }
            if (n < 4) {
                unsigned char* op = p.ws + WS_H2 + (size_t)T0 * D * 2 + (size_t)(256 * z + 64 * g + 16 * ds) * 2;
                const u32x4 oa = (u32x4){pk2(o[0], o[1]), pk2(o[2], o[3]), pk2(o[4], o[5]), pk2(o[6], o[7])}, ob = (u32x4){pk2(o[8], o[9]), pk2(o[10], o[11]), pk2(o[12], o[13]), pk2(o[14], o[15])};
                asm volatile("global_store_dwordx4 %0, %1, off\n\tglobal_store_dwordx4 %0, %2, off offset:16\n\ts_nop 3" :: "v"(op), "v"(oa), "v"(ob) : "memory");
            }
            if (T1 < 0) break;
            T0 = T1; par ^= 1;
            if (++i == TOK_PER_TICKET) { i = 0; tk = tkn; tkn = claim(ctr + z * 64, lane); }
        }
    }
    asm volatile("s_waitcnt vmcnt(0)" ::: "memory");
}
#undef VM_STAGE
#undef VM_ROWS
#undef VM_REC
#undef VM_EIDX
#undef VM_WAIT
__device__ __forceinline__ void phase_final_norm(const Params& p) {
    const int tid_ = tid_opaque(), lane = tid_ & 63;
    const int gw = (int)blockIdx.x * (NTHREADS / 64) + __builtin_amdgcn_readfirstlane(tid_ >> 6), ngw = (int)gridDim.x * (NTHREADS / 64);
    const unsigned loff = 16u * (unsigned)lane;
    f32x4 g[4];
#pragma unroll
    for (int q = 0; q < 4; ++q) g[q] = *(const f32x4*)(p.lnf_g + loff + 4 * q);
    f32x4 rg2[4];
#pragma unroll
    for (int q = 0; q < 4; ++q) { const f32x4 t = *(const f32x4*)(p.ln2_g + loff + 4 * q); rg2[q] = (f32x4){1.0f / t.x, 1.0f / t.y, 1.0f / t.z, 1.0f / t.w}; }
    for (int tok0 = gw * 4; tok0 < NTOK; tok0 += ngw * 4) {
        u32x4 w0[4], w1[4];
#pragma unroll
        for (int r = 0; r < 4; ++r) {
            const bf16_t* hrow = (const bf16_t*)(p.ws + WS_H2 + (size_t)(tok0 + r) * D * 2) + loff;
            w0[r] = *(const u32x4*)hrow; w1[r] = *(const u32x4*)(hrow + 8);
        }
        f32x4 y[4][4]; float ss[4];
#pragma unroll
        for (int r = 0; r < 4; ++r) {
            y[r][0] = (f32x4){bflo(w0[r].x), bfhi(w0[r].x), bflo(w0[r].y), bfhi(w0[r].y)}; y[r][1] = (f32x4){bflo(w0[r].z), bfhi(w0[r].z), bflo(w0[r].w), bfhi(w0[r].w)};
            y[r][2] = (f32x4){bflo(w1[r].x), bfhi(w1[r].x), bflo(w1[r].y), bfhi(w1[r].y)}; y[r][3] = (f32x4){bflo(w1[r].z), bfhi(w1[r].z), bflo(w1[r].w), bfhi(w1[r].w)};
            if (V_MFMA) {
                const bf16_t* grow = (const bf16_t*)(p.ws + WS_H1G + (size_t)(tok0 + r) * D * 2) + loff;
                const u32x4 a0 = *(const u32x4*)grow, a1 = *(const u32x4*)(grow + 8);
                y[r][0] += (f32x4){bflo(a0.x), bfhi(a0.x), bflo(a0.y), bfhi(a0.y)} * rg2[0]; y[r][1] += (f32x4){bflo(a0.z), bfhi(a0.z), bflo(a0.w), bfhi(a0.w)} * rg2[1];
                y[r][2] += (f32x4){bflo(a1.x), bfhi(a1.x), bflo(a1.y), bfhi(a1.y)} * rg2[2]; y[r][3] += (f32x4){bflo(a1.z), bfhi(a1.z), bflo(a1.w), bfhi(a1.w)} * rg2[3];
            }
            ss[r] = 0.f;
#pragma unroll
            for (int q = 0; q < 4; ++q) ss[r] += (y[r][q].x * y[r][q].x + y[r][q].y * y[r][q].y) + (y[r][q].z * y[r][q].z + y[r][q].w * y[r][q].w);
        }
#pragma unroll
        for (int o = 1; o < 64; o <<= 1) {
#pragma unroll
            for (int r = 0; r < 4; ++r) ss[r] += __shfl_xor(ss[r], o);
        }
#pragma unroll
        for (int r = 0; r < 4; ++r) {
            const float rstd = 1.0f / sqrtf(ss[r] * (1.0f / D) + EPS);
            float* orow = (float*)((unsigned char*)p.out + (size_t)(tok0 + r) * D * 4) + loff;
#pragma unroll
            for (int q = 0; q < 4; ++q) *(f32x4*)(orow + 4 * q) = (f32x4){y[r][q].x * rstd * g[q].x, y[r][q].y * rstd * g[q].y, y[r][q].z * rstd * g[q].z, y[r][q].w * rstd * g[q].w};
        }
    }
}
}

constexpr int LDS_BYTES = 148480;
extern __shared__ __attribute__((aligned(16))) unsigned char dyn_lds[];

__device__ __forceinline__ Params load_params() {
#if !defined(__HIP_DEVICE_COMPILE__)
    return Params{};
#else
    const __attribute__((address_space(4))) unsigned char* ka = (const __attribute__((address_space(4))) unsigned char*)__builtin_amdgcn_kernarg_segment_ptr();
    asm volatile("" : "+s"(ka));
    const __attribute__((address_space(4))) Params* kp = (const __attribute__((address_space(4))) Params*)ka;
    Params r;
    r.x = kp->x; r.ln1_g = kp->ln1_g; r.w_in = kp->w_in; r.pe_k = kp->pe_k; r.w1_k = kp->w1_k; r.w2_k = kp->w2_k; r.pe_v = kp->pe_v; r.w1_v = kp->w1_v; r.w2_v = kp->w2_v;
    r.sinks = kp->sinks; r.w_out = kp->w_out; r.ln2_g = kp->ln2_g; r.wq = kp->wq; r.pkeys = kp->pkeys; r.pu = kp->pu; r.pv = kp->pv; r.lnf_g = kp->lnf_g; r.out = kp->out; r.ws = kp->ws;
    return r;
#endif
}
__global__ void __launch_bounds__(NTHREADS, 2) fwd_megakernel(Params p_unused) {
    cg::grid_group grid = cg::this_grid();
    float* lds = (float*)dyn_lds;
    PG8_LAS unsigned char* ldsp = (PG8_LAS unsigned char*)dyn_lds;
    volatile XLAS unsigned* bst = (volatile XLAS unsigned*)((XLAS unsigned char*)dyn_lds + (LDS_BYTES - 16));
    if (threadIdx.x < 4) bst[threadIdx.x] = 0u;
    __syncthreads();
    { const Params p = load_params(); (void)xcd_barrier_post((unsigned*)(p.ws + WS_BAR), bst); }
#define GRID_BARRIER() do { const Params p_ = load_params(); XcdBarrier xb_; xb_.bar = (unsigned*)(p_.ws + WS_BAR); xb_.x = xb_xcc_id(); \
        xb_.st = (volatile XLAS unsigned*)((XLAS unsigned char*)dyn_lds + (LDS_BYTES - 16)); xcd_barrier(xb_); } while (0)
    for (int rep = 0; rep < 1 + PROBE_PREP; ++rep) { const Params p = load_params(); phase_prep(p); }
    if (gridDim.y == 0x7fffu) grid.sync();
    GRID_BARRIER();
    for (int rep = 0; rep < 1 + PROBE_PROJ; ++rep) { const Params p = load_params();
      pg8::Gemm g{(const bf16_t*)(p.ws + WS_XN), (const bf16_t*)(p.ws + WS_WIN), NTOK, DINP, D}; pg8::StaticOrder S; S.init(NTOK, DINP, (int)gridDim.x, (int)blockIdx.x);
      EpiProjT E{p.ws}; pg8::gemm_phase<EpiProjT, pg8::StaticOrder, true, true>(ldsp, g, S, E); }
    GRID_BARRIER();
    for (int rep = 0; rep < 1 + PROBE_CS; ++rep) { const Params p = load_params(); cmp::phase_compress_swa(p, dyn_lds); }
    GRID_BARRIER();
    { const Params p = load_params(); att::phase_nsa_mfma<0>(p, dyn_lds); }
#if PROBE_NSA
    { const Params p = load_params(); att::phase_nsa_mfma<PROBE_NSA>(p, dyn_lds); }
#endif
    GRID_BARRIER();
    { const Params p = load_params();
      pg8::Gemm g{(const bf16_t*)(p.ws + WS_O), (const bf16_t*)(p.ws + WS_WOUT), NTOK, D, D}; pg8::StaticOrder S; S.init(NTOK, D, (int)gridDim.x, (int)blockIdx.x);
      EpiOutT E{p.x, p.ln2_g, p.out, (bf16_t*)(p.ws + WS_H1G), (float*)(p.ws + WS_SS2)}; pg8::gemm_phase<EpiOutT, pg8::StaticOrder, true, true>(ldsp, g, S, E); }
    GRID_BARRIER();
    for (int rep = 0; rep < 1 + PROBE_QP; ++rep) { const Params p = load_params();
      pg8::Gemm g{(const bf16_t*)(p.ws + WS_H1G), (const bf16_t*)(p.ws + WS_WQ), NTOK, PQ, D}; pg8::StaticOrder S; S.init(NTOK, PQ, (int)gridDim.x, (int)blockIdx.x);
      EpiQPT E{(const float*)(p.ws + WS_SS2), (bf16_t*)(p.ws + WS_QP)}; pg8::gemm_phase<EpiQPT, pg8::StaticOrder, true, true>(ldsp, g, S, E); }
    GRID_BARRIER();
    if (U_FP4 && U_INT4) { const Params p = load_params(); pex::quantize_h(p); }
    for (int rep = 0; rep < 1 + PROBE_SEL; ++rep) { const Params p = load_params(); psel::phase_peer_select(p, dyn_lds); }
    GRID_BARRIER();
    { const Params p = load_params(); pex::phase_sliced<false>(p); }
#if PROBE_PEXU
    { const Params p = load_params(); pex::phase_sliced<false, 1>(p); }
#endif
    GRID_BARRIER();
    for (int rep = 0; rep < 1 + PROBE_ACT; ++rep) { const Params p = load_params(); pex::phase_expert_act(p); }
    GRID_BARRIER();
    { const Params p = load_params(); if (V_MFMA) pex::phase_v_mfma(p, dyn_lds); else pex::phase_sliced<true>(p); }
#if PROBE_PEXV
    { const Params p = load_params(); pex::phase_sliced<true, 1>(p); }
#endif
    GRID_BARRIER();
    { const Params p = load_params(); pex::phase_final_norm(p); }
}

extern "C" void kernel_launch(void* const* d_in, const int* in_sizes, int n_in, void* d_out, int out_size, void* d_ws, size_t ws_size, hipStream_t stream) {
    if (n_in != 17 || ws_size < WS_END) { fprintf(stderr, "kernel_launch: unexpected inputs (n_in %d, ws %zu)\n", n_in, ws_size); return; }
    static int grid_blocks = 0;
    if (!grid_blocks) {
        int dev = 0, cus = 0, per_cu = 0;
        (void)hipGetDevice(&dev);
        (void)hipDeviceGetAttribute(&cus, hipDeviceAttributeMultiprocessorCount, dev);
        (void)hipFuncSetAttribute((const void*)fwd_megakernel, hipFuncAttributeMaxDynamicSharedMemorySize, LDS_BYTES);
        (void)hipOccupancyMaxActiveBlocksPerMultiprocessor(&per_cu, (const void*)fwd_megakernel, NTHREADS, LDS_BYTES);
        if (per_cu < 1) per_cu = 1;
        grid_blocks = cus * per_cu;
        fprintf(stderr, "kernel_launch: %d CUs x %d blocks/CU\n", cus, per_cu);
    }
    Params p{};
    p.x = (const float*)d_in[0]; p.ln1_g = (const float*)d_in[1]; p.w_in = (const float*)d_in[2];
    p.pe_k = (const float*)d_in[3]; p.w1_k = (const float*)d_in[4]; p.w2_k = (const float*)d_in[5];
    p.pe_v = (const float*)d_in[6]; p.w1_v = (const float*)d_in[7]; p.w2_v = (const float*)d_in[8];
    p.sinks = (const float*)d_in[9]; p.w_out = (const float*)d_in[10]; p.ln2_g = (const float*)d_in[11];
    p.wq = (const float*)d_in[12]; p.pkeys = (const float*)d_in[13]; p.pu = (const float*)d_in[14]; p.pv = (const float*)d_in[15];
    p.lnf_g = (const float*)d_in[16];
    p.out = (float*)d_out; p.ws = (unsigned char*)d_ws;
    (void)hipMemsetAsync((unsigned char*)d_ws + WS_BAR, 0, 16 * 1024 + 8192, stream);
    void* args[] = {&p};
    hipError_t e = hipLaunchCooperativeKernel((void*)fwd_megakernel, dim3(grid_blocks), dim3(NTHREADS), args, LDS_BYTES, stream);
    if (e != hipSuccess) fprintf(stderr, "cooperative launch failed: %s (grid %d)\n", hipGetErrorString(e), grid_blocks);
}
```

```cpp
#include <hip/hip_runtime.h>
#include <hip/hip_cooperative_groups.h>
#include <cstdint>
#include <cstdio>
namespace cg = cooperative_groups;
#define PROBE_PREP 0
#define PROBE_COMPRESS 0
#define PROBE_SWA 0
#define PROBE_NSA 0
#define PROBE_SUB 0
#define PROBE_COMB 0
#define PROBE_PEXU 0
#define PROBE_PEXV 0
#define PROBE_PROJ 0
#define PROBE_QP 0
#define PROBE_SEL 0
#define PROBE_CS 0
#define PROBE_ACT 0

typedef unsigned short bf16_t;
typedef short bf16x8 __attribute__((ext_vector_type(8)));
typedef float f32x4 __attribute__((ext_vector_type(4)));
typedef unsigned u32x4 __attribute__((ext_vector_type(4)));
typedef unsigned u32x2 __attribute__((ext_vector_type(2)));
__device__ __forceinline__ void st_wt8(void* p, u32x2 v) { asm volatile("global_store_dwordx2 %0, %1, off sc0 sc1" :: "v"(p), "v"(v) : "memory"); }

constexpr int BATCH = 2, T = 8192, D = 1024, NTOK = BATCH * T;
constexpr int HD = 64, NSA_H = 8, NSA_G = 2, NSA_HG = 4, SWA_H = 8;
constexpr int DIN = 1944, DINP = 2048;
constexpr int NCMP = 511, NCMPP = 512, NSEL = 128, TOPN = 16;
constexpr int NSA_WIN = 512, SWA_WIN = 128;
constexpr int PH = 8, PNK = 128, PDK = 256, PTOPK = 16, PQ = PH * PDK;
constexpr int NEXP = PNK * PNK;
constexpr float EPS = 1e-6f;
constexpr int NTHREADS = 512;
constexpr bool V_MFMA = true;
constexpr bool U_FP4 = true, V_FP4 = true, U_INT4 = true;

constexpr size_t MiB = 1u << 20;
constexpr size_t WS_SS2 = 0;
constexpr size_t WS_BAR = 128 * 1024;
constexpr size_t WS_WIN = 1 * MiB;
constexpr size_t WS_WOUT = 5 * MiB;
constexpr size_t WS_WQ = 7 * MiB;
constexpr size_t WS_PKEYS = 11 * MiB;
constexpr size_t WS_W1T = 12 * MiB;
constexpr size_t WS_W2T = 14 * MiB;
constexpr size_t WS_B1 = 14 * MiB + 512 * 1024;
constexpr size_t WS_XN = 16 * MiB;
constexpr size_t WS_O = WS_XN;
constexpr size_t WS_HQA = WS_XN;
constexpr size_t WS_HQB = WS_XN + 8 * MiB;
constexpr size_t WS_H2 = WS_XN;
constexpr size_t WS_QN = 48 * MiB;
constexpr size_t WS_QS = 64 * MiB;
constexpr size_t WS_KV6 = 80 * MiB;
constexpr size_t KV6_STRIDE = 4 * MiB;
constexpr size_t WS_KSW = 104 * MiB;
constexpr size_t WS_VSW = 106 * MiB;
constexpr size_t WS_GSIG = 108 * MiB;
constexpr size_t WS_KC = 110 * MiB;
constexpr size_t WS_VC = 110 * MiB + 512 * 1024;
constexpr size_t WS_H1G = 48 * MiB;
constexpr size_t WS_QP = 80 * MiB;
constexpr size_t WS_EIDX = 144 * MiB;
constexpr size_t WS_GATE = 152 * MiB;
constexpr size_t WS_U8 = 160 * MiB;
constexpr size_t WS_PART = 80 * MiB;
constexpr size_t WS_V8 = 176 * MiB;
constexpr size_t WS_VREC = 232 * MiB;
constexpr size_t WS_PW = 224 * MiB;
constexpr size_t WS_CTR = 128 * 1024 + 16 * 1024;
constexpr size_t WS_TOPV2 = 224 * MiB;
constexpr size_t WS_TOPI2 = 240 * MiB;
constexpr size_t WS_END = 256 * MiB;

struct Params {
    const float* x; const float* ln1_g; const float* w_in;
    const float* pe_k; const float* w1_k; const float* w2_k;
    const float* pe_v; const float* w1_v; const float* w2_v;
    const float* sinks; const float* w_out; const float* ln2_g;
    const float* wq; const float* pkeys; const float* pu; const float* pv; const float* lnf_g;
    float* out; unsigned char* ws;
};

__device__ __forceinline__ int tid_opaque() { int t = (int)threadIdx.x; asm volatile("" : "+v"(t)); return t; }
__device__ __forceinline__ unsigned f2bf(float f) { unsigned u = __float_as_uint(f); return (u + 0x7fffu + ((u >> 16) & 1u)) >> 16; }
__device__ __forceinline__ float bf2f(unsigned h) { return __uint_as_float(h << 16); }
__device__ __forceinline__ float bflo(unsigned w) { return __uint_as_float(w << 16); }
__device__ __forceinline__ float bfhi(unsigned w) { return __uint_as_float(w & 0xffff0000u); }
__device__ __forceinline__ unsigned pk2(float lo, float hi) { return f2bf(lo) | (f2bf(hi) << 16); }
__device__ __forceinline__ float wave_sum(float v) {
#pragma unroll
    for (int o = 1; o < 64; o <<= 1) v += __shfl_xor(v, o);
    return v;
}
__device__ __forceinline__ float gelu_tanh(float x) {
    const float u = 0.7978845608028654f * (x + 0.044715f * x * x * x);
    return 0.5f * x * (1.0f + tanhf(u));
}
__device__ __forceinline__ int win_orig_col(int n) {
    if (n < 1280) return n;
    if (n < 1792) return 1304 + (n - 1280);
    if (n < 1856) return 1816 + (n - 1792);
    if (n < 1920) return 1880 + (n - 1856);
    if (n < 1944) return 1280 + (n - 1920);
    return -1;
}

template <bool WIN_MAP>
__device__ __forceinline__ void prep_transpose(const float* W, int K, int N, int NP, bf16_t* WT, long gt, long ngt) {
    const long items = (long)NP * (K / 8);
    for (long it = gt; it < items; it += ngt) {
        const int n = (int)(it % NP), k0 = (int)(it / NP) * 8;
        const int col = WIN_MAP ? win_orig_col(n) : n;
        float v[8];
#pragma unroll
        for (int i = 0; i < 8; ++i) v[i] = (col >= 0) ? W[(size_t)(k0 + i) * N + col] : 0.f;
        u32x4 o; o.x = pk2(v[0], v[1]); o.y = pk2(v[2], v[3]); o.z = pk2(v[4], v[5]); o.w = pk2(v[6], v[7]);
        *(u32x4*)(WT + (size_t)n * K + k0) = o;
    }
}
__device__ __forceinline__ void prep_convert(const float* src, bf16_t* dst, long n8, long gt, long ngt) {
    for (long it = gt; it < n8; it += ngt) {
        const f32x4 a = *(const f32x4*)(src + it * 8), b = *(const f32x4*)(src + it * 8 + 4);
        u32x4 o; o.x = pk2(a.x, a.y); o.y = pk2(a.z, a.w); o.z = pk2(b.x, b.y); o.w = pk2(b.z, b.w);
        *(u32x4*)(dst + it * 8) = o;
    }
}
constexpr float U8_SCALE = 256.0f, V8_SCALE = 16.0f;
constexpr float U4_SCALE = 64.0f, V4_SCALE = 5.656854249f;
constexpr float UI_SCALE = 91.4285714f, HQ_SCALE = 16.0f;
constexpr int NSL4 = 4;
__device__ __forceinline__ void prep_convert_fp8(const float* src, unsigned char* dst, long n16, float sc, long gt, long ngt) {
    for (long it = gt; it < n16; it += ngt) {
        u32x4 o;
#pragma unroll
        for (int q = 0; q < 4; ++q) {
            const f32x4 a = *(const f32x4*)(src + it * 16 + q * 4);
            int w = 0;
            w = __builtin_amdgcn_cvt_pk_fp8_f32(a.x * sc, a.y * sc, w, false);
            w = __builtin_amdgcn_cvt_pk_fp8_f32(a.z * sc, a.w * sc, w, true);
            o[q] = (unsigned)w;
        }
        *(u32x4*)(dst + it * 16) = o;
    }
}
__device__ __forceinline__ void prep_convert_fp8_sliced(const float* src, unsigned char* dst, long n16, float sc, long gt, long ngt) {
    for (long it = gt; it < n16; it += ngt) {
        u32x4 o;
#pragma unroll
        for (int q = 0; q < 4; ++q) {
            const f32x4 a = *(const f32x4*)(src + it * 16 + q * 4);
            int w = 0;
            w = __builtin_amdgcn_cvt_pk_fp8_f32(a.x * sc, a.y * sc, w, false);
            w = __builtin_amdgcn_cvt_pk_fp8_f32(a.z * sc, a.w * sc, w, true);
            o[q] = (unsigned)w;
        }
        const long e = (it * 16) >> 10; const int col = (int)((it * 16) & 1023);
        *(u32x4*)(dst + (size_t)(col >> 7) * ((size_t)NEXP * 128) + e * 128 + (col & 127)) = o;
    }
}
__device__ __forceinline__ void prep_convert_fp4_sliced(const float* src, unsigned char* dst, long n32, float sc, long gt, long ngt) {
    for (long it = gt; it < n32; it += ngt) {
        u32x4 o;
#pragma unroll
        for (int q = 0; q < 4; ++q) {
            const f32x4 a = *(const f32x4*)(src + it * 32 + q * 8), b = *(const f32x4*)(src + it * 32 + q * 8 + 4);
            unsigned w = 0u;
            w = __builtin_amdgcn_cvt_scalef32_pk_fp4_f32(w, a.x * sc, a.y * sc, 1.0f, 0);
            w = __builtin_amdgcn_cvt_scalef32_pk_fp4_f32(w, a.z * sc, a.w * sc, 1.0f, 1);
            w = __builtin_amdgcn_cvt_scalef32_pk_fp4_f32(w, b.x * sc, b.y * sc, 1.0f, 2);
            w = __builtin_amdgcn_cvt_scalef32_pk_fp4_f32(w, b.z * sc, b.w * sc, 1.0f, 3);
            o[q] = w;
        }
        const long e = (it * 32) >> 10; const int col = (int)((it * 32) & 1023);
        *(u32x4*)(dst + (size_t)(col >> 8) * ((size_t)NEXP * 128) + e * 128 + ((col & 255) >> 1)) = o;
    }
}
__device__ __forceinline__ void prep_convert_fp4_vperm(const float* src, unsigned char* dst, long n32, float sc, long gt, long ngt) {
    for (long it = gt; it < n32; it += ngt) {
        const long e = it >> 5; const int z = (int)(it >> 3) & 3, q = (int)it & 3, hh = (int)(it >> 2) & 1;
        const float* sp = src + e * 1024 + 256 * z + 128 * hh + 4 * q;
        u32x4 o;
#pragma unroll
        for (int gl = 0; gl < 2; ++gl) {
            const f32x4 l0 = *(const f32x4*)(sp + 64 * gl), l1 = *(const f32x4*)(sp + 64 * gl + 16), l2 = *(const f32x4*)(sp + 64 * gl + 32), l3 = *(const f32x4*)(sp + 64 * gl + 48);
#pragma unroll
            for (int wh = 0; wh < 2; ++wh) {
                const int r0 = 2 * wh, r1 = 2 * wh + 1;
                unsigned w = 0u;
                w = __builtin_amdgcn_cvt_scalef32_pk_fp4_f32(w, l0[r0] * sc, l1[r0] * sc, 1.0f, 0);
                w = __builtin_amdgcn_cvt_scalef32_pk_fp4_f32(w, l2[r0] * sc, l3[r0] * sc, 1.0f, 1);
                w = __builtin_amdgcn_cvt_scalef32_pk_fp4_f32(w, l0[r1] * sc, l1[r1] * sc, 1.0f, 2);
                w = __builtin_amdgcn_cvt_scalef32_pk_fp4_f32(w, l2[r1] * sc, l3[r1] * sc, 1.0f, 3);
                o[2 * gl + wh] = w;
            }
        }
        *(u32x4*)(dst + (size_t)z * ((size_t)NEXP * 128) + e * 128 + 32 * q + 16 * hh) = o;
    }
}
__device__ __forceinline__ void prep_convert_int4_sliced(const float* src, unsigned char* dst, long n32, float sc, long gt, long ngt) {
    for (long it = gt; it < n32; it += ngt) {
        u32x4 o;
#pragma unroll
        for (int q = 0; q < 4; ++q) {
            const f32x4 a = *(const f32x4*)(src + it * 32 + q * 8), b = *(const f32x4*)(src + it * 32 + q * 8 + 4);
            const float f[8] = {a.x, a.y, a.z, a.w, b.x, b.y, b.z, b.w};
            unsigned w = 0u;
#pragma unroll
            for (int i = 0; i < 8; ++i) { int v = (int)rintf(f[i] * sc); v = v < -7 ? -7 : (v > 7 ? 7 : v); w |= ((unsigned)v & 15u) << (4 * i); }
            o[q] = w;
        }
        const long e = (it * 32) >> 10; const int col = (int)((it * 32) & 1023);
        *(u32x4*)(dst + (size_t)(col >> 8) * ((size_t)NEXP * 128) + e * 128 + ((col & 255) >> 1)) = o;
    }
}
constexpr int CONV_HEAVY_PCT = 42;
__device__ __forceinline__ void convert_expert_tables(const Params& p, int part  , int bi, int nblk) {
    constexpr long ITEMS_U = (long)NEXP * D / (U_FP4 ? 32 : 16), ITEMS_V = (long)NEXP * D / (V_FP4 ? 32 : 16);
    constexpr long FU = ITEMS_U * CONV_HEAVY_PCT / 100, FV = ITEMS_V * CONV_HEAVY_PCT / 100;
    const long ulo = part == 1 ? FU : 0, uhi = part == 0 ? FU : ITEMS_U, vlo = part == 1 ? FV : 0, vhi = part == 0 ? FV : ITEMS_V;
    {
        const long gt = ulo + (long)bi * NTHREADS + tid_opaque(), ngt = (long)nblk * NTHREADS;
        if (U_FP4 && U_INT4) prep_convert_int4_sliced(p.pu, p.ws + WS_U8, uhi, UI_SCALE, gt, ngt);
        else if (U_FP4) prep_convert_fp4_sliced(p.pu, p.ws + WS_U8, uhi, U4_SCALE, gt, ngt);
        else prep_convert_fp8_sliced(p.pu, p.ws + WS_U8, uhi, U8_SCALE, gt, ngt);
    }
    {
        const long gt = vlo + (long)bi * NTHREADS + tid_opaque(), ngt = (long)nblk * NTHREADS;
        if (V_FP4 && V_MFMA) prep_convert_fp4_vperm(p.pv, p.ws + WS_V8, vhi, V4_SCALE, gt, ngt);
        else if (V_FP4) prep_convert_fp4_sliced(p.pv, p.ws + WS_V8, vhi, V4_SCALE, gt, ngt);
        else prep_convert_fp8_sliced(p.pv, p.ws + WS_V8, vhi, V8_SCALE, gt, ngt);
    }
}
__device__ __forceinline__ void phase_prep(const Params& p) {
    const long gt = (long)blockIdx.x * NTHREADS + tid_opaque(), ngt = (long)gridDim.x * NTHREADS;
    const int lane = tid_opaque() & 63;
    const long gw = gt >> 6, ngw = ngt >> 6;
    unsigned char* ws = p.ws;
    for (long o4 = gw; o4 < 4 * 512; o4 += ngw) {
        if (o4 & 3) continue;
        const long o = o4 >> 2;
        const int kv = (int)(o >> 8), n = (int)(o & 255);
        const float* pe = kv ? p.pe_v : p.pe_k; const float* w1 = kv ? p.w1_v : p.w1_k;
        float s = 0.f;
        for (int k = lane; k < 2048; k += 64) s += pe[k] * w1[(size_t)k * 256 + n];
        s = wave_sum(s);
        if (lane == 0) ((float*)(ws + WS_B1))[o] = s;
    }
    {
        f32x4 g[4];
#pragma unroll
        for (int j = 0; j < 4; ++j) g[j] = *((const f32x4*)p.ln1_g + lane + 64 * j);
        for (long m0 = gw * 4; m0 < NTOK; m0 += ngw * 4) {
            f32x4 v[4][4]; float s[4];
#pragma unroll
            for (int r = 0; r < 4; ++r) {
                const f32x4* xr = (const f32x4*)(p.x + (size_t)(m0 + r) * D) + lane;
#pragma unroll
                for (int j = 0; j < 4; ++j) v[r][j] = xr[64 * j];
            }
#pragma unroll
            for (int r = 0; r < 4; ++r) {
                s[r] = 0.f;
#pragma unroll
                for (int j = 0; j < 4; ++j) s[r] += (v[r][j].x * v[r][j].x + v[r][j].y * v[r][j].y) + (v[r][j].z * v[r][j].z + v[r][j].w * v[r][j].w);
            }
#pragma unroll
            for (int o = 1; o < 64; o <<= 1) {
#pragma unroll
                for (int r = 0; r < 4; ++r) s[r] += __shfl_xor(s[r], o);
            }
#pragma unroll
            for (int r = 0; r < 4; ++r) {
                const float rstd = 1.0f / sqrtf(s[r] * (1.0f / D) + EPS);
                u32x2* o = (u32x2*)((bf16_t*)(ws + WS_XN) + (size_t)(m0 + r) * D) + lane;
#pragma unroll
                for (int j = 0; j < 4; ++j) {
                    u32x2 w; w.x = pk2(v[r][j].x * rstd * g[j].x, v[r][j].y * rstd * g[j].y); w.y = pk2(v[r][j].z * rstd * g[j].z, v[r][j].w * rstd * g[j].w);
                    st_wt8(o + 64 * j, w);
                }
            }
        }
    }
    prep_transpose<true>(p.w_in, D, DIN, DINP, (bf16_t*)(ws + WS_WIN), gt, ngt);
    prep_transpose<false>(p.w_out, D, D, D, (bf16_t*)(ws + WS_WOUT), gt, ngt);
    prep_transpose<false>(p.wq, D, PQ, PQ, (bf16_t*)(ws + WS_WQ), gt, ngt);
    prep_convert(p.pkeys, (bf16_t*)(ws + WS_PKEYS), (long)16 * 128 * 128 / 8, gt, ngt);
    prep_transpose<false>(p.w1_k, 2048, 256, 256, (bf16_t*)(ws + WS_W1T), gt, ngt);
    prep_transpose<false>(p.w1_v, 2048, 256, 256, (bf16_t*)(ws + WS_W1T) + 256 * 2048, gt, ngt);
    prep_transpose<false>(p.w2_k, 256, 64, 64, (bf16_t*)(ws + WS_W2T), gt, ngt);
    prep_transpose<false>(p.w2_v, 256, 64, 64, (bf16_t*)(ws + WS_W2T) + 64 * 256, gt, ngt);
    for (long i = gt; i < NTOK; i += ngt) ((float*)(ws + WS_SS2))[i] = 0.f;
}

template <class Epi>
__device__ __forceinline__ void gemm_simple(const bf16_t* A, const bf16_t* Bt, int M, int N, int K, const Epi& E) {
    const int lane = tid_opaque() & 63;
    const long gw = ((long)blockIdx.x * NTHREADS + tid_opaque()) >> 6, ngw = ((long)gridDim.x * NTHREADS) >> 6;
    const int ntn = N / 64; const long ntiles = (long)(M / 32) * ntn;
    const int fr = lane & 15, fq = lane >> 4;
    for (long tile = gw; tile < ntiles; tile += ngw) {
        const int m0 = (int)(tile / ntn) * 32, n0 = (int)(tile % ntn) * 64;
        f32x4 acc[2][4];
#pragma unroll
        for (int i = 0; i < 2; ++i)
#pragma unroll
            for (int j = 0; j < 4; ++j) acc[i][j] = (f32x4){0.f, 0.f, 0.f, 0.f};
        const bf16_t* ap = A + (size_t)(m0 + fr) * K + fq * 8;
        const bf16_t* bp = Bt + (size_t)(n0 + fr) * K + fq * 8;
        for (int k0 = 0; k0 < K; k0 += 32) {
            bf16x8 a[2], b[4];
#pragma unroll
            for (int i = 0; i < 2; ++i) a[i] = *(const bf16x8*)(ap + (size_t)i * 16 * K + k0);
#pragma unroll
            for (int j = 0; j < 4; ++j) b[j] = *(const bf16x8*)(bp + (size_t)j * 16 * K + k0);
#pragma unroll
            for (int i = 0; i < 2; ++i)
#pragma unroll
                for (int j = 0; j < 4; ++j) acc[i][j] = __builtin_amdgcn_mfma_f32_16x16x32_bf16(a[i], b[j], acc[i][j], 0, 0, 0);
        }
        E(acc, m0, n0, fr, fq);
    }
}

struct EpiProj {
    unsigned char* ws;
    __device__ __forceinline__ void operator()(const f32x4 (&acc)[2][4], int m0, int n0, int fr, int fq) const {
#pragma unroll
        for (int i = 0; i < 2; ++i)
#pragma unroll
            for (int j = 0; j < 4; ++j)
#pragma unroll
                for (int r = 0; r < 4; ++r) {
                    const int row = m0 + 16 * i + fq * 4 + r, n = n0 + 16 * j + fr;
                    const float v = acc[i][j][r];
                    const int b = row / T, t = row % T, d = n & 63;
                    if (n < 512) {
                        const int head = n >> 6;
                        ((bf16_t*)(ws + WS_QN))[((size_t)(b * 8 + head) * T + t) * 64 + d] = (bf16_t)f2bf(v * 0.125f);
                    } else if (n < 1280) {
                        const int arr = (n - 512) >> 7, g = ((n - 512) >> 6) & 1;
                        ((bf16_t*)(ws + WS_KV6 + arr * KV6_STRIDE))[((size_t)(b * 2 + g) * T + t) * 64 + d] = (bf16_t)f2bf(v);
                    } else if (n < 1792) {
                        const int head = (n - 1280) >> 6;
                        ((bf16_t*)(ws + WS_QS))[((size_t)(b * 8 + head) * T + t) * 64 + d] = (bf16_t)f2bf(v * 0.125f);
                    } else if (n < 1856) {
                        ((bf16_t*)(ws + WS_KSW))[((size_t)b * T + t) * 64 + d] = (bf16_t)f2bf(v);
                    } else if (n < 1920) {
                        ((bf16_t*)(ws + WS_VSW))[((size_t)b * T + t) * 64 + d] = (bf16_t)f2bf(v);
                    } else if (n < 1944) {
                        ((float*)(ws + WS_GSIG))[(size_t)row * 24 + (n - 1920)] = 1.0f / (1.0f + expf(-v));
                    }
                }
    }
};
struct EpiOut {
    const float* x; const float* g2; float* h1; bf16_t* h1g; float* ss2;
    __device__ __forceinline__ void operator()(const f32x4 (&acc)[2][4], int m0, int n0, int fr, int fq) const {
#pragma unroll
        for (int i = 0; i < 2; ++i)
#pragma unroll
            for (int r = 0; r < 4; ++r) {
                const int row = m0 + 16 * i + fq * 4 + r; float ss = 0.f;
#pragma unroll
                for (int j = 0; j < 4; ++j) {
                    const int n = n0 + 16 * j + fr; const size_t off = (size_t)row * D + n;
                    const float h = x[off] + acc[i][j][r];
                    h1[off] = h; h1g[off] = (bf16_t)f2bf(h * g2[n]); ss += h * h;
                }
                ss += __shfl_xor(ss, 1); ss += __shfl_xor(ss, 2); ss += __shfl_xor(ss, 4); ss += __shfl_xor(ss, 8);
                if (fr == 0) atomicAdd(ss2 + row, ss);
            }
    }
};
struct EpiQP {
    const float* ss2; bf16_t* qp;
    __device__ __forceinline__ void operator()(const f32x4 (&acc)[2][4], int m0, int n0, int fr, int fq) const {
#pragma unroll
        for (int i = 0; i < 2; ++i)
#pragma unroll
            for (int r = 0; r < 4; ++r) {
                const int row = m0 + 16 * i + fq * 4 + r;
                const float rstd = 1.0f / sqrtf(ss2[row] * (1.0f / D) + EPS);
#pragma unroll
                for (int j = 0; j < 4; ++j) qp[(size_t)row * PQ + n0 + 16 * j + fr] = (bf16_t)f2bf(acc[i][j][r] * rstd);
            }
    }
};

namespace pg8 {
#define PG8_LAS __attribute__((address_space(3)))
typedef unsigned short bf16_t;
typedef short bf16x8 __attribute__((ext_vector_type(8)));
typedef float f32x4 __attribute__((ext_vector_type(4)));
typedef unsigned u32x4 __attribute__((ext_vector_type(4)));
constexpr int BM = 256, BK = 64, HALF = 128, HTB = HALF * BK * 2  , STAGE_BYTES = 8 * HTB, NXCD = 8, WGM = 8;

__host__ __device__ __forceinline__ int lds_byte(int r, int c) { const int st = (r >> 4) * 2 + (c >> 5), rr = r & 15, cc = c & 31, ob = rr * 64 + cc * 2; return st * 1024 + (ob ^ (((ob >> 9) & 1) << 5)); }
__host__ __device__ __forceinline__ void stage_rc(int b, int& R, int& C) { const int st = b / 1024, sb = b % 1024, swz = sb ^ (((sb >> 9) & 1) << 5); R = (st >> 1) * 16 + swz / 64; C = (st & 1) * 32 + (swz % 64) / 2; }
__host__ __device__ __forceinline__ int perm32(int rho) { const int n = rho >> 4, i = rho & 15; return 8 * (i >> 2) + 4 * n + (i & 3); }

struct Unit { int pm, pn; };
struct Gemm { const bf16_t* A; const bf16_t* Bt; int M, N, K; };

struct StaticOrder {
    int nM, nN, nwg, G, c;
    __host__ __device__ __forceinline__ void init(int M, int N, int G_, int c_) { nM = M / BM; nN = N / BM; nwg = nM * nN; G = G_; c = c_; }
    __host__ __device__ __forceinline__ bool next(int i, Unit& u) const {
        const long L = (long)i * G + c; if (L >= nwg) return false;
        int wgid = (int)L; { const int q = nwg / NXCD, r = nwg % NXCD, xcd = wgid % NXCD, off = wgid / NXCD; wgid = (xcd < r ? xcd * (q + 1) : r * (q + 1) + (xcd - r) * q) + off; }
        const int nig = WGM * nN, gid = wgid / nig, fm = gid * WGM, gsz = (nM - fm) < WGM ? (nM - fm) : WGM;
        u.pm = fm + ((wgid % nig) % gsz); u.pn = (wgid % nig) / gsz; return true;
    }
    __device__ __forceinline__ void a_ready(const Unit&) const {}
    __device__ __forceinline__ void done(const Unit&) const {}
};

__device__ __forceinline__ unsigned cvt_pk_bf16(float lo, float hi) { unsigned r; asm volatile("v_cvt_pk_bf16_f32 %0, %1, %2" : "=v"(r) : "v"(lo), "v"(hi)); return r; }
template <class Epi, class Sched, bool ALIGN_EPI, bool SP2, bool PRE>
__device__ __forceinline__ void gemm_phase_impl(PG8_LAS unsigned char* lds, const Gemm g, const Sched& S, const Epi& E, f32x4 (&acc)[2][2][4][2]) {
    const int tid = tid_opaque(), wid = __builtin_amdgcn_readfirstlane(tid >> 6), lane = tid & 63, wr = wid >> 2, wc = wid & 3, fr = lane & 15, fq = lane >> 4;
    const int K = g.K, nt = K / BK;
    unsigned voffA[2], voffB[2];
#pragma unroll
    for (int i = 0; i < 2; ++i) { int R, C; stage_rc(tid * 16 + i * 8192, R, C); const int Rb = Epi::PERM ? ((R & ~31) + perm32(R & 31)) : R;
        voffA[i] = (unsigned)(R * K + C) * 2u; voffB[i] = (unsigned)(Rb * K + C) * 2u; }
    const size_t kstep = (size_t)(BK * 2);
    const size_t hstep = (size_t)HALF * K * 2;
    const size_t tstep = 2 * hstep;
    const unsigned ldsw = (unsigned)wid * 1024u;
    const int aoff = lds_byte(wr * 64 + fr, fq * 8), boff = lds_byte(wc * 32 + fr, fq * 8);
#define PG8_SA(b, h) (((b) * 2 + (h)) * HTB)
#define PG8_SB(b, h) ((4 + (b) * 2 + (h)) * HTB)
#define PG8_STAGE(bufoff, gbase, voff) do { _Pragma("unroll") for (int _i = 0; _i < 2; ++_i) \
        __builtin_amdgcn_global_load_lds((const unsigned*)((const char*)(gbase) + (voff)[_i]), (PG8_LAS unsigned*)(lds + (bufoff) + ldsw + _i * 8192), 16, 0, 0); } while (0)
#define PG8_LDA(dst, b, h) do { _Pragma("unroll") for (int m = 0; m < 4; ++m) _Pragma("unroll") for (int k = 0; k < 2; ++k) dst[m][k] = *(const PG8_LAS bf16x8*)(lds + PG8_SA(b, h) + aoff + m * 2048 + k * 1024); } while (0)
#define PG8_LDB(dst, b, h) do { _Pragma("unroll") for (int n = 0; n < 2; ++n) _Pragma("unroll") for (int k = 0; k < 2; ++k) dst[n][k] = *(const PG8_LAS bf16x8*)(lds + PG8_SB(b, h) + boff + n * 2048 + k * 1024); } while (0)
#define PG8_MMA(ai, bj, At, Bt) do { __builtin_amdgcn_s_setprio(1); _Pragma("unroll") for (int m = 0; m < 4; ++m) _Pragma("unroll") for (int n = 0; n < 2; ++n) _Pragma("unroll") for (int k = 0; k < 2; ++k) \
        acc[ai][bj][m][n] = __builtin_amdgcn_mfma_f32_16x16x32_bf16(Bt[n][k], At[m][k], acc[ai][bj][m][n], 0, 0, 0); __builtin_amdgcn_s_setprio(0); } while (0)
#define PG8_WAIT_V(n) asm volatile("s_waitcnt vmcnt(" #n ")" ::: "memory")
#define PG8_WAIT_L(n) asm volatile("s_waitcnt lgkmcnt(" #n ")" ::: "memory")
#define PG8_BAR __builtin_amdgcn_s_barrier()
#define PG8_SCHED __builtin_amdgcn_sched_barrier(0)
#define PG8_ACC_USE do { _Pragma("unroll") for (int a = 0; a < 2; ++a) _Pragma("unroll") for (int b = 0; b < 2; ++b) _Pragma("unroll") for (int m = 0; m < 4; ++m) _Pragma("unroll") for (int n = 0; n < 2; ++n) \
        asm volatile("" : "+v"(acc[a][b][m][n])); } while (0)
    Unit cur, nxt; int ui = 0;
    if (!S.next(0, cur)) return;
    if constexpr (!PRE) {
#pragma unroll
    for (int a = 0; a < 2; ++a)
#pragma unroll
        for (int b = 0; b < 2; ++b)
#pragma unroll
            for (int m = 0; m < 4; ++m)
#pragma unroll
                for (int n = 0; n < 2; ++n) acc[a][b][m][n] = (f32x4){0.f, 0.f, 0.f, 0.f};
    }
    bf16x8 At[4][2], B0[2][2], B1[2][2];
    const char* cA = (const char*)g.A + (size_t)cur.pm * tstep; const char* cB = (const char*)g.Bt + (size_t)cur.pn * tstep;
    S.a_ready(cur);
    if constexpr (SP2) {
        PG8_STAGE(PG8_SB(0, 0), cB, voffB); PG8_STAGE(PG8_SB(0, 1), cB + hstep, voffB); PG8_STAGE(PG8_SA(0, 0), cA, voffA); PG8_STAGE(PG8_SA(0, 1), cA + hstep, voffA);
        if (wr == 1) PG8_BAR;
        PG8_WAIT_V(2); PG8_BAR;
        if constexpr (PRE) PG8_ACC_USE;
        PG8_STAGE(PG8_SB(1, 0), cB + kstep, voffB); PG8_STAGE(PG8_SA(1, 0), cA + kstep, voffA); PG8_STAGE(PG8_SB(1, 1), cB + hstep + kstep, voffB);
        PG8_WAIT_V(6); PG8_BAR;
    } else {
        PG8_STAGE(PG8_SB(0, 0), cB, voffB); PG8_STAGE(PG8_SA(0, 0), cA, voffA); PG8_STAGE(PG8_SB(0, 1), cB + hstep, voffB); PG8_STAGE(PG8_SA(0, 1), cA + hstep, voffA);
        if (wr == 1) PG8_BAR;
        PG8_WAIT_V(4); PG8_BAR;
        if constexpr (PRE) PG8_ACC_USE;
        PG8_STAGE(PG8_SB(1, 0), cB + kstep, voffB); PG8_STAGE(PG8_SA(1, 0), cA + kstep, voffA); PG8_STAGE(PG8_SB(1, 1), cB + hstep + kstep, voffB);
        PG8_WAIT_V(6); PG8_BAR;
    }
    for (;;) {
        const bool has_next = S.next(ui + 1, nxt);
        const char* nA = has_next ? (const char*)g.A + (size_t)nxt.pm * tstep : cA; const char* nB = has_next ? (const char*)g.Bt + (size_t)nxt.pn * tstep : cB;
        for (int t = 0; t < nt; t += 2) {
            const bool last = (t == nt - 2);
            const char* a1 = cA + (size_t)(t + 1) * kstep;
            const char* a2 = last ? nA : cA + (size_t)(t + 2) * kstep; const char* b2 = last ? nB : cB + (size_t)(t + 2) * kstep;
            const char* a3 = a2 + kstep; const char* b3 = b2 + kstep;
            if (last && has_next) S.a_ready(nxt);
            if constexpr (SP2) {
            PG8_LDB(B0, 0, 0); PG8_LDB(B1, 0, 1); PG8_SCHED; PG8_LDA(At, 0, 0); PG8_STAGE(PG8_SA(1, 1), a1 + hstep, voffA);
            PG8_WAIT_V(8); PG8_WAIT_L(0); PG8_BAR; PG8_MMA(0, 0, At, B0); PG8_MMA(0, 1, At, B1); PG8_BAR; PG8_SCHED;
            PG8_LDA(At, 0, 1); PG8_STAGE(PG8_SB(0, 0), b2, voffB); PG8_STAGE(PG8_SB(0, 1), b2 + hstep, voffB); PG8_STAGE(PG8_SA(0, 0), a2, voffA);
            PG8_WAIT_V(8); PG8_WAIT_L(0); PG8_BAR; PG8_MMA(1, 0, At, B0); PG8_MMA(1, 1, At, B1); PG8_BAR; PG8_SCHED;
            PG8_LDB(B0, 1, 0); PG8_LDB(B1, 1, 1); PG8_SCHED; PG8_LDA(At, 1, 0); PG8_STAGE(PG8_SA(0, 1), a2 + hstep, voffA);
            PG8_WAIT_V(8); PG8_WAIT_L(0); PG8_BAR; PG8_MMA(0, 0, At, B0); PG8_MMA(0, 1, At, B1); PG8_BAR; PG8_SCHED;
            PG8_LDA(At, 1, 1); PG8_STAGE(PG8_SB(1, 0), b3, voffB); PG8_STAGE(PG8_SB(1, 1), b3 + hstep, voffB); PG8_STAGE(PG8_SA(1, 0), a3, voffA);
            PG8_WAIT_V(8); PG8_WAIT_L(0); PG8_BAR; PG8_MMA(1, 0, At, B0); PG8_MMA(1, 1, At, B1); PG8_BAR; PG8_SCHED;
            } else {
            PG8_LDB(B0, 0, 0); PG8_SCHED; PG8_LDA(At, 0, 0); PG8_STAGE(PG8_SA(1, 1), a1 + hstep, voffA);
            PG8_WAIT_L(8); PG8_BAR; PG8_WAIT_L(0); PG8_MMA(0, 0, At, B0); PG8_BAR; PG8_SCHED;
            PG8_LDB(B1, 0, 1); PG8_STAGE(PG8_SB(0, 0), b2, voffB);
            PG8_BAR; PG8_WAIT_L(0); PG8_MMA(0, 1, At, B1); PG8_BAR;
            PG8_LDA(At, 0, 1); PG8_STAGE(PG8_SA(0, 0), a2, voffA);
            PG8_BAR; PG8_WAIT_L(0); PG8_MMA(1, 0, At, B0); PG8_BAR; PG8_SCHED;
            PG8_STAGE(PG8_SB(0, 1), b2 + hstep, voffB);
            PG8_WAIT_V(6); PG8_BAR; PG8_MMA(1, 1, At, B1); PG8_BAR;
            PG8_LDB(B0, 1, 0); PG8_SCHED; PG8_LDA(At, 1, 0); PG8_STAGE(PG8_SA(0, 1), a2 + hstep, voffA);
            PG8_WAIT_L(8); PG8_BAR; PG8_WAIT_L(0); PG8_MMA(0, 0, At, B0); PG8_BAR; PG8_SCHED;
            PG8_LDB(B1, 1, 1); PG8_STAGE(PG8_SB(1, 0), b3, voffB);
            PG8_BAR; PG8_WAIT_L(0); PG8_MMA(0, 1, At, B1); PG8_BAR;
            PG8_LDA(At, 1, 1); PG8_STAGE(PG8_SA(1, 0), a3, voffA);
            PG8_BAR; PG8_WAIT_L(0); PG8_MMA(1, 0, At, B0); PG8_BAR; PG8_SCHED;
            PG8_STAGE(PG8_SB(1, 1), b3 + hstep, voffB);
            PG8_WAIT_V(6); PG8_BAR; PG8_MMA(1, 1, At, B1); PG8_BAR;
            }
        }
        if constexpr (ALIGN_EPI) { if (wr == 0) PG8_BAR; }
        if constexpr (!Epi::AFTER_DRAIN) { E(acc, cur, wr, wc, fr, fq); S.done(cur); }
        if (!has_next) break;
        if constexpr (PRE) { E.reinit(acc, nxt, wr, wc, fr, fq); PG8_ACC_USE; } else {
#pragma unroll
        for (int a = 0; a < 2; ++a)
#pragma unroll
            for (int b = 0; b < 2; ++b)
#pragma unroll
                for (int m = 0; m < 4; ++m)
#pragma unroll
                    for (int n = 0; n < 2; ++n) acc[a][b][m][n] = (f32x4){0.f, 0.f, 0.f, 0.f};
        }
        cur = nxt; cA = nA; cB = nB; ++ui;
        if constexpr (ALIGN_EPI) { if (wr == 1) PG8_BAR; }
    }
    PG8_WAIT_V(0);
    if constexpr (!ALIGN_EPI) { if (wr == 0) PG8_BAR; }
    PG8_BAR;
    if constexpr (Epi::AFTER_DRAIN) { E.fused(acc, cur, wr, wc, fr, fq, lds, wid, lane); S.done(cur); }
#undef PG8_SA
#undef PG8_SB
#undef PG8_STAGE
#undef PG8_LDA
#undef PG8_LDB
#undef PG8_MMA
#undef PG8_WAIT_V
#undef PG8_WAIT_L
#undef PG8_BAR
#undef PG8_SCHED
#undef PG8_ACC_USE
}
template <class Epi, class Sched, bool ALIGN_EPI = false, bool SP2 = false>
__device__ __forceinline__ void gemm_phase(PG8_LAS unsigned char* lds, const Gemm g, const Sched& S, const Epi& E) {
    f32x4 acc[2][2][4][2];
    gemm_phase_impl<Epi, Sched, ALIGN_EPI, SP2, false>(lds, g, S, E, acc);
}
}

struct EpiProjT {
    static constexpr bool PERM = true, AFTER_DRAIN = false;
    unsigned char* ws;
    __device__ __forceinline__ void operator()(const f32x4 (&acc)[2][2][4][2], const pg8::Unit& u, int wr, int wc, int fr, int fq) const {
        const int row0 = u.pm * 256 + wr * 64 + fr;
#pragma unroll
        for (int bj = 0; bj < 2; ++bj) {
            const int n8 = u.pn * 256 + bj * 128 + wc * 32 + 8 * fq;
            if (n8 >= 1944) continue;
            if (n8 >= 1920) {
#pragma unroll
                for (int ai = 0; ai < 2; ++ai)
#pragma unroll
                    for (int m = 0; m < 4; ++m) {
                        const int row = row0 + ai * 128 + m * 16;
                        const f32x4 v0 = acc[ai][bj][m][0], v1 = acc[ai][bj][m][1];
                        float* dst = (float*)(ws + WS_GSIG) + (size_t)row * 24 + (n8 - 1920);
                        *(f32x4*)dst = (f32x4){1.0f / (1.0f + __expf(-v0[0])), 1.0f / (1.0f + __expf(-v0[1])), 1.0f / (1.0f + __expf(-v0[2])), 1.0f / (1.0f + __expf(-v0[3]))};
                        *(f32x4*)(dst + 4) = (f32x4){1.0f / (1.0f + __expf(-v1[0])), 1.0f / (1.0f + __expf(-v1[1])), 1.0f / (1.0f + __expf(-v1[2])), 1.0f / (1.0f + __expf(-v1[3]))};
                    }
                continue;
            }
            bf16_t* base; int nh, hidx; float sc = 1.0f;
            if (n8 < 512) { base = (bf16_t*)(ws + WS_QN); nh = 8; hidx = n8 >> 6; sc = 0.125f * 1.4426950408889634f; }
            else if (n8 < 1280) { const int arr = (n8 - 512) >> 7; base = (bf16_t*)(ws + WS_KV6 + (size_t)arr * KV6_STRIDE); nh = 2; hidx = ((n8 - 512) >> 6) & 1; }
            else if (n8 < 1792) { base = (bf16_t*)(ws + WS_QS); nh = 8; hidx = (n8 - 1280) >> 6; sc = 0.125f * 1.4426950408889634f; }
            else if (n8 < 1856) { base = (bf16_t*)(ws + WS_KSW); nh = 1; hidx = 0; }
            else { base = (bf16_t*)(ws + WS_VSW); nh = 1; hidx = 0; }
            const int d0 = n8 & 63;
#pragma unroll
            for (int ai = 0; ai < 2; ++ai)
#pragma unroll
                for (int m = 0; m < 4; ++m) {
                    const int row = row0 + ai * 128 + m * 16, b = row >> 13, t = row & (T - 1);
                    const f32x4 v0 = acc[ai][bj][m][0] * sc, v1 = acc[ai][bj][m][1] * sc;
                    u32x4 w; w.x = pg8::cvt_pk_bf16(v0[0], v0[1]); w.y = pg8::cvt_pk_bf16(v0[2], v0[3]); w.z = pg8::cvt_pk_bf16(v1[0], v1[1]); w.w = pg8::cvt_pk_bf16(v1[2], v1[3]);
                    *(u32x4*)(base + ((size_t)(b * nh + hidx) * T + t) * 64 + d0) = w;
                }
        }
    }
};
struct EpiOutT {
    static constexpr bool PERM = false, AFTER_DRAIN = false;
    const float* x; const float* g2; float* h1; bf16_t* h1g; float* ss2;
    static __device__ __forceinline__ void load_x(const float* x, f32x4 (&acc)[2][2][4][2], const pg8::Unit& u, int wr, int wc, int fr, int fq) {
        const int row0 = u.pm * 256 + wr * 64 + fr, col0 = u.pn * 256 + wc * 32 + 4 * fq;
#pragma unroll
        for (int ai = 0; ai < 2; ++ai)
#pragma unroll
            for (int m = 0; m < 4; ++m)
#pragma unroll
                for (int bj = 0; bj < 2; ++bj)
#pragma unroll
                    for (int n = 0; n < 2; ++n) acc[ai][bj][m][n] = *(const f32x4*)(x + (size_t)(row0 + ai * 128 + m * 16) * D + (col0 + bj * 128 + n * 16));
    }
    __device__ __forceinline__ void reinit(f32x4 (&acc)[2][2][4][2], const pg8::Unit& u, int wr, int wc, int fr, int fq) const { load_x(x, acc, u, wr, wc, fr, fq); }
    __device__ __forceinline__ void operator()(const f32x4 (&acc)[2][2][4][2], const pg8::Unit& u, int wr, int wc, int fr, int fq) const {
        const int row0 = u.pm * 256 + wr * 64 + fr, col0 = u.pn * 256 + wc * 32 + 4 * fq;
        f32x4 gg[2][2];
#pragma unroll
        for (int bj = 0; bj < 2; ++bj)
#pragma unroll
            for (int n = 0; n < 2; ++n) gg[bj][n] = *(const f32x4*)(g2 + col0 + bj * 128 + n * 16);
#pragma unroll
        for (int ai = 0; ai < 2; ++ai)
#pragma unroll
            for (int m = 0; m < 4; ++m) {
                const int row = row0 + ai * 128 + m * 16; float ss = 0.f;
#pragma unroll
                for (int bj = 0; bj < 2; ++bj)
#pragma unroll
                    for (int n = 0; n < 2; ++n) {
                        const size_t off = (size_t)row * D + (col0 + bj * 128 + n * 16);
                        const f32x4 h = acc[ai][bj][m][n]; const f32x4 g = gg[bj][n];
                        u32x2 w; w.x = pg8::cvt_pk_bf16(h[0] * g[0], h[1] * g[1]); w.y = pg8::cvt_pk_bf16(h[2] * g[2], h[3] * g[3]);
                        *(u32x2*)(h1g + off) = w;
                        ss += (h[0] * h[0] + h[1] * h[1]) + (h[2] * h[2] + h[3] * h[3]);
                    }
                ss += __shfl_xor(ss, 16); ss += __shfl_xor(ss, 32);
                if (fq == 0) atomicAdd(ss2 + row, ss);
            }
    }
};
struct EpiQPT {
    static constexpr bool PERM = true, AFTER_DRAIN = false;
    const float* ss2; bf16_t* qp;
    __device__ __forceinline__ void operator()(const f32x4 (&acc)[2][2][4][2], const pg8::Unit& u, int wr, int wc, int fr, int fq) const {
        const int row0 = u.pm * 256 + wr * 64 + fr;
        float ssr[2][4];
#pragma unroll
        for (int ai = 0; ai < 2; ++ai)
#pragma unroll
            for (int m = 0; m < 4; ++m) ssr[ai][m] = ss2[row0 + ai * 128 + m * 16];
#pragma unroll
        for (int ai = 0; ai < 2; ++ai)
#pragma unroll
            for (int m = 0; m < 4; ++m) {
                const int row = row0 + ai * 128 + m * 16;
                const float rstd = 1.0f / sqrtf(ssr[ai][m] * (1.0f / D) + EPS);
#pragma unroll
                for (int bj = 0; bj < 2; ++bj) {
                    const int n8 = u.pn * 256 + bj * 128 + wc * 32 + 8 * fq;
                    const f32x4 v0 = acc[ai][bj][m][0] * rstd, v1 = acc[ai][bj][m][1] * rstd;
                    u32x4 w; w.x = pg8::cvt_pk_bf16(v0[0], v0[1]); w.y = pg8::cvt_pk_bf16(v0[2], v0[3]); w.z = pg8::cvt_pk_bf16(v1[0], v1[1]); w.w = pg8::cvt_pk_bf16(v1[2], v1[3]);
                    *(u32x4*)(qp + (size_t)row * PQ + n8) = w;
                }
            }
    }
};

__device__ __forceinline__ void phase_compress(const Params& p, float* lds) {
    float* flat = lds;
    float* part = lds + 2048;
    float* hid = lds + 2560;
    const int tid = tid_opaque();
    const int nunits = 2 * BATCH * NCMP * NSA_G;
    for (int u = blockIdx.x; u < nunits; u += gridDim.x) {
        const int kv = u / (BATCH * NCMP * NSA_G); int r = u % (BATCH * NCMP * NSA_G);
        const int b = r / (NCMP * NSA_G); r %= (NCMP * NSA_G);
        const int c = r / NSA_G, g = r % NSA_G;
        const bf16_t* raw = (const bf16_t*)(p.ws + WS_KV6 + (size_t)kv * KV6_STRIDE) + ((size_t)(b * 2 + g) * T + 16 * c) * 64;
        const float* pe = kv ? p.pe_v : p.pe_k; const float* w1 = kv ? p.w1_v : p.w1_k; const float* w2 = kv ? p.w2_v : p.w2_k;
        for (int i = tid; i < 2048; i += NTHREADS) flat[i] = bf2f(raw[i]) + pe[i];
        __syncthreads();
        {
            const int j = tid & 255, half = tid >> 8;
            float a = 0.f;
            const float* wp = w1 + (size_t)(half * 1024) * 256 + j; const float* fp = flat + half * 1024;
            for (int i = 0; i < 1024; ++i) a += fp[i] * wp[(size_t)i * 256];
            part[tid] = a;
        }
        __syncthreads();
        if (tid < 256) hid[tid] = gelu_tanh(part[tid] + part[tid + 256]);
        __syncthreads();
        if (tid < 64) {
            float a = 0.f;
            for (int j = 0; j < 256; ++j) a += hid[j] * w2[j * 64 + tid];
            bf16_t* dst = (bf16_t*)(p.ws + (kv ? WS_VC : WS_KC)) + ((size_t)(b * 2 + g) * NCMPP + c) * 64;
            dst[tid] = (bf16_t)f2bf(a);
        }
        __syncthreads();
    }
}

__device__ __forceinline__ void load_row64(const bf16_t* src, float (&k)[64]) {
#pragma unroll
    for (int c = 0; c < 8; ++c) {
        const u32x4 w = *(const u32x4*)(src + 8 * c);
        k[8 * c + 0] = bflo(w.x); k[8 * c + 1] = bfhi(w.x); k[8 * c + 2] = bflo(w.y); k[8 * c + 3] = bfhi(w.y);
        k[8 * c + 4] = bflo(w.z); k[8 * c + 5] = bfhi(w.z); k[8 * c + 6] = bflo(w.w); k[8 * c + 7] = bfhi(w.w);
    }
}
__device__ __forceinline__ float dot_row64(const bf16_t* src, const float (&q)[64]) {
    float s0 = 0.f, s1 = 0.f;
#pragma unroll
    for (int c = 0; c < 8; ++c) {
        const u32x4 w = *(const u32x4*)(src + 8 * c);
        s0 += q[8 * c + 0] * bflo(w.x); s1 += q[8 * c + 1] * bfhi(w.x); s0 += q[8 * c + 2] * bflo(w.y); s1 += q[8 * c + 3] * bfhi(w.y);
        s0 += q[8 * c + 4] * bflo(w.z); s1 += q[8 * c + 5] * bfhi(w.z); s0 += q[8 * c + 6] * bflo(w.w); s1 += q[8 * c + 7] * bfhi(w.w);
    }
    return s0 + s1;
}
__device__ __forceinline__ void osm_update(float s, const bf16_t* vsrc, float& m, float& l, float (&acc)[32]) {
    const float mn = fmaxf(m, s), alpha = __expf(m - mn), pr = __expf(s - mn);
    l = l * alpha + pr; m = mn;
#pragma unroll
    for (int c = 0; c < 4; ++c) {
        const u32x4 w = *(const u32x4*)(vsrc + 8 * c);
        acc[8 * c + 0] = acc[8 * c + 0] * alpha + pr * bflo(w.x); acc[8 * c + 1] = acc[8 * c + 1] * alpha + pr * bfhi(w.x);
        acc[8 * c + 2] = acc[8 * c + 2] * alpha + pr * bflo(w.y); acc[8 * c + 3] = acc[8 * c + 3] * alpha + pr * bfhi(w.y);
        acc[8 * c + 4] = acc[8 * c + 4] * alpha + pr * bflo(w.z); acc[8 * c + 5] = acc[8 * c + 5] * alpha + pr * bfhi(w.z);
        acc[8 * c + 6] = acc[8 * c + 6] * alpha + pr * bflo(w.w); acc[8 * c + 7] = acc[8 * c + 7] * alpha + pr * bfhi(w.w);
    }
}

__device__ __forceinline__ void phase_nsa(const Params& p, float* lds) {
    float* imp = lds;
    int* sel = (int*)(lds + 64 * 129);
    const int tid = tid_opaque(), qi = tid & 63, h = (tid >> 6) & 3, dh = tid >> 8;
    const unsigned char* ws = p.ws;
    const int nunits = BATCH * NSA_G * (T / 64);
    for (int u = blockIdx.x; u < nunits; u += gridDim.x) {
        const int b = u / (NSA_G * (T / 64)), g = (u / (T / 64)) % NSA_G, tile = u % (T / 64);
        const int t = tile * 64 + qi, head = g * 4 + h;
        const float slope = exp2f(-0.5f * (float)(9 + head));
        float q[64];
        load_row64((const bf16_t*)(ws + WS_QN) + ((size_t)(b * 8 + head) * T + t) * 64, q);
        const bf16_t* KC = (const bf16_t*)(ws + WS_KC) + (size_t)(b * 2 + g) * NCMPP * 64;
        const bf16_t* VC = (const bf16_t*)(ws + WS_VC) + (size_t)(b * 2 + g) * NCMPP * 64 + dh * 32;
        const bf16_t* KS = (const bf16_t*)(ws + WS_KV6 + 2 * KV6_STRIDE) + (size_t)(b * 2 + g) * T * 64;
        const bf16_t* VS = (const bf16_t*)(ws + WS_KV6 + 3 * KV6_STRIDE) + (size_t)(b * 2 + g) * T * 64 + dh * 32;
        const bf16_t* KW = (const bf16_t*)(ws + WS_KV6 + 4 * KV6_STRIDE) + (size_t)(b * 2 + g) * T * 64;
        const bf16_t* VW = (const bf16_t*)(ws + WS_KV6 + 5 * KV6_STRIDE) + (size_t)(b * 2 + g) * T * 64 + dh * 32;
        const float* gs = (const float*)(ws + WS_GSIG) + (size_t)(b * T + t) * 24 + head * 3;
        float o[32];
#pragma unroll
        for (int d = 0; d < 32; ++d) o[d] = 0.f;
        for (int i = tid; i < 64 * 129; i += NTHREADS) imp[i] = 0.f;
        __syncthreads();
        const int nc = 4 * tile + 3;
        float mc = -1e30f, lc = 0.f;
        {
            float acc[32];
#pragma unroll
            for (int d = 0; d < 32; ++d) acc[d] = 0.f;
            for (int c = 0; c < nc; ++c) {
                const int dist = t - (16 * c + 31);
                if (dist >= 0) {
                    const float s = dot_row64(KC + (size_t)c * 64, q) - slope * (float)dist;
                    osm_update(s, VC + (size_t)c * 64, mc, lc, acc);
                }
            }
            const float inv = gs[0] / fmaxf(lc, 1e-30f);
#pragma unroll
            for (int d = 0; d < 32; ++d) o[d] += acc[d] * inv;
        }
        if (dh == 0) {
            const float invl = 1.0f / fmaxf(lc, 1e-30f);
            for (int c = 0; c < nc; ++c) {
                const int dist = t - (16 * c + 31);
                if (dist >= 0) {
                    const float s = dot_row64(KC + (size_t)c * 64, q) - slope * (float)dist;
                    const float pr = __expf(s - mc) * invl;
                    const int sb = c >> 2;
                    atomicAdd(&imp[qi * 129 + sb], pr);
                    if ((c & 3) == 3 && sb + 1 < NSEL) atomicAdd(&imp[qi * 129 + sb + 1], pr);
                }
            }
        }
        __syncthreads();
        if (tid < 64) {
            const int blk_t = tile;
            float* row = imp + tid * 129;
            for (int j = 0; j <= blk_t; ++j) if (j == 0 || j == blk_t || j == blk_t - 1) row[j] = 1.0e4f;
            for (int k = 0; k < TOPN; ++k) {
                float best = -INFINITY; int bi = -1;
                for (int j = 0; j <= blk_t; ++j) { const float v = row[j]; if (v > best) { best = v; bi = j; } }
                sel[tid * 16 + k] = bi;
                if (bi >= 0) row[bi] = -INFINITY;
            }
        }
        __syncthreads();
        {
            float m = -1e30f, l = 0.f, acc[32];
#pragma unroll
            for (int d = 0; d < 32; ++d) acc[d] = 0.f;
            for (int k = 0; k < TOPN; ++k) {
                const int j = sel[qi * 16 + k];
                if (j >= 0) {
                    for (int i = 0; i < 64; ++i) {
                        const int pos = 64 * j + i;
                        if (pos <= t) {
                            const float s = dot_row64(KS + (size_t)pos * 64, q) - slope * (float)(t - pos);
                            osm_update(s, VS + (size_t)pos * 64, m, l, acc);
                        }
                    }
                }
            }
            const float inv = gs[1] / fmaxf(l, 1e-30f);
#pragma unroll
            for (int d = 0; d < 32; ++d) o[d] += acc[d] * inv;
        }
        {
            float m = -1e30f, l = 0.f, acc[32];
#pragma unroll
            for (int d = 0; d < 32; ++d) acc[d] = 0.f;
            for (int i = 0; i < NSA_WIN; ++i) {
                const int pos = t - (NSA_WIN - 1) + i;
                if (pos >= 0) {
                    const float s = dot_row64(KW + (size_t)pos * 64, q) - slope * (float)(t - pos);
                    osm_update(s, VW + (size_t)pos * 64, m, l, acc);
                }
            }
            const float inv = gs[2] / fmaxf(l, 1e-30f);
#pragma unroll
            for (int d = 0; d < 32; ++d) o[d] += acc[d] * inv;
        }
        bf16_t* O = (bf16_t*)(p.ws + WS_O) + (size_t)(b * T + t) * D + g * 256 + h * 64 + dh * 32;
#pragma unroll
        for (int c = 0; c < 4; ++c) {
            u32x4 w; w.x = pk2(o[8 * c], o[8 * c + 1]); w.y = pk2(o[8 * c + 2], o[8 * c + 3]); w.z = pk2(o[8 * c + 4], o[8 * c + 5]); w.w = pk2(o[8 * c + 6], o[8 * c + 7]);
            *(u32x4*)(O + 8 * c) = w;
        }
        __syncthreads();
    }
}

__device__ __forceinline__ void phase_swa(const Params& p) {
    const unsigned char* ws = p.ws;
    const long gt = (long)blockIdx.x * NTHREADS + tid_opaque(), ngt = (long)gridDim.x * NTHREADS;
    const long items = (long)NTOK * SWA_H * 2;
    for (long it = gt; it < items; it += ngt) {
        const int tt = (int)(it % T); long r = it / T;
        const int dh = (int)(r % 2); r /= 2;
        const int head = (int)(r % SWA_H); const int b = (int)(r / SWA_H);
        const float slope = exp2f(-0.5f * (float)(head + 1));
        float q[64];
        load_row64((const bf16_t*)(ws + WS_QS) + ((size_t)(b * 8 + head) * T + tt) * 64, q);
        const bf16_t* K = (const bf16_t*)(ws + WS_KSW) + (size_t)b * T * 64;
        const bf16_t* V = (const bf16_t*)(ws + WS_VSW) + (size_t)b * T * 64 + dh * 32;
        const float sink = p.sinks[head];
        float m = sink, l = 1.0f, acc[32];
#pragma unroll
        for (int d = 0; d < 32; ++d) acc[d] = 0.f;
        for (int i = 0; i < SWA_WIN; ++i) {
            const int pos = tt - (SWA_WIN - 1) + i;
            if (pos >= 0) {
                const float s = dot_row64(K + (size_t)pos * 64, q) - slope * (float)(tt - pos);
                osm_update(s, V + (size_t)pos * 64, m, l, acc);
            }
        }
        const float inv = 1.0f / l;
        bf16_t* O = (bf16_t*)(p.ws + WS_O) + (size_t)(b * T + tt) * D + 512 + head * 64 + dh * 32;
#pragma unroll
        for (int c = 0; c < 4; ++c) {
            u32x4 w; w.x = pk2(acc[8 * c] * inv, acc[8 * c + 1] * inv); w.y = pk2(acc[8 * c + 2] * inv, acc[8 * c + 3] * inv);
            w.z = pk2(acc[8 * c + 4] * inv, acc[8 * c + 5] * inv); w.w = pk2(acc[8 * c + 6] * inv, acc[8 * c + 7] * inv);
            *(u32x4*)(O + 8 * c) = w;
        }
    }
}

__device__ __forceinline__ void topk_insert(float v, int i, float (&tv)[16], int (&ti)[16]) {
#pragma unroll
    for (int k = 0; k < 16; ++k) {
        const bool sw = v > tv[k];
        const float ov = tv[k]; const int oi = ti[k];
        tv[k] = sw ? v : ov; ti[k] = sw ? i : oi;
        v = sw ? ov : v; i = sw ? oi : i;
    }
}
__device__ __forceinline__ void phase_peer_sub(const Params& p) {
    const unsigned char* ws = p.ws;
    const long gt = (long)blockIdx.x * NTHREADS + tid_opaque(), ngt = (long)gridDim.x * NTHREADS;
    const long items = (long)NTOK * 16;
    for (long it = gt; it < items; it += ngt) {
        const int tok = (int)(it % NTOK), hc = (int)(it / NTOK);
        const bf16_t* qp = (const bf16_t*)(ws + WS_QP) + (size_t)tok * PQ + hc * 128;
        float q0[64], q1[64];
        load_row64(qp, q0); load_row64(qp + 64, q1);
        const bf16_t* keys = (const bf16_t*)(ws + WS_PKEYS) + (size_t)hc * 128 * 128;
        float tv[16]; int ti[16];
#pragma unroll
        for (int k = 0; k < 16; ++k) { tv[k] = -INFINITY; ti[k] = 0; }
        for (int n = 0; n < 128; ++n) {
            const float s = dot_row64(keys + (size_t)n * 128, q0) + dot_row64(keys + (size_t)n * 128 + 64, q1);
            topk_insert(s, n, tv, ti);
        }
        float* ov = (float*)(p.ws + WS_TOPV2) + ((size_t)tok * 16 + hc) * 16;
        int* oi = (int*)(p.ws + WS_TOPI2) + ((size_t)tok * 16 + hc) * 16;
#pragma unroll
        for (int k = 0; k < 16; ++k) { ov[k] = tv[k]; oi[k] = ti[k]; }
    }
}
__device__ __forceinline__ void phase_peer_comb(const Params& p) {
    const long gt = (long)blockIdx.x * NTHREADS + tid_opaque(), ngt = (long)gridDim.x * NTHREADS;
    const long items = (long)NTOK * PH;
    for (long it = gt; it < items; it += ngt) {
        const int tok = (int)(it / PH), h = (int)(it % PH);
        const float* v1 = (const float*)(p.ws + WS_TOPV2) + ((size_t)tok * 16 + h * 2) * 16;
        const float* v2 = v1 + 16;
        const int* i1 = (const int*)(p.ws + WS_TOPI2) + ((size_t)tok * 16 + h * 2) * 16;
        const int* i2 = i1 + 16;
        float s2[16];
#pragma unroll
        for (int k = 0; k < 16; ++k) s2[k] = v2[k];
        float tv[16]; int ti[16];
#pragma unroll
        for (int k = 0; k < 16; ++k) { tv[k] = -INFINITY; ti[k] = 0; }
        for (int a = 0; a < 16; ++a) {
            const float s1 = v1[a];
#pragma unroll
            for (int bb = 0; bb < 16; ++bb) topk_insert(s1 + s2[bb], a * 16 + bb, tv, ti);
        }
        float e[16], sum = 0.f;
#pragma unroll
        for (int k = 0; k < 16; ++k) { e[k] = __expf(tv[k] - tv[0]); sum += e[k]; }
        const float inv = 1.0f / sum;
        int* eo = (int*)(p.ws + WS_EIDX) + (size_t)tok * 128 + h * 16;
        float* go = (float*)(p.ws + WS_GATE) + (size_t)tok * 128 + h * 16;
#pragma unroll
        for (int k = 0; k < 16; ++k) { const int ci = ti[k]; eo[k] = i1[ci >> 4] * PNK + i2[ci & 15]; go[k] = e[k] * inv; }
    }
}

typedef float f32x2 __attribute__((ext_vector_type(2)));
__device__ __forceinline__ void unpack16_fp8(const u32x4& w, float (&f)[16]) {
#pragma unroll
    for (int q = 0; q < 4; ++q) {
        const f32x2 lo = __builtin_amdgcn_cvt_pk_f32_fp8((int)w[q], false), hi = __builtin_amdgcn_cvt_pk_f32_fp8((int)w[q], true);
        f[4 * q] = lo.x; f[4 * q + 1] = lo.y; f[4 * q + 2] = hi.x; f[4 * q + 3] = hi.y;
    }
}
__device__ __forceinline__ float reduce8(const float (&d)[8], int lane) {
    const bool b5 = lane & 32, b4 = lane & 16, b3 = lane & 8;
    float e[4], f[2];
#pragma unroll
    for (int i = 0; i < 4; ++i) { const float snd = b5 ? d[i] : d[i + 4], keep = b5 ? d[i + 4] : d[i]; e[i] = keep + __shfl_xor(snd, 32); }
#pragma unroll
    for (int i = 0; i < 2; ++i) { const float snd = b4 ? e[i] : e[i + 2], keep = b4 ? e[i + 2] : e[i]; f[i] = keep + __shfl_xor(snd, 16); }
    const float snd = b3 ? f[0] : f[1], keep = b3 ? f[1] : f[0];
    float g = keep + __shfl_xor(snd, 8);
    g += __shfl_xor(g, 4); g += __shfl_xor(g, 2); g += __shfl_xor(g, 1);
    return g;
}
__device__ __forceinline__ void phase_peer_expert(const Params& p) {
    const unsigned char* ws = p.ws;
    const int tid_ = tid_opaque(), lane = tid_ & 63;
    const int gw = (int)blockIdx.x * (NTHREADS / 64) + __builtin_amdgcn_readfirstlane(tid_ >> 6), ngw = (int)gridDim.x * (NTHREADS / 64);
    const unsigned char* U = ws + WS_U8; const unsigned char* V = ws + WS_V8;
    const unsigned loff = 16u * (unsigned)lane;
    for (int tok = gw; tok < NTOK; tok += ngw) {
        const bf16_t* hg = (const bf16_t*)(ws + WS_H1G + (size_t)tok * D * 2) + loff;
        float a[16];
        {
            const u32x4 w0 = *(const u32x4*)hg, w1 = *(const u32x4*)(hg + 8);
            a[0] = bflo(w0.x); a[1] = bfhi(w0.x); a[2] = bflo(w0.y); a[3] = bfhi(w0.y); a[4] = bflo(w0.z); a[5] = bfhi(w0.z); a[6] = bflo(w0.w); a[7] = bfhi(w0.w);
            a[8] = bflo(w1.x); a[9] = bfhi(w1.x); a[10] = bflo(w1.y); a[11] = bfhi(w1.y); a[12] = bflo(w1.z); a[13] = bfhi(w1.z); a[14] = bflo(w1.w); a[15] = bfhi(w1.w);
        }
        const float rstd2 = (1.0f / U8_SCALE) / sqrtf(((const float*)(ws + WS_SS2))[tok] * (1.0f / D) + EPS);
        const int e_lo = ((const int*)(ws + WS_EIDX))[(size_t)tok * 128 + lane], e_hi = ((const int*)(ws + WS_EIDX))[(size_t)tok * 128 + 64 + lane];
        const float g_lo = ((const float*)(ws + WS_GATE))[(size_t)tok * 128 + lane], g_hi = ((const float*)(ws + WS_GATE))[(size_t)tok * 128 + 64 + lane];
        float acc[16];
#pragma unroll
        for (int i = 0; i < 16; ++i) acc[i] = 0.f;
        u32x4 uw[8], vw[8];
#pragma unroll
        for (int k = 0; k < 8; ++k) { const int e = __builtin_amdgcn_readlane(e_lo, k); uw[k] = *(const u32x4*)(U + (size_t)e * D + loff); vw[k] = *(const u32x4*)(V + (size_t)e * D + loff); }
#pragma unroll 1
        for (int b = 0; b < 16; ++b) {
            const int nsrc = (b + 1 < 8) ? e_lo : e_hi; const int nbase = ((b + 1) & 7) * 8;
            float d[8];
#pragma unroll
            for (int k = 0; k < 8; ++k) {
                float uf[16]; unpack16_fp8(uw[k], uf);
                float d0 = 0.f, d1 = 0.f;
#pragma unroll
                for (int i = 0; i < 16; i += 2) { d0 += a[i] * uf[i]; d1 += a[i + 1] * uf[i + 1]; }
                d[k] = d0 + d1;
                __builtin_amdgcn_sched_barrier(0);
            }
            if (b + 1 < 16) {
#pragma unroll
                for (int k = 0; k < 8; ++k) { const int e = __builtin_amdgcn_readlane(nsrc, nbase + k); uw[k] = *(const u32x4*)(U + (size_t)e * D + loff); }
            }
            const float dk = reduce8(d, lane);
            const float gsel = __shfl((b < 8) ? g_lo : g_hi, (b & 7) * 8 + ((lane >> 3) & 7));
            const float w = gsel * gelu_tanh(dk * rstd2);
#pragma unroll
            for (int k = 0; k < 8; ++k) {
                const float wk = __uint_as_float((unsigned)__builtin_amdgcn_readlane((int)__float_as_uint(w), 8 * k));
                float vf[16]; unpack16_fp8(vw[k], vf);
#pragma unroll
                for (int i = 0; i < 16; ++i) acc[i] += wk * vf[i];
                __builtin_amdgcn_sched_barrier(0);
            }
            if (b + 1 < 16) {
#pragma unroll
                for (int k = 0; k < 8; ++k) { const int e = __builtin_amdgcn_readlane(nsrc, nbase + k); vw[k] = *(const u32x4*)(V + (size_t)e * D + loff); }
            }
        }
        float* orow = (float*)((unsigned char*)p.out + (size_t)tok * D * 4) + loff;
        float y[16]; float ss = 0.f;
#pragma unroll
        for (int q = 0; q < 4; ++q) {
            const f32x4 h = *(const f32x4*)(orow + 4 * q);
            y[4 * q] = h.x + acc[4 * q] * (1.0f / V8_SCALE); y[4 * q + 1] = h.y + acc[4 * q + 1] * (1.0f / V8_SCALE);
            y[4 * q + 2] = h.z + acc[4 * q + 2] * (1.0f / V8_SCALE); y[4 * q + 3] = h.w + acc[4 * q + 3] * (1.0f / V8_SCALE);
        }
#pragma unroll
        for (int i = 0; i < 16; ++i) ss += y[i] * y[i];
        const float rstd = 1.0f / sqrtf(wave_sum(ss) * (1.0f / D) + EPS);
#pragma unroll
        for (int q = 0; q < 4; ++q) {
            const f32x4 g = *(const f32x4*)(p.lnf_g + loff + 4 * q);
            *(f32x4*)(orow + 4 * q) = (f32x4){y[4 * q] * rstd * g.x, y[4 * q + 1] * rstd * g.y, y[4 * q + 2] * rstd * g.z, y[4 * q + 3] * rstd * g.w};
        }
    }
}


namespace psel {
#define HD __host__ __device__ __forceinline__
HD unsigned f2ord(float f) { unsigned u = __builtin_bit_cast(unsigned, f); const unsigned m = (unsigned)((int)u >> 31); return u ^ (m | 0x80000000u); }
HD float ord2f(unsigned o) { const unsigned m = (unsigned)((int)o >> 31); return __builtin_bit_cast(float, o ^ (~m | 0x80000000u)); }
HD unsigned umax_(unsigned a, unsigned b) { return a > b ? a : b; }
HD unsigned umin_(unsigned a, unsigned b) { return a < b ? a : b; }
HD void sort16_desc(unsigned (&a)[16]) {
#define CE_(i, j) { const unsigned h_ = umax_(a[i], a[j]), l_ = umin_(a[i], a[j]); a[i] = h_; a[j] = l_; }
    CE_(0, 13) CE_(1, 12) CE_(2, 15) CE_(3, 14) CE_(4, 8) CE_(5, 6) CE_(7, 11) CE_(9, 10)
    CE_(0, 5) CE_(1, 7) CE_(2, 9) CE_(3, 4) CE_(6, 13) CE_(8, 14) CE_(10, 15) CE_(11, 12)
    CE_(0, 1) CE_(2, 3) CE_(4, 5) CE_(6, 8) CE_(7, 9) CE_(10, 11) CE_(12, 13) CE_(14, 15)
    CE_(0, 2) CE_(1, 3) CE_(4, 10) CE_(5, 11) CE_(6, 7) CE_(8, 9) CE_(12, 14) CE_(13, 15)
    CE_(1, 2) CE_(3, 12) CE_(4, 6) CE_(5, 7) CE_(8, 10) CE_(9, 11) CE_(13, 14)
    CE_(1, 4) CE_(2, 6) CE_(5, 8) CE_(7, 10) CE_(9, 13) CE_(11, 14)
    CE_(2, 4) CE_(3, 6) CE_(9, 12) CE_(11, 13)
    CE_(3, 5) CE_(6, 8) CE_(7, 9) CE_(10, 12)
    CE_(3, 4) CE_(5, 6) CE_(7, 8) CE_(9, 10) CE_(11, 12)
    CE_(6, 7) CE_(8, 9)
#undef CE_
}
HD void merge16_desc(unsigned (&a)[16], const unsigned (&b)[16]) {
#pragma unroll
    for (int i = 0; i < 16; ++i) a[i] = umax_(a[i], b[15 - i]);
#pragma unroll
    for (int j = 8; j > 0; j >>= 1)
#pragma unroll
        for (int i = 0; i < 16; ++i) {
            const int l = i ^ j;
            if (l > i) { const unsigned hi = umax_(a[i], a[l]), lo = umin_(a[i], a[l]); a[i] = hi; a[l] = lo; }
        }
}
HD void top16_of_64(unsigned (&g0)[16], unsigned (&g1)[16], unsigned (&g2)[16], unsigned (&g3)[16]) {
    sort16_desc(g0); sort16_desc(g1); sort16_desc(g2); sort16_desc(g3);
    merge16_desc(g0, g1); merge16_desc(g2, g3); merge16_desc(g0, g2);
}
struct PairTab { int a[64]; int b[64]; int n; };
constexpr PairTab make_pairs() {
    PairTab t{}; int n = 0;
    for (int a = 0; a < 16; ++a) for (int b = 0; b < 16; ++b) if ((a + 1) * (b + 1) <= 16) { t.a[n] = a; t.b[n] = b; ++n; }
    t.n = n; for (int i = n; i < 64; ++i) { t.a[i] = 0; t.b[i] = 0; }
    return t;
}
#undef HD
typedef float f32x16 __attribute__((ext_vector_type(16)));
#define PLAS __attribute__((address_space(3)))
static constexpr PairTab PT = make_pairs();
__device__ __forceinline__ constexpr int crow_c(int r) { return (r & 3) + 8 * (r >> 2); }
__device__ __forceinline__ void phase_peer_select(const Params& p, unsigned char* lds_generic) {
    const unsigned char* ws = p.ws;
    const int tid = tid_opaque(), lane = tid & 63, wid = __builtin_amdgcn_readfirstlane(tid >> 6), r32 = lane & 31, hi = lane >> 5;
    PLAS int* tab = (PLAS int*)((PLAS unsigned char*)lds_generic) + wid * 2048;
    const int gw = (int)blockIdx.x * (NTHREADS / 64) + wid, ngw = (int)gridDim.x * (NTHREADS / 64);
    const __amdgpu_buffer_rsrc_t rq = __builtin_amdgcn_make_buffer_rsrc((void*)(p.ws + WS_QP), (short)0, (int)((size_t)NTOK * PQ * 2), 0x00020000);
    const __amdgpu_buffer_rsrc_t rk = __builtin_amdgcn_make_buffer_rsrc((void*)(p.ws + WS_PKEYS), (short)0, 16 * 128 * 128 * 2, 0x00020000);
    const int h = (int)blockIdx.x & 7, nbh = (int)gridDim.x >> 3, bh = (int)blockIdx.x >> 3;
    PLAS unsigned char* kl = (PLAS unsigned char*)lds_generic + 65536;
    if (bh < nbh) {
#pragma unroll 1
        for (int j = wid; j < 64; j += NTHREADS / 64) {
            const int c = j >> 5, row = 4 * (j & 31) + (lane >> 4);
            const unsigned goff = (unsigned)(((h * 2 + c) * 128 + row) * 256 + (((lane & 15) ^ (row & 15)) * 16));
            __builtin_amdgcn_raw_ptr_buffer_load_lds(rk, (PLAS void*)(kl + j * 1024), 16, (int)goff, 0, 0, 0);
        }
    }
    asm volatile("s_waitcnt vmcnt(0)" ::: "memory");
    __syncthreads();
    unsigned xo[8];
#pragma unroll
    for (int d0 = 0; d0 < 8; ++d0) xo[d0] = (unsigned)(r32 * 256 + (((2 * d0 + hi) ^ (r32 & 15)) * 16));
    (void)gw; (void)ngw;
    for (int tb = bh + nbh * wid; tb < NTOK / 32 && bh < nbh; tb += nbh * (NTHREADS / 64)) {
        const int tok = 32 * tb + r32;
        int hi4 = 4 * hi; asm volatile("" : "+v"(hi4));
        unsigned k1[16], k2[16];
#pragma unroll
        for (int c = 0; c < 2; ++c) {
            const int hc = h * 2 + c;
            const unsigned qoff = (unsigned)(r32 * PQ + 8 * hi) * 2u;
            const int qso = (tb * 32 * PQ + hc * 128) * 2;
            bf16x8 qf[8];
#pragma unroll
            for (int d0 = 0; d0 < 8; ++d0) qf[d0] = __builtin_bit_cast(bf16x8, __builtin_amdgcn_raw_buffer_load_b128(rq, (int)qoff, qso + 32 * d0, 0));
            unsigned g[4][16];
#pragma unroll
            for (int nt = 0; nt < 4; ++nt) {
                f32x16 acc;
#pragma unroll
                for (int r = 0; r < 16; ++r) acc[r] = 0.f;
#pragma unroll
                for (int d0 = 0; d0 < 8; ++d0) {
                    const bf16x8 kf = *(const PLAS bf16x8*)(kl + c * 32768 + nt * 8192 + xo[d0]);
                    acc = __builtin_amdgcn_mfma_f32_32x32x16_bf16(kf, qf[d0], acc, 0, 0, 0);
                }
#pragma unroll
                for (int r = 0; r < 16; ++r) g[nt][r] = (f2ord(acc[r]) & 0xFFFFFF80u) | (unsigned)((127 - 32 * nt - crow_c(r)) - hi4);
                __builtin_amdgcn_sched_barrier(0);
            }
            top16_of_64(g[0], g[1], g[2], g[3]);
            unsigned pb[16];
#pragma unroll
            for (int i = 0; i < 16; ++i) pb[i] = (unsigned)__shfl_xor((int)g[0][i], 32);
            merge16_desc(g[0], pb);
#pragma unroll
            for (int i = 0; i < 16; ++i) { if (c == 0) k1[i] = g[0][i]; else k2[i] = g[0][i]; }
        }
        float v1[16], v2[16];
#pragma unroll
        for (int i = 0; i < 16; ++i) { v1[i] = ord2f(k1[i] & 0xFFFFFF80u); v2[i] = ord2f(k2[i] & 0xFFFFFF80u); }
        unsigned cg[4][16];
#pragma unroll
        for (int s = 0; s < 64; ++s) {
            unsigned key = 0u;
            if (s < PT.n) key = (f2ord(v1[PT.a[s]] + v2[PT.b[s]]) & 0xFFFFFF00u) | (unsigned)(255 - (PT.a[s] * 16 + PT.b[s]));
            cg[s >> 4][s & 15] = key;
        }
        top16_of_64(cg[0], cg[1], cg[2], cg[3]);
#pragma unroll
        for (int i = 0; i < 16; ++i) { tab[i * 64 + lane] = 127 - (int)(k1[i] & 127u); tab[(16 + i) * 64 + lane] = 127 - (int)(k2[i] & 127u); }
        __builtin_amdgcn_fence(__ATOMIC_RELEASE, "wavefront"); __builtin_amdgcn_wave_barrier();
        int eo[16]; float ge[16]; float gsum = 0.f;
        const float top = ord2f(cg[0][0] & 0xFFFFFF00u);
#pragma unroll
        for (int k = 0; k < 16; ++k) {
            const int ab = 255 - (int)(cg[0][k] & 255u);
            eo[k] = tab[(ab >> 4) * 64 + lane] * PNK + tab[(16 + (ab & 15)) * 64 + lane];
            ge[k] = __expf(ord2f(cg[0][k] & 0xFFFFFF00u) - top); gsum += ge[k];
        }
        __builtin_amdgcn_wave_barrier();
        const float ginv = 1.0f / gsum;
        if (hi == 0) {
            int* eout = (int*)(p.ws + WS_EIDX) + ((size_t)h * NTOK + tok) * 16;
            float* gout = (float*)(p.ws + WS_GATE) + ((size_t)h * NTOK + tok) * 16;
#pragma unroll
            for (int q = 0; q < 4; ++q) {
                *(u32x4*)(eout + 4 * q) = (u32x4){(unsigned)eo[4 * q], (unsigned)eo[4 * q + 1], (unsigned)eo[4 * q + 2], (unsigned)eo[4 * q + 3]};
                *(f32x4*)(gout + 4 * q) = (f32x4){ge[4 * q] * ginv, ge[4 * q + 1] * ginv, ge[4 * q + 2] * ginv, ge[4 * q + 3] * ginv};
            }
        }
    }
}
}

namespace att {
typedef float f32x16 __attribute__((ext_vector_type(16)));
typedef short s16x4 __attribute__((ext_vector_type(4)));
typedef short v4i16_t __attribute__((ext_vector_type(4)));
#define ALAS __attribute__((address_space(3)))
typedef ALAS unsigned char* lptr;
constexpr int L_K = 0, L_V = 16384, L_IMP = 32768, L_SELM = L_IMP + 64 * 129 * 4, L_UNION = L_SELM + 1024, L_WSCR = L_UNION + 16, L_ACC = L_WSCR + 8 * 256, L_END = L_ACC + 8 * 8192;
constexpr float LOG2E = 1.4426950408889634f;
constexpr float THR = 10.0f;
__device__ __forceinline__ constexpr int crow_c(int r) { return (r & 3) + 8 * (r >> 2); }
__device__ __forceinline__ unsigned cvtpk(float lo, float hi) { typedef float f2 __attribute__((ext_vector_type(2))); typedef __bf16 b2 __attribute__((ext_vector_type(2)));
    f2 v = {lo, hi}; b2 b = __builtin_convertvector(v, b2); return __builtin_bit_cast(unsigned, b); }
__device__ __forceinline__ s16x4 vtr(lptr p) { return __builtin_bit_cast(s16x4, __builtin_amdgcn_ds_read_tr16_b64_v4i16((ALAS v4i16_t*)p)); }

struct Stage { u32x4 k, v; };
__device__ __forceinline__ void stage_load(const bf16_t* Kt, const bf16_t* Vt, int wid, int lane, Stage& s, bool withV) {
    s.k = *(const u32x4*)(Kt + (size_t)lane * 64 + wid * 8);
    if (withV) s.v = *(const u32x4*)(Vt + (size_t)(16 * (wid & 3) + (lane >> 2)) * 64 + (wid >> 2) * 32 + (lane & 3) * 8);
}
__device__ __forceinline__ void stage_store(lptr kbuf, lptr vbuf, int wid, int lane, const Stage& s, bool withV) {
    *(ALAS u32x4*)(kbuf + wid * 1024 + lane * 16) = s.k;
    if (withV) *(ALAS u32x4*)(vbuf + wid * 1024 + lane * 16) = s.v;
}
__device__ __forceinline__ void qk_tile(f32x16& p0, f32x16& p1, lptr kbuf, const bf16x8 (&qf)[4], float cb, float sk, int r32, int hi) {
    asm volatile("" : "+v"(sk));
    const float cb2 = cb + sk * (float)(4 * hi);
#pragma unroll
    for (int r = 0; r < 16; ++r) {
        float a = __builtin_fmaf(sk, (float)crow_c(r), cb2), b = __builtin_fmaf(sk, (float)(crow_c(r) + 32), cb2);
        asm("" : "+v"(a)); asm("" : "+v"(b));
        p0[r] = a; p1[r] = b;
    }
    lptr kb = kbuf + hi * 1024 + r32 * 16;
#pragma unroll
    for (int d0 = 0; d0 < 4; ++d0) {
        const bf16x8 k0 = *(const ALAS bf16x8*)(kb + d0 * 2048), k1 = *(const ALAS bf16x8*)(kb + d0 * 2048 + 512);
        p0 = __builtin_amdgcn_mfma_f32_32x32x16_bf16(k0, qf[d0], p0, 0, 0, 0);
        p1 = __builtin_amdgcn_mfma_f32_32x32x16_bf16(k1, qf[d0], p1, 0, 0, 0);
    }
}
__device__ __forceinline__ float min2f(float a, float b) { float r; asm("v_min_f32_e32 %0, %1, %2" : "=v"(r) : "v"(a), "v"(b)); return r; }
#define MASK_EL(x, C, lim, OP) do { float x_ = (x); asm("v_cmp_" OP "_i32_e32 vcc, %2, %1\n\tv_cndmask_b32_e32 %0, %0, %3, vcc" : "+v"(x_) : "v"(lim), "n"(C), "v"(ninf) : "vcc"); (x) = x_; } while (0)
#define MASK_ROW(r, C, lim, OP) do { MASK_EL(p0[r], C, lim, OP); MASK_EL(p1[r], (C) + 32, lim, OP); } while (0)
#define MASK_ALL(lim, OP) do { MASK_ROW(0, 0, lim, OP); MASK_ROW(1, 1, lim, OP); MASK_ROW(2, 2, lim, OP); MASK_ROW(3, 3, lim, OP); MASK_ROW(4, 8, lim, OP); MASK_ROW(5, 9, lim, OP); MASK_ROW(6, 10, lim, OP); MASK_ROW(7, 11, lim, OP); \
        MASK_ROW(8, 16, lim, OP); MASK_ROW(9, 17, lim, OP); MASK_ROW(10, 18, lim, OP); MASK_ROW(11, 19, lim, OP); MASK_ROW(12, 24, lim, OP); MASK_ROW(13, 25, lim, OP); MASK_ROW(14, 26, lim, OP); MASK_ROW(15, 27, lim, OP); } while (0)
__device__ __forceinline__ void mask_tile(f32x16& p0, f32x16& p1, int hi_lim, int lo_lim, int hi) {
    float ninf = -INFINITY; asm volatile("" : "+v"(ninf));
    if (__builtin_amdgcn_readfirstlane(lo_lim) < 0) { int hl = hi_lim - 4 * hi; asm volatile("" : "+v"(hl)); MASK_ALL(hl, "gt"); }
    else { int ll = lo_lim - 4 * hi; asm volatile("" : "+v"(ll)); MASK_ALL(ll, "le"); }
}
#undef MASK_ALL
#undef MASK_ROW
#undef MASK_EL
__device__ __forceinline__ float max3f(float a, float b, float c) { float r; asm("v_max3_f32 %0, %1, %2, %3" : "=v"(r) : "v"(a), "v"(b), "v"(c)); return r; }
__device__ __forceinline__ float max2f(float a, float b) { float r; asm("v_max_f32_e32 %0, %1, %2" : "=v"(r) : "v"(a), "v"(b)); return r; }
__device__ __forceinline__ float full_sum(float x) {
    const auto rr = __builtin_amdgcn_permlane32_swap(__float_as_uint(x), __float_as_uint(x), false, false);
    return __uint_as_float(rr[0]) + __uint_as_float(rr[1]);
}
__device__ __forceinline__ float tile_max(const f32x16& p0, const f32x16& p1) {
    float a = max3f(p0[0], p0[1], p1[0]), b = max3f(p0[2], p0[3], p1[1]); a = max3f(a, p1[2], p1[3]);
#pragma unroll
    for (int r = 4; r < 16; r += 4) { a = max3f(a, p0[r], p0[r + 1]); b = max3f(b, p0[r + 2], p0[r + 3]); a = max3f(a, p1[r], p1[r + 1]); b = max3f(b, p1[r + 2], p1[r + 3]); }
    const float m = max2f(a, b);
    const auto rr = __builtin_amdgcn_permlane32_swap(__float_as_uint(m), __float_as_uint(m), false, false);
    return max2f(__uint_as_float(rr[0]), __uint_as_float(rr[1]));
}
__device__ __forceinline__ float tile_sum(const f32x16& p0, const f32x16& p1) {
    float a = p0[0], b = p1[0];
#pragma unroll
    for (int r = 1; r < 16; ++r) { a += p0[r]; asm("" : "+v"(a)); b += p1[r]; asm("" : "+v"(b)); }
    return a + b;
}
__device__ __forceinline__ void pack_p(u32x4 (&pw)[4], const f32x16& p0, const f32x16& p1) {
    pw[0] = (u32x4){cvtpk(p0[0], p0[1]), cvtpk(p0[2], p0[3]), cvtpk(p0[4], p0[5]), cvtpk(p0[6], p0[7])};
    pw[1] = (u32x4){cvtpk(p0[8], p0[9]), cvtpk(p0[10], p0[11]), cvtpk(p0[12], p0[13]), cvtpk(p0[14], p0[15])};
    pw[2] = (u32x4){cvtpk(p1[0], p1[1]), cvtpk(p1[2], p1[3]), cvtpk(p1[4], p1[5]), cvtpk(p1[6], p1[7])};
    pw[3] = (u32x4){cvtpk(p1[8], p1[9]), cvtpk(p1[10], p1[11]), cvtpk(p1[12], p1[13]), cvtpk(p1[14], p1[15])};
}
__device__ __forceinline__ void pv_packed(f32x16& o0, f32x16& o1, const u32x4 (&pw)[4], lptr vbuf, int lane, int hi) {
    lptr vp = vbuf + ((lane >> 4) & 1) * 32 + (lane & 3) * 8 + (4 * hi + ((lane & 15) >> 2)) * 64;
#pragma unroll
    for (int ks = 0; ks < 4; ++ks) {
        const s16x4 a = vtr(vp + ks * 1024), b = vtr(vp + ks * 1024 + 512);
        const s16x4 c = vtr(vp + 4096 + ks * 1024), d = vtr(vp + 4096 + ks * 1024 + 512);
        const bf16x8 v0 = (bf16x8){a[0], a[1], a[2], a[3], b[0], b[1], b[2], b[3]}, v1 = (bf16x8){c[0], c[1], c[2], c[3], d[0], d[1], d[2], d[3]};
        const bf16x8 pa = __builtin_bit_cast(bf16x8, pw[ks]);
        o0 = __builtin_amdgcn_mfma_f32_32x32x16_bf16(pa, v0, o0, 0, 0, 0);
        o1 = __builtin_amdgcn_mfma_f32_32x32x16_bf16(pa, v1, o1, 0, 0, 0);
    }
}
__device__ __forceinline__ void pv_tile(f32x16& o0, f32x16& o1, const f32x16& p0, const f32x16& p1, lptr vbuf, int lane, int hi) {
    u32x4 pw[4]; pack_p(pw, p0, p1);
    pv_packed(o0, o1, pw, vbuf, lane, hi);
}
__device__ __forceinline__ void ov_frags(bf16x8 (&ovf)[4], int r32, int hi) {
#pragma unroll
    for (int ks = 0; ks < 4; ++ks)
#pragma unroll
        for (int j = 0; j < 8; ++j) {
            const int q4 = 4 * ks + 2 * (j >> 2) + hi;
            const bool on = (r32 == q4) || ((j & 3) == 3 && r32 == q4 + 1);
            ovf[ks][j] = on ? (short)0x3F80 : (short)0;
        }
}
__device__ __forceinline__ void scale_rows(f32x16& o0, f32x16& o1, float f, ALAS float* wscr, int r32, int hi) {
    if (hi == 0) wscr[r32] = f;
    __builtin_amdgcn_fence(__ATOMIC_RELEASE, "wavefront"); __builtin_amdgcn_wave_barrier();
#pragma unroll
    for (int r = 0; r < 16; ++r) { const float a = wscr[crow_c(r) + 4 * hi]; o0[r] *= a; o1[r] *= a; }
    __builtin_amdgcn_wave_barrier();
}
template <bool FIRST>
__device__ __forceinline__ void acc_rows(ALAS float* accw, const f32x16& o0, const f32x16& o1, float f, ALAS float* wscr, int r32, int hi) {
    if (hi == 0) wscr[r32] = f;
    __builtin_amdgcn_fence(__ATOMIC_RELEASE, "wavefront"); __builtin_amdgcn_wave_barrier();
#pragma unroll
    for (int r = 0; r < 16; ++r) {
        const int row = crow_c(r) + 4 * hi; const float a = wscr[row];
        ALAS float* d = accw + row * 64 + r32;
        if (FIRST) { d[0] = o0[r] * a; d[32] = o1[r] * a; } else { d[0] += o0[r] * a; d[32] += o1[r] * a; }
    }
    __builtin_amdgcn_wave_barrier();
}
__device__ __forceinline__ void store_acc(ALAS float* accw, bf16_t* O, int lane) {
    __builtin_amdgcn_fence(__ATOMIC_RELEASE, "wavefront"); __builtin_amdgcn_wave_barrier();
#pragma unroll
    for (int it = 0; it < 4; ++it) {
        const int item = it * 64 + lane, row = item >> 3, ch = item & 7;
        const f32x4 x = *(const ALAS f32x4*)(accw + row * 64 + ch * 8), y = *(const ALAS f32x4*)(accw + row * 64 + ch * 8 + 4);
        u32x4 w; w.x = cvtpk(x[0], x[1]); w.y = cvtpk(x[2], x[3]); w.z = cvtpk(y[0], y[1]); w.w = cvtpk(y[2], y[3]);
        *(u32x4*)(O + (size_t)(row & 7) * D + (row >> 3) * 64 + ch * 8) = w;
    }
    __builtin_amdgcn_wave_barrier();
}
struct Br { float m, l; f32x16 o0, o1; };
__device__ __forceinline__ void attend_tile(Br& s, lptr kbuf, lptr vbuf, const bf16x8 (&qf)[4], float cb, float sk, bool domask, int hi_lim, int lo_lim, ALAS float* wscr, int lane, int r32, int hi) {
    f32x16 p0, p1;
    const float mu = (s.m < -1e29f) ? 0.f : s.m;
    qk_tile(p0, p1, kbuf, qf, cb - mu, sk, r32, hi);
    if (domask) mask_tile(p0, p1, hi_lim, lo_lim, hi);
    const float rm = tile_max(p0, p1);
    if (__any(rm + mu > s.m + THR)) {
        const float mn = fmaxf(s.m, rm + mu), alpha = __builtin_amdgcn_exp2f(s.m - mn), delta = mn - mu;
        s.l *= alpha; s.m = mn;
        scale_rows(s.o0, s.o1, alpha, wscr, r32, hi);
#pragma unroll
        for (int r = 0; r < 16; ++r) { p0[r] -= delta; p1[r] -= delta; }
    }
#pragma unroll
    for (int r = 0; r < 16; ++r) { p0[r] = __builtin_amdgcn_exp2f(p0[r]); p1[r] = __builtin_amdgcn_exp2f(p1[r]); }
    s.l += tile_sum(p0, p1);
    pv_tile(s.o0, s.o1, p0, p1, vbuf, lane, hi);
}

#define ATT_BAR() asm volatile("s_waitcnt lgkmcnt(0)\n\ts_barrier" ::: "memory")
template <int PVAR = 0>
__device__ __forceinline__ void nsa_unit(const Params& p, unsigned char* lds_generic, int b, int g, int tile) {
    lptr lds = (lptr)lds_generic;
    const int tid = tid_opaque(), lane = tid & 63, wid = __builtin_amdgcn_readfirstlane(tid >> 6), r32 = lane & 31, hi = lane >> 5;
    const int h = r32 >> 3, qi = r32 & 7, tq = 8 * wid + qi, t = 64 * tile + tq, head = g * 4 + h;
    const float slope = exp2f(-0.5f * (float)(9 + head)) * LOG2E;
    const unsigned char* ws = p.ws;
    ALAS float* imp = (ALAS float*)(lds + L_IMP);
    ALAS unsigned* selm = (ALAS unsigned*)(lds + L_SELM);
    ALAS unsigned* uni = (ALAS unsigned*)(lds + L_UNION);
    ALAS float* wscr = (ALAS float*)(lds + L_WSCR) + wid * 64;
    const bf16_t* KC = (const bf16_t*)(ws + WS_KC) + (size_t)(b * 2 + g) * NCMPP * 64;
    const bf16_t* VC = (const bf16_t*)(ws + WS_VC) + (size_t)(b * 2 + g) * NCMPP * 64;
    const bf16_t* KS = (const bf16_t*)(ws + WS_KV6 + 2 * KV6_STRIDE) + (size_t)(b * 2 + g) * T * 64;
    const bf16_t* VS = (const bf16_t*)(ws + WS_KV6 + 3 * KV6_STRIDE) + (size_t)(b * 2 + g) * T * 64;
    const bf16_t* KW = (const bf16_t*)(ws + WS_KV6 + 4 * KV6_STRIDE) + (size_t)(b * 2 + g) * T * 64;
    const bf16_t* VW = (const bf16_t*)(ws + WS_KV6 + 5 * KV6_STRIDE) + (size_t)(b * 2 + g) * T * 64;
    const float* gs = (const float*)(ws + WS_GSIG) + (size_t)(b * T + t) * 24 + head * 3;
    bf16x8 qf[4];
    {
        const bf16_t* qp = (const bf16_t*)(ws + WS_QN) + ((size_t)(b * 8 + head) * T + t) * 64 + 8 * hi;
#pragma unroll
        for (int d0 = 0; d0 < 4; ++d0) qf[d0] = *(const bf16x8*)(qp + 16 * d0);
    }
    for (int i = tid; i < 64 * 129; i += NTHREADS) imp[i] = 0.f;
    if (tid < 4) uni[tid] = 0u;
    ALAS float* accw = (ALAS float*)(lds + L_ACC) + wid * 2048;
    const int nc = 4 * tile + 3, n = (nc + 63) >> 6, n2 = 2 * n;
    const int nw = (tile < 8) ? tile + 1 : 9, NS = n2 + nw;
#define GK(x) ((x) < n2 ? KC + (size_t)((x) < n ? (x) : (x) - n) * 4096 : ((x) < NS ? KW + (size_t)(tile - ((x) - n2)) * 4096 : KS + (size_t)tile * 4096))
#define GV(x) ((x) < n2 ? VC + (size_t)((x) < n ? (x) : (x) - n) * 4096 : ((x) < NS ? VW + (size_t)(tile - ((x) - n2)) * 4096 : VS + (size_t)tile * 4096))
#define PIPE_HEAD(x) do { if ((x) + 2 <= NS) stage_load(GK((x) + 2), GV((x) + 2), wid, lane, sB, true); } while (0)
#define PIPE_TAIL(x) do { if ((x) + 1 <= NS) stage_store(lds + L_K + (cur ^ 1) * 8192, lds + L_V + (cur ^ 1) * 8192, wid, lane, sA, true); ATT_BAR(); cur ^= 1; sA = sB; } while (0)
    Stage sA, sB; int cur = 0;
    stage_load(GK(0), GV(0), wid, lane, sA, true);
    stage_store(lds + L_K, lds + L_V, wid, lane, sA, true);
    ATT_BAR();
    stage_load(GK(1), GV(1), wid, lane, sA, true);
    const int cmax = (t >= 31) ? ((t - 31) >> 4) : -1;
    const float skc = 16.0f * slope, cbc = -slope * (float)(t - 31);
    float mc = -1e30f, lc = 0.f;
    for (int x = 0; x < n; ++x) {
        PIPE_HEAD(x);
        const int i = x;
        if (!(PVAR & 1)) {
        f32x16 p0, p1;
        qk_tile(p0, p1, lds + L_K + cur * 8192, qf, cbc + skc * (float)(64 * i), skc, r32, hi);
        if (__any(cmax - 64 * i < 63)) mask_tile(p0, p1, cmax - 64 * i, -1, hi);
        const float rm = tile_max(p0, p1), mn = fmaxf(mc, rm);
#pragma unroll
        for (int r = 0; r < 16; ++r) { p0[r] = __builtin_amdgcn_exp2f(p0[r] - mn); p1[r] = __builtin_amdgcn_exp2f(p1[r] - mn); }
        lc = lc * __builtin_amdgcn_exp2f(mc - mn) + tile_sum(p0, p1); mc = mn;
        }
        PIPE_TAIL(x);
    }
    {
        lc = full_sum(lc);
        const float nrm = (lc > 0.f) ? (mc + __builtin_amdgcn_logf(lc)) : 0.f;
        Br sc; sc.m = 0.f; sc.l = 0.f;
#pragma unroll
        for (int r = 0; r < 16; ++r) { sc.o0[r] = 0.f; sc.o1[r] = 0.f; }
        bf16x8 ovf[4]; ov_frags(ovf, r32, hi);
        for (int x = n; x < n2; ++x) {
            PIPE_HEAD(x);
            const int i = x - n;
            if (!(PVAR & 2)) {
            f32x16 p0, p1;
            qk_tile(p0, p1, lds + L_K + cur * 8192, qf, cbc + skc * (float)(64 * i) - nrm, skc, r32, hi);
            if (__any(cmax - 64 * i < 63)) mask_tile(p0, p1, cmax - 64 * i, -1, hi);
#pragma unroll
            for (int r = 0; r < 16; ++r) { p0[r] = __builtin_amdgcn_exp2f(p0[r]); p1[r] = __builtin_amdgcn_exp2f(p1[r]); }
            u32x4 pw[4]; pack_p(pw, p0, p1);
            pv_packed(sc.o0, sc.o1, pw, lds + L_V + cur * 8192, lane, hi);
            f32x16 ia;
#pragma unroll
            for (int r = 0; r < 16; ++r) ia[r] = 0.f;
#pragma unroll
            for (int ks = 0; ks < 4; ++ks) ia = __builtin_amdgcn_mfma_f32_32x32x16_bf16(__builtin_bit_cast(bf16x8, pw[ks]), ovf[ks], ia, 0, 0, 0);
            const int sb = 16 * i + r32;
            if (r32 <= 16 && sb < NSEL) {
#pragma unroll
                for (int m = 0; m < 4; ++m) imp[(8 * wid + 4 * hi + m) * 129 + sb] += (ia[m] + ia[m + 4]) + (ia[m + 8] + ia[m + 12]);
            }
            }
            PIPE_TAIL(x);
        }
        acc_rows<true>(accw, sc.o0, sc.o1, gs[0], wscr, r32, hi);
    }
    {
        Br sw; sw.m = -1e30f; sw.l = 0.f;
#pragma unroll
        for (int r = 0; r < 16; ++r) { sw.o0[r] = 0.f; sw.o1[r] = 0.f; }
        for (int x = n2; x < NS; ++x) {
            PIPE_HEAD(x);
            const int j = tile - (x - n2);
            const float cb = -slope * (float)(t - 64 * j);
            if (!(PVAR & 4)) attend_tile(sw, lds + L_K + cur * 8192, lds + L_V + cur * 8192, qf, cb, slope, (j == tile) || (j == tile - 8), (j == tile) ? tq : 63, (j == tile - 8) ? tq : -1, wscr, lane, r32, hi);
            PIPE_TAIL(x);
        }
        acc_rows<false>(accw, sw.o0, sw.o1, gs[2] / fmaxf(full_sum(sw.l), 1e-30f), wscr, r32, hi);
    }
#undef GK
#undef GV
#undef PIPE_HEAD
#undef PIPE_TAIL
    if (!(PVAR & 16)) {
        const int q = tid >> 3, sub = tid & 7;
        unsigned kq[16];
#pragma unroll
        for (int i = 0; i < 16; ++i) {
            const int j = sub * 16 + i; float x = imp[q * 129 + j];
            if (j == 0 || j == tile || j == tile - 1) x = 1.0e4f;
            if (j > tile) x = -INFINITY;
            kq[i] = (psel::f2ord(x) & 0xFFFFFF80u) | (unsigned)(127 - j);
        }
        psel::sort16_desc(kq);
#pragma unroll
        for (int off = 1; off < 8; off <<= 1) {
            unsigned pb[16];
#pragma unroll
            for (int i = 0; i < 16; ++i) pb[i] = (unsigned)__shfl_xor((int)kq[i], off);
            psel::merge16_desc(kq, pb);
        }
        if (sub == 0) {
            unsigned w0 = 0u, w1 = 0u, w2 = 0u, w3 = 0u;
            const unsigned ninf = psel::f2ord(-INFINITY) & 0xFFFFFF80u;
#pragma unroll
            for (int i = 0; i < 16; ++i) {
                const int bj = 127 - (int)(kq[i] & 127u); const bool ok = (kq[i] & 0xFFFFFF80u) != ninf;
                const int k = bj >> 5; const unsigned bit = ok ? (1u << (bj & 31)) : 0u;
                w0 |= (k == 0) ? bit : 0u; w1 |= (k == 1) ? bit : 0u; w2 |= (k == 2) ? bit : 0u; w3 |= (k == 3) ? bit : 0u;
            }
            selm[q * 4 + 0] = w0; selm[q * 4 + 1] = w1; selm[q * 4 + 2] = w2; selm[q * 4 + 3] = w3;
            atomicOr((unsigned*)(uni + 0), w0); atomicOr((unsigned*)(uni + 1), w1); atomicOr((unsigned*)(uni + 2), w2); atomicOr((unsigned*)(uni + 3), w3);
        }
    }
    __syncthreads();
    {
        unsigned u0 = uni[0], u1 = uni[1], u2 = uni[2], u3 = uni[3];
        u0 = __builtin_amdgcn_readfirstlane(u0); u1 = __builtin_amdgcn_readfirstlane(u1); u2 = __builtin_amdgcn_readfirstlane(u2); u3 = __builtin_amdgcn_readfirstlane(u3);
        const unsigned s0 = selm[tq * 4 + 0], s1 = selm[tq * 4 + 1], s2 = selm[tq * 4 + 2], s3 = selm[tq * 4 + 3];
        Br sb_; sb_.m = -1e30f; sb_.l = 0.f;
#pragma unroll
        for (int r = 0; r < 16; ++r) { sb_.o0[r] = 0.f; sb_.o1[r] = 0.f; }
#define POP_BLOCK(j) do { if (u3) { const int bb = 31 - __builtin_clz(u3); u3 ^= 1u << bb; j = 96 + bb; } else if (u2) { const int bb = 31 - __builtin_clz(u2); u2 ^= 1u << bb; j = 64 + bb; } \
        else if (u1) { const int bb = 31 - __builtin_clz(u1); u1 ^= 1u << bb; j = 32 + bb; } else if (u0) { const int bb = 31 - __builtin_clz(u0); u0 ^= 1u << bb; j = bb; } else j = -1; } while (0)
        int j, j1, j2; POP_BLOCK(j); POP_BLOCK(j1); POP_BLOCK(j2);
        if (j1 >= 0) stage_load(KS + (size_t)j1 * 4096, VS + (size_t)j1 * 4096, wid, lane, sA, true);
        while (j >= 0) {
            if (j2 >= 0) stage_load(KS + (size_t)j2 * 4096, VS + (size_t)j2 * 4096, wid, lane, sB, true);
            const unsigned wsel = (j >> 5) == 0 ? s0 : (j >> 5) == 1 ? s1 : (j >> 5) == 2 ? s2 : s3;
            const bool mine = (wsel >> (j & 31)) & 1u;
            if (!(PVAR & 8) && __any(mine)) {
                const float cb = mine ? -slope * (float)(t - 64 * j) : -INFINITY;
                attend_tile(sb_, lds + L_K + cur * 8192, lds + L_V + cur * 8192, qf, cb, slope, j == tile, tq, -1, wscr, lane, r32, hi);
            }
            if (j1 >= 0) stage_store(lds + L_K + (cur ^ 1) * 8192, lds + L_V + (cur ^ 1) * 8192, wid, lane, sA, true);
            ATT_BAR();
            cur ^= 1; sA = sB; j = j1; j1 = j2; POP_BLOCK(j2);
        }
#undef POP_BLOCK
        acc_rows<false>(accw, sb_.o0, sb_.o1, gs[1] / fmaxf(full_sum(sb_.l), 1e-30f), wscr, r32, hi);
    }
    store_acc(accw, (bf16_t*)(p.ws + (PVAR ? WS_QP : WS_O)) + (size_t)(b * T + 64 * tile + 8 * wid) * D + g * 256, lane);
}

__device__ __forceinline__ void swa_unit(const Params& p, unsigned char* lds_generic, int b, int hh, int tile) {
    lptr lds = (lptr)lds_generic;
    const int tid = tid_opaque(), lane = tid & 63, wid = __builtin_amdgcn_readfirstlane(tid >> 6), r32 = lane & 31, hi = lane >> 5;
    const int h = r32 >> 3, qi = r32 & 7, tq = 8 * wid + qi, t = 64 * tile + tq, head = hh * 4 + h;
    const float slope = exp2f(-0.5f * (float)(head + 1)) * LOG2E;
    const unsigned char* ws = p.ws;
    ALAS float* wscr = (ALAS float*)(lds + L_WSCR) + wid * 64;
    const bf16_t* K = (const bf16_t*)(ws + WS_KSW) + (size_t)b * T * 64;
    const bf16_t* V = (const bf16_t*)(ws + WS_VSW) + (size_t)b * T * 64;
    bf16x8 qf[4];
    {
        const bf16_t* qp = (const bf16_t*)(ws + WS_QS) + ((size_t)(b * 8 + head) * T + t) * 64 + 8 * hi;
#pragma unroll
        for (int d0 = 0; d0 < 4; ++d0) qf[d0] = *(const bf16x8*)(qp + 16 * d0);
    }
    Br sw; sw.m = p.sinks[head] * LOG2E; sw.l = hi ? 0.f : 1.0f;
#pragma unroll
    for (int r = 0; r < 16; ++r) { sw.o0[r] = 0.f; sw.o1[r] = 0.f; }
    const int jlo = (tile - 2 > 0) ? tile - 2 : 0;
    Stage sA, sB; int cur = 0;
    stage_load(K + (size_t)tile * 4096, V + (size_t)tile * 4096, wid, lane, sA, true);
    stage_store(lds + L_K, lds + L_V, wid, lane, sA, true);
    ATT_BAR();
    if (tile - 1 >= jlo) stage_load(K + (size_t)(tile - 1) * 4096, V + (size_t)(tile - 1) * 4096, wid, lane, sA, true);
    for (int j = tile; j >= jlo; --j) {
        if (j - 2 >= jlo) stage_load(K + (size_t)(j - 2) * 4096, V + (size_t)(j - 2) * 4096, wid, lane, sB, true);
        const float cb = -slope * (float)(t - 64 * j);
        attend_tile(sw, lds + L_K + cur * 8192, lds + L_V + cur * 8192, qf, cb, slope, (j == tile) || (j == tile - 2), (j == tile) ? tq : 63, (j == tile - 2) ? tq : -1, wscr, lane, r32, hi);
        if (j > jlo) stage_store(lds + L_K + (cur ^ 1) * 8192, lds + L_V + (cur ^ 1) * 8192, wid, lane, sA, true);
        ATT_BAR();
        cur ^= 1; sA = sB;
    }
    ALAS float* accw = (ALAS float*)(lds + L_ACC) + wid * 2048;
    acc_rows<true>(accw, sw.o0, sw.o1, 1.0f / full_sum(sw.l), wscr, r32, hi);
    store_acc(accw, (bf16_t*)(p.ws + WS_O) + (size_t)(b * T + 64 * tile + 8 * wid) * D + 512 + hh * 256, lane);
}
__device__ __forceinline__ void swa_unit2(const Params& p, unsigned char* lds_generic, int b, int tile) {
    lptr lds = (lptr)lds_generic;
    const int tid = tid_opaque(), lane = tid & 63, wid = __builtin_amdgcn_readfirstlane(tid >> 6), r32 = lane & 31, hi = lane >> 5;
    const int h = r32 >> 3, qi = r32 & 7, tq = 8 * wid + qi, t = 64 * tile + tq;
    const unsigned char* ws = p.ws;
    ALAS float* wscr = (ALAS float*)(lds + L_WSCR) + wid * 64;
    ALAS float* accw = (ALAS float*)(lds + L_ACC) + wid * 2048;
    const bf16_t* K = (const bf16_t*)(ws + WS_KSW) + (size_t)b * T * 64;
    const bf16_t* V = (const bf16_t*)(ws + WS_VSW) + (size_t)b * T * 64;
    const int nt = (tile >= 2) ? 3 : tile + 1;
    Stage st[3];
#pragma unroll
    for (int jj = 0; jj < 3; ++jj) if (jj < nt) stage_load(K + (size_t)(tile - jj) * 4096, V + (size_t)(tile - jj) * 4096, wid, lane, st[jj], true);
#pragma unroll
    for (int jj = 0; jj < 3; ++jj) if (jj < nt) stage_store(lds + jj * 8192, lds + 24576 + jj * 8192, wid, lane, st[jj], true);
    ATT_BAR();
#pragma unroll 1
    for (int hh = 0; hh < 2; ++hh) {
        const int head = hh * 4 + h;
        const float slope = exp2f(-0.5f * (float)(head + 1)) * LOG2E;
        bf16x8 qf[4];
        {
            const bf16_t* qp = (const bf16_t*)(ws + WS_QS) + ((size_t)(b * 8 + head) * T + t) * 64 + 8 * hi;
#pragma unroll
            for (int d0 = 0; d0 < 4; ++d0) qf[d0] = *(const bf16x8*)(qp + 16 * d0);
        }
        Br sw; sw.m = p.sinks[head] * LOG2E; sw.l = hi ? 0.f : 1.0f;
#pragma unroll
        for (int r = 0; r < 16; ++r) { sw.o0[r] = 0.f; sw.o1[r] = 0.f; }
        for (int jj = 0; jj < nt; ++jj) {
            const int j = tile - jj;
            const float cb = -slope * (float)(t - 64 * j);
            attend_tile(sw, lds + jj * 8192, lds + 24576 + jj * 8192, qf, cb, slope, jj != 1, (jj == 0) ? tq : 63, (jj == 2) ? tq : -1, wscr, lane, r32, hi);
        }
        acc_rows<true>(accw, sw.o0, sw.o1, 1.0f / full_sum(sw.l), wscr, r32, hi);
        store_acc(accw, (bf16_t*)(p.ws + WS_O) + (size_t)(b * T + 64 * tile + 8 * wid) * D + 512 + hh * 256, lane);
    }
    ATT_BAR();
}
__device__ __forceinline__ void phase_swa_mfma(const Params& p, unsigned char* lds) {
    for (int u = blockIdx.x; u < BATCH * 2 * (T / 64); u += gridDim.x) swa_unit(p, lds, u >> 8, (u >> 7) & 1, u & 127);
}
template <int PVAR = 0>
__device__ __forceinline__ void phase_nsa_mfma(const Params& p, unsigned char* lds) {
    const int nu = BATCH * NSA_G * (T / 64);
    for (int i = blockIdx.x; i < nu; i += gridDim.x) {
        const int u = (i < (int)gridDim.x) ? (nu - 1 - i) : (i - (int)gridDim.x);
        nsa_unit<PVAR>(p, lds, u >> 8, (u >> 7) & 1, u & 127);
    }
}
}


namespace cmp {
#define CLAS __attribute__((address_space(3)))
constexpr int HS = 264;
__device__ __forceinline__ void compress_unit(const Params& p, unsigned char* lds_generic, int unit) {
    const unsigned char* ws = p.ws;
    const int tid = tid_opaque(), lane = tid & 63, wid = __builtin_amdgcn_readfirstlane(tid >> 6), fr = lane & 15, fq = lane >> 4;
    const int row0 = unit * 32, kv = row0 >> 11, bg = (row0 & 2047) >> 9, c0 = row0 & 511;
    const bf16_t* raw = (const bf16_t*)(ws + WS_KV6 + (size_t)kv * KV6_STRIDE) + (size_t)bg * T * 64;
    const bf16_t* W1T = (const bf16_t*)(ws + WS_W1T) + (size_t)kv * 256 * 2048;
    const bf16_t* W2T = (const bf16_t*)(ws + WS_W2T) + (size_t)kv * 64 * 256;
    const float* b1 = (const float*)(ws + WS_B1) + kv * 256;
    CLAS bf16_t* H = (CLAS bf16_t*)((CLAS unsigned char*)lds_generic);
    const int n0 = wid * 32;
    f32x4 acc[2][2];
#pragma unroll
    for (int i = 0; i < 2; ++i)
#pragma unroll
        for (int j = 0; j < 2; ++j) acc[i][j] = (f32x4){0.f, 0.f, 0.f, 0.f};
    constexpr int LS = 72;
    constexpr int A_BYTES = 32 * LS * 2, B_BYTES = 256 * LS * 2, ST_BYTES = A_BYTES + B_BYTES;
    CLAS unsigned char* sm = (CLAS unsigned char*)lds_generic;
    const int arow = tid >> 3, chunk = tid & 7;
    const bf16_t* ag = raw + (size_t)(c0 + arow) * 1024 + chunk * 8;
    const bf16_t* bgp = W1T + (size_t)arow * 2048 + chunk * 8;
    u32x4 sa, sb[4];
#define CMP_LOAD(k0_) do { if (tid < 256) sa = *(const u32x4*)(ag + (k0_)); _Pragma("unroll") for (int j_ = 0; j_ < 4; ++j_) sb[j_] = *(const u32x4*)(bgp + (size_t)j_ * 64 * 2048 + (k0_)); } while (0)
#define CMP_STORE(buf_) do { CLAS unsigned char* d_ = sm + (buf_) * ST_BYTES; if (tid < 256) *(CLAS u32x4*)(d_ + (arow * LS + chunk * 8) * 2) = sa; \
        _Pragma("unroll") for (int j_ = 0; j_ < 4; ++j_) *(CLAS u32x4*)(d_ + A_BYTES + ((arow + 64 * j_) * LS + chunk * 8) * 2) = sb[j_]; } while (0)
    CMP_LOAD(0); CMP_STORE(0);
    __syncthreads();
    for (int kt = 0; kt < 32; ++kt) {
        const int cur = kt & 1;
        if (kt + 1 < 32) CMP_LOAD((kt + 1) * 64);
        const CLAS unsigned char* As = sm + cur * ST_BYTES; const CLAS unsigned char* Bs = As + A_BYTES;
#pragma unroll
        for (int ks = 0; ks < 2; ++ks) {
            bf16x8 a[2], b[2];
#pragma unroll
            for (int i = 0; i < 2; ++i) { a[i] = *(const CLAS bf16x8*)(As + ((16 * i + fr) * LS + 32 * ks + 8 * fq) * 2); b[i] = *(const CLAS bf16x8*)(Bs + ((n0 + 16 * i + fr) * LS + 32 * ks + 8 * fq) * 2); }
#pragma unroll
            for (int i = 0; i < 2; ++i)
#pragma unroll
                for (int j = 0; j < 2; ++j) acc[i][j] = __builtin_amdgcn_mfma_f32_16x16x32_bf16(a[i], b[j], acc[i][j], 0, 0, 0);
        }
        if (kt + 1 < 32) CMP_STORE(cur ^ 1);
        __syncthreads();
    }
#undef CMP_LOAD
#undef CMP_STORE
#pragma unroll
    for (int i = 0; i < 2; ++i)
#pragma unroll
        for (int j = 0; j < 2; ++j) {
            const int n = n0 + 16 * j + fr; const float bias = b1[n];
#pragma unroll
            for (int r = 0; r < 4; ++r) H[(16 * i + 4 * fq + r) * HS + n] = (bf16_t)f2bf(gelu_tanh(acc[i][j][r] + bias));
        }
    __syncthreads();
    {
        const int mi = wid >> 2, nj = wid & 3;
        f32x4 o = (f32x4){0.f, 0.f, 0.f, 0.f};
        const CLAS bf16_t* hp = H + (16 * mi + fr) * HS + fq * 8;
        const bf16_t* wp = W2T + (size_t)(16 * nj + fr) * 256 + fq * 8;
#pragma unroll
        for (int k0 = 0; k0 < 256; k0 += 32) {
            const bf16x8 ha = *(const CLAS bf16x8*)(hp + k0), wb = *(const bf16x8*)(wp + k0);
            o = __builtin_amdgcn_mfma_f32_16x16x32_bf16(ha, wb, o, 0, 0, 0);
        }
        bf16_t* dst = (bf16_t*)(p.ws + (kv ? WS_VC : WS_KC)) + ((size_t)bg * NCMPP + c0 + 16 * mi + 4 * fq) * 64 + 16 * nj + fr;
#pragma unroll
        for (int r = 0; r < 4; ++r) dst[(size_t)r * 64] = (bf16_t)f2bf(o[r]);
    }
    __syncthreads();
}
__device__ __forceinline__ void phase_compress_swa(const Params& p, unsigned char* lds) {
    const int G = (int)gridDim.x, bx = (int)blockIdx.x;
    if (G >= 256) {
        if (bx < 128) { compress_unit(p, lds, bx); convert_expert_tables(p, 0, bx, 128); }
        else { convert_expert_tables(p, 1, bx - 128, G - 128);
               for (int u = bx - 128; u < BATCH * (T / 64); u += G - 128) att::swa_unit2(p, lds, u >> 7, u & 127); }
    } else {
        for (int u = bx; u < 128; u += G) compress_unit(p, lds, u);
        for (int u = bx; u < BATCH * (T / 64); u += G) att::swa_unit2(p, lds, u >> 7, u & 127);
        convert_expert_tables(p, 2, bx, G);
    }
}
}

#define XB_TMO      128
#define XB_MIS      192
#define XB_XCNT(j)  (256  + 64 * (j))
#define XB_XSUB(j)  (1280 + 64 * (j))
#define XB_XGEN(j)  (2304 + 64 * (j))
#define XB_TOP      3328
#define XB_TOPGEN   3392
#define XCD_BAR_WORDS 3456
#define XB_SPIN_CAP (1u << 18)
#define XLAS __attribute__((address_space(3)))

__device__ __forceinline__ unsigned xb_ld(unsigned* p)              { return __hip_atomic_load(p, __ATOMIC_RELAXED, __HIP_MEMORY_SCOPE_AGENT); }
__device__ __forceinline__ unsigned xb_add(unsigned* p, unsigned v) { return __hip_atomic_fetch_add(p, v, __ATOMIC_RELAXED, __HIP_MEMORY_SCOPE_AGENT); }
__device__ __forceinline__ unsigned xb_xcc_id() { return (unsigned)__builtin_amdgcn_s_getreg((3 << 11) | 20) & 0xFu; }
#define XB_SPIN(cond, bar) do { unsigned _sp = 0; while (cond) { __builtin_amdgcn_s_sleep(1); \
    if ((++_sp & 255u) == 0u) { if (xb_ld(&(bar)[XB_TMO])) break; if (_sp > XB_SPIN_CAP) { atomicAdd(&(bar)[XB_TMO], 1u); break; } } } } while (0)

struct XcdBarrier {
    unsigned* bar; unsigned x;
    volatile XLAS unsigned* st;
};

__device__ __forceinline__ XcdBarrier xcd_barrier_post(unsigned* bar, volatile XLAS unsigned* st) {
    XcdBarrier b; b.bar = bar; b.x = xb_xcc_id(); b.st = st;
    if (threadIdx.x == 0) {
        if (b.x != (blockIdx.x & 7u)) { (void)xb_add(&bar[XB_MIS], 1u); asm volatile("s_waitcnt vmcnt(0)" ::: "memory"); }
        st[3] = xb_add(&bar[XB_XCNT(b.x)], 1u); }
    return b;
}
__device__ __forceinline__ void xcd_barrier_complete(unsigned* bar, unsigned x, unsigned& nloc, unsigned& nx, unsigned& regular) {
    const unsigned G = gridDim.x * gridDim.y * gridDim.z;
    unsigned sum, cnt, mine, n32, sp = 0u;
    for (;;) {
        sum = 0u; cnt = 0u; mine = 0u; n32 = 0u;
#pragma unroll
        for (unsigned j = 0; j < 16; ++j) { const unsigned c = xb_ld(&bar[XB_XCNT(j)]); sum += c; cnt += (c > 0u) ? 1u : 0u; mine = (j == x) ? c : mine; n32 += (j < 8u && c == 32u) ? 1u : 0u; }
        if (sum == G) break;
        __builtin_amdgcn_s_sleep(1);
        if ((++sp & 255u) == 0u) { if (xb_ld(&bar[XB_TMO])) break; if (sp > XB_SPIN_CAP) { atomicAdd(&bar[XB_TMO], 1u); break; } }
    }
    nloc = mine > 0u ? mine : 1u; nx = cnt > 0u ? cnt : 1u;
    regular = (sum == G && G == 256u && n32 == 8u) ? 1u : 0u;
    if (regular != 0u && xb_ld(&bar[XB_MIS]) == 0u) regular |= 2u;
}

struct XbNoHook { __device__ __forceinline__ void operator()() const {} };
template <class Hook = XbNoHook, bool NOWB = false>
__device__ __forceinline__ void xcd_barrier(const XcdBarrier& b, const Hook& hook = Hook()) {
    asm volatile("s_waitcnt vmcnt(0)" ::: "memory");
    __syncthreads();
    const int hk_wid = __builtin_amdgcn_readfirstlane((int)threadIdx.x >> 6);
    if (hk_wid != 0) hook();
    if (threadIdx.x == 0) {
        unsigned* bar = b.bar;
        __builtin_amdgcn_s_waitcnt(0);
        unsigned nloc = b.st[0], nx = b.st[1];
        if (nloc == 0u) { unsigned reg_ = 0u; xcd_barrier_complete(bar, b.x, nloc, nx, reg_); b.st[0] = nloc; b.st[1] = nx; b.st[2] = reg_; }
        const unsigned old = __hip_atomic_fetch_add(&bar[XB_XSUB(b.x)], 1u, __ATOMIC_RELAXED, __HIP_MEMORY_SCOPE_WORKGROUP);
        const unsigned gen = old / nloc;
        if (old + 1u == (gen + 1u) * nloc) {
            if (!(NOWB && (b.st[2] & 2u) != 0u))
            __builtin_amdgcn_fence(__ATOMIC_RELEASE, "agent");
            asm volatile("s_waitcnt vmcnt(0)" ::: "memory");
            (void)xb_add(&bar[XB_TOP], 1u);
            const unsigned target = (gen + 1u) * nx;
            XB_SPIN(xb_ld(&bar[XB_TOP]) < target, bar);
            __builtin_amdgcn_fence(__ATOMIC_ACQUIRE, "agent");
            (void)__hip_atomic_fetch_add(&bar[XB_XGEN(b.x)], 1u, __ATOMIC_RELAXED, __HIP_MEMORY_SCOPE_WORKGROUP);
            asm volatile("s_waitcnt vmcnt(0)" ::: "memory");
        } else {
            unsigned zero_ = 0u; asm volatile("" : "+v"(zero_));
            XB_SPIN(__hip_atomic_fetch_add(&bar[XB_XGEN(b.x)], zero_, __ATOMIC_RELAXED, __HIP_MEMORY_SCOPE_WORKGROUP) <= gen, bar);
            __builtin_amdgcn_fence(__ATOMIC_ACQUIRE, "agent");
            asm volatile("s_waitcnt vmcnt(0)" ::: "memory");
        }
    }
    __syncthreads();
    if (hk_wid == 0) hook();
}


constexpr int LDS_BYTES_FWD = 148480;
extern __shared__ __attribute__((aligned(16))) unsigned char dyn_lds[];
namespace pex {
constexpr int TOK_PER_TICKET = 16, NTICKET = NTOK / TOK_PER_TICKET;
__device__ __forceinline__ int claim(unsigned* ctr, int lane) {
    unsigned t = 0u;
    if (lane == 0) t = __hip_atomic_fetch_add(ctr, 1u, __ATOMIC_RELAXED, __HIP_MEMORY_SCOPE_AGENT);
    return __builtin_amdgcn_readfirstlane((int)t);
}
__device__ __forceinline__ unsigned claim_issue(unsigned* ctr, int lane) {
    unsigned t = 0u;
    if (lane == 0) t = atomicInc(ctr, 0xFFFFFFFFu);
    return t;
}
__device__ __forceinline__ int claim_get(unsigned t) { return __builtin_amdgcn_readfirstlane((int)t); }
struct UMeta { int e_lo, e_hi; float g_lo, g_hi; u32x4 h0, h1; float ss; };
__device__ __forceinline__ void u_meta(const unsigned char* ws, int tok, int lane, unsigned loff, UMeta& m) {
    const int* ep = (const int*)(ws + WS_EIDX) + (size_t)tok * 128;
    m.e_lo = ep[lane]; m.e_hi = ep[64 + lane];
    const float* gp = (const float*)(ws + WS_GATE) + (size_t)tok * 128;
    m.g_lo = gp[lane]; m.g_hi = gp[64 + lane];
    const bf16_t* hg = (const bf16_t*)(ws + WS_H1G + (size_t)tok * D * 2) + loff;
    m.h0 = *(const u32x4*)hg; m.h1 = *(const u32x4*)(hg + 8);
    m.ss = ((const float*)(ws + WS_SS2))[tok];
}
constexpr int UB = 16;
__device__ __forceinline__ void u_task(const unsigned char* ws, int tok, int y, int lane, unsigned loff, const UMeta& m, int tok_next, UMeta& mn) {
    unsigned long long m0 = __ballot((m.e_lo >> 11) == y), m1 = __ballot((m.e_hi >> 11) == y);
    const unsigned char* U = ws + WS_U8;
    const int grp = (lane >> 3) & 7;
    bool first = true;
    f32x2 a2[8]; float rstd2 = 0.f;
    do {
        int slot[UB]; u32x4 uw[UB];
#pragma unroll
        for (int k = 0; k < UB; ++k) {
            int e = 0; slot[k] = -1;
            if (m0 != 0ull) { const int j = __builtin_ctzll(m0); m0 &= m0 - 1ull; slot[k] = j; e = __builtin_amdgcn_readlane(m.e_lo, j); }
            else if (m1 != 0ull) { const int j = __builtin_ctzll(m1); m1 &= m1 - 1ull; slot[k] = 64 + j; e = __builtin_amdgcn_readlane(m.e_hi, j); }
            if (slot[k] >= 0) uw[k] = *(const u32x4*)(U + (size_t)e * D + loff); else uw[k] = (u32x4){0u, 0u, 0u, 0u};
        }
        if (first) {
            if (tok_next >= 0) u_meta(ws, tok_next, lane, loff, mn);
            const u32x4 w0 = m.h0, w1 = m.h1;
            a2[0] = (f32x2){bflo(w0.x), bfhi(w0.x)}; a2[1] = (f32x2){bflo(w0.y), bfhi(w0.y)}; a2[2] = (f32x2){bflo(w0.z), bfhi(w0.z)}; a2[3] = (f32x2){bflo(w0.w), bfhi(w0.w)};
            a2[4] = (f32x2){bflo(w1.x), bfhi(w1.x)}; a2[5] = (f32x2){bflo(w1.y), bfhi(w1.y)}; a2[6] = (f32x2){bflo(w1.z), bfhi(w1.z)}; a2[7] = (f32x2){bflo(w1.w), bfhi(w1.w)};
            rstd2 = (1.0f / U8_SCALE) / sqrtf(m.ss * (1.0f / D) + EPS);
            first = false;
        }
#pragma unroll
        for (int hb = 0; hb < UB / 8; ++hb) {
            if (slot[8 * hb] < 0) break;
            float d[8];
#pragma unroll
            for (int k = 0; k < 8; ++k) {
                f32x2 dd = (f32x2){0.f, 0.f};
#pragma unroll
                for (int q = 0; q < 4; ++q) {
                    const f32x2 lo = __builtin_amdgcn_cvt_pk_f32_fp8((int)uw[8 * hb + k][q], false), hi = __builtin_amdgcn_cvt_pk_f32_fp8((int)uw[8 * hb + k][q], true);
                    dd += a2[2 * q] * lo; dd += a2[2 * q + 1] * hi;
                }
                d[k] = dd.x + dd.y;
                __builtin_amdgcn_sched_barrier(0);
            }
            const float dk = reduce8(d, lane);
            int myslot = -1;
#pragma unroll
            for (int k = 0; k < 8; ++k) myslot = (grp == k) ? slot[8 * hb + k] : myslot;
            const float gA = __shfl(m.g_lo, myslot & 63), gB = __shfl(m.g_hi, myslot & 63);
            const float g = (myslot & 64) ? gB : gA;
            if (myslot >= 0 && (lane & 7) == 0) ((float*)(ws + WS_PW))[(size_t)tok * 128 + myslot] = g * gelu_tanh(dk * rstd2);
        }
    } while ((m0 | m1) != 0ull);
}
struct VMeta { u32x4 e[4]; };
__device__ __forceinline__ void v_meta(const Params& p, int tok, int y, int lane, VMeta& m) {
    const unsigned char* ep = p.ws + WS_EIDX + ((size_t)(lane >> 3) * NTOK + tok) * 64;
#pragma unroll
    for (int q = 0; q < 4; ++q) m.e[q] = *(const u32x4*)(ep + 16 * q);
}
__device__ __forceinline__ void ucol_task(const Params& p, int tok, int y, int lane, const VMeta& m, int tok_next, VMeta& mn) {
    const int cc = lane & 7;
    const bool b2 = lane & 4, b1 = lane & 2, b0 = lane & 1;
    const __amdgpu_buffer_rsrc_t ru = __builtin_amdgcn_make_buffer_rsrc((void*)(p.ws + WS_U8 + (size_t)y * ((size_t)NEXP * 128)), (short)0, NEXP * 128, 0x00020000);
    const unsigned coff = (unsigned)cc * 16u;
    u32x4 uw[16];
#pragma unroll
    for (int q = 0; q < 4; ++q) {
        uw[4 * q] = __builtin_bit_cast(u32x4, __builtin_amdgcn_raw_buffer_load_b128(ru, (int)(m.e[q].x * 128u + coff), 0, 0));
        uw[4 * q + 1] = __builtin_bit_cast(u32x4, __builtin_amdgcn_raw_buffer_load_b128(ru, (int)(m.e[q].y * 128u + coff), 0, 0));
        uw[4 * q + 2] = __builtin_bit_cast(u32x4, __builtin_amdgcn_raw_buffer_load_b128(ru, (int)(m.e[q].z * 128u + coff), 0, 0));
        uw[4 * q + 3] = __builtin_bit_cast(u32x4, __builtin_amdgcn_raw_buffer_load_b128(ru, (int)(m.e[q].w * 128u + coff), 0, 0));
    }
    f32x2 a2[8];
    {
        const unsigned char* hp = p.ws + WS_H1G + (size_t)tok * D * 2 + (size_t)y * 256;
        const u32x4 w0 = *(const u32x4*)(hp + cc * 32u), w1 = *(const u32x4*)(hp + cc * 32u + 16u);
        a2[0] = (f32x2){bflo(w0.x), bfhi(w0.x)}; a2[1] = (f32x2){bflo(w0.y), bfhi(w0.y)}; a2[2] = (f32x2){bflo(w0.z), bfhi(w0.z)}; a2[3] = (f32x2){bflo(w0.w), bfhi(w0.w)};
        a2[4] = (f32x2){bflo(w1.x), bfhi(w1.x)}; a2[5] = (f32x2){bflo(w1.y), bfhi(w1.y)}; a2[6] = (f32x2){bflo(w1.z), bfhi(w1.z)}; a2[7] = (f32x2){bflo(w1.w), bfhi(w1.w)};
    }
    if (tok_next >= 0) v_meta(p, tok_next, y, lane, mn);
    float d[16];
#pragma unroll
    for (int i = 0; i < 16; ++i) {
        f32x2 dd = (f32x2){0.f, 0.f};
#pragma unroll
        for (int q = 0; q < 4; ++q) {
            const f32x2 lo = __builtin_amdgcn_cvt_pk_f32_fp8((int)uw[i][q], false), hi = __builtin_amdgcn_cvt_pk_f32_fp8((int)uw[i][q], true);
            dd += a2[2 * q] * lo; dd += a2[2 * q + 1] * hi;
        }
        d[i] = dd.x + dd.y;
        __builtin_amdgcn_sched_barrier(0);
    }
    float s8[8], s4[4], s2[2];
#pragma unroll
    for (int i = 0; i < 8; ++i) { const float snd = b2 ? d[i] : d[i + 8], keep = b2 ? d[i + 8] : d[i]; s8[i] = keep + __shfl_xor(snd, 4); }
#pragma unroll
    for (int i = 0; i < 4; ++i) { const float snd = b1 ? s8[i] : s8[i + 4], keep = b1 ? s8[i + 4] : s8[i]; s4[i] = keep + __shfl_xor(snd, 2); }
#pragma unroll
    for (int i = 0; i < 2; ++i) { const float snd = b0 ? s4[i] : s4[i + 2], keep = b0 ? s4[i + 2] : s4[i]; s2[i] = keep + __shfl_xor(snd, 1); }
    const unsigned so = (unsigned)(16 * (lane >> 3) + (b2 ? 8 : 0) + (b1 ? 4 : 0) + (b0 ? 2 : 0)) * 2u;
    *(unsigned*)(p.ws + WS_PART + ((size_t)tok * 8 + y) * 256 + so) = pk2(s2[0], s2[1]);
}
__device__ __forceinline__ void phase_expert_act(const Params& p, unsigned char* lds_generic) {
    const int tid_ = tid_opaque(), lane = tid_ & 63, wid = __builtin_amdgcn_readfirstlane(tid_ >> 6);
    const int gw = (int)blockIdx.x * (NTHREADS / 64) + wid, ngw = (int)gridDim.x * (NTHREADS / 64);
    att::lptr stg = (att::lptr)lds_generic + wid * 1024;
    const float* gsrc = (const float*)(p.ws + WS_GATE);
    int pos2[2];
#pragma unroll
    for (int hf = 0; hf < 2; ++hf) {
        const int o = 64 * hf + lane, sg = 8 * (o & 15) + (o >> 4);
        const int G = sg >> 5, rho = sg & 31;
        pos2[hf] = (((rho >> 2) & 3) * 4 + G) * 8 + (rho >> 4) * 4 + (rho & 3);
    }
    for (int tok0 = 2 * gw; tok0 < NTOK; tok0 += 2 * ngw) {
        float wa[2], wb[2];
#pragma unroll
        for (int tt = 0; tt < 2; ++tt) {
            const int tok = tok0 + tt;
            const bf16_t* pp = (const bf16_t*)(p.ws + WS_PART) + (size_t)tok * 1024;
            float sa = 0.f, sb = 0.f;
#pragma unroll
            for (int y = 0; y < (U_FP4 ? NSL4 : 8); ++y) { sa += bf2f(pp[y * 128 + lane]); sb += bf2f(pp[y * 128 + 64 + lane]); }
            const float rstd2 = ((U_FP4 && U_INT4) ? 256.0f / (UI_SCALE * HQ_SCALE) : 1.0f / (U_FP4 ? U4_SCALE : U8_SCALE)) / sqrtf(((const float*)(p.ws + WS_SS2))[tok] * (1.0f / D) + EPS);
            const size_t hm_lo = ((size_t)(lane >> 4) * NTOK + tok) * 16 + (lane & 15), hm_hi = ((size_t)(4 + (lane >> 4)) * NTOK + tok) * 16 + (lane & 15);
            wa[tt] = gsrc[hm_lo] * gelu_tanh(sa * rstd2); wb[tt] = gsrc[hm_hi] * gelu_tanh(sb * rstd2);
            if (!V_MFMA) { float* wp = (float*)(p.ws + WS_PW) + (size_t)tok * 128; wp[lane] = wa[tt]; wp[64 + lane] = wb[tt]; }
        }
        if (V_MFMA) {
#pragma unroll
            for (int tt = 0; tt < 2; ++tt) {
                float mx = fmaxf(fabsf(wa[tt]), fabsf(wb[tt]));
#pragma unroll
                for (int o = 1; o < 64; o <<= 1) mx = fmaxf(mx, __shfl_xor(mx, o));
                mx = fmaxf(mx, 1e-30f);
                const int ex = (int)((__float_as_uint(mx) >> 23) & 255u) - 126;
                const float sc = __uint_as_float((unsigned)(127 + 8 - ex) << 23);
                att::lptr row = stg + tt * 400;
#pragma unroll
                for (int hf = 0; hf < 2; ++hf) {
                    const float x = (hf ? wb[tt] : wa[tt]) * sc;
                    const int b0 = __builtin_amdgcn_cvt_pk_fp8_f32(x, x, 0, false) & 255;
                    const float r1 = (x - __builtin_amdgcn_cvt_f32_fp8(b0, 0)) * 16.0f;
                    const int b1 = __builtin_amdgcn_cvt_pk_fp8_f32(r1, r1, 0, false) & 255;
                    const float r2 = (r1 - __builtin_amdgcn_cvt_f32_fp8(b1, 0)) * 16.0f;
                    const int b2 = __builtin_amdgcn_cvt_pk_fp8_f32(r2, r2, 0, false) & 255;
                    row[pos2[hf]] = (unsigned char)b0; row[128 + pos2[hf]] = (unsigned char)b1; row[256 + pos2[hf]] = (unsigned char)b2;
                }
                if (lane == 0) *(ALAS float*)(row + 384) = __uint_as_float((unsigned)(127 + ex - 8) << 23) * (1.0f / V4_SCALE);
            }
            __builtin_amdgcn_fence(__ATOMIC_RELEASE, "wavefront"); __builtin_amdgcn_wave_barrier();
            if (lane < 50) {
                const int tt = lane >= 25 ? 1 : 0, piece = lane - 25 * tt;
                const u32x4 v = *(const ALAS u32x4*)(stg + tt * 400 + piece * 16);
                *(u32x4*)(p.ws + WS_VREC + (size_t)(tok0 + tt) * 1024 + 512 + piece * 16) = v;
            }
            __builtin_amdgcn_wave_barrier();
        }
    }
}
__device__ __forceinline__ void v_task(const Params& p, int tok, int y, int lane, const VMeta& m, int tok_next, VMeta& mn) {
    const int cc = lane & 7;
    const bool b5 = lane & 32, b4 = lane & 16, b3 = lane & 8;
    const __amdgpu_buffer_rsrc_t rv = __builtin_amdgcn_make_buffer_rsrc((void*)(p.ws + WS_V8 + (size_t)y * ((size_t)NEXP * 128)), (short)0, NEXP * 128, 0x00020000);
    const unsigned coff = (unsigned)cc * 16u;
    u32x4 vw[16];
#pragma unroll
    for (int q = 0; q < 4; ++q) {
        vw[4 * q] = __builtin_bit_cast(u32x4, __builtin_amdgcn_raw_buffer_load_b128(rv, (int)(m.e[q].x * 128u + coff), 0, 0));
        vw[4 * q + 1] = __builtin_bit_cast(u32x4, __builtin_amdgcn_raw_buffer_load_b128(rv, (int)(m.e[q].y * 128u + coff), 0, 0));
        vw[4 * q + 2] = __builtin_bit_cast(u32x4, __builtin_amdgcn_raw_buffer_load_b128(rv, (int)(m.e[q].z * 128u + coff), 0, 0));
        vw[4 * q + 3] = __builtin_bit_cast(u32x4, __builtin_amdgcn_raw_buffer_load_b128(rv, (int)(m.e[q].w * 128u + coff), 0, 0));
    }
    f32x4 w[4];
    {
        const unsigned char* wp = p.ws + WS_PW + (size_t)tok * 512;
        const unsigned woff = (unsigned)(lane >> 3) * 64u;
#pragma unroll
        for (int q = 0; q < 4; ++q) w[q] = *(const f32x4*)(wp + woff + 16 * q);
    }
    const unsigned colb = (unsigned)(128 * y + 16 * cc + (b5 ? 8 : 0) + (b4 ? 4 : 0) + (b3 ? 2 : 0)) * 4u;
    const unsigned hb = *(const unsigned*)(p.ws + WS_H1G + (size_t)tok * D * 2 + (colb >> 1));
    const f32x2 g2v = *(const f32x2*)((const unsigned char*)p.ln2_g + colb);
    const f32x2 h = (f32x2){bflo(hb) / g2v.x, bfhi(hb) / g2v.y};
    if (tok_next >= 0) v_meta(p, tok_next, y, lane, mn);
    f32x2 acc2[8];
#pragma unroll
    for (int q = 0; q < 8; ++q) acc2[q] = (f32x2){0.f, 0.f};
#pragma unroll
    for (int i = 0; i < 16; ++i) {
        const float wi = w[i >> 2][i & 3];
#pragma unroll
        for (int q = 0; q < 4; ++q) {
            const f32x2 lo = __builtin_amdgcn_cvt_pk_f32_fp8((int)vw[i][q], false), hi = __builtin_amdgcn_cvt_pk_f32_fp8((int)vw[i][q], true);
            acc2[2 * q] += lo * wi; acc2[2 * q + 1] += hi * wi;
        }
        __builtin_amdgcn_sched_barrier(0);
    }
    float acc[16];
#pragma unroll
    for (int q = 0; q < 8; ++q) { acc[2 * q] = acc2[q].x; acc[2 * q + 1] = acc2[q].y; }
    float s8[8], s4[4], s2[2];
#pragma unroll
    for (int i = 0; i < 8; ++i) { const float snd = b5 ? acc[i] : acc[i + 8], keep = b5 ? acc[i + 8] : acc[i]; s8[i] = keep + __shfl_xor(snd, 32); }
#pragma unroll
    for (int i = 0; i < 4; ++i) { const float snd = b4 ? s8[i] : s8[i + 4], keep = b4 ? s8[i + 4] : s8[i]; s4[i] = keep + __shfl_xor(snd, 16); }
#pragma unroll
    for (int i = 0; i < 2; ++i) { const float snd = b3 ? s4[i] : s4[i + 2], keep = b3 ? s4[i + 2] : s4[i]; s2[i] = keep + __shfl_xor(snd, 8); }
    *(unsigned*)(p.ws + WS_H2 + (size_t)tok * D * 2 + (colb >> 1)) = pk2(h.x + s2[0] * (1.0f / V8_SCALE), h.y + s2[1] * (1.0f / V8_SCALE));
}

__device__ __forceinline__ void unpack32_fp4(const u32x4& w, f32x2 (&f)[16]) {
#pragma unroll
    for (int q = 0; q < 4; ++q) {
        f[4 * q + 0] = __builtin_amdgcn_cvt_scalef32_pk_f32_fp4(w[q], 1.0f, 0);
        f[4 * q + 1] = __builtin_amdgcn_cvt_scalef32_pk_f32_fp4(w[q], 1.0f, 1);
        f[4 * q + 2] = __builtin_amdgcn_cvt_scalef32_pk_f32_fp4(w[q], 1.0f, 2);
        f[4 * q + 3] = __builtin_amdgcn_cvt_scalef32_pk_f32_fp4(w[q], 1.0f, 3);
    }
}
__device__ __forceinline__ void ucol4_task(const Params& p, int tok, int z, int lane, const VMeta& m, int tok_next, VMeta& mn) {
    const int cc = lane & 7;
    const bool b2 = lane & 4, b1 = lane & 2, b0 = lane & 1;
    const __amdgpu_buffer_rsrc_t ru = __builtin_amdgcn_make_buffer_rsrc((void*)(p.ws + WS_U8 + (size_t)z * ((size_t)NEXP * 128)), (short)0, NEXP * 128, 0x00020000);
    const unsigned coff = (unsigned)cc * 16u;
    u32x4 uw[16];
#pragma unroll
    for (int q = 0; q < 4; ++q) {
        uw[4 * q] = __builtin_bit_cast(u32x4, __builtin_amdgcn_raw_buffer_load_b128(ru, (int)(m.e[q].x * 128u + coff), 0, 0));
        uw[4 * q + 1] = __builtin_bit_cast(u32x4, __builtin_amdgcn_raw_buffer_load_b128(ru, (int)(m.e[q].y * 128u + coff), 0, 0));
        uw[4 * q + 2] = __builtin_bit_cast(u32x4, __builtin_amdgcn_raw_buffer_load_b128(ru, (int)(m.e[q].z * 128u + coff), 0, 0));
        uw[4 * q + 3] = __builtin_bit_cast(u32x4, __builtin_amdgcn_raw_buffer_load_b128(ru, (int)(m.e[q].w * 128u + coff), 0, 0));
    }
    f32x2 a2[16];
    {
        const unsigned char* hp = p.ws + WS_H1G + (size_t)tok * D * 2 + (size_t)z * 512 + cc * 64u;
#pragma unroll
        for (int q = 0; q < 4; ++q) {
            const u32x4 w = *(const u32x4*)(hp + 16 * q);
            a2[4 * q] = (f32x2){bflo(w.x), bfhi(w.x)}; a2[4 * q + 1] = (f32x2){bflo(w.y), bfhi(w.y)}; a2[4 * q + 2] = (f32x2){bflo(w.z), bfhi(w.z)}; a2[4 * q + 3] = (f32x2){bflo(w.w), bfhi(w.w)};
        }
    }
    if (tok_next >= 0) v_meta(p, tok_next, z, lane, mn);
    float d[16];
#pragma unroll
    for (int i = 0; i < 16; ++i) {
        f32x2 uf[16]; unpack32_fp4(uw[i], uf);
        f32x2 dd = (f32x2){0.f, 0.f};
#pragma unroll
        for (int q = 0; q < 16; ++q) dd += a2[q] * uf[q];
        d[i] = dd.x + dd.y;
        __builtin_amdgcn_sched_barrier(0);
    }
    float s8[8], s4[4], s2[2];
#pragma unroll
    for (int i = 0; i < 8; ++i) { const float snd = b2 ? d[i] : d[i + 8], keep = b2 ? d[i + 8] : d[i]; s8[i] = keep + __shfl_xor(snd, 4); }
#pragma unroll
    for (int i = 0; i < 4; ++i) { const float snd = b1 ? s8[i] : s8[i + 4], keep = b1 ? s8[i + 4] : s8[i]; s4[i] = keep + __shfl_xor(snd, 2); }
#pragma unroll
    for (int i = 0; i < 2; ++i) { const float snd = b0 ? s4[i] : s4[i + 2], keep = b0 ? s4[i + 2] : s4[i]; s2[i] = keep + __shfl_xor(snd, 1); }
    const unsigned so = (unsigned)(16 * (lane >> 3) + (b2 ? 8 : 0) + (b1 ? 4 : 0) + (b0 ? 2 : 0)) * 2u;
    *(unsigned*)(p.ws + WS_PART + ((size_t)tok * 8 + z) * 256 + so) = pk2(s2[0], s2[1]);
}
__device__ __forceinline__ void v4_task(const Params& p, int tok, int z, int lane, const VMeta& m, int tok_next, VMeta& mn) {
    const int cc = lane & 7;
    const bool b5 = lane & 32, b4 = lane & 16, b3 = lane & 8;
    const __amdgpu_buffer_rsrc_t rv = __builtin_amdgcn_make_buffer_rsrc((void*)(p.ws + WS_V8 + (size_t)z * ((size_t)NEXP * 128)), (short)0, NEXP * 128, 0x00020000);
    const unsigned coff = (unsigned)cc * 16u;
    u32x4 vw[16];
#pragma unroll
    for (int q = 0; q < 4; ++q) {
        vw[4 * q] = __builtin_bit_cast(u32x4, __builtin_amdgcn_raw_buffer_load_b128(rv, (int)(m.e[q].x * 128u + coff), 0, 0));
        vw[4 * q + 1] = __builtin_bit_cast(u32x4, __builtin_amdgcn_raw_buffer_load_b128(rv, (int)(m.e[q].y * 128u + coff), 0, 0));
        vw[4 * q + 2] = __builtin_bit_cast(u32x4, __builtin_amdgcn_raw_buffer_load_b128(rv, (int)(m.e[q].z * 128u + coff), 0, 0));
        vw[4 * q + 3] = __builtin_bit_cast(u32x4, __builtin_amdgcn_raw_buffer_load_b128(rv, (int)(m.e[q].w * 128u + coff), 0, 0));
    }
    f32x4 w[4];
    {
        const unsigned char* wp = p.ws + WS_PW + (size_t)tok * 512;
        const unsigned woff = (unsigned)(lane >> 3) * 64u;
#pragma unroll
        for (int q = 0; q < 4; ++q) w[q] = *(const f32x4*)(wp + woff + 16 * q);
    }
    const unsigned col = (unsigned)(256 * z + 32 * cc + (b5 ? 16 : 0) + (b4 ? 8 : 0) + (b3 ? 4 : 0));
    const u32x2 hb = *(const u32x2*)(p.ws + WS_H1G + (size_t)tok * D * 2 + col * 2u);
    const f32x4 g2v = *(const f32x4*)(p.ln2_g + col);
    if (tok_next >= 0) v_meta(p, tok_next, z, lane, mn);
    f32x2 acc2[16];
#pragma unroll
    for (int q = 0; q < 16; ++q) acc2[q] = (f32x2){0.f, 0.f};
#pragma unroll
    for (int i = 0; i < 16; ++i) {
        const float wi = w[i >> 2][i & 3];
        f32x2 vf[16]; unpack32_fp4(vw[i], vf);
#pragma unroll
        for (int q = 0; q < 16; ++q) acc2[q] += vf[q] * wi;
        __builtin_amdgcn_sched_barrier(0);
    }
    float acc[32];
#pragma unroll
    for (int q = 0; q < 16; ++q) { acc[2 * q] = acc2[q].x; acc[2 * q + 1] = acc2[q].y; }
    float s16[16], s8[8], s4[4];
#pragma unroll
    for (int i = 0; i < 16; ++i) { const float snd = b5 ? acc[i] : acc[i + 16], keep = b5 ? acc[i + 16] : acc[i]; s16[i] = keep + __shfl_xor(snd, 32); }
#pragma unroll
    for (int i = 0; i < 8; ++i) { const float snd = b4 ? s16[i] : s16[i + 8], keep = b4 ? s16[i + 8] : s16[i]; s8[i] = keep + __shfl_xor(snd, 16); }
#pragma unroll
    for (int i = 0; i < 4; ++i) { const float snd = b3 ? s8[i] : s8[i + 4], keep = b3 ? s8[i + 4] : s8[i]; s4[i] = keep + __shfl_xor(snd, 8); }
    const float h0 = bflo(hb.x) / g2v.x + s4[0] * (1.0f / V4_SCALE), h1 = bfhi(hb.x) / g2v.y + s4[1] * (1.0f / V4_SCALE);
    const float h2 = bflo(hb.y) / g2v.z + s4[2] * (1.0f / V4_SCALE), h3 = bfhi(hb.y) / g2v.w + s4[3] * (1.0f / V4_SCALE);
    *(u32x2*)(p.ws + WS_H2 + (size_t)tok * D * 2 + col * 2u) = (u32x2){pk2(h0, h1), pk2(h2, h3)};
}

__device__ __forceinline__ void quantize_h(const Params& p) {
    const int tid_ = tid_opaque(), lane = tid_ & 63;
    const int gw = (int)blockIdx.x * (NTHREADS / 64) + __builtin_amdgcn_readfirstlane(tid_ >> 6), ngw = (int)gridDim.x * (NTHREADS / 64);
    for (int tok = gw; tok < NTOK; tok += ngw) {
        const bf16_t* hrow = (const bf16_t*)(p.ws + WS_H1G + (size_t)tok * D * 2) + 16 * lane;
        const u32x4 w0 = *(const u32x4*)hrow, w1 = *(const u32x4*)(hrow + 8);
        const float f[16] = {bflo(w0.x), bfhi(w0.x), bflo(w0.y), bfhi(w0.y), bflo(w0.z), bfhi(w0.z), bflo(w0.w), bfhi(w0.w),
                             bflo(w1.x), bfhi(w1.x), bflo(w1.y), bfhi(w1.y), bflo(w1.z), bfhi(w1.z), bflo(w1.w), bfhi(w1.w)};
        unsigned pa[2] = {0u, 0u}, pb[2] = {0u, 0u};
#pragma unroll
        for (int i = 0; i < 16; ++i) {
            int q = (int)rintf(f[i] * HQ_SCALE); q = q < -120 ? -120 : (q > 119 ? 119 : q);
            pb[i >> 3] |= ((unsigned)q & 15u) << (4 * (i & 7));
            pa[i >> 3] |= ((unsigned)((q + 8) >> 4) & 15u) << (4 * (i & 7));
        }
        *(u32x2*)(p.ws + WS_HQA + (size_t)tok * 512 + lane * 8) = (u32x2){pa[0], pa[1]};
        *(u32x2*)(p.ws + WS_HQB + (size_t)tok * 512 + lane * 8) = (u32x2){pb[0], pb[1]};
    }
}
__device__ __forceinline__ void ucoli_task(const Params& p, int tok, int z, int lane, const VMeta& m, int tok_next, VMeta& mn) {
    const int cc = lane & 7;
    const bool b2 = lane & 4, b1 = lane & 2, b0 = lane & 1;
    const __amdgpu_buffer_rsrc_t ru = __builtin_amdgcn_make_buffer_rsrc((void*)(p.ws + WS_U8 + (size_t)z * ((size_t)NEXP * 128)), (short)0, NEXP * 128, 0x00020000);
    const unsigned coff = (unsigned)cc * 16u;
    u32x4 uw[16];
#pragma unroll
    for (int q = 0; q < 4; ++q) {
        uw[4 * q] = __builtin_bit_cast(u32x4, __builtin_amdgcn_raw_buffer_load_b128(ru, (int)(m.e[q].x * 128u + coff), 0, 0));
        uw[4 * q + 1] = __builtin_bit_cast(u32x4, __builtin_amdgcn_raw_buffer_load_b128(ru, (int)(m.e[q].y * 128u + coff), 0, 0));
        uw[4 * q + 2] = __builtin_bit_cast(u32x4, __builtin_amdgcn_raw_buffer_load_b128(ru, (int)(m.e[q].z * 128u + coff), 0, 0));
        uw[4 * q + 3] = __builtin_bit_cast(u32x4, __builtin_amdgcn_raw_buffer_load_b128(ru, (int)(m.e[q].w * 128u + coff), 0, 0));
    }
    const u32x4 pa = *(const u32x4*)(p.ws + WS_HQA + (size_t)tok * 512 + z * 128 + coff);
    const u32x4 pb = *(const u32x4*)(p.ws + WS_HQB + (size_t)tok * 512 + z * 128 + coff);
    if (tok_next >= 0) v_meta(p, tok_next, z, lane, mn);
    float d[16];
#pragma unroll
    for (int i = 0; i < 16; ++i) {
        int sa = 0, sb = 0;
#pragma unroll
        for (int q = 0; q < 4; ++q) { sa = __builtin_amdgcn_sdot8((int)uw[i][q], (int)pa[q], sa, false); sb = __builtin_amdgcn_sdot8((int)uw[i][q], (int)pb[q], sb, false); }
        d[i] = (float)(16 * sa + sb);
    }
    float s8[8], s4[4], s2[2];
#pragma unroll
    for (int i = 0; i < 8; ++i) { const float snd = b2 ? d[i] : d[i + 8], keep = b2 ? d[i + 8] : d[i]; s8[i] = keep + __shfl_xor(snd, 4); }
#pragma unroll
    for (int i = 0; i < 4; ++i) { const float snd = b1 ? s8[i] : s8[i + 4], keep = b1 ? s8[i + 4] : s8[i]; s4[i] = keep + __shfl_xor(snd, 2); }
#pragma unroll
    for (int i = 0; i < 2; ++i) { const float snd = b0 ? s4[i] : s4[i + 2], keep = b0 ? s4[i + 2] : s4[i]; s2[i] = keep + __shfl_xor(snd, 1); }
    const unsigned so = (unsigned)(16 * (lane >> 3) + (b2 ? 8 : 0) + (b1 ? 4 : 0) + (b0 ? 2 : 0)) * 2u;
    *(unsigned*)(p.ws + WS_PART + ((size_t)tok * 8 + z) * 256 + so) = pk2(s2[0] * (1.0f / 256.0f), s2[1] * (1.0f / 256.0f));
}
struct URows { u32x4 uw[16]; u32x4 pa, pb; };
__device__ __forceinline__ void u_issue(const Params& p, const __amdgpu_buffer_rsrc_t ru, int tok, int z, unsigned coff, const VMeta& m, URows& r) {
#pragma unroll
    for (int q = 0; q < 4; ++q) {
        r.uw[4 * q] = __builtin_bit_cast(u32x4, __builtin_amdgcn_raw_buffer_load_b128(ru, (int)(m.e[q].x * 128u + coff), 0, 0));
        r.uw[4 * q + 1] = __builtin_bit_cast(u32x4, __builtin_amdgcn_raw_buffer_load_b128(ru, (int)(m.e[q].y * 128u + coff), 0, 0));
        r.uw[4 * q + 2] = __builtin_bit_cast(u32x4, __builtin_amdgcn_raw_buffer_load_b128(ru, (int)(m.e[q].z * 128u + coff), 0, 0));
        r.uw[4 * q + 3] = __builtin_bit_cast(u32x4, __builtin_amdgcn_raw_buffer_load_b128(ru, (int)(m.e[q].w * 128u + coff), 0, 0));
    }
    r.pa = *(const u32x4*)(p.ws + WS_HQA + (size_t)tok * 512 + z * 128 + coff);
    r.pb = *(const u32x4*)(p.ws + WS_HQB + (size_t)tok * 512 + z * 128 + coff);
}
__device__ __forceinline__ void u_finish(const Params& p, int tok, int z, int lane, const URows& r) {
    const bool b2 = lane & 4, b1 = lane & 2, b0 = lane & 1;
    float d[16];
#pragma unroll
    for (int i = 0; i < 16; ++i) {
        int sa = 0, sb = 0;
#pragma unroll
        for (int q = 0; q < 4; ++q) { sa = __builtin_amdgcn_sdot8((int)r.uw[i][q], (int)r.pa[q], sa, false); sb = __builtin_amdgcn_sdot8((int)r.uw[i][q], (int)r.pb[q], sb, false); }
        d[i] = (float)(16 * sa + sb);
    }
    float s8[8], s4[4], s2[2];
#pragma unroll
    for (int i = 0; i < 8; ++i) { const float snd = b2 ? d[i] : d[i + 8], keep = b2 ? d[i + 8] : d[i]; s8[i] = keep + __shfl_xor(snd, 4); }
#pragma unroll
    for (int i = 0; i < 4; ++i) { const float snd = b1 ? s8[i] : s8[i + 4], keep = b1 ? s8[i + 4] : s8[i]; s4[i] = keep + __shfl_xor(snd, 2); }
#pragma unroll
    for (int i = 0; i < 2; ++i) { const float snd = b0 ? s4[i] : s4[i + 2], keep = b0 ? s4[i + 2] : s4[i]; s2[i] = keep + __shfl_xor(snd, 1); }
    const unsigned so = (unsigned)(16 * (lane >> 3) + (b2 ? 8 : 0) + (b1 ? 4 : 0) + (b0 ? 2 : 0)) * 2u;
    *(unsigned*)(p.ws + WS_PART + ((size_t)tok * 8 + z) * 256 + so) = pk2(s2[0] * (1.0f / 256.0f), s2[1] * (1.0f / 256.0f));
}
__device__ __forceinline__ void phase_u_pipe(const Params& p) {
    const int tid_ = tid_opaque(), lane = tid_ & 63;
    const unsigned coff = (unsigned)(lane & 7) * 16u;
    unsigned* ctr = (unsigned*)(p.ws + WS_CTR);
    const int x0 = (int)(xb_xcc_id() & 7u);
    volatile XLAS unsigned* cen_ = (volatile XLAS unsigned*)((XLAS unsigned char*)dyn_lds + (LDS_BYTES_FWD - 16));
    const bool regular = (cen_[2] & 1u) != 0u; const int xrank = (int)cen_[3], toff = regular ? 512 : 0;
    unsigned oc1 = 0u, oc2 = 0u, oc3 = 0u;
    for (int k = 0; k < NSL4; ++k) {
        const int z = (x0 + k) & (NSL4 - 1);
        if (k == 1) {
            oc1 = __hip_atomic_load(ctr + ((x0 + 1) & (NSL4 - 1)) * 64, __ATOMIC_RELAXED, __HIP_MEMORY_SCOPE_AGENT);
            oc2 = __hip_atomic_load(ctr + ((x0 + 2) & (NSL4 - 1)) * 64, __ATOMIC_RELAXED, __HIP_MEMORY_SCOPE_AGENT);
            oc3 = __hip_atomic_load(ctr + ((x0 + 3) & (NSL4 - 1)) * 64, __ATOMIC_RELAXED, __HIP_MEMORY_SCOPE_AGENT);
        }
        if (k >= 1 && (int)__builtin_amdgcn_readfirstlane(k == 1 ? oc1 : (k == 2 ? oc2 : oc3)) + toff >= NTICKET) continue;
        int tk = (regular && k == 0) ? __builtin_amdgcn_readfirstlane((xrank * 8 + (tid_ >> 6)) * 2 + (x0 >> 2)) : claim(ctr + z * 64, lane) + toff;
        if (tk >= NTICKET) continue;
        unsigned tkn_raw = claim_issue(ctr + z * 64, lane); int tkn = NTICKET; bool need_claim = false;
        const __amdgpu_buffer_rsrc_t ru = __builtin_amdgcn_make_buffer_rsrc((void*)(p.ws + WS_U8 + (size_t)z * ((size_t)NEXP * 128)), (short)0, NEXP * 128, 0x00020000);
        int i = 0, T0 = tk * TOK_PER_TICKET;
        VMeta mA, mB; URows rA, rB;
        v_meta(p, T0, z, lane, mA);
        u_issue(p, ru, T0, z, coff, mA, rA);
        v_meta(p, T0 + 1, z, lane, mB);
#define U_NEXT() do { const int i1 = i + 1, i2 = i + 2; \
            T1 = (i1 < TOK_PER_TICKET) ? tk * TOK_PER_TICKET + i1 : ((tkn < NTICKET) ? tkn * TOK_PER_TICKET + (i1 - TOK_PER_TICKET) : -1); \
            T2 = (i2 < TOK_PER_TICKET) ? tk * TOK_PER_TICKET + i2 : ((tkn < NTICKET) ? tkn * TOK_PER_TICKET + (i2 - TOK_PER_TICKET) : -1); } while (0)
#define U_STEP(mX, rX, mY, rY) do { int T1, T2; if (need_claim) { tkn_raw = claim_issue(ctr + z * 64, lane); need_claim = false; } U_NEXT(); \
              \
              \
            v_meta(p, T2 >= 0 ? T2 : T0, z, lane, mX); \
            u_issue(p, ru, T1 >= 0 ? T1 : T0, z, coff, mY, rY); \
            u_finish(p, T0, z, lane, rX); \
            tkn = claim_get(tkn_raw) + toff; \
            if (T1 < 0) { done = true; } else { T0 = T1; if (++i == TOK_PER_TICKET) { i = 0; tk = tkn; need_claim = true; } } } while (0)
        bool done = false;
#pragma unroll 1
        while (true) {
            U_STEP(mA, rA, mB, rB); if (done) break;
            U_STEP(mB, rB, mA, rA); if (done) break;
        }
#undef U_STEP
#undef U_NEXT
    }
}
template <bool VPHASE, int PROBE = 0>
__device__ __forceinline__ void phase_sliced(const Params& p_in) {
    Params p = p_in; if (PROBE) p.out = (float*)(p_in.ws + WS_QP);
    const int tid_ = tid_opaque(), lane = tid_ & 63;
    const unsigned loff = 16u * (unsigned)lane;
    unsigned* ctr = (unsigned*)(p.ws + WS_CTR + (VPHASE ? 2048 : 0) + PROBE * 4096);
    constexpr bool FP4 = VPHASE ? V_FP4 : U_FP4;
    constexpr int NSL = FP4 ? NSL4 : 8;
    const int x0 = (int)(xb_xcc_id() & 7u);
    for (int k = 0; k < NSL; ++k) {
        const int y = (x0 + k) & (NSL - 1);
        int tk = claim(ctr + y * 64, lane);
        if (tk >= NTICKET) continue;
        VMeta vm, vmn;
        v_meta(p, tk * TOK_PER_TICKET, y, lane, vm);
        while (tk < NTICKET) {
            const int tkn = claim(ctr + y * 64, lane);
#pragma unroll 1
            for (int i = 0; i < TOK_PER_TICKET; ++i) {
                const int tok = tk * TOK_PER_TICKET + i;
                const int tok_next = (i + 1 < TOK_PER_TICKET) ? tok + 1 : ((tkn < NTICKET) ? tkn * TOK_PER_TICKET : -1);
                if (VPHASE) { if (FP4) v4_task(p, tok, y, lane, vm, tok_next, vmn); else v_task(p, tok, y, lane, vm, tok_next, vmn); vm = vmn; }
                else { if (FP4 && U_INT4) ucoli_task(p, tok, y, lane, vm, tok_next, vmn); else if (FP4) ucol4_task(p, tok, y, lane, vm, tok_next, vmn); else ucol_task(p, tok, y, lane, vm, tok_next, vmn); vm = vmn; }
            }
            tk = tkn;
        }
    }
}
typedef int v8i __attribute__((ext_vector_type(8)));
#define VM_WAIT(n) asm volatile("s_waitcnt vmcnt(" #n ")" ::: "memory")
#define VM_ROWS(G, m0_, m1_, m2_, m3_) do { \
        __builtin_amdgcn_raw_ptr_buffer_load_lds(rv, (ALAS void*)(lw + (G) * 4096), 16, (int)((m0_) * 128u + coff), 0, 0, 0); \
        __builtin_amdgcn_raw_ptr_buffer_load_lds(rv, (ALAS void*)(lw + (G) * 4096 + 1024), 16, (int)((m1_) * 128u + coff), 0, 0, 0); \
        __builtin_amdgcn_raw_ptr_buffer_load_lds(rv, (ALAS void*)(lw + (G) * 4096 + 2048), 16, (int)((m2_) * 128u + coff), 0, 0, 0); \
        __builtin_amdgcn_raw_ptr_buffer_load_lds(rv, (ALAS void*)(lw + (G) * 4096 + 3072), 16, (int)((m3_) * 128u + coff), 0, 0, 0); } while (0)
#define VM_REC(tok_, par_) __builtin_amdgcn_raw_ptr_buffer_load_lds(rrec, (ALAS void*)(lw + 16384 + (par_) * 1024), 16, (int)(rec_lane + (unsigned)(tok_) * rec_mul), 0, 0, 0)
#define VM_EIDX(par_) do { const unsigned ea_ = lwa0 + 16384u + (unsigned)(par_) * 1024u + (unsigned)(lane >> 3) * 64u; \
        asm volatile("ds_read_b128 %0, %4\n\tds_read_b128 %1, %4 offset:16\n\tds_read_b128 %2, %4 offset:32\n\tds_read_b128 %3, %4 offset:48\n\ts_waitcnt lgkmcnt(0)" \
                     : "=&v"(e0), "=&v"(e1), "=&v"(e2), "=&v"(e3) : "v"(ea_) : "memory"); } while (0)
#define VM_STAGE(G, lastN, m0_, m1_, m2_, m3_) do { \
        VM_WAIT(12);            \
        u32x2 t00, t01, t10, t11, t20, t21, t30, t31; \
        asm volatile("ds_read_b64_tr_b16 %0, %8 offset:" #G "*4096\n\tds_read_b64_tr_b16 %1, %8 offset:" #G "*4096+512\n\t" \
                     "ds_read_b64_tr_b16 %2, %9 offset:" #G "*4096\n\tds_read_b64_tr_b16 %3, %9 offset:" #G "*4096+512\n\t" \
                     "ds_read_b64_tr_b16 %4, %10 offset:" #G "*4096\n\tds_read_b64_tr_b16 %5, %10 offset:" #G "*4096+512\n\t" \
                     "ds_read_b64_tr_b16 %6, %11 offset:" #G "*4096\n\tds_read_b64_tr_b16 %7, %11 offset:" #G "*4096+512\n\t" \
                     "s_waitcnt lgkmcnt(0)" \
                     : "=&v"(t00), "=&v"(t01), "=&v"(t10), "=&v"(t11), "=&v"(t20), "=&v"(t21), "=&v"(t30), "=&v"(t31) \
                     : "v"(ta0), "v"(ta1), "v"(ta2), "v"(ta3) : "memory"); \
        if ((G) == 0 && T1 >= 0) VM_EIDX(par ^ 1); \
        VM_ROWS(G, m0_, m1_, m2_, m3_); \
        const unsigned wlo_ = (G) == 0 ? bw0.x : ((G) == 1 ? bw0.z : ((G) == 2 ? bw1.x : bw1.z)), whi_ = (G) == 0 ? bw0.y : ((G) == 1 ? bw0.w : ((G) == 2 ? bw1.y : bw1.w)); \
        const v8i B_ = (v8i){(int)__builtin_amdgcn_perm(0u, wlo_, sel0), (int)__builtin_amdgcn_perm(0u, wlo_, sel1), (int)__builtin_amdgcn_perm(0u, wlo_, sel2), (int)__builtin_amdgcn_perm(0u, wlo_, sel3), \
                             (int)__builtin_amdgcn_perm(0u, whi_, sel0), (int)__builtin_amdgcn_perm(0u, whi_, sel1), (int)__builtin_amdgcn_perm(0u, whi_, sel2), (int)__builtin_amdgcn_perm(0u, whi_, sel3)}; \
        acc0 = __builtin_amdgcn_mfma_scale_f32_16x16x128_f8f6f4((v8i){(int)t00.x, (int)t00.y, (int)t01.x, (int)t01.y, 0, 0, 0, 0}, B_, acc0, 4, 0, 0, 0x7F7F7F7F, 0, 0x7F7F7F7F); \
        acc1 = __builtin_amdgcn_mfma_scale_f32_16x16x128_f8f6f4((v8i){(int)t10.x, (int)t10.y, (int)t11.x, (int)t11.y, 0, 0, 0, 0}, B_, acc1, 4, 0, 0, 0x7F7F7F7F, 0, 0x7F7F7F7F); \
        acc2 = __builtin_amdgcn_mfma_scale_f32_16x16x128_f8f6f4((v8i){(int)t20.x, (int)t20.y, (int)t21.x, (int)t21.y, 0, 0, 0, 0}, B_, acc2, 4, 0, 0, 0x7F7F7F7F, 0, 0x7F7F7F7F); \
        acc3 = __builtin_amdgcn_mfma_scale_f32_16x16x128_f8f6f4((v8i){(int)t30.x, (int)t30.y, (int)t31.x, (int)t31.y, 0, 0, 0, 0}, B_, acc3, 4, 0, 0, 0x7F7F7F7F, 0, 0x7F7F7F7F); \
    } while (0)
constexpr int V_LDS_PER_WAVE = 18432;
__device__ __forceinline__ void phase_v_mfma(const Params& p, unsigned char* lds_generic) {
    const int tid_ = tid_opaque(), lane = tid_ & 63, wid = __builtin_amdgcn_readfirstlane(tid_ >> 6);
    att::lptr lw = (att::lptr)lds_generic + wid * V_LDS_PER_WAVE;
    const int n = lane & 15, g = lane >> 4, tr_r = n >> 2, tr_c = n & 3;
    const unsigned lwa0 = (unsigned)(size_t)lw;
    const unsigned lwa = lwa0 + (unsigned)((8 * g + tr_r) * 128 + 8 * tr_c);
    const unsigned ta0 = lwa + (unsigned)((0 ^ tr_r) * 32), ta1 = lwa + (unsigned)((1 ^ tr_r) * 32), ta2 = lwa + (unsigned)((2 ^ tr_r) * 32), ta3 = lwa + (unsigned)((3 ^ tr_r) * 32);
    const unsigned coff = (2u * ((unsigned)((lane & 7) >> 1) ^ (unsigned)((lane >> 3) & 3)) + (unsigned)(lane & 1)) * 16u;
    const int sp = n >> 2, ds = n & 3;
    const unsigned selz = 0x0C0C0C0Cu;
    const unsigned sel0 = sp == 3 ? selz : (selz ^ ((0x0Cu ^ 0u) << (8 * ds))), sel1 = sp == 3 ? selz : (selz ^ ((0x0Cu ^ 1u) << (8 * ds)));
    const unsigned sel2 = sp == 3 ? selz : (selz ^ ((0x0Cu ^ 2u) << (8 * ds))), sel3 = sp == 3 ? selz : (selz ^ ((0x0Cu ^ 3u) << (8 * ds)));
    const float fsp = sp == 0 ? 1.0f : (sp == 1 ? 1.0f / 16.0f : (sp == 2 ? 1.0f / 256.0f : 0.0f));
    const unsigned bwa = 512u + (unsigned)((sp > 2 ? 2 : sp) * 128 + g * 32);
    unsigned* ctr = (unsigned*)(p.ws + WS_CTR + 2048);
    const __amdgpu_buffer_rsrc_t rrec = __builtin_amdgcn_make_buffer_rsrc((void*)p.ws, (short)0, (int)(WS_END - 1), 0x00020000);
    const unsigned rec_lane = lane < 32 ? (unsigned)(WS_EIDX + (size_t)(lane >> 2) * NTOK * 64 + (lane & 3) * 16) : (unsigned)(WS_VREC + 512 + (size_t)(lane - 32) * 16);
    const unsigned rec_mul = lane < 32 ? 64u : 1024u;
    const int x0 = (int)(xb_xcc_id() & 7u);
    volatile XLAS unsigned* cen_ = (volatile XLAS unsigned*)((XLAS unsigned char*)dyn_lds + (LDS_BYTES_FWD - 16));
    const bool regular = (cen_[2] & 1u) != 0u; const int xrank = (int)cen_[3], toff = regular ? 512 : 0;
    unsigned oc1 = 0u, oc2 = 0u, oc3 = 0u;
    for (int k = 0; k < NSL4; ++k) {
        const int z = (x0 + k) & (NSL4 - 1);
        if (k == 1) {
            oc1 = __hip_atomic_load(ctr + ((x0 + 1) & (NSL4 - 1)) * 64, __ATOMIC_RELAXED, __HIP_MEMORY_SCOPE_AGENT);
            oc2 = __hip_atomic_load(ctr + ((x0 + 2) & (NSL4 - 1)) * 64, __ATOMIC_RELAXED, __HIP_MEMORY_SCOPE_AGENT);
            oc3 = __hip_atomic_load(ctr + ((x0 + 3) & (NSL4 - 1)) * 64, __ATOMIC_RELAXED, __HIP_MEMORY_SCOPE_AGENT);
        }
        if (k >= 1 && (int)__builtin_amdgcn_readfirstlane(k == 1 ? oc1 : (k == 2 ? oc2 : oc3)) + toff >= NTICKET) continue;
        int tk = (regular && k == 0) ? __builtin_amdgcn_readfirstlane((xrank * 8 + (tid_ >> 6)) * 2 + (x0 >> 2)) : claim(ctr + z * 64, lane) + toff;
        if (tk >= NTICKET) continue;
        unsigned tkn_raw = claim_issue(ctr + z * 64, lane); int tkn = NTICKET; bool need_claim = false;
        const __amdgpu_buffer_rsrc_t rv = __builtin_amdgcn_make_buffer_rsrc((void*)(p.ws + WS_V8 + (size_t)z * ((size_t)NEXP * 128)), (short)0, NEXP * 128, 0x00020000);
        int i = 0, T0 = tk * TOK_PER_TICKET, par = 0;
        u32x4 e0, e1, e2, e3;
        VM_REC(T0, 0);
        VM_WAIT(0);
        VM_EIDX(0);
        if (1 < TOK_PER_TICKET) VM_REC(T0 + 1, 1);
        VM_ROWS(0, e0.x, e0.y, e0.z, e0.w); VM_ROWS(1, e1.x, e1.y, e1.z, e1.w); VM_ROWS(2, e2.x, e2.y, e2.z, e2.w); VM_ROWS(3, e3.x, e3.y, e3.z, e3.w);
#pragma unroll 1
        while (true) {
            int T1, T2;
            if (need_claim) { tkn_raw = claim_issue(ctr + z * 64, lane); need_claim = false; }
            { const int i1 = i + 1, i2 = i + 2;
              T1 = (i1 < TOK_PER_TICKET) ? tk * TOK_PER_TICKET + i1 : ((tkn < NTICKET) ? tkn * TOK_PER_TICKET + (i1 - TOK_PER_TICKET) : -1);
              T2 = (i2 < TOK_PER_TICKET) ? tk * TOK_PER_TICKET + i2 : ((tkn < NTICKET) ? tkn * TOK_PER_TICKET + (i2 - TOK_PER_TICKET) : -1); }
            u32x4 bw0, bw1; float osc;
            { const unsigned ba_ = lwa0 + 16384u + (unsigned)par * 1024u;
              asm volatile("ds_read_b128 %0, %3\n\tds_read_b128 %1, %3 offset:16\n\tds_read_b32 %2, %4 offset:896\n\ts_waitcnt lgkmcnt(0)"
                           : "=&v"(bw0), "=&v"(bw1), "=&v"(osc) : "v"(ba_ + bwa), "v"(ba_) : "memory"); }
            VM_REC(T2 >= 0 ? T2 : T0, par);
            f32x4 acc0 = (f32x4){0.f, 0.f, 0.f, 0.f}, acc1 = acc0, acc2 = acc0, acc3 = acc0;
            VM_STAGE(0, 12, e0.x, e0.y, e0.z, e0.w); VM_STAGE(1, 8, e1.x, e1.y, e1.z, e1.w); VM_STAGE(2, 4, e2.x, e2.y, e2.z, e2.w); VM_STAGE(3, 0, e3.x, e3.y, e3.z, e3.w);
            float o[16];
#pragma unroll
            for (int q = 0; q < 4; ++q) {
                const f32x4 a = q == 0 ? acc0 : (q == 1 ? acc1 : (q == 2 ? acc2 : acc3));
#pragma unroll
                for (int r = 0; r < 4; ++r) {
                    float v = a[r] * fsp;
                    v += __int_as_float(__builtin_amdgcn_update_dpp(0, __float_as_int(v), 0x124, 0xF, 0xF, false));
                    v += __int_as_float(__builtin_amdgcn_update_dpp(0, __float_as_int(v), 0x128, 0xF, 0xF, false));
                    o[4 * q + r] = v * osc;
                }
            }
            if (n < 4) {
                unsigned char* op = p.ws + WS_H2 + (size_t)T0 * D * 2 + (size_t)(256 * z + 64 * g + 16 * ds) * 2;
                const u32x4 oa = (u32x4){pk2(o[0], o[1]), pk2(o[2], o[3]), pk2(o[4], o[5]), pk2(o[6], o[7])}, ob = (u32x4){pk2(o[8], o[9]), pk2(o[10], o[11]), pk2(o[12], o[13]), pk2(o[14], o[15])};
                asm volatile("global_store_dwordx4 %0, %1, off\n\tglobal_store_dwordx4 %0, %2, off offset:16\n\ts_nop 3" :: "v"(op), "v"(oa), "v"(ob) : "memory");
            }
            tkn = claim_get(tkn_raw) + toff;
            if (T1 < 0) break;
            T0 = T1; par ^= 1;
            if (++i == TOK_PER_TICKET) { i = 0; tk = tkn; need_claim = true; }
        }
    }
    asm volatile("s_waitcnt vmcnt(0)" ::: "memory");
}
#undef VM_STAGE
#undef VM_ROWS
#undef VM_REC
#undef VM_EIDX
#undef VM_WAIT
__device__ __forceinline__ void phase_final_norm(const Params& p) {
    const int tid_ = tid_opaque(), lane = tid_ & 63;
    const int gw = (int)blockIdx.x * (NTHREADS / 64) + __builtin_amdgcn_readfirstlane(tid_ >> 6), ngw = (int)gridDim.x * (NTHREADS / 64);
    const unsigned loff = 16u * (unsigned)lane;
    f32x4 g[4];
#pragma unroll
    for (int q = 0; q < 4; ++q) g[q] = *(const f32x4*)(p.lnf_g + loff + 4 * q);
    f32x4 rg2[4];
#pragma unroll
    for (int q = 0; q < 4; ++q) { const f32x4 t = *(const f32x4*)(p.ln2_g + loff + 4 * q); rg2[q] = (f32x4){1.0f / t.x, 1.0f / t.y, 1.0f / t.z, 1.0f / t.w}; }
    for (int tok0 = gw * 4; tok0 < NTOK; tok0 += ngw * 4) {
        u32x4 w0[4], w1[4];
#pragma unroll
        for (int r = 0; r < 4; ++r) {
            const bf16_t* hrow = (const bf16_t*)(p.ws + WS_H2 + (size_t)(tok0 + r) * D * 2) + loff;
            w0[r] = *(const u32x4*)hrow; w1[r] = *(const u32x4*)(hrow + 8);
        }
        f32x4 y[4][4]; float ss[4];
#pragma unroll
        for (int r = 0; r < 4; ++r) {
            y[r][0] = (f32x4){bflo(w0[r].x), bfhi(w0[r].x), bflo(w0[r].y), bfhi(w0[r].y)}; y[r][1] = (f32x4){bflo(w0[r].z), bfhi(w0[r].z), bflo(w0[r].w), bfhi(w0[r].w)};
            y[r][2] = (f32x4){bflo(w1[r].x), bfhi(w1[r].x), bflo(w1[r].y), bfhi(w1[r].y)}; y[r][3] = (f32x4){bflo(w1[r].z), bfhi(w1[r].z), bflo(w1[r].w), bfhi(w1[r].w)};
            if (V_MFMA) {
                const bf16_t* grow = (const bf16_t*)(p.ws + WS_H1G + (size_t)(tok0 + r) * D * 2) + loff;
                const u32x4 a0 = *(const u32x4*)grow, a1 = *(const u32x4*)(grow + 8);
                y[r][0] += (f32x4){bflo(a0.x), bfhi(a0.x), bflo(a0.y), bfhi(a0.y)} * rg2[0]; y[r][1] += (f32x4){bflo(a0.z), bfhi(a0.z), bflo(a0.w), bfhi(a0.w)} * rg2[1];
                y[r][2] += (f32x4){bflo(a1.x), bfhi(a1.x), bflo(a1.y), bfhi(a1.y)} * rg2[2]; y[r][3] += (f32x4){bflo(a1.z), bfhi(a1.z), bflo(a1.w), bfhi(a1.w)} * rg2[3];
            }
            ss[r] = 0.f;
#pragma unroll
            for (int q = 0; q < 4; ++q) ss[r] += (y[r][q].x * y[r][q].x + y[r][q].y * y[r][q].y) + (y[r][q].z * y[r][q].z + y[r][q].w * y[r][q].w);
        }
#pragma unroll
        for (int o = 1; o < 64; o <<= 1) {
#pragma unroll
            for (int r = 0; r < 4; ++r) ss[r] += __shfl_xor(ss[r], o);
        }
#pragma unroll
        for (int r = 0; r < 4; ++r) {
            const float rstd = 1.0f / sqrtf(ss[r] * (1.0f / D) + EPS);
            float* orow = (float*)((unsigned char*)p.out + (size_t)(tok0 + r) * D * 4) + loff;
#pragma unroll
            for (int q = 0; q < 4; ++q) *(f32x4*)(orow + 4 * q) = (f32x4){y[r][q].x * rstd * g[q].x, y[r][q].y * rstd * g[q].y, y[r][q].z * rstd * g[q].z, y[r][q].w * rstd * g[q].w};
        }
    }
}

__device__ __forceinline__ void final_norm_pass(const Params& p, int tok0, unsigned loff, const f32x4 (&g)[4], const f32x4 (&rg2)[4], const u32x4 (&a0v)[4], const u32x4 (&a1v)[4]) {
    u32x4 w0[4], w1[4];
#pragma unroll
    for (int r = 0; r < 4; ++r) {
        const bf16_t* hrow = (const bf16_t*)(p.ws + WS_H2 + (size_t)(tok0 + r) * D * 2) + loff;
        w0[r] = *(const u32x4*)hrow; w1[r] = *(const u32x4*)(hrow + 8);
    }
    f32x4 y[4][4]; float ss[4];
#pragma unroll
    for (int r = 0; r < 4; ++r) {
        y[r][0] = (f32x4){bflo(w0[r].x), bfhi(w0[r].x), bflo(w0[r].y), bfhi(w0[r].y)}; y[r][1] = (f32x4){bflo(w0[r].z), bfhi(w0[r].z), bflo(w0[r].w), bfhi(w0[r].w)};
        y[r][2] = (f32x4){bflo(w1[r].x), bfhi(w1[r].x), bflo(w1[r].y), bfhi(w1[r].y)}; y[r][3] = (f32x4){bflo(w1[r].z), bfhi(w1[r].z), bflo(w1[r].w), bfhi(w1[r].w)};
        const u32x4 a0 = a0v[r], a1 = a1v[r];
        y[r][0] += (f32x4){bflo(a0.x), bfhi(a0.x), bflo(a0.y), bfhi(a0.y)} * rg2[0]; y[r][1] += (f32x4){bflo(a0.z), bfhi(a0.z), bflo(a0.w), bfhi(a0.w)} * rg2[1];
        y[r][2] += (f32x4){bflo(a1.x), bfhi(a1.x), bflo(a1.y), bfhi(a1.y)} * rg2[2]; y[r][3] += (f32x4){bflo(a1.z), bfhi(a1.z), bflo(a1.w), bfhi(a1.w)} * rg2[3];
        ss[r] = 0.f;
#pragma unroll
        for (int q = 0; q < 4; ++q) ss[r] += (y[r][q].x * y[r][q].x + y[r][q].y * y[r][q].y) + (y[r][q].z * y[r][q].z + y[r][q].w * y[r][q].w);
    }
#pragma unroll
    for (int o = 1; o < 64; o <<= 1) {
#pragma unroll
        for (int r = 0; r < 4; ++r) ss[r] += __shfl_xor(ss[r], o);
    }
#pragma unroll
    for (int r = 0; r < 4; ++r) {
        const float rstd = 1.0f / sqrtf(ss[r] * (1.0f / D) + EPS);
        float* orow = (float*)((unsigned char*)p.out + (size_t)(tok0 + r) * D * 4) + loff;
#pragma unroll
        for (int q = 0; q < 4; ++q) *(f32x4*)(orow + 4 * q) = (f32x4){y[r][q].x * rstd * g[q].x, y[r][q].y * rstd * g[q].y, y[r][q].z * rstd * g[q].z, y[r][q].w * rstd * g[q].w};
    }
}
__device__ __forceinline__ void phase_final_norm_pre(const Params& p, const u32x4 (&pre0)[2][4], const u32x4 (&pre1)[2][4]) {
    static_assert(V_MFMA, "the preloaded final norm adds the residual from h1*g");
    const int tid_ = tid_opaque(), lane = tid_ & 63;
    const int gw = (int)blockIdx.x * (NTHREADS / 64) + __builtin_amdgcn_readfirstlane(tid_ >> 6), ngw = (int)gridDim.x * (NTHREADS / 64);
    const unsigned loff = 16u * (unsigned)lane;
    f32x4 g[4];
#pragma unroll
    for (int q = 0; q < 4; ++q) g[q] = *(const f32x4*)(p.lnf_g + loff + 4 * q);
    f32x4 rg2[4];
#pragma unroll
    for (int q = 0; q < 4; ++q) { const f32x4 t = *(const f32x4*)(p.ln2_g + loff + 4 * q); rg2[q] = (f32x4){1.0f / t.x, 1.0f / t.y, 1.0f / t.z, 1.0f / t.w}; }
    int tok0 = gw * 4;
    if (tok0 < NTOK) { final_norm_pass(p, tok0, loff, g, rg2, pre0[0], pre1[0]); tok0 += ngw * 4; }
    if (tok0 < NTOK) { final_norm_pass(p, tok0, loff, g, rg2, pre0[1], pre1[1]); tok0 += ngw * 4; }
    for (; tok0 < NTOK; tok0 += ngw * 4) {
        u32x4 a0v[4], a1v[4];
#pragma unroll
        for (int r = 0; r < 4; ++r) { const bf16_t* grow = (const bf16_t*)(p.ws + WS_H1G + (size_t)(tok0 + r) * D * 2) + loff; a0v[r] = *(const u32x4*)grow; a1v[r] = *(const u32x4*)(grow + 8); }
        final_norm_pass(p, tok0, loff, g, rg2, a0v, a1v);
    }
}
}

constexpr int LDS_BYTES = 148480;
static_assert(LDS_BYTES_FWD == LDS_BYTES, "LDS size constants out of sync");
extern __shared__ __attribute__((aligned(16))) unsigned char dyn_lds[];

__device__ __forceinline__ Params load_params() {
#if !defined(__HIP_DEVICE_COMPILE__)
    return Params{};
#else
    const __attribute__((address_space(4))) unsigned char* ka = (const __attribute__((address_space(4))) unsigned char*)__builtin_amdgcn_kernarg_segment_ptr();
    asm volatile("" : "+s"(ka));
    const __attribute__((address_space(4))) Params* kp = (const __attribute__((address_space(4))) Params*)ka;
    Params r;
    r.x = kp->x; r.ln1_g = kp->ln1_g; r.w_in = kp->w_in; r.pe_k = kp->pe_k; r.w1_k = kp->w1_k; r.w2_k = kp->w2_k; r.pe_v = kp->pe_v; r.w1_v = kp->w1_v; r.w2_v = kp->w2_v;
    r.sinks = kp->sinks; r.w_out = kp->w_out; r.ln2_g = kp->ln2_g; r.wq = kp->wq; r.pkeys = kp->pkeys; r.pu = kp->pu; r.pv = kp->pv; r.lnf_g = kp->lnf_g; r.out = kp->out; r.ws = kp->ws;
    return r;
#endif
}
__global__ void __launch_bounds__(NTHREADS, 2) fwd_megakernel(Params p_unused) {
    cg::grid_group grid = cg::this_grid();
    float* lds = (float*)dyn_lds;
    PG8_LAS unsigned char* ldsp = (PG8_LAS unsigned char*)dyn_lds;
    volatile XLAS unsigned* bst = (volatile XLAS unsigned*)((XLAS unsigned char*)dyn_lds + (LDS_BYTES - 16));
    if (threadIdx.x < 4) bst[threadIdx.x] = 0u;
    __syncthreads();
    { const Params p = load_params(); (void)xcd_barrier_post((unsigned*)(p.ws + WS_BAR), bst); }
#define GRID_BARRIER() do { const Params p_ = load_params(); XcdBarrier xb_; xb_.bar = (unsigned*)(p_.ws + WS_BAR); xb_.x = xb_xcc_id(); \
        xb_.st = (volatile XLAS unsigned*)((XLAS unsigned char*)dyn_lds + (LDS_BYTES - 16)); xcd_barrier(xb_); } while (0)
    for (int rep = 0; rep < 1 + PROBE_PREP; ++rep) { const Params p = load_params(); phase_prep(p); }
    if (gridDim.y == 0x7fffu) grid.sync();
    GRID_BARRIER();
    for (int rep = 0; rep < 1 + PROBE_PROJ; ++rep) { const Params p = load_params();
      pg8::Gemm g{(const bf16_t*)(p.ws + WS_XN), (const bf16_t*)(p.ws + WS_WIN), NTOK, DINP, D}; pg8::StaticOrder S; S.init(NTOK, DINP, (int)gridDim.x, (int)blockIdx.x);
      EpiProjT E{p.ws}; pg8::gemm_phase<EpiProjT, pg8::StaticOrder, true, true>(ldsp, g, S, E); }
    GRID_BARRIER();
    for (int rep = 0; rep < 1 + PROBE_CS; ++rep) { const Params p = load_params(); cmp::phase_compress_swa(p, dyn_lds); }
    GRID_BARRIER();
    { const Params p = load_params(); att::phase_nsa_mfma<0>(p, dyn_lds); }
#if PROBE_NSA
    { const Params p = load_params(); att::phase_nsa_mfma<PROBE_NSA>(p, dyn_lds); }
#endif
    { f32x4 accx[2][2][4][2];
      { const Params p_ = load_params(); XcdBarrier xb_; xb_.bar = (unsigned*)(p_.ws + WS_BAR); xb_.x = xb_xcc_id();
        xb_.st = (volatile XLAS unsigned*)((XLAS unsigned char*)dyn_lds + (LDS_BYTES - 16));
        pg8::StaticOrder S0; S0.init(NTOK, D, (int)gridDim.x, (int)blockIdx.x); pg8::Unit u0; const bool has0 = S0.next(0, u0);
        const int tid0 = tid_opaque(), wid0 = __builtin_amdgcn_readfirstlane(tid0 >> 6), lane0 = tid0 & 63;
        const float* xp = p_.x;
        xcd_barrier(xb_, [&]() { if (has0) EpiOutT::load_x(xp, accx, u0, wid0 >> 2, wid0 & 3, lane0 & 15, lane0 >> 4); }); }
      const Params p = load_params();
      pg8::Gemm g{(const bf16_t*)(p.ws + WS_O), (const bf16_t*)(p.ws + WS_WOUT), NTOK, D, D}; pg8::StaticOrder S; S.init(NTOK, D, (int)gridDim.x, (int)blockIdx.x);
      EpiOutT E{p.x, p.ln2_g, p.out, (bf16_t*)(p.ws + WS_H1G), (float*)(p.ws + WS_SS2)}; pg8::gemm_phase_impl<EpiOutT, pg8::StaticOrder, true, true, true>(ldsp, g, S, E, accx); }
    { const Params p_ = load_params(); XcdBarrier xb_; xb_.bar = (unsigned*)(p_.ws + WS_BAR); xb_.x = xb_xcc_id();
      xb_.st = (volatile XLAS unsigned*)((XLAS unsigned char*)dyn_lds + (LDS_BYTES - 16)); xcd_barrier<XbNoHook, true>(xb_); }
    for (int rep = 0; rep < 1 + PROBE_QP; ++rep) { const Params p = load_params();
      pg8::Gemm g{(const bf16_t*)(p.ws + WS_H1G), (const bf16_t*)(p.ws + WS_WQ), NTOK, PQ, D}; pg8::StaticOrder S; S.init(NTOK, PQ, (int)gridDim.x, (int)blockIdx.x);
      EpiQPT E{(const float*)(p.ws + WS_SS2), (bf16_t*)(p.ws + WS_QP)}; pg8::gemm_phase<EpiQPT, pg8::StaticOrder, true, true>(ldsp, g, S, E); }
    GRID_BARRIER();
    if (U_FP4 && U_INT4) { const Params p = load_params(); pex::quantize_h(p); }
    for (int rep = 0; rep < 1 + PROBE_SEL; ++rep) { const Params p = load_params(); psel::phase_peer_select(p, dyn_lds); }
    GRID_BARRIER();
    { const Params p = load_params(); if (U_FP4 && U_INT4) pex::phase_u_pipe(p); else pex::phase_sliced<false>(p); }
#if PROBE_PEXU
    { const Params p = load_params(); pex::phase_sliced<false, 1>(p); }
#endif
    GRID_BARRIER();
    for (int rep = 0; rep < 1 + PROBE_ACT; ++rep) { const Params p = load_params(); pex::phase_expert_act(p, dyn_lds); }
    GRID_BARRIER();
    { const Params p = load_params(); if (V_MFMA) pex::phase_v_mfma(p, dyn_lds); else pex::phase_sliced<true>(p); }
#if PROBE_PEXV
    { const Params p = load_params(); pex::phase_sliced<true, 1>(p); }
#endif
    { u32x4 pre0[2][4], pre1[2][4];
      { const Params p_ = load_params(); XcdBarrier xb_; xb_.bar = (unsigned*)(p_.ws + WS_BAR); xb_.x = xb_xcc_id();
        xb_.st = (volatile XLAS unsigned*)((XLAS unsigned char*)dyn_lds + (LDS_BYTES - 16));
        const int tidn = tid_opaque(), lanen = tidn & 63;
        const int gwn = (int)blockIdx.x * (NTHREADS / 64) + __builtin_amdgcn_readfirstlane(tidn >> 6), stepn = (int)gridDim.x * (NTHREADS / 64) * 4;
        const unsigned char* h1gp = p_.ws + WS_H1G;
        xcd_barrier(xb_, [&]() {
#pragma unroll
            for (int k = 0; k < 2; ++k) {
                const int t0 = gwn * 4 + k * stepn;
                if (t0 < NTOK) {
#pragma unroll
                    for (int r = 0; r < 4; ++r) { const bf16_t* grow = (const bf16_t*)(h1gp + (size_t)(t0 + r) * D * 2) + 16 * lanen; pre0[k][r] = *(const u32x4*)grow; pre1[k][r] = *(const u32x4*)(grow + 8); }
                }
            } }); }
      const Params p = load_params(); pex::phase_final_norm_pre(p, pre0, pre1); }
}

extern "C" void kernel_launch(void* const* d_in, const int* in_sizes, int n_in, void* d_out, int out_size, void* d_ws, size_t ws_size, hipStream_t stream) {
    if (n_in != 17 || ws_size < WS_END) { fprintf(stderr, "kernel_launch: unexpected inputs (n_in %d, ws %zu)\n", n_in, ws_size); return; }
    static int grid_blocks = 0;
    if (!grid_blocks) {
        int dev = 0, cus = 0, per_cu = 0;
        (void)hipGetDevice(&dev);
        (void)hipDeviceGetAttribute(&cus, hipDeviceAttributeMultiprocessorCount, dev);
        (void)hipFuncSetAttribute((const void*)fwd_megakernel, hipFuncAttributeMaxDynamicSharedMemorySize, LDS_BYTES);
        (void)hipOccupancyMaxActiveBlocksPerMultiprocessor(&per_cu, (const void*)fwd_megakernel, NTHREADS, LDS_BYTES);
        if (per_cu < 1) per_cu = 1;
        grid_blocks = cus * per_cu;
        fprintf(stderr, "kernel_launch: %d CUs x %d blocks/CU\n", cus, per_cu);
    }
    Params p{};
    p.x = (const float*)d_in[0]; p.ln1_g = (const float*)d_in[1]; p.w_in = (const float*)d_in[2];
    p.pe_k = (const float*)d_in[3]; p.w1_k = (const float*)d_in[4]; p.w2_k = (const float*)d_in[5];
    p.pe_v = (const float*)d_in[6]; p.w1_v = (const float*)d_in[7]; p.w2_v = (const float*)d_in[8];
    p.sinks = (const float*)d_in[9]; p.w_out = (const float*)d_in[10]; p.ln2_g = (const float*)d_in[11];
    p.wq = (const float*)d_in[12]; p.pkeys = (const float*)d_in[13]; p.pu = (const float*)d_in[14]; p.pv = (const float*)d_in[15];
    p.lnf_g = (const float*)d_in[16];
    p.out = (float*)d_out; p.ws = (unsigned char*)d_ws;
    (void)hipMemsetAsync((unsigned char*)d_ws + WS_BAR, 0, 16 * 1024 + 8192, stream);
    void* args[] = {&p};
    hipError_t e = hipLaunchCooperativeKernel((void*)fwd_megakernel, dim3(grid_blocks), dim3(NTHREADS), args, LDS_BYTES, stream);
    if (e != hipSuccess) fprintf(stderr, "cooperative launch failed: %s (grid %d)\n", hipGetErrorString(e), grid_blocks);
}
```
